# Optimizing an MI355X kernel written in HIP

```python
import jax, jax.numpy as jnp
from jax import lax
import numpy as np

D_MODEL = 4096
BATCH = 4
SEQ = 2048
DEPTH = 2

N_META = 16
CHUNK = 16
EXPAND = 2
D_INNER = EXPAND * D_MODEL
N_MIXERS = 2
HG_DK = 128
HG_HEADS = D_INNER // HG_DK
HG_DV = D_INNER // HG_HEADS
GLA_HEADS = 8
GLA_KW = D_INNER // 2
GLA_DK = GLA_KW // GLA_HEADS
GLA_DV = D_INNER // GLA_HEADS
GLA_RANK = 16
GLA_GATE_NORM = 16.0
ALPHA = (2.0 * DEPTH) ** 0.25
BETA = (8.0 * DEPTH) ** -0.25
LN_EPS = 1e-5
RMS_EPS = 1e-6

kernel_name = 'hgrn2_gla_interleaved_deepnorm_meta'


def layer_norm(x, g, b):
    xf = x.astype(jnp.float32)
    mu = jnp.mean(xf, axis=-1, keepdims=True)
    var = jnp.mean(jnp.square(xf - mu), axis=-1, keepdims=True)
    return ((xf - mu) * lax.rsqrt(var + LN_EPS) * g.astype(jnp.float32) + b.astype(jnp.float32)).astype(x.dtype)


def head_rms_norm(o, g):
    B, T, H, dv = o.shape
    ms = jnp.mean(jnp.square(o), axis=-1, keepdims=True)
    return (o * lax.rsqrt(ms + RMS_EPS)).reshape(B, T, H * dv) * g.astype(jnp.float32)


def chunked_gated_linear_attention(q, k, v, log_g):
    B, T, H, dk = q.shape
    dv = v.shape[-1]
    nc = T // CHUNK

    def to_chunks(a):
        return a.reshape(B, nc, CHUNK, H, a.shape[-1]).transpose(1, 0, 3, 2, 4)

    q, k, v, log_g = (to_chunks(a) for a in (q, k, v, log_g))
    b = jnp.cumsum(log_g, axis=-2)
    b_last = b[..., -1:, :]
    q_dec = q * jnp.exp(b)
    k_inv = k * jnp.exp(-b)
    k_dec = k * jnp.exp(b_last - b)
    causal = jnp.tril(jnp.ones((CHUNK, CHUNK), dtype=bool))
    scores = jnp.where(causal, jnp.einsum('nbhid,nbhjd->nbhij', q_dec, k_inv), 0.0)
    o_intra = jnp.einsum('nbhij,nbhjv->nbhiv', scores, v)
    g_last = jnp.exp(b_last[..., 0, :])

    def step(S, xs):
        qd, kd, vc, gl = xs
        o = jnp.einsum('bhid,bhdv->bhiv', qd, S)
        S = gl[..., None] * S + jnp.einsum('bhjd,bhjv->bhdv', kd, vc)
        return S, o

    S0 = jnp.zeros((B, H, dk, dv), dtype=q.dtype)
    _, o_inter = lax.scan(step, S0, (q_dec, k_dec, v, g_last))
    o = o_intra + o_inter
    return o.transpose(1, 0, 3, 2, 4).reshape(B, T, H, dv)


def hgrn2_mixer(x, w_in, b_f, lb, norm_g, w_out):
    B, T, _ = x.shape
    q, f, i, z = jnp.split(x @ w_in, 4, axis=-1)
    q = jax.nn.silu(q.astype(jnp.float32))
    fg = lb + (1.0 - lb) * jax.nn.sigmoid((f + b_f).astype(jnp.float32))
    k = 1.0 - fg
    log_g = jnp.log(fg)
    o = chunked_gated_linear_attention(
        q.reshape(B, T, HG_HEADS, HG_DK), k.reshape(B, T, HG_HEADS, HG_DK),
        i.astype(jnp.float32).reshape(B, T, HG_HEADS, HG_DV), log_g.reshape(B, T, HG_HEADS, HG_DK))
    y = head_rms_norm(o, norm_g) * jax.nn.silu(z.astype(jnp.float32))
    return y.astype(x.dtype) @ w_out


def gla_mixer(x, w_in, w_g1, w_g2, b_g, norm_g, w_out):
    B, T, _ = x.shape
    q, k, v, z = jnp.split(x @ w_in, [GLA_KW, 2 * GLA_KW, 2 * GLA_KW + D_INNER], axis=-1)
    log_g = jax.nn.log_sigmoid(((x @ w_g1) @ w_g2 + b_g).astype(jnp.float32)) / GLA_GATE_NORM
    q = q.astype(jnp.float32) * (GLA_DK ** -0.5)
    o = chunked_gated_linear_attention(
        q.reshape(B, T, GLA_HEADS, GLA_DK), k.astype(jnp.float32).reshape(B, T, GLA_HEADS, GLA_DK),
        v.astype(jnp.float32).reshape(B, T, GLA_HEADS, GLA_DV), log_g.reshape(B, T, GLA_HEADS, GLA_DK))
    y = head_rms_norm(o, norm_g) * jax.nn.silu(z.astype(jnp.float32))
    return y.astype(x.dtype) @ w_out


def setup_inputs(seed: int = 0) -> dict:
    key = jax.random.key(seed)
    ks = jax.random.split(key, 24)
    n = lambda k, shape, s: jax.random.normal(k, shape, jnp.float32) * s
    sd = D_MODEL ** -0.5
    x = n(ks[0], (BATCH, SEQ, D_MODEL), 1.0)
    meta = n(ks[1], (N_META, D_MODEL), 1.0)
    lb_logits = n(ks[2], (DEPTH + 1, HG_HEADS * HG_DK), 0.1)
    l0_w_in = jnp.concatenate([
        n(ks[3], (D_MODEL, D_INNER), sd),
        n(ks[4], (D_MODEL, D_INNER), sd),
        n(ks[5], (D_MODEL, D_INNER), sd * BETA),
        n(ks[6], (D_MODEL, D_INNER), sd),
    ], axis=1)
    l0_b_f = n(ks[7], (D_INNER,), 0.01)
    l0_norm_g = 1.0 + n(ks[8], (D_INNER,), 0.01)
    l0_w_out = n(ks[9], (D_INNER, D_MODEL), D_INNER ** -0.5 * BETA)
    l0_ln_g = 1.0 + n(ks[10], (D_MODEL,), 0.01)
    l0_ln_b = n(ks[11], (D_MODEL,), 0.01)
    l1_w_in = jnp.concatenate([
        n(ks[12], (D_MODEL, GLA_KW), sd),
        n(ks[13], (D_MODEL, GLA_KW), sd),
        n(ks[14], (D_MODEL, D_INNER), sd * BETA),
        n(ks[15], (D_MODEL, D_INNER), sd),
    ], axis=1)
    l1_w_g1 = n(ks[16], (D_MODEL, GLA_RANK), sd)
    l1_w_g2 = n(ks[17], (GLA_RANK, GLA_KW), GLA_RANK ** -0.5)
    l1_b_g = n(ks[18], (GLA_KW,), 0.01)
    l1_norm_g = 1.0 + n(ks[19], (D_INNER,), 0.01)
    l1_w_out = n(ks[20], (D_INNER, D_MODEL), D_INNER ** -0.5 * BETA)
    l1_ln_g = 1.0 + n(ks[21], (D_MODEL,), 0.01)
    l1_ln_b = n(ks[22], (D_MODEL,), 0.01)
    return {'x': x, 'meta': meta, 'lb_logits': lb_logits,
            'l0_w_in': l0_w_in, 'l0_b_f': l0_b_f, 'l0_norm_g': l0_norm_g, 'l0_w_out': l0_w_out,
            'l0_ln_g': l0_ln_g, 'l0_ln_b': l0_ln_b,
            'l1_w_in': l1_w_in, 'l1_w_g1': l1_w_g1, 'l1_w_g2': l1_w_g2, 'l1_b_g': l1_b_g,
            'l1_norm_g': l1_norm_g, 'l1_w_out': l1_w_out, 'l1_ln_g': l1_ln_g, 'l1_ln_b': l1_ln_b}


def reference(x, meta, lb_logits,
              l0_w_in, l0_b_f, l0_norm_g, l0_w_out, l0_ln_g, l0_ln_b,
              l1_w_in, l1_w_g1, l1_w_g2, l1_b_g, l1_norm_g, l1_w_out, l1_ln_g, l1_ln_b):
    B = x.shape[0]
    lb_all = jnp.cumsum(jax.nn.softmax(lb_logits.astype(jnp.float32), axis=0), axis=0)
    mixers = (
        lambda h, li: hgrn2_mixer(h, l0_w_in, l0_b_f, lb_all[li], l0_norm_g, l0_w_out),
        lambda h, li: gla_mixer(h, l1_w_in, l1_w_g1, l1_w_g2, l1_b_g, l1_norm_g, l1_w_out),
    )
    post_norms = ((l0_ln_g, l0_ln_b), (l1_ln_g, l1_ln_b))
    meta_b = jnp.broadcast_to(meta[None].astype(x.dtype), (B, N_META, D_MODEL))
    h = jnp.concatenate([meta_b, x], axis=1)
    for li in range(DEPTH):
        g, b = post_norms[li]
        h = layer_norm(ALPHA * h + mixers[li % N_MIXERS](h, li), g, b)
    return h[:, N_META:]
```

```cpp
#include <hip/hip_runtime.h>
#include <cstdio>
#include <cstdint>
#define MK_N_LAUNCHES 10
namespace pg8 {
#define PG8_LAS __attribute__((address_space(3)))
typedef unsigned short bf16_t;
typedef short bf16x8 __attribute__((ext_vector_type(8)));
typedef float f32x4 __attribute__((ext_vector_type(4)));
typedef unsigned u32x4 __attribute__((ext_vector_type(4)));
constexpr int BM = 256, BK = 64, HALF = 128, HTB = HALF * BK * 2  , STAGE_BYTES = 8 * HTB, NXCD = 8, WGM = 8;

__host__ __device__ __forceinline__ int lds_byte(int r, int c) { const int st = (r >> 4) * 2 + (c >> 5), rr = r & 15, cc = c & 31, ob = rr * 64 + cc * 2; return st * 1024 + (ob ^ (((ob >> 9) & 1) << 5)); }
__host__ __device__ __forceinline__ void stage_rc(int b, int& R, int& C) { const int st = b / 1024, sb = b % 1024, swz = sb ^ (((sb >> 9) & 1) << 5); R = (st >> 1) * 16 + swz / 64; C = (st & 1) * 32 + (swz % 64) / 2; }
__host__ __device__ __forceinline__ int perm32(int rho) { const int n = rho >> 4, i = rho & 15; return 8 * (i >> 2) + 4 * n + (i & 3); }

struct Unit { int pm, pn; };
struct Gemm { const bf16_t* A; const bf16_t* Bt; int M, N, K; };

struct StaticOrder {
    int nM, nN, nwg, G, c;
    __host__ __device__ void init(int M, int N, int G_, int c_) { nM = M / BM; nN = N / BM; nwg = nM * nN; G = G_; c = c_; }
    __host__ __device__ bool next(int i, Unit& u) const {
        const long L = (long)i * G + c; if (L >= nwg) return false;
        int wgid = (int)L; { const int q = nwg / NXCD, r = nwg % NXCD, xcd = wgid % NXCD, off = wgid / NXCD; wgid = (xcd < r ? xcd * (q + 1) : r * (q + 1) + (xcd - r) * q) + off; }
        const int nig = WGM * nN, gid = wgid / nig, fm = gid * WGM, gsz = (nM - fm) < WGM ? (nM - fm) : WGM;
        u.pm = fm + ((wgid % nig) % gsz); u.pn = (wgid % nig) / gsz; return true;
    }
    __device__ __forceinline__ void a_ready(const Unit&) const {}
    __device__ __forceinline__ void done(const Unit&) const {}
};

__device__ __forceinline__ unsigned cvt_pk_bf16(float lo, float hi) { unsigned r; asm volatile("v_cvt_pk_bf16_f32 %0, %1, %2" : "=v"(r) : "v"(lo), "v"(hi)); return r; }
typedef float f32x2 __attribute__((ext_vector_type(2)));
__device__ __forceinline__ f32x2 gelu_pk(f32x2 v) {
    const f32x2 av = __builtin_elementwise_abs(v), d = av * 0.2316418882f + 1.0f;
    f32x2 t; t.x = __builtin_amdgcn_rcpf(d.x); t.y = __builtin_amdgcn_rcpf(d.y);
    f32x2 q = t * 0.5307027145f + (-0.7265760135f); q = q * t + 0.7107068705f; q = q * t + (-0.142248368f); q = q * t + 0.127414796f; q = q * t;
    const f32x2 s = (v * v) * (-0.72134752044f);
    f32x2 e; e.x = __builtin_amdgcn_exp2f(s.x); e.y = __builtin_amdgcn_exp2f(s.y);
    const f32x2 m = v * (q * e), r = v - m;
    f32x2 o; o.x = v.x < 0.f ? m.x : r.x; o.y = v.y < 0.f ? m.y : r.y; return o;
}

template <int ACT  > struct EpiBf16 {
    static constexpr bool PERM = true, AFTER_DRAIN = false; static_assert(ACT == 0 || ACT == 1, "EpiBf16: ACT is 0 (none) or 1 (gelu_pk)");
    bf16_t* O; int ldc; const float* bias; int split_cols; size_t split_stride; float scale0;
    __device__ __forceinline__ void operator()(const f32x4 (&acc)[2][2][4][2], const Unit& u, int wr, int wc, int fr, int fq) const {
        const int row0 = u.pm * BM + wr * 64 + fr; int colt = u.pn * BM; bf16_t* base = O;
        float sc = 1.f; if (split_cols) { const int t = colt / split_cols; base += (size_t)t * split_stride; colt -= t * split_cols; if (t == 0) sc = scale0; }
        const int col0 = colt + wc * 32 + 8 * fq, bcol0 = u.pn * BM + wc * 32 + 8 * fq;
        f32x4 bv[2][2];
#pragma unroll
        for (int bj = 0; bj < 2; ++bj)
#pragma unroll
            for (int n = 0; n < 2; ++n) bv[bj][n] = bias ? *(const f32x4*)(bias + bcol0 + bj * HALF + 4 * n) : (f32x4){0.f, 0.f, 0.f, 0.f};
#pragma unroll
        for (int ai = 0; ai < 2; ++ai)
#pragma unroll
            for (int m = 0; m < 4; ++m) { bf16_t* rowp = base + (size_t)(row0 + ai * HALF + m * 16) * ldc + col0;
#pragma unroll
                for (int bj = 0; bj < 2; ++bj) { f32x4 v0 = acc[ai][bj][m][0] + bv[bj][0], v1 = acc[ai][bj][m][1] + bv[bj][1];
                    if (ACT == 1) { f32x2 a = gelu_pk((f32x2){v0[0], v0[1]}), b = gelu_pk((f32x2){v0[2], v0[3]}), c = gelu_pk((f32x2){v1[0], v1[1]}), d = gelu_pk((f32x2){v1[2], v1[3]});
                        v0 = (f32x4){a.x, a.y, b.x, b.y}; v1 = (f32x4){c.x, c.y, d.x, d.y}; }
                    v0 = v0 * sc; v1 = v1 * sc; u32x4 w; w.x = cvt_pk_bf16(v0[0], v0[1]); w.y = cvt_pk_bf16(v0[2], v0[3]); w.z = cvt_pk_bf16(v1[0], v1[1]); w.w = cvt_pk_bf16(v1[2], v1[3]);
                    *(u32x4*)(rowp + bj * HALF) = w; } }
    }
};
struct EpiResid {
    static constexpr bool PERM = false, AFTER_DRAIN = false;
    float* C; int ldc; const float* resA; const float* resB; int rowsA; int rowsValid; float alpha;
    __device__ __forceinline__ void operator()(const f32x4 (&acc)[2][2][4][2], const Unit& u, int wr, int wc, int fr, int fq) const {
        const int row0 = u.pm * BM + wr * 64 + fr, col0 = u.pn * BM + wc * 32 + 4 * fq;
#pragma unroll
        for (int ai = 0; ai < 2; ++ai)
#pragma unroll
            for (int m = 0; m < 4; ++m) { const int r = row0 + ai * HALF + m * 16;
                if (r < rowsValid) {
                    const float* rp = (r < rowsA) ? resA + (size_t)r * ldc + col0 : resB + (size_t)(r - rowsA) * ldc + col0;
                    float* cp = C + (size_t)r * ldc + col0;
#pragma unroll
                    for (int bj = 0; bj < 2; ++bj)
#pragma unroll
                        for (int n = 0; n < 2; ++n) { const f32x4 rv = *(const f32x4*)(rp + bj * HALF + n * 16); *(f32x4*)(cp + bj * HALF + n * 16) = rv * alpha + acc[ai][bj][m][n]; } }
                asm volatile("" ::: "memory"); }
    }
};


template <class Epi, class Sched, bool ALIGN_EPI = false, bool SP2 = false>
__device__ __forceinline__ void gemm_phase(PG8_LAS unsigned char* lds, const Gemm g, const Sched& S, const Epi& E) {
    const int tid = threadIdx.x, wid = __builtin_amdgcn_readfirstlane(tid >> 6), lane = tid & 63, wr = wid >> 2, wc = wid & 3, fr = lane & 15, fq = lane >> 4;
    const int K = g.K, nt = K / BK;
    unsigned voffA[2], voffB[2];
#pragma unroll
    for (int i = 0; i < 2; ++i) { int R, C; stage_rc(tid * 16 + i * 8192, R, C); const int Rb = Epi::PERM ? ((R & ~31) + perm32(R & 31)) : R;
        voffA[i] = (unsigned)(R * K + C) * 2u; voffB[i] = (unsigned)(Rb * K + C) * 2u; }
    const size_t kstep = (size_t)(BK * 2);
    const size_t hstep = (size_t)HALF * K * 2;
    const size_t tstep = 2 * hstep;
    const unsigned ldsw = (unsigned)wid * 1024u;
    const int aoff = lds_byte(wr * 64 + fr, fq * 8), boff = lds_byte(wc * 32 + fr, fq * 8);
#define PG8_SA(b, h) (((b) * 2 + (h)) * HTB)
#define PG8_SB(b, h) ((4 + (b) * 2 + (h)) * HTB)
#define PG8_STAGE(bufoff, gbase, voff) do { _Pragma("unroll") for (int _i = 0; _i < 2; ++_i) \
        __builtin_amdgcn_global_load_lds((const unsigned*)((const char*)(gbase) + (voff)[_i]), (PG8_LAS unsigned*)(lds + (bufoff) + ldsw + _i * 8192), 16, 0, 0); } while (0)
#define PG8_LDA(dst, b, h) do { _Pragma("unroll") for (int m = 0; m < 4; ++m) _Pragma("unroll") for (int k = 0; k < 2; ++k) dst[m][k] = *(const PG8_LAS bf16x8*)(lds + PG8_SA(b, h) + aoff + m * 2048 + k * 1024); } while (0)
#define PG8_LDB(dst, b, h) do { _Pragma("unroll") for (int n = 0; n < 2; ++n) _Pragma("unroll") for (int k = 0; k < 2; ++k) dst[n][k] = *(const PG8_LAS bf16x8*)(lds + PG8_SB(b, h) + boff + n * 2048 + k * 1024); } while (0)
#define PG8_MMA(ai, bj, At, Bt) do { __builtin_amdgcn_s_setprio(1); _Pragma("unroll") for (int m = 0; m < 4; ++m) _Pragma("unroll") for (int n = 0; n < 2; ++n) _Pragma("unroll") for (int k = 0; k < 2; ++k) \
        acc[ai][bj][m][n] = __builtin_amdgcn_mfma_f32_16x16x32_bf16(Bt[n][k], At[m][k], acc[ai][bj][m][n], 0, 0, 0); __builtin_amdgcn_s_setprio(0); } while (0)
#define PG8_WAIT_V(n) asm volatile("s_waitcnt vmcnt(" #n ")" ::: "memory")
#define PG8_WAIT_L(n) asm volatile("s_waitcnt lgkmcnt(" #n ")" ::: "memory")
#define PG8_BAR __builtin_amdgcn_s_barrier()
#define PG8_SCHED __builtin_amdgcn_sched_barrier(0)
    Unit cur, nxt; int ui = 0;
    if (!S.next(0, cur)) return;
    f32x4 acc[2][2][4][2];
#pragma unroll
    for (int a = 0; a < 2; ++a)
#pragma unroll
        for (int b = 0; b < 2; ++b)
#pragma unroll
            for (int m = 0; m < 4; ++m)
#pragma unroll
                for (int n = 0; n < 2; ++n) acc[a][b][m][n] = (f32x4){0.f, 0.f, 0.f, 0.f};
    bf16x8 At[4][2], B0[2][2], B1[2][2];
    const char* cA = (const char*)g.A + (size_t)cur.pm * tstep; const char* cB = (const char*)g.Bt + (size_t)cur.pn * tstep;
    S.a_ready(cur);
    if constexpr (SP2) {
        PG8_STAGE(PG8_SB(0, 0), cB, voffB); PG8_STAGE(PG8_SB(0, 1), cB + hstep, voffB); PG8_STAGE(PG8_SA(0, 0), cA, voffA); PG8_STAGE(PG8_SA(0, 1), cA + hstep, voffA);
        if (wr == 1) PG8_BAR;
        PG8_WAIT_V(2); PG8_BAR;
        PG8_STAGE(PG8_SB(1, 0), cB + kstep, voffB); PG8_STAGE(PG8_SA(1, 0), cA + kstep, voffA); PG8_STAGE(PG8_SB(1, 1), cB + hstep + kstep, voffB);
        PG8_WAIT_V(6); PG8_BAR;
    } else {
        PG8_STAGE(PG8_SB(0, 0), cB, voffB); PG8_STAGE(PG8_SA(0, 0), cA, voffA); PG8_STAGE(PG8_SB(0, 1), cB + hstep, voffB); PG8_STAGE(PG8_SA(0, 1), cA + hstep, voffA);
        if (wr == 1) PG8_BAR;
        PG8_WAIT_V(4); PG8_BAR;
        PG8_STAGE(PG8_SB(1, 0), cB + kstep, voffB); PG8_STAGE(PG8_SA(1, 0), cA + kstep, voffA); PG8_STAGE(PG8_SB(1, 1), cB + hstep + kstep, voffB);
        PG8_WAIT_V(6); PG8_BAR;
    }
    for (;;) {
        const bool has_next = S.next(ui + 1, nxt);
        const char* nA = has_next ? (const char*)g.A + (size_t)nxt.pm * tstep : cA; const char* nB = has_next ? (const char*)g.Bt + (size_t)nxt.pn * tstep : cB;
        for (int t = 0; t < nt; t += 2) {
            const bool last = (t == nt - 2);
            const char* a1 = cA + (size_t)(t + 1) * kstep;
            const char* a2 = last ? nA : cA + (size_t)(t + 2) * kstep; const char* b2 = last ? nB : cB + (size_t)(t + 2) * kstep;
            const char* a3 = a2 + kstep; const char* b3 = b2 + kstep;
            if (last && has_next) S.a_ready(nxt);
            if constexpr (SP2) {
            PG8_LDB(B0, 0, 0); PG8_LDB(B1, 0, 1); PG8_SCHED; PG8_LDA(At, 0, 0); PG8_STAGE(PG8_SA(1, 1), a1 + hstep, voffA);
            PG8_WAIT_V(8); PG8_WAIT_L(0); PG8_BAR; PG8_MMA(0, 0, At, B0); PG8_MMA(0, 1, At, B1); PG8_BAR; PG8_SCHED;
            PG8_LDA(At, 0, 1); PG8_STAGE(PG8_SB(0, 0), b2, voffB); PG8_STAGE(PG8_SB(0, 1), b2 + hstep, voffB); PG8_STAGE(PG8_SA(0, 0), a2, voffA);
            PG8_WAIT_V(8); PG8_WAIT_L(0); PG8_BAR; PG8_MMA(1, 0, At, B0); PG8_MMA(1, 1, At, B1); PG8_BAR; PG8_SCHED;
            PG8_LDB(B0, 1, 0); PG8_LDB(B1, 1, 1); PG8_SCHED; PG8_LDA(At, 1, 0); PG8_STAGE(PG8_SA(0, 1), a2 + hstep, voffA);
            PG8_WAIT_V(8); PG8_WAIT_L(0); PG8_BAR; PG8_MMA(0, 0, At, B0); PG8_MMA(0, 1, At, B1); PG8_BAR; PG8_SCHED;
            PG8_LDA(At, 1, 1); PG8_STAGE(PG8_SB(1, 0), b3, voffB); PG8_STAGE(PG8_SB(1, 1), b3 + hstep, voffB); PG8_STAGE(PG8_SA(1, 0), a3, voffA);
            PG8_WAIT_V(8); PG8_WAIT_L(0); PG8_BAR; PG8_MMA(1, 0, At, B0); PG8_MMA(1, 1, At, B1); PG8_BAR; PG8_SCHED;
            } else {
            PG8_LDB(B0, 0, 0); PG8_SCHED; PG8_LDA(At, 0, 0); PG8_STAGE(PG8_SA(1, 1), a1 + hstep, voffA);
            PG8_WAIT_L(8); PG8_BAR; PG8_WAIT_L(0); PG8_MMA(0, 0, At, B0); PG8_BAR; PG8_SCHED;
            PG8_LDB(B1, 0, 1); PG8_STAGE(PG8_SB(0, 0), b2, voffB);
            PG8_BAR; PG8_WAIT_L(0); PG8_MMA(0, 1, At, B1); PG8_BAR;
            PG8_LDA(At, 0, 1); PG8_STAGE(PG8_SA(0, 0), a2, voffA);
            PG8_BAR; PG8_WAIT_L(0); PG8_MMA(1, 0, At, B0); PG8_BAR; PG8_SCHED;
            PG8_STAGE(PG8_SB(0, 1), b2 + hstep, voffB);
            PG8_WAIT_V(6); PG8_BAR; PG8_MMA(1, 1, At, B1); PG8_BAR;
            PG8_LDB(B0, 1, 0); PG8_SCHED; PG8_LDA(At, 1, 0); PG8_STAGE(PG8_SA(0, 1), a2 + hstep, voffA);
            PG8_WAIT_L(8); PG8_BAR; PG8_WAIT_L(0); PG8_MMA(0, 0, At, B0); PG8_BAR; PG8_SCHED;
            PG8_LDB(B1, 1, 1); PG8_STAGE(PG8_SB(1, 0), b3, voffB);
            PG8_BAR; PG8_WAIT_L(0); PG8_MMA(0, 1, At, B1); PG8_BAR;
            PG8_LDA(At, 1, 1); PG8_STAGE(PG8_SA(1, 0), a3, voffA);
            PG8_BAR; PG8_WAIT_L(0); PG8_MMA(1, 0, At, B0); PG8_BAR; PG8_SCHED;
            PG8_STAGE(PG8_SB(1, 1), b3 + hstep, voffB);
            PG8_WAIT_V(6); PG8_BAR; PG8_MMA(1, 1, At, B1); PG8_BAR;
            }
        }
        if constexpr (ALIGN_EPI) { if (wr == 0) PG8_BAR; }
        if constexpr (!Epi::AFTER_DRAIN) { E(acc, cur, wr, wc, fr, fq); S.done(cur); }
        if (!has_next) break;
#pragma unroll
        for (int a = 0; a < 2; ++a)
#pragma unroll
            for (int b = 0; b < 2; ++b)
#pragma unroll
                for (int m = 0; m < 4; ++m)
#pragma unroll
                    for (int n = 0; n < 2; ++n) acc[a][b][m][n] = (f32x4){0.f, 0.f, 0.f, 0.f};
        cur = nxt; cA = nA; cB = nB; ++ui;
        if constexpr (ALIGN_EPI) { if (wr == 1) PG8_BAR; }
    }
    PG8_WAIT_V(0);
    if constexpr (!ALIGN_EPI) { if (wr == 0) PG8_BAR; }
    PG8_BAR;
    if constexpr (Epi::AFTER_DRAIN) { E.fused(acc, cur, wr, wc, fr, fq, lds, wid, lane); S.done(cur); }
#undef PG8_SA
#undef PG8_SB
#undef PG8_STAGE
#undef PG8_LDA
#undef PG8_LDB
#undef PG8_MMA
#undef PG8_WAIT_V
#undef PG8_WAIT_L
#undef PG8_BAR
#undef PG8_SCHED
}
}
#ifndef PG8_SP2
#define PG8_SP2 true
#endif
#ifndef PG8_ALIGN
#define PG8_ALIGN true
#endif

constexpr int NWAVES = 8;
constexpr int PER_PHASE = 10;
#ifndef MK_N_LAUNCHES
#define MK_N_LAUNCHES 1
#endif
constexpr int N_LAUNCHES = MK_N_LAUNCHES;

constexpr int D = 4096, NB = 4, SEQ = 2048, NMETA = 16, DI = 8192;
constexpr int MX = NB * SEQ;
constexpr int MR = MX + NMETA;
constexpr int MP = 8448;
constexpr int N0 = 4 * DI;
constexpr int N1 = 2 * 4096 + 2 * DI;
constexpr int HG_H = 64, HG_DK = 128;
constexpr int GL_H = 8, GL_DK = 512, GL_DV = 1024, GL_R = 16;
constexpr float LN_EPS = 1e-5f, RMS_EPS = 1e-6f;
constexpr float ALPHA = 1.41421356237309515f;

constexpr size_t MiB = 1u << 20;
constexpr size_t WS_CTL = 0, CTL_ZERO_BYTES = 1 * MiB;
constexpr size_t WS_LB0 = 1 * MiB;
constexpr size_t WS_G1 = 2 * MiB;
constexpr size_t WS_WT0IN = 4 * MiB;
constexpr size_t WS_WT0OUT = WS_WT0IN + 256 * MiB;
constexpr size_t WS_WT1IN = WS_WT0OUT + 64 * MiB;
constexpr size_t WS_WT1OUT = WS_WT1IN + 192 * MiB;
constexpr size_t WS_XB = WS_WT1OUT + 64 * MiB;
constexpr size_t WS_H1B = WS_XB + 66 * MiB;
constexpr size_t WS_QFIZ = WS_H1B + 66 * MiB;
constexpr size_t WS_Y = WS_QFIZ + 528 * MiB;
constexpr size_t WS_PRE = WS_Y + 132 * MiB;
constexpr size_t WS_O1 = WS_PRE + 132 * MiB;
constexpr size_t WS_END = WS_O1 + 257 * MiB;
static_assert((size_t)MP * D * 2 <= 66 * MiB && (size_t)MP * N0 * 2 <= 528 * MiB && (size_t)MP * DI * 2 <= 132 * MiB && (size_t)MP * D * 4 <= 132 * MiB && (size_t)MR * DI * 4 <= 257 * MiB, "d_ws map");
constexpr int CW_BAR = 4096;

constexpr int RING_OFF = 0, RING_BYTES = 131072;
constexpr int LDSCTL_OFF = RING_BYTES, MISC_OFF = LDSCTL_OFF + 320;
constexpr int LDS_BYTES = 147456;
static_assert(MISC_OFF + 128 <= LDS_BYTES, "LDS map");

#define GAS __attribute__((address_space(1)))
#define LAS __attribute__((address_space(3)))
typedef unsigned short bf16;
typedef unsigned v4u __attribute__((ext_vector_type(4)));
typedef unsigned v2u __attribute__((ext_vector_type(2)));
typedef float f32x4 __attribute__((ext_vector_type(4)));
typedef GAS unsigned gu32;
#define RLX_AGENT __ATOMIC_RELAXED, __HIP_MEMORY_SCOPE_AGENT
#define LDS_WAIT() asm volatile("s_waitcnt lgkmcnt(0)" ::: "memory")
#define DI_ __device__ __forceinline__
DI_ unsigned f2bf(float f) { unsigned u = __builtin_bit_cast(unsigned, f); return (u + 0x7fffu + ((u >> 16) & 1u)) >> 16; }
DI_ unsigned pk2(float lo, float hi) { return f2bf(lo) | (f2bf(hi) << 16); }
DI_ float bflo(unsigned w) { return __builtin_bit_cast(float, w << 16); }
DI_ float bfhi(unsigned w) { return __builtin_bit_cast(float, w & 0xffff0000u); }
DI_ float bf2f(bf16 b) { return __builtin_bit_cast(float, (unsigned)b << 16); }
DI_ float sigm(float x) { return 1.f / (1.f + __expf(-x)); }
DI_ float silu(float x) { return x / (1.f + __expf(-x)); }

#define XB_TMO      128
#define XB_XCNT(j)  (256  + 64 * (j))
#define XB_XSUB(j)  (1280 + 64 * (j))
#define XB_XGEN(j)  (2304 + 64 * (j))
#define XB_TOP      3328
#define XB_TOPGEN   3392
#define XCD_BAR_WORDS 3456
#define XB_SPIN_CAP (1u << 18)

__device__ __forceinline__ unsigned xb_ld(unsigned* p)              { return __hip_atomic_load(p, __ATOMIC_RELAXED, __HIP_MEMORY_SCOPE_AGENT); }
__device__ __forceinline__ unsigned xb_add(unsigned* p, unsigned v) { return __hip_atomic_fetch_add(p, v, __ATOMIC_RELAXED, __HIP_MEMORY_SCOPE_AGENT); }
__device__ __forceinline__ unsigned xb_xcc_id() { return (unsigned)__builtin_amdgcn_s_getreg((3 << 11) | 20) & 0xFu; }
#define XB_SPIN(cond, bar) do { unsigned _sp = 0; while (cond) { __builtin_amdgcn_s_sleep(1); \
    if ((++_sp & 255u) == 0u) { if (xb_ld(&(bar)[XB_TMO])) break; if (_sp > XB_SPIN_CAP) { atomicAdd(&(bar)[XB_TMO], 1u); break; } } } } while (0)

struct XcdBarrier {
    unsigned* bar; unsigned x;
    volatile LAS unsigned* st;
};
__device__ __forceinline__ XcdBarrier xcd_barrier_post(unsigned* bar, volatile LAS unsigned* st) {
    XcdBarrier b; b.bar = bar; b.x = xb_xcc_id(); b.st = st;
    if (threadIdx.x == 0) (void)xb_add(&bar[XB_XCNT(b.x)], 1u);
    return b;
}
__device__ __forceinline__ void xcd_barrier_complete(unsigned* bar, unsigned x, unsigned& nloc, unsigned& nx) {
    const unsigned G = gridDim.x * gridDim.y * gridDim.z;
    unsigned sum, cnt, mine, sp = 0u;
    for (;;) {
        sum = 0u; cnt = 0u; mine = 0u;
#pragma unroll
        for (unsigned j = 0; j < 16; ++j) { const unsigned c = xb_ld(&bar[XB_XCNT(j)]); sum += c; cnt += (c > 0u) ? 1u : 0u; mine = (j == x) ? c : mine; }
        if (sum == G) break;
        __builtin_amdgcn_s_sleep(1);
        if ((++sp & 255u) == 0u) { if (xb_ld(&bar[XB_TMO])) break; if (sp > XB_SPIN_CAP) { atomicAdd(&bar[XB_TMO], 1u); break; } }
    }
    nloc = mine > 0u ? mine : 1u; nx = cnt > 0u ? cnt : 1u;
}
__device__ __forceinline__ void xcd_barrier(const XcdBarrier& b) {
    asm volatile("s_waitcnt vmcnt(0)" ::: "memory");
    __syncthreads();
    if (threadIdx.x == 0) {
        unsigned* bar = b.bar;
        __builtin_amdgcn_s_waitcnt(0);
        unsigned nloc = b.st[0], nx = b.st[1];
        if (nloc == 0u) { xcd_barrier_complete(bar, b.x, nloc, nx); b.st[0] = nloc; b.st[1] = nx; }
        const unsigned old = xb_add(&bar[XB_XSUB(b.x)], 1u);
        const unsigned gen = old / nloc;
        if (old + 1u == (gen + 1u) * nloc) {
            __builtin_amdgcn_fence(__ATOMIC_RELEASE, "agent");
            asm volatile("s_waitcnt vmcnt(0)" ::: "memory");
            const unsigned og = xb_add(&bar[XB_TOP], 1u);
            const unsigned tg = og / nx;
            if (og + 1u == (tg + 1u) * nx) xb_add(&bar[XB_TOPGEN], 1u);
            else XB_SPIN(xb_ld(&bar[XB_TOPGEN]) == tg, bar);
            __builtin_amdgcn_fence(__ATOMIC_ACQUIRE, "agent");
            xb_add(&bar[XB_XGEN(b.x)], 1u);
            asm volatile("s_waitcnt vmcnt(0)" ::: "memory");
        } else {
            XB_SPIN(xb_ld(&bar[XB_XGEN(b.x)]) == gen, bar);
            __builtin_amdgcn_fence(__ATOMIC_ACQUIRE, "agent");
            asm volatile("s_waitcnt vmcnt(0)" ::: "memory");
        }
    }
    __syncthreads();
}

struct Frame {
    LAS unsigned char* lds;
    volatile LAS unsigned* MISC;
    gu32* ctl;
    int tid, lane, wave;
    int vcu, G;
    const float *x, *meta, *lb_logits;
    const float *w0in, *b_f, *ng0, *w0out, *ln0g, *ln0b;
    const float *w1in, *wg1, *wg2, *b_g, *ng1, *w1out, *ln1g, *ln1b;
    float* out;
    float *LB0, *G1, *PRE, *O1;
    bf16 *WT0IN, *WT0OUT, *WT1IN, *WT1OUT, *XB, *H1B, *QFIZ, *Y;
};

DI_ float wave_sum(float v) {
#pragma unroll
    for (int o = 1; o < 64; o <<= 1) v += __shfl_xor(v, o);
    return v;
}

DI_ void p0_transpose_item(const float* W, int K, int N, bf16* WT, LAS float* scr, int item, int lane) {
    const int nblk = N / 32, kb = item / nblk, nb = item % nblk, k0 = 64 * kb, n0 = 32 * nb;
#pragma unroll 8
    for (int i = 0; i < 32; ++i) { const int kk = 2 * i + (lane >> 5); scr[kk * 33 + (lane & 31)] = W[(size_t)(k0 + kk) * N + n0 + (lane & 31)]; }
    LDS_WAIT(); asm volatile("" ::: "memory");
    const int c = lane & 7;
#pragma unroll
    for (int j = 0; j < 4; ++j) { const int n = (lane >> 3) + 8 * j; const LAS float* s = scr + (8 * c) * 33 + n;
        v4u o; o.x = pk2(s[0 * 33], s[1 * 33]); o.y = pk2(s[2 * 33], s[3 * 33]); o.z = pk2(s[4 * 33], s[5 * 33]); o.w = pk2(s[6 * 33], s[7 * 33]);
        *(GAS v4u*)(WT + (size_t)(n0 + n) * K + k0 + 8 * c) = o; }
    LDS_WAIT(); asm volatile("" ::: "memory");
}

DI_ void p0_prologue(Frame& F) {
    LAS float* scr = (LAS float*)(F.lds + RING_OFF + F.wave * 16384);
    const int gw = F.vcu * NWAVES + F.wave, NGW = F.G * NWAVES;
    constexpr int I_0 = (D / 64) * (N0 / 32), I_1 = (DI / 64) * (D / 32), I_2 = (D / 64) * (N1 / 32), I_3 = I_1;
    constexpr int NITEMS = I_0 + I_1 + I_2 + I_3;
    for (int it = gw; it < NITEMS; it += NGW) {
        int r = it;
        if (r < I_0) { p0_transpose_item(F.w0in, D, N0, F.WT0IN, scr, r, F.lane); continue; } r -= I_0;
        if (r < I_1) { p0_transpose_item(F.w0out, DI, D, F.WT0OUT, scr, r, F.lane); continue; } r -= I_1;
        if (r < I_2) { p0_transpose_item(F.w1in, D, N1, F.WT1IN, scr, r, F.lane); continue; } r -= I_2;
        p0_transpose_item(F.w1out, DI, D, F.WT1OUT, scr, r, F.lane);
    }
    for (int m = gw; m < MP; m += NGW) {
        GAS unsigned long long* o8 = (GAS unsigned long long*)(F.XB + (size_t)m * D) + F.lane;
        if (m < MR) {
            const float* src = (m < MX) ? F.x + (size_t)m * D : F.meta + (size_t)(m - MX) * D;
            const GAS f32x4* xr = (const GAS f32x4*)src + F.lane;
#pragma unroll 4
            for (int j = 0; j < 16; ++j) { const f32x4 v = xr[64 * j]; o8[64 * j] = (unsigned long long)pk2(v.x, v.y) | ((unsigned long long)pk2(v.z, v.w) << 32); }
        } else {
#pragma unroll 4
            for (int j = 0; j < 16; ++j) o8[64 * j] = 0ull;
        }
    }
    for (int m = MR + gw; m < MP; m += NGW) {
        GAS unsigned long long* o8 = (GAS unsigned long long*)(F.H1B + (size_t)m * D) + F.lane;
#pragma unroll 4
        for (int j = 0; j < 16; ++j) o8[64 * j] = 0ull;
    }
    for (int c = gw * 64 + F.lane; c < DI; c += NGW * 64) {
        const float l0 = F.lb_logits[c], l1 = F.lb_logits[DI + c], l2 = F.lb_logits[2 * DI + c];
        const float mx = fmaxf(l0, fmaxf(l1, l2));
        const float e0 = __expf(l0 - mx), e1 = __expf(l1 - mx), e2 = __expf(l2 - mx);
        F.LB0[c] = e0 / (e0 + e1 + e2);
    }
}

DI_ void p2_l0_rec_naive(Frame& F) {
    LAS float* qs = (LAS float*)(F.lds);
    LAS float* fs = qs + 2048;
    LAS float* ks = fs + 2048;
    LAS float* vs = ks + 2048;
    LAS float* pb = vs + 2048;
    const int tid = F.tid, dv = tid & 127, kg = tid >> 7;
    const int lj = tid >> 5, lc = (tid & 31) * 4;
    for (int u = blockIdx.x; u < NB * HG_H; u += F.G) {
        const int b = u >> 6, h = u & 63;
        float S[32];
#pragma unroll
        for (int i = 0; i < 32; ++i) S[i] = 0.f;
        float lbv[4], bfv[4], ngv[4];
#pragma unroll
        for (int i = 0; i < 4; ++i) { lbv[i] = F.LB0[h * 128 + lc + i]; bfv[i] = F.b_f[h * 128 + lc + i]; ngv[i] = F.ng0[h * 128 + lc + i]; }
        for (int tb = 0; tb < 129; ++tb) {
            const int rbase = (tb == 0) ? MX : b * SEQ + 16 * (tb - 1);
            const bf16* row = F.QFIZ + (size_t)(rbase + lj) * N0 + h * 128 + lc;
            {
                const v2u q4 = *(const GAS v2u*)(row), f4 = *(const GAS v2u*)(row + DI), i4 = *(const GAS v2u*)(row + 2 * DI);
                const float qv[4] = {bflo(q4.x), bfhi(q4.x), bflo(q4.y), bfhi(q4.y)};
                const float fv[4] = {bflo(f4.x), bfhi(f4.x), bflo(f4.y), bfhi(f4.y)};
                const float iv[4] = {bflo(i4.x), bfhi(i4.x), bflo(i4.y), bfhi(i4.y)};
#pragma unroll
                for (int i = 0; i < 4; ++i) {
                    const float fg = lbv[i] + (1.f - lbv[i]) * sigm(fv[i] + bfv[i]);
                    qs[lj * 128 + lc + i] = silu(qv[i]); fs[lj * 128 + lc + i] = fg; ks[lj * 128 + lc + i] = 1.f - fg; vs[lj * 128 + lc + i] = iv[i];
                }
            }
            __syncthreads();
            for (int j = 0; j < 16; ++j) {
                const float vj = vs[j * 128 + dv]; float po = 0.f;
#pragma unroll
                for (int i = 0; i < 32; i += 4) {
                    const f32x4 f4 = *(const LAS f32x4*)(fs + j * 128 + kg * 32 + i), k4 = *(const LAS f32x4*)(ks + j * 128 + kg * 32 + i), q4 = *(const LAS f32x4*)(qs + j * 128 + kg * 32 + i);
                    S[i + 0] = f4.x * S[i + 0] + k4.x * vj; po += q4.x * S[i + 0];
                    S[i + 1] = f4.y * S[i + 1] + k4.y * vj; po += q4.y * S[i + 1];
                    S[i + 2] = f4.z * S[i + 2] + k4.z * vj; po += q4.z * S[i + 2];
                    S[i + 3] = f4.w * S[i + 3] + k4.w * vj; po += q4.w * S[i + 3];
                }
                pb[(j * 4 + kg) * 128 + dv] = po;
            }
            __syncthreads();
            {
                f32x4 o = *(const LAS f32x4*)(pb + (lj * 4 + 0) * 128 + lc);
                o += *(const LAS f32x4*)(pb + (lj * 4 + 1) * 128 + lc);
                o += *(const LAS f32x4*)(pb + (lj * 4 + 2) * 128 + lc);
                o += *(const LAS f32x4*)(pb + (lj * 4 + 3) * 128 + lc);
                float ss = o.x * o.x + o.y * o.y + o.z * o.z + o.w * o.w;
                ss += __shfl_xor(ss, 16); ss += __shfl_xor(ss, 8); ss += __shfl_xor(ss, 4); ss += __shfl_xor(ss, 2); ss += __shfl_xor(ss, 1);
                const float rs = rsqrtf(ss * (1.f / 128.f) + RMS_EPS);
                const v2u z4 = *(const GAS v2u*)(row + 3 * DI);
                const float y0 = o.x * rs * ngv[0] * silu(bflo(z4.x)), y1 = o.y * rs * ngv[1] * silu(bfhi(z4.x));
                const float y2 = o.z * rs * ngv[2] * silu(bflo(z4.y)), y3 = o.w * rs * ngv[3] * silu(bfhi(z4.y));
                if (tb > 0 || b == 0) { v2u w; w.x = pk2(y0, y1); w.y = pk2(y2, y3); *(GAS v2u*)(F.Y + (size_t)(rbase + lj) * DI + h * 128 + lc) = w; }
            }
        }
        __syncthreads();
    }
}

DI_ void ln_phase(Frame& F, const float* src, int nrows, const float* g, const float* bt, float* dst32, bf16* dstb, float* G1) {
    const int gw = F.vcu * NWAVES + F.wave, NGW = F.G * NWAVES;
    for (int r = gw; r < nrows; r += NGW) {
        const GAS f32x4* s = (const GAS f32x4*)(src + (size_t)r * D) + F.lane;
        f32x4 v[16]; float sm = 0.f;
#pragma unroll
        for (int j = 0; j < 16; ++j) { v[j] = s[64 * j]; sm += (v[j].x + v[j].y) + (v[j].z + v[j].w); }
        const float mean = wave_sum(sm) * (1.f / D); float s2 = 0.f;
#pragma unroll
        for (int j = 0; j < 16; ++j) { v[j] = v[j] - mean; s2 += (v[j].x * v[j].x + v[j].y * v[j].y) + (v[j].z * v[j].z + v[j].w * v[j].w); }
        const float rstd = rsqrtf(wave_sum(s2) * (1.f / D) + LN_EPS);
#pragma unroll
        for (int j = 0; j < 16; ++j) {
            const f32x4 gg = *((const GAS f32x4*)g + F.lane + 64 * j), bb = *((const GAS f32x4*)bt + F.lane + 64 * j);
            v[j] = v[j] * rstd * gg + bb;
            if (dst32) *((GAS f32x4*)(dst32 + (size_t)r * D) + F.lane + 64 * j) = v[j];
            if (dstb) { v2u w; w.x = pk2(v[j].x, v[j].y); w.y = pk2(v[j].z, v[j].w); *((GAS v2u*)(dstb + (size_t)r * D) + F.lane + 64 * j) = w; }
            if ((j & 3) == 3) asm volatile("" ::: "memory");
        }
        if (G1) {
            LAS float* rowbuf = (LAS float*)(F.lds + RING_OFF + F.wave * 16384);
#pragma unroll
            for (int j = 0; j < 16; ++j) *(LAS f32x4*)(rowbuf + 256 * j + 4 * F.lane) = v[j];
            LDS_WAIT(); asm volatile("" ::: "memory");
            float a[16];
#pragma unroll
            for (int q = 0; q < 16; ++q) a[q] = 0.f;
#pragma unroll 2
            for (int i = 0; i < 64; ++i) {
                const int k = 64 * i + F.lane;
                const float e = rowbuf[k];
                const GAS f32x4* w = (const GAS f32x4*)(F.wg1 + (size_t)k * GL_R);
                const f32x4 w0 = w[0], w1 = w[1], w2 = w[2], w3 = w[3];
                a[0] += e * w0.x; a[1] += e * w0.y; a[2] += e * w0.z; a[3] += e * w0.w;
                a[4] += e * w1.x; a[5] += e * w1.y; a[6] += e * w1.z; a[7] += e * w1.w;
                a[8] += e * w2.x; a[9] += e * w2.y; a[10] += e * w2.z; a[11] += e * w2.w;
                a[12] += e * w3.x; a[13] += e * w3.y; a[14] += e * w3.z; a[15] += e * w3.w;
            }
#pragma unroll
            for (int q = 0; q < 16; ++q) a[q] = wave_sum(a[q]);
            if (F.lane == 0) {
#pragma unroll
                for (int q = 0; q < 16; q += 4) *(GAS f32x4*)(G1 + (size_t)r * GL_R + q) = (f32x4){a[q], a[q + 1], a[q + 2], a[q + 3]};
            }
            LDS_WAIT(); asm volatile("" ::: "memory");
        }
    }
}

DI_ void p6_l1_rec_naive(Frame& F) {
    LAS float* qs = (LAS float*)(F.lds);
    LAS float* ks = qs + 4096;
    LAS float* gs = ks + 4096;
    LAS float* vs = gs + 4096;
    LAS float* pb = vs + 512;
    const int tid = F.tid, dv = tid & 63, kg = tid >> 6;
    const float qscale = 0.04419417382415922f;
    for (int u = blockIdx.x; u < NB * GL_H * 16; u += F.G) {
        const int dvs = u & 15, bh = u >> 4, b = bh >> 3, h = bh & 7;
        float S[64];
#pragma unroll
        for (int i = 0; i < 64; ++i) S[i] = 0.f;
        float w2[16];
#pragma unroll
        for (int r = 0; r < 16; ++r) w2[r] = F.wg2[(size_t)r * 4096 + h * 512 + tid];
        const float bg = F.b_g[h * 512 + tid];
        for (int tb = 0; tb < 258; ++tb) {
            const int rbase = (tb < 2) ? MX + 8 * tb : b * SEQ + 8 * (tb - 2);
            for (int j = 0; j < 8; ++j) {
                const size_t r = (size_t)(rbase + j);
                const float q = bf2f(F.QFIZ[r * N1 + h * 512 + tid]) * qscale, k = bf2f(F.QFIZ[r * N1 + 4096 + h * 512 + tid]);
                const float* g1 = F.G1 + r * GL_R;
                float xg = bg;
#pragma unroll
                for (int rr = 0; rr < 16; ++rr) xg += g1[rr] * w2[rr];
                const float ls = fminf(xg, 0.f) - log1pf(__expf(-fabsf(xg)));
                qs[j * 512 + tid] = q; ks[j * 512 + tid] = k; gs[j * 512 + tid] = __expf(ls * (1.f / 16.f));
            }
            vs[tid] = bf2f(F.QFIZ[(size_t)(rbase + (tid >> 6)) * N1 + 8192 + h * 1024 + dvs * 64 + (tid & 63)]);
            __syncthreads();
            for (int j = 0; j < 8; ++j) {
                const float vj = vs[j * 64 + dv]; float po = 0.f;
#pragma unroll
                for (int i = 0; i < 64; i += 4) {
                    const f32x4 g4 = *(const LAS f32x4*)(gs + j * 512 + kg * 64 + i), k4 = *(const LAS f32x4*)(ks + j * 512 + kg * 64 + i), q4 = *(const LAS f32x4*)(qs + j * 512 + kg * 64 + i);
                    S[i + 0] = g4.x * S[i + 0] + k4.x * vj; po += q4.x * S[i + 0];
                    S[i + 1] = g4.y * S[i + 1] + k4.y * vj; po += q4.y * S[i + 1];
                    S[i + 2] = g4.z * S[i + 2] + k4.z * vj; po += q4.z * S[i + 2];
                    S[i + 3] = g4.w * S[i + 3] + k4.w * vj; po += q4.w * S[i + 3];
                    if ((i & 12) == 12) asm volatile("" ::: "memory");
                }
                pb[(j * 8 + kg) * 64 + dv] = po;
            }
            __syncthreads();
            {
                const int j = tid >> 6, d = tid & 63; float o = 0.f;
#pragma unroll
                for (int g = 0; g < 8; ++g) o += pb[(j * 8 + g) * 64 + d];
                if (tb >= 2 || b == 0) F.O1[(size_t)(rbase + j) * DI + h * 1024 + dvs * 64 + d] = o;
            }
        }
        __syncthreads();
    }
}

DI_ void p7_normgate(Frame& F) {
    const int gw = F.vcu * NWAVES + F.wave, NGW = F.G * NWAVES;
    for (int it = gw; it < MX * GL_H; it += NGW) {
        const int r = it >> 3, h = it & 7;
        const GAS f32x4* o = (const GAS f32x4*)(F.O1 + (size_t)r * DI + h * 1024) + F.lane;
        f32x4 v[4]; float ss = 0.f;
#pragma unroll
        for (int j = 0; j < 4; ++j) { v[j] = o[64 * j]; ss += (v[j].x * v[j].x + v[j].y * v[j].y) + (v[j].z * v[j].z + v[j].w * v[j].w); }
        const float rs = rsqrtf(wave_sum(ss) * (1.f / 1024.f) + RMS_EPS);
#pragma unroll
        for (int j = 0; j < 4; ++j) {
            const int c = h * 1024 + 256 * j + 4 * F.lane;
            const v2u z4 = *(const GAS v2u*)(F.QFIZ + (size_t)r * N1 + 16384 + c);
            const f32x4 ng = *(const GAS f32x4*)(F.ng1 + c);
            v2u w; w.x = pk2(v[j].x * rs * ng.x * silu(bflo(z4.x)), v[j].y * rs * ng.y * silu(bfhi(z4.x)));
            w.y = pk2(v[j].z * rs * ng.z * silu(bflo(z4.y)), v[j].w * rs * ng.w * silu(bfhi(z4.y)));
            *(GAS v2u*)(F.Y + (size_t)r * DI + c) = w;
        }
    }
}

struct Args { const float* in[17]; float* out; unsigned char* ws; int ph_lo, ph_hi, li, pad; };
__global__ void __launch_bounds__(NWAVES * 64, 2) mk_fwd(Args args) {
    extern __shared__ __attribute__((aligned(16))) unsigned char lds[];
    Frame F;
    F.lds = (LAS unsigned char*)lds;
    F.MISC = (volatile LAS unsigned*)(F.lds + MISC_OFF);
    F.tid = threadIdx.x; F.lane = F.tid & 63; F.wave = __builtin_amdgcn_readfirstlane(F.tid >> 6);
    F.G = gridDim.x; { const int bx = blockIdx.x; F.vcu = (F.G % 8 == 0) ? (bx % 8) * (F.G / 8) + bx / 8 : bx; }
    unsigned char* ws = args.ws;
    F.ctl = (gu32*)(ws + WS_CTL);
    F.x = args.in[0]; F.meta = args.in[1]; F.lb_logits = args.in[2];
    F.w0in = args.in[3]; F.b_f = args.in[4]; F.ng0 = args.in[5]; F.w0out = args.in[6]; F.ln0g = args.in[7]; F.ln0b = args.in[8];
    F.w1in = args.in[9]; F.wg1 = args.in[10]; F.wg2 = args.in[11]; F.b_g = args.in[12]; F.ng1 = args.in[13]; F.w1out = args.in[14]; F.ln1g = args.in[15]; F.ln1b = args.in[16];
    F.out = args.out;
    F.LB0 = (float*)(ws + WS_LB0); F.G1 = (float*)(ws + WS_G1); F.PRE = (float*)(ws + WS_PRE); F.O1 = (float*)(ws + WS_O1);
    F.WT0IN = (bf16*)(ws + WS_WT0IN); F.WT0OUT = (bf16*)(ws + WS_WT0OUT); F.WT1IN = (bf16*)(ws + WS_WT1IN); F.WT1OUT = (bf16*)(ws + WS_WT1OUT);
    F.XB = (bf16*)(ws + WS_XB); F.H1B = (bf16*)(ws + WS_H1B); F.QFIZ = (bf16*)(ws + WS_QFIZ); F.Y = (bf16*)(ws + WS_Y);
    for (int u = F.tid; u < (LDS_BYTES - LDSCTL_OFF) / 4; u += NWAVES * 64) ((LAS unsigned*)(F.lds + LDSCTL_OFF))[u] = 0u;
    __syncthreads();
    XcdBarrier bar; bar.bar = (unsigned*)(F.ctl + CW_BAR); bar.x = 0; bar.st = nullptr;
    if (N_LAUNCHES == 1) bar = xcd_barrier_post((unsigned*)(F.ctl + CW_BAR), F.MISC + 8);
#define GRID_BAR() do { if (N_LAUNCHES == 1) xcd_barrier(bar); } while (0)
    const int lo = args.ph_lo, hi = args.ph_hi;
#define IN(k) (lo <= (k) && (k) < hi)
#define BOTH(k) (IN(k) && IN((k) + 1))

#ifndef SKIP_P0
    if (IN(0)) { p0_prologue(F); if (BOTH(0)) GRID_BAR(); }
#endif
#ifndef SKIP_P1
    if (IN(1)) {
        pg8::Gemm g{F.XB, F.WT0IN, MP, N0, D}; pg8::StaticOrder S; S.init(MP, N0, F.G, (int)blockIdx.x);
        pg8::EpiBf16<0> E{F.QFIZ, N0, nullptr, 0, 0, 1.f};
        pg8::gemm_phase<pg8::EpiBf16<0>, pg8::StaticOrder, PG8_ALIGN, PG8_SP2>(F.lds + RING_OFF, g, S, E);
        if (BOTH(1)) GRID_BAR();
    }
#endif
#ifndef SKIP_P2
    if (IN(2)) { p2_l0_rec_naive(F); if (BOTH(2)) GRID_BAR(); }
#endif
#ifndef SKIP_P3
    if (IN(3)) {
        pg8::Gemm g{F.Y, F.WT0OUT, MP, D, DI}; pg8::StaticOrder S; S.init(MP, D, F.G, (int)blockIdx.x);
        pg8::EpiResid E{F.PRE, D, F.x, F.meta, MX, MR, ALPHA};
        pg8::gemm_phase<pg8::EpiResid, pg8::StaticOrder, PG8_ALIGN, PG8_SP2>(F.lds + RING_OFF, g, S, E);
        if (BOTH(3)) GRID_BAR();
    }
#endif
#ifndef SKIP_P4
    if (IN(4)) { ln_phase(F, F.PRE, MR, F.ln0g, F.ln0b, F.PRE, F.H1B, F.G1); if (BOTH(4)) GRID_BAR(); }
#endif
#ifndef SKIP_P5
    if (IN(5)) {
        pg8::Gemm g{F.H1B, F.WT1IN, MP, N1, D}; pg8::StaticOrder S; S.init(MP, N1, F.G, (int)blockIdx.x);
        pg8::EpiBf16<0> E{F.QFIZ, N1, nullptr, 0, 0, 1.f};
        pg8::gemm_phase<pg8::EpiBf16<0>, pg8::StaticOrder, PG8_ALIGN, PG8_SP2>(F.lds + RING_OFF, g, S, E);
        if (BOTH(5)) GRID_BAR();
    }
#endif
#ifndef SKIP_P6
    if (IN(6)) { p6_l1_rec_naive(F); if (BOTH(6)) GRID_BAR(); }
#endif
#ifndef SKIP_P7
    if (IN(7)) { p7_normgate(F); if (BOTH(7)) GRID_BAR(); }
#endif
#ifndef SKIP_P8
    if (IN(8)) {
        pg8::Gemm g{F.Y, F.WT1OUT, MX, D, DI}; pg8::StaticOrder S; S.init(MX, D, F.G, (int)blockIdx.x);
        pg8::EpiResid E{F.PRE, D, F.PRE, F.PRE, MX, MX, ALPHA};
        pg8::gemm_phase<pg8::EpiResid, pg8::StaticOrder, PG8_ALIGN, PG8_SP2>(F.lds + RING_OFF, g, S, E);
        if (BOTH(8)) GRID_BAR();
    }
#endif
#ifndef SKIP_P9
    if (IN(9)) { ln_phase(F, F.PRE, MX, F.ln1g, F.ln1b, F.out, nullptr, nullptr); }
#endif
#undef IN
#undef BOTH
}

extern "C" void kernel_launch(void* const* d_in, const int* in_sizes, int n_in, void* d_out, int out_size, void* d_ws, size_t ws_size, hipStream_t stream) {
    static int grid = 0;
    if (grid == 0) {
        if (n_in != 17 || in_sizes[0] != MX * D || out_size != MX * D || ws_size < WS_END) { fprintf(stderr, "kernel_launch: unexpected problem (n_in %d, in0 %d, out %d, ws %zu < %zu); nothing launched\n", n_in, n_in > 0 ? in_sizes[0] : -1, out_size, ws_size, (size_t)WS_END); grid = -1; return; }
        int dev = 0, cus = 0, per_cu = 0;
        if (hipGetDevice(&dev) != hipSuccess || hipDeviceGetAttribute(&cus, hipDeviceAttributeMultiprocessorCount, dev) != hipSuccess) { fprintf(stderr, "kernel_launch: device query failed\n"); grid = -1; return; }
        if (hipFuncSetAttribute((const void*)mk_fwd, hipFuncAttributeMaxDynamicSharedMemorySize, LDS_BYTES) != hipSuccess) { fprintf(stderr, "kernel_launch: hipFuncSetAttribute failed\n"); grid = -1; return; }
        if (hipOccupancyMaxActiveBlocksPerMultiprocessor(&per_cu, (const void*)mk_fwd, NWAVES * 64, LDS_BYTES) != hipSuccess || per_cu < 1)
            fprintf(stderr, "kernel_launch: note: occupancy query reports %d workgroups per CU\n", per_cu);
        (void)hipGetLastError();
        grid = cus;
    }
    if (grid < 0) return;
    if (hipMemsetAsync((char*)d_ws + WS_CTL, 0, CTL_ZERO_BYTES, stream) != hipSuccess) { fprintf(stderr, "kernel_launch: memset failed\n"); return; }
    Args a{};
    for (int i = 0; i < 17; ++i) a.in[i] = (const float*)d_in[i];
    a.out = (float*)d_out; a.ws = (unsigned char*)d_ws;
    for (int li = 0; li < N_LAUNCHES; ++li) {
        a.ph_lo = (N_LAUNCHES == 1) ? 0 : li; a.ph_hi = (N_LAUNCHES == 1) ? PER_PHASE : li + 1; a.li = li; a.pad = 0;
        hipLaunchKernelGGL(mk_fwd, dim3(grid), dim3(NWAVES * 64), LDS_BYTES, stream, a);
        const hipError_t le = hipPeekAtLastError();
        if (le != hipSuccess) { fprintf(stderr, "kernel_launch: launch %d failed: %s\n", li, hipGetErrorName(le)); break; }
    }
}
```

```cpp
#include <hip/hip_runtime.h>
#include <cstdio>
#include <cstdint>
#define MK_N_LAUNCHES 1
namespace pg8 {
#define PG8_LAS __attribute__((address_space(3)))
typedef unsigned short bf16_t;
typedef short bf16x8 __attribute__((ext_vector_type(8)));
typedef float f32x4 __attribute__((ext_vector_type(4)));
typedef unsigned u32x4 __attribute__((ext_vector_type(4)));
constexpr int BM = 256, BK = 64, HALF = 128, HTB = HALF * BK * 2  , STAGE_BYTES = 8 * HTB, NXCD = 8, WGM = 8;

__host__ __device__ __forceinline__ int lds_byte(int r, int c) { const int st = (r >> 4) * 2 + (c >> 5), rr = r & 15, cc = c & 31, ob = rr * 64 + cc * 2; return st * 1024 + (ob ^ (((ob >> 9) & 1) << 5)); }
__host__ __device__ __forceinline__ void stage_rc(int b, int& R, int& C) { const int st = b / 1024, sb = b % 1024, swz = sb ^ (((sb >> 9) & 1) << 5); R = (st >> 1) * 16 + swz / 64; C = (st & 1) * 32 + (swz % 64) / 2; }
__host__ __device__ __forceinline__ int perm32(int rho) { const int n = rho >> 4, i = rho & 15; return 8 * (i >> 2) + 4 * n + (i & 3); }

struct Unit { int pm, pn; };
struct Gemm { const bf16_t* A; const bf16_t* Bt; int M, N, K; };

struct StaticOrder {
    int nM, nN, nwg, G, c;
    __host__ __device__ void init(int M, int N, int G_, int c_) { nM = M / BM; nN = N / BM; nwg = nM * nN; G = G_; c = c_; }
    __host__ __device__ bool next(int i, Unit& u) const {
        const long L = (long)i * G + c; if (L >= nwg) return false;
        int wgid = (int)L; { const int q = nwg / NXCD, r = nwg % NXCD, xcd = wgid % NXCD, off = wgid / NXCD; wgid = (xcd < r ? xcd * (q + 1) : r * (q + 1) + (xcd - r) * q) + off; }
        const int nig = WGM * nN, gid = wgid / nig, fm = gid * WGM, gsz = (nM - fm) < WGM ? (nM - fm) : WGM;
        u.pm = fm + ((wgid % nig) % gsz); u.pn = (wgid % nig) / gsz; return true;
    }
    __device__ __forceinline__ void a_ready(const Unit&) const {}
    __device__ __forceinline__ void done(const Unit&) const {}
};

__device__ __forceinline__ unsigned cvt_pk_bf16(float lo, float hi) { unsigned r; asm volatile("v_cvt_pk_bf16_f32 %0, %1, %2" : "=v"(r) : "v"(lo), "v"(hi)); return r; }
typedef float f32x2 __attribute__((ext_vector_type(2)));
__device__ __forceinline__ f32x2 gelu_pk(f32x2 v) {
    const f32x2 av = __builtin_elementwise_abs(v), d = av * 0.2316418882f + 1.0f;
    f32x2 t; t.x = __builtin_amdgcn_rcpf(d.x); t.y = __builtin_amdgcn_rcpf(d.y);
    f32x2 q = t * 0.5307027145f + (-0.7265760135f); q = q * t + 0.7107068705f; q = q * t + (-0.142248368f); q = q * t + 0.127414796f; q = q * t;
    const f32x2 s = (v * v) * (-0.72134752044f);
    f32x2 e; e.x = __builtin_amdgcn_exp2f(s.x); e.y = __builtin_amdgcn_exp2f(s.y);
    const f32x2 m = v * (q * e), r = v - m;
    f32x2 o; o.x = v.x < 0.f ? m.x : r.x; o.y = v.y < 0.f ? m.y : r.y; return o;
}

template <int ACT  > struct EpiBf16 {
    static constexpr bool PERM = true, AFTER_DRAIN = false; static_assert(ACT == 0 || ACT == 1, "EpiBf16: ACT is 0 (none) or 1 (gelu_pk)");
    bf16_t* O; int ldc; const float* bias; int split_cols; size_t split_stride; float scale0;
    __device__ __forceinline__ void operator()(const f32x4 (&acc)[2][2][4][2], const Unit& u, int wr, int wc, int fr, int fq) const {
        const int row0 = u.pm * BM + wr * 64 + fr; int colt = u.pn * BM; bf16_t* base = O;
        float sc = 1.f; if (split_cols) { const int t = colt / split_cols; base += (size_t)t * split_stride; colt -= t * split_cols; if (t == 0) sc = scale0; }
        const int col0 = colt + wc * 32 + 8 * fq, bcol0 = u.pn * BM + wc * 32 + 8 * fq;
        f32x4 bv[2][2];
#pragma unroll
        for (int bj = 0; bj < 2; ++bj)
#pragma unroll
            for (int n = 0; n < 2; ++n) bv[bj][n] = bias ? *(const f32x4*)(bias + bcol0 + bj * HALF + 4 * n) : (f32x4){0.f, 0.f, 0.f, 0.f};
#pragma unroll
        for (int ai = 0; ai < 2; ++ai)
#pragma unroll
            for (int m = 0; m < 4; ++m) { bf16_t* rowp = base + (size_t)(row0 + ai * HALF + m * 16) * ldc + col0;
#pragma unroll
                for (int bj = 0; bj < 2; ++bj) { f32x4 v0 = acc[ai][bj][m][0] + bv[bj][0], v1 = acc[ai][bj][m][1] + bv[bj][1];
                    if (ACT == 1) { f32x2 a = gelu_pk((f32x2){v0[0], v0[1]}), b = gelu_pk((f32x2){v0[2], v0[3]}), c = gelu_pk((f32x2){v1[0], v1[1]}), d = gelu_pk((f32x2){v1[2], v1[3]});
                        v0 = (f32x4){a.x, a.y, b.x, b.y}; v1 = (f32x4){c.x, c.y, d.x, d.y}; }
                    v0 = v0 * sc; v1 = v1 * sc; u32x4 w; w.x = cvt_pk_bf16(v0[0], v0[1]); w.y = cvt_pk_bf16(v0[2], v0[3]); w.z = cvt_pk_bf16(v1[0], v1[1]); w.w = cvt_pk_bf16(v1[2], v1[3]);
                    *(u32x4*)(rowp + bj * HALF) = w; } }
    }
};
struct EpiResid {
    static constexpr bool PERM = false, AFTER_DRAIN = false;
    float* C; int ldc; const float* resA; const float* resB; int rowsA; int rowsValid; float alpha;
    __device__ __forceinline__ void operator()(const f32x4 (&acc)[2][2][4][2], const Unit& u, int wr, int wc, int fr, int fq) const {
        const int row0 = u.pm * BM + wr * 64 + fr, col0 = u.pn * BM + wc * 32 + 4 * fq;
#pragma unroll
        for (int ai = 0; ai < 2; ++ai)
#pragma unroll
            for (int m = 0; m < 4; ++m) { const int r = row0 + ai * HALF + m * 16;
                if (r < rowsValid) {
                    const float* rp = (r < rowsA) ? resA + (size_t)r * ldc + col0 : resB + (size_t)(r - rowsA) * ldc + col0;
                    float* cp = C + (size_t)r * ldc + col0;
#pragma unroll
                    for (int bj = 0; bj < 2; ++bj)
#pragma unroll
                        for (int n = 0; n < 2; ++n) { const f32x4 rv = *(const f32x4*)(rp + bj * HALF + n * 16); *(f32x4*)(cp + bj * HALF + n * 16) = rv * alpha + acc[ai][bj][m][n]; } }
                asm volatile("" ::: "memory"); }
    }
};


template <class Epi, class Sched, bool ALIGN_EPI = false, bool SP2 = false>
__device__ __forceinline__ void gemm_phase(PG8_LAS unsigned char* lds, const Gemm g, const Sched& S, const Epi& E) {
    const int tid = threadIdx.x, wid = __builtin_amdgcn_readfirstlane(tid >> 6), lane = tid & 63, wr = wid >> 2, wc = wid & 3, fr = lane & 15, fq = lane >> 4;
    const int K = g.K, nt = K / BK;
    unsigned voffA[2], voffB[2];
#pragma unroll
    for (int i = 0; i < 2; ++i) { int R, C; stage_rc(tid * 16 + i * 8192, R, C); const int Rb = Epi::PERM ? ((R & ~31) + perm32(R & 31)) : R;
        voffA[i] = (unsigned)(R * K + C) * 2u; voffB[i] = (unsigned)(Rb * K + C) * 2u; }
    const size_t kstep = (size_t)(BK * 2);
    const size_t hstep = (size_t)HALF * K * 2;
    const size_t tstep = 2 * hstep;
    const unsigned ldsw = (unsigned)wid * 1024u;
    const int aoff = lds_byte(wr * 64 + fr, fq * 8), boff = lds_byte(wc * 32 + fr, fq * 8);
#define PG8_SA(b, h) (((b) * 2 + (h)) * HTB)
#define PG8_SB(b, h) ((4 + (b) * 2 + (h)) * HTB)
#define PG8_STAGE(bufoff, gbase, voff) do { _Pragma("unroll") for (int _i = 0; _i < 2; ++_i) \
        __builtin_amdgcn_global_load_lds((const unsigned*)((const char*)(gbase) + (voff)[_i]), (PG8_LAS unsigned*)(lds + (bufoff) + ldsw + _i * 8192), 16, 0, 0); } while (0)
#define PG8_LDA(dst, b, h) do { _Pragma("unroll") for (int m = 0; m < 4; ++m) _Pragma("unroll") for (int k = 0; k < 2; ++k) dst[m][k] = *(const PG8_LAS bf16x8*)(lds + PG8_SA(b, h) + aoff + m * 2048 + k * 1024); } while (0)
#define PG8_LDB(dst, b, h) do { _Pragma("unroll") for (int n = 0; n < 2; ++n) _Pragma("unroll") for (int k = 0; k < 2; ++k) dst[n][k] = *(const PG8_LAS bf16x8*)(lds + PG8_SB(b, h) + boff + n * 2048 + k * 1024); } while (0)
#define PG8_MMA(ai, bj, At, Bt) do { __builtin_amdgcn_s_setprio(1); _Pragma("unroll") for (int m = 0; m < 4; ++m) _Pragma("unroll") for (int n = 0; n < 2; ++n) _Pragma("unroll") for (int k = 0; k < 2; ++k) \
        acc[ai][bj][m][n] = __builtin_amdgcn_mfma_f32_16x16x32_bf16(Bt[n][k], At[m][k], acc[ai][bj][m][n], 0, 0, 0); __builtin_amdgcn_s_setprio(0); } while (0)
#define PG8_WAIT_V(n) asm volatile("s_waitcnt vmcnt(" #n ")" ::: "memory")
#define PG8_WAIT_L(n) asm volatile("s_waitcnt lgkmcnt(" #n ")" ::: "memory")
#define PG8_BAR __builtin_amdgcn_s_barrier()
#define PG8_SCHED __builtin_amdgcn_sched_barrier(0)
    Unit cur, nxt; int ui = 0;
    if (!S.next(0, cur)) return;
    f32x4 acc[2][2][4][2];
#pragma unroll
    for (int a = 0; a < 2; ++a)
#pragma unroll
        for (int b = 0; b < 2; ++b)
#pragma unroll
            for (int m = 0; m < 4; ++m)
#pragma unroll
                for (int n = 0; n < 2; ++n) acc[a][b][m][n] = (f32x4){0.f, 0.f, 0.f, 0.f};
    bf16x8 At[4][2], B0[2][2], B1[2][2];
    const char* cA = (const char*)g.A + (size_t)cur.pm * tstep; const char* cB = (const char*)g.Bt + (size_t)cur.pn * tstep;
    S.a_ready(cur);
    if constexpr (SP2) {
        PG8_STAGE(PG8_SB(0, 0), cB, voffB); PG8_STAGE(PG8_SB(0, 1), cB + hstep, voffB); PG8_STAGE(PG8_SA(0, 0), cA, voffA); PG8_STAGE(PG8_SA(0, 1), cA + hstep, voffA);
        if (wr == 1) PG8_BAR;
        PG8_WAIT_V(2); PG8_BAR;
        PG8_STAGE(PG8_SB(1, 0), cB + kstep, voffB); PG8_STAGE(PG8_SA(1, 0), cA + kstep, voffA); PG8_STAGE(PG8_SB(1, 1), cB + hstep + kstep, voffB);
        PG8_WAIT_V(6); PG8_BAR;
    } else {
        PG8_STAGE(PG8_SB(0, 0), cB, voffB); PG8_STAGE(PG8_SA(0, 0), cA, voffA); PG8_STAGE(PG8_SB(0, 1), cB + hstep, voffB); PG8_STAGE(PG8_SA(0, 1), cA + hstep, voffA);
        if (wr == 1) PG8_BAR;
        PG8_WAIT_V(4); PG8_BAR;
        PG8_STAGE(PG8_SB(1, 0), cB + kstep, voffB); PG8_STAGE(PG8_SA(1, 0), cA + kstep, voffA); PG8_STAGE(PG8_SB(1, 1), cB + hstep + kstep, voffB);
        PG8_WAIT_V(6); PG8_BAR;
    }
    for (;;) {
        const bool has_next = S.next(ui + 1, nxt);
        const char* nA = has_next ? (const char*)g.A + (size_t)nxt.pm * tstep : cA; const char* nB = has_next ? (const char*)g.Bt + (size_t)nxt.pn * tstep : cB;
        for (int t = 0; t < nt; t += 2) {
            const bool last = (t == nt - 2);
            const char* a1 = cA + (size_t)(t + 1) * kstep;
            const char* a2 = last ? nA : cA + (size_t)(t + 2) * kstep; const char* b2 = last ? nB : cB + (size_t)(t + 2) * kstep;
            const char* a3 = a2 + kstep; const char* b3 = b2 + kstep;
            if (last && has_next) S.a_ready(nxt);
            if constexpr (SP2) {
            PG8_LDB(B0, 0, 0); PG8_LDB(B1, 0, 1); PG8_SCHED; PG8_LDA(At, 0, 0); PG8_STAGE(PG8_SA(1, 1), a1 + hstep, voffA);
            PG8_WAIT_V(8); PG8_WAIT_L(0); PG8_BAR; PG8_MMA(0, 0, At, B0); PG8_MMA(0, 1, At, B1); PG8_BAR; PG8_SCHED;
            PG8_LDA(At, 0, 1); PG8_STAGE(PG8_SB(0, 0), b2, voffB); PG8_STAGE(PG8_SB(0, 1), b2 + hstep, voffB); PG8_STAGE(PG8_SA(0, 0), a2, voffA);
            PG8_WAIT_V(8); PG8_WAIT_L(0); PG8_BAR; PG8_MMA(1, 0, At, B0); PG8_MMA(1, 1, At, B1); PG8_BAR; PG8_SCHED;
            PG8_LDB(B0, 1, 0); PG8_LDB(B1, 1, 1); PG8_SCHED; PG8_LDA(At, 1, 0); PG8_STAGE(PG8_SA(0, 1), a2 + hstep, voffA);
            PG8_WAIT_V(8); PG8_WAIT_L(0); PG8_BAR; PG8_MMA(0, 0, At, B0); PG8_MMA(0, 1, At, B1); PG8_BAR; PG8_SCHED;
            PG8_LDA(At, 1, 1); PG8_STAGE(PG8_SB(1, 0), b3, voffB); PG8_STAGE(PG8_SB(1, 1), b3 + hstep, voffB); PG8_STAGE(PG8_SA(1, 0), a3, voffA);
            PG8_WAIT_V(8); PG8_WAIT_L(0); PG8_BAR; PG8_MMA(1, 0, At, B0); PG8_MMA(1, 1, At, B1); PG8_BAR; PG8_SCHED;
            } else {
            PG8_LDB(B0, 0, 0); PG8_SCHED; PG8_LDA(At, 0, 0); PG8_STAGE(PG8_SA(1, 1), a1 + hstep, voffA);
            PG8_WAIT_L(8); PG8_BAR; PG8_WAIT_L(0); PG8_MMA(0, 0, At, B0); PG8_BAR; PG8_SCHED;
            PG8_LDB(B1, 0, 1); PG8_STAGE(PG8_SB(0, 0), b2, voffB);
            PG8_BAR; PG8_WAIT_L(0); PG8_MMA(0, 1, At, B1); PG8_BAR;
            PG8_LDA(At, 0, 1); PG8_STAGE(PG8_SA(0, 0), a2, voffA);
            PG8_BAR; PG8_WAIT_L(0); PG8_MMA(1, 0, At, B0); PG8_BAR; PG8_SCHED;
            PG8_STAGE(PG8_SB(0, 1), b2 + hstep, voffB);
            PG8_WAIT_V(6); PG8_BAR; PG8_MMA(1, 1, At, B1); PG8_BAR;
            PG8_LDB(B0, 1, 0); PG8_SCHED; PG8_LDA(At, 1, 0); PG8_STAGE(PG8_SA(0, 1), a2 + hstep, voffA);
            PG8_WAIT_L(8); PG8_BAR; PG8_WAIT_L(0); PG8_MMA(0, 0, At, B0); PG8_BAR; PG8_SCHED;
            PG8_LDB(B1, 1, 1); PG8_STAGE(PG8_SB(1, 0), b3, voffB);
            PG8_BAR; PG8_WAIT_L(0); PG8_MMA(0, 1, At, B1); PG8_BAR;
            PG8_LDA(At, 1, 1); PG8_STAGE(PG8_SA(1, 0), a3, voffA);
            PG8_BAR; PG8_WAIT_L(0); PG8_MMA(1, 0, At, B0); PG8_BAR; PG8_SCHED;
            PG8_STAGE(PG8_SB(1, 1), b3 + hstep, voffB);
            PG8_WAIT_V(6); PG8_BAR; PG8_MMA(1, 1, At, B1); PG8_BAR;
            }
        }
        if constexpr (ALIGN_EPI) { if (wr == 0) PG8_BAR; }
        if constexpr (!Epi::AFTER_DRAIN) { E(acc, cur, wr, wc, fr, fq); S.done(cur); }
        if (!has_next) break;
#pragma unroll
        for (int a = 0; a < 2; ++a)
#pragma unroll
            for (int b = 0; b < 2; ++b)
#pragma unroll
                for (int m = 0; m < 4; ++m)
#pragma unroll
                    for (int n = 0; n < 2; ++n) acc[a][b][m][n] = (f32x4){0.f, 0.f, 0.f, 0.f};
        cur = nxt; cA = nA; cB = nB; ++ui;
        if constexpr (ALIGN_EPI) { if (wr == 1) PG8_BAR; }
    }
    PG8_WAIT_V(0);
    if constexpr (!ALIGN_EPI) { if (wr == 0) PG8_BAR; }
    PG8_BAR;
    if constexpr (Epi::AFTER_DRAIN) { E.fused(acc, cur, wr, wc, fr, fq, lds, wid, lane); S.done(cur); }
#undef PG8_SA
#undef PG8_SB
#undef PG8_STAGE
#undef PG8_LDA
#undef PG8_LDB
#undef PG8_MMA
#undef PG8_WAIT_V
#undef PG8_WAIT_L
#undef PG8_BAR
#undef PG8_SCHED
}
}
#ifndef PG8_SP2
#define PG8_SP2 true
#endif
#ifndef PG8_ALIGN
#define PG8_ALIGN true
#endif

constexpr int NWAVES = 8;
constexpr int PER_PHASE = 10;
#ifndef MK_N_LAUNCHES
#define MK_N_LAUNCHES 1
#endif
constexpr int N_LAUNCHES = MK_N_LAUNCHES;

constexpr int D = 4096, NB = 4, SEQ = 2048, NMETA = 16, DI = 8192;
constexpr int MX = NB * SEQ;
constexpr int MR = MX + NMETA;
constexpr int MP = 8448;
constexpr int N0 = 4 * DI;
constexpr int N1 = 2 * 4096 + 2 * DI;
constexpr int HG_H = 64, HG_DK = 128;
constexpr int GL_H = 8, GL_DK = 512, GL_DV = 1024, GL_R = 16;
constexpr float LN_EPS = 1e-5f, RMS_EPS = 1e-6f;
constexpr float ALPHA = 1.41421356237309515f;

constexpr size_t MiB = 1u << 20;
constexpr size_t WS_CTL = 0, CTL_ZERO_BYTES = 1 * MiB;
constexpr size_t WS_LB0 = 1 * MiB;
constexpr size_t WS_G1 = 2 * MiB;
constexpr size_t WS_WT0IN = 4 * MiB;
constexpr size_t WS_WT0OUT = WS_WT0IN + 256 * MiB;
constexpr size_t WS_WT1IN = WS_WT0OUT + 64 * MiB;
constexpr size_t WS_WT1OUT = WS_WT1IN + 192 * MiB;
constexpr size_t WS_XB = WS_WT1OUT + 64 * MiB;
constexpr size_t WS_H1B = WS_XB + 66 * MiB;
constexpr size_t WS_QFIZ = WS_H1B + 66 * MiB;
constexpr size_t WS_Y = WS_QFIZ + 528 * MiB;
constexpr size_t WS_PRE = WS_Y + 132 * MiB;
constexpr size_t WS_O1 = WS_PRE + 132 * MiB;
constexpr size_t WS_END = WS_O1 + 257 * MiB;
static_assert((size_t)MP * D * 2 <= 66 * MiB && (size_t)MP * N0 * 2 <= 528 * MiB && (size_t)MP * DI * 2 <= 132 * MiB && (size_t)MP * D * 4 <= 132 * MiB && (size_t)MR * DI * 4 <= 257 * MiB, "d_ws map");
constexpr int CW_BAR = 4096;

constexpr int RING_OFF = 0, RING_BYTES = 131072;
constexpr int LDSCTL_OFF = RING_BYTES, MISC_OFF = LDSCTL_OFF + 320;
constexpr int LDS_BYTES = 147456;
static_assert(MISC_OFF + 128 <= LDS_BYTES, "LDS map");

#define GAS __attribute__((address_space(1)))
#define LAS __attribute__((address_space(3)))
typedef unsigned short bf16;
typedef unsigned v4u __attribute__((ext_vector_type(4)));
typedef unsigned v2u __attribute__((ext_vector_type(2)));
typedef float f32x4 __attribute__((ext_vector_type(4)));
typedef GAS unsigned gu32;
#define RLX_AGENT __ATOMIC_RELAXED, __HIP_MEMORY_SCOPE_AGENT
#define LDS_WAIT() asm volatile("s_waitcnt lgkmcnt(0)" ::: "memory")
#define DI_ __device__ __forceinline__
DI_ unsigned f2bf(float f) { unsigned u = __builtin_bit_cast(unsigned, f); return (u + 0x7fffu + ((u >> 16) & 1u)) >> 16; }
DI_ unsigned pk2(float lo, float hi) { return f2bf(lo) | (f2bf(hi) << 16); }
DI_ float bflo(unsigned w) { return __builtin_bit_cast(float, w << 16); }
DI_ float bfhi(unsigned w) { return __builtin_bit_cast(float, w & 0xffff0000u); }
DI_ float bf2f(bf16 b) { return __builtin_bit_cast(float, (unsigned)b << 16); }
DI_ float sigm(float x) { return 1.f / (1.f + __expf(-x)); }
DI_ float silu(float x) { return x / (1.f + __expf(-x)); }

#define XB_TMO      128
#define XB_XCNT(j)  (256  + 64 * (j))
#define XB_XSUB(j)  (1280 + 64 * (j))
#define XB_XGEN(j)  (2304 + 64 * (j))
#define XB_TOP      3328
#define XB_TOPGEN   3392
#define XCD_BAR_WORDS 3456
#define XB_SPIN_CAP (1u << 18)

__device__ __forceinline__ unsigned xb_ld(unsigned* p)              { return __hip_atomic_load(p, __ATOMIC_RELAXED, __HIP_MEMORY_SCOPE_AGENT); }
__device__ __forceinline__ unsigned xb_add(unsigned* p, unsigned v) { return __hip_atomic_fetch_add(p, v, __ATOMIC_RELAXED, __HIP_MEMORY_SCOPE_AGENT); }
__device__ __forceinline__ unsigned xb_xcc_id() { return (unsigned)__builtin_amdgcn_s_getreg((3 << 11) | 20) & 0xFu; }
#define XB_SPIN(cond, bar) do { unsigned _sp = 0; while (cond) { __builtin_amdgcn_s_sleep(1); \
    if ((++_sp & 255u) == 0u) { if (xb_ld(&(bar)[XB_TMO])) break; if (_sp > XB_SPIN_CAP) { atomicAdd(&(bar)[XB_TMO], 1u); break; } } } } while (0)

struct XcdBarrier {
    unsigned* bar; unsigned x;
    volatile LAS unsigned* st;
};
__device__ __forceinline__ XcdBarrier xcd_barrier_post(unsigned* bar, volatile LAS unsigned* st) {
    XcdBarrier b; b.bar = bar; b.x = xb_xcc_id(); b.st = st;
    if (threadIdx.x == 0) (void)xb_add(&bar[XB_XCNT(b.x)], 1u);
    return b;
}
__device__ __forceinline__ void xcd_barrier_complete(unsigned* bar, unsigned x, unsigned& nloc, unsigned& nx) {
    const unsigned G = gridDim.x * gridDim.y * gridDim.z;
    unsigned sum, cnt, mine, sp = 0u;
    for (;;) {
        sum = 0u; cnt = 0u; mine = 0u;
#pragma unroll
        for (unsigned j = 0; j < 16; ++j) { const unsigned c = xb_ld(&bar[XB_XCNT(j)]); sum += c; cnt += (c > 0u) ? 1u : 0u; mine = (j == x) ? c : mine; }
        if (sum == G) break;
        __builtin_amdgcn_s_sleep(1);
        if ((++sp & 255u) == 0u) { if (xb_ld(&bar[XB_TMO])) break; if (sp > XB_SPIN_CAP) { atomicAdd(&bar[XB_TMO], 1u); break; } }
    }
    nloc = mine > 0u ? mine : 1u; nx = cnt > 0u ? cnt : 1u;
}
__device__ __forceinline__ void xcd_barrier(const XcdBarrier& b) {
    asm volatile("s_waitcnt vmcnt(0)" ::: "memory");
    __syncthreads();
    if (threadIdx.x == 0) {
        unsigned* bar = b.bar;
        __builtin_amdgcn_s_waitcnt(0);
        unsigned nloc = b.st[0], nx = b.st[1];
        if (nloc == 0u) { xcd_barrier_complete(bar, b.x, nloc, nx); b.st[0] = nloc; b.st[1] = nx; }
        const unsigned old = xb_add(&bar[XB_XSUB(b.x)], 1u);
        const unsigned gen = old / nloc;
        if (old + 1u == (gen + 1u) * nloc) {
            __builtin_amdgcn_fence(__ATOMIC_RELEASE, "agent");
            asm volatile("s_waitcnt vmcnt(0)" ::: "memory");
            const unsigned og = xb_add(&bar[XB_TOP], 1u);
            const unsigned tg = og / nx;
            if (og + 1u == (tg + 1u) * nx) xb_add(&bar[XB_TOPGEN], 1u);
            else XB_SPIN(xb_ld(&bar[XB_TOPGEN]) == tg, bar);
            __builtin_amdgcn_fence(__ATOMIC_ACQUIRE, "agent");
            xb_add(&bar[XB_XGEN(b.x)], 1u);
            asm volatile("s_waitcnt vmcnt(0)" ::: "memory");
        } else {
            XB_SPIN(xb_ld(&bar[XB_XGEN(b.x)]) == gen, bar);
            __builtin_amdgcn_fence(__ATOMIC_ACQUIRE, "agent");
            asm volatile("s_waitcnt vmcnt(0)" ::: "memory");
        }
    }
    __syncthreads();
}

struct Frame {
    LAS unsigned char* lds;
    volatile LAS unsigned* MISC;
    gu32* ctl;
    int tid, lane, wave;
    int vcu, G;
    const float *x, *meta, *lb_logits;
    const float *w0in, *b_f, *ng0, *w0out, *ln0g, *ln0b;
    const float *w1in, *wg1, *wg2, *b_g, *ng1, *w1out, *ln1g, *ln1b;
    float* out;
    float *LB0, *G1, *PRE, *O1;
    bf16 *WT0IN, *WT0OUT, *WT1IN, *WT1OUT, *XB, *H1B, *QFIZ, *Y;
};

DI_ float wave_sum(float v) {
#pragma unroll
    for (int o = 1; o < 64; o <<= 1) v += __shfl_xor(v, o);
    return v;
}

DI_ void p0_transpose_item(const float* W, int K, int N, bf16* WT, LAS float* scr, int item, int lane) {
    const int nblk = N / 32, kb = item / nblk, nb = item % nblk, k0 = 64 * kb, n0 = 32 * nb;
#pragma unroll 8
    for (int i = 0; i < 32; ++i) { const int kk = 2 * i + (lane >> 5); scr[kk * 33 + (lane & 31)] = W[(size_t)(k0 + kk) * N + n0 + (lane & 31)]; }
    LDS_WAIT(); asm volatile("" ::: "memory");
    const int c = lane & 7;
#pragma unroll
    for (int j = 0; j < 4; ++j) { const int n = (lane >> 3) + 8 * j; const LAS float* s = scr + (8 * c) * 33 + n;
        v4u o; o.x = pk2(s[0 * 33], s[1 * 33]); o.y = pk2(s[2 * 33], s[3 * 33]); o.z = pk2(s[4 * 33], s[5 * 33]); o.w = pk2(s[6 * 33], s[7 * 33]);
        *(GAS v4u*)(WT + (size_t)(n0 + n) * K + k0 + 8 * c) = o; }
    LDS_WAIT(); asm volatile("" ::: "memory");
}

DI_ void p0_prologue(Frame& F) {
    LAS float* scr = (LAS float*)(F.lds + RING_OFF + F.wave * 16384);
    const int gw = F.vcu * NWAVES + F.wave, NGW = F.G * NWAVES;
    constexpr int I_0 = (D / 64) * (N0 / 32), I_1 = (DI / 64) * (D / 32), I_2 = (D / 64) * (N1 / 32), I_3 = I_1;
    constexpr int NITEMS = I_0 + I_1 + I_2 + I_3;
    for (int it = gw; it < NITEMS; it += NGW) {
        int r = it;
        if (r < I_0) { p0_transpose_item(F.w0in, D, N0, F.WT0IN, scr, r, F.lane); continue; } r -= I_0;
        if (r < I_1) { p0_transpose_item(F.w0out, DI, D, F.WT0OUT, scr, r, F.lane); continue; } r -= I_1;
        if (r < I_2) { p0_transpose_item(F.w1in, D, N1, F.WT1IN, scr, r, F.lane); continue; } r -= I_2;
        p0_transpose_item(F.w1out, DI, D, F.WT1OUT, scr, r, F.lane);
    }
    for (int m = gw; m < MP; m += NGW) {
        GAS unsigned long long* o8 = (GAS unsigned long long*)(F.XB + (size_t)m * D) + F.lane;
        if (m < MR) {
            const float* src = (m < MX) ? F.x + (size_t)m * D : F.meta + (size_t)(m - MX) * D;
            const GAS f32x4* xr = (const GAS f32x4*)src + F.lane;
#pragma unroll 4
            for (int j = 0; j < 16; ++j) { const f32x4 v = xr[64 * j]; o8[64 * j] = (unsigned long long)pk2(v.x, v.y) | ((unsigned long long)pk2(v.z, v.w) << 32); }
        } else {
#pragma unroll 4
            for (int j = 0; j < 16; ++j) o8[64 * j] = 0ull;
        }
    }
    for (int m = MR + gw; m < MP; m += NGW) {
        GAS unsigned long long* o8 = (GAS unsigned long long*)(F.H1B + (size_t)m * D) + F.lane;
#pragma unroll 4
        for (int j = 0; j < 16; ++j) o8[64 * j] = 0ull;
    }
    for (int c = gw * 64 + F.lane; c < DI; c += NGW * 64) {
        const float l0 = F.lb_logits[c], l1 = F.lb_logits[DI + c], l2 = F.lb_logits[2 * DI + c];
        const float mx = fmaxf(l0, fmaxf(l1, l2));
        const float e0 = __expf(l0 - mx), e1 = __expf(l1 - mx), e2 = __expf(l2 - mx);
        F.LB0[c] = e0 / (e0 + e1 + e2);
    }
}

DI_ void p2_l0_rec_naive(Frame& F) {
    LAS float* qs = (LAS float*)(F.lds);
    LAS float* fs = qs + 2048;
    LAS float* ks = fs + 2048;
    LAS float* vs = ks + 2048;
    LAS float* pb = vs + 2048;
    const int tid = F.tid, dv = tid & 127, kg = tid >> 7;
    const int lj = tid >> 5, lc = (tid & 31) * 4;
    for (int u = blockIdx.x; u < NB * HG_H; u += F.G) {
        const int b = u >> 6, h = u & 63;
        float S[32];
#pragma unroll
        for (int i = 0; i < 32; ++i) S[i] = 0.f;
        float lbv[4], bfv[4], ngv[4];
#pragma unroll
        for (int i = 0; i < 4; ++i) { lbv[i] = F.LB0[h * 128 + lc + i]; bfv[i] = F.b_f[h * 128 + lc + i]; ngv[i] = F.ng0[h * 128 + lc + i]; }
        for (int tb = 0; tb < 129; ++tb) {
            const int rbase = (tb == 0) ? MX : b * SEQ + 16 * (tb - 1);
            const bf16* row = F.QFIZ + (size_t)(rbase + lj) * N0 + h * 128 + lc;
            {
                const v2u q4 = *(const GAS v2u*)(row), f4 = *(const GAS v2u*)(row + DI), i4 = *(const GAS v2u*)(row + 2 * DI);
                const float qv[4] = {bflo(q4.x), bfhi(q4.x), bflo(q4.y), bfhi(q4.y)};
                const float fv[4] = {bflo(f4.x), bfhi(f4.x), bflo(f4.y), bfhi(f4.y)};
                const float iv[4] = {bflo(i4.x), bfhi(i4.x), bflo(i4.y), bfhi(i4.y)};
#pragma unroll
                for (int i = 0; i < 4; ++i) {
                    const float fg = lbv[i] + (1.f - lbv[i]) * sigm(fv[i] + bfv[i]);
                    qs[lj * 128 + lc + i] = silu(qv[i]); fs[lj * 128 + lc + i] = fg; ks[lj * 128 + lc + i] = 1.f - fg; vs[lj * 128 + lc + i] = iv[i];
                }
            }
            __syncthreads();
            for (int j = 0; j < 16; ++j) {
                const float vj = vs[j * 128 + dv]; float po = 0.f;
#pragma unroll
                for (int i = 0; i < 32; i += 4) {
                    const f32x4 f4 = *(const LAS f32x4*)(fs + j * 128 + kg * 32 + i), k4 = *(const LAS f32x4*)(ks + j * 128 + kg * 32 + i), q4 = *(const LAS f32x4*)(qs + j * 128 + kg * 32 + i);
                    S[i + 0] = f4.x * S[i + 0] + k4.x * vj; po += q4.x * S[i + 0];
                    S[i + 1] = f4.y * S[i + 1] + k4.y * vj; po += q4.y * S[i + 1];
                    S[i + 2] = f4.z * S[i + 2] + k4.z * vj; po += q4.z * S[i + 2];
                    S[i + 3] = f4.w * S[i + 3] + k4.w * vj; po += q4.w * S[i + 3];
                }
                pb[(j * 4 + kg) * 128 + dv] = po;
            }
            __syncthreads();
            {
                f32x4 o = *(const LAS f32x4*)(pb + (lj * 4 + 0) * 128 + lc);
                o += *(const LAS f32x4*)(pb + (lj * 4 + 1) * 128 + lc);
                o += *(const LAS f32x4*)(pb + (lj * 4 + 2) * 128 + lc);
                o += *(const LAS f32x4*)(pb + (lj * 4 + 3) * 128 + lc);
                float ss = o.x * o.x + o.y * o.y + o.z * o.z + o.w * o.w;
                ss += __shfl_xor(ss, 16); ss += __shfl_xor(ss, 8); ss += __shfl_xor(ss, 4); ss += __shfl_xor(ss, 2); ss += __shfl_xor(ss, 1);
                const float rs = rsqrtf(ss * (1.f / 128.f) + RMS_EPS);
                const v2u z4 = *(const GAS v2u*)(row + 3 * DI);
                const float y0 = o.x * rs * ngv[0] * silu(bflo(z4.x)), y1 = o.y * rs * ngv[1] * silu(bfhi(z4.x));
                const float y2 = o.z * rs * ngv[2] * silu(bflo(z4.y)), y3 = o.w * rs * ngv[3] * silu(bfhi(z4.y));
                if (tb > 0 || b == 0) { v2u w; w.x = pk2(y0, y1); w.y = pk2(y2, y3); *(GAS v2u*)(F.Y + (size_t)(rbase + lj) * DI + h * 128 + lc) = w; }
            }
        }
        __syncthreads();
    }
}

DI_ void ln_phase(Frame& F, const float* src, int nrows, const float* g, const float* bt, float* dst32, bf16* dstb, float* G1) {
    const int gw = F.vcu * NWAVES + F.wave, NGW = F.G * NWAVES;
    for (int r = gw; r < nrows; r += NGW) {
        const GAS f32x4* s = (const GAS f32x4*)(src + (size_t)r * D) + F.lane;
        f32x4 v[16]; float sm = 0.f;
#pragma unroll
        for (int j = 0; j < 16; ++j) { v[j] = s[64 * j]; sm += (v[j].x + v[j].y) + (v[j].z + v[j].w); }
        const float mean = wave_sum(sm) * (1.f / D); float s2 = 0.f;
#pragma unroll
        for (int j = 0; j < 16; ++j) { v[j] = v[j] - mean; s2 += (v[j].x * v[j].x + v[j].y * v[j].y) + (v[j].z * v[j].z + v[j].w * v[j].w); }
        const float rstd = rsqrtf(wave_sum(s2) * (1.f / D) + LN_EPS);
#pragma unroll
        for (int j = 0; j < 16; ++j) {
            const f32x4 gg = *((const GAS f32x4*)g + F.lane + 64 * j), bb = *((const GAS f32x4*)bt + F.lane + 64 * j);
            v[j] = v[j] * rstd * gg + bb;
            if (dst32) *((GAS f32x4*)(dst32 + (size_t)r * D) + F.lane + 64 * j) = v[j];
            if (dstb) { v2u w; w.x = pk2(v[j].x, v[j].y); w.y = pk2(v[j].z, v[j].w); *((GAS v2u*)(dstb + (size_t)r * D) + F.lane + 64 * j) = w; }
            if ((j & 3) == 3) asm volatile("" ::: "memory");
        }
        if (G1) {
            LAS float* rowbuf = (LAS float*)(F.lds + RING_OFF + F.wave * 16384);
#pragma unroll
            for (int j = 0; j < 16; ++j) *(LAS f32x4*)(rowbuf + 256 * j + 4 * F.lane) = v[j];
            LDS_WAIT(); asm volatile("" ::: "memory");
            float a[16];
#pragma unroll
            for (int q = 0; q < 16; ++q) a[q] = 0.f;
#pragma unroll 2
            for (int i = 0; i < 64; ++i) {
                const int k = 64 * i + F.lane;
                const float e = rowbuf[k];
                const GAS f32x4* w = (const GAS f32x4*)(F.wg1 + (size_t)k * GL_R);
                const f32x4 w0 = w[0], w1 = w[1], w2 = w[2], w3 = w[3];
                a[0] += e * w0.x; a[1] += e * w0.y; a[2] += e * w0.z; a[3] += e * w0.w;
                a[4] += e * w1.x; a[5] += e * w1.y; a[6] += e * w1.z; a[7] += e * w1.w;
                a[8] += e * w2.x; a[9] += e * w2.y; a[10] += e * w2.z; a[11] += e * w2.w;
                a[12] += e * w3.x; a[13] += e * w3.y; a[14] += e * w3.z; a[15] += e * w3.w;
            }
#pragma unroll
            for (int q = 0; q < 16; ++q) a[q] = wave_sum(a[q]);
            if (F.lane == 0) {
#pragma unroll
                for (int q = 0; q < 16; q += 4) *(GAS f32x4*)(G1 + (size_t)r * GL_R + q) = (f32x4){a[q], a[q + 1], a[q + 2], a[q + 3]};
            }
            LDS_WAIT(); asm volatile("" ::: "memory");
        }
    }
}

DI_ void p6_l1_rec_naive(Frame& F) {
    LAS float* qs = (LAS float*)(F.lds);
    LAS float* ks = qs + 4096;
    LAS float* gs = ks + 4096;
    LAS float* vs = gs + 4096;
    LAS float* pb = vs + 512;
    const int tid = F.tid, dv = tid & 63, kg = tid >> 6;
    const float qscale = 0.04419417382415922f;
    for (int u = blockIdx.x; u < NB * GL_H * 16; u += F.G) {
        const int dvs = u & 15, bh = u >> 4, b = bh >> 3, h = bh & 7;
        float S[64];
#pragma unroll
        for (int i = 0; i < 64; ++i) S[i] = 0.f;
        float w2[16];
#pragma unroll
        for (int r = 0; r < 16; ++r) w2[r] = F.wg2[(size_t)r * 4096 + h * 512 + tid];
        const float bg = F.b_g[h * 512 + tid];
        for (int tb = 0; tb < 258; ++tb) {
            const int rbase = (tb < 2) ? MX + 8 * tb : b * SEQ + 8 * (tb - 2);
            for (int j = 0; j < 8; ++j) {
                const size_t r = (size_t)(rbase + j);
                const float q = bf2f(F.QFIZ[r * N1 + h * 512 + tid]) * qscale, k = bf2f(F.QFIZ[r * N1 + 4096 + h * 512 + tid]);
                const float* g1 = F.G1 + r * GL_R;
                float xg = bg;
#pragma unroll
                for (int rr = 0; rr < 16; ++rr) xg += g1[rr] * w2[rr];
                const float ls = fminf(xg, 0.f) - log1pf(__expf(-fabsf(xg)));
                qs[j * 512 + tid] = q; ks[j * 512 + tid] = k; gs[j * 512 + tid] = __expf(ls * (1.f / 16.f));
            }
            vs[tid] = bf2f(F.QFIZ[(size_t)(rbase + (tid >> 6)) * N1 + 8192 + h * 1024 + dvs * 64 + (tid & 63)]);
            __syncthreads();
            for (int j = 0; j < 8; ++j) {
                const float vj = vs[j * 64 + dv]; float po = 0.f;
#pragma unroll
                for (int i = 0; i < 64; i += 4) {
                    const f32x4 g4 = *(const LAS f32x4*)(gs + j * 512 + kg * 64 + i), k4 = *(const LAS f32x4*)(ks + j * 512 + kg * 64 + i), q4 = *(const LAS f32x4*)(qs + j * 512 + kg * 64 + i);
                    S[i + 0] = g4.x * S[i + 0] + k4.x * vj; po += q4.x * S[i + 0];
                    S[i + 1] = g4.y * S[i + 1] + k4.y * vj; po += q4.y * S[i + 1];
                    S[i + 2] = g4.z * S[i + 2] + k4.z * vj; po += q4.z * S[i + 2];
                    S[i + 3] = g4.w * S[i + 3] + k4.w * vj; po += q4.w * S[i + 3];
                    if ((i & 12) == 12) asm volatile("" ::: "memory");
                }
                pb[(j * 8 + kg) * 64 + dv] = po;
            }
            __syncthreads();
            {
                const int j = tid >> 6, d = tid & 63; float o = 0.f;
#pragma unroll
                for (int g = 0; g < 8; ++g) o += pb[(j * 8 + g) * 64 + d];
                if (tb >= 2 || b == 0) F.O1[(size_t)(rbase + j) * DI + h * 1024 + dvs * 64 + d] = o;
            }
        }
        __syncthreads();
    }
}

DI_ void p7_normgate(Frame& F) {
    const int gw = F.vcu * NWAVES + F.wave, NGW = F.G * NWAVES;
    for (int it = gw; it < MX * GL_H; it += NGW) {
        const int r = it >> 3, h = it & 7;
        const GAS f32x4* o = (const GAS f32x4*)(F.O1 + (size_t)r * DI + h * 1024) + F.lane;
        f32x4 v[4]; float ss = 0.f;
#pragma unroll
        for (int j = 0; j < 4; ++j) { v[j] = o[64 * j]; ss += (v[j].x * v[j].x + v[j].y * v[j].y) + (v[j].z * v[j].z + v[j].w * v[j].w); }
        const float rs = rsqrtf(wave_sum(ss) * (1.f / 1024.f) + RMS_EPS);
#pragma unroll
        for (int j = 0; j < 4; ++j) {
            const int c = h * 1024 + 256 * j + 4 * F.lane;
            const v2u z4 = *(const GAS v2u*)(F.QFIZ + (size_t)r * N1 + 16384 + c);
            const f32x4 ng = *(const GAS f32x4*)(F.ng1 + c);
            v2u w; w.x = pk2(v[j].x * rs * ng.x * silu(bflo(z4.x)), v[j].y * rs * ng.y * silu(bfhi(z4.x)));
            w.y = pk2(v[j].z * rs * ng.z * silu(bflo(z4.y)), v[j].w * rs * ng.w * silu(bfhi(z4.y)));
            *(GAS v2u*)(F.Y + (size_t)r * DI + c) = w;
        }
    }
}

struct Args { const float* in[17]; float* out; unsigned char* ws; int ph_lo, ph_hi, li, pad; };
__global__ void __launch_bounds__(NWAVES * 64, 2) mk_fwd(Args args) {
    extern __shared__ __attribute__((aligned(16))) unsigned char lds[];
    Frame F;
    F.lds = (LAS unsigned char*)lds;
    F.MISC = (volatile LAS unsigned*)(F.lds + MISC_OFF);
    F.tid = threadIdx.x; F.lane = F.tid & 63; F.wave = __builtin_amdgcn_readfirstlane(F.tid >> 6);
    F.G = gridDim.x; { const int bx = blockIdx.x; F.vcu = (F.G % 8 == 0) ? (bx % 8) * (F.G / 8) + bx / 8 : bx; }
    unsigned char* ws = args.ws;
    F.ctl = (gu32*)(ws + WS_CTL);
    F.x = args.in[0]; F.meta = args.in[1]; F.lb_logits = args.in[2];
    F.w0in = args.in[3]; F.b_f = args.in[4]; F.ng0 = args.in[5]; F.w0out = args.in[6]; F.ln0g = args.in[7]; F.ln0b = args.in[8];
    F.w1in = args.in[9]; F.wg1 = args.in[10]; F.wg2 = args.in[11]; F.b_g = args.in[12]; F.ng1 = args.in[13]; F.w1out = args.in[14]; F.ln1g = args.in[15]; F.ln1b = args.in[16];
    F.out = args.out;
    F.LB0 = (float*)(ws + WS_LB0); F.G1 = (float*)(ws + WS_G1); F.PRE = (float*)(ws + WS_PRE); F.O1 = (float*)(ws + WS_O1);
    F.WT0IN = (bf16*)(ws + WS_WT0IN); F.WT0OUT = (bf16*)(ws + WS_WT0OUT); F.WT1IN = (bf16*)(ws + WS_WT1IN); F.WT1OUT = (bf16*)(ws + WS_WT1OUT);
    F.XB = (bf16*)(ws + WS_XB); F.H1B = (bf16*)(ws + WS_H1B); F.QFIZ = (bf16*)(ws + WS_QFIZ); F.Y = (bf16*)(ws + WS_Y);
    for (int u = F.tid; u < (LDS_BYTES - LDSCTL_OFF) / 4; u += NWAVES * 64) ((LAS unsigned*)(F.lds + LDSCTL_OFF))[u] = 0u;
    __syncthreads();
    XcdBarrier bar; bar.bar = (unsigned*)(F.ctl + CW_BAR); bar.x = 0; bar.st = nullptr;
    if (N_LAUNCHES == 1) bar = xcd_barrier_post((unsigned*)(F.ctl + CW_BAR), F.MISC + 8);
#define GRID_BAR() do { if (N_LAUNCHES == 1) xcd_barrier(bar); } while (0)
    const int lo = args.ph_lo, hi = args.ph_hi;
#define IN(k) (lo <= (k) && (k) < hi)
#define BOTH(k) (IN(k) && IN((k) + 1))

#ifndef SKIP_P0
    if (IN(0)) { p0_prologue(F); if (BOTH(0)) GRID_BAR(); }
#endif
#ifndef SKIP_P1
    if (IN(1)) {
        pg8::Gemm g{F.XB, F.WT0IN, MP, N0, D}; pg8::StaticOrder S; S.init(MP, N0, F.G, (int)blockIdx.x);
        pg8::EpiBf16<0> E{F.QFIZ, N0, nullptr, 0, 0, 1.f};
        pg8::gemm_phase<pg8::EpiBf16<0>, pg8::StaticOrder, PG8_ALIGN, PG8_SP2>(F.lds + RING_OFF, g, S, E);
        if (BOTH(1)) GRID_BAR();
    }
#endif
#ifndef SKIP_P2
    if (IN(2)) { p2_l0_rec_naive(F); if (BOTH(2)) GRID_BAR(); }
#endif
#ifndef SKIP_P3
    if (IN(3)) {
        pg8::Gemm g{F.Y, F.WT0OUT, MP, D, DI}; pg8::StaticOrder S; S.init(MP, D, F.G, (int)blockIdx.x);
        pg8::EpiResid E{F.PRE, D, F.x, F.meta, MX, MR, ALPHA};
        pg8::gemm_phase<pg8::EpiResid, pg8::StaticOrder, PG8_ALIGN, PG8_SP2>(F.lds + RING_OFF, g, S, E);
        if (BOTH(3)) GRID_BAR();
    }
#endif
#ifndef SKIP_P4
    if (IN(4)) { ln_phase(F, F.PRE, MR, F.ln0g, F.ln0b, F.PRE, F.H1B, F.G1); if (BOTH(4)) GRID_BAR(); }
#endif
#ifndef SKIP_P5
    if (IN(5)) {
        pg8::Gemm g{F.H1B, F.WT1IN, MP, N1, D}; pg8::StaticOrder S; S.init(MP, N1, F.G, (int)blockIdx.x);
        pg8::EpiBf16<0> E{F.QFIZ, N1, nullptr, 0, 0, 1.f};
        pg8::gemm_phase<pg8::EpiBf16<0>, pg8::StaticOrder, PG8_ALIGN, PG8_SP2>(F.lds + RING_OFF, g, S, E);
        if (BOTH(5)) GRID_BAR();
    }
#endif
#ifndef SKIP_P6
    if (IN(6)) { p6_l1_rec_naive(F); if (BOTH(6)) GRID_BAR(); }
#endif
#ifndef SKIP_P7
    if (IN(7)) { p7_normgate(F); if (BOTH(7)) GRID_BAR(); }
#endif
#ifndef SKIP_P8
    if (IN(8)) {
        pg8::Gemm g{F.Y, F.WT1OUT, MX, D, DI}; pg8::StaticOrder S; S.init(MX, D, F.G, (int)blockIdx.x);
        pg8::EpiResid E{F.PRE, D, F.PRE, F.PRE, MX, MX, ALPHA};
        pg8::gemm_phase<pg8::EpiResid, pg8::StaticOrder, PG8_ALIGN, PG8_SP2>(F.lds + RING_OFF, g, S, E);
        if (BOTH(8)) GRID_BAR();
    }
#endif
#ifndef SKIP_P9
    if (IN(9)) { ln_phase(F, F.PRE, MX, F.ln1g, F.ln1b, F.out, nullptr, nullptr); }
#endif
#undef IN
#undef BOTH
}

extern "C" void kernel_launch(void* const* d_in, const int* in_sizes, int n_in, void* d_out, int out_size, void* d_ws, size_t ws_size, hipStream_t stream) {
    static int grid = 0;
    if (grid == 0) {
        if (n_in != 17 || in_sizes[0] != MX * D || out_size != MX * D || ws_size < WS_END) { fprintf(stderr, "kernel_launch: unexpected problem (n_in %d, in0 %d, out %d, ws %zu < %zu); nothing launched\n", n_in, n_in > 0 ? in_sizes[0] : -1, out_size, ws_size, (size_t)WS_END); grid = -1; return; }
        int dev = 0, cus = 0, per_cu = 0;
        if (hipGetDevice(&dev) != hipSuccess || hipDeviceGetAttribute(&cus, hipDeviceAttributeMultiprocessorCount, dev) != hipSuccess) { fprintf(stderr, "kernel_launch: device query failed\n"); grid = -1; return; }
        if (hipFuncSetAttribute((const void*)mk_fwd, hipFuncAttributeMaxDynamicSharedMemorySize, LDS_BYTES) != hipSuccess) { fprintf(stderr, "kernel_launch: hipFuncSetAttribute failed\n"); grid = -1; return; }
        if (hipOccupancyMaxActiveBlocksPerMultiprocessor(&per_cu, (const void*)mk_fwd, NWAVES * 64, LDS_BYTES) != hipSuccess || per_cu < 1)
            fprintf(stderr, "kernel_launch: note: occupancy query reports %d workgroups per CU\n", per_cu);
        (void)hipGetLastError();
        grid = cus;
    }
    if (grid < 0) return;
    if (hipMemsetAsync((char*)d_ws + WS_CTL, 0, CTL_ZERO_BYTES, stream) != hipSuccess) { fprintf(stderr, "kernel_launch: memset failed\n"); return; }
    Args a{};
    for (int i = 0; i < 17; ++i) a.in[i] = (const float*)d_in[i];
    a.out = (float*)d_out; a.ws = (unsigned char*)d_ws;
    for (int li = 0; li < N_LAUNCHES; ++li) {
        a.ph_lo = (N_LAUNCHES == 1) ? 0 : li; a.ph_hi = (N_LAUNCHES == 1) ? PER_PHASE : li + 1; a.li = li; a.pad = 0;
        hipLaunchKernelGGL(mk_fwd, dim3(grid), dim3(NWAVES * 64), LDS_BYTES, stream, a);
        const hipError_t le = hipPeekAtLastError();
        if (le != hipSuccess) { fprintf(stderr, "kernel_launch: launch %d failed: %s\n", li, hipGetErrorName(le)); break; }
    }
}
```

```cpp
#include <hip/hip_runtime.h>
#include <cstdio>
#include <cstdint>
#define MK_N_LAUNCHES 1
#define USE_L0_MFMA 1
#define USE_L1_MFMA 1
namespace pg8 {
#define PG8_LAS __attribute__((address_space(3)))
typedef unsigned short bf16_t;
typedef short bf16x8 __attribute__((ext_vector_type(8)));
typedef float f32x4 __attribute__((ext_vector_type(4)));
typedef unsigned u32x4 __attribute__((ext_vector_type(4)));
constexpr int BM = 256, BK = 64, HALF = 128, HTB = HALF * BK * 2  , STAGE_BYTES = 8 * HTB, NXCD = 8, WGM = 8;

__host__ __device__ __forceinline__ int lds_byte(int r, int c) { const int st = (r >> 4) * 2 + (c >> 5), rr = r & 15, cc = c & 31, ob = rr * 64 + cc * 2; return st * 1024 + (ob ^ (((ob >> 9) & 1) << 5)); }
__host__ __device__ __forceinline__ void stage_rc(int b, int& R, int& C) { const int st = b / 1024, sb = b % 1024, swz = sb ^ (((sb >> 9) & 1) << 5); R = (st >> 1) * 16 + swz / 64; C = (st & 1) * 32 + (swz % 64) / 2; }
__host__ __device__ __forceinline__ int perm32(int rho) { const int n = rho >> 4, i = rho & 15; return 8 * (i >> 2) + 4 * n + (i & 3); }

struct Unit { int pm, pn; };
struct Gemm { const bf16_t* A; const bf16_t* Bt; int M, N, K; };

struct StaticOrder {
    int nM, nN, nwg, G, c;
    __host__ __device__ void init(int M, int N, int G_, int c_) { nM = M / BM; nN = N / BM; nwg = nM * nN; G = G_; c = c_; }
    __host__ __device__ bool next(int i, Unit& u) const {
        const long L = (long)i * G + c; if (L >= nwg) return false;
        int wgid = (int)L; { const int q = nwg / NXCD, r = nwg % NXCD, xcd = wgid % NXCD, off = wgid / NXCD; wgid = (xcd < r ? xcd * (q + 1) : r * (q + 1) + (xcd - r) * q) + off; }
        const int nig = WGM * nN, gid = wgid / nig, fm = gid * WGM, gsz = (nM - fm) < WGM ? (nM - fm) : WGM;
        u.pm = fm + ((wgid % nig) % gsz); u.pn = (wgid % nig) / gsz; return true;
    }
    __device__ __forceinline__ void a_ready(const Unit&) const {}
    __device__ __forceinline__ void done(const Unit&) const {}
};

__device__ __forceinline__ unsigned cvt_pk_bf16(float lo, float hi) { unsigned r; asm volatile("v_cvt_pk_bf16_f32 %0, %1, %2" : "=v"(r) : "v"(lo), "v"(hi)); return r; }
typedef float f32x2 __attribute__((ext_vector_type(2)));
__device__ __forceinline__ f32x2 gelu_pk(f32x2 v) {
    const f32x2 av = __builtin_elementwise_abs(v), d = av * 0.2316418882f + 1.0f;
    f32x2 t; t.x = __builtin_amdgcn_rcpf(d.x); t.y = __builtin_amdgcn_rcpf(d.y);
    f32x2 q = t * 0.5307027145f + (-0.7265760135f); q = q * t + 0.7107068705f; q = q * t + (-0.142248368f); q = q * t + 0.127414796f; q = q * t;
    const f32x2 s = (v * v) * (-0.72134752044f);
    f32x2 e; e.x = __builtin_amdgcn_exp2f(s.x); e.y = __builtin_amdgcn_exp2f(s.y);
    const f32x2 m = v * (q * e), r = v - m;
    f32x2 o; o.x = v.x < 0.f ? m.x : r.x; o.y = v.y < 0.f ? m.y : r.y; return o;
}

template <int ACT  > struct EpiBf16 {
    static constexpr bool PERM = true, AFTER_DRAIN = false; static_assert(ACT == 0 || ACT == 1, "EpiBf16: ACT is 0 (none) or 1 (gelu_pk)");
    bf16_t* O; int ldc; const float* bias; int split_cols; size_t split_stride; float scale0;
    __device__ __forceinline__ void operator()(const f32x4 (&acc)[2][2][4][2], const Unit& u, int wr, int wc, int fr, int fq) const {
        const int row0 = u.pm * BM + wr * 64 + fr; int colt = u.pn * BM; bf16_t* base = O;
        float sc = 1.f; if (split_cols) { const int t = colt / split_cols; base += (size_t)t * split_stride; colt -= t * split_cols; if (t == 0) sc = scale0; }
        const int col0 = colt + wc * 32 + 8 * fq, bcol0 = u.pn * BM + wc * 32 + 8 * fq;
        f32x4 bv[2][2];
#pragma unroll
        for (int bj = 0; bj < 2; ++bj)
#pragma unroll
            for (int n = 0; n < 2; ++n) bv[bj][n] = bias ? *(const f32x4*)(bias + bcol0 + bj * HALF + 4 * n) : (f32x4){0.f, 0.f, 0.f, 0.f};
#pragma unroll
        for (int ai = 0; ai < 2; ++ai)
#pragma unroll
            for (int m = 0; m < 4; ++m) { bf16_t* rowp = base + (size_t)(row0 + ai * HALF + m * 16) * ldc + col0;
#pragma unroll
                for (int bj = 0; bj < 2; ++bj) { f32x4 v0 = acc[ai][bj][m][0] + bv[bj][0], v1 = acc[ai][bj][m][1] + bv[bj][1];
                    if (ACT == 1) { f32x2 a = gelu_pk((f32x2){v0[0], v0[1]}), b = gelu_pk((f32x2){v0[2], v0[3]}), c = gelu_pk((f32x2){v1[0], v1[1]}), d = gelu_pk((f32x2){v1[2], v1[3]});
                        v0 = (f32x4){a.x, a.y, b.x, b.y}; v1 = (f32x4){c.x, c.y, d.x, d.y}; }
                    v0 = v0 * sc; v1 = v1 * sc; u32x4 w; w.x = cvt_pk_bf16(v0[0], v0[1]); w.y = cvt_pk_bf16(v0[2], v0[3]); w.z = cvt_pk_bf16(v1[0], v1[1]); w.w = cvt_pk_bf16(v1[2], v1[3]);
                    *(u32x4*)(rowp + bj * HALF) = w; } }
    }
};
struct EpiResid {
    static constexpr bool PERM = false, AFTER_DRAIN = false;
    float* C; int ldc; const float* resA; const float* resB; int rowsA; int rowsValid; float alpha;
    __device__ __forceinline__ void operator()(const f32x4 (&acc)[2][2][4][2], const Unit& u, int wr, int wc, int fr, int fq) const {
        const int row0 = u.pm * BM + wr * 64 + fr, col0 = u.pn * BM + wc * 32 + 4 * fq;
#pragma unroll
        for (int ai = 0; ai < 2; ++ai)
#pragma unroll
            for (int m = 0; m < 4; ++m) { const int r = row0 + ai * HALF + m * 16;
                if (r < rowsValid) {
                    const float* rp = (r < rowsA) ? resA + (size_t)r * ldc + col0 : resB + (size_t)(r - rowsA) * ldc + col0;
                    float* cp = C + (size_t)r * ldc + col0;
#pragma unroll
                    for (int bj = 0; bj < 2; ++bj)
#pragma unroll
                        for (int n = 0; n < 2; ++n) { const f32x4 rv = *(const f32x4*)(rp + bj * HALF + n * 16); *(f32x4*)(cp + bj * HALF + n * 16) = rv * alpha + acc[ai][bj][m][n]; } }
                asm volatile("" ::: "memory"); }
    }
};


template <class Epi, class Sched, bool ALIGN_EPI = false, bool SP2 = false>
__device__ __forceinline__ void gemm_phase(PG8_LAS unsigned char* lds, const Gemm g, const Sched& S, const Epi& E) {
    const int tid = threadIdx.x, wid = __builtin_amdgcn_readfirstlane(tid >> 6), lane = tid & 63, wr = wid >> 2, wc = wid & 3, fr = lane & 15, fq = lane >> 4;
    const int K = g.K, nt = K / BK;
    unsigned voffA[2], voffB[2];
#pragma unroll
    for (int i = 0; i < 2; ++i) { int R, C; stage_rc(tid * 16 + i * 8192, R, C); const int Rb = Epi::PERM ? ((R & ~31) + perm32(R & 31)) : R;
        voffA[i] = (unsigned)(R * K + C) * 2u; voffB[i] = (unsigned)(Rb * K + C) * 2u; }
    const size_t kstep = (size_t)(BK * 2);
    const size_t hstep = (size_t)HALF * K * 2;
    const size_t tstep = 2 * hstep;
    const unsigned ldsw = (unsigned)wid * 1024u;
    const int aoff = lds_byte(wr * 64 + fr, fq * 8), boff = lds_byte(wc * 32 + fr, fq * 8);
#define PG8_SA(b, h) (((b) * 2 + (h)) * HTB)
#define PG8_SB(b, h) ((4 + (b) * 2 + (h)) * HTB)
#define PG8_STAGE(bufoff, gbase, voff) do { _Pragma("unroll") for (int _i = 0; _i < 2; ++_i) \
        __builtin_amdgcn_global_load_lds((const unsigned*)((const char*)(gbase) + (voff)[_i]), (PG8_LAS unsigned*)(lds + (bufoff) + ldsw + _i * 8192), 16, 0, 0); } while (0)
#define PG8_LDA(dst, b, h) do { _Pragma("unroll") for (int m = 0; m < 4; ++m) _Pragma("unroll") for (int k = 0; k < 2; ++k) dst[m][k] = *(const PG8_LAS bf16x8*)(lds + PG8_SA(b, h) + aoff + m * 2048 + k * 1024); } while (0)
#define PG8_LDB(dst, b, h) do { _Pragma("unroll") for (int n = 0; n < 2; ++n) _Pragma("unroll") for (int k = 0; k < 2; ++k) dst[n][k] = *(const PG8_LAS bf16x8*)(lds + PG8_SB(b, h) + boff + n * 2048 + k * 1024); } while (0)
#define PG8_MMA(ai, bj, At, Bt) do { __builtin_amdgcn_s_setprio(1); _Pragma("unroll") for (int m = 0; m < 4; ++m) _Pragma("unroll") for (int n = 0; n < 2; ++n) _Pragma("unroll") for (int k = 0; k < 2; ++k) \
        acc[ai][bj][m][n] = __builtin_amdgcn_mfma_f32_16x16x32_bf16(Bt[n][k], At[m][k], acc[ai][bj][m][n], 0, 0, 0); __builtin_amdgcn_s_setprio(0); } while (0)
#define PG8_WAIT_V(n) asm volatile("s_waitcnt vmcnt(" #n ")" ::: "memory")
#define PG8_WAIT_L(n) asm volatile("s_waitcnt lgkmcnt(" #n ")" ::: "memory")
#define PG8_BAR __builtin_amdgcn_s_barrier()
#define PG8_SCHED __builtin_amdgcn_sched_barrier(0)
    Unit cur, nxt; int ui = 0;
    if (!S.next(0, cur)) return;
    f32x4 acc[2][2][4][2];
#pragma unroll
    for (int a = 0; a < 2; ++a)
#pragma unroll
        for (int b = 0; b < 2; ++b)
#pragma unroll
            for (int m = 0; m < 4; ++m)
#pragma unroll
                for (int n = 0; n < 2; ++n) acc[a][b][m][n] = (f32x4){0.f, 0.f, 0.f, 0.f};
    bf16x8 At[4][2], B0[2][2], B1[2][2];
    const char* cA = (const char*)g.A + (size_t)cur.pm * tstep; const char* cB = (const char*)g.Bt + (size_t)cur.pn * tstep;
    S.a_ready(cur);
    if constexpr (SP2) {
        PG8_STAGE(PG8_SB(0, 0), cB, voffB); PG8_STAGE(PG8_SB(0, 1), cB + hstep, voffB); PG8_STAGE(PG8_SA(0, 0), cA, voffA); PG8_STAGE(PG8_SA(0, 1), cA + hstep, voffA);
        if (wr == 1) PG8_BAR;
        PG8_WAIT_V(2); PG8_BAR;
        PG8_STAGE(PG8_SB(1, 0), cB + kstep, voffB); PG8_STAGE(PG8_SA(1, 0), cA + kstep, voffA); PG8_STAGE(PG8_SB(1, 1), cB + hstep + kstep, voffB);
        PG8_WAIT_V(6); PG8_BAR;
    } else {
        PG8_STAGE(PG8_SB(0, 0), cB, voffB); PG8_STAGE(PG8_SA(0, 0), cA, voffA); PG8_STAGE(PG8_SB(0, 1), cB + hstep, voffB); PG8_STAGE(PG8_SA(0, 1), cA + hstep, voffA);
        if (wr == 1) PG8_BAR;
        PG8_WAIT_V(4); PG8_BAR;
        PG8_STAGE(PG8_SB(1, 0), cB + kstep, voffB); PG8_STAGE(PG8_SA(1, 0), cA + kstep, voffA); PG8_STAGE(PG8_SB(1, 1), cB + hstep + kstep, voffB);
        PG8_WAIT_V(6); PG8_BAR;
    }
    for (;;) {
        const bool has_next = S.next(ui + 1, nxt);
        const char* nA = has_next ? (const char*)g.A + (size_t)nxt.pm * tstep : cA; const char* nB = has_next ? (const char*)g.Bt + (size_t)nxt.pn * tstep : cB;
        for (int t = 0; t < nt; t += 2) {
            const bool last = (t == nt - 2);
            const char* a1 = cA + (size_t)(t + 1) * kstep;
            const char* a2 = last ? nA : cA + (size_t)(t + 2) * kstep; const char* b2 = last ? nB : cB + (size_t)(t + 2) * kstep;
            const char* a3 = a2 + kstep; const char* b3 = b2 + kstep;
            if (last && has_next) S.a_ready(nxt);
            if constexpr (SP2) {
            PG8_LDB(B0, 0, 0); PG8_LDB(B1, 0, 1); PG8_SCHED; PG8_LDA(At, 0, 0); PG8_STAGE(PG8_SA(1, 1), a1 + hstep, voffA);
            PG8_WAIT_V(8); PG8_WAIT_L(0); PG8_BAR; PG8_MMA(0, 0, At, B0); PG8_MMA(0, 1, At, B1); PG8_BAR; PG8_SCHED;
            PG8_LDA(At, 0, 1); PG8_STAGE(PG8_SB(0, 0), b2, voffB); PG8_STAGE(PG8_SB(0, 1), b2 + hstep, voffB); PG8_STAGE(PG8_SA(0, 0), a2, voffA);
            PG8_WAIT_V(8); PG8_WAIT_L(0); PG8_BAR; PG8_MMA(1, 0, At, B0); PG8_MMA(1, 1, At, B1); PG8_BAR; PG8_SCHED;
            PG8_LDB(B0, 1, 0); PG8_LDB(B1, 1, 1); PG8_SCHED; PG8_LDA(At, 1, 0); PG8_STAGE(PG8_SA(0, 1), a2 + hstep, voffA);
            PG8_WAIT_V(8); PG8_WAIT_L(0); PG8_BAR; PG8_MMA(0, 0, At, B0); PG8_MMA(0, 1, At, B1); PG8_BAR; PG8_SCHED;
            PG8_LDA(At, 1, 1); PG8_STAGE(PG8_SB(1, 0), b3, voffB); PG8_STAGE(PG8_SB(1, 1), b3 + hstep, voffB); PG8_STAGE(PG8_SA(1, 0), a3, voffA);
            PG8_WAIT_V(8); PG8_WAIT_L(0); PG8_BAR; PG8_MMA(1, 0, At, B0); PG8_MMA(1, 1, At, B1); PG8_BAR; PG8_SCHED;
            } else {
            PG8_LDB(B0, 0, 0); PG8_SCHED; PG8_LDA(At, 0, 0); PG8_STAGE(PG8_SA(1, 1), a1 + hstep, voffA);
            PG8_WAIT_L(8); PG8_BAR; PG8_WAIT_L(0); PG8_MMA(0, 0, At, B0); PG8_BAR; PG8_SCHED;
            PG8_LDB(B1, 0, 1); PG8_STAGE(PG8_SB(0, 0), b2, voffB);
            PG8_BAR; PG8_WAIT_L(0); PG8_MMA(0, 1, At, B1); PG8_BAR;
            PG8_LDA(At, 0, 1); PG8_STAGE(PG8_SA(0, 0), a2, voffA);
            PG8_BAR; PG8_WAIT_L(0); PG8_MMA(1, 0, At, B0); PG8_BAR; PG8_SCHED;
            PG8_STAGE(PG8_SB(0, 1), b2 + hstep, voffB);
            PG8_WAIT_V(6); PG8_BAR; PG8_MMA(1, 1, At, B1); PG8_BAR;
            PG8_LDB(B0, 1, 0); PG8_SCHED; PG8_LDA(At, 1, 0); PG8_STAGE(PG8_SA(0, 1), a2 + hstep, voffA);
            PG8_WAIT_L(8); PG8_BAR; PG8_WAIT_L(0); PG8_MMA(0, 0, At, B0); PG8_BAR; PG8_SCHED;
            PG8_LDB(B1, 1, 1); PG8_STAGE(PG8_SB(1, 0), b3, voffB);
            PG8_BAR; PG8_WAIT_L(0); PG8_MMA(0, 1, At, B1); PG8_BAR;
            PG8_LDA(At, 1, 1); PG8_STAGE(PG8_SA(1, 0), a3, voffA);
            PG8_BAR; PG8_WAIT_L(0); PG8_MMA(1, 0, At, B0); PG8_BAR; PG8_SCHED;
            PG8_STAGE(PG8_SB(1, 1), b3 + hstep, voffB);
            PG8_WAIT_V(6); PG8_BAR; PG8_MMA(1, 1, At, B1); PG8_BAR;
            }
        }
        if constexpr (ALIGN_EPI) { if (wr == 0) PG8_BAR; }
        if constexpr (!Epi::AFTER_DRAIN) { E(acc, cur, wr, wc, fr, fq); S.done(cur); }
        if (!has_next) break;
#pragma unroll
        for (int a = 0; a < 2; ++a)
#pragma unroll
            for (int b = 0; b < 2; ++b)
#pragma unroll
                for (int m = 0; m < 4; ++m)
#pragma unroll
                    for (int n = 0; n < 2; ++n) acc[a][b][m][n] = (f32x4){0.f, 0.f, 0.f, 0.f};
        cur = nxt; cA = nA; cB = nB; ++ui;
        if constexpr (ALIGN_EPI) { if (wr == 1) PG8_BAR; }
    }
    PG8_WAIT_V(0);
    if constexpr (!ALIGN_EPI) { if (wr == 0) PG8_BAR; }
    PG8_BAR;
    if constexpr (Epi::AFTER_DRAIN) { E.fused(acc, cur, wr, wc, fr, fq, lds, wid, lane); S.done(cur); }
#undef PG8_SA
#undef PG8_SB
#undef PG8_STAGE
#undef PG8_LDA
#undef PG8_LDB
#undef PG8_MMA
#undef PG8_WAIT_V
#undef PG8_WAIT_L
#undef PG8_BAR
#undef PG8_SCHED
}
}
#ifndef PG8_SP2
#define PG8_SP2 true
#endif
#ifndef PG8_ALIGN
#define PG8_ALIGN true
#endif

constexpr int NWAVES = 8;
constexpr int PER_PHASE = 12;
#ifndef MK_N_LAUNCHES
#define MK_N_LAUNCHES 1
#endif
constexpr int N_LAUNCHES = MK_N_LAUNCHES;

constexpr int D = 4096, NB = 4, SEQ = 2048, NMETA = 16, DI = 8192;
constexpr int MX = NB * SEQ;
constexpr int MR = MX + NMETA;
constexpr int MP = 8448;
constexpr int N0 = 4 * DI;
constexpr int N1 = 2 * 4096 + 2 * DI;
constexpr int HG_H = 64, HG_DK = 128;
constexpr int GL_H = 8, GL_DK = 512, GL_DV = 1024, GL_R = 16;
constexpr float LN_EPS = 1e-5f, RMS_EPS = 1e-6f;
constexpr float ALPHA = 1.41421356237309515f;

constexpr size_t MiB = 1u << 20;
constexpr size_t WS_CTL = 0, CTL_ZERO_BYTES = 1 * MiB;
constexpr size_t WS_LB0 = 1 * MiB;
constexpr size_t WS_G1 = 2 * MiB;
constexpr size_t WS_WT0IN = 4 * MiB;
constexpr size_t WS_WT0OUT = WS_WT0IN + 256 * MiB;
constexpr size_t WS_WT1IN = WS_WT0OUT + 64 * MiB;
constexpr size_t WS_WT1OUT = WS_WT1IN + 192 * MiB;
constexpr size_t WS_XB = WS_WT1OUT + 64 * MiB;
constexpr size_t WS_H1B = WS_XB + 66 * MiB;
constexpr size_t WS_QFIZ = WS_H1B + 66 * MiB;
constexpr size_t WS_Y = WS_QFIZ + 528 * MiB;
constexpr size_t WS_PRE = WS_Y + 132 * MiB;
constexpr size_t WS_REC = WS_PRE + 132 * MiB;
constexpr size_t WS_REC1 = WS_REC, WS_VF1 = WS_REC + 139 * MiB, WS_O1 = WS_REC + 270 * MiB;
constexpr size_t WS_END = WS_REC + 528 * MiB;
static_assert((size_t)MP * D * 2 <= 66 * MiB && (size_t)MP * N0 * 2 <= 528 * MiB && (size_t)MP * DI * 2 <= 132 * MiB && (size_t)MP * D * 4 <= 132 * MiB && (size_t)MR * DI * 4 <= 258 * MiB, "d_ws map");
static_assert((size_t)256 * 65 * 27648 <= 440 * MiB && (size_t)32 * 65 * 69632 <= 139 * MiB && (size_t)32 * 65 * 65536 <= 131 * MiB, "record map");
constexpr int CW_BAR = 4096;

constexpr int RING_OFF = 0, RING_BYTES = 155648;
constexpr int LDSCTL_OFF = RING_BYTES, MISC_OFF = LDSCTL_OFF + 320;
constexpr int LDS_BYTES = 163840;
static_assert(MISC_OFF + 128 <= LDS_BYTES, "LDS map");

#define GAS __attribute__((address_space(1)))
#define LAS __attribute__((address_space(3)))
typedef unsigned short bf16;
typedef unsigned v4u __attribute__((ext_vector_type(4)));
typedef unsigned v2u __attribute__((ext_vector_type(2)));
typedef float f32x4 __attribute__((ext_vector_type(4)));
typedef GAS unsigned gu32;
#define RLX_AGENT __ATOMIC_RELAXED, __HIP_MEMORY_SCOPE_AGENT
#define LDS_WAIT() asm volatile("s_waitcnt lgkmcnt(0)" ::: "memory")
#define DI_ __device__ __forceinline__
DI_ unsigned f2bf(float f) { unsigned u = __builtin_bit_cast(unsigned, f); return (u + 0x7fffu + ((u >> 16) & 1u)) >> 16; }
DI_ unsigned pk2(float lo, float hi) { return f2bf(lo) | (f2bf(hi) << 16); }
DI_ float bflo(unsigned w) { return __builtin_bit_cast(float, w << 16); }
DI_ float bfhi(unsigned w) { return __builtin_bit_cast(float, w & 0xffff0000u); }
DI_ float bf2f(bf16 b) { return __builtin_bit_cast(float, (unsigned)b << 16); }
DI_ float sigm(float x) { return 1.f / (1.f + __expf(-x)); }
DI_ float silu(float x) { return x / (1.f + __expf(-x)); }

#define XB_TMO      128
#define XB_XCNT(j)  (256  + 64 * (j))
#define XB_XSUB(j)  (1280 + 64 * (j))
#define XB_XGEN(j)  (2304 + 64 * (j))
#define XB_TOP      3328
#define XB_TOPGEN   3392
#define XCD_BAR_WORDS 3456
#define XB_SPIN_CAP (1u << 18)

__device__ __forceinline__ unsigned xb_ld(unsigned* p)              { return __hip_atomic_load(p, __ATOMIC_RELAXED, __HIP_MEMORY_SCOPE_AGENT); }
__device__ __forceinline__ unsigned xb_add(unsigned* p, unsigned v) { return __hip_atomic_fetch_add(p, v, __ATOMIC_RELAXED, __HIP_MEMORY_SCOPE_AGENT); }
__device__ __forceinline__ unsigned xb_xcc_id() { return (unsigned)__builtin_amdgcn_s_getreg((3 << 11) | 20) & 0xFu; }
#define XB_SPIN(cond, bar) do { unsigned _sp = 0; while (cond) { __builtin_amdgcn_s_sleep(1); \
    if ((++_sp & 255u) == 0u) { if (xb_ld(&(bar)[XB_TMO])) break; if (_sp > XB_SPIN_CAP) { atomicAdd(&(bar)[XB_TMO], 1u); break; } } } } while (0)

struct XcdBarrier {
    unsigned* bar; unsigned x;
    volatile LAS unsigned* st;
};
__device__ __forceinline__ XcdBarrier xcd_barrier_post(unsigned* bar, volatile LAS unsigned* st) {
    XcdBarrier b; b.bar = bar; b.x = xb_xcc_id(); b.st = st;
    if (threadIdx.x == 0) (void)xb_add(&bar[XB_XCNT(b.x)], 1u);
    return b;
}
__device__ __forceinline__ void xcd_barrier_complete(unsigned* bar, unsigned x, unsigned& nloc, unsigned& nx) {
    const unsigned G = gridDim.x * gridDim.y * gridDim.z;
    unsigned sum, cnt, mine, sp = 0u;
    for (;;) {
        sum = 0u; cnt = 0u; mine = 0u;
#pragma unroll
        for (unsigned j = 0; j < 16; ++j) { const unsigned c = xb_ld(&bar[XB_XCNT(j)]); sum += c; cnt += (c > 0u) ? 1u : 0u; mine = (j == x) ? c : mine; }
        if (sum == G) break;
        __builtin_amdgcn_s_sleep(1);
        if ((++sp & 255u) == 0u) { if (xb_ld(&bar[XB_TMO])) break; if (sp > XB_SPIN_CAP) { atomicAdd(&bar[XB_TMO], 1u); break; } }
    }
    nloc = mine > 0u ? mine : 1u; nx = cnt > 0u ? cnt : 1u;
}
__device__ __forceinline__ void xcd_barrier(const XcdBarrier& b) {
    asm volatile("s_waitcnt vmcnt(0)" ::: "memory");
    __syncthreads();
    if (threadIdx.x == 0) {
        unsigned* bar = b.bar;
        __builtin_amdgcn_s_waitcnt(0);
        unsigned nloc = b.st[0], nx = b.st[1];
        if (nloc == 0u) { xcd_barrier_complete(bar, b.x, nloc, nx); b.st[0] = nloc; b.st[1] = nx; }
        const unsigned old = xb_add(&bar[XB_XSUB(b.x)], 1u);
        const unsigned gen = old / nloc;
        if (old + 1u == (gen + 1u) * nloc) {
            __builtin_amdgcn_fence(__ATOMIC_RELEASE, "agent");
            asm volatile("s_waitcnt vmcnt(0)" ::: "memory");
            const unsigned og = xb_add(&bar[XB_TOP], 1u);
            const unsigned tg = og / nx;
            if (og + 1u == (tg + 1u) * nx) xb_add(&bar[XB_TOPGEN], 1u);
            else XB_SPIN(xb_ld(&bar[XB_TOPGEN]) == tg, bar);
            __builtin_amdgcn_fence(__ATOMIC_ACQUIRE, "agent");
            xb_add(&bar[XB_XGEN(b.x)], 1u);
            asm volatile("s_waitcnt vmcnt(0)" ::: "memory");
        } else {
            XB_SPIN(xb_ld(&bar[XB_XGEN(b.x)]) == gen, bar);
            __builtin_amdgcn_fence(__ATOMIC_ACQUIRE, "agent");
            asm volatile("s_waitcnt vmcnt(0)" ::: "memory");
        }
    }
    __syncthreads();
}

struct Frame {
    LAS unsigned char* lds;
    volatile LAS unsigned* MISC;
    gu32* ctl;
    int tid, lane, wave;
    int vcu, G;
    const float *x, *meta, *lb_logits;
    const float *w0in, *b_f, *ng0, *w0out, *ln0g, *ln0b;
    const float *w1in, *wg1, *wg2, *b_g, *ng1, *w1out, *ln1g, *ln1b;
    float* out;
    float *LB0, *G1, *PRE, *O1;
    unsigned char *REC0, *REC1, *VF1;
    bf16 *WT0IN, *WT0OUT, *WT1IN, *WT1OUT, *XB, *H1B, *QFIZ, *Y;
};

DI_ float wave_sum(float v) {
#pragma unroll
    for (int o = 1; o < 64; o <<= 1) v += __shfl_xor(v, o);
    return v;
}

DI_ void p0_transpose_item(const float* W, int K, int N, bf16* WT, LAS float* scr, int item, int lane) {
    const int nblk = N / 32, kb = item / nblk, nb = item % nblk, k0 = 64 * kb, n0 = 32 * nb;
#pragma unroll 8
    for (int i = 0; i < 32; ++i) { const int kk = 2 * i + (lane >> 5); scr[kk * 33 + (lane & 31)] = W[(size_t)(k0 + kk) * N + n0 + (lane & 31)]; }
    LDS_WAIT(); asm volatile("" ::: "memory");
    const int c = lane & 7;
#pragma unroll
    for (int j = 0; j < 4; ++j) { const int n = (lane >> 3) + 8 * j; const LAS float* s = scr + (8 * c) * 33 + n;
        v4u o; o.x = pk2(s[0 * 33], s[1 * 33]); o.y = pk2(s[2 * 33], s[3 * 33]); o.z = pk2(s[4 * 33], s[5 * 33]); o.w = pk2(s[6 * 33], s[7 * 33]);
        *(GAS v4u*)(WT + (size_t)(n0 + n) * K + k0 + 8 * c) = o; }
    LDS_WAIT(); asm volatile("" ::: "memory");
}

DI_ void p0_prologue(Frame& F) {
    LAS float* scr = (LAS float*)(F.lds + RING_OFF + F.wave * 16384);
    const int gw = F.vcu * NWAVES + F.wave, NGW = F.G * NWAVES;
    constexpr int I_0 = (D / 64) * (N0 / 32), I_1 = (DI / 64) * (D / 32), I_2 = (D / 64) * (N1 / 32), I_3 = I_1;
    constexpr int NITEMS = I_0 + I_1 + I_2 + I_3;
    for (int it = gw; it < NITEMS; it += NGW) {
        int r = it;
        if (r < I_0) { p0_transpose_item(F.w0in, D, N0, F.WT0IN, scr, r, F.lane); continue; } r -= I_0;
        if (r < I_1) { p0_transpose_item(F.w0out, DI, D, F.WT0OUT, scr, r, F.lane); continue; } r -= I_1;
        if (r < I_2) { p0_transpose_item(F.w1in, D, N1, F.WT1IN, scr, r, F.lane); continue; } r -= I_2;
        p0_transpose_item(F.w1out, DI, D, F.WT1OUT, scr, r, F.lane);
    }
    for (int m = gw; m < MP; m += NGW) {
        GAS unsigned long long* o8 = (GAS unsigned long long*)(F.XB + (size_t)m * D) + F.lane;
        if (m < MR) {
            const float* src = (m < MX) ? F.x + (size_t)m * D : F.meta + (size_t)(m - MX) * D;
            const GAS f32x4* xr = (const GAS f32x4*)src + F.lane;
#pragma unroll 4
            for (int j = 0; j < 16; ++j) { const f32x4 v = xr[64 * j]; o8[64 * j] = (unsigned long long)pk2(v.x, v.y) | ((unsigned long long)pk2(v.z, v.w) << 32); }
        } else {
#pragma unroll 4
            for (int j = 0; j < 16; ++j) o8[64 * j] = 0ull;
        }
    }
    for (int m = MR + gw; m < MP; m += NGW) {
        GAS unsigned long long* o8 = (GAS unsigned long long*)(F.H1B + (size_t)m * D) + F.lane;
#pragma unroll 4
        for (int j = 0; j < 16; ++j) o8[64 * j] = 0ull;
    }
    for (int c = gw * 64 + F.lane; c < DI; c += NGW * 64) {
        const float l0 = F.lb_logits[c], l1 = F.lb_logits[DI + c], l2 = F.lb_logits[2 * DI + c];
        const float mx = fmaxf(l0, fmaxf(l1, l2));
        const float e0 = __expf(l0 - mx), e1 = __expf(l1 - mx), e2 = __expf(l2 - mx);
        F.LB0[c] = e0 / (e0 + e1 + e2);
    }
}

DI_ void p2_l0_rec_naive(Frame& F) {
    LAS float* qs = (LAS float*)(F.lds);
    LAS float* fs = qs + 2048;
    LAS float* ks = fs + 2048;
    LAS float* vs = ks + 2048;
    LAS float* pb = vs + 2048;
    const int tid = F.tid, dv = tid & 127, kg = tid >> 7;
    const int lj = tid >> 5, lc = (tid & 31) * 4;
    for (int u = blockIdx.x; u < NB * HG_H; u += F.G) {
        const int b = u >> 6, h = u & 63;
        float S[32];
#pragma unroll
        for (int i = 0; i < 32; ++i) S[i] = 0.f;
        float lbv[4], bfv[4], ngv[4];
#pragma unroll
        for (int i = 0; i < 4; ++i) { lbv[i] = F.LB0[h * 128 + lc + i]; bfv[i] = F.b_f[h * 128 + lc + i]; ngv[i] = F.ng0[h * 128 + lc + i]; }
        for (int tb = 0; tb < 129; ++tb) {
            const int rbase = (tb == 0) ? MX : b * SEQ + 16 * (tb - 1);
            const bf16* row = F.QFIZ + (size_t)(rbase + lj) * N0 + h * 128 + lc;
            {
                const v2u q4 = *(const GAS v2u*)(row), f4 = *(const GAS v2u*)(row + DI), i4 = *(const GAS v2u*)(row + 2 * DI);
                const float qv[4] = {bflo(q4.x), bfhi(q4.x), bflo(q4.y), bfhi(q4.y)};
                const float fv[4] = {bflo(f4.x), bfhi(f4.x), bflo(f4.y), bfhi(f4.y)};
                const float iv[4] = {bflo(i4.x), bfhi(i4.x), bflo(i4.y), bfhi(i4.y)};
#pragma unroll
                for (int i = 0; i < 4; ++i) {
                    const float fg = lbv[i] + (1.f - lbv[i]) * sigm(fv[i] + bfv[i]);
                    qs[lj * 128 + lc + i] = silu(qv[i]); fs[lj * 128 + lc + i] = fg; ks[lj * 128 + lc + i] = 1.f - fg; vs[lj * 128 + lc + i] = iv[i];
                }
            }
            __syncthreads();
            for (int j = 0; j < 16; ++j) {
                const float vj = vs[j * 128 + dv]; float po = 0.f;
#pragma unroll
                for (int i = 0; i < 32; i += 4) {
                    const f32x4 f4 = *(const LAS f32x4*)(fs + j * 128 + kg * 32 + i), k4 = *(const LAS f32x4*)(ks + j * 128 + kg * 32 + i), q4 = *(const LAS f32x4*)(qs + j * 128 + kg * 32 + i);
                    S[i + 0] = f4.x * S[i + 0] + k4.x * vj; po += q4.x * S[i + 0];
                    S[i + 1] = f4.y * S[i + 1] + k4.y * vj; po += q4.y * S[i + 1];
                    S[i + 2] = f4.z * S[i + 2] + k4.z * vj; po += q4.z * S[i + 2];
                    S[i + 3] = f4.w * S[i + 3] + k4.w * vj; po += q4.w * S[i + 3];
                }
                pb[(j * 4 + kg) * 128 + dv] = po;
            }
            __syncthreads();
            {
                f32x4 o = *(const LAS f32x4*)(pb + (lj * 4 + 0) * 128 + lc);
                o += *(const LAS f32x4*)(pb + (lj * 4 + 1) * 128 + lc);
                o += *(const LAS f32x4*)(pb + (lj * 4 + 2) * 128 + lc);
                o += *(const LAS f32x4*)(pb + (lj * 4 + 3) * 128 + lc);
                float ss = o.x * o.x + o.y * o.y + o.z * o.z + o.w * o.w;
                ss += __shfl_xor(ss, 16); ss += __shfl_xor(ss, 8); ss += __shfl_xor(ss, 4); ss += __shfl_xor(ss, 2); ss += __shfl_xor(ss, 1);
                const float rs = rsqrtf(ss * (1.f / 128.f) + RMS_EPS);
                const v2u z4 = *(const GAS v2u*)(row + 3 * DI);
                const float y0 = o.x * rs * ngv[0] * silu(bflo(z4.x)), y1 = o.y * rs * ngv[1] * silu(bfhi(z4.x));
                const float y2 = o.z * rs * ngv[2] * silu(bflo(z4.y)), y3 = o.w * rs * ngv[3] * silu(bfhi(z4.y));
                if (tb > 0 || b == 0) { v2u w; w.x = pk2(y0, y1); w.y = pk2(y2, y3); *(GAS v2u*)(F.Y + (size_t)(rbase + lj) * DI + h * 128 + lc) = w; }
            }
        }
        __syncthreads();
    }
}

DI_ void ln_phase(Frame& F, const float* src, int nrows, const float* g, const float* bt, float* dst32, bf16* dstb, float* G1) {
    const int gw = F.vcu * NWAVES + F.wave, NGW = F.G * NWAVES;
    for (int r = gw; r < nrows; r += NGW) {
        const GAS f32x4* s = (const GAS f32x4*)(src + (size_t)r * D) + F.lane;
        f32x4 v[16]; float sm = 0.f;
#pragma unroll
        for (int j = 0; j < 16; ++j) { v[j] = s[64 * j]; sm += (v[j].x + v[j].y) + (v[j].z + v[j].w); }
        const float mean = wave_sum(sm) * (1.f / D); float s2 = 0.f;
#pragma unroll
        for (int j = 0; j < 16; ++j) { v[j] = v[j] - mean; s2 += (v[j].x * v[j].x + v[j].y * v[j].y) + (v[j].z * v[j].z + v[j].w * v[j].w); }
        const float rstd = rsqrtf(wave_sum(s2) * (1.f / D) + LN_EPS);
#pragma unroll
        for (int j = 0; j < 16; ++j) {
            const f32x4 gg = *((const GAS f32x4*)g + F.lane + 64 * j), bb = *((const GAS f32x4*)bt + F.lane + 64 * j);
            v[j] = v[j] * rstd * gg + bb;
            if (dst32) *((GAS f32x4*)(dst32 + (size_t)r * D) + F.lane + 64 * j) = v[j];
            if (dstb) { v2u w; w.x = pk2(v[j].x, v[j].y); w.y = pk2(v[j].z, v[j].w); *((GAS v2u*)(dstb + (size_t)r * D) + F.lane + 64 * j) = w; }
            if ((j & 3) == 3) asm volatile("" ::: "memory");
        }
        if (G1) {
            LAS float* rowbuf = (LAS float*)(F.lds + RING_OFF + F.wave * 16384);
#pragma unroll
            for (int j = 0; j < 16; ++j) *(LAS f32x4*)(rowbuf + 256 * j + 4 * F.lane) = v[j];
            LDS_WAIT(); asm volatile("" ::: "memory");
            float a[16];
#pragma unroll
            for (int q = 0; q < 16; ++q) a[q] = 0.f;
#pragma unroll 2
            for (int i = 0; i < 64; ++i) {
                const int k = 64 * i + F.lane;
                const float e = rowbuf[k];
                const GAS f32x4* w = (const GAS f32x4*)(F.wg1 + (size_t)k * GL_R);
                const f32x4 w0 = w[0], w1 = w[1], w2 = w[2], w3 = w[3];
                a[0] += e * w0.x; a[1] += e * w0.y; a[2] += e * w0.z; a[3] += e * w0.w;
                a[4] += e * w1.x; a[5] += e * w1.y; a[6] += e * w1.z; a[7] += e * w1.w;
                a[8] += e * w2.x; a[9] += e * w2.y; a[10] += e * w2.z; a[11] += e * w2.w;
                a[12] += e * w3.x; a[13] += e * w3.y; a[14] += e * w3.z; a[15] += e * w3.w;
            }
#pragma unroll
            for (int q = 0; q < 16; ++q) a[q] = wave_sum(a[q]);
            if (F.lane == 0) {
#pragma unroll
                for (int q = 0; q < 16; q += 4) *(GAS f32x4*)(G1 + (size_t)r * GL_R + q) = (f32x4){a[q], a[q + 1], a[q + 2], a[q + 3]};
            }
            LDS_WAIT(); asm volatile("" ::: "memory");
        }
    }
}

DI_ void p6_l1_rec_naive(Frame& F) {
    LAS float* qs = (LAS float*)(F.lds);
    LAS float* ks = qs + 4096;
    LAS float* gs = ks + 4096;
    LAS float* vs = gs + 4096;
    LAS float* pb = vs + 512;
    const int tid = F.tid, dv = tid & 63, kg = tid >> 6;
    const float qscale = 0.04419417382415922f;
    for (int u = blockIdx.x; u < NB * GL_H * 16; u += F.G) {
        const int dvs = u & 15, bh = u >> 4, b = bh >> 3, h = bh & 7;
        float S[64];
#pragma unroll
        for (int i = 0; i < 64; ++i) S[i] = 0.f;
        float w2[16];
#pragma unroll
        for (int r = 0; r < 16; ++r) w2[r] = F.wg2[(size_t)r * 4096 + h * 512 + tid];
        const float bg = F.b_g[h * 512 + tid];
        for (int tb = 0; tb < 258; ++tb) {
            const int rbase = (tb < 2) ? MX + 8 * tb : b * SEQ + 8 * (tb - 2);
            for (int j = 0; j < 8; ++j) {
                const size_t r = (size_t)(rbase + j);
                const float q = bf2f(F.QFIZ[r * N1 + h * 512 + tid]) * qscale, k = bf2f(F.QFIZ[r * N1 + 4096 + h * 512 + tid]);
                const float* g1 = F.G1 + r * GL_R;
                float xg = bg;
#pragma unroll
                for (int rr = 0; rr < 16; ++rr) xg += g1[rr] * w2[rr];
                const float ls = fminf(xg, 0.f) - log1pf(__expf(-fabsf(xg)));
                qs[j * 512 + tid] = q; ks[j * 512 + tid] = k; gs[j * 512 + tid] = __expf(ls * (1.f / 16.f));
            }
            vs[tid] = bf2f(F.QFIZ[(size_t)(rbase + (tid >> 6)) * N1 + 8192 + h * 1024 + dvs * 64 + (tid & 63)]);
            __syncthreads();
            for (int j = 0; j < 8; ++j) {
                const float vj = vs[j * 64 + dv]; float po = 0.f;
#pragma unroll
                for (int i = 0; i < 64; i += 4) {
                    const f32x4 g4 = *(const LAS f32x4*)(gs + j * 512 + kg * 64 + i), k4 = *(const LAS f32x4*)(ks + j * 512 + kg * 64 + i), q4 = *(const LAS f32x4*)(qs + j * 512 + kg * 64 + i);
                    S[i + 0] = g4.x * S[i + 0] + k4.x * vj; po += q4.x * S[i + 0];
                    S[i + 1] = g4.y * S[i + 1] + k4.y * vj; po += q4.y * S[i + 1];
                    S[i + 2] = g4.z * S[i + 2] + k4.z * vj; po += q4.z * S[i + 2];
                    S[i + 3] = g4.w * S[i + 3] + k4.w * vj; po += q4.w * S[i + 3];
                    if ((i & 12) == 12) asm volatile("" ::: "memory");
                }
                pb[(j * 8 + kg) * 64 + dv] = po;
            }
            __syncthreads();
            {
                const int j = tid >> 6, d = tid & 63; float o = 0.f;
#pragma unroll
                for (int g = 0; g < 8; ++g) o += pb[(j * 8 + g) * 64 + d];
                if (tb >= 2 || b == 0) F.O1[(size_t)(rbase + j) * DI + h * 1024 + dvs * 64 + d] = o;
            }
        }
        __syncthreads();
    }
}

DI_ void p7_normgate(Frame& F) {
    const int gw = F.vcu * NWAVES + F.wave, NGW = F.G * NWAVES;
    for (int it = gw; it < MX * GL_H; it += NGW) {
        const int r = it >> 3, h = it & 7;
        const GAS f32x4* o = (const GAS f32x4*)(F.O1 + (size_t)r * DI + h * 1024) + F.lane;
        f32x4 v[4]; float ss = 0.f;
#pragma unroll
        for (int j = 0; j < 4; ++j) { v[j] = o[64 * j]; ss += (v[j].x * v[j].x + v[j].y * v[j].y) + (v[j].z * v[j].z + v[j].w * v[j].w); }
        const float rs = rsqrtf(wave_sum(ss) * (1.f / 1024.f) + RMS_EPS);
#pragma unroll
        for (int j = 0; j < 4; ++j) {
            const int c = h * 1024 + 256 * j + 4 * F.lane;
            const v2u z4 = *(const GAS v2u*)(F.QFIZ + (size_t)r * N1 + 16384 + c);
            const f32x4 ng = *(const GAS f32x4*)(F.ng1 + c);
            v2u w; w.x = pk2(v[j].x * rs * ng.x * silu(bflo(z4.x)), v[j].y * rs * ng.y * silu(bfhi(z4.x)));
            w.y = pk2(v[j].z * rs * ng.z * silu(bflo(z4.y)), v[j].w * rs * ng.w * silu(bfhi(z4.y)));
            *(GAS v2u*)(F.Y + (size_t)r * DI + c) = w;
        }
    }
}

typedef short bf16x8 __attribute__((ext_vector_type(8)));
constexpr int NCH = 65;
constexpr float LOG2E = 1.4426950408889634f;
constexpr int R1_QD = 0, R1_KD = 32768, R1_P = 65536, R1_GL = 67584, R1_SH = 69632;
constexpr int ST1 = R1_SH + 8192;
constexpr int R0_QD = 0, R0_KD = 8192, R0_P = 16384, R0_V = 18432, R0_GL = 26624, R0_SZ = 27648;
constexpr int ST0 = R0_SZ;

DI_ unsigned cvtpk(float lo, float hi) { unsigned r; asm volatile("v_cvt_pk_bf16_f32 %0, %1, %2" : "=v"(r) : "v"(lo), "v"(hi)); return r; }
template <int N> DI_ float row_shr(float x) { return __builtin_bit_cast(float, __builtin_amdgcn_update_dpp(0, __builtin_bit_cast(int, x), 0x110 + N, 0xF, 0xF, true)); }
DI_ float scan16(float x) { x += row_shr<1>(x); x += row_shr<2>(x); x += row_shr<4>(x); x += row_shr<8>(x); return x; }
DI_ float ex2(float x) { return __builtin_amdgcn_exp2f(x); }
DI_ float lg2(float x) { return __builtin_amdgcn_logf(x); }
DI_ int row_of(int b, int c, int tok) { return c == 0 ? MX + tok - 16 : b * SEQ + 32 * (c - 1) + tok; }
DI_ bf16x8 mk8(unsigned a, unsigned b, unsigned c, unsigned d) { v4u t; t.x = a; t.y = b; t.z = c; t.w = d; return __builtin_bit_cast(bf16x8, t); }
#define MFMA16(a, b, c) __builtin_amdgcn_mfma_f32_16x16x32_bf16((a), (b), (c), 0, 0, 0)

DI_ void l1_prep(Frame& F, unsigned char* REC1, unsigned char* VF1) {
    const int lane = F.lane, w = F.wave, r = lane & 15, g = lane >> 4;
    LAS unsigned char* T = F.lds + w * 16384;
    LAS unsigned char* Tv = F.lds + w * 16384 + 4096;
    LAS f32x4* Pp = (LAS f32x4*)(F.lds + 131072);
    const float qscale = 0.04419417382415922f;
    for (int it = blockIdx.x; it < NB * GL_H * NCH; it += F.G) {
        const int bh = it / NCH, c = it - bh * NCH, b = bh >> 3, h = bh & 7;
        unsigned char* rec = REC1 + (size_t)it * R1_SH;
        int row[2]; bool nul[2];
#pragma unroll
        for (int ti = 0; ti < 2; ++ti) { const int tok = 16 * ti + r; nul[ti] = (c == 0 && tok < 16); row[ti] = nul[ti] ? 0 : row_of(b, c, tok); }
        float g1v[2][16];
#pragma unroll
        for (int ti = 0; ti < 2; ++ti) {
            const GAS f32x4* gp = (const GAS f32x4*)(F.G1 + (size_t)row[ti] * GL_R);
#pragma unroll
            for (int q = 0; q < 4; ++q) { const f32x4 t = gp[q]; g1v[ti][4 * q] = t.x; g1v[ti][4 * q + 1] = t.y; g1v[ti][4 * q + 2] = t.z; g1v[ti][4 * q + 3] = t.w; }
        }
        f32x4 pacc[3];
#pragma unroll
        for (int t = 0; t < 3; ++t) pacc[t] = (f32x4){0.f, 0.f, 0.f, 0.f};
#pragma unroll 1
        for (int si = 0; si < 2; ++si) {
            const int s = 2 * w + si, col = h * 512 + 32 * s + 8 * g;
            float xg[2][8];
            { const f32x4 b0 = *(const GAS f32x4*)(F.b_g + col), b1 = *(const GAS f32x4*)(F.b_g + col + 4);
#pragma unroll
              for (int ti = 0; ti < 2; ++ti) { xg[ti][0] = b0.x; xg[ti][1] = b0.y; xg[ti][2] = b0.z; xg[ti][3] = b0.w; xg[ti][4] = b1.x; xg[ti][5] = b1.y; xg[ti][6] = b1.z; xg[ti][7] = b1.w; } }
#pragma unroll
            for (int rr = 0; rr < 16; ++rr) {
                const f32x4 w0 = *(const GAS f32x4*)(F.wg2 + (size_t)rr * 4096 + col), w1 = *(const GAS f32x4*)(F.wg2 + (size_t)rr * 4096 + col + 4);
                const float wv[8] = {w0.x, w0.y, w0.z, w0.w, w1.x, w1.y, w1.z, w1.w};
#pragma unroll
                for (int ti = 0; ti < 2; ++ti)
#pragma unroll
                    for (int e = 0; e < 8; ++e) xg[ti][e] += g1v[ti][rr] * wv[e];
                if ((rr & 3) == 3) asm volatile("" ::: "memory");
            }
            float qv[2][8], kv[2][8];
#pragma unroll
            for (int ti = 0; ti < 2; ++ti) {
                const v4u q4 = *(const GAS v4u*)(F.QFIZ + (size_t)row[ti] * N1 + col), k4 = *(const GAS v4u*)(F.QFIZ + (size_t)row[ti] * N1 + 4096 + col);
                qv[ti][0] = bflo(q4.x); qv[ti][1] = bfhi(q4.x); qv[ti][2] = bflo(q4.y); qv[ti][3] = bfhi(q4.y); qv[ti][4] = bflo(q4.z); qv[ti][5] = bfhi(q4.z); qv[ti][6] = bflo(q4.w); qv[ti][7] = bfhi(q4.w);
                kv[ti][0] = bflo(k4.x); kv[ti][1] = bfhi(k4.x); kv[ti][2] = bflo(k4.y); kv[ti][3] = bfhi(k4.y); kv[ti][4] = bflo(k4.z); kv[ti][5] = bfhi(k4.z); kv[ti][6] = bflo(k4.w); kv[ti][7] = bfhi(k4.w);
            }
            unsigned qd[2][4], ki[2][4], kd[2][4]; float gl[8];
#pragma unroll
            for (int e = 0; e < 8; e += 2) {
                float bb[2][2], BB[2];
#pragma unroll
                for (int u = 0; u < 2; ++u) {
                    float L0 = nul[0] ? 0.f : (fminf(xg[0][e + u], 0.f) * LOG2E - lg2(1.f + ex2(-fabsf(xg[0][e + u]) * LOG2E))) * (1.f / 16.f);
                    float L1 = nul[1] ? 0.f : (fminf(xg[1][e + u], 0.f) * LOG2E - lg2(1.f + ex2(-fabsf(xg[1][e + u]) * LOG2E))) * (1.f / 16.f);
                    const float b0 = scan16(L0);
                    const float b1 = scan16(L1) + __shfl(b0, (lane & 48) | 15);
                    bb[0][u] = b0; bb[1][u] = b1; BB[u] = __shfl(b1, (lane & 48) | 15);
                    gl[e + u] = ex2(BB[u]);
                }
#pragma unroll
                for (int ti = 0; ti < 2; ++ti) {
                    const float q0 = nul[ti] ? 0.f : qv[ti][e] * qscale, q1 = nul[ti] ? 0.f : qv[ti][e + 1] * qscale;
                    const float k0 = nul[ti] ? 0.f : kv[ti][e], k1 = nul[ti] ? 0.f : kv[ti][e + 1];
                    qd[ti][e >> 1] = cvtpk(q0 * ex2(bb[ti][0]), q1 * ex2(bb[ti][1]));
                    ki[ti][e >> 1] = cvtpk(k0 * ex2(-bb[ti][0]), k1 * ex2(-bb[ti][1]));
                    kd[ti][e >> 1] = cvtpk(k0 * ex2(BB[0] - bb[ti][0]), k1 * ex2(BB[1] - bb[ti][1]));
                }
            }
            const bf16x8 qf0 = mk8(qd[0][0], qd[0][1], qd[0][2], qd[0][3]), qf1 = mk8(qd[1][0], qd[1][1], qd[1][2], qd[1][3]);
            const bf16x8 kf0 = mk8(ki[0][0], ki[0][1], ki[0][2], ki[0][3]), kf1 = mk8(ki[1][0], ki[1][1], ki[1][2], ki[1][3]);
            pacc[0] = MFMA16(kf0, qf0, pacc[0]);
            pacc[1] = MFMA16(kf0, qf1, pacc[1]);
            pacc[2] = MFMA16(kf1, qf1, pacc[2]);
#pragma unroll
            for (int ti = 0; ti < 2; ++ti)
#pragma unroll
                for (int h2 = 0; h2 < 2; ++h2) {
                    const int lp = (2 * (g & 1) + h2) * 16 + r;
                    v2u d; d.x = qd[ti][2 * h2]; d.y = qd[ti][2 * h2 + 1];
                    *(GAS v2u*)(rec + R1_QD + ((ti * 16 + s) * 64 + lp) * 16 + (g >> 1) * 8) = d;
                }
#pragma unroll
            for (int ti = 0; ti < 2; ++ti)
#pragma unroll
                for (int e = 0; e < 8; ++e) {
                    const unsigned wd = kd[ti][e >> 1]; const unsigned short hv = (e & 1) ? (unsigned short)(wd >> 16) : (unsigned short)(wd & 0xffffu);
                    *(LAS unsigned short*)(T + (32 * si + 8 * g + e) * 64 + (16 * ti + r) * 2) = hv;
                }
            if (r == 0) { *(GAS f32x4*)(rec + R1_GL + (32 * s + 8 * g) * 4) = (f32x4){gl[0], gl[1], gl[2], gl[3]}; *(GAS f32x4*)(rec + R1_GL + (32 * s + 8 * g + 4) * 4) = (f32x4){gl[4], gl[5], gl[6], gl[7]}; }
        }
#pragma unroll
        for (int t = 0; t < 3; ++t) Pp[(w * 3 + t) * 64 + lane] = pacc[t];
#pragma unroll
        for (int i = 0; i < 8; ++i) {
            const int q = lane + 64 * i, tk = q >> 4, c16 = q & 15; const bool nl = (c == 0 && tk < 16);
            v4u d = (v4u){0u, 0u, 0u, 0u};
            if (!nl) d = *(const GAS v4u*)(F.QFIZ + (size_t)row_of(b, c, tk) * N1 + 8192 + h * 1024 + 128 * w + 8 * c16);
            *(LAS v2u*)(Tv + tk * 264 + c16 * 16) = (v2u){d.x, d.y}; *(LAS v2u*)(Tv + tk * 264 + c16 * 16 + 8) = (v2u){d.z, d.w};
        }
        LDS_WAIT(); asm volatile("" ::: "memory");
#pragma unroll
        for (int ml = 0; ml < 4; ++ml) { const v4u d = *(const LAS v4u*)(T + (16 * ml + r) * 64 + 16 * g); *(GAS v4u*)(rec + R1_KD + ((4 * w + ml) * 64 + lane) * 16) = d; }
#pragma unroll
        for (int sl = 0; sl < 8; ++sl) {
            unsigned short hv[8];
#pragma unroll
            for (int e = 0; e < 8; ++e) hv[e] = *(const LAS unsigned short*)(Tv + (8 * g + e) * 264 + (16 * sl + r) * 2);
            v4u d; d.x = hv[0] | ((unsigned)hv[1] << 16); d.y = hv[2] | ((unsigned)hv[3] << 16); d.z = hv[4] | ((unsigned)hv[5] << 16); d.w = hv[6] | ((unsigned)hv[7] << 16);
            *(GAS v4u*)(VF1 + ((size_t)it * 64 + 8 * w + sl) * 1024 + lane * 16) = d;
        }
        __syncthreads();
        if (w < 4) {
            const int tj = (w == 2 || w == 3) ? 1 : 0, ti = (w == 1 || w == 2) ? 1 : 0;
            f32x4 sum = (f32x4){0.f, 0.f, 0.f, 0.f};
            if (w < 3) {
#pragma unroll
                for (int ww = 0; ww < 8; ++ww) sum += Pp[(ww * 3 + w) * 64 + lane];
            }
            float pv[4] = {sum.x, sum.y, sum.z, sum.w};
#pragma unroll
            for (int jj = 0; jj < 4; ++jj) { const int j = 16 * tj + 4 * g + jj, i = 16 * ti + r; if (j > i) pv[jj] = 0.f; }
            const int lp = (2 * tj + (g >> 1)) * 16 + r;
            v2u d; d.x = cvtpk(pv[0], pv[1]); d.y = cvtpk(pv[2], pv[3]);
            *(GAS v2u*)(rec + R1_P + (ti * 64 + lp) * 16 + 8 * (g & 1)) = d;
        }
        __syncthreads();
    }
}

DI_ void l1_seq(Frame& F, const unsigned char* REC1, const unsigned char* VF1, float* O1) {
    const int lane = F.lane, w = F.wave, r = lane & 15, g = lane >> 4;
    for (int u = F.vcu; u < NB * GL_H * 8; u += F.G) {
        const int bh = u >> 3, ds = u & 7, b = bh >> 3, h = bh & 7;
        f32x4 acc[32];
#pragma unroll
        for (int m = 0; m < 32; ++m) acc[m] = (f32x4){0.f, 0.f, 0.f, 0.f};
#define L1_DMA(c_) do { const unsigned char* rs_ = REC1 + (size_t)(bh * NCH + (c_)) * R1_SH; const unsigned char* vs_ = VF1 + ((size_t)(bh * NCH + (c_)) * 64 + ds * 8) * 1024; \
        LAS unsigned char* st_ = F.lds + ((c_) & 1) * ST1; \
        for (int p_ = w; p_ < 76; p_ += 8) { const unsigned char* src_ = (p_ < 68) ? rs_ + p_ * 1024 : vs_ + (p_ - 68) * 1024; \
            __builtin_amdgcn_global_load_lds((const unsigned*)(src_ + lane * 16), (LAS unsigned*)(st_ + p_ * 1024), 16, 0, 0); } } while (0)
        L1_DMA(0);
        for (int c = 0; c < NCH; ++c) {
            asm volatile("s_waitcnt vmcnt(0)" ::: "memory");
            __builtin_amdgcn_s_barrier();
            asm volatile("" ::: "memory");
            if (c + 1 < NCH) L1_DMA(c + 1);
            const LAS unsigned char* st = F.lds + (c & 1) * ST1;
            const bf16x8 vf = *(const LAS bf16x8*)(st + R1_SH + w * 1024 + lane * 16);
            if (c > 0) {
                f32x4 o0 = (f32x4){0.f, 0.f, 0.f, 0.f}, o1 = o0;
                o0 = MFMA16(*(const LAS bf16x8*)(st + R1_P + lane * 16), vf, o0);
                o1 = MFMA16(*(const LAS bf16x8*)(st + R1_P + 1024 + lane * 16), vf, o1);
#pragma unroll
                for (int s = 0; s < 16; ++s) {
                    const bf16x8 sb = mk8(cvtpk(acc[2 * s].x, acc[2 * s].y), cvtpk(acc[2 * s].z, acc[2 * s].w), cvtpk(acc[2 * s + 1].x, acc[2 * s + 1].y), cvtpk(acc[2 * s + 1].z, acc[2 * s + 1].w));
                    o0 = MFMA16(*(const LAS bf16x8*)(st + R1_QD + s * 1024 + lane * 16), sb, o0);
                    o1 = MFMA16(*(const LAS bf16x8*)(st + R1_QD + (16 + s) * 1024 + lane * 16), sb, o1);
                }
                float* op = O1 + (size_t)(b * SEQ + 32 * (c - 1) + 4 * g) * DI + h * 1024 + ds * 128 + 16 * w + r;
                op[0] = o0.x; op[(size_t)DI] = o0.y; op[(size_t)2 * DI] = o0.z; op[(size_t)3 * DI] = o0.w;
                op[(size_t)16 * DI] = o1.x; op[(size_t)17 * DI] = o1.y; op[(size_t)18 * DI] = o1.z; op[(size_t)19 * DI] = o1.w;
            }
#pragma unroll
            for (int m = 0; m < 32; ++m) {
                const f32x4 gl4 = *(const LAS f32x4*)(st + R1_GL + (16 * m + 4 * g) * 4);
                acc[m] = MFMA16(*(const LAS bf16x8*)(st + R1_KD + m * 1024 + lane * 16), vf, acc[m] * gl4);
            }
        }
#undef L1_DMA
        asm volatile("s_waitcnt vmcnt(0)" ::: "memory");
        __builtin_amdgcn_s_barrier();
    }
}

DI_ void l0_prep(Frame& F, unsigned char* REC0) {
    const int lane = F.lane, w = F.wave, r = lane & 15, g = lane >> 4;
    LAS unsigned char* T = F.lds + w * 16640;
    LAS unsigned char* Tv = T + 8192;
    const int gw = F.vcu * NWAVES + w, NGW = F.G * NWAVES;
    for (int it = gw; it < NB * HG_H * NCH; it += NGW) {
        const int bh = it / NCH, c = it - bh * NCH, b = bh >> 6, h = bh & 63;
        unsigned char* rec = REC0 + (size_t)it * R0_SZ;
        int row[2]; bool nul[2];
#pragma unroll
        for (int ti = 0; ti < 2; ++ti) { const int tok = 16 * ti + r; nul[ti] = (c == 0 && tok < 16); row[ti] = nul[ti] ? 0 : row_of(b, c, tok); }
        f32x4 pacc[3];
#pragma unroll
        for (int t = 0; t < 3; ++t) pacc[t] = (f32x4){0.f, 0.f, 0.f, 0.f};
#pragma unroll
        for (int s = 0; s < 4; ++s) {
            const int col = h * 128 + 32 * s + 8 * g;
            float lbv[8], bfv[8];
            { const f32x4 a0 = *(const GAS f32x4*)(F.LB0 + col), a1 = *(const GAS f32x4*)(F.LB0 + col + 4), c0 = *(const GAS f32x4*)(F.b_f + col), c1 = *(const GAS f32x4*)(F.b_f + col + 4);
              lbv[0] = a0.x; lbv[1] = a0.y; lbv[2] = a0.z; lbv[3] = a0.w; lbv[4] = a1.x; lbv[5] = a1.y; lbv[6] = a1.z; lbv[7] = a1.w;
              bfv[0] = c0.x; bfv[1] = c0.y; bfv[2] = c0.z; bfv[3] = c0.w; bfv[4] = c1.x; bfv[5] = c1.y; bfv[6] = c1.z; bfv[7] = c1.w; }
            float qv[2][8], fv[2][8];
#pragma unroll
            for (int ti = 0; ti < 2; ++ti) {
                const v4u q4 = *(const GAS v4u*)(F.QFIZ + (size_t)row[ti] * N0 + col), f4 = *(const GAS v4u*)(F.QFIZ + (size_t)row[ti] * N0 + DI + col);
                qv[ti][0] = bflo(q4.x); qv[ti][1] = bfhi(q4.x); qv[ti][2] = bflo(q4.y); qv[ti][3] = bfhi(q4.y); qv[ti][4] = bflo(q4.z); qv[ti][5] = bfhi(q4.z); qv[ti][6] = bflo(q4.w); qv[ti][7] = bfhi(q4.w);
                fv[ti][0] = bflo(f4.x); fv[ti][1] = bfhi(f4.x); fv[ti][2] = bflo(f4.y); fv[ti][3] = bfhi(f4.y); fv[ti][4] = bflo(f4.z); fv[ti][5] = bfhi(f4.z); fv[ti][6] = bflo(f4.w); fv[ti][7] = bfhi(f4.w);
            }
            unsigned qd[2][4], ki[2][4], kd[2][4]; float gl[8];
#pragma unroll
            for (int e = 0; e < 8; e += 2) {
                float bb[2][2], BB[2], kk[2][2];
#pragma unroll
                for (int u = 0; u < 2; ++u) {
                    const float fg0 = lbv[e + u] + (1.f - lbv[e + u]) * sigm(fv[0][e + u] + bfv[e + u]);
                    const float fg1 = lbv[e + u] + (1.f - lbv[e + u]) * sigm(fv[1][e + u] + bfv[e + u]);
                    const float L0 = nul[0] ? 0.f : lg2(fg0), L1 = nul[1] ? 0.f : lg2(fg1);
                    kk[0][u] = nul[0] ? 0.f : 1.f - fg0; kk[1][u] = nul[1] ? 0.f : 1.f - fg1;
                    const float b0 = scan16(L0);
                    const float b1 = scan16(L1) + __shfl(b0, (lane & 48) | 15);
                    bb[0][u] = b0; bb[1][u] = b1; BB[u] = __shfl(b1, (lane & 48) | 15);
                    gl[e + u] = ex2(BB[u]);
                }
#pragma unroll
                for (int ti = 0; ti < 2; ++ti) {
                    const float q0 = nul[ti] ? 0.f : silu(qv[ti][e]), q1 = nul[ti] ? 0.f : silu(qv[ti][e + 1]);
                    qd[ti][e >> 1] = cvtpk(q0 * ex2(bb[ti][0]), q1 * ex2(bb[ti][1]));
                    ki[ti][e >> 1] = cvtpk(kk[ti][0] * ex2(-bb[ti][0]), kk[ti][1] * ex2(-bb[ti][1]));
                    kd[ti][e >> 1] = cvtpk(kk[ti][0] * ex2(BB[0] - bb[ti][0]), kk[ti][1] * ex2(BB[1] - bb[ti][1]));
                }
            }
            const bf16x8 qf0 = mk8(qd[0][0], qd[0][1], qd[0][2], qd[0][3]), qf1 = mk8(qd[1][0], qd[1][1], qd[1][2], qd[1][3]);
            const bf16x8 kf0 = mk8(ki[0][0], ki[0][1], ki[0][2], ki[0][3]), kf1 = mk8(ki[1][0], ki[1][1], ki[1][2], ki[1][3]);
            pacc[0] = MFMA16(kf0, qf0, pacc[0]);
            pacc[1] = MFMA16(kf0, qf1, pacc[1]);
            pacc[2] = MFMA16(kf1, qf1, pacc[2]);
#pragma unroll
            for (int ti = 0; ti < 2; ++ti)
#pragma unroll
                for (int h2 = 0; h2 < 2; ++h2) {
                    const int lp = (2 * (g & 1) + h2) * 16 + r;
                    v2u d; d.x = qd[ti][2 * h2]; d.y = qd[ti][2 * h2 + 1];
                    *(GAS v2u*)(rec + R0_QD + ((ti * 4 + s) * 64 + lp) * 16 + (g >> 1) * 8) = d;
                }
#pragma unroll
            for (int ti = 0; ti < 2; ++ti)
#pragma unroll
                for (int e = 0; e < 8; ++e) {
                    const unsigned wd = kd[ti][e >> 1]; const unsigned short hv = (e & 1) ? (unsigned short)(wd >> 16) : (unsigned short)(wd & 0xffffu);
                    *(LAS unsigned short*)(T + (32 * s + 8 * g + e) * 64 + (16 * ti + r) * 2) = hv;
                }
            if (r == 0) { *(GAS f32x4*)(rec + R0_GL + (32 * s + 8 * g) * 4) = (f32x4){gl[0], gl[1], gl[2], gl[3]}; *(GAS f32x4*)(rec + R0_GL + (32 * s + 8 * g + 4) * 4) = (f32x4){gl[4], gl[5], gl[6], gl[7]}; }
        }
#pragma unroll
        for (int t = 0; t < 4; ++t) {
            const int tj = (t >= 2) ? 1 : 0, ti = (t == 1 || t == 2) ? 1 : 0;
            float pv[4] = {0.f, 0.f, 0.f, 0.f};
            if (t < 3) { pv[0] = pacc[t].x; pv[1] = pacc[t].y; pv[2] = pacc[t].z; pv[3] = pacc[t].w; }
#pragma unroll
            for (int jj = 0; jj < 4; ++jj) { const int j = 16 * tj + 4 * g + jj, i = 16 * ti + r; if (j > i) pv[jj] = 0.f; }
            const int lp = (2 * tj + (g >> 1)) * 16 + r;
            v2u d; d.x = cvtpk(pv[0], pv[1]); d.y = cvtpk(pv[2], pv[3]);
            *(GAS v2u*)(rec + R0_P + (ti * 64 + lp) * 16 + 8 * (g & 1)) = d;
        }
#pragma unroll
        for (int i = 0; i < 8; ++i) {
            const int q = lane + 64 * i, tk = q >> 4, c16 = q & 15; const bool nl = (c == 0 && tk < 16);
            v4u d = (v4u){0u, 0u, 0u, 0u};
            if (!nl) d = *(const GAS v4u*)(F.QFIZ + (size_t)row_of(b, c, tk) * N0 + 2 * DI + h * 128 + 8 * c16);
            *(LAS v2u*)(Tv + tk * 264 + c16 * 16) = (v2u){d.x, d.y}; *(LAS v2u*)(Tv + tk * 264 + c16 * 16 + 8) = (v2u){d.z, d.w};
        }
        LDS_WAIT(); asm volatile("" ::: "memory");
#pragma unroll
        for (int mt = 0; mt < 8; ++mt) { const v4u d = *(const LAS v4u*)(T + (16 * mt + r) * 64 + 16 * g); *(GAS v4u*)(rec + R0_KD + (mt * 64 + lane) * 16) = d; }
#pragma unroll
        for (int sl = 0; sl < 8; ++sl) {
            unsigned short hv[8];
#pragma unroll
            for (int e = 0; e < 8; ++e) hv[e] = *(const LAS unsigned short*)(Tv + (8 * g + e) * 264 + (16 * sl + r) * 2);
            v4u d; d.x = hv[0] | ((unsigned)hv[1] << 16); d.y = hv[2] | ((unsigned)hv[3] << 16); d.z = hv[4] | ((unsigned)hv[5] << 16); d.w = hv[6] | ((unsigned)hv[7] << 16);
            *(GAS v4u*)(rec + R0_V + (sl * 64 + lane) * 16) = d;
        }
        LDS_WAIT(); asm volatile("" ::: "memory");
    }
}

DI_ void l0_seq(Frame& F, const unsigned char* REC0) {
    const int lane = F.lane, w = F.wave, r = lane & 15, g = lane >> 4;
    LAS float* obuf = (LAS float*)(F.lds + 2 * ST0);
    constexpr int OB = 32 * 132;
    for (int u = F.vcu; u < NB * HG_H; u += F.G) {
        const int bh = u, b = bh >> 6, h = bh & 63;
        f32x4 acc[8];
#pragma unroll
        for (int m = 0; m < 8; ++m) acc[m] = (f32x4){0.f, 0.f, 0.f, 0.f};
        const int ntok = 4 * w + g, ndv = 8 * r;
        float ngv[8];
        { const f32x4 a0 = *(const GAS f32x4*)(F.ng0 + h * 128 + ndv), a1 = *(const GAS f32x4*)(F.ng0 + h * 128 + ndv + 4);
          ngv[0] = a0.x; ngv[1] = a0.y; ngv[2] = a0.z; ngv[3] = a0.w; ngv[4] = a1.x; ngv[5] = a1.y; ngv[6] = a1.z; ngv[7] = a1.w; }
#define L0_DMA(c_) do { const unsigned char* rs_ = REC0 + (size_t)(bh * NCH + (c_)) * R0_SZ; LAS unsigned char* st_ = F.lds + ((c_) & 1) * ST0; \
        for (int p_ = w; p_ < 27; p_ += 8) __builtin_amdgcn_global_load_lds((const unsigned*)(rs_ + p_ * 1024 + lane * 16), (LAS unsigned*)(st_ + p_ * 1024), 16, 0, 0); } while (0)
        L0_DMA(0);
        v4u zprev = (v4u){0u, 0u, 0u, 0u};
        for (int c = 0; c <= NCH; ++c) {
            asm volatile("s_waitcnt vmcnt(0)" ::: "memory");
            __builtin_amdgcn_s_barrier();
            asm volatile("" ::: "memory");
            if (c + 1 < NCH) L0_DMA(c + 1);
            v4u zcur = (v4u){0u, 0u, 0u, 0u};
            const bool zvalid = (c < NCH) && !(c == 0 && ntok < 16);
            if (zvalid) zcur = *(const GAS v4u*)(F.QFIZ + (size_t)row_of(b, c, ntok) * N0 + 3 * DI + h * 128 + ndv);
            if (c >= 1) {
                const int cp = c - 1;
                const LAS float* ob = obuf + (cp & 1) * OB + ntok * 132 + ndv;
                const f32x4 x0 = *(const LAS f32x4*)(ob), x1 = *(const LAS f32x4*)(ob + 4);
                float ss = (x0.x * x0.x + x0.y * x0.y) + (x0.z * x0.z + x0.w * x0.w) + (x1.x * x1.x + x1.y * x1.y) + (x1.z * x1.z + x1.w * x1.w);
                ss += __shfl_xor(ss, 8); ss += __shfl_xor(ss, 4); ss += __shfl_xor(ss, 2); ss += __shfl_xor(ss, 1);
                const float rs = rsqrtf(ss * (1.f / 128.f) + RMS_EPS);
                const bool wr = !(cp == 0 && (ntok < 16 || b != 0));
                if (wr) {
                    v4u d;
                    d.x = cvtpk(x0.x * rs * ngv[0] * silu(bflo(zprev.x)), x0.y * rs * ngv[1] * silu(bfhi(zprev.x)));
                    d.y = cvtpk(x0.z * rs * ngv[2] * silu(bflo(zprev.y)), x0.w * rs * ngv[3] * silu(bfhi(zprev.y)));
                    d.z = cvtpk(x1.x * rs * ngv[4] * silu(bflo(zprev.z)), x1.y * rs * ngv[5] * silu(bfhi(zprev.z)));
                    d.w = cvtpk(x1.z * rs * ngv[6] * silu(bflo(zprev.w)), x1.w * rs * ngv[7] * silu(bfhi(zprev.w)));
                    *(GAS v4u*)(F.Y + (size_t)row_of(b, cp, ntok) * DI + h * 128 + ndv) = d;
                }
            }
            zprev = zcur;
            if (c < NCH) {
                const LAS unsigned char* st = F.lds + (c & 1) * ST0;
                const bf16x8 vf = *(const LAS bf16x8*)(st + R0_V + w * 1024 + lane * 16);
                f32x4 o0 = (f32x4){0.f, 0.f, 0.f, 0.f}, o1 = o0;
                o0 = MFMA16(*(const LAS bf16x8*)(st + R0_P + lane * 16), vf, o0);
                o1 = MFMA16(*(const LAS bf16x8*)(st + R0_P + 1024 + lane * 16), vf, o1);
#pragma unroll
                for (int s = 0; s < 4; ++s) {
                    const bf16x8 sb = mk8(cvtpk(acc[2 * s].x, acc[2 * s].y), cvtpk(acc[2 * s].z, acc[2 * s].w), cvtpk(acc[2 * s + 1].x, acc[2 * s + 1].y), cvtpk(acc[2 * s + 1].z, acc[2 * s + 1].w));
                    o0 = MFMA16(*(const LAS bf16x8*)(st + R0_QD + s * 1024 + lane * 16), sb, o0);
                    o1 = MFMA16(*(const LAS bf16x8*)(st + R0_QD + (4 + s) * 1024 + lane * 16), sb, o1);
                }
                LAS float* ow = obuf + (c & 1) * OB + (4 * g) * 132 + 16 * w + r;
                ow[0] = o0.x; ow[132] = o0.y; ow[264] = o0.z; ow[396] = o0.w;
                ow[16 * 132] = o1.x; ow[17 * 132] = o1.y; ow[18 * 132] = o1.z; ow[19 * 132] = o1.w;
#pragma unroll
                for (int m = 0; m < 8; ++m) {
                    const f32x4 gl4 = *(const LAS f32x4*)(st + R0_GL + (16 * m + 4 * g) * 4);
                    acc[m] = MFMA16(*(const LAS bf16x8*)(st + R0_KD + m * 1024 + lane * 16), vf, acc[m] * gl4);
                }
                asm volatile("s_waitcnt lgkmcnt(0)" ::: "memory");
            }
        }
#undef L0_DMA
        asm volatile("s_waitcnt vmcnt(0)" ::: "memory");
        __builtin_amdgcn_s_barrier();
    }
}

struct Args { const float* in[17]; float* out; unsigned char* ws; int ph_lo, ph_hi, li, pad; };
__global__ void __launch_bounds__(NWAVES * 64, 2) mk_fwd(Args args) {
    extern __shared__ __attribute__((aligned(16))) unsigned char lds[];
    Frame F;
    F.lds = (LAS unsigned char*)lds;
    F.MISC = (volatile LAS unsigned*)(F.lds + MISC_OFF);
    F.tid = threadIdx.x; F.lane = F.tid & 63; F.wave = __builtin_amdgcn_readfirstlane(F.tid >> 6);
    F.G = gridDim.x; { const int bx = blockIdx.x; F.vcu = (F.G % 8 == 0) ? (bx % 8) * (F.G / 8) + bx / 8 : bx; }
    unsigned char* ws = args.ws;
    F.ctl = (gu32*)(ws + WS_CTL);
    F.x = args.in[0]; F.meta = args.in[1]; F.lb_logits = args.in[2];
    F.w0in = args.in[3]; F.b_f = args.in[4]; F.ng0 = args.in[5]; F.w0out = args.in[6]; F.ln0g = args.in[7]; F.ln0b = args.in[8];
    F.w1in = args.in[9]; F.wg1 = args.in[10]; F.wg2 = args.in[11]; F.b_g = args.in[12]; F.ng1 = args.in[13]; F.w1out = args.in[14]; F.ln1g = args.in[15]; F.ln1b = args.in[16];
    F.out = args.out;
    F.LB0 = (float*)(ws + WS_LB0); F.G1 = (float*)(ws + WS_G1); F.PRE = (float*)(ws + WS_PRE); F.O1 = (float*)(ws + WS_O1); F.REC0 = ws + WS_REC; F.REC1 = ws + WS_REC1; F.VF1 = ws + WS_VF1;
    F.WT0IN = (bf16*)(ws + WS_WT0IN); F.WT0OUT = (bf16*)(ws + WS_WT0OUT); F.WT1IN = (bf16*)(ws + WS_WT1IN); F.WT1OUT = (bf16*)(ws + WS_WT1OUT);
    F.XB = (bf16*)(ws + WS_XB); F.H1B = (bf16*)(ws + WS_H1B); F.QFIZ = (bf16*)(ws + WS_QFIZ); F.Y = (bf16*)(ws + WS_Y);
    for (int u = F.tid; u < (LDS_BYTES - LDSCTL_OFF) / 4; u += NWAVES * 64) ((LAS unsigned*)(F.lds + LDSCTL_OFF))[u] = 0u;
    __syncthreads();
    XcdBarrier bar; bar.bar = (unsigned*)(F.ctl + CW_BAR); bar.x = 0; bar.st = nullptr;
    if (N_LAUNCHES == 1) bar = xcd_barrier_post((unsigned*)(F.ctl + CW_BAR), F.MISC + 8);
#define GRID_BAR() do { if (N_LAUNCHES == 1) xcd_barrier(bar); } while (0)
    const int lo = args.ph_lo, hi = args.ph_hi;
#ifdef ONLY_PHASE
#define IN(k) ((k) == ONLY_PHASE && lo <= (k) && (k) < hi)
#else
#define IN(k) (lo <= (k) && (k) < hi)
#endif
#define BOTH(k) (IN(k) && IN((k) + 1))

    if (IN(0)) { p0_prologue(F); if (BOTH(0)) GRID_BAR(); }
    if (IN(1)) {
        pg8::Gemm g{F.XB, F.WT0IN, MP, N0, D}; pg8::StaticOrder S; S.init(MP, N0, F.G, (int)blockIdx.x);
        pg8::EpiBf16<0> E{F.QFIZ, N0, nullptr, 0, 0, 1.f};
        pg8::gemm_phase<pg8::EpiBf16<0>, pg8::StaticOrder, PG8_ALIGN, PG8_SP2>(F.lds + RING_OFF, g, S, E);
        if (BOTH(1)) GRID_BAR();
    }
#if USE_L0_MFMA
    if (IN(2)) { l0_prep(F, F.REC0); if (BOTH(2)) GRID_BAR(); }
    if (IN(3)) { l0_seq(F, F.REC0); if (BOTH(3)) GRID_BAR(); }
#else
    if (IN(2)) { if (BOTH(2)) GRID_BAR(); }
    if (IN(3)) { p2_l0_rec_naive(F); if (BOTH(3)) GRID_BAR(); }
#endif
    if (IN(4)) {
        pg8::Gemm g{F.Y, F.WT0OUT, MP, D, DI}; pg8::StaticOrder S; S.init(MP, D, F.G, (int)blockIdx.x);
        pg8::EpiResid E{F.PRE, D, F.x, F.meta, MX, MR, ALPHA};
        pg8::gemm_phase<pg8::EpiResid, pg8::StaticOrder, PG8_ALIGN, PG8_SP2>(F.lds + RING_OFF, g, S, E);
        if (BOTH(4)) GRID_BAR();
    }
    if (IN(5)) { ln_phase(F, F.PRE, MR, F.ln0g, F.ln0b, F.PRE, F.H1B, F.G1); if (BOTH(5)) GRID_BAR(); }
    if (IN(6)) {
        pg8::Gemm g{F.H1B, F.WT1IN, MP, N1, D}; pg8::StaticOrder S; S.init(MP, N1, F.G, (int)blockIdx.x);
        pg8::EpiBf16<0> E{F.QFIZ, N1, nullptr, 0, 0, 1.f};
        pg8::gemm_phase<pg8::EpiBf16<0>, pg8::StaticOrder, PG8_ALIGN, PG8_SP2>(F.lds + RING_OFF, g, S, E);
        if (BOTH(6)) GRID_BAR();
    }
#if USE_L1_MFMA
    if (IN(7)) { l1_prep(F, F.REC1, F.VF1); if (BOTH(7)) GRID_BAR(); }
    if (IN(8)) { l1_seq(F, F.REC1, F.VF1, F.O1); if (BOTH(8)) GRID_BAR(); }
#else
    if (IN(7)) { if (BOTH(7)) GRID_BAR(); }
    if (IN(8)) { p6_l1_rec_naive(F); if (BOTH(8)) GRID_BAR(); }
#endif
    if (IN(9)) { p7_normgate(F); if (BOTH(9)) GRID_BAR(); }
    if (IN(10)) {
        pg8::Gemm g{F.Y, F.WT1OUT, MX, D, DI}; pg8::StaticOrder S; S.init(MX, D, F.G, (int)blockIdx.x);
        pg8::EpiResid E{F.PRE, D, F.PRE, F.PRE, MX, MX, ALPHA};
        pg8::gemm_phase<pg8::EpiResid, pg8::StaticOrder, PG8_ALIGN, PG8_SP2>(F.lds + RING_OFF, g, S, E);
        if (BOTH(10)) GRID_BAR();
    }
    if (IN(11)) { ln_phase(F, F.PRE, MX, F.ln1g, F.ln1b, F.out, nullptr, nullptr); }
#undef IN
#undef BOTH
}

extern "C" void kernel_launch(void* const* d_in, const int* in_sizes, int n_in, void* d_out, int out_size, void* d_ws, size_t ws_size, hipStream_t stream) {
    static int grid = 0;
    if (grid == 0) {
        if (n_in != 17 || in_sizes[0] != MX * D || out_size != MX * D || ws_size < WS_END) { fprintf(stderr, "kernel_launch: unexpected problem (n_in %d, in0 %d, out %d, ws %zu < %zu); nothing launched\n", n_in, n_in > 0 ? in_sizes[0] : -1, out_size, ws_size, (size_t)WS_END); grid = -1; return; }
        int dev = 0, cus = 0, per_cu = 0;
        if (hipGetDevice(&dev) != hipSuccess || hipDeviceGetAttribute(&cus, hipDeviceAttributeMultiprocessorCount, dev) != hipSuccess) { fprintf(stderr, "kernel_launch: device query failed\n"); grid = -1; return; }
        if (hipFuncSetAttribute((const void*)mk_fwd, hipFuncAttributeMaxDynamicSharedMemorySize, LDS_BYTES) != hipSuccess) { fprintf(stderr, "kernel_launch: hipFuncSetAttribute failed\n"); grid = -1; return; }
        if (hipOccupancyMaxActiveBlocksPerMultiprocessor(&per_cu, (const void*)mk_fwd, NWAVES * 64, LDS_BYTES) != hipSuccess || per_cu < 1)
            fprintf(stderr, "kernel_launch: note: occupancy query reports %d workgroups per CU\n", per_cu);
        (void)hipGetLastError();
        grid = cus;
    }
    if (grid < 0) return;
    if (hipMemsetAsync((char*)d_ws + WS_CTL, 0, CTL_ZERO_BYTES, stream) != hipSuccess) { fprintf(stderr, "kernel_launch: memset failed\n"); return; }
    Args a{};
    for (int i = 0; i < 17; ++i) a.in[i] = (const float*)d_in[i];
    a.out = (float*)d_out; a.ws = (unsigned char*)d_ws;
    for (int li = 0; li < N_LAUNCHES; ++li) {
        a.ph_lo = (N_LAUNCHES == 1) ? 0 : li; a.ph_hi = (N_LAUNCHES == 1) ? PER_PHASE : li + 1; a.li = li; a.pad = 0;
        hipLaunchKernelGGL(mk_fwd, dim3(grid), dim3(NWAVES * 64), LDS_BYTES, stream, a);
        const hipError_t le = hipPeekAtLastError();
        if (le != hipSuccess) { fprintf(stderr, "kernel_launch: launch %d failed: %s\n", li, hipGetErrorName(le)); break; }
    }
}
```

```cpp
#include <hip/hip_runtime.h>
#include <cstdio>
#include <cstdint>
#define MK_N_LAUNCHES 1
#define USE_L0_MFMA 2
#define USE_L1_MFMA 1
namespace pg8 {
#define PG8_LAS __attribute__((address_space(3)))
typedef unsigned short bf16_t;
typedef short bf16x8 __attribute__((ext_vector_type(8)));
typedef float f32x4 __attribute__((ext_vector_type(4)));
typedef unsigned u32x4 __attribute__((ext_vector_type(4)));
constexpr int BM = 256, BK = 64, HALF = 128, HTB = HALF * BK * 2  , STAGE_BYTES = 8 * HTB, NXCD = 8, WGM = 8;

__host__ __device__ __forceinline__ int lds_byte(int r, int c) { const int st = (r >> 4) * 2 + (c >> 5), rr = r & 15, cc = c & 31, ob = rr * 64 + cc * 2; return st * 1024 + (ob ^ (((ob >> 9) & 1) << 5)); }
__host__ __device__ __forceinline__ void stage_rc(int b, int& R, int& C) { const int st = b / 1024, sb = b % 1024, swz = sb ^ (((sb >> 9) & 1) << 5); R = (st >> 1) * 16 + swz / 64; C = (st & 1) * 32 + (swz % 64) / 2; }
__host__ __device__ __forceinline__ int perm32(int rho) { const int n = rho >> 4, i = rho & 15; return 8 * (i >> 2) + 4 * n + (i & 3); }

struct Unit { int pm, pn; };
struct Gemm { const bf16_t* A; const bf16_t* Bt; int M, N, K; };

struct StaticOrder {
    int nM, nN, nwg, G, c;
    __host__ __device__ void init(int M, int N, int G_, int c_) { nM = M / BM; nN = N / BM; nwg = nM * nN; G = G_; c = c_; }
    __host__ __device__ bool next(int i, Unit& u) const {
        const long L = (long)i * G + c; if (L >= nwg) return false;
        int wgid = (int)L; { const int q = nwg / NXCD, r = nwg % NXCD, xcd = wgid % NXCD, off = wgid / NXCD; wgid = (xcd < r ? xcd * (q + 1) : r * (q + 1) + (xcd - r) * q) + off; }
        const int nig = WGM * nN, gid = wgid / nig, fm = gid * WGM, gsz = (nM - fm) < WGM ? (nM - fm) : WGM;
        u.pm = fm + ((wgid % nig) % gsz); u.pn = (wgid % nig) / gsz; return true;
    }
    __device__ __forceinline__ void a_ready(const Unit&) const {}
    __device__ __forceinline__ void done(const Unit&) const {}
};

__device__ __forceinline__ unsigned cvt_pk_bf16(float lo, float hi) { unsigned r; asm volatile("v_cvt_pk_bf16_f32 %0, %1, %2" : "=v"(r) : "v"(lo), "v"(hi)); return r; }
typedef float f32x2 __attribute__((ext_vector_type(2)));
__device__ __forceinline__ f32x2 gelu_pk(f32x2 v) {
    const f32x2 av = __builtin_elementwise_abs(v), d = av * 0.2316418882f + 1.0f;
    f32x2 t; t.x = __builtin_amdgcn_rcpf(d.x); t.y = __builtin_amdgcn_rcpf(d.y);
    f32x2 q = t * 0.5307027145f + (-0.7265760135f); q = q * t + 0.7107068705f; q = q * t + (-0.142248368f); q = q * t + 0.127414796f; q = q * t;
    const f32x2 s = (v * v) * (-0.72134752044f);
    f32x2 e; e.x = __builtin_amdgcn_exp2f(s.x); e.y = __builtin_amdgcn_exp2f(s.y);
    const f32x2 m = v * (q * e), r = v - m;
    f32x2 o; o.x = v.x < 0.f ? m.x : r.x; o.y = v.y < 0.f ? m.y : r.y; return o;
}

template <int ACT  > struct EpiBf16 {
    static constexpr bool PERM = true, AFTER_DRAIN = false; static_assert(ACT == 0 || ACT == 1, "EpiBf16: ACT is 0 (none) or 1 (gelu_pk)");
    bf16_t* O; int ldc; const float* bias; int split_cols; size_t split_stride; float scale0;
    __device__ __forceinline__ void operator()(const f32x4 (&acc)[2][2][4][2], const Unit& u, int wr, int wc, int fr, int fq) const {
        const int row0 = u.pm * BM + wr * 64 + fr; int colt = u.pn * BM; bf16_t* base = O;
        float sc = 1.f; if (split_cols) { const int t = colt / split_cols; base += (size_t)t * split_stride; colt -= t * split_cols; if (t == 0) sc = scale0; }
        const int col0 = colt + wc * 32 + 8 * fq, bcol0 = u.pn * BM + wc * 32 + 8 * fq;
        f32x4 bv[2][2];
#pragma unroll
        for (int bj = 0; bj < 2; ++bj)
#pragma unroll
            for (int n = 0; n < 2; ++n) bv[bj][n] = bias ? *(const f32x4*)(bias + bcol0 + bj * HALF + 4 * n) : (f32x4){0.f, 0.f, 0.f, 0.f};
#pragma unroll
        for (int ai = 0; ai < 2; ++ai)
#pragma unroll
            for (int m = 0; m < 4; ++m) { bf16_t* rowp = base + (size_t)(row0 + ai * HALF + m * 16) * ldc + col0;
#pragma unroll
                for (int bj = 0; bj < 2; ++bj) { f32x4 v0 = acc[ai][bj][m][0] + bv[bj][0], v1 = acc[ai][bj][m][1] + bv[bj][1];
                    if (ACT == 1) { f32x2 a = gelu_pk((f32x2){v0[0], v0[1]}), b = gelu_pk((f32x2){v0[2], v0[3]}), c = gelu_pk((f32x2){v1[0], v1[1]}), d = gelu_pk((f32x2){v1[2], v1[3]});
                        v0 = (f32x4){a.x, a.y, b.x, b.y}; v1 = (f32x4){c.x, c.y, d.x, d.y}; }
                    v0 = v0 * sc; v1 = v1 * sc; u32x4 w; w.x = cvt_pk_bf16(v0[0], v0[1]); w.y = cvt_pk_bf16(v0[2], v0[3]); w.z = cvt_pk_bf16(v1[0], v1[1]); w.w = cvt_pk_bf16(v1[2], v1[3]);
                    *(u32x4*)(rowp + bj * HALF) = w; } }
    }
};
struct EpiResid {
    static constexpr bool PERM = false, AFTER_DRAIN = false;
    float* C; int ldc; const float* resA; const float* resB; int rowsA; int rowsValid; float alpha;
    __device__ __forceinline__ void operator()(const f32x4 (&acc)[2][2][4][2], const Unit& u, int wr, int wc, int fr, int fq) const {
        const int row0 = u.pm * BM + wr * 64 + fr, col0 = u.pn * BM + wc * 32 + 4 * fq;
#pragma unroll
        for (int ai = 0; ai < 2; ++ai)
#pragma unroll
            for (int m = 0; m < 4; ++m) { const int r = row0 + ai * HALF + m * 16;
                if (r < rowsValid) {
                    const float* rp = (r < rowsA) ? resA + (size_t)r * ldc + col0 : resB + (size_t)(r - rowsA) * ldc + col0;
                    float* cp = C + (size_t)r * ldc + col0;
#pragma unroll
                    for (int bj = 0; bj < 2; ++bj)
#pragma unroll
                        for (int n = 0; n < 2; ++n) { const f32x4 rv = *(const f32x4*)(rp + bj * HALF + n * 16); *(f32x4*)(cp + bj * HALF + n * 16) = rv * alpha + acc[ai][bj][m][n]; } }
                asm volatile("" ::: "memory"); }
    }
};


template <class Epi, class Sched, bool ALIGN_EPI = false, bool SP2 = false>
__device__ __forceinline__ void gemm_phase(PG8_LAS unsigned char* lds, const Gemm g, const Sched& S, const Epi& E) {
    const int tid = threadIdx.x, wid = __builtin_amdgcn_readfirstlane(tid >> 6), lane = tid & 63, wr = wid >> 2, wc = wid & 3, fr = lane & 15, fq = lane >> 4;
    const int K = g.K, nt = K / BK;
    unsigned voffA[2], voffB[2];
#pragma unroll
    for (int i = 0; i < 2; ++i) { int R, C; stage_rc(tid * 16 + i * 8192, R, C); const int Rb = Epi::PERM ? ((R & ~31) + perm32(R & 31)) : R;
        voffA[i] = (unsigned)(R * K + C) * 2u; voffB[i] = (unsigned)(Rb * K + C) * 2u; }
    const size_t kstep = (size_t)(BK * 2);
    const size_t hstep = (size_t)HALF * K * 2;
    const size_t tstep = 2 * hstep;
    const unsigned ldsw = (unsigned)wid * 1024u;
    const int aoff = lds_byte(wr * 64 + fr, fq * 8), boff = lds_byte(wc * 32 + fr, fq * 8);
#define PG8_SA(b, h) (((b) * 2 + (h)) * HTB)
#define PG8_SB(b, h) ((4 + (b) * 2 + (h)) * HTB)
#define PG8_STAGE(bufoff, gbase, voff) do { _Pragma("unroll") for (int _i = 0; _i < 2; ++_i) \
        __builtin_amdgcn_global_load_lds((const unsigned*)((const char*)(gbase) + (voff)[_i]), (PG8_LAS unsigned*)(lds + (bufoff) + ldsw + _i * 8192), 16, 0, 0); } while (0)
#define PG8_LDA(dst, b, h) do { _Pragma("unroll") for (int m = 0; m < 4; ++m) _Pragma("unroll") for (int k = 0; k < 2; ++k) dst[m][k] = *(const PG8_LAS bf16x8*)(lds + PG8_SA(b, h) + aoff + m * 2048 + k * 1024); } while (0)
#define PG8_LDB(dst, b, h) do { _Pragma("unroll") for (int n = 0; n < 2; ++n) _Pragma("unroll") for (int k = 0; k < 2; ++k) dst[n][k] = *(const PG8_LAS bf16x8*)(lds + PG8_SB(b, h) + boff + n * 2048 + k * 1024); } while (0)
#define PG8_MMA(ai, bj, At, Bt) do { __builtin_amdgcn_s_setprio(1); _Pragma("unroll") for (int m = 0; m < 4; ++m) _Pragma("unroll") for (int n = 0; n < 2; ++n) _Pragma("unroll") for (int k = 0; k < 2; ++k) \
        acc[ai][bj][m][n] = __builtin_amdgcn_mfma_f32_16x16x32_bf16(Bt[n][k], At[m][k], acc[ai][bj][m][n], 0, 0, 0); __builtin_amdgcn_s_setprio(0); } while (0)
#define PG8_WAIT_V(n) asm volatile("s_waitcnt vmcnt(" #n ")" ::: "memory")
#define PG8_WAIT_L(n) asm volatile("s_waitcnt lgkmcnt(" #n ")" ::: "memory")
#define PG8_BAR __builtin_amdgcn_s_barrier()
#define PG8_SCHED __builtin_amdgcn_sched_barrier(0)
    Unit cur, nxt; int ui = 0;
    if (!S.next(0, cur)) return;
    f32x4 acc[2][2][4][2];
#pragma unroll
    for (int a = 0; a < 2; ++a)
#pragma unroll
        for (int b = 0; b < 2; ++b)
#pragma unroll
            for (int m = 0; m < 4; ++m)
#pragma unroll
                for (int n = 0; n < 2; ++n) acc[a][b][m][n] = (f32x4){0.f, 0.f, 0.f, 0.f};
    bf16x8 At[4][2], B0[2][2], B1[2][2];
    const char* cA = (const char*)g.A + (size_t)cur.pm * tstep; const char* cB = (const char*)g.Bt + (size_t)cur.pn * tstep;
    S.a_ready(cur);
    if constexpr (SP2) {
        PG8_STAGE(PG8_SB(0, 0), cB, voffB); PG8_STAGE(PG8_SB(0, 1), cB + hstep, voffB); PG8_STAGE(PG8_SA(0, 0), cA, voffA); PG8_STAGE(PG8_SA(0, 1), cA + hstep, voffA);
        if (wr == 1) PG8_BAR;
        PG8_WAIT_V(2); PG8_BAR;
        PG8_STAGE(PG8_SB(1, 0), cB + kstep, voffB); PG8_STAGE(PG8_SA(1, 0), cA + kstep, voffA); PG8_STAGE(PG8_SB(1, 1), cB + hstep + kstep, voffB);
        PG8_WAIT_V(6); PG8_BAR;
    } else {
        PG8_STAGE(PG8_SB(0, 0), cB, voffB); PG8_STAGE(PG8_SA(0, 0), cA, voffA); PG8_STAGE(PG8_SB(0, 1), cB + hstep, voffB); PG8_STAGE(PG8_SA(0, 1), cA + hstep, voffA);
        if (wr == 1) PG8_BAR;
        PG8_WAIT_V(4); PG8_BAR;
        PG8_STAGE(PG8_SB(1, 0), cB + kstep, voffB); PG8_STAGE(PG8_SA(1, 0), cA + kstep, voffA); PG8_STAGE(PG8_SB(1, 1), cB + hstep + kstep, voffB);
        PG8_WAIT_V(6); PG8_BAR;
    }
    for (;;) {
        const bool has_next = S.next(ui + 1, nxt);
        const char* nA = has_next ? (const char*)g.A + (size_t)nxt.pm * tstep : cA; const char* nB = has_next ? (const char*)g.Bt + (size_t)nxt.pn * tstep : cB;
        for (int t = 0; t < nt; t += 2) {
            const bool last = (t == nt - 2);
            const char* a1 = cA + (size_t)(t + 1) * kstep;
            const char* a2 = last ? nA : cA + (size_t)(t + 2) * kstep; const char* b2 = last ? nB : cB + (size_t)(t + 2) * kstep;
            const char* a3 = a2 + kstep; const char* b3 = b2 + kstep;
            if (last && has_next) S.a_ready(nxt);
            if constexpr (SP2) {
            PG8_LDB(B0, 0, 0); PG8_LDB(B1, 0, 1); PG8_SCHED; PG8_LDA(At, 0, 0); PG8_STAGE(PG8_SA(1, 1), a1 + hstep, voffA);
            PG8_WAIT_V(8); PG8_WAIT_L(0); PG8_BAR; PG8_MMA(0, 0, At, B0); PG8_MMA(0, 1, At, B1); PG8_BAR; PG8_SCHED;
            PG8_LDA(At, 0, 1); PG8_STAGE(PG8_SB(0, 0), b2, voffB); PG8_STAGE(PG8_SB(0, 1), b2 + hstep, voffB); PG8_STAGE(PG8_SA(0, 0), a2, voffA);
            PG8_WAIT_V(8); PG8_WAIT_L(0); PG8_BAR; PG8_MMA(1, 0, At, B0); PG8_MMA(1, 1, At, B1); PG8_BAR; PG8_SCHED;
            PG8_LDB(B0, 1, 0); PG8_LDB(B1, 1, 1); PG8_SCHED; PG8_LDA(At, 1, 0); PG8_STAGE(PG8_SA(0, 1), a2 + hstep, voffA);
            PG8_WAIT_V(8); PG8_WAIT_L(0); PG8_BAR; PG8_MMA(0, 0, At, B0); PG8_MMA(0, 1, At, B1); PG8_BAR; PG8_SCHED;
            PG8_LDA(At, 1, 1); PG8_STAGE(PG8_SB(1, 0), b3, voffB); PG8_STAGE(PG8_SB(1, 1), b3 + hstep, voffB); PG8_STAGE(PG8_SA(1, 0), a3, voffA);
            PG8_WAIT_V(8); PG8_WAIT_L(0); PG8_BAR; PG8_MMA(1, 0, At, B0); PG8_MMA(1, 1, At, B1); PG8_BAR; PG8_SCHED;
            } else {
            PG8_LDB(B0, 0, 0); PG8_SCHED; PG8_LDA(At, 0, 0); PG8_STAGE(PG8_SA(1, 1), a1 + hstep, voffA);
            PG8_WAIT_L(8); PG8_BAR; PG8_WAIT_L(0); PG8_MMA(0, 0, At, B0); PG8_BAR; PG8_SCHED;
            PG8_LDB(B1, 0, 1); PG8_STAGE(PG8_SB(0, 0), b2, voffB);
            PG8_BAR; PG8_WAIT_L(0); PG8_MMA(0, 1, At, B1); PG8_BAR;
            PG8_LDA(At, 0, 1); PG8_STAGE(PG8_SA(0, 0), a2, voffA);
            PG8_BAR; PG8_WAIT_L(0); PG8_MMA(1, 0, At, B0); PG8_BAR; PG8_SCHED;
            PG8_STAGE(PG8_SB(0, 1), b2 + hstep, voffB);
            PG8_WAIT_V(6); PG8_BAR; PG8_MMA(1, 1, At, B1); PG8_BAR;
            PG8_LDB(B0, 1, 0); PG8_SCHED; PG8_LDA(At, 1, 0); PG8_STAGE(PG8_SA(0, 1), a2 + hstep, voffA);
            PG8_WAIT_L(8); PG8_BAR; PG8_WAIT_L(0); PG8_MMA(0, 0, At, B0); PG8_BAR; PG8_SCHED;
            PG8_LDB(B1, 1, 1); PG8_STAGE(PG8_SB(1, 0), b3, voffB);
            PG8_BAR; PG8_WAIT_L(0); PG8_MMA(0, 1, At, B1); PG8_BAR;
            PG8_LDA(At, 1, 1); PG8_STAGE(PG8_SA(1, 0), a3, voffA);
            PG8_BAR; PG8_WAIT_L(0); PG8_MMA(1, 0, At, B0); PG8_BAR; PG8_SCHED;
            PG8_STAGE(PG8_SB(1, 1), b3 + hstep, voffB);
            PG8_WAIT_V(6); PG8_BAR; PG8_MMA(1, 1, At, B1); PG8_BAR;
            }
        }
        if constexpr (ALIGN_EPI) { if (wr == 0) PG8_BAR; }
        if constexpr (!Epi::AFTER_DRAIN) { E(acc, cur, wr, wc, fr, fq); S.done(cur); }
        if (!has_next) break;
#pragma unroll
        for (int a = 0; a < 2; ++a)
#pragma unroll
            for (int b = 0; b < 2; ++b)
#pragma unroll
                for (int m = 0; m < 4; ++m)
#pragma unroll
                    for (int n = 0; n < 2; ++n) acc[a][b][m][n] = (f32x4){0.f, 0.f, 0.f, 0.f};
        cur = nxt; cA = nA; cB = nB; ++ui;
        if constexpr (ALIGN_EPI) { if (wr == 1) PG8_BAR; }
    }
    PG8_WAIT_V(0);
    if constexpr (!ALIGN_EPI) { if (wr == 0) PG8_BAR; }
    PG8_BAR;
    if constexpr (Epi::AFTER_DRAIN) { E.fused(acc, cur, wr, wc, fr, fq, lds, wid, lane); S.done(cur); }
#undef PG8_SA
#undef PG8_SB
#undef PG8_STAGE
#undef PG8_LDA
#undef PG8_LDB
#undef PG8_MMA
#undef PG8_WAIT_V
#undef PG8_WAIT_L
#undef PG8_BAR
#undef PG8_SCHED
}
}
#ifndef PG8_SP2
#define PG8_SP2 true
#endif
#ifndef PG8_ALIGN
#define PG8_ALIGN true
#endif

constexpr int NWAVES = 8;
constexpr int PER_PHASE = 12;
#ifndef MK_N_LAUNCHES
#define MK_N_LAUNCHES 1
#endif
#ifndef PROBE_MASK
#define PROBE_MASK 0
#endif
#define REP(k) (((PROBE_MASK >> (k)) & 1) + 1)
#ifndef PROBE_VAR
#define PROBE_VAR 0
#endif
#ifndef PROBE_CLK
#define PROBE_CLK 0
#endif
#ifndef STAMP_MASK
#define STAMP_MASK 0
#endif
#ifndef USE_AUX
#define USE_AUX 0
#endif
#ifndef USE_TILE_TRANSPOSE
#define USE_TILE_TRANSPOSE 0
#endif
#ifndef USE_L1_SEQ2
#define USE_L1_SEQ2 0
#endif
#ifndef USE_TICKETS
#define USE_TICKETS 0
#endif
constexpr int N_LAUNCHES = MK_N_LAUNCHES;

constexpr int D = 4096, NB = 4, SEQ = 2048, NMETA = 16, DI = 8192;
constexpr int MX = NB * SEQ;
constexpr int MR = MX + NMETA;
constexpr int MP = 8448;
constexpr int N0 = 4 * DI;
constexpr int N1 = 2 * 4096 + 2 * DI;
constexpr int HG_H = 64, HG_DK = 128;
constexpr int GL_H = 8, GL_DK = 512, GL_DV = 1024, GL_R = 16;
constexpr float LN_EPS = 1e-5f, RMS_EPS = 1e-6f;
constexpr float ALPHA = 1.41421356237309515f;

constexpr size_t MiB = 1u << 20;
constexpr size_t WS_CTL = 0, CTL_ZERO_BYTES = 1 * MiB;
constexpr size_t WS_LB0 = 1 * MiB;
constexpr size_t WS_G1 = 2 * MiB;
constexpr size_t WS_WG1T = 3 * MiB;
constexpr size_t WS_W2F = 3 * MiB + 256 * 1024;
constexpr size_t WS_WT0IN = 4 * MiB;
constexpr size_t WS_WT0OUT = WS_WT0IN + 256 * MiB;
constexpr size_t WS_WT1IN = WS_WT0OUT + 64 * MiB;
constexpr size_t WS_WT1OUT = WS_WT1IN + 192 * MiB;
constexpr size_t WS_XB = WS_WT1OUT + 64 * MiB;
constexpr size_t WS_H1B = WS_XB + 66 * MiB;
constexpr size_t WS_QFIZ = WS_H1B + 66 * MiB;
constexpr size_t WS_Y = WS_QFIZ + 528 * MiB;
constexpr size_t WS_PRE = WS_Y + 132 * MiB;
constexpr size_t WS_REC = WS_PRE + 132 * MiB;
constexpr size_t WS_Q0 = WS_REC + 520 * MiB;
constexpr size_t WS_Y0 = WS_REC + 523 * MiB;
constexpr size_t WS_REC1 = WS_REC, WS_VF1 = WS_REC + 139 * MiB, WS_O1 = WS_REC + 270 * MiB;
constexpr size_t WS_END = WS_REC + 528 * MiB;
static_assert((size_t)MP * D * 2 <= 66 * MiB && (size_t)MP * N0 * 2 <= 528 * MiB && (size_t)MP * DI * 2 <= 132 * MiB && (size_t)MP * D * 4 <= 132 * MiB && (size_t)MR * DI * 4 <= 258 * MiB, "d_ws map");
static_assert((size_t)256 * 65 * 27648 <= 440 * MiB && (size_t)32 * 65 * 69632 <= 139 * MiB && (size_t)32 * 65 * 65536 <= 131 * MiB, "record map");
constexpr int CW_BAR = 4096, CW_POOL = 8192;

constexpr int RING_OFF = 0, RING_BYTES = 155648;
constexpr int LDSCTL_OFF = RING_BYTES, MISC_OFF = LDSCTL_OFF + 320;
constexpr int LDS_BYTES = 163840;
static_assert(MISC_OFF + 128 <= LDS_BYTES, "LDS map");

#define GAS __attribute__((address_space(1)))
#define LAS __attribute__((address_space(3)))
typedef unsigned short bf16;
typedef unsigned v4u __attribute__((ext_vector_type(4)));
typedef unsigned v2u __attribute__((ext_vector_type(2)));
typedef float f32x4 __attribute__((ext_vector_type(4)));
typedef GAS unsigned gu32;
#define RLX_AGENT __ATOMIC_RELAXED, __HIP_MEMORY_SCOPE_AGENT
#define LDS_WAIT() asm volatile("s_waitcnt lgkmcnt(0)" ::: "memory")
#define DI_ __device__ __forceinline__
DI_ unsigned f2bf(float f) { unsigned u = __builtin_bit_cast(unsigned, f); return (u + 0x7fffu + ((u >> 16) & 1u)) >> 16; }
DI_ unsigned pk2(float lo, float hi) { return f2bf(lo) | (f2bf(hi) << 16); }
DI_ unsigned hwpk(float lo, float hi) { unsigned r; asm volatile("v_cvt_pk_bf16_f32 %0, %1, %2" : "=v"(r) : "v"(lo), "v"(hi)); return r; }
DI_ float bflo(unsigned w) { return __builtin_bit_cast(float, w << 16); }
DI_ float bfhi(unsigned w) { return __builtin_bit_cast(float, w & 0xffff0000u); }
DI_ float bf2f(bf16 b) { return __builtin_bit_cast(float, (unsigned)b << 16); }
DI_ float sigm(float x) { return __builtin_amdgcn_rcpf(1.f + __builtin_amdgcn_exp2f(x * -1.4426950408889634f)); }
DI_ float silu(float x) { return x * __builtin_amdgcn_rcpf(1.f + __builtin_amdgcn_exp2f(x * -1.4426950408889634f)); }

#define XB_TMO      128
#define XB_XCNT(j)  (256  + 64 * (j))
#define XB_XSUB(j)  (1280 + 64 * (j))
#define XB_XGEN(j)  (2304 + 64 * (j))
#define XB_TOP      3328
#define XB_TOPGEN   3392
#define XCD_BAR_WORDS 3456
#define XB_SPIN_CAP (1u << 18)

__device__ __forceinline__ unsigned xb_ld(unsigned* p)              { return __hip_atomic_load(p, __ATOMIC_RELAXED, __HIP_MEMORY_SCOPE_AGENT); }
__device__ __forceinline__ unsigned xb_add(unsigned* p, unsigned v) { return __hip_atomic_fetch_add(p, v, __ATOMIC_RELAXED, __HIP_MEMORY_SCOPE_AGENT); }
__device__ __forceinline__ unsigned xb_xcc_id() { return (unsigned)__builtin_amdgcn_s_getreg((3 << 11) | 20) & 0xFu; }
#define XB_SPIN(cond, bar) do { unsigned _sp = 0; while (cond) { __builtin_amdgcn_s_sleep(1); \
    if ((++_sp & 255u) == 0u) { if (xb_ld(&(bar)[XB_TMO])) break; if (_sp > XB_SPIN_CAP) { atomicAdd(&(bar)[XB_TMO], 1u); break; } } } } while (0)

struct XcdBarrier {
    unsigned* bar; unsigned x;
    volatile LAS unsigned* st;
};
__device__ __forceinline__ XcdBarrier xcd_barrier_post(unsigned* bar, volatile LAS unsigned* st) {
    XcdBarrier b; b.bar = bar; b.x = xb_xcc_id(); b.st = st;
    if (threadIdx.x == 0) (void)xb_add(&bar[XB_XCNT(b.x)], 1u);
    return b;
}
__device__ __forceinline__ void xcd_barrier_complete(unsigned* bar, unsigned x, unsigned& nloc, unsigned& nx) {
    const unsigned G = gridDim.x * gridDim.y * gridDim.z;
    unsigned sum, cnt, mine, sp = 0u;
    for (;;) {
        sum = 0u; cnt = 0u; mine = 0u;
#pragma unroll
        for (unsigned j = 0; j < 16; ++j) { const unsigned c = xb_ld(&bar[XB_XCNT(j)]); sum += c; cnt += (c > 0u) ? 1u : 0u; mine = (j == x) ? c : mine; }
        if (sum == G) break;
        __builtin_amdgcn_s_sleep(1);
        if ((++sp & 255u) == 0u) { if (xb_ld(&bar[XB_TMO])) break; if (sp > XB_SPIN_CAP) { atomicAdd(&bar[XB_TMO], 1u); break; } }
    }
    nloc = mine > 0u ? mine : 1u; nx = cnt > 0u ? cnt : 1u;
}
__device__ __forceinline__ void xcd_barrier(const XcdBarrier& b) {
    asm volatile("s_waitcnt vmcnt(0)" ::: "memory");
    __syncthreads();
    if (threadIdx.x == 0) {
        unsigned* bar = b.bar;
        __builtin_amdgcn_s_waitcnt(0);
        unsigned nloc = b.st[0], nx = b.st[1];
        if (nloc == 0u) { xcd_barrier_complete(bar, b.x, nloc, nx); b.st[0] = nloc; b.st[1] = nx; }
        const unsigned old = xb_add(&bar[XB_XSUB(b.x)], 1u);
        const unsigned gen = old / nloc;
        if (old + 1u == (gen + 1u) * nloc) {
            __builtin_amdgcn_fence(__ATOMIC_RELEASE, "agent");
            asm volatile("s_waitcnt vmcnt(0)" ::: "memory");
            const unsigned og = xb_add(&bar[XB_TOP], 1u);
            const unsigned tg = og / nx;
            if (og + 1u == (tg + 1u) * nx) xb_add(&bar[XB_TOPGEN], 1u);
            else XB_SPIN(xb_ld(&bar[XB_TOPGEN]) == tg, bar);
            __builtin_amdgcn_fence(__ATOMIC_ACQUIRE, "agent");
            xb_add(&bar[XB_XGEN(b.x)], 1u);
            asm volatile("s_waitcnt vmcnt(0)" ::: "memory");
        } else {
            XB_SPIN(xb_ld(&bar[XB_XGEN(b.x)]) == gen, bar);
            __builtin_amdgcn_fence(__ATOMIC_ACQUIRE, "agent");
            asm volatile("s_waitcnt vmcnt(0)" ::: "memory");
        }
    }
    __syncthreads();
}

struct Frame {
    LAS unsigned char* lds;
    volatile LAS unsigned* MISC;
    gu32* ctl;
    int tid, lane, wave;
    int vcu, G;
    const float *x, *meta, *lb_logits;
    const float *w0in, *b_f, *ng0, *w0out, *ln0g, *ln0b;
    const float *w1in, *wg1, *wg2, *b_g, *ng1, *w1out, *ln1g, *ln1b;
    float* out;
    float *LB0, *G1, *PRE, *O1;
    unsigned char *REC0, *REC1, *VF1;
    bf16 *WG1T, *W2F, *Q0, *Y0;
    bf16 *WT0IN, *WT0OUT, *WT1IN, *WT1OUT, *XB, *H1B, *QFIZ, *Y;
};

DI_ float wave_sum(float v) {
#pragma unroll
    for (int o = 1; o < 64; o <<= 1) v += __shfl_xor(v, o);
    return v;
}

DI_ void p0_transpose_item(const float* W, int K, int N, bf16* WT, LAS float* scr, int item, int lane) {
    const int nblk = N / 32, kb = item / nblk, nb = item % nblk, k0 = 64 * kb, n0 = 32 * nb;
    float wv[32];
#pragma unroll
    for (int i = 0; i < 32; ++i) wv[i] = W[(size_t)(k0 + 2 * i + (lane >> 5)) * N + n0 + (lane & 31)];
#pragma unroll
    for (int i = 0; i < 32; ++i) scr[(2 * i + (lane >> 5)) * 33 + (lane & 31)] = wv[i];
    LDS_WAIT(); asm volatile("" ::: "memory");
    const int c = lane & 7;
#pragma unroll
    for (int j = 0; j < 4; ++j) { const int n = (lane >> 3) + 8 * j; const LAS float* s = scr + (8 * c) * 33 + n;
        v4u o; o.x = hwpk(s[0 * 33], s[1 * 33]); o.y = hwpk(s[2 * 33], s[3 * 33]); o.z = hwpk(s[4 * 33], s[5 * 33]); o.w = hwpk(s[6 * 33], s[7 * 33]);
        *(GAS v4u*)(WT + (size_t)(n0 + n) * K + k0 + 8 * c) = o; }
    LDS_WAIT(); asm volatile("" ::: "memory");
}

DI_ void p0_tile_load(const float* W, int N, int k0, int n0, int tid, f32x4 (&wv)[8]) {
    const int row = tid >> 5, c4 = tid & 31;
#pragma unroll
    for (int i = 0; i < 8; ++i) wv[i] = *(const GAS f32x4*)(W + (size_t)(k0 + row + 16 * i) * N + n0 + 4 * c4);
}
DI_ void p0_tile_to_lds(int tid, const f32x4 (&wv)[8], LAS unsigned char* img) {
    const int row = tid >> 5, c4 = tid & 31;
#pragma unroll
    for (int i = 0; i < 8; ++i) { const int k = row + 16 * i; const int col = (2 * c4) ^ (2 * ((k >> 3) & 15));
        *(LAS v2u*)(img + k * 256 + col * 4) = (v2u){hwpk(wv[i].x, wv[i].y), hwpk(wv[i].z, wv[i].w)}; }
}
DI_ void p0_tile_from_lds(bf16* WT, int K, int k0, int n0, int tid, LAS unsigned char* img) {
    __syncthreads();
    const int kc = tid & 15;
#pragma unroll
    for (int j = 0; j < 4; ++j) { const int n = (tid >> 4) + 32 * j; unsigned short hv[8];
#pragma unroll
        for (int e = 0; e < 8; ++e) hv[e] = *(const LAS unsigned short*)(img + (8 * kc + e) * 256 + ((((n >> 1) ^ (2 * kc)) << 2) | ((n & 1) << 1)));
        v4u o; o.x = hv[0] | ((unsigned)hv[1] << 16); o.y = hv[2] | ((unsigned)hv[3] << 16); o.z = hv[4] | ((unsigned)hv[5] << 16); o.w = hv[6] | ((unsigned)hv[7] << 16);
        *(GAS v4u*)(WT + (size_t)(n0 + n) * K + k0 + 8 * kc) = o; }
    __syncthreads();
}
struct P0Tile { const float* W; bf16* WT; int K, N, k0, n0; };
DI_ P0Tile p0_tile_decode(Frame& F, int t) {
    constexpr int T_0 = (D / 128) * (N0 / 128), T_1 = (DI / 128) * (D / 128), T_2 = (D / 128) * (N1 / 128);
    P0Tile p;
    if (t < T_0) { p.W = F.w0in; p.WT = F.WT0IN; p.K = D; p.N = N0; }
    else if (t < T_0 + T_1) { t -= T_0; p.W = F.w0out; p.WT = F.WT0OUT; p.K = DI; p.N = D; }
    else if (t < T_0 + T_1 + T_2) { t -= T_0 + T_1; p.W = F.w1in; p.WT = F.WT1IN; p.K = D; p.N = N1; }
    else { t -= T_0 + T_1 + T_2; p.W = F.w1out; p.WT = F.WT1OUT; p.K = DI; p.N = D; }
    const int nt = p.N / 128, kb = t / nt, nb = t - kb * nt; p.k0 = 128 * kb; p.n0 = 128 * nb; return p;
}
DI_ void p0_transpose_all(Frame& F) {
    constexpr int NT = (D / 128) * (N0 / 128) + 2 * (DI / 128) * (D / 128) + (D / 128) * (N1 / 128);
    f32x4 wv[8];
    int t = F.vcu;
    if (t < NT) { const P0Tile p = p0_tile_decode(F, t); p0_tile_load(p.W, p.N, p.k0, p.n0, F.tid, wv); }
    for (; t < NT; t += F.G) {
        const P0Tile p = p0_tile_decode(F, t);
        p0_tile_to_lds(F.tid, wv, F.lds);
        if (t + F.G < NT) { const P0Tile q = p0_tile_decode(F, t + F.G); p0_tile_load(q.W, q.N, q.k0, q.n0, F.tid, wv); }
        p0_tile_from_lds(p.WT, p.K, p.k0, p.n0, F.tid, F.lds);
    }
}

DI_ void p0_prologue(Frame& F) {
    LAS float* scr = (LAS float*)(F.lds + RING_OFF + F.wave * 16384);
    const int gw = F.vcu * NWAVES + F.wave, NGW = F.G * NWAVES;
    constexpr int I_0 = (D / 64) * (N0 / 32), I_1 = (DI / 64) * (D / 32), I_2 = (D / 64) * (N1 / 32), I_3 = I_1;
    constexpr int NITEMS = I_0 + I_1 + I_2 + I_3;
#if USE_TILE_TRANSPOSE
    p0_transpose_all(F);
#else
    for (int it = gw; it < NITEMS; it += NGW) {
        int r = it;
        if (r < I_0) { p0_transpose_item(F.w0in, D, N0, F.WT0IN, scr, r, F.lane); continue; } r -= I_0;
        if (USE_AUX && USE_L0_MFMA == 2 && F.G == 256) break;
        if (r < I_1) { p0_transpose_item(F.w0out, DI, D, F.WT0OUT, scr, r, F.lane); continue; } r -= I_1;
        if (r < I_2) { p0_transpose_item(F.w1in, D, N1, F.WT1IN, scr, r, F.lane); continue; } r -= I_2;
        p0_transpose_item(F.w1out, DI, D, F.WT1OUT, scr, r, F.lane);
    }
#endif
    for (int m = gw; m < MP; m += NGW) {
        GAS unsigned long long* o8 = (GAS unsigned long long*)(F.XB + (size_t)m * D) + F.lane;
        if (m < MR) {
            const float* src = (m < MX) ? F.x + (size_t)m * D : F.meta + (size_t)(m - MX) * D;
            const GAS f32x4* xr = (const GAS f32x4*)src + F.lane;
#pragma unroll 4
            for (int j = 0; j < 16; ++j) { const f32x4 v = xr[64 * j]; o8[64 * j] = (unsigned long long)hwpk(v.x, v.y) | ((unsigned long long)hwpk(v.z, v.w) << 32); }
        } else {
#pragma unroll 4
            for (int j = 0; j < 16; ++j) o8[64 * j] = 0ull;
        }
    }
    for (int m = MR + gw; m < MP; m += NGW) {
        GAS unsigned long long* o8 = (GAS unsigned long long*)(F.H1B + (size_t)m * D) + F.lane;
#pragma unroll 4
        for (int j = 0; j < 16; ++j) o8[64 * j] = 0ull;
    }
    for (int i = gw * 64 + F.lane; i < 16 * N0 / 8; i += NGW * 64) { const int col8 = i % (N0 / 8); const unsigned v = (col8 >= DI / 8 && col8 < 2 * DI / 8) ? 0x47004700u : 0u;
        *((GAS v4u*)F.Q0 + i) = (v4u){v, v, v, v}; }
    for (int i = gw * 64 + F.lane; i < GL_R * D; i += NGW * 64) { const int n = i / D, k = i - n * D; F.WG1T[i] = (bf16)f2bf(F.wg1[(size_t)k * GL_R + n]); }
    for (int i = gw * 64 + F.lane; i < 8 * 16 * 2 * 64 * 8; i += NGW * 64) {
        const int e = i & 7, ln = (i >> 3) & 63, fr = i >> 9, m2 = fr & 1, s2 = (fr >> 1) & 15, hh = fr >> 5, rA = ln & 15, gA = ln >> 4;
        float v = 0.f; if (gA < 2) v = F.wg2[(size_t)(8 * gA + e) * 4096 + hh * 512 + 32 * s2 + 8 * (rA >> 2) + 4 * m2 + (rA & 3)];
        F.W2F[i] = (bf16)f2bf(v);
    }
    for (int c = gw * 64 + F.lane; c < DI; c += NGW * 64) {
        const float l0 = F.lb_logits[c], l1 = F.lb_logits[DI + c], l2 = F.lb_logits[2 * DI + c];
        const float mx = fmaxf(l0, fmaxf(l1, l2));
        const float e0 = __expf(l0 - mx), e1 = __expf(l1 - mx), e2 = __expf(l2 - mx);
        F.LB0[c] = e0 / (e0 + e1 + e2);
    }
}

DI_ void p2_l0_rec_naive(Frame& F) {
    LAS float* qs = (LAS float*)(F.lds);
    LAS float* fs = qs + 2048;
    LAS float* ks = fs + 2048;
    LAS float* vs = ks + 2048;
    LAS float* pb = vs + 2048;
    const int tid = F.tid, dv = tid & 127, kg = tid >> 7;
    const int lj = tid >> 5, lc = (tid & 31) * 4;
    for (int u = blockIdx.x; u < NB * HG_H; u += F.G) {
        const int b = u >> 6, h = u & 63;
        float S[32];
#pragma unroll
        for (int i = 0; i < 32; ++i) S[i] = 0.f;
        float lbv[4], bfv[4], ngv[4];
#pragma unroll
        for (int i = 0; i < 4; ++i) { lbv[i] = F.LB0[h * 128 + lc + i]; bfv[i] = F.b_f[h * 128 + lc + i]; ngv[i] = F.ng0[h * 128 + lc + i]; }
        for (int tb = 0; tb < 129; ++tb) {
            const int rbase = (tb == 0) ? MX : b * SEQ + 16 * (tb - 1);
            const bf16* row = F.QFIZ + (size_t)(rbase + lj) * N0 + h * 128 + lc;
            {
                const v2u q4 = *(const GAS v2u*)(row), f4 = *(const GAS v2u*)(row + DI), i4 = *(const GAS v2u*)(row + 2 * DI);
                const float qv[4] = {bflo(q4.x), bfhi(q4.x), bflo(q4.y), bfhi(q4.y)};
                const float fv[4] = {bflo(f4.x), bfhi(f4.x), bflo(f4.y), bfhi(f4.y)};
                const float iv[4] = {bflo(i4.x), bfhi(i4.x), bflo(i4.y), bfhi(i4.y)};
#pragma unroll
                for (int i = 0; i < 4; ++i) {
                    const float fg = lbv[i] + (1.f - lbv[i]) * sigm(fv[i] + bfv[i]);
                    qs[lj * 128 + lc + i] = silu(qv[i]); fs[lj * 128 + lc + i] = fg; ks[lj * 128 + lc + i] = 1.f - fg; vs[lj * 128 + lc + i] = iv[i];
                }
            }
            __syncthreads();
            for (int j = 0; j < 16; ++j) {
                const float vj = vs[j * 128 + dv]; float po = 0.f;
#pragma unroll
                for (int i = 0; i < 32; i += 4) {
                    const f32x4 f4 = *(const LAS f32x4*)(fs + j * 128 + kg * 32 + i), k4 = *(const LAS f32x4*)(ks + j * 128 + kg * 32 + i), q4 = *(const LAS f32x4*)(qs + j * 128 + kg * 32 + i);
                    S[i + 0] = f4.x * S[i + 0] + k4.x * vj; po += q4.x * S[i + 0];
                    S[i + 1] = f4.y * S[i + 1] + k4.y * vj; po += q4.y * S[i + 1];
                    S[i + 2] = f4.z * S[i + 2] + k4.z * vj; po += q4.z * S[i + 2];
                    S[i + 3] = f4.w * S[i + 3] + k4.w * vj; po += q4.w * S[i + 3];
                }
                pb[(j * 4 + kg) * 128 + dv] = po;
            }
            __syncthreads();
            {
                f32x4 o = *(const LAS f32x4*)(pb + (lj * 4 + 0) * 128 + lc);
                o += *(const LAS f32x4*)(pb + (lj * 4 + 1) * 128 + lc);
                o += *(const LAS f32x4*)(pb + (lj * 4 + 2) * 128 + lc);
                o += *(const LAS f32x4*)(pb + (lj * 4 + 3) * 128 + lc);
                float ss = o.x * o.x + o.y * o.y + o.z * o.z + o.w * o.w;
                ss += __shfl_xor(ss, 16); ss += __shfl_xor(ss, 8); ss += __shfl_xor(ss, 4); ss += __shfl_xor(ss, 2); ss += __shfl_xor(ss, 1);
                const float rs = rsqrtf(ss * (1.f / 128.f) + RMS_EPS);
                const v2u z4 = *(const GAS v2u*)(row + 3 * DI);
                const float y0 = o.x * rs * ngv[0] * silu(bflo(z4.x)), y1 = o.y * rs * ngv[1] * silu(bfhi(z4.x));
                const float y2 = o.z * rs * ngv[2] * silu(bflo(z4.y)), y3 = o.w * rs * ngv[3] * silu(bfhi(z4.y));
                if (tb > 0 || b == 0) { v2u w; w.x = pk2(y0, y1); w.y = pk2(y2, y3); *(GAS v2u*)(F.Y + (size_t)(rbase + lj) * DI + h * 128 + lc) = w; }
            }
        }
        __syncthreads();
    }
}

DI_ void ln_phase(Frame& F, const float* src, int nrows, const float* g, const float* bt, float* dst32, bf16* dstb, float* G1) {
    const int gw = F.vcu * NWAVES + F.wave, NGW = F.G * NWAVES;
    for (int r = gw; r < nrows; r += NGW) {
        const GAS f32x4* s = (const GAS f32x4*)(src + (size_t)r * D) + F.lane;
        f32x4 v[16]; float sm = 0.f;
#pragma unroll
        for (int j = 0; j < 16; ++j) { v[j] = s[64 * j]; sm += (v[j].x + v[j].y) + (v[j].z + v[j].w); }
        const float mean = wave_sum(sm) * (1.f / D); float s2 = 0.f;
#pragma unroll
        for (int j = 0; j < 16; ++j) { v[j] = v[j] - mean; s2 += (v[j].x * v[j].x + v[j].y * v[j].y) + (v[j].z * v[j].z + v[j].w * v[j].w); }
        const float rstd = rsqrtf(wave_sum(s2) * (1.f / D) + LN_EPS);
#pragma unroll
        for (int j = 0; j < 16; ++j) {
            const f32x4 gg = *((const GAS f32x4*)g + F.lane + 64 * j), bb = *((const GAS f32x4*)bt + F.lane + 64 * j);
            v[j] = v[j] * rstd * gg + bb;
            if (dst32) *((GAS f32x4*)(dst32 + (size_t)r * D) + F.lane + 64 * j) = v[j];
            if (dstb) { v2u w; w.x = hwpk(v[j].x, v[j].y); w.y = hwpk(v[j].z, v[j].w); *((GAS v2u*)(dstb + (size_t)r * D) + F.lane + 64 * j) = w; }
            if ((j & 3) == 3) asm volatile("" ::: "memory");
        }
        if (G1) {
            LAS float* rowbuf = (LAS float*)(F.lds + RING_OFF + F.wave * 16384);
#pragma unroll
            for (int j = 0; j < 16; ++j) *(LAS f32x4*)(rowbuf + 256 * j + 4 * F.lane) = v[j];
            LDS_WAIT(); asm volatile("" ::: "memory");
            float a[16];
#pragma unroll
            for (int q = 0; q < 16; ++q) a[q] = 0.f;
#pragma unroll 2
            for (int i = 0; i < 64; ++i) {
                const int k = 64 * i + F.lane;
                const float e = rowbuf[k];
                const GAS f32x4* w = (const GAS f32x4*)(F.wg1 + (size_t)k * GL_R);
                const f32x4 w0 = w[0], w1 = w[1], w2 = w[2], w3 = w[3];
                a[0] += e * w0.x; a[1] += e * w0.y; a[2] += e * w0.z; a[3] += e * w0.w;
                a[4] += e * w1.x; a[5] += e * w1.y; a[6] += e * w1.z; a[7] += e * w1.w;
                a[8] += e * w2.x; a[9] += e * w2.y; a[10] += e * w2.z; a[11] += e * w2.w;
                a[12] += e * w3.x; a[13] += e * w3.y; a[14] += e * w3.z; a[15] += e * w3.w;
            }
#pragma unroll
            for (int q = 0; q < 16; ++q) a[q] = wave_sum(a[q]);
            if (F.lane == 0) {
#pragma unroll
                for (int q = 0; q < 16; q += 4) *(GAS f32x4*)(G1 + (size_t)r * GL_R + q) = (f32x4){a[q], a[q + 1], a[q + 2], a[q + 3]};
            }
            LDS_WAIT(); asm volatile("" ::: "memory");
        }
    }
}

DI_ void p6_l1_rec_naive(Frame& F) {
    LAS float* qs = (LAS float*)(F.lds);
    LAS float* ks = qs + 4096;
    LAS float* gs = ks + 4096;
    LAS float* vs = gs + 4096;
    LAS float* pb = vs + 512;
    const int tid = F.tid, dv = tid & 63, kg = tid >> 6;
    const float qscale = 0.04419417382415922f;
    for (int u = blockIdx.x; u < NB * GL_H * 16; u += F.G) {
        const int dvs = u & 15, bh = u >> 4, b = bh >> 3, h = bh & 7;
        float S[64];
#pragma unroll
        for (int i = 0; i < 64; ++i) S[i] = 0.f;
        float w2[16];
#pragma unroll
        for (int r = 0; r < 16; ++r) w2[r] = F.wg2[(size_t)r * 4096 + h * 512 + tid];
        const float bg = F.b_g[h * 512 + tid];
        for (int tb = 0; tb < 258; ++tb) {
            const int rbase = (tb < 2) ? MX + 8 * tb : b * SEQ + 8 * (tb - 2);
            for (int j = 0; j < 8; ++j) {
                const size_t r = (size_t)(rbase + j);
                const float q = bf2f(F.QFIZ[r * N1 + h * 512 + tid]) * qscale, k = bf2f(F.QFIZ[r * N1 + 4096 + h * 512 + tid]);
                const float* g1 = F.G1 + r * GL_R;
                float xg = bg;
#pragma unroll
                for (int rr = 0; rr < 16; ++rr) xg += g1[rr] * w2[rr];
                const float ls = fminf(xg, 0.f) - log1pf(__expf(-fabsf(xg)));
                qs[j * 512 + tid] = q; ks[j * 512 + tid] = k; gs[j * 512 + tid] = __expf(ls * (1.f / 16.f));
            }
            vs[tid] = bf2f(F.QFIZ[(size_t)(rbase + (tid >> 6)) * N1 + 8192 + h * 1024 + dvs * 64 + (tid & 63)]);
            __syncthreads();
            for (int j = 0; j < 8; ++j) {
                const float vj = vs[j * 64 + dv]; float po = 0.f;
#pragma unroll
                for (int i = 0; i < 64; i += 4) {
                    const f32x4 g4 = *(const LAS f32x4*)(gs + j * 512 + kg * 64 + i), k4 = *(const LAS f32x4*)(ks + j * 512 + kg * 64 + i), q4 = *(const LAS f32x4*)(qs + j * 512 + kg * 64 + i);
                    S[i + 0] = g4.x * S[i + 0] + k4.x * vj; po += q4.x * S[i + 0];
                    S[i + 1] = g4.y * S[i + 1] + k4.y * vj; po += q4.y * S[i + 1];
                    S[i + 2] = g4.z * S[i + 2] + k4.z * vj; po += q4.z * S[i + 2];
                    S[i + 3] = g4.w * S[i + 3] + k4.w * vj; po += q4.w * S[i + 3];
                    if ((i & 12) == 12) asm volatile("" ::: "memory");
                }
                pb[(j * 8 + kg) * 64 + dv] = po;
            }
            __syncthreads();
            {
                const int j = tid >> 6, d = tid & 63; float o = 0.f;
#pragma unroll
                for (int g = 0; g < 8; ++g) o += pb[(j * 8 + g) * 64 + d];
                if (tb >= 2 || b == 0) F.O1[(size_t)(rbase + j) * DI + h * 1024 + dvs * 64 + d] = o;
            }
        }
        __syncthreads();
    }
}

DI_ void p7_normgate(Frame& F) {
    const int gw = F.vcu * NWAVES + F.wave, NGW = F.G * NWAVES;
    for (int it = gw; it < MX * GL_H; it += NGW) {
        const int r = it >> 3, h = it & 7;
        const GAS v4u* o = (const GAS v4u*)((const bf16*)F.O1 + (size_t)r * DI + h * 1024) + F.lane;
        const GAS v4u* zp = (const GAS v4u*)(F.QFIZ + (size_t)r * N1 + 16384 + h * 1024) + F.lane;
        v4u ov[2], zv[2]; float ss = 0.f;
#pragma unroll
        for (int j = 0; j < 2; ++j) { ov[j] = o[64 * j]; zv[j] = zp[64 * j]; }
        float x[2][8];
#pragma unroll
        for (int j = 0; j < 2; ++j) { x[j][0] = bflo(ov[j].x); x[j][1] = bfhi(ov[j].x); x[j][2] = bflo(ov[j].y); x[j][3] = bfhi(ov[j].y); x[j][4] = bflo(ov[j].z); x[j][5] = bfhi(ov[j].z); x[j][6] = bflo(ov[j].w); x[j][7] = bfhi(ov[j].w);
#pragma unroll
            for (int e = 0; e < 8; ++e) ss += x[j][e] * x[j][e]; }
        const float rs = rsqrtf(wave_sum(ss) * (1.f / 1024.f) + RMS_EPS);
#pragma unroll
        for (int j = 0; j < 2; ++j) {
            const int c = h * 1024 + 512 * j + 8 * F.lane;
            const f32x4 n0 = *(const GAS f32x4*)(F.ng1 + c), n1 = *(const GAS f32x4*)(F.ng1 + c + 4);
            const float z[8] = {bflo(zv[j].x), bfhi(zv[j].x), bflo(zv[j].y), bfhi(zv[j].y), bflo(zv[j].z), bfhi(zv[j].z), bflo(zv[j].w), bfhi(zv[j].w)};
            v4u wv; wv.x = pk2(x[j][0] * rs * n0.x * silu(z[0]), x[j][1] * rs * n0.y * silu(z[1])); wv.y = pk2(x[j][2] * rs * n0.z * silu(z[2]), x[j][3] * rs * n0.w * silu(z[3]));
            wv.z = pk2(x[j][4] * rs * n1.x * silu(z[4]), x[j][5] * rs * n1.y * silu(z[5])); wv.w = pk2(x[j][6] * rs * n1.z * silu(z[6]), x[j][7] * rs * n1.w * silu(z[7]));
            *(GAS v4u*)(F.Y + (size_t)r * DI + c) = wv;
        }
    }
}

typedef short bf16x8 __attribute__((ext_vector_type(8)));
constexpr int NCH = 65;
constexpr float LOG2E = 1.4426950408889634f;
constexpr int R1_QD = 0, R1_KD = 32768, R1_P = 65536, R1_GL = 67584, R1_SH = 69632;
constexpr int ST1 = R1_SH + 8192;
constexpr int R0_QD = 0, R0_KD = 8192, R0_P = 16384, R0_V = 18432, R0_GL = 26624, R0_SZ = 27648;
constexpr int ST0 = R0_SZ;

DI_ unsigned cvtpk(float lo, float hi) { unsigned r; asm volatile("v_cvt_pk_bf16_f32 %0, %1, %2" : "=v"(r) : "v"(lo), "v"(hi)); return r; }
template <int N> DI_ float row_shr(float x) { return __builtin_bit_cast(float, __builtin_amdgcn_update_dpp(0, __builtin_bit_cast(int, x), 0x110 + N, 0xF, 0xF, true)); }
DI_ float bcast15(float x) { return __builtin_bit_cast(float, __builtin_amdgcn_update_dpp(0, __builtin_bit_cast(int, x), 0x15F, 0xF, 0xF, true)); }
DI_ float scan16(float x) { x += row_shr<1>(x); x += row_shr<2>(x); x += row_shr<4>(x); x += row_shr<8>(x); return x; }
DI_ float ex2(float x) { return __builtin_amdgcn_exp2f(x); }
DI_ float lg2(float x) { return __builtin_amdgcn_logf(x); }
DI_ int row_of(int b, int c, int tok) { return c == 0 ? MX + tok - 16 : b * SEQ + 32 * (c - 1) + tok; }
DI_ bf16x8 mk8(unsigned a, unsigned b, unsigned c, unsigned d) { v4u t; t.x = a; t.y = b; t.z = c; t.w = d; return __builtin_bit_cast(bf16x8, t); }
#define MFMA16(a, b, c) __builtin_amdgcn_mfma_f32_16x16x32_bf16((a), (b), (c), 0, 0, 0)

DI_ void l1_prep(Frame& F, unsigned char* REC1, unsigned char* VF1, const bf16* W2F) {
    const int lane = F.lane, w = F.wave, r = lane & 15, g = lane >> 4;
    LAS unsigned char* T = F.lds + w * 16384;
    LAS unsigned char* Tv = F.lds + w * 16384 + 4096;
    LAS f32x4* Pp = (LAS f32x4*)(F.lds + 131072);
    const float qscale = 0.04419417382415922f;
    for (int it = blockIdx.x; it < NB * GL_H * NCH; it += F.G) {
        const int bh = it / NCH, c = it - bh * NCH, b = bh >> 3, h = bh & 7;
        unsigned char* rec = REC1 + (size_t)it * R1_SH;
        int row[2]; bool nul[2];
#pragma unroll
        for (int ti = 0; ti < 2; ++ti) { const int tok = 16 * ti + r; nul[ti] = (c == 0 && tok < 16); row[ti] = nul[ti] ? 0 : row_of(b, c, tok); }
        bf16x8 g1f[2];
#pragma unroll
        for (int ti = 0; ti < 2; ++ti) {
            f32x4 t0 = (f32x4){0.f, 0.f, 0.f, 0.f}, t1 = t0;
            if (g < 2) { const GAS f32x4* gp = (const GAS f32x4*)(F.G1 + (size_t)row[ti] * GL_R + 8 * g); t0 = gp[0]; t1 = gp[1]; }
            g1f[ti] = mk8(pk2(t0.x, t0.y), pk2(t0.z, t0.w), pk2(t1.x, t1.y), pk2(t1.z, t1.w));
        }
        f32x4 pacc[3];
#pragma unroll
        for (int t = 0; t < 3; ++t) pacc[t] = (f32x4){0.f, 0.f, 0.f, 0.f};
        v4u qraw[2][2], kraw[2][2];
#pragma unroll
        for (int si = 0; si < 2; ++si)
#pragma unroll
            for (int ti = 0; ti < 2; ++ti) { const bf16* rp = F.QFIZ + (size_t)row[ti] * N1 + h * 512 + 32 * (2 * w + si) + 8 * g; qraw[si][ti] = *(const GAS v4u*)rp; kraw[si][ti] = *(const GAS v4u*)(rp + 4096); }
        asm volatile("" ::: "memory");
#pragma unroll
        for (int si = 0; si < 2; ++si) {
            const int s = 2 * w + si, col = h * 512 + 32 * s + 8 * g;
            float xg[2][8];
            { const f32x4 b0 = *(const GAS f32x4*)(F.b_g + col), b1 = *(const GAS f32x4*)(F.b_g + col + 4);
              const bf16x8 wa = *(const GAS bf16x8*)(W2F + ((size_t)((h * 16 + s) * 2 + 0) * 64 + lane) * 8), wb = *(const GAS bf16x8*)(W2F + ((size_t)((h * 16 + s) * 2 + 1) * 64 + lane) * 8);
#pragma unroll
              for (int ti = 0; ti < 2; ++ti) { const f32x4 xa = MFMA16(wa, g1f[ti], b0), xb = MFMA16(wb, g1f[ti], b1);
                  xg[ti][0] = xa.x; xg[ti][1] = xa.y; xg[ti][2] = xa.z; xg[ti][3] = xa.w; xg[ti][4] = xb.x; xg[ti][5] = xb.y; xg[ti][6] = xb.z; xg[ti][7] = xb.w; } }
            float qv[2][8], kv[2][8];
#pragma unroll
            for (int ti = 0; ti < 2; ++ti) {
                const v4u q4 = qraw[si][ti], k4 = kraw[si][ti];
                qv[ti][0] = bflo(q4.x); qv[ti][1] = bfhi(q4.x); qv[ti][2] = bflo(q4.y); qv[ti][3] = bfhi(q4.y); qv[ti][4] = bflo(q4.z); qv[ti][5] = bfhi(q4.z); qv[ti][6] = bflo(q4.w); qv[ti][7] = bfhi(q4.w);
                kv[ti][0] = bflo(k4.x); kv[ti][1] = bfhi(k4.x); kv[ti][2] = bflo(k4.y); kv[ti][3] = bfhi(k4.y); kv[ti][4] = bflo(k4.z); kv[ti][5] = bfhi(k4.z); kv[ti][6] = bflo(k4.w); kv[ti][7] = bfhi(k4.w);
            }
            unsigned qd[2][4], ki[2][4], kd[2][4]; float gl[8];
#pragma unroll
            for (int e = 0; e < 8; e += 2) {
                float bb[2][2], BB[2];
#pragma unroll
                for (int u = 0; u < 2; ++u) {
                    float L0 = nul[0] ? 0.f : (fminf(xg[0][e + u], 0.f) * LOG2E - lg2(1.f + ex2(-fabsf(xg[0][e + u]) * LOG2E))) * (1.f / 16.f);
                    float L1 = nul[1] ? 0.f : (fminf(xg[1][e + u], 0.f) * LOG2E - lg2(1.f + ex2(-fabsf(xg[1][e + u]) * LOG2E))) * (1.f / 16.f);
                    const float b0 = scan16(L0);
                    const float b1 = scan16(L1) + bcast15(b0);
                    bb[0][u] = b0; bb[1][u] = b1; BB[u] = bcast15(b1);
                    gl[e + u] = ex2(BB[u]);
                }
#pragma unroll
                for (int ti = 0; ti < 2; ++ti) {
                    const float q0 = nul[ti] ? 0.f : qv[ti][e] * qscale, q1 = nul[ti] ? 0.f : qv[ti][e + 1] * qscale;
                    const float k0 = nul[ti] ? 0.f : kv[ti][e], k1 = nul[ti] ? 0.f : kv[ti][e + 1];
                    qd[ti][e >> 1] = cvtpk(q0 * ex2(bb[ti][0]), q1 * ex2(bb[ti][1]));
                    ki[ti][e >> 1] = cvtpk(k0 * ex2(-bb[ti][0]), k1 * ex2(-bb[ti][1]));
                    kd[ti][e >> 1] = cvtpk(k0 * ex2(BB[0] - bb[ti][0]), k1 * ex2(BB[1] - bb[ti][1]));
                }
            }
            const bf16x8 qf0 = mk8(qd[0][0], qd[0][1], qd[0][2], qd[0][3]), qf1 = mk8(qd[1][0], qd[1][1], qd[1][2], qd[1][3]);
            const bf16x8 kf0 = mk8(ki[0][0], ki[0][1], ki[0][2], ki[0][3]), kf1 = mk8(ki[1][0], ki[1][1], ki[1][2], ki[1][3]);
            pacc[0] = MFMA16(kf0, qf0, pacc[0]);
            pacc[1] = MFMA16(kf0, qf1, pacc[1]);
            pacc[2] = MFMA16(kf1, qf1, pacc[2]);
#pragma unroll
            for (int ti = 0; ti < 2; ++ti)
#pragma unroll
                for (int h2 = 0; h2 < 2; ++h2) {
                    const int lp = (2 * (g & 1) + h2) * 16 + r;
                    v2u d; d.x = qd[ti][2 * h2]; d.y = qd[ti][2 * h2 + 1];
                    *(GAS v2u*)(rec + R1_QD + ((ti * 16 + s) * 64 + lp) * 16 + (g >> 1) * 8) = d;
                }
#pragma unroll
            for (int ti = 0; ti < 2; ++ti)
#pragma unroll
                for (int e = 0; e < 8; ++e) {
                    const unsigned wd = kd[ti][e >> 1]; const unsigned short hv = (e & 1) ? (unsigned short)(wd >> 16) : (unsigned short)(wd & 0xffffu);
                    *(LAS unsigned short*)(T + (32 * si + 8 * g + e) * 64 + (16 * ti + r) * 2) = hv;
                }
            if (r == 0) { *(GAS f32x4*)(rec + R1_GL + (32 * s + 8 * g) * 4) = (f32x4){gl[0], gl[1], gl[2], gl[3]}; *(GAS f32x4*)(rec + R1_GL + (32 * s + 8 * g + 4) * 4) = (f32x4){gl[4], gl[5], gl[6], gl[7]}; }
        }
#pragma unroll
        for (int t = 0; t < 3; ++t) Pp[(w * 3 + t) * 64 + lane] = pacc[t];
        LDS_WAIT(); asm volatile("" ::: "memory");
#pragma unroll
        for (int ml = 0; ml < 4; ++ml) { const v4u d = *(const LAS v4u*)(T + (16 * ml + r) * 64 + 16 * g); *(GAS v4u*)(rec + R1_KD + ((4 * w + ml) * 64 + lane) * 16) = d; }
        __syncthreads();
        if (w < 4) {
            const int tj = (w == 2 || w == 3) ? 1 : 0, ti = (w == 1 || w == 2) ? 1 : 0;
            f32x4 sum = (f32x4){0.f, 0.f, 0.f, 0.f};
            if (w < 3) {
#pragma unroll
                for (int ww = 0; ww < 8; ++ww) sum += Pp[(ww * 3 + w) * 64 + lane];
            }
            float pv[4] = {sum.x, sum.y, sum.z, sum.w};
#pragma unroll
            for (int jj = 0; jj < 4; ++jj) { const int j = 16 * tj + 4 * g + jj, i = 16 * ti + r; if (j > i) pv[jj] = 0.f; }
            const int lp = (2 * tj + (g >> 1)) * 16 + r;
            v2u d; d.x = cvtpk(pv[0], pv[1]); d.y = cvtpk(pv[2], pv[3]);
            *(GAS v2u*)(rec + R1_P + (ti * 64 + lp) * 16 + 8 * (g & 1)) = d;
        }
        __syncthreads();
    }
}

template <int VAR> DI_ void l1_seq(Frame& F, const unsigned char* REC1, const unsigned char* VF1, float* O1) {
    const int lane = F.lane, w = F.wave, r = lane & 15, g = lane >> 4;
    for (int u = F.vcu; u < NB * GL_H * 8; u += F.G) {
        const int bh = u >> 3, ds = u & 7, b = bh >> 3, h = bh & 7;
        f32x4 acc[32];
#pragma unroll
        for (int m = 0; m < 32; ++m) acc[m] = (f32x4){0.f, 0.f, 0.f, 0.f};
#define L1_DMA(c_) do { const unsigned char* rs_ = REC1 + (size_t)(bh * NCH + (c_)) * R1_SH; LAS unsigned char* st_ = F.lds + ((c_) & 1) * ST1; \
        for (int p_ = w; p_ < 76; p_ += 8) { const unsigned char* src_; \
            if (p_ < 68) src_ = rs_ + p_ * 1024 + lane * 16; \
            else { const int tk_ = 4 * (p_ - 68) + (lane >> 4);         \
                   src_ = ((c_) == 0 && tk_ < 16) ? (const unsigned char*)(F.H1B + (size_t)MR * D) + (lane & 15) * 16 \
                        : (const unsigned char*)(F.QFIZ + (size_t)row_of(b, (c_), tk_) * N1 + 8192 + h * 1024 + ds * 128) + (lane & 15) * 16; } \
            __builtin_amdgcn_global_load_lds((const unsigned*)src_, (LAS unsigned*)(st_ + p_ * 1024), 16, 0, 0); } } while (0)
        if (VAR != 1) L1_DMA(0);
        for (int c = 0; c < NCH; ++c) {
            asm volatile("s_waitcnt vmcnt(0)" ::: "memory");
            __builtin_amdgcn_s_barrier();
            asm volatile("" ::: "memory");
            if (VAR != 1 && c + 1 < NCH) L1_DMA(c + 1);
            if (VAR == 2) continue;
            const LAS unsigned char* st = F.lds + (c & 1) * ST1;
            unsigned short vh[8];
#pragma unroll
            for (int e = 0; e < 8; ++e) vh[e] = *(const LAS unsigned short*)(st + R1_SH + (8 * g + e) * 256 + (16 * w + r) * 2);
            const bf16x8 vf = mk8(vh[0] | ((unsigned)vh[1] << 16), vh[2] | ((unsigned)vh[3] << 16), vh[4] | ((unsigned)vh[5] << 16), vh[6] | ((unsigned)vh[7] << 16));
#define SCHED_FENCE() __builtin_amdgcn_sched_barrier(0)
            if (c > 0) {
                f32x4 o0 = (f32x4){0.f, 0.f, 0.f, 0.f}, o1 = o0;
                bf16x8 qb[2][4];
#define LDQ(buf_, gi_) do { _Pragma("unroll") for (int sl_ = 0; sl_ < 2; ++sl_) { qb[buf_][sl_] = *(const LAS bf16x8*)(st + R1_QD + (2 * (gi_) + sl_) * 1024 + lane * 16); \
                    qb[buf_][2 + sl_] = *(const LAS bf16x8*)(st + R1_QD + (16 + 2 * (gi_) + sl_) * 1024 + lane * 16); } } while (0)
                const bf16x8 p0 = *(const LAS bf16x8*)(st + R1_P + lane * 16), p1 = *(const LAS bf16x8*)(st + R1_P + 1024 + lane * 16);
                LDQ(0, 0);
                SCHED_FENCE();
                o0 = MFMA16(vf, p0, o0); o1 = MFMA16(vf, p1, o1);
#pragma unroll
                for (int gi = 0; gi < 8; ++gi) {
                    if (gi < 7) LDQ((gi + 1) & 1, gi + 1);
                    SCHED_FENCE();
#pragma unroll
                    for (int sl = 0; sl < 2; ++sl) { const int s2 = 2 * gi + sl;
                        const bf16x8 sb = mk8(cvtpk(acc[2 * s2].x, acc[2 * s2].y), cvtpk(acc[2 * s2].z, acc[2 * s2].w), cvtpk(acc[2 * s2 + 1].x, acc[2 * s2 + 1].y), cvtpk(acc[2 * s2 + 1].z, acc[2 * s2 + 1].w));
                        o0 = MFMA16(sb, qb[gi & 1][sl], o0); o1 = MFMA16(sb, qb[gi & 1][2 + sl], o1); }
                    SCHED_FENCE();
                }
#undef LDQ
                if (VAR == 1) { asm volatile("" :: "v"(o0), "v"(o1)); } else {
                    bf16* op = (bf16*)O1 + (size_t)(b * SEQ + 32 * (c - 1) + r) * DI + h * 1024 + ds * 128 + 16 * w + 4 * g;
                    *(GAS v2u*)op = (v2u){pk2(o0.x, o0.y), pk2(o0.z, o0.w)}; *(GAS v2u*)(op + (size_t)16 * DI) = (v2u){pk2(o1.x, o1.y), pk2(o1.z, o1.w)}; }
            }
            {
                f32x4 ug[2][4]; bf16x8 uk[2][4];
#define LDU(buf_, gi_) do { _Pragma("unroll") for (int ml_ = 0; ml_ < 4; ++ml_) { const int m_ = 4 * (gi_) + ml_; ug[buf_][ml_] = *(const LAS f32x4*)(st + R1_GL + (16 * m_ + 4 * g) * 4); \
                    uk[buf_][ml_] = *(const LAS bf16x8*)(st + R1_KD + m_ * 1024 + lane * 16); } } while (0)
                LDU(0, 0);
                SCHED_FENCE();
#pragma unroll
                for (int gi = 0; gi < 8; ++gi) {
                    if (gi < 7) LDU((gi + 1) & 1, gi + 1);
                    SCHED_FENCE();
#pragma unroll
                    for (int ml = 0; ml < 4; ++ml) { const int m = 4 * gi + ml; acc[m] = MFMA16(uk[gi & 1][ml], vf, acc[m] * ug[gi & 1][ml]); }
                    SCHED_FENCE();
                }
#undef LDU
            }
        }
#undef L1_DMA
        if (VAR == 1) { _Pragma("unroll") for (int m = 0; m < 32; ++m) asm volatile("" :: "v"(acc[m])); }
        asm volatile("s_waitcnt vmcnt(0)" ::: "memory");
        __builtin_amdgcn_s_barrier();
    }
}

constexpr int R2_QD = 0, R2_KD = 32768, R2_P = 65536, R2_GL = 67584, ST2 = 69632, X2_OFF = 2 * ST2;
DI_ void l1_seq2(Frame& F, const unsigned char* REC1) {
    const int lane = F.lane, w = F.wave, r = lane & 15, g = lane >> 4, dkh = w >> 2, dvq = w & 3;
    for (int u = F.vcu; u < NB * GL_H * 8; u += F.G) {
        const int bh = u >> 3, ds = u & 7, b = bh >> 3, h = bh & 7;
        f32x4 acc[16][2];
#pragma unroll
        for (int m = 0; m < 16; ++m) { acc[m][0] = (f32x4){0.f, 0.f, 0.f, 0.f}; acc[m][1] = acc[m][0]; }
        const int vcol = 8192 + h * 1024 + ds * 128 + 32 * dvq + r;
        int voff[8];
#pragma unroll
        for (int e = 0; e < 8; ++e) voff[e] = (8 * g + e) * N1 + vcol;
        const bf16* xv = F.QFIZ + (size_t)(b * SEQ - 32) * N1;
#define VCH(c_) (((c_) == 0) ? F.QFIZ + (size_t)(MX - 16) * N1 : xv + (size_t)(c_) * 32 * N1)
#define L2_DMA(c_) do { const unsigned char* rs_ = REC1 + (size_t)(bh * NCH + (c_)) * R1_SH; LAS unsigned char* st_ = F.lds + ((c_) & 1) * ST2; \
        _Pragma("unroll") for (int i_ = 0; i_ < 8; ++i_) { const int p_ = w + 8 * i_; __builtin_amdgcn_global_load_lds((const unsigned*)(rs_ + p_ * 1024 + lane * 16), (LAS unsigned*)(st_ + p_ * 1024), 16, 0, 0); } \
        if (w < 4) __builtin_amdgcn_global_load_lds((const unsigned*)(rs_ + (w + 64) * 1024 + lane * 16), (LAS unsigned*)(st_ + (w + 64) * 1024), 16, 0, 0); } while (0)
#define L2_VLOAD(c_, set_) do { const bf16* vb_ = VCH(c_); _Pragma("unroll") for (int e_ = 0; e_ < 8; ++e_) { vr[set_][0][e_] = (unsigned)*(const GAS unsigned short*)(vb_ + voff[e_]); vr[set_][1][e_] = (unsigned)*(const GAS unsigned short*)(vb_ + voff[e_] + 16); } } while (0)
        unsigned vr[2][2][8];
        f32x4 keep[2][2];
        L2_DMA(0); L2_VLOAD(0, 0);
#define L2_BODY(C_, PAR) do { const int c = (C_); \
            asm volatile("s_waitcnt vmcnt(0)" ::: "memory"); \
            __builtin_amdgcn_s_barrier(); \
            asm volatile("" ::: "memory"); \
            if (c >= 2 && c <= NCH) {                                  \
                const v4u px = *(const LAS v4u*)(F.lds + X2_OFF + (PAR ^ 1) * 8192 + (w ^ 4) * 1024 + lane * 16); \
                const f32x4 a0 = keep[PAR ^ 1][0] + (f32x4){bflo(px.x), bfhi(px.x), bflo(px.y), bfhi(px.y)}, a1 = keep[PAR ^ 1][1] + (f32x4){bflo(px.z), bfhi(px.z), bflo(px.w), bfhi(px.w)}; \
                bf16* op = (bf16*)F.O1 + (size_t)(b * SEQ + 32 * (c - 2) + r) * DI + h * 1024 + ds * 128 + 32 * dvq + 16 * dkh + 4 * g; \
                *(GAS v2u*)op = (v2u){pk2(a0.x, a0.y), pk2(a0.z, a0.w)}; *(GAS v2u*)(op + (size_t)16 * DI) = (v2u){pk2(a1.x, a1.y), pk2(a1.z, a1.w)}; } \
            if (c + 1 < NCH) { L2_VLOAD(c + 1, PAR ^ 1); L2_DMA(c + 1); }          \
            if (c < NCH) { \
                const LAS unsigned char* st = F.lds + (c & 1) * ST2; \
                bf16x8 vf[2]; \
                _Pragma("unroll") for (int t_ = 0; t_ < 2; ++t_) { _Pragma("unroll") for (int e_ = 0; e_ < 8; ++e_) asm volatile("" : "+v"(vr[PAR][t_][e_]));     \
                    vf[t_] = mk8(vr[PAR][t_][0] | (vr[PAR][t_][1] << 16), vr[PAR][t_][2] | (vr[PAR][t_][3] << 16), vr[PAR][t_][4] | (vr[PAR][t_][5] << 16), vr[PAR][t_][6] | (vr[PAR][t_][7] << 16)); } \
                const LAS f32x4* glp = (const LAS f32x4*)(st + R2_GL + (256 * dkh + 4 * g) * 4); \
                f32x4 ug[2][2]; bf16x8 uk[2][2]; \
                if (c > 0) { \
                    f32x4 o[2][2]; \
                    _Pragma("unroll") for (int ti = 0; ti < 2; ++ti) { o[ti][0] = (f32x4){0.f, 0.f, 0.f, 0.f}; o[ti][1] = o[ti][0]; } \
                    if (dkh == 0) { const bf16x8 p0 = *(const LAS bf16x8*)(st + R2_P + lane * 16), p1 = *(const LAS bf16x8*)(st + R2_P + 1024 + lane * 16); \
                        o[0][0] = MFMA16(vf[0], p0, o[0][0]); o[0][1] = MFMA16(vf[1], p0, o[0][1]); o[1][0] = MFMA16(vf[0], p1, o[1][0]); o[1][1] = MFMA16(vf[1], p1, o[1][1]); } \
                    bf16x8 qb[2][2]; \
                    qb[0][0] = *(const LAS bf16x8*)(st + R2_QD + (8 * dkh) * 1024 + lane * 16); qb[0][1] = *(const LAS bf16x8*)(st + R2_QD + (16 + 8 * dkh) * 1024 + lane * 16); \
                    SCHED_FENCE(); \
                    _Pragma("unroll") for (int s2 = 0; s2 < 8; ++s2) { \
                        if (s2 < 7) { qb[(s2 + 1) & 1][0] = *(const LAS bf16x8*)(st + R2_QD + (8 * dkh + s2 + 1) * 1024 + lane * 16); qb[(s2 + 1) & 1][1] = *(const LAS bf16x8*)(st + R2_QD + (16 + 8 * dkh + s2 + 1) * 1024 + lane * 16); } \
                        SCHED_FENCE(); \
                        _Pragma("unroll") for (int t_ = 0; t_ < 2; ++t_) { \
                            const bf16x8 sb = mk8(cvtpk(acc[2 * s2][t_].x, acc[2 * s2][t_].y), cvtpk(acc[2 * s2][t_].z, acc[2 * s2][t_].w), cvtpk(acc[2 * s2 + 1][t_].x, acc[2 * s2 + 1][t_].y), cvtpk(acc[2 * s2 + 1][t_].z, acc[2 * s2 + 1][t_].w)); \
                            o[0][t_] = MFMA16(sb, qb[s2 & 1][0], o[0][t_]); o[1][t_] = MFMA16(sb, qb[s2 & 1][1], o[1][t_]); } \
                        SCHED_FENCE(); \
                    } \
                      \
                    { const f32x4 s0 = o[0][dkh ^ 1], s1 = o[1][dkh ^ 1]; \
                      *(LAS v4u*)(F.lds + X2_OFF + PAR * 8192 + w * 1024 + lane * 16) = (v4u){pk2(s0.x, s0.y), pk2(s0.z, s0.w), pk2(s1.x, s1.y), pk2(s1.z, s1.w)}; \
                      keep[PAR][0] = o[0][dkh]; keep[PAR][1] = o[1][dkh]; } \
                } \
                _Pragma("unroll") for (int ml_ = 0; ml_ < 2; ++ml_) { ug[0][ml_] = glp[4 * ml_]; uk[0][ml_] = *(const LAS bf16x8*)(st + R2_KD + (16 * dkh + ml_) * 1024 + lane * 16); } \
                SCHED_FENCE(); \
                _Pragma("unroll") for (int gi = 0; gi < 8; ++gi) { \
                    if (gi < 7) { _Pragma("unroll") for (int ml_ = 0; ml_ < 2; ++ml_) { const int m_ = 2 * (gi + 1) + ml_; ug[(gi + 1) & 1][ml_] = glp[4 * m_]; uk[(gi + 1) & 1][ml_] = *(const LAS bf16x8*)(st + R2_KD + (16 * dkh + m_) * 1024 + lane * 16); } } \
                    SCHED_FENCE(); \
                    _Pragma("unroll") for (int ml = 0; ml < 2; ++ml) { const int m = 2 * gi + ml; \
                        acc[m][0] = MFMA16(uk[gi & 1][ml], vf[0], acc[m][0] * ug[gi & 1][ml]); acc[m][1] = MFMA16(uk[gi & 1][ml], vf[1], acc[m][1] * ug[gi & 1][ml]); } \
                    SCHED_FENCE(); \
                } \
                asm volatile("s_waitcnt lgkmcnt(0)" ::: "memory"); \
            } \
        } while (0)
        for (int c2 = 0; c2 <= NCH; c2 += 2) { L2_BODY(c2, 0); L2_BODY(c2 + 1, 1); }
#undef L2_BODY
#undef L2_VLOAD
#undef L2_DMA
#undef VCH
        asm volatile("s_waitcnt vmcnt(0) lgkmcnt(0)" ::: "memory");
        __builtin_amdgcn_s_barrier();
    }
}

DI_ void l0_prep(Frame& F, unsigned char* REC0) {
    const int lane = F.lane, w = F.wave, r = lane & 15, g = lane >> 4;
    LAS unsigned char* T = F.lds + w * 16640;
    LAS unsigned char* Tv = T + 8192;
    const int gw = F.vcu * NWAVES + w, NGW = F.G * NWAVES;
    for (int it = gw; it < NB * HG_H * NCH; it += NGW) {
        const int bh = it / NCH, c = it - bh * NCH, b = bh >> 6, h = bh & 63;
        unsigned char* rec = REC0 + (size_t)it * R0_SZ;
        int row[2]; bool nul[2];
#pragma unroll
        for (int ti = 0; ti < 2; ++ti) { const int tok = 16 * ti + r; nul[ti] = (c == 0 && tok < 16); row[ti] = nul[ti] ? 0 : row_of(b, c, tok); }
        f32x4 pacc[3];
#pragma unroll
        for (int t = 0; t < 3; ++t) pacc[t] = (f32x4){0.f, 0.f, 0.f, 0.f};
        v4u qraw[4][2], fraw[4][2], vraw[8];
#pragma unroll
        for (int s = 0; s < 4; ++s)
#pragma unroll
            for (int ti = 0; ti < 2; ++ti) { const bf16* rp = F.QFIZ + (size_t)row[ti] * N0 + h * 128 + 32 * s + 8 * g; qraw[s][ti] = *(const GAS v4u*)rp; fraw[s][ti] = *(const GAS v4u*)(rp + DI); }
#pragma unroll
        for (int i = 0; i < 8; ++i) { const int q = lane + 64 * i, tk = q >> 4, c16 = q & 15; const bool nl = (c == 0 && tk < 16);
            vraw[i] = (v4u){0u, 0u, 0u, 0u}; if (!nl) vraw[i] = *(const GAS v4u*)(F.QFIZ + (size_t)row_of(b, c, tk) * N0 + 2 * DI + h * 128 + 8 * c16); }
        asm volatile("" ::: "memory");
#pragma unroll
        for (int s = 0; s < 4; ++s) {
            const int col = h * 128 + 32 * s + 8 * g;
            float lbv[8], bfv[8];
            { const f32x4 a0 = *(const GAS f32x4*)(F.LB0 + col), a1 = *(const GAS f32x4*)(F.LB0 + col + 4), c0 = *(const GAS f32x4*)(F.b_f + col), c1 = *(const GAS f32x4*)(F.b_f + col + 4);
              lbv[0] = a0.x; lbv[1] = a0.y; lbv[2] = a0.z; lbv[3] = a0.w; lbv[4] = a1.x; lbv[5] = a1.y; lbv[6] = a1.z; lbv[7] = a1.w;
              bfv[0] = c0.x; bfv[1] = c0.y; bfv[2] = c0.z; bfv[3] = c0.w; bfv[4] = c1.x; bfv[5] = c1.y; bfv[6] = c1.z; bfv[7] = c1.w; }
            float qv[2][8], fv[2][8];
#pragma unroll
            for (int ti = 0; ti < 2; ++ti) {
                const v4u q4 = qraw[s][ti], f4 = fraw[s][ti];
                qv[ti][0] = bflo(q4.x); qv[ti][1] = bfhi(q4.x); qv[ti][2] = bflo(q4.y); qv[ti][3] = bfhi(q4.y); qv[ti][4] = bflo(q4.z); qv[ti][5] = bfhi(q4.z); qv[ti][6] = bflo(q4.w); qv[ti][7] = bfhi(q4.w);
                fv[ti][0] = bflo(f4.x); fv[ti][1] = bfhi(f4.x); fv[ti][2] = bflo(f4.y); fv[ti][3] = bfhi(f4.y); fv[ti][4] = bflo(f4.z); fv[ti][5] = bfhi(f4.z); fv[ti][6] = bflo(f4.w); fv[ti][7] = bfhi(f4.w);
            }
            unsigned qd[2][4], ki[2][4], kd[2][4]; float gl[8];
#pragma unroll
            for (int e = 0; e < 8; e += 2) {
                float bb[2][2], BB[2], kk[2][2];
#pragma unroll
                for (int u = 0; u < 2; ++u) {
                    const float fg0 = lbv[e + u] + (1.f - lbv[e + u]) * sigm(fv[0][e + u] + bfv[e + u]);
                    const float fg1 = lbv[e + u] + (1.f - lbv[e + u]) * sigm(fv[1][e + u] + bfv[e + u]);
                    const float L0 = nul[0] ? 0.f : lg2(fg0), L1 = nul[1] ? 0.f : lg2(fg1);
                    kk[0][u] = nul[0] ? 0.f : 1.f - fg0; kk[1][u] = nul[1] ? 0.f : 1.f - fg1;
                    const float b0 = scan16(L0);
                    const float b1 = scan16(L1) + bcast15(b0);
                    bb[0][u] = b0; bb[1][u] = b1; BB[u] = bcast15(b1);
                    gl[e + u] = ex2(BB[u]);
                }
#pragma unroll
                for (int ti = 0; ti < 2; ++ti) {
                    const float q0 = nul[ti] ? 0.f : silu(qv[ti][e]), q1 = nul[ti] ? 0.f : silu(qv[ti][e + 1]);
                    qd[ti][e >> 1] = cvtpk(q0 * ex2(bb[ti][0]), q1 * ex2(bb[ti][1]));
                    ki[ti][e >> 1] = cvtpk(kk[ti][0] * ex2(-bb[ti][0]), kk[ti][1] * ex2(-bb[ti][1]));
                    kd[ti][e >> 1] = cvtpk(kk[ti][0] * ex2(BB[0] - bb[ti][0]), kk[ti][1] * ex2(BB[1] - bb[ti][1]));
                }
            }
            const bf16x8 qf0 = mk8(qd[0][0], qd[0][1], qd[0][2], qd[0][3]), qf1 = mk8(qd[1][0], qd[1][1], qd[1][2], qd[1][3]);
            const bf16x8 kf0 = mk8(ki[0][0], ki[0][1], ki[0][2], ki[0][3]), kf1 = mk8(ki[1][0], ki[1][1], ki[1][2], ki[1][3]);
            pacc[0] = MFMA16(kf0, qf0, pacc[0]);
            pacc[1] = MFMA16(kf0, qf1, pacc[1]);
            pacc[2] = MFMA16(kf1, qf1, pacc[2]);
#pragma unroll
            for (int ti = 0; ti < 2; ++ti)
#pragma unroll
                for (int h2 = 0; h2 < 2; ++h2) {
                    const int lp = (2 * (g & 1) + h2) * 16 + r;
                    v2u d; d.x = qd[ti][2 * h2]; d.y = qd[ti][2 * h2 + 1];
                    *(GAS v2u*)(rec + R0_QD + ((ti * 4 + s) * 64 + lp) * 16 + (g >> 1) * 8) = d;
                }
#pragma unroll
            for (int ti = 0; ti < 2; ++ti)
#pragma unroll
                for (int e = 0; e < 8; ++e) {
                    const unsigned wd = kd[ti][e >> 1]; const unsigned short hv = (e & 1) ? (unsigned short)(wd >> 16) : (unsigned short)(wd & 0xffffu);
                    *(LAS unsigned short*)(T + (32 * s + 8 * g + e) * 64 + (16 * ti + r) * 2) = hv;
                }
            if (r == 0) { *(GAS f32x4*)(rec + R0_GL + (32 * s + 8 * g) * 4) = (f32x4){gl[0], gl[1], gl[2], gl[3]}; *(GAS f32x4*)(rec + R0_GL + (32 * s + 8 * g + 4) * 4) = (f32x4){gl[4], gl[5], gl[6], gl[7]}; }
        }
#pragma unroll
        for (int t = 0; t < 4; ++t) {
            const int tj = (t >= 2) ? 1 : 0, ti = (t == 1 || t == 2) ? 1 : 0;
            float pv[4] = {0.f, 0.f, 0.f, 0.f};
            if (t < 3) { pv[0] = pacc[t].x; pv[1] = pacc[t].y; pv[2] = pacc[t].z; pv[3] = pacc[t].w; }
#pragma unroll
            for (int jj = 0; jj < 4; ++jj) { const int j = 16 * tj + 4 * g + jj, i = 16 * ti + r; if (j > i) pv[jj] = 0.f; }
            const int lp = (2 * tj + (g >> 1)) * 16 + r;
            v2u d; d.x = cvtpk(pv[0], pv[1]); d.y = cvtpk(pv[2], pv[3]);
            *(GAS v2u*)(rec + R0_P + (ti * 64 + lp) * 16 + 8 * (g & 1)) = d;
        }
#pragma unroll
        for (int i = 0; i < 8; ++i) {
            const int q = lane + 64 * i, tk = q >> 4, c16 = q & 15; const v4u d = vraw[i];
            *(LAS v2u*)(Tv + tk * 264 + c16 * 16) = (v2u){d.x, d.y}; *(LAS v2u*)(Tv + tk * 264 + c16 * 16 + 8) = (v2u){d.z, d.w};
        }
        LDS_WAIT(); asm volatile("" ::: "memory");
#pragma unroll
        for (int mt = 0; mt < 8; ++mt) { const v4u d = *(const LAS v4u*)(T + (16 * mt + r) * 64 + 16 * g); *(GAS v4u*)(rec + R0_KD + (mt * 64 + lane) * 16) = d; }
#pragma unroll
        for (int sl = 0; sl < 8; ++sl) {
            unsigned short hv[8];
#pragma unroll
            for (int e = 0; e < 8; ++e) hv[e] = *(const LAS unsigned short*)(Tv + (8 * g + e) * 264 + (16 * sl + r) * 2);
            v4u d; d.x = hv[0] | ((unsigned)hv[1] << 16); d.y = hv[2] | ((unsigned)hv[3] << 16); d.z = hv[4] | ((unsigned)hv[5] << 16); d.w = hv[6] | ((unsigned)hv[7] << 16);
            *(GAS v4u*)(rec + R0_V + (sl * 64 + lane) * 16) = d;
        }
        LDS_WAIT(); asm volatile("" ::: "memory");
    }
}

DI_ void l0_seq(Frame& F, const unsigned char* REC0) {
    const int lane = F.lane, w = F.wave, r = lane & 15, g = lane >> 4;
    LAS float* obuf = (LAS float*)(F.lds + 2 * ST0);
    constexpr int OB = 32 * 132;
    for (int u = F.vcu; u < NB * HG_H; u += F.G) {
        const int bh = u, b = bh >> 6, h = bh & 63;
        f32x4 acc[8];
#pragma unroll
        for (int m = 0; m < 8; ++m) acc[m] = (f32x4){0.f, 0.f, 0.f, 0.f};
        const int ntok = 4 * w + g, ndv = 8 * r;
        float ngv[8];
        { const f32x4 a0 = *(const GAS f32x4*)(F.ng0 + h * 128 + ndv), a1 = *(const GAS f32x4*)(F.ng0 + h * 128 + ndv + 4);
          ngv[0] = a0.x; ngv[1] = a0.y; ngv[2] = a0.z; ngv[3] = a0.w; ngv[4] = a1.x; ngv[5] = a1.y; ngv[6] = a1.z; ngv[7] = a1.w; }
#define L0_DMA(c_) do { const unsigned char* rs_ = REC0 + (size_t)(bh * NCH + (c_)) * R0_SZ; LAS unsigned char* st_ = F.lds + ((c_) & 1) * ST0; \
        for (int p_ = w; p_ < 27; p_ += 8) __builtin_amdgcn_global_load_lds((const unsigned*)(rs_ + p_ * 1024 + lane * 16), (LAS unsigned*)(st_ + p_ * 1024), 16, 0, 0); } while (0)
        L0_DMA(0);
        v4u zprev = (v4u){0u, 0u, 0u, 0u};
        for (int c = 0; c <= NCH; ++c) {
            asm volatile("s_waitcnt vmcnt(0)" ::: "memory");
            __builtin_amdgcn_s_barrier();
            asm volatile("" ::: "memory");
            if (c + 1 < NCH) L0_DMA(c + 1);
            v4u zcur = (v4u){0u, 0u, 0u, 0u};
            const bool zvalid = (c < NCH) && !(c == 0 && ntok < 16);
            if (zvalid) zcur = *(const GAS v4u*)(F.QFIZ + (size_t)row_of(b, c, ntok) * N0 + 3 * DI + h * 128 + ndv);
            if (c >= 1) {
                const int cp = c - 1;
                const LAS float* ob = obuf + (cp & 1) * OB + ntok * 132 + ndv;
                const f32x4 x0 = *(const LAS f32x4*)(ob), x1 = *(const LAS f32x4*)(ob + 4);
                float ss = (x0.x * x0.x + x0.y * x0.y) + (x0.z * x0.z + x0.w * x0.w) + (x1.x * x1.x + x1.y * x1.y) + (x1.z * x1.z + x1.w * x1.w);
                ss += __shfl_xor(ss, 8); ss += __shfl_xor(ss, 4); ss += __shfl_xor(ss, 2); ss += __shfl_xor(ss, 1);
                const float rs = rsqrtf(ss * (1.f / 128.f) + RMS_EPS);
                const bool wr = !(cp == 0 && (ntok < 16 || b != 0));
                if (wr) {
                    v4u d;
                    d.x = cvtpk(x0.x * rs * ngv[0] * silu(bflo(zprev.x)), x0.y * rs * ngv[1] * silu(bfhi(zprev.x)));
                    d.y = cvtpk(x0.z * rs * ngv[2] * silu(bflo(zprev.y)), x0.w * rs * ngv[3] * silu(bfhi(zprev.y)));
                    d.z = cvtpk(x1.x * rs * ngv[4] * silu(bflo(zprev.z)), x1.y * rs * ngv[5] * silu(bfhi(zprev.z)));
                    d.w = cvtpk(x1.z * rs * ngv[6] * silu(bflo(zprev.w)), x1.w * rs * ngv[7] * silu(bfhi(zprev.w)));
                    *(GAS v4u*)(F.Y + (size_t)row_of(b, cp, ntok) * DI + h * 128 + ndv) = d;
                }
            }
            zprev = zcur;
            if (c < NCH) {
                const LAS unsigned char* st = F.lds + (c & 1) * ST0;
                const bf16x8 vf = *(const LAS bf16x8*)(st + R0_V + w * 1024 + lane * 16);
                const bf16x8 p0 = *(const LAS bf16x8*)(st + R0_P + lane * 16), p1 = *(const LAS bf16x8*)(st + R0_P + 1024 + lane * 16);
                bf16x8 qf[8], kf[8]; f32x4 gf[8];
#pragma unroll
                for (int q = 0; q < 8; ++q) qf[q] = *(const LAS bf16x8*)(st + R0_QD + q * 1024 + lane * 16);
#pragma unroll
                for (int m = 0; m < 8; ++m) { gf[m] = *(const LAS f32x4*)(st + R0_GL + (16 * m + 4 * g) * 4); kf[m] = *(const LAS bf16x8*)(st + R0_KD + m * 1024 + lane * 16); }
                SCHED_FENCE();
                f32x4 o0 = (f32x4){0.f, 0.f, 0.f, 0.f}, o1 = o0;
                o0 = MFMA16(vf, p0, o0); o1 = MFMA16(vf, p1, o1);
#pragma unroll
                for (int s2 = 0; s2 < 4; ++s2) {
                    const bf16x8 sb = mk8(cvtpk(acc[2 * s2].x, acc[2 * s2].y), cvtpk(acc[2 * s2].z, acc[2 * s2].w), cvtpk(acc[2 * s2 + 1].x, acc[2 * s2 + 1].y), cvtpk(acc[2 * s2 + 1].z, acc[2 * s2 + 1].w));
                    o0 = MFMA16(sb, qf[s2], o0); o1 = MFMA16(sb, qf[4 + s2], o1);
                }
#pragma unroll
                for (int m = 0; m < 8; ++m) acc[m] = MFMA16(kf[m], vf, acc[m] * gf[m]);
                LAS float* ow = obuf + (c & 1) * OB + r * 132 + 16 * w + 4 * g;
                *(LAS f32x4*)ow = o0; *(LAS f32x4*)(ow + 16 * 132) = o1;
                asm volatile("s_waitcnt lgkmcnt(0)" ::: "memory");
            }
        }
#undef L0_DMA
        asm volatile("s_waitcnt vmcnt(0)" ::: "memory");
        __builtin_amdgcn_s_barrier();
    }
}

template <int KS, int MODE>
DI_ void skinny(Frame& F, const bf16* A, const bf16* Bt, int K, int n_first, int n_slices, bf16* Ob, int ldo, float* Of, const float* res) {
    const int lane = F.lane, w = F.wave, r = lane & 15, g = lane >> 4;
    constexpr int SPB = 8 / KS;
    const int kw = w % KS, sw = w / KS, klen = K / KS, kbeg = kw * klen;
    LAS f32x4* red = (LAS f32x4*)F.lds;
    for (int p = F.vcu; p * SPB < n_slices; p += F.G) {
        const int sl = p * SPB + sw, n0 = n_first + 16 * sl;
        f32x4 acc = (f32x4){0.f, 0.f, 0.f, 0.f};
        if (sl < n_slices) {
            const GAS v4u* bp = (const GAS v4u*)(Bt + (size_t)(n0 + r) * K + kbeg + 16 * g);
            const GAS v4u* ap = (const GAS v4u*)(A + (size_t)r * K + kbeg + 16 * g);
            for (int kk = 0; kk < klen; kk += 256) {
                v4u bv[8], av[8];
#pragma unroll
                for (int u = 0; u < 4; ++u) { bv[2 * u] = bp[(kk + 64 * u) / 8]; bv[2 * u + 1] = bp[(kk + 64 * u) / 8 + 1]; av[2 * u] = ap[(kk + 64 * u) / 8]; av[2 * u + 1] = ap[(kk + 64 * u) / 8 + 1]; }
                asm volatile("" ::: "memory");
#pragma unroll
                for (int u = 0; u < 8; ++u) acc = MFMA16(__builtin_bit_cast(bf16x8, bv[u]), __builtin_bit_cast(bf16x8, av[u]), acc);
            }
        }
        if (KS > 1) {
            red[w * 64 + lane] = acc;
            __syncthreads();
            if (kw == 0) {
#pragma unroll
                for (int j = 1; j < KS; ++j) acc += red[(w + j) * 64 + lane];
            }
        }
        if (kw == 0 && sl < n_slices) {
            if (MODE == 0) { v2u d; d.x = pk2(acc.x, acc.y); d.y = pk2(acc.z, acc.w); *(GAS v2u*)(Ob + (size_t)r * ldo + n0 + 4 * g) = d; }
            else { const f32x4 rv = *(const GAS f32x4*)(res + (size_t)r * D + n0 + 4 * g); *(GAS f32x4*)(Of + (size_t)r * D + n0 + 4 * g) = rv * ALPHA + acc; }
        }
        if (KS > 1) __syncthreads();
    }
    asm volatile("s_waitcnt vmcnt(0)" ::: "memory");
}

DI_ void gate_proj(Frame& F, const bf16* WG1T  ) {
    const int lane = F.lane, w = F.wave, r = lane & 15, g = lane >> 4, kw = w & 3, sw = w >> 2;
    LAS f32x4* red = (LAS f32x4*)F.lds;
    for (int p = F.vcu; 2 * p < MR / 16; p += F.G) {
        const int t = 2 * p + sw;
        f32x4 acc = (f32x4){0.f, 0.f, 0.f, 0.f};
        if (t < MR / 16) {
            const GAS v4u* wp = (const GAS v4u*)(WG1T + (size_t)r * D + 1024 * kw + 16 * g);
            const GAS v4u* hp = (const GAS v4u*)(F.H1B + (size_t)(16 * t + r) * D + 1024 * kw + 16 * g);
            for (int kk = 0; kk < 1024; kk += 256) {
                v4u wv[8], hv[8];
#pragma unroll
                for (int u = 0; u < 4; ++u) { wv[2 * u] = wp[(kk + 64 * u) / 8]; wv[2 * u + 1] = wp[(kk + 64 * u) / 8 + 1]; hv[2 * u] = hp[(kk + 64 * u) / 8]; hv[2 * u + 1] = hp[(kk + 64 * u) / 8 + 1]; }
                asm volatile("" ::: "memory");
#pragma unroll
                for (int u = 0; u < 8; ++u) acc = MFMA16(__builtin_bit_cast(bf16x8, wv[u]), __builtin_bit_cast(bf16x8, hv[u]), acc);
            }
        }
        red[w * 64 + lane] = acc;
        __syncthreads();
        if (kw == 0 && t < MR / 16) {
            acc += red[(w + 1) * 64 + lane]; acc += red[(w + 2) * 64 + lane]; acc += red[(w + 3) * 64 + lane];
            *(GAS f32x4*)(F.G1 + (size_t)(16 * t + r) * GL_R + 4 * g) = acc;
        }
        __syncthreads();
    }
    asm volatile("s_waitcnt vmcnt(0)" ::: "memory");
}

#ifndef USE_AUX
#define USE_AUX 0
#endif
struct AuxT { const float* src; bf16* dst; int N, K; };
DI_ AuxT aux_decode(Frame& F, int it, unsigned char* dummy) {
    constexpr int I_1 = (DI / 64) * (D / 32), I_2 = (D / 64) * (N1 / 32), I_3 = I_1, AUX_ITERS = (I_1 + I_2 + I_3) / (256 * NWAVES);
    static_assert((I_1 + I_2 + I_3) % (256 * NWAVES) == 0, "aux tiles divide over the waves");
    const int gw = F.vcu * NWAVES + F.wave;
    AuxT t;
    if (it >= AUX_ITERS || F.G != 256) { t.src = (const float*)(dummy + (size_t)gw * 8192); t.dst = (bf16*)(dummy + 32 * MiB + (size_t)gw * 8192); t.N = 32; t.K = 64; return t; }
    int r_ = it * (256 * NWAVES) + gw; const float* W; bf16* WT; int K, N;
    if (r_ < I_1) { W = F.w0out; WT = F.WT0OUT; K = DI; N = D; }
    else if (r_ < I_1 + I_2) { r_ -= I_1; W = F.w1in; WT = F.WT1IN; K = D; N = N1; }
    else { r_ -= I_1 + I_2; W = F.w1out; WT = F.WT1OUT; K = DI; N = D; }
    const int nblk = N / 32, kb = r_ / nblk, nb = r_ - kb * nblk;
    t.src = W + (size_t)(64 * kb) * N + 32 * nb; t.dst = WT + (size_t)(32 * nb) * K + 64 * kb; t.N = N; t.K = K; return t;
}
DI_ void aux_load(Frame& F, const AuxT& t, f32x4 (&wv)[8]) {
    const int rowi = F.lane >> 3, c4 = F.lane & 7;
#pragma unroll
    for (int i = 0; i < 8; ++i) wv[i] = *(const GAS f32x4*)(t.src + (size_t)(8 * i + rowi) * t.N + 4 * c4);
}
DI_ void aux_store(Frame& F, const AuxT& t, const f32x4 (&wv)[8], LAS unsigned char* scr  ) {
    const int lane = F.lane, rowi = lane >> 3, c4 = lane & 7;
#pragma unroll
    for (int i = 0; i < 8; ++i) { LAS unsigned* p = (LAS unsigned*)(scr + (8 * i + rowi) * 68 + c4 * 8); p[0] = cvtpk(wv[i].x, wv[i].y); p[1] = cvtpk(wv[i].z, wv[i].w); }
    LDS_WAIT(); asm volatile("" ::: "memory");
    const int kc = lane & 7;
#pragma unroll
    for (int j = 0; j < 4; ++j) { const int n = (lane >> 3) + 8 * j; unsigned short hv[8];
#pragma unroll
        for (int e = 0; e < 8; ++e) hv[e] = *(const LAS unsigned short*)(scr + (8 * kc + e) * 68 + n * 2);
        v4u o; o.x = hv[0] | ((unsigned)hv[1] << 16); o.y = hv[2] | ((unsigned)hv[3] << 16); o.z = hv[4] | ((unsigned)hv[5] << 16); o.w = hv[6] | ((unsigned)hv[7] << 16);
        *(GAS v4u*)(t.dst + (size_t)n * t.K + 8 * kc) = o; }
    LDS_WAIT(); asm volatile("" ::: "memory");
}

constexpr int F0_QD = 0, F0_KI = 8192, F0_T = 16384, F0_GL = 24576, F0_TV = 25088, F0_STG = 33536;
DI_ void f0_load(const bf16* cb, const int (&oq)[2], int ov, v2u (&q2)[2], v2u (&f2)[2], v4u& vraw) {
#pragma unroll
    for (int ti = 0; ti < 2; ++ti) { q2[ti] = *(const GAS v2u*)(cb + oq[ti]); f2[ti] = *(const GAS v2u*)(cb + oq[ti] + DI); }
    vraw = *(const GAS v4u*)(cb + ov);
}
DI_ void f0_prep(Frame& F, LAS unsigned char* st, const v2u (&q2)[2], const v2u (&f2)[2], const v4u& vraw, const f32x4& lb4, const f32x4& bf4) {
    const int lane = F.lane, w = F.wave, r = lane & 15, g = lane >> 4, ps = w >> 1, hf = w & 1;
    const float lbv[4] = {lb4.x, lb4.y, lb4.z, lb4.w}, bfv[4] = {bf4.x, bf4.y, bf4.z, bf4.w};
    float Lv[2][4], qq[2][4], kk[2][4];
#pragma unroll
    for (int ti = 0; ti < 2; ++ti) {
        const float qv[4] = {bflo(q2[ti].x), bfhi(q2[ti].x), bflo(q2[ti].y), bfhi(q2[ti].y)}, fv[4] = {bflo(f2[ti].x), bfhi(f2[ti].x), bflo(f2[ti].y), bfhi(f2[ti].y)};
#pragma unroll
        for (int x = 0; x < 4; ++x) { const float fg = lbv[x] + (1.f - lbv[x]) * sigm(fv[x] + bfv[x]);
            Lv[ti][x] = lg2(fg); kk[ti][x] = 1.f - fg; qq[ti][x] = silu(qv[x]); }
    }
    float qd[2][4], ki[2][4], kd[2][4], gl[4];
#pragma unroll
    for (int x = 0; x < 4; ++x) {
        const float b0 = scan16(Lv[0][x]);
        const float b1 = scan16(Lv[1][x]) + bcast15(b0);
        const float BB = bcast15(b1);
        gl[x] = ex2(BB);
        qd[0][x] = qq[0][x] * ex2(b0); ki[0][x] = kk[0][x] * ex2(-b0); kd[0][x] = ki[0][x] * gl[x];
        qd[1][x] = qq[1][x] * ex2(b1); ki[1][x] = kk[1][x] * ex2(-b1); kd[1][x] = ki[1][x] * gl[x];
    }
    const int lp = (2 * (g & 1) + hf) * 16 + r;
#pragma unroll
    for (int ti = 0; ti < 2; ++ti) {
        *(LAS v2u*)(st + F0_QD + ((ti * 4 + ps) * 64 + lp) * 16 + (g >> 1) * 8) = (v2u){cvtpk(qd[ti][0], qd[ti][1]), cvtpk(qd[ti][2], qd[ti][3])};
        *(LAS v2u*)(st + F0_KI + ((ti * 4 + ps) * 64 + lp) * 16 + (g >> 1) * 8) = (v2u){cvtpk(ki[ti][0], ki[ti][1]), cvtpk(ki[ti][2], ki[ti][3])};
        const unsigned k01 = cvtpk(kd[ti][0], kd[ti][1]), k23 = cvtpk(kd[ti][2], kd[ti][3]);
        LAS unsigned char* tp = st + F0_T + (32 * ps + 8 * g + 4 * hf) * 64 + (16 * ti + r) * 2;
        *(LAS unsigned short*)(tp) = (unsigned short)(k01 & 0xffffu); *(LAS unsigned short*)(tp + 64) = (unsigned short)(k01 >> 16);
        *(LAS unsigned short*)(tp + 128) = (unsigned short)(k23 & 0xffffu); *(LAS unsigned short*)(tp + 192) = (unsigned short)(k23 >> 16);
    }
    if (r == 0) *(LAS f32x4*)(st + F0_GL + (32 * ps + 8 * g + 4 * hf) * 4) = (f32x4){gl[0], gl[1], gl[2], gl[3]};
    { const int tk = 4 * w + (lane >> 4), c16 = lane & 15;
      *(LAS v2u*)(st + F0_TV + tk * 264 + c16 * 16) = (v2u){vraw.x, vraw.y}; *(LAS v2u*)(st + F0_TV + tk * 264 + c16 * 16 + 8) = (v2u){vraw.z, vraw.w}; }
}
DI_ void l0_fused(Frame& F, unsigned char* dummy) {
    const int lane = F.lane, w = F.wave, r = lane & 15, g = lane >> 4, ps = w >> 1, hf = w & 1;
    LAS float* obuf = (LAS float*)(F.lds + 2 * F0_STG);
    constexpr int OB = 32 * 132;
    for (int u = F.vcu; u < NB * HG_H; u += F.G) {
        const int bh = u, b = bh >> 6, h = bh & 63;
        f32x4 acc[8];
#pragma unroll
        for (int m = 0; m < 8; ++m) acc[m] = (f32x4){0.f, 0.f, 0.f, 0.f};
        const int ntok = 4 * w + g, ndv = 8 * r;
        float ngv[8];
        { const f32x4 a0 = *(const GAS f32x4*)(F.ng0 + h * 128 + ndv), a1 = *(const GAS f32x4*)(F.ng0 + h * 128 + ndv + 4);
          ngv[0] = a0.x; ngv[1] = a0.y; ngv[2] = a0.z; ngv[3] = a0.w; ngv[4] = a1.x; ngv[5] = a1.y; ngv[6] = a1.z; ngv[7] = a1.w; }
        const int colp = h * 128 + 32 * ps + 8 * g + 4 * hf;
        const f32x4 lb4 = *(const GAS f32x4*)(F.LB0 + colp), bf4 = *(const GAS f32x4*)(F.b_f + colp);
        v2u q2s[2][2], f2s[2][2]; v4u vrs[2];
        const int oq[2] = {r * N0 + colp, (16 + r) * N0 + colp};
        const int ov = (4 * w + (lane >> 4)) * N0 + 2 * DI + h * 128 + 8 * (lane & 15), oz = ntok * N0 + 3 * DI + h * 128 + ndv, oy = ntok * DI + h * 128 + ndv;
        const bf16* xq = F.QFIZ + (size_t)(b * SEQ - 32) * N0;
        bf16* xy = F.Y + (size_t)(b * SEQ - 32) * DI;
        bf16* y0 = (b == 0) ? F.Y0 : F.Y0 + (size_t)32 * DI;
#define QCH(c_) (((c_) == 0) ? (const bf16*)F.Q0 : xq + (size_t)(c_) * 32 * N0)
        f0_load(QCH(0), oq, ov, q2s[0], f2s[0], vrs[0]);
        f0_prep(F, F.lds, q2s[0], f2s[0], vrs[0], lb4, bf4);
        f0_load(QCH(1), oq, ov, q2s[1], f2s[1], vrs[1]);
        LAS unsigned char* ascr = F.lds + 2 * F0_STG + 33792 + w * 4352;
        f32x4 awv[8];
        v4u zs[2]; zs[0] = (v4u){0u, 0u, 0u, 0u}; zs[1] = zs[0];
#define F0_BODY(C_, PAR) do { const int c = (C_); \
            asm volatile("s_waitcnt lgkmcnt(0)" ::: "memory"); \
            __builtin_amdgcn_s_barrier(); \
            asm volatile("" ::: "memory"); \
            f0_load(QCH((c + 2 < NCH) ? c + 2 : NCH - 1), oq, ov, q2s[PAR], f2s[PAR], vrs[PAR]); \
            AuxT at_; if (USE_AUX) { at_ = aux_decode(F, c, dummy); aux_load(F, at_, awv); } \
            { const int cz = (c < NCH) ? c : NCH - 1; zs[PAR] = *(const GAS v4u*)(QCH(cz) + oz); } \
            { \
                const int cp = c - 1; \
                const LAS float* ob = obuf + (cp & 1) * OB + ntok * 132 + ndv; \
                const f32x4 x0 = *(const LAS f32x4*)(ob), x1 = *(const LAS f32x4*)(ob + 4); \
                float ss = (x0.x * x0.x + x0.y * x0.y) + (x0.z * x0.z + x0.w * x0.w) + (x1.x * x1.x + x1.y * x1.y) + (x1.z * x1.z + x1.w * x1.w); \
                ss = bcast15(scan16(ss)); \
                const float rs = rsqrtf(ss * (1.f / 128.f) + RMS_EPS); \
                bf16* yb = (cp <= 0) ? ((cp == 0) ? y0 : F.Y0 + (size_t)32 * DI) : xy + (size_t)cp * 32 * DI; \
                { \
                    v4u d; \
                    d.x = cvtpk(x0.x * rs * ngv[0] * silu(bflo(zs[PAR ^ 1].x)), x0.y * rs * ngv[1] * silu(bfhi(zs[PAR ^ 1].x))); \
                    d.y = cvtpk(x0.z * rs * ngv[2] * silu(bflo(zs[PAR ^ 1].y)), x0.w * rs * ngv[3] * silu(bfhi(zs[PAR ^ 1].y))); \
                    d.z = cvtpk(x1.x * rs * ngv[4] * silu(bflo(zs[PAR ^ 1].z)), x1.y * rs * ngv[5] * silu(bfhi(zs[PAR ^ 1].z))); \
                    d.w = cvtpk(x1.z * rs * ngv[6] * silu(bflo(zs[PAR ^ 1].w)), x1.w * rs * ngv[7] * silu(bfhi(zs[PAR ^ 1].w))); \
                    *(GAS v4u*)(yb + oy) = d; \
                } \
            } \
             \
            { \
                const LAS unsigned char* st = F.lds + (c & 1) * F0_STG; \
 \
                unsigned short hv[8]; \
                _Pragma("unroll") \
                for (int e = 0; e < 8; ++e) hv[e] = *(const LAS unsigned short*)(st + F0_TV + (16 * (e >> 2) + 4 * g + (e & 3)) * 264 + (16 * w + r) * 2); \
                const bf16x8 vf = mk8(hv[0] | ((unsigned)hv[1] << 16), hv[2] | ((unsigned)hv[3] << 16), hv[4] | ((unsigned)hv[5] << 16), hv[6] | ((unsigned)hv[7] << 16)); \
                bf16x8 qf[8], kf[8]; \
                _Pragma("unroll") \
                for (int q = 0; q < 8; ++q) { qf[q] = *(const LAS bf16x8*)(st + F0_QD + q * 1024 + lane * 16); kf[q] = *(const LAS bf16x8*)(st + F0_KI + q * 1024 + lane * 16); } \
                SCHED_FENCE(); \
 \
                f32x4 pt00 = (f32x4){0.f, 0.f, 0.f, 0.f}, pt01 = pt00, pt11 = pt00; \
                _Pragma("unroll") \
                for (int s2 = 0; s2 < 4; ++s2) { pt00 = MFMA16(kf[s2], qf[s2], pt00); pt01 = MFMA16(kf[s2], qf[4 + s2], pt01); pt11 = MFMA16(kf[4 + s2], qf[4 + s2], pt11); } \
                const bool m0 = (4 * g + 0 <= r), m1 = (4 * g + 1 <= r), m2 = (4 * g + 2 <= r), m3 = (4 * g + 3 <= r); \
 \
                                const bf16x8 pb0 = mk8(cvtpk(m0 ? pt00.x : 0.f, m1 ? pt00.y : 0.f), cvtpk(m2 ? pt00.z : 0.f, m3 ? pt00.w : 0.f), 0u, 0u); \
                const bf16x8 pb1 = mk8(pk2(pt01.x, pt01.y), pk2(pt01.z, pt01.w), cvtpk(m0 ? pt11.x : 0.f, m1 ? pt11.y : 0.f), cvtpk(m2 ? pt11.z : 0.f, m3 ? pt11.w : 0.f)); \
                f32x4 o0 = (f32x4){0.f, 0.f, 0.f, 0.f}, o1 = o0; \
                o0 = MFMA16(vf, pb0, o0); o1 = MFMA16(vf, pb1, o1); \
                _Pragma("unroll") \
                for (int s2 = 0; s2 < 4; ++s2) { \
                    const bf16x8 sb = mk8(cvtpk(acc[2 * s2].x, acc[2 * s2].y), cvtpk(acc[2 * s2].z, acc[2 * s2].w), cvtpk(acc[2 * s2 + 1].x, acc[2 * s2 + 1].y), cvtpk(acc[2 * s2 + 1].z, acc[2 * s2 + 1].w)); \
                    o0 = MFMA16(sb, qf[s2], o0); o1 = MFMA16(sb, qf[4 + s2], o1); \
                } \
                LAS float* ow = obuf + (c & 1) * OB + r * 132 + 16 * w + 4 * g; \
                *(LAS f32x4*)ow = o0; *(LAS f32x4*)(ow + 16 * 132) = o1; \
                f32x4 gf[8]; v2u klo[8], khi[8]; \
                _Pragma("unroll") \
                for (int m = 0; m < 8; ++m) { gf[m] = *(const LAS f32x4*)(st + F0_GL + (16 * m + 4 * g) * 4); \
                    klo[m] = *(const LAS v2u*)(st + F0_T + (16 * m + r) * 64 + 8 * g); khi[m] = *(const LAS v2u*)(st + F0_T + (16 * m + r) * 64 + 32 + 8 * g); } \
                SCHED_FENCE(); \
                _Pragma("unroll") \
                for (int m = 0; m < 8; ++m) acc[m] = MFMA16(mk8(klo[m].x, klo[m].y, khi[m].x, khi[m].y), vf, acc[m] * gf[m]); \
                SCHED_FENCE(); \
            } \
            f0_prep(F, F.lds + ((c + 1) & 1) * F0_STG, q2s[PAR ^ 1], f2s[PAR ^ 1], vrs[PAR ^ 1], lb4, bf4); \
            if (USE_AUX) aux_store(F, at_, awv, ascr); \
        } while (0)
        for (int c2 = 0; c2 <= NCH; c2 += 2) { F0_BODY(c2, 0); F0_BODY(c2 + 1, 1); }
#undef F0_BODY
#undef QCH
        asm volatile("s_waitcnt vmcnt(0) lgkmcnt(0)" ::: "memory");
        __builtin_amdgcn_s_barrier();
    }
}

struct Args { const float* in[17]; float* out; unsigned char* ws; int ph_lo, ph_hi, li, pad; };
__global__ void __launch_bounds__(NWAVES * 64, 2) mk_fwd(Args args) {
    extern __shared__ __attribute__((aligned(16))) unsigned char lds[];
    Frame F;
    F.lds = (LAS unsigned char*)lds;
    F.MISC = (volatile LAS unsigned*)(F.lds + MISC_OFF);
    F.tid = threadIdx.x; F.lane = F.tid & 63; F.wave = __builtin_amdgcn_readfirstlane(F.tid >> 6);
    F.G = gridDim.x; { const int bx = blockIdx.x; F.vcu = (F.G % 8 == 0) ? (bx % 8) * (F.G / 8) + bx / 8 : bx; }
    unsigned char* ws = args.ws;
    F.ctl = (gu32*)(ws + WS_CTL);
    F.x = args.in[0]; F.meta = args.in[1]; F.lb_logits = args.in[2];
    F.w0in = args.in[3]; F.b_f = args.in[4]; F.ng0 = args.in[5]; F.w0out = args.in[6]; F.ln0g = args.in[7]; F.ln0b = args.in[8];
    F.w1in = args.in[9]; F.wg1 = args.in[10]; F.wg2 = args.in[11]; F.b_g = args.in[12]; F.ng1 = args.in[13]; F.w1out = args.in[14]; F.ln1g = args.in[15]; F.ln1b = args.in[16];
    F.out = args.out;
    F.LB0 = (float*)(ws + WS_LB0); F.G1 = (float*)(ws + WS_G1); F.PRE = (float*)(ws + WS_PRE); F.O1 = (float*)(ws + WS_O1); F.WG1T = (bf16*)(ws + WS_WG1T); F.W2F = (bf16*)(ws + WS_W2F); F.Q0 = (bf16*)(ws + WS_Q0); F.Y0 = (bf16*)(ws + WS_Y0); F.REC0 = ws + WS_REC; F.REC1 = ws + WS_REC1; F.VF1 = ws + WS_VF1;
    F.WT0IN = (bf16*)(ws + WS_WT0IN); F.WT0OUT = (bf16*)(ws + WS_WT0OUT); F.WT1IN = (bf16*)(ws + WS_WT1IN); F.WT1OUT = (bf16*)(ws + WS_WT1OUT);
    F.XB = (bf16*)(ws + WS_XB); F.H1B = (bf16*)(ws + WS_H1B); F.QFIZ = (bf16*)(ws + WS_QFIZ); F.Y = (bf16*)(ws + WS_Y);
    for (int u = F.tid; u < (LDS_BYTES - LDSCTL_OFF) / 4; u += NWAVES * 64) ((LAS unsigned*)(F.lds + LDSCTL_OFF))[u] = 0u;
    __syncthreads();
    int vb = (int)blockIdx.x;
    if (USE_TICKETS && N_LAUNCHES == 1 && (F.G % 8) == 0) {
        if (F.tid == 0) {
            const unsigned per = (unsigned)F.G / 8u; unsigned x = xb_xcc_id() & 7u, got = 0xffffffffu;
            for (unsigned tr = 0; tr < 8u; ++tr) { const unsigned y = (x + tr) & 7u; const unsigned t = xb_add((unsigned*)(F.ctl + CW_POOL) + 64 * y, 1u); if (t < per) { got = y + 8u * t; break; } }
            F.MISC[12] = (got == 0xffffffffu) ? blockIdx.x : got;
        }
        __syncthreads();
        vb = (int)F.MISC[12];
    }
    { F.vcu = (F.G % 8 == 0) ? (vb % 8) * (F.G / 8) + vb / 8 : vb; }
    XcdBarrier bar; bar.bar = (unsigned*)(F.ctl + CW_BAR); bar.x = 0; bar.st = nullptr;
    if (N_LAUNCHES == 1) bar = xcd_barrier_post((unsigned*)(F.ctl + CW_BAR), F.MISC + 8);
#define GRID_BAR() do { if (N_LAUNCHES == 1) xcd_barrier(bar); } while (0)
    const int lo = args.ph_lo, hi = args.ph_hi;
    unsigned long long pclk0 = 0, pclkn = 0; (void)pclk0;
    unsigned long long st_prev = STAMP_MASK ? __builtin_amdgcn_s_memrealtime() : 0ull, st_acc = 0ull;
#define STAMP(k) do { if (STAMP_MASK) { const unsigned long long t_ = __builtin_amdgcn_s_memrealtime(); if ((STAMP_MASK >> (k)) & 1) st_acc += t_ - st_prev; st_prev = t_; } } while (0)
#ifdef ONLY_PHASE
#define IN(k) ((k) == ONLY_PHASE && lo <= (k) && (k) < hi)
#else
#define IN(k) (lo <= (k) && (k) < hi)
#endif
#define BOTH(k) (IN(k) && IN((k) + 1))

    if (IN(0)) { for (int rep = 0; rep < REP(0); ++rep) { p0_prologue(F); if (rep + 1 < REP(0)) GRID_BAR(); } if (BOTH(0)) GRID_BAR(); }
    STAMP(0);
    if (IN(1)) {
        skinny<1, 0>(F, F.XB + (size_t)MX * D, F.WT0IN, D, 0, N0 / 16, (USE_L0_MFMA == 2) ? F.Q0 + (size_t)16 * N0 : F.QFIZ + (size_t)MX * N0, N0, nullptr, nullptr);
        pg8::Gemm g{F.XB, F.WT0IN, MX, N0, D}; pg8::StaticOrder S; S.init(MX, N0, F.G, vb);
        pg8::EpiBf16<0> E{F.QFIZ, N0, nullptr, 0, 0, 1.f};
        if (PROBE_CLK == 1) pclk0 = __builtin_amdgcn_s_memtime();
        for (int rep = 0; rep < REP(1); ++rep) { pg8::gemm_phase<pg8::EpiBf16<0>, pg8::StaticOrder, PG8_ALIGN, PG8_SP2>(F.lds + RING_OFF, g, S, E); if (rep + 1 < REP(1)) GRID_BAR(); }
        if (PROBE_CLK == 1) pclkn = __builtin_amdgcn_s_memtime() - pclk0;
        if (BOTH(1)) GRID_BAR();
    }
    STAMP(1);
#if USE_L0_MFMA == 2
    STAMP(2);
    if (IN(3)) { for (int rep = 0; rep < REP(3); ++rep) { l0_fused(F, F.REC0); if (rep + 1 < REP(3)) GRID_BAR(); } if (BOTH(3)) GRID_BAR(); }
#elif USE_L0_MFMA
    if (IN(2)) { for (int rep = 0; rep < REP(2); ++rep) { l0_prep(F, F.REC0); if (rep + 1 < REP(2)) GRID_BAR(); } if (BOTH(2)) GRID_BAR(); }
    STAMP(2);
    if (IN(3)) { for (int rep = 0; rep < REP(3); ++rep) { l0_seq(F, F.REC0); if (rep + 1 < REP(3)) GRID_BAR(); } if (BOTH(3)) GRID_BAR(); }
#else
    if (IN(2)) { if (BOTH(2)) GRID_BAR(); }
    if (IN(3)) { for (int rep = 0; rep < REP(3); ++rep) { p2_l0_rec_naive(F); if (rep + 1 < REP(3)) GRID_BAR(); } if (BOTH(3)) GRID_BAR(); }
#endif
    STAMP(3);
    if (IN(4)) {
        skinny<4, 1>(F, (USE_L0_MFMA == 2) ? F.Y0 + (size_t)16 * DI : F.Y + (size_t)MX * DI, F.WT0OUT, DI, 0, D / 16, nullptr, 0, F.PRE + (size_t)MX * D, F.meta);
        pg8::Gemm g{F.Y, F.WT0OUT, MX, D, DI}; pg8::StaticOrder S; S.init(MX, D, F.G, vb);
        pg8::EpiResid E{F.PRE, D, F.x, F.meta, MX, MX, ALPHA};
        for (int rep = 0; rep < REP(4); ++rep) { pg8::gemm_phase<pg8::EpiResid, pg8::StaticOrder, PG8_ALIGN, PG8_SP2>(F.lds + RING_OFF, g, S, E); if (rep + 1 < REP(4)) GRID_BAR(); }
        if (BOTH(4)) GRID_BAR();
    }
    STAMP(4);
    if (IN(5)) { for (int rep = 0; rep < REP(5); ++rep) { ln_phase(F, F.PRE, MR, F.ln0g, F.ln0b, F.PRE, F.H1B, nullptr); if (rep + 1 < REP(5)) GRID_BAR(); } if (BOTH(5)) GRID_BAR(); }
    STAMP(5);
    if (IN(6)) {
        gate_proj(F, F.WG1T);
        skinny<2, 0>(F, F.H1B + (size_t)MX * D, F.WT1IN, D, 4096, (N1 - 4096 - DI) / 16, F.QFIZ + (size_t)MX * N1, N1, nullptr, nullptr);
        pg8::Gemm g{F.H1B, F.WT1IN, MX, N1, D}; pg8::StaticOrder S; S.init(MX, N1, F.G, vb);
        pg8::EpiBf16<0> E{F.QFIZ, N1, nullptr, 0, 0, 1.f};
        for (int rep = 0; rep < REP(6); ++rep) { pg8::gemm_phase<pg8::EpiBf16<0>, pg8::StaticOrder, PG8_ALIGN, PG8_SP2>(F.lds + RING_OFF, g, S, E); if (rep + 1 < REP(6)) GRID_BAR(); }
        if (BOTH(6)) GRID_BAR();
    }
    STAMP(6);
#if USE_L1_MFMA
    if (IN(7)) { for (int rep = 0; rep < REP(7); ++rep) { l1_prep(F, F.REC1, F.VF1, F.W2F); if (rep + 1 < REP(7)) GRID_BAR(); } if (BOTH(7)) GRID_BAR(); }
    STAMP(7);
#if USE_L1_SEQ2
    if (IN(8)) { l1_seq2(F, F.REC1); if (BOTH(8)) GRID_BAR(); }
#else
    if (IN(8)) { l1_seq<0>(F, F.REC1, F.VF1, F.O1); if (REP(8) > 1) { GRID_BAR(); l1_seq<PROBE_VAR>(F, F.REC1, F.VF1, F.O1); } if (BOTH(8)) GRID_BAR(); }
#endif
#else
    if (IN(7)) { if (BOTH(7)) GRID_BAR(); }
    if (IN(8)) { for (int rep = 0; rep < REP(8); ++rep) { p6_l1_rec_naive(F); if (rep + 1 < REP(8)) GRID_BAR(); } if (BOTH(8)) GRID_BAR(); }
#endif
    STAMP(8);
    if (IN(9)) { for (int rep = 0; rep < REP(9); ++rep) { p7_normgate(F); if (rep + 1 < REP(9)) GRID_BAR(); } if (BOTH(9)) GRID_BAR(); }
    STAMP(9);
    if (IN(10)) {
        pg8::Gemm g{F.Y, F.WT1OUT, MX, D, DI}; pg8::StaticOrder S; S.init(MX, D, F.G, vb);
        pg8::EpiResid E{F.PRE, D, F.PRE, F.PRE, MX, MX, ALPHA};
        if (PROBE_CLK == 10) pclk0 = __builtin_amdgcn_s_memtime();
        for (int rep = 0; rep < REP(10); ++rep) { pg8::gemm_phase<pg8::EpiResid, pg8::StaticOrder, PG8_ALIGN, PG8_SP2>(F.lds + RING_OFF, g, S, E); if (rep + 1 < REP(10)) GRID_BAR(); }
        if (PROBE_CLK == 10) pclkn = __builtin_amdgcn_s_memtime() - pclk0;
        if (BOTH(10)) GRID_BAR();
    }
    STAMP(10);
    if (IN(11)) { for (int rep = 0; rep < REP(11); ++rep) { ln_phase(F, F.PRE, MX, F.ln1g, F.ln1b, F.out, nullptr, nullptr); if (rep + 1 < REP(11)) GRID_BAR(); } }
    STAMP(11);
    if (STAMP_MASK && blockIdx.x == 0 && F.tid == 0) { const unsigned long long t0 = __builtin_amdgcn_s_memrealtime(); while (__builtin_amdgcn_s_memrealtime() - t0 < st_acc) __builtin_amdgcn_s_sleep(8); }
    if (PROBE_CLK && blockIdx.x == 0 && F.tid == 0) { const unsigned long long t0 = __builtin_amdgcn_s_memrealtime(); while (__builtin_amdgcn_s_memrealtime() - t0 < pclkn / (PROBE_CLK == 10 ? 10ull : 100ull)) __builtin_amdgcn_s_sleep(8); }
#undef IN
#undef BOTH
}

extern "C" void kernel_launch(void* const* d_in, const int* in_sizes, int n_in, void* d_out, int out_size, void* d_ws, size_t ws_size, hipStream_t stream) {
    static int grid = 0;
    if (grid == 0) {
        if (n_in != 17 || in_sizes[0] != MX * D || out_size != MX * D || ws_size < WS_END) { fprintf(stderr, "kernel_launch: unexpected problem (n_in %d, in0 %d, out %d, ws %zu < %zu); nothing launched\n", n_in, n_in > 0 ? in_sizes[0] : -1, out_size, ws_size, (size_t)WS_END); grid = -1; return; }
        int dev = 0, cus = 0, per_cu = 0;
        if (hipGetDevice(&dev) != hipSuccess || hipDeviceGetAttribute(&cus, hipDeviceAttributeMultiprocessorCount, dev) != hipSuccess) { fprintf(stderr, "kernel_launch: device query failed\n"); grid = -1; return; }
        if (hipFuncSetAttribute((const void*)mk_fwd, hipFuncAttributeMaxDynamicSharedMemorySize, LDS_BYTES) != hipSuccess) { fprintf(stderr, "kernel_launch: hipFuncSetAttribute failed\n"); grid = -1; return; }
        if (hipOccupancyMaxActiveBlocksPerMultiprocessor(&per_cu, (const void*)mk_fwd, NWAVES * 64, LDS_BYTES) != hipSuccess || per_cu < 1)
            fprintf(stderr, "kernel_launch: note: occupancy query reports %d workgroups per CU\n", per_cu);
        (void)hipGetLastError();
        grid = cus;
    }
    if (grid < 0) return;
    if (hipMemsetAsync((char*)d_ws + WS_CTL, 0, CTL_ZERO_BYTES, stream) != hipSuccess) { fprintf(stderr, "kernel_launch: memset failed\n"); return; }
    Args a{};
    for (int i = 0; i < 17; ++i) a.in[i] = (const float*)d_in[i];
    a.out = (float*)d_out; a.ws = (unsigned char*)d_ws;
    for (int li = 0; li < N_LAUNCHES; ++li) {
        a.ph_lo = (N_LAUNCHES == 1) ? 0 : li; a.ph_hi = (N_LAUNCHES == 1) ? PER_PHASE : li + 1; a.li = li; a.pad = 0;
        hipLaunchKernelGGL(mk_fwd, dim3(grid), dim3(NWAVES * 64), LDS_BYTES, stream, a);
        const hipError_t le = hipPeekAtLastError();
        if (le != hipSuccess) { fprintf(stderr, "kernel_launch: launch %d failed: %s\n", li, hipGetErrorName(le)); break; }
    }
}
```

```cpp
#include <hip/hip_runtime.h>
#include <cstdio>
#include <cstdint>
#define MK_N_LAUNCHES 1
#define USE_L0_MFMA 2
#define USE_L1_MFMA 1
namespace pg8 {
#define PG8_LAS __attribute__((address_space(3)))
typedef unsigned short bf16_t;
typedef short bf16x8 __attribute__((ext_vector_type(8)));
typedef float f32x4 __attribute__((ext_vector_type(4)));
typedef unsigned u32x4 __attribute__((ext_vector_type(4)));
constexpr int BM = 256, BK = 64, HALF = 128, HTB = HALF * BK * 2  , STAGE_BYTES = 8 * HTB, NXCD = 8, WGM = 8;

__host__ __device__ __forceinline__ int lds_byte(int r, int c) { const int st = (r >> 4) * 2 + (c >> 5), rr = r & 15, cc = c & 31, ob = rr * 64 + cc * 2; return st * 1024 + (ob ^ (((ob >> 9) & 1) << 5)); }
__host__ __device__ __forceinline__ void stage_rc(int b, int& R, int& C) { const int st = b / 1024, sb = b % 1024, swz = sb ^ (((sb >> 9) & 1) << 5); R = (st >> 1) * 16 + swz / 64; C = (st & 1) * 32 + (swz % 64) / 2; }
__host__ __device__ __forceinline__ int perm32(int rho) { const int n = rho >> 4, i = rho & 15; return 8 * (i >> 2) + 4 * n + (i & 3); }

struct Unit { int pm, pn; };
struct Gemm { const bf16_t* A; const bf16_t* Bt; int M, N, K; };

struct StaticOrder {
    int nM, nN, nwg, G, c;
    __host__ __device__ void init(int M, int N, int G_, int c_) { nM = M / BM; nN = N / BM; nwg = nM * nN; G = G_; c = c_; }
    __host__ __device__ bool next(int i, Unit& u) const {
        const long L = (long)i * G + c; if (L >= nwg) return false;
        int wgid = (int)L; { const int q = nwg / NXCD, r = nwg % NXCD, xcd = wgid % NXCD, off = wgid / NXCD; wgid = (xcd < r ? xcd * (q + 1) : r * (q + 1) + (xcd - r) * q) + off; }
        const int nig = WGM * nN, gid = wgid / nig, fm = gid * WGM, gsz = (nM - fm) < WGM ? (nM - fm) : WGM;
        u.pm = fm + ((wgid % nig) % gsz); u.pn = (wgid % nig) / gsz; return true;
    }
    __device__ __forceinline__ void a_ready(const Unit&) const {}
    __device__ __forceinline__ void done(const Unit&) const {}
};

__device__ __forceinline__ unsigned cvt_pk_bf16(float lo, float hi) { unsigned r; asm volatile("v_cvt_pk_bf16_f32 %0, %1, %2" : "=v"(r) : "v"(lo), "v"(hi)); return r; }
typedef float f32x2 __attribute__((ext_vector_type(2)));
__device__ __forceinline__ f32x2 gelu_pk(f32x2 v) {
    const f32x2 av = __builtin_elementwise_abs(v), d = av * 0.2316418882f + 1.0f;
    f32x2 t; t.x = __builtin_amdgcn_rcpf(d.x); t.y = __builtin_amdgcn_rcpf(d.y);
    f32x2 q = t * 0.5307027145f + (-0.7265760135f); q = q * t + 0.7107068705f; q = q * t + (-0.142248368f); q = q * t + 0.127414796f; q = q * t;
    const f32x2 s = (v * v) * (-0.72134752044f);
    f32x2 e; e.x = __builtin_amdgcn_exp2f(s.x); e.y = __builtin_amdgcn_exp2f(s.y);
    const f32x2 m = v * (q * e), r = v - m;
    f32x2 o; o.x = v.x < 0.f ? m.x : r.x; o.y = v.y < 0.f ? m.y : r.y; return o;
}

template <int ACT  > struct EpiBf16 {
    static constexpr bool PERM = true, AFTER_DRAIN = false, KHOOK = false; static_assert(ACT == 0 || ACT == 1, "EpiBf16: ACT is 0 (none) or 1 (gelu_pk)");
    bf16_t* O; int ldc; const float* bias; int split_cols; size_t split_stride; float scale0;
    __device__ __forceinline__ void operator()(const f32x4 (&acc)[2][2][4][2], const Unit& u, int wr, int wc, int fr, int fq) const {
        const int row0 = u.pm * BM + wr * 64 + fr; int colt = u.pn * BM; bf16_t* base = O;
        float sc = 1.f; if (split_cols) { const int t = colt / split_cols; base += (size_t)t * split_stride; colt -= t * split_cols; if (t == 0) sc = scale0; }
        const int col0 = colt + wc * 32 + 8 * fq, bcol0 = u.pn * BM + wc * 32 + 8 * fq;
        f32x4 bv[2][2];
#pragma unroll
        for (int bj = 0; bj < 2; ++bj)
#pragma unroll
            for (int n = 0; n < 2; ++n) bv[bj][n] = bias ? *(const f32x4*)(bias + bcol0 + bj * HALF + 4 * n) : (f32x4){0.f, 0.f, 0.f, 0.f};
#pragma unroll
        for (int ai = 0; ai < 2; ++ai)
#pragma unroll
            for (int m = 0; m < 4; ++m) { bf16_t* rowp = base + (size_t)(row0 + ai * HALF + m * 16) * ldc + col0;
#pragma unroll
                for (int bj = 0; bj < 2; ++bj) { f32x4 v0 = acc[ai][bj][m][0] + bv[bj][0], v1 = acc[ai][bj][m][1] + bv[bj][1];
                    if (ACT == 1) { f32x2 a = gelu_pk((f32x2){v0[0], v0[1]}), b = gelu_pk((f32x2){v0[2], v0[3]}), c = gelu_pk((f32x2){v1[0], v1[1]}), d = gelu_pk((f32x2){v1[2], v1[3]});
                        v0 = (f32x4){a.x, a.y, b.x, b.y}; v1 = (f32x4){c.x, c.y, d.x, d.y}; }
                    v0 = v0 * sc; v1 = v1 * sc; u32x4 w; w.x = cvt_pk_bf16(v0[0], v0[1]); w.y = cvt_pk_bf16(v0[2], v0[3]); w.z = cvt_pk_bf16(v1[0], v1[1]); w.w = cvt_pk_bf16(v1[2], v1[3]);
                    *(u32x4*)(rowp + bj * HALF) = w; } }
    }
};
struct EpiResid {
    static constexpr bool PERM = false, AFTER_DRAIN = false, KHOOK = false;
    float* C; int ldc; const float* resA; const float* resB; int rowsA; int rowsValid; float alpha;
    __device__ __forceinline__ void operator()(const f32x4 (&acc)[2][2][4][2], const Unit& u, int wr, int wc, int fr, int fq) const {
        const int row0 = u.pm * BM + wr * 64 + fr, col0 = u.pn * BM + wc * 32 + 4 * fq;
#pragma unroll
        for (int ai = 0; ai < 2; ++ai)
#pragma unroll
            for (int m = 0; m < 4; ++m) { const int r = row0 + ai * HALF + m * 16;
                if (r < rowsValid) {
                    const float* rp = (r < rowsA) ? resA + (size_t)r * ldc + col0 : resB + (size_t)(r - rowsA) * ldc + col0;
                    float* cp = C + (size_t)r * ldc + col0;
#pragma unroll
                    for (int bj = 0; bj < 2; ++bj)
#pragma unroll
                        for (int n = 0; n < 2; ++n) { const f32x4 rv = *(const f32x4*)(rp + bj * HALF + n * 16); *(f32x4*)(cp + bj * HALF + n * 16) = rv * alpha + acc[ai][bj][m][n]; } }
                asm volatile("" ::: "memory"); }
    }
};

struct EpiResidScale {
    static constexpr bool PERM = false, AFTER_DRAIN = false, KHOOK = true;
    float* C; int ldc; const float* res; float alpha; const float* SS; float eps;
    __device__ __forceinline__ void unit_begin(const Unit& u, int par, PG8_LAS unsigned char* lds) const {
        const int tid = threadIdx.x, row = tid >> 1, hh = 4 * (tid & 1);
        float sv[4];
        { const f32x4* sp = (const f32x4*)(SS + ((size_t)(u.pm * BM + row) * 8 + hh) * 8);
#pragma unroll
          for (int q = 0; q < 4; ++q) { const f32x4 a = sp[2 * q], b = sp[2 * q + 1]; sv[q] = (a.x + a.y) + (a.z + a.w) + (b.x + b.y) + (b.z + b.w); asm volatile("" ::: "memory"); } }
        const f32x4 s = (f32x4){sv[0], sv[1], sv[2], sv[3]};
        f32x4 rs; rs.x = __builtin_amdgcn_rsqf(s.x * (1.f / 1024.f) + eps); rs.y = __builtin_amdgcn_rsqf(s.y * (1.f / 1024.f) + eps); rs.z = __builtin_amdgcn_rsqf(s.z * (1.f / 1024.f) + eps); rs.w = __builtin_amdgcn_rsqf(s.w * (1.f / 1024.f) + eps);
        *(PG8_LAS f32x4*)(lds + 131072 + par * 8192 + (row * 8 + hh) * 4) = rs;
    }
    __device__ __forceinline__ void khook(f32x4 (&acc)[2][2][4][2], int par, int hb, int wr, int fr, PG8_LAS unsigned char* lds) const {
        const PG8_LAS float* T = (const PG8_LAS float*)(lds + 131072 + par * 8192);
        asm volatile("s_nop 15\n\ts_nop 15" ::: "memory");
#pragma unroll
        for (int ai = 0; ai < 2; ++ai)
#pragma unroll
            for (int m = 0; m < 4; ++m) { const int row = ai * HALF + wr * 64 + m * 16 + fr;
                typedef float f32x2h __attribute__((ext_vector_type(2))); f32x2h tv;
                asm volatile("ds_read2_b32 %0, %1 offset1:1\n\ts_waitcnt lgkmcnt(0)" : "=&v"(tv) : "v"((unsigned)(size_t)(T + row * 8 + hb - 1)) : "memory");
                const float ratio = tv.x * __builtin_amdgcn_rcpf(tv.y);
#pragma unroll
                for (int bj = 0; bj < 2; ++bj)
#pragma unroll
                    for (int n = 0; n < 2; ++n) { f32x4& a = acc[ai][bj][m][n];
                        asm volatile("v_mul_f32 %0, %0, %4\n\tv_mul_f32 %1, %1, %4\n\tv_mul_f32 %2, %2, %4\n\tv_mul_f32 %3, %3, %4\n\ts_nop 1" : "+v"(a.x), "+v"(a.y), "+v"(a.z), "+v"(a.w) : "v"(ratio)); } }
    }
    __device__ __forceinline__ void epi(const f32x4 (&acc)[2][2][4][2], const Unit& u, int wr, int wc, int fr, int fq, int par, PG8_LAS unsigned char* lds) const {
        const PG8_LAS float* T = (const PG8_LAS float*)(lds + 131072 + par * 8192);
        const int row0 = u.pm * BM + wr * 64 + fr, col0 = u.pn * BM + wc * 32 + 4 * fq;
#pragma unroll
        for (int ai = 0; ai < 2; ++ai)
#pragma unroll
            for (int m = 0; m < 4; ++m) { const int r = row0 + ai * HALF + m * 16; const float sc = T[(ai * HALF + wr * 64 + m * 16 + fr) * 8 + 7];
                const float* rp = res + (size_t)r * ldc + col0; float* cp = C + (size_t)r * ldc + col0;
#pragma unroll
                for (int bj = 0; bj < 2; ++bj)
#pragma unroll
                    for (int n = 0; n < 2; ++n) { const f32x4 rv = *(const f32x4*)(rp + bj * HALF + n * 16); *(f32x4*)(cp + bj * HALF + n * 16) = rv * alpha + acc[ai][bj][m][n] * sc; }
                asm volatile("" ::: "memory"); }
    }
};


template <class Epi, class Sched, bool ALIGN_EPI = false, bool SP2 = false>
__device__ __forceinline__ void gemm_phase(PG8_LAS unsigned char* lds, const Gemm g, const Sched& S, const Epi& E) {
    const int tid = threadIdx.x, wid = __builtin_amdgcn_readfirstlane(tid >> 6), lane = tid & 63, wr = wid >> 2, wc = wid & 3, fr = lane & 15, fq = lane >> 4;
    const int K = g.K, nt = K / BK;
    unsigned voffA[2], voffB[2];
#pragma unroll
    for (int i = 0; i < 2; ++i) { int R, C; stage_rc(tid * 16 + i * 8192, R, C); const int Rb = Epi::PERM ? ((R & ~31) + perm32(R & 31)) : R;
        voffA[i] = (unsigned)(R * K + C) * 2u; voffB[i] = (unsigned)(Rb * K + C) * 2u; }
    const size_t kstep = (size_t)(BK * 2);
    const size_t hstep = (size_t)HALF * K * 2;
    const size_t tstep = 2 * hstep;
    const unsigned ldsw = (unsigned)wid * 1024u;
    const int aoff = lds_byte(wr * 64 + fr, fq * 8), boff = lds_byte(wc * 32 + fr, fq * 8);
#define PG8_SA(b, h) (((b) * 2 + (h)) * HTB)
#define PG8_SB(b, h) ((4 + (b) * 2 + (h)) * HTB)
#define PG8_STAGE(bufoff, gbase, voff) do { _Pragma("unroll") for (int _i = 0; _i < 2; ++_i) \
        __builtin_amdgcn_global_load_lds((const unsigned*)((const char*)(gbase) + (voff)[_i]), (PG8_LAS unsigned*)(lds + (bufoff) + ldsw + _i * 8192), 16, 0, 0); } while (0)
#define PG8_LDA(dst, b, h) do { _Pragma("unroll") for (int m = 0; m < 4; ++m) _Pragma("unroll") for (int k = 0; k < 2; ++k) dst[m][k] = *(const PG8_LAS bf16x8*)(lds + PG8_SA(b, h) + aoff + m * 2048 + k * 1024); } while (0)
#define PG8_LDB(dst, b, h) do { _Pragma("unroll") for (int n = 0; n < 2; ++n) _Pragma("unroll") for (int k = 0; k < 2; ++k) dst[n][k] = *(const PG8_LAS bf16x8*)(lds + PG8_SB(b, h) + boff + n * 2048 + k * 1024); } while (0)
#define PG8_MMA(ai, bj, At, Bt) do { __builtin_amdgcn_s_setprio(1); _Pragma("unroll") for (int m = 0; m < 4; ++m) _Pragma("unroll") for (int n = 0; n < 2; ++n) _Pragma("unroll") for (int k = 0; k < 2; ++k) \
        acc[ai][bj][m][n] = __builtin_amdgcn_mfma_f32_16x16x32_bf16(Bt[n][k], At[m][k], acc[ai][bj][m][n], 0, 0, 0); __builtin_amdgcn_s_setprio(0); } while (0)
#define PG8_WAIT_V(n) asm volatile("s_waitcnt vmcnt(" #n ")" ::: "memory")
#define PG8_WAIT_L(n) asm volatile("s_waitcnt lgkmcnt(" #n ")" ::: "memory")
#define PG8_BAR __builtin_amdgcn_s_barrier()
#define PG8_SCHED __builtin_amdgcn_sched_barrier(0)
    Unit cur, nxt; int ui = 0;
    if (!S.next(0, cur)) return;
    f32x4 acc[2][2][4][2];
#pragma unroll
    for (int a = 0; a < 2; ++a)
#pragma unroll
        for (int b = 0; b < 2; ++b)
#pragma unroll
            for (int m = 0; m < 4; ++m)
#pragma unroll
                for (int n = 0; n < 2; ++n) acc[a][b][m][n] = (f32x4){0.f, 0.f, 0.f, 0.f};
    bf16x8 At[4][2], B0[2][2], B1[2][2];
    const char* cA = (const char*)g.A + (size_t)cur.pm * tstep; const char* cB = (const char*)g.Bt + (size_t)cur.pn * tstep;
    if constexpr (Epi::KHOOK) E.unit_begin(cur, ui & 1, lds);
    S.a_ready(cur);
    if constexpr (SP2) {
        PG8_STAGE(PG8_SB(0, 0), cB, voffB); PG8_STAGE(PG8_SB(0, 1), cB + hstep, voffB); PG8_STAGE(PG8_SA(0, 0), cA, voffA); PG8_STAGE(PG8_SA(0, 1), cA + hstep, voffA);
        if (wr == 1) PG8_BAR;
        PG8_WAIT_V(2); PG8_BAR;
        PG8_STAGE(PG8_SB(1, 0), cB + kstep, voffB); PG8_STAGE(PG8_SA(1, 0), cA + kstep, voffA); PG8_STAGE(PG8_SB(1, 1), cB + hstep + kstep, voffB);
        PG8_WAIT_V(6); PG8_BAR;
    } else {
        PG8_STAGE(PG8_SB(0, 0), cB, voffB); PG8_STAGE(PG8_SA(0, 0), cA, voffA); PG8_STAGE(PG8_SB(0, 1), cB + hstep, voffB); PG8_STAGE(PG8_SA(0, 1), cA + hstep, voffA);
        if (wr == 1) PG8_BAR;
        PG8_WAIT_V(4); PG8_BAR;
        PG8_STAGE(PG8_SB(1, 0), cB + kstep, voffB); PG8_STAGE(PG8_SA(1, 0), cA + kstep, voffA); PG8_STAGE(PG8_SB(1, 1), cB + hstep + kstep, voffB);
        PG8_WAIT_V(6); PG8_BAR;
    }
    for (;;) {
        const bool has_next = S.next(ui + 1, nxt);
        const char* nA = has_next ? (const char*)g.A + (size_t)nxt.pm * tstep : cA; const char* nB = has_next ? (const char*)g.Bt + (size_t)nxt.pn * tstep : cB;
        const int tseg = Epi::KHOOK ? 16 : nt;
        for (int tb = 0; tb < nt; tb += tseg) {
        if constexpr (Epi::KHOOK) { if (tb != 0) { PG8_SCHED; E.khook(acc, ui & 1, tb >> 4, wr, fr, lds); PG8_SCHED; } }
        for (int t = tb; t < tb + tseg; t += 2) {
            const bool last = (t == nt - 2);
            const char* a1 = cA + (size_t)(t + 1) * kstep;
            const char* a2 = last ? nA : cA + (size_t)(t + 2) * kstep; const char* b2 = last ? nB : cB + (size_t)(t + 2) * kstep;
            const char* a3 = a2 + kstep; const char* b3 = b2 + kstep;
            if (last && has_next) S.a_ready(nxt);
            if constexpr (SP2) {
            PG8_LDB(B0, 0, 0); PG8_LDB(B1, 0, 1); PG8_SCHED; PG8_LDA(At, 0, 0); PG8_STAGE(PG8_SA(1, 1), a1 + hstep, voffA);
            PG8_WAIT_V(8); PG8_WAIT_L(0); PG8_BAR; PG8_MMA(0, 0, At, B0); PG8_MMA(0, 1, At, B1); PG8_BAR; PG8_SCHED;
            PG8_LDA(At, 0, 1); PG8_STAGE(PG8_SB(0, 0), b2, voffB); PG8_STAGE(PG8_SB(0, 1), b2 + hstep, voffB); PG8_STAGE(PG8_SA(0, 0), a2, voffA);
            PG8_WAIT_V(8); PG8_WAIT_L(0); PG8_BAR; PG8_MMA(1, 0, At, B0); PG8_MMA(1, 1, At, B1); PG8_BAR; PG8_SCHED;
            PG8_LDB(B0, 1, 0); PG8_LDB(B1, 1, 1); PG8_SCHED; PG8_LDA(At, 1, 0); PG8_STAGE(PG8_SA(0, 1), a2 + hstep, voffA);
            PG8_WAIT_V(8); PG8_WAIT_L(0); PG8_BAR; PG8_MMA(0, 0, At, B0); PG8_MMA(0, 1, At, B1); PG8_BAR; PG8_SCHED;
            PG8_LDA(At, 1, 1); PG8_STAGE(PG8_SB(1, 0), b3, voffB); PG8_STAGE(PG8_SB(1, 1), b3 + hstep, voffB); PG8_STAGE(PG8_SA(1, 0), a3, voffA);
            PG8_WAIT_V(8); PG8_WAIT_L(0); PG8_BAR; PG8_MMA(1, 0, At, B0); PG8_MMA(1, 1, At, B1); PG8_BAR; PG8_SCHED;
            } else {
            PG8_LDB(B0, 0, 0); PG8_SCHED; PG8_LDA(At, 0, 0); PG8_STAGE(PG8_SA(1, 1), a1 + hstep, voffA);
            PG8_WAIT_L(8); PG8_BAR; PG8_WAIT_L(0); PG8_MMA(0, 0, At, B0); PG8_BAR; PG8_SCHED;
            PG8_LDB(B1, 0, 1); PG8_STAGE(PG8_SB(0, 0), b2, voffB);
            PG8_BAR; PG8_WAIT_L(0); PG8_MMA(0, 1, At, B1); PG8_BAR;
            PG8_LDA(At, 0, 1); PG8_STAGE(PG8_SA(0, 0), a2, voffA);
            PG8_BAR; PG8_WAIT_L(0); PG8_MMA(1, 0, At, B0); PG8_BAR; PG8_SCHED;
            PG8_STAGE(PG8_SB(0, 1), b2 + hstep, voffB);
            PG8_WAIT_V(6); PG8_BAR; PG8_MMA(1, 1, At, B1); PG8_BAR;
            PG8_LDB(B0, 1, 0); PG8_SCHED; PG8_LDA(At, 1, 0); PG8_STAGE(PG8_SA(0, 1), a2 + hstep, voffA);
            PG8_WAIT_L(8); PG8_BAR; PG8_WAIT_L(0); PG8_MMA(0, 0, At, B0); PG8_BAR; PG8_SCHED;
            PG8_LDB(B1, 1, 1); PG8_STAGE(PG8_SB(1, 0), b3, voffB);
            PG8_BAR; PG8_WAIT_L(0); PG8_MMA(0, 1, At, B1); PG8_BAR;
            PG8_LDA(At, 1, 1); PG8_STAGE(PG8_SA(1, 0), a3, voffA);
            PG8_BAR; PG8_WAIT_L(0); PG8_MMA(1, 0, At, B0); PG8_BAR; PG8_SCHED;
            PG8_STAGE(PG8_SB(1, 1), b3 + hstep, voffB);
            PG8_WAIT_V(6); PG8_BAR; PG8_MMA(1, 1, At, B1); PG8_BAR;
            }
        }
        }
        if constexpr (ALIGN_EPI) { if (wr == 0) PG8_BAR; }
        if constexpr (Epi::KHOOK) { E.epi(acc, cur, wr, wc, fr, fq, ui & 1, lds); S.done(cur); }
        else if constexpr (!Epi::AFTER_DRAIN) { E(acc, cur, wr, wc, fr, fq); S.done(cur); }
        if (!has_next) break;
#pragma unroll
        for (int a = 0; a < 2; ++a)
#pragma unroll
            for (int b = 0; b < 2; ++b)
#pragma unroll
                for (int m = 0; m < 4; ++m)
#pragma unroll
                    for (int n = 0; n < 2; ++n) acc[a][b][m][n] = (f32x4){0.f, 0.f, 0.f, 0.f};
        cur = nxt; cA = nA; cB = nB; ++ui;
        if constexpr (Epi::KHOOK) E.unit_begin(cur, ui & 1, lds);
        if constexpr (ALIGN_EPI) { if (wr == 1) PG8_BAR; }
    }
    PG8_WAIT_V(0);
    if constexpr (!ALIGN_EPI) { if (wr == 0) PG8_BAR; }
    PG8_BAR;
    if constexpr (Epi::AFTER_DRAIN) { E.fused(acc, cur, wr, wc, fr, fq, lds, wid, lane); S.done(cur); }
#undef PG8_SA
#undef PG8_SB
#undef PG8_STAGE
#undef PG8_LDA
#undef PG8_LDB
#undef PG8_MMA
#undef PG8_WAIT_V
#undef PG8_WAIT_L
#undef PG8_BAR
#undef PG8_SCHED
}
}
#ifndef PG8_SP2
#define PG8_SP2 true
#endif
#ifndef PG8_ALIGN
#define PG8_ALIGN true
#endif

constexpr int NWAVES = 8;
constexpr int PER_PHASE = 12;
#ifndef MK_N_LAUNCHES
#define MK_N_LAUNCHES 1
#endif
#ifndef PROBE_MASK
#define PROBE_MASK 0
#endif
#define REP(k) (((PROBE_MASK >> (k)) & 1) + 1)
#ifndef PROBE_VAR
#define PROBE_VAR 0
#endif
#ifndef PROBE_CLK
#define PROBE_CLK 0
#endif
#ifndef STAMP_MASK
#define STAMP_MASK 0
#endif
#ifndef USE_AUX
#define USE_AUX 0
#endif
#ifndef USE_TILE_TRANSPOSE
#define USE_TILE_TRANSPOSE 0
#endif
#ifndef USE_L1_SEQ2
#define USE_L1_SEQ2 0
#endif
#ifndef USE_FUSED_NORM
#define USE_FUSED_NORM 1
#endif
#ifndef USE_TICKETS
#define USE_TICKETS 0
#endif
constexpr int N_LAUNCHES = MK_N_LAUNCHES;

constexpr int D = 4096, NB = 4, SEQ = 2048, NMETA = 16, DI = 8192;
constexpr int MX = NB * SEQ;
constexpr int MR = MX + NMETA;
constexpr int MP = 8448;
constexpr int N0 = 4 * DI;
constexpr int N1 = 2 * 4096 + 2 * DI;
constexpr int HG_H = 64, HG_DK = 128;
constexpr int GL_H = 8, GL_DK = 512, GL_DV = 1024, GL_R = 16;
constexpr float LN_EPS = 1e-5f, RMS_EPS = 1e-6f;
constexpr float ALPHA = 1.41421356237309515f;

constexpr size_t MiB = 1u << 20;
constexpr size_t WS_CTL = 0, CTL_ZERO_BYTES = 1 * MiB;
constexpr size_t WS_LB0 = 1 * MiB;
constexpr size_t WS_G1 = 2 * MiB;
constexpr size_t WS_WG1T = 3 * MiB;
constexpr size_t WS_W2F = 3 * MiB + 256 * 1024;
constexpr size_t WS_WT0IN = 4 * MiB;
constexpr size_t WS_WT0OUT = WS_WT0IN + 256 * MiB;
constexpr size_t WS_WT1IN = WS_WT0OUT + 64 * MiB;
constexpr size_t WS_WT1OUT = WS_WT1IN + 192 * MiB;
constexpr size_t WS_XB = WS_WT1OUT + 64 * MiB;
constexpr size_t WS_H1B = WS_XB + 66 * MiB;
constexpr size_t WS_QFIZ = WS_H1B + 66 * MiB;
constexpr size_t WS_Y = WS_QFIZ + 528 * MiB;
constexpr size_t WS_PRE = WS_Y + 132 * MiB;
constexpr size_t WS_REC = WS_PRE + 132 * MiB;
constexpr size_t WS_Q0 = WS_REC + 520 * MiB;
constexpr size_t WS_Y0 = WS_REC + 523 * MiB;
constexpr size_t WS_REC1 = WS_REC, WS_VF1 = WS_REC + 139 * MiB, WS_O1 = WS_REC + 270 * MiB;
constexpr size_t WS_END = WS_REC + 528 * MiB;
static_assert((size_t)MP * D * 2 <= 66 * MiB && (size_t)MP * N0 * 2 <= 528 * MiB && (size_t)MP * DI * 2 <= 132 * MiB && (size_t)MP * D * 4 <= 132 * MiB && (size_t)MR * DI * 4 <= 258 * MiB, "d_ws map");
static_assert((size_t)256 * 65 * 27648 <= 440 * MiB && (size_t)32 * 65 * 69632 <= 139 * MiB && (size_t)32 * 65 * 65536 <= 131 * MiB, "record map");
constexpr int CW_BAR = 4096, CW_POOL = 8192;

constexpr int RING_OFF = 0, RING_BYTES = 155648;
constexpr int LDSCTL_OFF = RING_BYTES, MISC_OFF = LDSCTL_OFF + 320;
constexpr int LDS_BYTES = 163840;
static_assert(MISC_OFF + 128 <= LDS_BYTES, "LDS map");

#define GAS __attribute__((address_space(1)))
#define LAS __attribute__((address_space(3)))
typedef unsigned short bf16;
typedef unsigned v4u __attribute__((ext_vector_type(4)));
typedef unsigned v2u __attribute__((ext_vector_type(2)));
typedef float f32x4 __attribute__((ext_vector_type(4)));
typedef GAS unsigned gu32;
#define RLX_AGENT __ATOMIC_RELAXED, __HIP_MEMORY_SCOPE_AGENT
#define LDS_WAIT() asm volatile("s_waitcnt lgkmcnt(0)" ::: "memory")
#define DI_ __device__ __forceinline__
DI_ unsigned f2bf(float f) { unsigned u = __builtin_bit_cast(unsigned, f); return (u + 0x7fffu + ((u >> 16) & 1u)) >> 16; }
DI_ unsigned pk2(float lo, float hi) { return f2bf(lo) | (f2bf(hi) << 16); }
DI_ unsigned hwpk(float lo, float hi) { unsigned r; asm volatile("v_cvt_pk_bf16_f32 %0, %1, %2" : "=v"(r) : "v"(lo), "v"(hi)); return r; }
DI_ float bflo(unsigned w) { return __builtin_bit_cast(float, w << 16); }
DI_ float bfhi(unsigned w) { return __builtin_bit_cast(float, w & 0xffff0000u); }
DI_ float bf2f(bf16 b) { return __builtin_bit_cast(float, (unsigned)b << 16); }
DI_ float sigm(float x) { return __builtin_amdgcn_rcpf(1.f + __builtin_amdgcn_exp2f(x * -1.4426950408889634f)); }
DI_ float silu(float x) { return x * __builtin_amdgcn_rcpf(1.f + __builtin_amdgcn_exp2f(x * -1.4426950408889634f)); }

#define XB_TMO      128
#define XB_XCNT(j)  (256  + 64 * (j))
#define XB_XSUB(j)  (1280 + 64 * (j))
#define XB_XGEN(j)  (2304 + 64 * (j))
#define XB_TOP      3328
#define XB_TOPGEN   3392
#define XCD_BAR_WORDS 3456
#define XB_SPIN_CAP (1u << 18)

__device__ __forceinline__ unsigned xb_ld(unsigned* p)              { return __hip_atomic_load(p, __ATOMIC_RELAXED, __HIP_MEMORY_SCOPE_AGENT); }
__device__ __forceinline__ unsigned xb_add(unsigned* p, unsigned v) { return __hip_atomic_fetch_add(p, v, __ATOMIC_RELAXED, __HIP_MEMORY_SCOPE_AGENT); }
__device__ __forceinline__ unsigned xb_xcc_id() { return (unsigned)__builtin_amdgcn_s_getreg((3 << 11) | 20) & 0xFu; }
#define XB_SPIN(cond, bar) do { unsigned _sp = 0; while (cond) { __builtin_amdgcn_s_sleep(1); \
    if ((++_sp & 255u) == 0u) { if (xb_ld(&(bar)[XB_TMO])) break; if (_sp > XB_SPIN_CAP) { atomicAdd(&(bar)[XB_TMO], 1u); break; } } } } while (0)

struct XcdBarrier {
    unsigned* bar; unsigned x;
    volatile LAS unsigned* st;
};
__device__ __forceinline__ XcdBarrier xcd_barrier_post(unsigned* bar, volatile LAS unsigned* st) {
    XcdBarrier b; b.bar = bar; b.x = xb_xcc_id(); b.st = st;
    if (threadIdx.x == 0) (void)xb_add(&bar[XB_XCNT(b.x)], 1u);
    return b;
}
__device__ __forceinline__ void xcd_barrier_complete(unsigned* bar, unsigned x, unsigned& nloc, unsigned& nx) {
    const unsigned G = gridDim.x * gridDim.y * gridDim.z;
    unsigned sum, cnt, mine, sp = 0u;
    for (;;) {
        sum = 0u; cnt = 0u; mine = 0u;
#pragma unroll
        for (unsigned j = 0; j < 16; ++j) { const unsigned c = xb_ld(&bar[XB_XCNT(j)]); sum += c; cnt += (c > 0u) ? 1u : 0u; mine = (j == x) ? c : mine; }
        if (sum == G) break;
        __builtin_amdgcn_s_sleep(1);
        if ((++sp & 255u) == 0u) { if (xb_ld(&bar[XB_TMO])) break; if (sp > XB_SPIN_CAP) { atomicAdd(&bar[XB_TMO], 1u); break; } }
    }
    nloc = mine > 0u ? mine : 1u; nx = cnt > 0u ? cnt : 1u;
}
__device__ __forceinline__ void xcd_barrier(const XcdBarrier& b) {
    asm volatile("s_waitcnt vmcnt(0)" ::: "memory");
    __syncthreads();
    if (threadIdx.x == 0) {
        unsigned* bar = b.bar;
        __builtin_amdgcn_s_waitcnt(0);
        unsigned nloc = b.st[0], nx = b.st[1];
        if (nloc == 0u) { xcd_barrier_complete(bar, b.x, nloc, nx); b.st[0] = nloc; b.st[1] = nx; }
        const unsigned old = xb_add(&bar[XB_XSUB(b.x)], 1u);
        const unsigned gen = old / nloc;
        if (old + 1u == (gen + 1u) * nloc) {
            __builtin_amdgcn_fence(__ATOMIC_RELEASE, "agent");
            asm volatile("s_waitcnt vmcnt(0)" ::: "memory");
            const unsigned og = xb_add(&bar[XB_TOP], 1u);
            const unsigned tg = og / nx;
            if (og + 1u == (tg + 1u) * nx) xb_add(&bar[XB_TOPGEN], 1u);
            else XB_SPIN(xb_ld(&bar[XB_TOPGEN]) == tg, bar);
            __builtin_amdgcn_fence(__ATOMIC_ACQUIRE, "agent");
            xb_add(&bar[XB_XGEN(b.x)], 1u);
            asm volatile("s_waitcnt vmcnt(0)" ::: "memory");
        } else {
            XB_SPIN(xb_ld(&bar[XB_XGEN(b.x)]) == gen, bar);
            __builtin_amdgcn_fence(__ATOMIC_ACQUIRE, "agent");
            asm volatile("s_waitcnt vmcnt(0)" ::: "memory");
        }
    }
    __syncthreads();
}

struct Frame {
    LAS unsigned char* lds;
    volatile LAS unsigned* MISC;
    gu32* ctl;
    int tid, lane, wave;
    int vcu, G;
    const float *x, *meta, *lb_logits;
    const float *w0in, *b_f, *ng0, *w0out, *ln0g, *ln0b;
    const float *w1in, *wg1, *wg2, *b_g, *ng1, *w1out, *ln1g, *ln1b;
    float* out;
    float *LB0, *G1, *PRE, *O1;
    unsigned char *REC0, *REC1, *VF1;
    bf16 *WG1T, *W2F, *Q0, *Y0;
    float* SS;
    bf16 *WT0IN, *WT0OUT, *WT1IN, *WT1OUT, *XB, *H1B, *QFIZ, *Y;
};

DI_ float wave_sum(float v) {
#pragma unroll
    for (int o = 1; o < 64; o <<= 1) v += __shfl_xor(v, o);
    return v;
}

DI_ void p0_transpose_item(const float* W, int K, int N, bf16* WT, LAS float* scr, int item, int lane) {
    const int nblk = N / 32, kb = item / nblk, nb = item % nblk, k0 = 64 * kb, n0 = 32 * nb;
    float wv[32];
#pragma unroll
    for (int i = 0; i < 32; ++i) wv[i] = W[(size_t)(k0 + 2 * i + (lane >> 5)) * N + n0 + (lane & 31)];
#pragma unroll
    for (int i = 0; i < 32; ++i) scr[(2 * i + (lane >> 5)) * 33 + (lane & 31)] = wv[i];
    LDS_WAIT(); asm volatile("" ::: "memory");
    const int c = lane & 7;
#pragma unroll
    for (int j = 0; j < 4; ++j) { const int n = (lane >> 3) + 8 * j; const LAS float* s = scr + (8 * c) * 33 + n;
        v4u o; o.x = hwpk(s[0 * 33], s[1 * 33]); o.y = hwpk(s[2 * 33], s[3 * 33]); o.z = hwpk(s[4 * 33], s[5 * 33]); o.w = hwpk(s[6 * 33], s[7 * 33]);
        *(GAS v4u*)(WT + (size_t)(n0 + n) * K + k0 + 8 * c) = o; }
    LDS_WAIT(); asm volatile("" ::: "memory");
}

DI_ void p0_tile_load(const float* W, int N, int k0, int n0, int tid, f32x4 (&wv)[8]) {
    const int row = tid >> 5, c4 = tid & 31;
#pragma unroll
    for (int i = 0; i < 8; ++i) wv[i] = *(const GAS f32x4*)(W + (size_t)(k0 + row + 16 * i) * N + n0 + 4 * c4);
}
DI_ void p0_tile_to_lds(int tid, const f32x4 (&wv)[8], LAS unsigned char* img) {
    const int row = tid >> 5, c4 = tid & 31;
#pragma unroll
    for (int i = 0; i < 8; ++i) { const int k = row + 16 * i; const int col = (2 * c4) ^ (2 * ((k >> 3) & 15));
        *(LAS v2u*)(img + k * 256 + col * 4) = (v2u){hwpk(wv[i].x, wv[i].y), hwpk(wv[i].z, wv[i].w)}; }
}
DI_ void p0_tile_from_lds(bf16* WT, int K, int k0, int n0, int tid, LAS unsigned char* img) {
    __syncthreads();
    const int kc = tid & 15;
#pragma unroll
    for (int j = 0; j < 4; ++j) { const int n = (tid >> 4) + 32 * j; unsigned short hv[8];
#pragma unroll
        for (int e = 0; e < 8; ++e) hv[e] = *(const LAS unsigned short*)(img + (8 * kc + e) * 256 + ((((n >> 1) ^ (2 * kc)) << 2) | ((n & 1) << 1)));
        v4u o; o.x = hv[0] | ((unsigned)hv[1] << 16); o.y = hv[2] | ((unsigned)hv[3] << 16); o.z = hv[4] | ((unsigned)hv[5] << 16); o.w = hv[6] | ((unsigned)hv[7] << 16);
        *(GAS v4u*)(WT + (size_t)(n0 + n) * K + k0 + 8 * kc) = o; }
    __syncthreads();
}
struct P0Tile { const float* W; bf16* WT; int K, N, k0, n0; };
DI_ P0Tile p0_tile_decode(Frame& F, int t) {
    constexpr int T_0 = (D / 128) * (N0 / 128), T_1 = (DI / 128) * (D / 128), T_2 = (D / 128) * (N1 / 128);
    P0Tile p;
    if (t < T_0) { p.W = F.w0in; p.WT = F.WT0IN; p.K = D; p.N = N0; }
    else if (t < T_0 + T_1) { t -= T_0; p.W = F.w0out; p.WT = F.WT0OUT; p.K = DI; p.N = D; }
    else if (t < T_0 + T_1 + T_2) { t -= T_0 + T_1; p.W = F.w1in; p.WT = F.WT1IN; p.K = D; p.N = N1; }
    else { t -= T_0 + T_1 + T_2; p.W = F.w1out; p.WT = F.WT1OUT; p.K = DI; p.N = D; }
    const int nt = p.N / 128, kb = t / nt, nb = t - kb * nt; p.k0 = 128 * kb; p.n0 = 128 * nb; return p;
}
DI_ void p0_transpose_all(Frame& F) {
    constexpr int NT = (D / 128) * (N0 / 128) + 2 * (DI / 128) * (D / 128) + (D / 128) * (N1 / 128);
    f32x4 wv[8];
    int t = F.vcu;
    if (t < NT) { const P0Tile p = p0_tile_decode(F, t); p0_tile_load(p.W, p.N, p.k0, p.n0, F.tid, wv); }
    for (; t < NT; t += F.G) {
        const P0Tile p = p0_tile_decode(F, t);
        p0_tile_to_lds(F.tid, wv, F.lds);
        if (t + F.G < NT) { const P0Tile q = p0_tile_decode(F, t + F.G); p0_tile_load(q.W, q.N, q.k0, q.n0, F.tid, wv); }
        p0_tile_from_lds(p.WT, p.K, p.k0, p.n0, F.tid, F.lds);
    }
}

DI_ void p0_prologue(Frame& F) {
    LAS float* scr = (LAS float*)(F.lds + RING_OFF + F.wave * 16384);
    const int gw = F.vcu * NWAVES + F.wave, NGW = F.G * NWAVES;
    constexpr int I_0 = (D / 64) * (N0 / 32), I_1 = (DI / 64) * (D / 32), I_2 = (D / 64) * (N1 / 32), I_3 = I_1;
    constexpr int NITEMS = I_0 + I_1 + I_2 + I_3;
#if USE_TILE_TRANSPOSE
    p0_transpose_all(F);
#else
    for (int it = gw; it < NITEMS; it += NGW) {
        int r = it;
        if (r < I_0) { p0_transpose_item(F.w0in, D, N0, F.WT0IN, scr, r, F.lane); continue; } r -= I_0;
        if (USE_AUX && USE_L0_MFMA == 2 && F.G == 256) break;
        if (r < I_1) { p0_transpose_item(F.w0out, DI, D, F.WT0OUT, scr, r, F.lane); continue; } r -= I_1;
        if (r < I_2) { p0_transpose_item(F.w1in, D, N1, F.WT1IN, scr, r, F.lane); continue; } r -= I_2;
        p0_transpose_item(F.w1out, DI, D, F.WT1OUT, scr, r, F.lane);
    }
#endif
    for (int m = gw; m < MP; m += NGW) {
        GAS unsigned long long* o8 = (GAS unsigned long long*)(F.XB + (size_t)m * D) + F.lane;
        if (m < MR) {
            const float* src = (m < MX) ? F.x + (size_t)m * D : F.meta + (size_t)(m - MX) * D;
            const GAS f32x4* xr = (const GAS f32x4*)src + F.lane;
#pragma unroll 4
            for (int j = 0; j < 16; ++j) { const f32x4 v = xr[64 * j]; o8[64 * j] = (unsigned long long)hwpk(v.x, v.y) | ((unsigned long long)hwpk(v.z, v.w) << 32); }
        } else {
#pragma unroll 4
            for (int j = 0; j < 16; ++j) o8[64 * j] = 0ull;
        }
    }
    for (int m = MR + gw; m < MP; m += NGW) {
        GAS unsigned long long* o8 = (GAS unsigned long long*)(F.H1B + (size_t)m * D) + F.lane;
#pragma unroll 4
        for (int j = 0; j < 16; ++j) o8[64 * j] = 0ull;
    }
    for (int i = gw * 64 + F.lane; i < 16 * N0 / 8; i += NGW * 64) { const int col8 = i % (N0 / 8); const unsigned v = (col8 >= DI / 8 && col8 < 2 * DI / 8) ? 0x47004700u : 0u;
        *((GAS v4u*)F.Q0 + i) = (v4u){v, v, v, v}; }
    for (int i = gw * 64 + F.lane; i < GL_R * D; i += NGW * 64) { const int n = i / D, k = i - n * D; F.WG1T[i] = (bf16)f2bf(F.wg1[(size_t)k * GL_R + n]); }
    for (int i = gw * 64 + F.lane; i < 8 * 16 * 2 * 64 * 8; i += NGW * 64) {
        const int e = i & 7, ln = (i >> 3) & 63, fr = i >> 9, m2 = fr & 1, s2 = (fr >> 1) & 15, hh = fr >> 5, rA = ln & 15, gA = ln >> 4;
        float v = 0.f; if (gA < 2) v = F.wg2[(size_t)(8 * gA + e) * 4096 + hh * 512 + 32 * s2 + 8 * (rA >> 2) + 4 * m2 + (rA & 3)];
        F.W2F[i] = (bf16)f2bf(v);
    }
    for (int c = gw * 64 + F.lane; c < DI; c += NGW * 64) {
        const float l0 = F.lb_logits[c], l1 = F.lb_logits[DI + c], l2 = F.lb_logits[2 * DI + c];
        const float mx = fmaxf(l0, fmaxf(l1, l2));
        const float e0 = __expf(l0 - mx), e1 = __expf(l1 - mx), e2 = __expf(l2 - mx);
        F.LB0[c] = e0 / (e0 + e1 + e2);
    }
}

DI_ void p2_l0_rec_naive(Frame& F) {
    LAS float* qs = (LAS float*)(F.lds);
    LAS float* fs = qs + 2048;
    LAS float* ks = fs + 2048;
    LAS float* vs = ks + 2048;
    LAS float* pb = vs + 2048;
    const int tid = F.tid, dv = tid & 127, kg = tid >> 7;
    const int lj = tid >> 5, lc = (tid & 31) * 4;
    for (int u = blockIdx.x; u < NB * HG_H; u += F.G) {
        const int b = u >> 6, h = u & 63;
        float S[32];
#pragma unroll
        for (int i = 0; i < 32; ++i) S[i] = 0.f;
        float lbv[4], bfv[4], ngv[4];
#pragma unroll
        for (int i = 0; i < 4; ++i) { lbv[i] = F.LB0[h * 128 + lc + i]; bfv[i] = F.b_f[h * 128 + lc + i]; ngv[i] = F.ng0[h * 128 + lc + i]; }
        for (int tb = 0; tb < 129; ++tb) {
            const int rbase = (tb == 0) ? MX : b * SEQ + 16 * (tb - 1);
            const bf16* row = F.QFIZ + (size_t)(rbase + lj) * N0 + h * 128 + lc;
            {
                const v2u q4 = *(const GAS v2u*)(row), f4 = *(const GAS v2u*)(row + DI), i4 = *(const GAS v2u*)(row + 2 * DI);
                const float qv[4] = {bflo(q4.x), bfhi(q4.x), bflo(q4.y), bfhi(q4.y)};
                const float fv[4] = {bflo(f4.x), bfhi(f4.x), bflo(f4.y), bfhi(f4.y)};
                const float iv[4] = {bflo(i4.x), bfhi(i4.x), bflo(i4.y), bfhi(i4.y)};
#pragma unroll
                for (int i = 0; i < 4; ++i) {
                    const float fg = lbv[i] + (1.f - lbv[i]) * sigm(fv[i] + bfv[i]);
                    qs[lj * 128 + lc + i] = silu(qv[i]); fs[lj * 128 + lc + i] = fg; ks[lj * 128 + lc + i] = 1.f - fg; vs[lj * 128 + lc + i] = iv[i];
                }
            }
            __syncthreads();
            for (int j = 0; j < 16; ++j) {
                const float vj = vs[j * 128 + dv]; float po = 0.f;
#pragma unroll
                for (int i = 0; i < 32; i += 4) {
                    const f32x4 f4 = *(const LAS f32x4*)(fs + j * 128 + kg * 32 + i), k4 = *(const LAS f32x4*)(ks + j * 128 + kg * 32 + i), q4 = *(const LAS f32x4*)(qs + j * 128 + kg * 32 + i);
                    S[i + 0] = f4.x * S[i + 0] + k4.x * vj; po += q4.x * S[i + 0];
                    S[i + 1] = f4.y * S[i + 1] + k4.y * vj; po += q4.y * S[i + 1];
                    S[i + 2] = f4.z * S[i + 2] + k4.z * vj; po += q4.z * S[i + 2];
                    S[i + 3] = f4.w * S[i + 3] + k4.w * vj; po += q4.w * S[i + 3];
                }
                pb[(j * 4 + kg) * 128 + dv] = po;
            }
            __syncthreads();
            {
                f32x4 o = *(const LAS f32x4*)(pb + (lj * 4 + 0) * 128 + lc);
                o += *(const LAS f32x4*)(pb + (lj * 4 + 1) * 128 + lc);
                o += *(const LAS f32x4*)(pb + (lj * 4 + 2) * 128 + lc);
                o += *(const LAS f32x4*)(pb + (lj * 4 + 3) * 128 + lc);
                float ss = o.x * o.x + o.y * o.y + o.z * o.z + o.w * o.w;
                ss += __shfl_xor(ss, 16); ss += __shfl_xor(ss, 8); ss += __shfl_xor(ss, 4); ss += __shfl_xor(ss, 2); ss += __shfl_xor(ss, 1);
                const float rs = rsqrtf(ss * (1.f / 128.f) + RMS_EPS);
                const v2u z4 = *(const GAS v2u*)(row + 3 * DI);
                const float y0 = o.x * rs * ngv[0] * silu(bflo(z4.x)), y1 = o.y * rs * ngv[1] * silu(bfhi(z4.x));
                const float y2 = o.z * rs * ngv[2] * silu(bflo(z4.y)), y3 = o.w * rs * ngv[3] * silu(bfhi(z4.y));
                if (tb > 0 || b == 0) { v2u w; w.x = pk2(y0, y1); w.y = pk2(y2, y3); *(GAS v2u*)(F.Y + (size_t)(rbase + lj) * DI + h * 128 + lc) = w; }
            }
        }
        __syncthreads();
    }
}

DI_ void ln_phase(Frame& F, const float* src, int nrows, const float* g, const float* bt, float* dst32, bf16* dstb, float* G1) {
    const int gw = F.vcu * NWAVES + F.wave, NGW = F.G * NWAVES;
    for (int r = gw; r < nrows; r += NGW) {
        const GAS f32x4* s = (const GAS f32x4*)(src + (size_t)r * D) + F.lane;
        f32x4 v[16]; float sm = 0.f;
#pragma unroll
        for (int j = 0; j < 16; ++j) { v[j] = s[64 * j]; sm += (v[j].x + v[j].y) + (v[j].z + v[j].w); }
        const float mean = wave_sum(sm) * (1.f / D); float s2 = 0.f;
#pragma unroll
        for (int j = 0; j < 16; ++j) { v[j] = v[j] - mean; s2 += (v[j].x * v[j].x + v[j].y * v[j].y) + (v[j].z * v[j].z + v[j].w * v[j].w); }
        const float rstd = rsqrtf(wave_sum(s2) * (1.f / D) + LN_EPS);
#pragma unroll
        for (int j = 0; j < 16; ++j) {
            const f32x4 gg = *((const GAS f32x4*)g + F.lane + 64 * j), bb = *((const GAS f32x4*)bt + F.lane + 64 * j);
            v[j] = v[j] * rstd * gg + bb;
            if (dst32) *((GAS f32x4*)(dst32 + (size_t)r * D) + F.lane + 64 * j) = v[j];
            if (dstb) { v2u w; w.x = hwpk(v[j].x, v[j].y); w.y = hwpk(v[j].z, v[j].w); *((GAS v2u*)(dstb + (size_t)r * D) + F.lane + 64 * j) = w; }
            if ((j & 3) == 3) asm volatile("" ::: "memory");
        }
        if (G1) {
            LAS float* rowbuf = (LAS float*)(F.lds + RING_OFF + F.wave * 16384);
#pragma unroll
            for (int j = 0; j < 16; ++j) *(LAS f32x4*)(rowbuf + 256 * j + 4 * F.lane) = v[j];
            LDS_WAIT(); asm volatile("" ::: "memory");
            float a[16];
#pragma unroll
            for (int q = 0; q < 16; ++q) a[q] = 0.f;
#pragma unroll 2
            for (int i = 0; i < 64; ++i) {
                const int k = 64 * i + F.lane;
                const float e = rowbuf[k];
                const GAS f32x4* w = (const GAS f32x4*)(F.wg1 + (size_t)k * GL_R);
                const f32x4 w0 = w[0], w1 = w[1], w2 = w[2], w3 = w[3];
                a[0] += e * w0.x; a[1] += e * w0.y; a[2] += e * w0.z; a[3] += e * w0.w;
                a[4] += e * w1.x; a[5] += e * w1.y; a[6] += e * w1.z; a[7] += e * w1.w;
                a[8] += e * w2.x; a[9] += e * w2.y; a[10] += e * w2.z; a[11] += e * w2.w;
                a[12] += e * w3.x; a[13] += e * w3.y; a[14] += e * w3.z; a[15] += e * w3.w;
            }
#pragma unroll
            for (int q = 0; q < 16; ++q) a[q] = wave_sum(a[q]);
            if (F.lane == 0) {
#pragma unroll
                for (int q = 0; q < 16; q += 4) *(GAS f32x4*)(G1 + (size_t)r * GL_R + q) = (f32x4){a[q], a[q + 1], a[q + 2], a[q + 3]};
            }
            LDS_WAIT(); asm volatile("" ::: "memory");
        }
    }
}

DI_ void p6_l1_rec_naive(Frame& F) {
    LAS float* qs = (LAS float*)(F.lds);
    LAS float* ks = qs + 4096;
    LAS float* gs = ks + 4096;
    LAS float* vs = gs + 4096;
    LAS float* pb = vs + 512;
    const int tid = F.tid, dv = tid & 63, kg = tid >> 6;
    const float qscale = 0.04419417382415922f;
    for (int u = blockIdx.x; u < NB * GL_H * 16; u += F.G) {
        const int dvs = u & 15, bh = u >> 4, b = bh >> 3, h = bh & 7;
        float S[64];
#pragma unroll
        for (int i = 0; i < 64; ++i) S[i] = 0.f;
        float w2[16];
#pragma unroll
        for (int r = 0; r < 16; ++r) w2[r] = F.wg2[(size_t)r * 4096 + h * 512 + tid];
        const float bg = F.b_g[h * 512 + tid];
        for (int tb = 0; tb < 258; ++tb) {
            const int rbase = (tb < 2) ? MX + 8 * tb : b * SEQ + 8 * (tb - 2);
            for (int j = 0; j < 8; ++j) {
                const size_t r = (size_t)(rbase + j);
                const float q = bf2f(F.QFIZ[r * N1 + h * 512 + tid]) * qscale, k = bf2f(F.QFIZ[r * N1 + 4096 + h * 512 + tid]);
                const float* g1 = F.G1 + r * GL_R;
                float xg = bg;
#pragma unroll
                for (int rr = 0; rr < 16; ++rr) xg += g1[rr] * w2[rr];
                const float ls = fminf(xg, 0.f) - log1pf(__expf(-fabsf(xg)));
                qs[j * 512 + tid] = q; ks[j * 512 + tid] = k; gs[j * 512 + tid] = __expf(ls * (1.f / 16.f));
            }
            vs[tid] = bf2f(F.QFIZ[(size_t)(rbase + (tid >> 6)) * N1 + 8192 + h * 1024 + dvs * 64 + (tid & 63)]);
            __syncthreads();
            for (int j = 0; j < 8; ++j) {
                const float vj = vs[j * 64 + dv]; float po = 0.f;
#pragma unroll
                for (int i = 0; i < 64; i += 4) {
                    const f32x4 g4 = *(const LAS f32x4*)(gs + j * 512 + kg * 64 + i), k4 = *(const LAS f32x4*)(ks + j * 512 + kg * 64 + i), q4 = *(const LAS f32x4*)(qs + j * 512 + kg * 64 + i);
                    S[i + 0] = g4.x * S[i + 0] + k4.x * vj; po += q4.x * S[i + 0];
                    S[i + 1] = g4.y * S[i + 1] + k4.y * vj; po += q4.y * S[i + 1];
                    S[i + 2] = g4.z * S[i + 2] + k4.z * vj; po += q4.z * S[i + 2];
                    S[i + 3] = g4.w * S[i + 3] + k4.w * vj; po += q4.w * S[i + 3];
                    if ((i & 12) == 12) asm volatile("" ::: "memory");
                }
                pb[(j * 8 + kg) * 64 + dv] = po;
            }
            __syncthreads();
            {
                const int j = tid >> 6, d = tid & 63; float o = 0.f;
#pragma unroll
                for (int g = 0; g < 8; ++g) o += pb[(j * 8 + g) * 64 + d];
                if (tb >= 2 || b == 0) F.O1[(size_t)(rbase + j) * DI + h * 1024 + dvs * 64 + d] = o;
            }
        }
        __syncthreads();
    }
}

DI_ void p7_normgate(Frame& F) {
    const int gw = F.vcu * NWAVES + F.wave, NGW = F.G * NWAVES;
    for (int it = gw; it < MX * GL_H; it += NGW) {
        const int r = it >> 3, h = it & 7;
        const GAS v4u* o = (const GAS v4u*)((const bf16*)F.O1 + (size_t)r * DI + h * 1024) + F.lane;
        const GAS v4u* zp = (const GAS v4u*)(F.QFIZ + (size_t)r * N1 + 16384 + h * 1024) + F.lane;
        v4u ov[2], zv[2]; float ss = 0.f;
#pragma unroll
        for (int j = 0; j < 2; ++j) { ov[j] = o[64 * j]; zv[j] = zp[64 * j]; }
        float x[2][8];
#pragma unroll
        for (int j = 0; j < 2; ++j) { x[j][0] = bflo(ov[j].x); x[j][1] = bfhi(ov[j].x); x[j][2] = bflo(ov[j].y); x[j][3] = bfhi(ov[j].y); x[j][4] = bflo(ov[j].z); x[j][5] = bfhi(ov[j].z); x[j][6] = bflo(ov[j].w); x[j][7] = bfhi(ov[j].w);
#pragma unroll
            for (int e = 0; e < 8; ++e) ss += x[j][e] * x[j][e]; }
        const float rs = rsqrtf(wave_sum(ss) * (1.f / 1024.f) + RMS_EPS);
#pragma unroll
        for (int j = 0; j < 2; ++j) {
            const int c = h * 1024 + 512 * j + 8 * F.lane;
            const f32x4 n0 = *(const GAS f32x4*)(F.ng1 + c), n1 = *(const GAS f32x4*)(F.ng1 + c + 4);
            const float z[8] = {bflo(zv[j].x), bfhi(zv[j].x), bflo(zv[j].y), bfhi(zv[j].y), bflo(zv[j].z), bfhi(zv[j].z), bflo(zv[j].w), bfhi(zv[j].w)};
            v4u wv; wv.x = pk2(x[j][0] * rs * n0.x * silu(z[0]), x[j][1] * rs * n0.y * silu(z[1])); wv.y = pk2(x[j][2] * rs * n0.z * silu(z[2]), x[j][3] * rs * n0.w * silu(z[3]));
            wv.z = pk2(x[j][4] * rs * n1.x * silu(z[4]), x[j][5] * rs * n1.y * silu(z[5])); wv.w = pk2(x[j][6] * rs * n1.z * silu(z[6]), x[j][7] * rs * n1.w * silu(z[7]));
            *(GAS v4u*)(F.Y + (size_t)r * DI + c) = wv;
        }
    }
}

typedef short bf16x8 __attribute__((ext_vector_type(8)));
#ifndef USE_FUSED_NORM
#define USE_FUSED_NORM 1
#endif
constexpr int NCH = 65;
constexpr int SSP_OFF = 155648 + 512;
constexpr float LOG2E = 1.4426950408889634f;
constexpr int R1_QD = 0, R1_KD = 32768, R1_P = 65536, R1_GL = 67584, R1_SH = 69632;
constexpr int ST1 = R1_SH + 8192;
constexpr int R0_QD = 0, R0_KD = 8192, R0_P = 16384, R0_V = 18432, R0_GL = 26624, R0_SZ = 27648;
constexpr int ST0 = R0_SZ;

DI_ unsigned cvtpk(float lo, float hi) { unsigned r; asm volatile("v_cvt_pk_bf16_f32 %0, %1, %2" : "=v"(r) : "v"(lo), "v"(hi)); return r; }
template <int N> DI_ float row_shr(float x) { return __builtin_bit_cast(float, __builtin_amdgcn_update_dpp(0, __builtin_bit_cast(int, x), 0x110 + N, 0xF, 0xF, true)); }
DI_ float bcast15(float x) { return __builtin_bit_cast(float, __builtin_amdgcn_update_dpp(0, __builtin_bit_cast(int, x), 0x15F, 0xF, 0xF, true)); }
DI_ float scan16(float x) { x += row_shr<1>(x); x += row_shr<2>(x); x += row_shr<4>(x); x += row_shr<8>(x); return x; }
DI_ float ex2(float x) { return __builtin_amdgcn_exp2f(x); }
DI_ float lg2(float x) { return __builtin_amdgcn_logf(x); }
DI_ int row_of(int b, int c, int tok) { return c == 0 ? MX + tok - 16 : b * SEQ + 32 * (c - 1) + tok; }
DI_ bf16x8 mk8(unsigned a, unsigned b, unsigned c, unsigned d) { v4u t; t.x = a; t.y = b; t.z = c; t.w = d; return __builtin_bit_cast(bf16x8, t); }
#define MFMA16(a, b, c) __builtin_amdgcn_mfma_f32_16x16x32_bf16((a), (b), (c), 0, 0, 0)

DI_ void l1_prep(Frame& F, unsigned char* REC1, unsigned char* VF1, const bf16* W2F) {
    const int lane = F.lane, w = F.wave, r = lane & 15, g = lane >> 4;
    LAS unsigned char* T = F.lds + w * 16384;
    LAS unsigned char* Tv = F.lds + w * 16384 + 4096;
    LAS f32x4* Pp = (LAS f32x4*)(F.lds + 131072);
    const float qscale = 0.04419417382415922f;
    for (int it = blockIdx.x; it < NB * GL_H * NCH; it += F.G) {
        const int bh = it / NCH, c = it - bh * NCH, b = bh >> 3, h = bh & 7;
        unsigned char* rec = REC1 + (size_t)it * R1_SH;
        int row[2]; bool nul[2];
#pragma unroll
        for (int ti = 0; ti < 2; ++ti) { const int tok = 16 * ti + r; nul[ti] = (c == 0 && tok < 16); row[ti] = nul[ti] ? 0 : row_of(b, c, tok); }
        bf16x8 g1f[2];
#pragma unroll
        for (int ti = 0; ti < 2; ++ti) {
            f32x4 t0 = (f32x4){0.f, 0.f, 0.f, 0.f}, t1 = t0;
            if (g < 2) { const GAS f32x4* gp = (const GAS f32x4*)(F.G1 + (size_t)row[ti] * GL_R + 8 * g); t0 = gp[0]; t1 = gp[1]; }
            g1f[ti] = mk8(pk2(t0.x, t0.y), pk2(t0.z, t0.w), pk2(t1.x, t1.y), pk2(t1.z, t1.w));
        }
        f32x4 pacc[3];
#pragma unroll
        for (int t = 0; t < 3; ++t) pacc[t] = (f32x4){0.f, 0.f, 0.f, 0.f};
        v4u qraw[2][2], kraw[2][2];
#pragma unroll
        for (int si = 0; si < 2; ++si)
#pragma unroll
            for (int ti = 0; ti < 2; ++ti) { const bf16* rp = F.QFIZ + (size_t)row[ti] * N1 + h * 512 + 32 * (2 * w + si) + 8 * g; qraw[si][ti] = *(const GAS v4u*)rp; kraw[si][ti] = *(const GAS v4u*)(rp + 4096); }
        asm volatile("" ::: "memory");
#pragma unroll
        for (int si = 0; si < 2; ++si) {
            const int s = 2 * w + si, col = h * 512 + 32 * s + 8 * g;
            float xg[2][8];
            { const f32x4 b0 = *(const GAS f32x4*)(F.b_g + col), b1 = *(const GAS f32x4*)(F.b_g + col + 4);
              const bf16x8 wa = *(const GAS bf16x8*)(W2F + ((size_t)((h * 16 + s) * 2 + 0) * 64 + lane) * 8), wb = *(const GAS bf16x8*)(W2F + ((size_t)((h * 16 + s) * 2 + 1) * 64 + lane) * 8);
#pragma unroll
              for (int ti = 0; ti < 2; ++ti) { const f32x4 xa = MFMA16(wa, g1f[ti], b0), xb = MFMA16(wb, g1f[ti], b1);
                  xg[ti][0] = xa.x; xg[ti][1] = xa.y; xg[ti][2] = xa.z; xg[ti][3] = xa.w; xg[ti][4] = xb.x; xg[ti][5] = xb.y; xg[ti][6] = xb.z; xg[ti][7] = xb.w; } }
            float qv[2][8], kv[2][8];
#pragma unroll
            for (int ti = 0; ti < 2; ++ti) {
                const v4u q4 = qraw[si][ti], k4 = kraw[si][ti];
                qv[ti][0] = bflo(q4.x); qv[ti][1] = bfhi(q4.x); qv[ti][2] = bflo(q4.y); qv[ti][3] = bfhi(q4.y); qv[ti][4] = bflo(q4.z); qv[ti][5] = bfhi(q4.z); qv[ti][6] = bflo(q4.w); qv[ti][7] = bfhi(q4.w);
                kv[ti][0] = bflo(k4.x); kv[ti][1] = bfhi(k4.x); kv[ti][2] = bflo(k4.y); kv[ti][3] = bfhi(k4.y); kv[ti][4] = bflo(k4.z); kv[ti][5] = bfhi(k4.z); kv[ti][6] = bflo(k4.w); kv[ti][7] = bfhi(k4.w);
            }
            unsigned qd[2][4], ki[2][4], kd[2][4]; float gl[8];
#pragma unroll
            for (int e = 0; e < 8; e += 2) {
                float bb[2][2], BB[2];
#pragma unroll
                for (int u = 0; u < 2; ++u) {
                    float L0 = nul[0] ? 0.f : (fminf(xg[0][e + u], 0.f) * LOG2E - lg2(1.f + ex2(-fabsf(xg[0][e + u]) * LOG2E))) * (1.f / 16.f);
                    float L1 = nul[1] ? 0.f : (fminf(xg[1][e + u], 0.f) * LOG2E - lg2(1.f + ex2(-fabsf(xg[1][e + u]) * LOG2E))) * (1.f / 16.f);
                    const float b0 = scan16(L0);
                    const float b1 = scan16(L1) + bcast15(b0);
                    bb[0][u] = b0; bb[1][u] = b1; BB[u] = bcast15(b1);
                    gl[e + u] = ex2(BB[u]);
                }
#pragma unroll
                for (int ti = 0; ti < 2; ++ti) {
                    const float q0 = nul[ti] ? 0.f : qv[ti][e] * qscale, q1 = nul[ti] ? 0.f : qv[ti][e + 1] * qscale;
                    const float k0 = nul[ti] ? 0.f : kv[ti][e], k1 = nul[ti] ? 0.f : kv[ti][e + 1];
                    qd[ti][e >> 1] = cvtpk(q0 * ex2(bb[ti][0]), q1 * ex2(bb[ti][1]));
                    ki[ti][e >> 1] = cvtpk(k0 * ex2(-bb[ti][0]), k1 * ex2(-bb[ti][1]));
                    kd[ti][e >> 1] = cvtpk(k0 * ex2(BB[0] - bb[ti][0]), k1 * ex2(BB[1] - bb[ti][1]));
                }
            }
            const bf16x8 qf0 = mk8(qd[0][0], qd[0][1], qd[0][2], qd[0][3]), qf1 = mk8(qd[1][0], qd[1][1], qd[1][2], qd[1][3]);
            const bf16x8 kf0 = mk8(ki[0][0], ki[0][1], ki[0][2], ki[0][3]), kf1 = mk8(ki[1][0], ki[1][1], ki[1][2], ki[1][3]);
            pacc[0] = MFMA16(kf0, qf0, pacc[0]);
            pacc[1] = MFMA16(kf0, qf1, pacc[1]);
            pacc[2] = MFMA16(kf1, qf1, pacc[2]);
#pragma unroll
            for (int ti = 0; ti < 2; ++ti)
#pragma unroll
                for (int h2 = 0; h2 < 2; ++h2) {
                    const int lp = (2 * (g & 1) + h2) * 16 + r;
                    v2u d; d.x = qd[ti][2 * h2]; d.y = qd[ti][2 * h2 + 1];
                    *(GAS v2u*)(rec + R1_QD + ((ti * 16 + s) * 64 + lp) * 16 + (g >> 1) * 8) = d;
                }
#pragma unroll
            for (int ti = 0; ti < 2; ++ti)
#pragma unroll
                for (int e = 0; e < 8; ++e) {
                    const unsigned wd = kd[ti][e >> 1]; const unsigned short hv = (e & 1) ? (unsigned short)(wd >> 16) : (unsigned short)(wd & 0xffffu);
                    *(LAS unsigned short*)(T + (32 * si + 8 * g + e) * 64 + (16 * ti + r) * 2) = hv;
                }
            if (r == 0) { *(GAS f32x4*)(rec + R1_GL + (32 * s + 8 * g) * 4) = (f32x4){gl[0], gl[1], gl[2], gl[3]}; *(GAS f32x4*)(rec + R1_GL + (32 * s + 8 * g + 4) * 4) = (f32x4){gl[4], gl[5], gl[6], gl[7]}; }
        }
#pragma unroll
        for (int t = 0; t < 3; ++t) Pp[(w * 3 + t) * 64 + lane] = pacc[t];
        LDS_WAIT(); asm volatile("" ::: "memory");
#pragma unroll
        for (int ml = 0; ml < 4; ++ml) { const v4u d = *(const LAS v4u*)(T + (16 * ml + r) * 64 + 16 * g); *(GAS v4u*)(rec + R1_KD + ((4 * w + ml) * 64 + lane) * 16) = d; }
        __syncthreads();
        if (w < 4) {
            const int tj = (w == 2 || w == 3) ? 1 : 0, ti = (w == 1 || w == 2) ? 1 : 0;
            f32x4 sum = (f32x4){0.f, 0.f, 0.f, 0.f};
            if (w < 3) {
#pragma unroll
                for (int ww = 0; ww < 8; ++ww) sum += Pp[(ww * 3 + w) * 64 + lane];
            }
            float pv[4] = {sum.x, sum.y, sum.z, sum.w};
#pragma unroll
            for (int jj = 0; jj < 4; ++jj) { const int j = 16 * tj + 4 * g + jj, i = 16 * ti + r; if (j > i) pv[jj] = 0.f; }
            const int lp = (2 * tj + (g >> 1)) * 16 + r;
            v2u d; d.x = cvtpk(pv[0], pv[1]); d.y = cvtpk(pv[2], pv[3]);
            *(GAS v2u*)(rec + R1_P + (ti * 64 + lp) * 16 + 8 * (g & 1)) = d;
        }
        __syncthreads();
    }
}

template <int VAR> DI_ void l1_seq(Frame& F, const unsigned char* REC1, const unsigned char* VF1, float* O1, float* SS) {
    const int lane = F.lane, w = F.wave, r = lane & 15, g = lane >> 4;
    for (int u = F.vcu; u < NB * GL_H * 8; u += F.G) {
        const int bh = u >> 3, ds = u & 7, b = bh >> 3, h = bh & 7;
        f32x4 acc[32];
#pragma unroll
        for (int m = 0; m < 32; ++m) acc[m] = (f32x4){0.f, 0.f, 0.f, 0.f};
#define L1_DMA(c_) do { const unsigned char* rs_ = REC1 + (size_t)(bh * NCH + (c_)) * R1_SH; LAS unsigned char* st_ = F.lds + ((c_) & 1) * ST1; \
        for (int p_ = w; p_ < 76; p_ += 8) { const unsigned char* src_; \
            if (p_ < 68) src_ = rs_ + p_ * 1024 + lane * 16; \
            else { const int tk_ = 4 * (p_ - 68) + (lane >> 4);         \
                   src_ = ((c_) == 0 && tk_ < 16) ? (const unsigned char*)(F.H1B + (size_t)MR * D) + (lane & 15) * 16 \
                        : (const unsigned char*)(F.QFIZ + (size_t)row_of(b, (c_), tk_) * N1 + 8192 + h * 1024 + ds * 128) + (lane & 15) * 16; } \
            __builtin_amdgcn_global_load_lds((const unsigned*)src_, (LAS unsigned*)(st_ + p_ * 1024), 16, 0, 0); } } while (0)
        const int ycol = h * 1024 + ds * 128 + 16 * w + 4 * g;
        const f32x4 ng4 = *(const GAS f32x4*)(F.ng1 + ycol);
        const bf16* xz = F.QFIZ + (size_t)(b * SEQ - 32) * N1 + 16384 + ycol;
        v2u zc0 = (v2u){0u, 0u}, zc1 = zc0, zn0 = zc0, zn1 = zc0;
        if (VAR != 1) L1_DMA(0);
        for (int c = 0; c < NCH; ++c) {
            asm volatile("s_waitcnt vmcnt(0) lgkmcnt(0)" ::: "memory");
            __builtin_amdgcn_s_barrier();
            asm volatile("" ::: "memory");
            if (VAR != 1 && c + 1 < NCH) L1_DMA(c + 1);
            if (USE_FUSED_NORM && VAR == 0 && c >= 2 && w == 0 && lane < 32) {
                const LAS float* pp = (const LAS float*)(F.lds + SSP_OFF) + ((c - 1) & 1) * 256 + lane; float sm = 0.f;
#pragma unroll
                for (int ww = 0; ww < 8; ++ww) sm += pp[ww * 32];
                SS[(size_t)(b * SEQ + 32 * (c - 2) + lane) * 64 + h * 8 + ds] = sm; }
            if (USE_FUSED_NORM && c + 1 < NCH) { const bf16* zp = xz + (size_t)((c + 1) * 32 + r) * N1; zn0 = *(const GAS v2u*)zp; zn1 = *(const GAS v2u*)(zp + (size_t)16 * N1); }
            if (VAR == 2) continue;
            const LAS unsigned char* st = F.lds + (c & 1) * ST1;
            unsigned short vh[8];
#pragma unroll
            for (int e = 0; e < 8; ++e) vh[e] = *(const LAS unsigned short*)(st + R1_SH + (8 * g + e) * 256 + (16 * w + r) * 2);
            const bf16x8 vf = mk8(vh[0] | ((unsigned)vh[1] << 16), vh[2] | ((unsigned)vh[3] << 16), vh[4] | ((unsigned)vh[5] << 16), vh[6] | ((unsigned)vh[7] << 16));
#define SCHED_FENCE() __builtin_amdgcn_sched_barrier(0)
            if (c > 0) {
                f32x4 o0 = (f32x4){0.f, 0.f, 0.f, 0.f}, o1 = o0;
                bf16x8 qb[2][4];
#define LDQ(buf_, gi_) do { _Pragma("unroll") for (int sl_ = 0; sl_ < 2; ++sl_) { qb[buf_][sl_] = *(const LAS bf16x8*)(st + R1_QD + (2 * (gi_) + sl_) * 1024 + lane * 16); \
                    qb[buf_][2 + sl_] = *(const LAS bf16x8*)(st + R1_QD + (16 + 2 * (gi_) + sl_) * 1024 + lane * 16); } } while (0)
                const bf16x8 p0 = *(const LAS bf16x8*)(st + R1_P + lane * 16), p1 = *(const LAS bf16x8*)(st + R1_P + 1024 + lane * 16);
                LDQ(0, 0);
                SCHED_FENCE();
                o0 = MFMA16(vf, p0, o0); o1 = MFMA16(vf, p1, o1);
#pragma unroll
                for (int gi = 0; gi < 8; ++gi) {
                    if (gi < 7) LDQ((gi + 1) & 1, gi + 1);
                    SCHED_FENCE();
#pragma unroll
                    for (int sl = 0; sl < 2; ++sl) { const int s2 = 2 * gi + sl;
                        const bf16x8 sb = mk8(cvtpk(acc[2 * s2].x, acc[2 * s2].y), cvtpk(acc[2 * s2].z, acc[2 * s2].w), cvtpk(acc[2 * s2 + 1].x, acc[2 * s2 + 1].y), cvtpk(acc[2 * s2 + 1].z, acc[2 * s2 + 1].w));
                        o0 = MFMA16(sb, qb[gi & 1][sl], o0); o1 = MFMA16(sb, qb[gi & 1][2 + sl], o1); }
                    SCHED_FENCE();
                }
#undef LDQ
                if (VAR == 1) { asm volatile("" :: "v"(o0), "v"(o1)); } else if (USE_FUSED_NORM) {
                    float t0 = (o0.x * o0.x + o0.y * o0.y) + (o0.z * o0.z + o0.w * o0.w), t1 = (o1.x * o1.x + o1.y * o1.y) + (o1.z * o1.z + o1.w * o1.w);
                    t0 += __shfl_xor(t0, 16); t1 += __shfl_xor(t1, 16); t0 += __shfl_xor(t0, 32); t1 += __shfl_xor(t1, 32);
                    const int row0 = b * SEQ + 32 * (c - 1) + r;
                    if (g == 0) { LAS float* pp = (LAS float*)(F.lds + SSP_OFF) + ((c & 1) * 8 + w) * 32; pp[r] = t0; pp[16 + r] = t1; }
                    const float y0 = o0.x * ng4.x * silu(bflo(zc0.x)), y1 = o0.y * ng4.y * silu(bfhi(zc0.x)), y2 = o0.z * ng4.z * silu(bflo(zc0.y)), y3 = o0.w * ng4.w * silu(bfhi(zc0.y));
                    const float y4 = o1.x * ng4.x * silu(bflo(zc1.x)), y5 = o1.y * ng4.y * silu(bfhi(zc1.x)), y6 = o1.z * ng4.z * silu(bflo(zc1.y)), y7 = o1.w * ng4.w * silu(bfhi(zc1.y));
                    bf16* op = F.Y + (size_t)row0 * DI + ycol;
                    *(GAS v2u*)op = (v2u){cvtpk(y0, y1), cvtpk(y2, y3)}; *(GAS v2u*)(op + (size_t)16 * DI) = (v2u){cvtpk(y4, y5), cvtpk(y6, y7)};
                } else {
                    bf16* op = (bf16*)O1 + (size_t)(b * SEQ + 32 * (c - 1) + r) * DI + h * 1024 + ds * 128 + 16 * w + 4 * g;
                    *(GAS v2u*)op = (v2u){pk2(o0.x, o0.y), pk2(o0.z, o0.w)}; *(GAS v2u*)(op + (size_t)16 * DI) = (v2u){pk2(o1.x, o1.y), pk2(o1.z, o1.w)}; }
            }
            {
                f32x4 ug[2][4]; bf16x8 uk[2][4];
#define LDU(buf_, gi_) do { _Pragma("unroll") for (int ml_ = 0; ml_ < 4; ++ml_) { const int m_ = 4 * (gi_) + ml_; ug[buf_][ml_] = *(const LAS f32x4*)(st + R1_GL + (16 * m_ + 4 * g) * 4); \
                    uk[buf_][ml_] = *(const LAS bf16x8*)(st + R1_KD + m_ * 1024 + lane * 16); } } while (0)
                LDU(0, 0);
                SCHED_FENCE();
#pragma unroll
                for (int gi = 0; gi < 8; ++gi) {
                    if (gi < 7) LDU((gi + 1) & 1, gi + 1);
                    SCHED_FENCE();
#pragma unroll
                    for (int ml = 0; ml < 4; ++ml) { const int m = 4 * gi + ml; acc[m] = MFMA16(uk[gi & 1][ml], vf, acc[m] * ug[gi & 1][ml]); }
                    SCHED_FENCE();
                }
#undef LDU
            }
            if (USE_FUSED_NORM) { zc0 = zn0; zc1 = zn1; }
        }
#undef L1_DMA
        if (VAR == 1) { _Pragma("unroll") for (int m = 0; m < 32; ++m) asm volatile("" :: "v"(acc[m])); }
        asm volatile("s_waitcnt vmcnt(0) lgkmcnt(0)" ::: "memory");
        __builtin_amdgcn_s_barrier();
        if (USE_FUSED_NORM && VAR == 0 && w == 0 && lane < 32) {
            const LAS float* pp = (const LAS float*)(F.lds + SSP_OFF) + ((NCH - 1) & 1) * 256 + lane; float sm = 0.f;
#pragma unroll
            for (int ww = 0; ww < 8; ++ww) sm += pp[ww * 32];
            SS[(size_t)(b * SEQ + 32 * (NCH - 2) + lane) * 64 + h * 8 + ds] = sm; }
        asm volatile("s_waitcnt vmcnt(0) lgkmcnt(0)" ::: "memory");
    }
}

constexpr int R2_QD = 0, R2_KD = 32768, R2_P = 65536, R2_GL = 67584, ST2 = 69632, X2_OFF = 2 * ST2;
DI_ void l1_seq2(Frame& F, const unsigned char* REC1) {
    const int lane = F.lane, w = F.wave, r = lane & 15, g = lane >> 4, dkh = w >> 2, dvq = w & 3;
    for (int u = F.vcu; u < NB * GL_H * 8; u += F.G) {
        const int bh = u >> 3, ds = u & 7, b = bh >> 3, h = bh & 7;
        f32x4 acc[16][2];
#pragma unroll
        for (int m = 0; m < 16; ++m) { acc[m][0] = (f32x4){0.f, 0.f, 0.f, 0.f}; acc[m][1] = acc[m][0]; }
        const int vcol = 8192 + h * 1024 + ds * 128 + 32 * dvq + r;
        int voff[8];
#pragma unroll
        for (int e = 0; e < 8; ++e) voff[e] = (8 * g + e) * N1 + vcol;
        const bf16* xv = F.QFIZ + (size_t)(b * SEQ - 32) * N1;
#define VCH(c_) (((c_) == 0) ? F.QFIZ + (size_t)(MX - 16) * N1 : xv + (size_t)(c_) * 32 * N1)
#define L2_DMA(c_) do { const unsigned char* rs_ = REC1 + (size_t)(bh * NCH + (c_)) * R1_SH; LAS unsigned char* st_ = F.lds + ((c_) & 1) * ST2; \
        _Pragma("unroll") for (int i_ = 0; i_ < 8; ++i_) { const int p_ = w + 8 * i_; __builtin_amdgcn_global_load_lds((const unsigned*)(rs_ + p_ * 1024 + lane * 16), (LAS unsigned*)(st_ + p_ * 1024), 16, 0, 0); } \
        if (w < 4) __builtin_amdgcn_global_load_lds((const unsigned*)(rs_ + (w + 64) * 1024 + lane * 16), (LAS unsigned*)(st_ + (w + 64) * 1024), 16, 0, 0); } while (0)
#define L2_VLOAD(c_, set_) do { const bf16* vb_ = VCH(c_); _Pragma("unroll") for (int e_ = 0; e_ < 8; ++e_) { vr[set_][0][e_] = (unsigned)*(const GAS unsigned short*)(vb_ + voff[e_]); vr[set_][1][e_] = (unsigned)*(const GAS unsigned short*)(vb_ + voff[e_] + 16); } } while (0)
        unsigned vr[2][2][8];
        f32x4 keep[2][2];
        L2_DMA(0); L2_VLOAD(0, 0);
#define L2_BODY(C_, PAR) do { const int c = (C_); \
            asm volatile("s_waitcnt vmcnt(0)" ::: "memory"); \
            __builtin_amdgcn_s_barrier(); \
            asm volatile("" ::: "memory"); \
            if (c >= 2 && c <= NCH) {                                  \
                const v4u px = *(const LAS v4u*)(F.lds + X2_OFF + (PAR ^ 1) * 8192 + (w ^ 4) * 1024 + lane * 16); \
                const f32x4 a0 = keep[PAR ^ 1][0] + (f32x4){bflo(px.x), bfhi(px.x), bflo(px.y), bfhi(px.y)}, a1 = keep[PAR ^ 1][1] + (f32x4){bflo(px.z), bfhi(px.z), bflo(px.w), bfhi(px.w)}; \
                bf16* op = (bf16*)F.O1 + (size_t)(b * SEQ + 32 * (c - 2) + r) * DI + h * 1024 + ds * 128 + 32 * dvq + 16 * dkh + 4 * g; \
                *(GAS v2u*)op = (v2u){pk2(a0.x, a0.y), pk2(a0.z, a0.w)}; *(GAS v2u*)(op + (size_t)16 * DI) = (v2u){pk2(a1.x, a1.y), pk2(a1.z, a1.w)}; } \
            if (c + 1 < NCH) { L2_VLOAD(c + 1, PAR ^ 1); L2_DMA(c + 1); }          \
            if (c < NCH) { \
                const LAS unsigned char* st = F.lds + (c & 1) * ST2; \
                bf16x8 vf[2]; \
                _Pragma("unroll") for (int t_ = 0; t_ < 2; ++t_) { _Pragma("unroll") for (int e_ = 0; e_ < 8; ++e_) asm volatile("" : "+v"(vr[PAR][t_][e_]));     \
                    vf[t_] = mk8(vr[PAR][t_][0] | (vr[PAR][t_][1] << 16), vr[PAR][t_][2] | (vr[PAR][t_][3] << 16), vr[PAR][t_][4] | (vr[PAR][t_][5] << 16), vr[PAR][t_][6] | (vr[PAR][t_][7] << 16)); } \
                const LAS f32x4* glp = (const LAS f32x4*)(st + R2_GL + (256 * dkh + 4 * g) * 4); \
                f32x4 ug[2][2]; bf16x8 uk[2][2]; \
                if (c > 0) { \
                    f32x4 o[2][2]; \
                    _Pragma("unroll") for (int ti = 0; ti < 2; ++ti) { o[ti][0] = (f32x4){0.f, 0.f, 0.f, 0.f}; o[ti][1] = o[ti][0]; } \
                    if (dkh == 0) { const bf16x8 p0 = *(const LAS bf16x8*)(st + R2_P + lane * 16), p1 = *(const LAS bf16x8*)(st + R2_P + 1024 + lane * 16); \
                        o[0][0] = MFMA16(vf[0], p0, o[0][0]); o[0][1] = MFMA16(vf[1], p0, o[0][1]); o[1][0] = MFMA16(vf[0], p1, o[1][0]); o[1][1] = MFMA16(vf[1], p1, o[1][1]); } \
                    bf16x8 qb[2][2]; \
                    qb[0][0] = *(const LAS bf16x8*)(st + R2_QD + (8 * dkh) * 1024 + lane * 16); qb[0][1] = *(const LAS bf16x8*)(st + R2_QD + (16 + 8 * dkh) * 1024 + lane * 16); \
                    SCHED_FENCE(); \
                    _Pragma("unroll") for (int s2 = 0; s2 < 8; ++s2) { \
                        if (s2 < 7) { qb[(s2 + 1) & 1][0] = *(const LAS bf16x8*)(st + R2_QD + (8 * dkh + s2 + 1) * 1024 + lane * 16); qb[(s2 + 1) & 1][1] = *(const LAS bf16x8*)(st + R2_QD + (16 + 8 * dkh + s2 + 1) * 1024 + lane * 16); } \
                        SCHED_FENCE(); \
                        _Pragma("unroll") for (int t_ = 0; t_ < 2; ++t_) { \
                            const bf16x8 sb = mk8(cvtpk(acc[2 * s2][t_].x, acc[2 * s2][t_].y), cvtpk(acc[2 * s2][t_].z, acc[2 * s2][t_].w), cvtpk(acc[2 * s2 + 1][t_].x, acc[2 * s2 + 1][t_].y), cvtpk(acc[2 * s2 + 1][t_].z, acc[2 * s2 + 1][t_].w)); \
                            o[0][t_] = MFMA16(sb, qb[s2 & 1][0], o[0][t_]); o[1][t_] = MFMA16(sb, qb[s2 & 1][1], o[1][t_]); } \
                        SCHED_FENCE(); \
                    } \
                      \
                    { const f32x4 s0 = o[0][dkh ^ 1], s1 = o[1][dkh ^ 1]; \
                      *(LAS v4u*)(F.lds + X2_OFF + PAR * 8192 + w * 1024 + lane * 16) = (v4u){pk2(s0.x, s0.y), pk2(s0.z, s0.w), pk2(s1.x, s1.y), pk2(s1.z, s1.w)}; \
                      keep[PAR][0] = o[0][dkh]; keep[PAR][1] = o[1][dkh]; } \
                } \
                _Pragma("unroll") for (int ml_ = 0; ml_ < 2; ++ml_) { ug[0][ml_] = glp[4 * ml_]; uk[0][ml_] = *(const LAS bf16x8*)(st + R2_KD + (16 * dkh + ml_) * 1024 + lane * 16); } \
                SCHED_FENCE(); \
                _Pragma("unroll") for (int gi = 0; gi < 8; ++gi) { \
                    if (gi < 7) { _Pragma("unroll") for (int ml_ = 0; ml_ < 2; ++ml_) { const int m_ = 2 * (gi + 1) + ml_; ug[(gi + 1) & 1][ml_] = glp[4 * m_]; uk[(gi + 1) & 1][ml_] = *(const LAS bf16x8*)(st + R2_KD + (16 * dkh + m_) * 1024 + lane * 16); } } \
                    SCHED_FENCE(); \
                    _Pragma("unroll") for (int ml = 0; ml < 2; ++ml) { const int m = 2 * gi + ml; \
                        acc[m][0] = MFMA16(uk[gi & 1][ml], vf[0], acc[m][0] * ug[gi & 1][ml]); acc[m][1] = MFMA16(uk[gi & 1][ml], vf[1], acc[m][1] * ug[gi & 1][ml]); } \
                    SCHED_FENCE(); \
                } \
                asm volatile("s_waitcnt lgkmcnt(0)" ::: "memory"); \
            } \
        } while (0)
        for (int c2 = 0; c2 <= NCH; c2 += 2) { L2_BODY(c2, 0); L2_BODY(c2 + 1, 1); }
#undef L2_BODY
#undef L2_VLOAD
#undef L2_DMA
#undef VCH
        asm volatile("s_waitcnt vmcnt(0) lgkmcnt(0)" ::: "memory");
        __builtin_amdgcn_s_barrier();
    }
}

DI_ void l0_prep(Frame& F, unsigned char* REC0) {
    const int lane = F.lane, w = F.wave, r = lane & 15, g = lane >> 4;
    LAS unsigned char* T = F.lds + w * 16640;
    LAS unsigned char* Tv = T + 8192;
    const int gw = F.vcu * NWAVES + w, NGW = F.G * NWAVES;
    for (int it = gw; it < NB * HG_H * NCH; it += NGW) {
        const int bh = it / NCH, c = it - bh * NCH, b = bh >> 6, h = bh & 63;
        unsigned char* rec = REC0 + (size_t)it * R0_SZ;
        int row[2]; bool nul[2];
#pragma unroll
        for (int ti = 0; ti < 2; ++ti) { const int tok = 16 * ti + r; nul[ti] = (c == 0 && tok < 16); row[ti] = nul[ti] ? 0 : row_of(b, c, tok); }
        f32x4 pacc[3];
#pragma unroll
        for (int t = 0; t < 3; ++t) pacc[t] = (f32x4){0.f, 0.f, 0.f, 0.f};
        v4u qraw[4][2], fraw[4][2], vraw[8];
#pragma unroll
        for (int s = 0; s < 4; ++s)
#pragma unroll
            for (int ti = 0; ti < 2; ++ti) { const bf16* rp = F.QFIZ + (size_t)row[ti] * N0 + h * 128 + 32 * s + 8 * g; qraw[s][ti] = *(const GAS v4u*)rp; fraw[s][ti] = *(const GAS v4u*)(rp + DI); }
#pragma unroll
        for (int i = 0; i < 8; ++i) { const int q = lane + 64 * i, tk = q >> 4, c16 = q & 15; const bool nl = (c == 0 && tk < 16);
            vraw[i] = (v4u){0u, 0u, 0u, 0u}; if (!nl) vraw[i] = *(const GAS v4u*)(F.QFIZ + (size_t)row_of(b, c, tk) * N0 + 2 * DI + h * 128 + 8 * c16); }
        asm volatile("" ::: "memory");
#pragma unroll
        for (int s = 0; s < 4; ++s) {
            const int col = h * 128 + 32 * s + 8 * g;
            float lbv[8], bfv[8];
            { const f32x4 a0 = *(const GAS f32x4*)(F.LB0 + col), a1 = *(const GAS f32x4*)(F.LB0 + col + 4), c0 = *(const GAS f32x4*)(F.b_f + col), c1 = *(const GAS f32x4*)(F.b_f + col + 4);
              lbv[0] = a0.x; lbv[1] = a0.y; lbv[2] = a0.z; lbv[3] = a0.w; lbv[4] = a1.x; lbv[5] = a1.y; lbv[6] = a1.z; lbv[7] = a1.w;
              bfv[0] = c0.x; bfv[1] = c0.y; bfv[2] = c0.z; bfv[3] = c0.w; bfv[4] = c1.x; bfv[5] = c1.y; bfv[6] = c1.z; bfv[7] = c1.w; }
            float qv[2][8], fv[2][8];
#pragma unroll
            for (int ti = 0; ti < 2; ++ti) {
                const v4u q4 = qraw[s][ti], f4 = fraw[s][ti];
                qv[ti][0] = bflo(q4.x); qv[ti][1] = bfhi(q4.x); qv[ti][2] = bflo(q4.y); qv[ti][3] = bfhi(q4.y); qv[ti][4] = bflo(q4.z); qv[ti][5] = bfhi(q4.z); qv[ti][6] = bflo(q4.w); qv[ti][7] = bfhi(q4.w);
                fv[ti][0] = bflo(f4.x); fv[ti][1] = bfhi(f4.x); fv[ti][2] = bflo(f4.y); fv[ti][3] = bfhi(f4.y); fv[ti][4] = bflo(f4.z); fv[ti][5] = bfhi(f4.z); fv[ti][6] = bflo(f4.w); fv[ti][7] = bfhi(f4.w);
            }
            unsigned qd[2][4], ki[2][4], kd[2][4]; float gl[8];
#pragma unroll
            for (int e = 0; e < 8; e += 2) {
                float bb[2][2], BB[2], kk[2][2];
#pragma unroll
                for (int u = 0; u < 2; ++u) {
                    const float fg0 = lbv[e + u] + (1.f - lbv[e + u]) * sigm(fv[0][e + u] + bfv[e + u]);
                    const float fg1 = lbv[e + u] + (1.f - lbv[e + u]) * sigm(fv[1][e + u] + bfv[e + u]);
                    const float L0 = nul[0] ? 0.f : lg2(fg0), L1 = nul[1] ? 0.f : lg2(fg1);
                    kk[0][u] = nul[0] ? 0.f : 1.f - fg0; kk[1][u] = nul[1] ? 0.f : 1.f - fg1;
                    const float b0 = scan16(L0);
                    const float b1 = scan16(L1) + bcast15(b0);
                    bb[0][u] = b0; bb[1][u] = b1; BB[u] = bcast15(b1);
                    gl[e + u] = ex2(BB[u]);
                }
#pragma unroll
                for (int ti = 0; ti < 2; ++ti) {
                    const float q0 = nul[ti] ? 0.f : silu(qv[ti][e]), q1 = nul[ti] ? 0.f : silu(qv[ti][e + 1]);
                    qd[ti][e >> 1] = cvtpk(q0 * ex2(bb[ti][0]), q1 * ex2(bb[ti][1]));
                    ki[ti][e >> 1] = cvtpk(kk[ti][0] * ex2(-bb[ti][0]), kk[ti][1] * ex2(-bb[ti][1]));
                    kd[ti][e >> 1] = cvtpk(kk[ti][0] * ex2(BB[0] - bb[ti][0]), kk[ti][1] * ex2(BB[1] - bb[ti][1]));
                }
            }
            const bf16x8 qf0 = mk8(qd[0][0], qd[0][1], qd[0][2], qd[0][3]), qf1 = mk8(qd[1][0], qd[1][1], qd[1][2], qd[1][3]);
            const bf16x8 kf0 = mk8(ki[0][0], ki[0][1], ki[0][2], ki[0][3]), kf1 = mk8(ki[1][0], ki[1][1], ki[1][2], ki[1][3]);
            pacc[0] = MFMA16(kf0, qf0, pacc[0]);
            pacc[1] = MFMA16(kf0, qf1, pacc[1]);
            pacc[2] = MFMA16(kf1, qf1, pacc[2]);
#pragma unroll
            for (int ti = 0; ti < 2; ++ti)
#pragma unroll
                for (int h2 = 0; h2 < 2; ++h2) {
                    const int lp = (2 * (g & 1) + h2) * 16 + r;
                    v2u d; d.x = qd[ti][2 * h2]; d.y = qd[ti][2 * h2 + 1];
                    *(GAS v2u*)(rec + R0_QD + ((ti * 4 + s) * 64 + lp) * 16 + (g >> 1) * 8) = d;
                }
#pragma unroll
            for (int ti = 0; ti < 2; ++ti)
#pragma unroll
                for (int e = 0; e < 8; ++e) {
                    const unsigned wd = kd[ti][e >> 1]; const unsigned short hv = (e & 1) ? (unsigned short)(wd >> 16) : (unsigned short)(wd & 0xffffu);
                    *(LAS unsigned short*)(T + (32 * s + 8 * g + e) * 64 + (16 * ti + r) * 2) = hv;
                }
            if (r == 0) { *(GAS f32x4*)(rec + R0_GL + (32 * s + 8 * g) * 4) = (f32x4){gl[0], gl[1], gl[2], gl[3]}; *(GAS f32x4*)(rec + R0_GL + (32 * s + 8 * g + 4) * 4) = (f32x4){gl[4], gl[5], gl[6], gl[7]}; }
        }
#pragma unroll
        for (int t = 0; t < 4; ++t) {
            const int tj = (t >= 2) ? 1 : 0, ti = (t == 1 || t == 2) ? 1 : 0;
            float pv[4] = {0.f, 0.f, 0.f, 0.f};
            if (t < 3) { pv[0] = pacc[t].x; pv[1] = pacc[t].y; pv[2] = pacc[t].z; pv[3] = pacc[t].w; }
#pragma unroll
            for (int jj = 0; jj < 4; ++jj) { const int j = 16 * tj + 4 * g + jj, i = 16 * ti + r; if (j > i) pv[jj] = 0.f; }
            const int lp = (2 * tj + (g >> 1)) * 16 + r;
            v2u d; d.x = cvtpk(pv[0], pv[1]); d.y = cvtpk(pv[2], pv[3]);
            *(GAS v2u*)(rec + R0_P + (ti * 64 + lp) * 16 + 8 * (g & 1)) = d;
        }
#pragma unroll
        for (int i = 0; i < 8; ++i) {
            const int q = lane + 64 * i, tk = q >> 4, c16 = q & 15; const v4u d = vraw[i];
            *(LAS v2u*)(Tv + tk * 264 + c16 * 16) = (v2u){d.x, d.y}; *(LAS v2u*)(Tv + tk * 264 + c16 * 16 + 8) = (v2u){d.z, d.w};
        }
        LDS_WAIT(); asm volatile("" ::: "memory");
#pragma unroll
        for (int mt = 0; mt < 8; ++mt) { const v4u d = *(const LAS v4u*)(T + (16 * mt + r) * 64 + 16 * g); *(GAS v4u*)(rec + R0_KD + (mt * 64 + lane) * 16) = d; }
#pragma unroll
        for (int sl = 0; sl < 8; ++sl) {
            unsigned short hv[8];
#pragma unroll
            for (int e = 0; e < 8; ++e) hv[e] = *(const LAS unsigned short*)(Tv + (8 * g + e) * 264 + (16 * sl + r) * 2);
            v4u d; d.x = hv[0] | ((unsigned)hv[1] << 16); d.y = hv[2] | ((unsigned)hv[3] << 16); d.z = hv[4] | ((unsigned)hv[5] << 16); d.w = hv[6] | ((unsigned)hv[7] << 16);
            *(GAS v4u*)(rec + R0_V + (sl * 64 + lane) * 16) = d;
        }
        LDS_WAIT(); asm volatile("" ::: "memory");
    }
}

DI_ void l0_seq(Frame& F, const unsigned char* REC0) {
    const int lane = F.lane, w = F.wave, r = lane & 15, g = lane >> 4;
    LAS float* obuf = (LAS float*)(F.lds + 2 * ST0);
    constexpr int OB = 32 * 132;
    for (int u = F.vcu; u < NB * HG_H; u += F.G) {
        const int bh = u, b = bh >> 6, h = bh & 63;
        f32x4 acc[8];
#pragma unroll
        for (int m = 0; m < 8; ++m) acc[m] = (f32x4){0.f, 0.f, 0.f, 0.f};
        const int ntok = 4 * w + g, ndv = 8 * r;
        float ngv[8];
        { const f32x4 a0 = *(const GAS f32x4*)(F.ng0 + h * 128 + ndv), a1 = *(const GAS f32x4*)(F.ng0 + h * 128 + ndv + 4);
          ngv[0] = a0.x; ngv[1] = a0.y; ngv[2] = a0.z; ngv[3] = a0.w; ngv[4] = a1.x; ngv[5] = a1.y; ngv[6] = a1.z; ngv[7] = a1.w; }
#define L0_DMA(c_) do { const unsigned char* rs_ = REC0 + (size_t)(bh * NCH + (c_)) * R0_SZ; LAS unsigned char* st_ = F.lds + ((c_) & 1) * ST0; \
        for (int p_ = w; p_ < 27; p_ += 8) __builtin_amdgcn_global_load_lds((const unsigned*)(rs_ + p_ * 1024 + lane * 16), (LAS unsigned*)(st_ + p_ * 1024), 16, 0, 0); } while (0)
        L0_DMA(0);
        v4u zprev = (v4u){0u, 0u, 0u, 0u};
        for (int c = 0; c <= NCH; ++c) {
            asm volatile("s_waitcnt vmcnt(0)" ::: "memory");
            __builtin_amdgcn_s_barrier();
            asm volatile("" ::: "memory");
            if (c + 1 < NCH) L0_DMA(c + 1);
            v4u zcur = (v4u){0u, 0u, 0u, 0u};
            const bool zvalid = (c < NCH) && !(c == 0 && ntok < 16);
            if (zvalid) zcur = *(const GAS v4u*)(F.QFIZ + (size_t)row_of(b, c, ntok) * N0 + 3 * DI + h * 128 + ndv);
            if (c >= 1) {
                const int cp = c - 1;
                const LAS float* ob = obuf + (cp & 1) * OB + ntok * 132 + ndv;
                const f32x4 x0 = *(const LAS f32x4*)(ob), x1 = *(const LAS f32x4*)(ob + 4);
                float ss = (x0.x * x0.x + x0.y * x0.y) + (x0.z * x0.z + x0.w * x0.w) + (x1.x * x1.x + x1.y * x1.y) + (x1.z * x1.z + x1.w * x1.w);
                ss += __shfl_xor(ss, 8); ss += __shfl_xor(ss, 4); ss += __shfl_xor(ss, 2); ss += __shfl_xor(ss, 1);
                const float rs = rsqrtf(ss * (1.f / 128.f) + RMS_EPS);
                const bool wr = !(cp == 0 && (ntok < 16 || b != 0));
                if (wr) {
                    v4u d;
                    d.x = cvtpk(x0.x * rs * ngv[0] * silu(bflo(zprev.x)), x0.y * rs * ngv[1] * silu(bfhi(zprev.x)));
                    d.y = cvtpk(x0.z * rs * ngv[2] * silu(bflo(zprev.y)), x0.w * rs * ngv[3] * silu(bfhi(zprev.y)));
                    d.z = cvtpk(x1.x * rs * ngv[4] * silu(bflo(zprev.z)), x1.y * rs * ngv[5] * silu(bfhi(zprev.z)));
                    d.w = cvtpk(x1.z * rs * ngv[6] * silu(bflo(zprev.w)), x1.w * rs * ngv[7] * silu(bfhi(zprev.w)));
                    *(GAS v4u*)(F.Y + (size_t)row_of(b, cp, ntok) * DI + h * 128 + ndv) = d;
                }
            }
            zprev = zcur;
            if (c < NCH) {
                const LAS unsigned char* st = F.lds + (c & 1) * ST0;
                const bf16x8 vf = *(const LAS bf16x8*)(st + R0_V + w * 1024 + lane * 16);
                const bf16x8 p0 = *(const LAS bf16x8*)(st + R0_P + lane * 16), p1 = *(const LAS bf16x8*)(st + R0_P + 1024 + lane * 16);
                bf16x8 qf[8], kf[8]; f32x4 gf[8];
#pragma unroll
                for (int q = 0; q < 8; ++q) qf[q] = *(const LAS bf16x8*)(st + R0_QD + q * 1024 + lane * 16);
#pragma unroll
                for (int m = 0; m < 8; ++m) { gf[m] = *(const LAS f32x4*)(st + R0_GL + (16 * m + 4 * g) * 4); kf[m] = *(const LAS bf16x8*)(st + R0_KD + m * 1024 + lane * 16); }
                SCHED_FENCE();
                f32x4 o0 = (f32x4){0.f, 0.f, 0.f, 0.f}, o1 = o0;
                o0 = MFMA16(vf, p0, o0); o1 = MFMA16(vf, p1, o1);
#pragma unroll
                for (int s2 = 0; s2 < 4; ++s2) {
                    const bf16x8 sb = mk8(cvtpk(acc[2 * s2].x, acc[2 * s2].y), cvtpk(acc[2 * s2].z, acc[2 * s2].w), cvtpk(acc[2 * s2 + 1].x, acc[2 * s2 + 1].y), cvtpk(acc[2 * s2 + 1].z, acc[2 * s2 + 1].w));
                    o0 = MFMA16(sb, qf[s2], o0); o1 = MFMA16(sb, qf[4 + s2], o1);
                }
#pragma unroll
                for (int m = 0; m < 8; ++m) acc[m] = MFMA16(kf[m], vf, acc[m] * gf[m]);
                LAS float* ow = obuf + (c & 1) * OB + r * 132 + 16 * w + 4 * g;
                *(LAS f32x4*)ow = o0; *(LAS f32x4*)(ow + 16 * 132) = o1;
                asm volatile("s_waitcnt lgkmcnt(0)" ::: "memory");
            }
        }
#undef L0_DMA
        asm volatile("s_waitcnt vmcnt(0)" ::: "memory");
        __builtin_amdgcn_s_barrier();
    }
}

template <int KS, int MODE>
DI_ void skinny(Frame& F, const bf16* A, const bf16* Bt, int K, int n_first, int n_slices, bf16* Ob, int ldo, float* Of, const float* res) {
    const int lane = F.lane, w = F.wave, r = lane & 15, g = lane >> 4;
    constexpr int SPB = 8 / KS;
    const int kw = w % KS, sw = w / KS, klen = K / KS, kbeg = kw * klen;
    LAS f32x4* red = (LAS f32x4*)F.lds;
    for (int p = F.vcu; p * SPB < n_slices; p += F.G) {
        const int sl = p * SPB + sw, n0 = n_first + 16 * sl;
        f32x4 acc = (f32x4){0.f, 0.f, 0.f, 0.f};
        if (sl < n_slices) {
            const GAS v4u* bp = (const GAS v4u*)(Bt + (size_t)(n0 + r) * K + kbeg + 16 * g);
            const GAS v4u* ap = (const GAS v4u*)(A + (size_t)r * K + kbeg + 16 * g);
            for (int kk = 0; kk < klen; kk += 256) {
                v4u bv[8], av[8];
#pragma unroll
                for (int u = 0; u < 4; ++u) { bv[2 * u] = bp[(kk + 64 * u) / 8]; bv[2 * u + 1] = bp[(kk + 64 * u) / 8 + 1]; av[2 * u] = ap[(kk + 64 * u) / 8]; av[2 * u + 1] = ap[(kk + 64 * u) / 8 + 1]; }
                asm volatile("" ::: "memory");
#pragma unroll
                for (int u = 0; u < 8; ++u) acc = MFMA16(__builtin_bit_cast(bf16x8, bv[u]), __builtin_bit_cast(bf16x8, av[u]), acc);
            }
        }
        if (KS > 1) {
            red[w * 64 + lane] = acc;
            __syncthreads();
            if (kw == 0) {
#pragma unroll
                for (int j = 1; j < KS; ++j) acc += red[(w + j) * 64 + lane];
            }
        }
        if (kw == 0 && sl < n_slices) {
            if (MODE == 0) { v2u d; d.x = pk2(acc.x, acc.y); d.y = pk2(acc.z, acc.w); *(GAS v2u*)(Ob + (size_t)r * ldo + n0 + 4 * g) = d; }
            else { const f32x4 rv = *(const GAS f32x4*)(res + (size_t)r * D + n0 + 4 * g); *(GAS f32x4*)(Of + (size_t)r * D + n0 + 4 * g) = rv * ALPHA + acc; }
        }
        if (KS > 1) __syncthreads();
    }
    asm volatile("s_waitcnt vmcnt(0)" ::: "memory");
}

DI_ void gate_proj(Frame& F, const bf16* WG1T  ) {
    const int lane = F.lane, w = F.wave, r = lane & 15, g = lane >> 4, kw = w & 3, sw = w >> 2;
    LAS f32x4* red = (LAS f32x4*)F.lds;
    for (int p = F.vcu; 2 * p < MR / 16; p += F.G) {
        const int t = 2 * p + sw;
        f32x4 acc = (f32x4){0.f, 0.f, 0.f, 0.f};
        if (t < MR / 16) {
            const GAS v4u* wp = (const GAS v4u*)(WG1T + (size_t)r * D + 1024 * kw + 16 * g);
            const GAS v4u* hp = (const GAS v4u*)(F.H1B + (size_t)(16 * t + r) * D + 1024 * kw + 16 * g);
            for (int kk = 0; kk < 1024; kk += 256) {
                v4u wv[8], hv[8];
#pragma unroll
                for (int u = 0; u < 4; ++u) { wv[2 * u] = wp[(kk + 64 * u) / 8]; wv[2 * u + 1] = wp[(kk + 64 * u) / 8 + 1]; hv[2 * u] = hp[(kk + 64 * u) / 8]; hv[2 * u + 1] = hp[(kk + 64 * u) / 8 + 1]; }
                asm volatile("" ::: "memory");
#pragma unroll
                for (int u = 0; u < 8; ++u) acc = MFMA16(__builtin_bit_cast(bf16x8, wv[u]), __builtin_bit_cast(bf16x8, hv[u]), acc);
            }
        }
        red[w * 64 + lane] = acc;
        __syncthreads();
        if (kw == 0 && t < MR / 16) {
            acc += red[(w + 1) * 64 + lane]; acc += red[(w + 2) * 64 + lane]; acc += red[(w + 3) * 64 + lane];
            *(GAS f32x4*)(F.G1 + (size_t)(16 * t + r) * GL_R + 4 * g) = acc;
        }
        __syncthreads();
    }
    asm volatile("s_waitcnt vmcnt(0)" ::: "memory");
}

#ifndef USE_AUX
#define USE_AUX 0
#endif
struct AuxT { const float* src; bf16* dst; int N, K; };
DI_ AuxT aux_decode(Frame& F, int it, unsigned char* dummy) {
    constexpr int I_1 = (DI / 64) * (D / 32), I_2 = (D / 64) * (N1 / 32), I_3 = I_1, AUX_ITERS = (I_1 + I_2 + I_3) / (256 * NWAVES);
    static_assert((I_1 + I_2 + I_3) % (256 * NWAVES) == 0, "aux tiles divide over the waves");
    const int gw = F.vcu * NWAVES + F.wave;
    AuxT t;
    if (it >= AUX_ITERS || F.G != 256) { t.src = (const float*)(dummy + (size_t)gw * 8192); t.dst = (bf16*)(dummy + 32 * MiB + (size_t)gw * 8192); t.N = 32; t.K = 64; return t; }
    int r_ = it * (256 * NWAVES) + gw; const float* W; bf16* WT; int K, N;
    if (r_ < I_1) { W = F.w0out; WT = F.WT0OUT; K = DI; N = D; }
    else if (r_ < I_1 + I_2) { r_ -= I_1; W = F.w1in; WT = F.WT1IN; K = D; N = N1; }
    else { r_ -= I_1 + I_2; W = F.w1out; WT = F.WT1OUT; K = DI; N = D; }
    const int nblk = N / 32, kb = r_ / nblk, nb = r_ - kb * nblk;
    t.src = W + (size_t)(64 * kb) * N + 32 * nb; t.dst = WT + (size_t)(32 * nb) * K + 64 * kb; t.N = N; t.K = K; return t;
}
DI_ void aux_load(Frame& F, const AuxT& t, f32x4 (&wv)[8]) {
    const int rowi = F.lane >> 3, c4 = F.lane & 7;
#pragma unroll
    for (int i = 0; i < 8; ++i) wv[i] = *(const GAS f32x4*)(t.src + (size_t)(8 * i + rowi) * t.N + 4 * c4);
}
DI_ void aux_store(Frame& F, const AuxT& t, const f32x4 (&wv)[8], LAS unsigned char* scr  ) {
    const int lane = F.lane, rowi = lane >> 3, c4 = lane & 7;
#pragma unroll
    for (int i = 0; i < 8; ++i) { LAS unsigned* p = (LAS unsigned*)(scr + (8 * i + rowi) * 68 + c4 * 8); p[0] = cvtpk(wv[i].x, wv[i].y); p[1] = cvtpk(wv[i].z, wv[i].w); }
    LDS_WAIT(); asm volatile("" ::: "memory");
    const int kc = lane & 7;
#pragma unroll
    for (int j = 0; j < 4; ++j) { const int n = (lane >> 3) + 8 * j; unsigned short hv[8];
#pragma unroll
        for (int e = 0; e < 8; ++e) hv[e] = *(const LAS unsigned short*)(scr + (8 * kc + e) * 68 + n * 2);
        v4u o; o.x = hv[0] | ((unsigned)hv[1] << 16); o.y = hv[2] | ((unsigned)hv[3] << 16); o.z = hv[4] | ((unsigned)hv[5] << 16); o.w = hv[6] | ((unsigned)hv[7] << 16);
        *(GAS v4u*)(t.dst + (size_t)n * t.K + 8 * kc) = o; }
    LDS_WAIT(); asm volatile("" ::: "memory");
}

constexpr int F0_QD = 0, F0_KI = 8192, F0_T = 16384, F0_GL = 24576, F0_TV = 25088, F0_STG = 33536;
DI_ void f0_load(const bf16* cb, const int (&oq)[2], int ov, v2u (&q2)[2], v2u (&f2)[2], v4u& vraw) {
#pragma unroll
    for (int ti = 0; ti < 2; ++ti) { q2[ti] = *(const GAS v2u*)(cb + oq[ti]); f2[ti] = *(const GAS v2u*)(cb + oq[ti] + DI); }
    vraw = *(const GAS v4u*)(cb + ov);
}
DI_ void f0_prep(Frame& F, LAS unsigned char* st, const v2u (&q2)[2], const v2u (&f2)[2], const v4u& vraw, const f32x4& lb4, const f32x4& bf4) {
    const int lane = F.lane, w = F.wave, r = lane & 15, g = lane >> 4, ps = w >> 1, hf = w & 1;
    const float lbv[4] = {lb4.x, lb4.y, lb4.z, lb4.w}, bfv[4] = {bf4.x, bf4.y, bf4.z, bf4.w};
    float Lv[2][4], qq[2][4], kk[2][4];
#pragma unroll
    for (int ti = 0; ti < 2; ++ti) {
        const float qv[4] = {bflo(q2[ti].x), bfhi(q2[ti].x), bflo(q2[ti].y), bfhi(q2[ti].y)}, fv[4] = {bflo(f2[ti].x), bfhi(f2[ti].x), bflo(f2[ti].y), bfhi(f2[ti].y)};
#pragma unroll
        for (int x = 0; x < 4; ++x) { const float fg = lbv[x] + (1.f - lbv[x]) * sigm(fv[x] + bfv[x]);
            Lv[ti][x] = lg2(fg); kk[ti][x] = 1.f - fg; qq[ti][x] = silu(qv[x]); }
    }
    float qd[2][4], ki[2][4], kd[2][4], gl[4];
#pragma unroll
    for (int x = 0; x < 4; ++x) {
        const float b0 = scan16(Lv[0][x]);
        const float b1 = scan16(Lv[1][x]) + bcast15(b0);
        const float BB = bcast15(b1);
        gl[x] = ex2(BB);
        qd[0][x] = qq[0][x] * ex2(b0); ki[0][x] = kk[0][x] * ex2(-b0); kd[0][x] = ki[0][x] * gl[x];
        qd[1][x] = qq[1][x] * ex2(b1); ki[1][x] = kk[1][x] * ex2(-b1); kd[1][x] = ki[1][x] * gl[x];
    }
    const int lp = (2 * (g & 1) + hf) * 16 + r;
#pragma unroll
    for (int ti = 0; ti < 2; ++ti) {
        *(LAS v2u*)(st + F0_QD + ((ti * 4 + ps) * 64 + lp) * 16 + (g >> 1) * 8) = (v2u){cvtpk(qd[ti][0], qd[ti][1]), cvtpk(qd[ti][2], qd[ti][3])};
        *(LAS v2u*)(st + F0_KI + ((ti * 4 + ps) * 64 + lp) * 16 + (g >> 1) * 8) = (v2u){cvtpk(ki[ti][0], ki[ti][1]), cvtpk(ki[ti][2], ki[ti][3])};
        const unsigned k01 = cvtpk(kd[ti][0], kd[ti][1]), k23 = cvtpk(kd[ti][2], kd[ti][3]);
        LAS unsigned char* tp = st + F0_T + (32 * ps + 8 * g + 4 * hf) * 64 + (16 * ti + r) * 2;
        *(LAS unsigned short*)(tp) = (unsigned short)(k01 & 0xffffu); *(LAS unsigned short*)(tp + 64) = (unsigned short)(k01 >> 16);
        *(LAS unsigned short*)(tp + 128) = (unsigned short)(k23 & 0xffffu); *(LAS unsigned short*)(tp + 192) = (unsigned short)(k23 >> 16);
    }
    if (r == 0) *(LAS f32x4*)(st + F0_GL + (32 * ps + 8 * g + 4 * hf) * 4) = (f32x4){gl[0], gl[1], gl[2], gl[3]};
    { const int tk = 4 * w + (lane >> 4), c16 = lane & 15;
      *(LAS v2u*)(st + F0_TV + tk * 264 + c16 * 16) = (v2u){vraw.x, vraw.y}; *(LAS v2u*)(st + F0_TV + tk * 264 + c16 * 16 + 8) = (v2u){vraw.z, vraw.w}; }
}
DI_ void l0_fused(Frame& F, unsigned char* dummy) {
    const int lane = F.lane, w = F.wave, r = lane & 15, g = lane >> 4, ps = w >> 1, hf = w & 1;
    LAS float* obuf = (LAS float*)(F.lds + 2 * F0_STG);
    constexpr int OB = 32 * 132;
    for (int u = F.vcu; u < NB * HG_H; u += F.G) {
        const int bh = u, b = bh >> 6, h = bh & 63;
        f32x4 acc[8];
#pragma unroll
        for (int m = 0; m < 8; ++m) acc[m] = (f32x4){0.f, 0.f, 0.f, 0.f};
        const int ntok = 4 * w + g, ndv = 8 * r;
        float ngv[8];
        { const f32x4 a0 = *(const GAS f32x4*)(F.ng0 + h * 128 + ndv), a1 = *(const GAS f32x4*)(F.ng0 + h * 128 + ndv + 4);
          ngv[0] = a0.x; ngv[1] = a0.y; ngv[2] = a0.z; ngv[3] = a0.w; ngv[4] = a1.x; ngv[5] = a1.y; ngv[6] = a1.z; ngv[7] = a1.w; }
        const int colp = h * 128 + 32 * ps + 8 * g + 4 * hf;
        const f32x4 lb4 = *(const GAS f32x4*)(F.LB0 + colp), bf4 = *(const GAS f32x4*)(F.b_f + colp);
        v2u q2s[2][2], f2s[2][2]; v4u vrs[2];
        const int oq[2] = {r * N0 + colp, (16 + r) * N0 + colp};
        const int ov = (4 * w + (lane >> 4)) * N0 + 2 * DI + h * 128 + 8 * (lane & 15), oz = ntok * N0 + 3 * DI + h * 128 + ndv, oy = ntok * DI + h * 128 + ndv;
        const bf16* xq = F.QFIZ + (size_t)(b * SEQ - 32) * N0;
        bf16* xy = F.Y + (size_t)(b * SEQ - 32) * DI;
        bf16* y0 = (b == 0) ? F.Y0 : F.Y0 + (size_t)32 * DI;
#define QCH(c_) (((c_) == 0) ? (const bf16*)F.Q0 : xq + (size_t)(c_) * 32 * N0)
        f0_load(QCH(0), oq, ov, q2s[0], f2s[0], vrs[0]);
        f0_prep(F, F.lds, q2s[0], f2s[0], vrs[0], lb4, bf4);
        f0_load(QCH(1), oq, ov, q2s[1], f2s[1], vrs[1]);
        LAS unsigned char* ascr = F.lds + 2 * F0_STG + 33792 + w * 4352;
        f32x4 awv[8];
        v4u zs[2]; zs[0] = (v4u){0u, 0u, 0u, 0u}; zs[1] = zs[0];
#define F0_BODY(C_, PAR) do { const int c = (C_); \
            asm volatile("s_waitcnt lgkmcnt(0)" ::: "memory"); \
            __builtin_amdgcn_s_barrier(); \
            asm volatile("" ::: "memory"); \
            f0_load(QCH((c + 2 < NCH) ? c + 2 : NCH - 1), oq, ov, q2s[PAR], f2s[PAR], vrs[PAR]); \
            AuxT at_; if (USE_AUX) { at_ = aux_decode(F, c, dummy); aux_load(F, at_, awv); } \
            { const int cz = (c < NCH) ? c : NCH - 1; zs[PAR] = *(const GAS v4u*)(QCH(cz) + oz); } \
            { \
                const int cp = c - 1; \
                const LAS float* ob = obuf + (cp & 1) * OB + ntok * 132 + ndv; \
                const f32x4 x0 = *(const LAS f32x4*)(ob), x1 = *(const LAS f32x4*)(ob + 4); \
                float ss = (x0.x * x0.x + x0.y * x0.y) + (x0.z * x0.z + x0.w * x0.w) + (x1.x * x1.x + x1.y * x1.y) + (x1.z * x1.z + x1.w * x1.w); \
                ss = bcast15(scan16(ss)); \
                const float rs = rsqrtf(ss * (1.f / 128.f) + RMS_EPS); \
                bf16* yb = (cp <= 0) ? ((cp == 0) ? y0 : F.Y0 + (size_t)32 * DI) : xy + (size_t)cp * 32 * DI; \
                { \
                    v4u d; \
                    d.x = cvtpk(x0.x * rs * ngv[0] * silu(bflo(zs[PAR ^ 1].x)), x0.y * rs * ngv[1] * silu(bfhi(zs[PAR ^ 1].x))); \
                    d.y = cvtpk(x0.z * rs * ngv[2] * silu(bflo(zs[PAR ^ 1].y)), x0.w * rs * ngv[3] * silu(bfhi(zs[PAR ^ 1].y))); \
                    d.z = cvtpk(x1.x * rs * ngv[4] * silu(bflo(zs[PAR ^ 1].z)), x1.y * rs * ngv[5] * silu(bfhi(zs[PAR ^ 1].z))); \
                    d.w = cvtpk(x1.z * rs * ngv[6] * silu(bflo(zs[PAR ^ 1].w)), x1.w * rs * ngv[7] * silu(bfhi(zs[PAR ^ 1].w))); \
                    *(GAS v4u*)(yb + oy) = d; \
                } \
            } \
             \
            { \
                const LAS unsigned char* st = F.lds + (c & 1) * F0_STG; \
 \
                unsigned short hv[8]; \
                _Pragma("unroll") \
                for (int e = 0; e < 8; ++e) hv[e] = *(const LAS unsigned short*)(st + F0_TV + (16 * (e >> 2) + 4 * g + (e & 3)) * 264 + (16 * w + r) * 2); \
                const bf16x8 vf = mk8(hv[0] | ((unsigned)hv[1] << 16), hv[2] | ((unsigned)hv[3] << 16), hv[4] | ((unsigned)hv[5] << 16), hv[6] | ((unsigned)hv[7] << 16)); \
                bf16x8 qf[8], kf[8]; \
                _Pragma("unroll") \
                for (int q = 0; q < 8; ++q) { qf[q] = *(const LAS bf16x8*)(st + F0_QD + q * 1024 + lane * 16); kf[q] = *(const LAS bf16x8*)(st + F0_KI + q * 1024 + lane * 16); } \
                SCHED_FENCE(); \
 \
                f32x4 pt00 = (f32x4){0.f, 0.f, 0.f, 0.f}, pt01 = pt00, pt11 = pt00; \
                _Pragma("unroll") \
                for (int s2 = 0; s2 < 4; ++s2) { pt00 = MFMA16(kf[s2], qf[s2], pt00); pt01 = MFMA16(kf[s2], qf[4 + s2], pt01); pt11 = MFMA16(kf[4 + s2], qf[4 + s2], pt11); } \
                const bool m0 = (4 * g + 0 <= r), m1 = (4 * g + 1 <= r), m2 = (4 * g + 2 <= r), m3 = (4 * g + 3 <= r); \
 \
                                const bf16x8 pb0 = mk8(cvtpk(m0 ? pt00.x : 0.f, m1 ? pt00.y : 0.f), cvtpk(m2 ? pt00.z : 0.f, m3 ? pt00.w : 0.f), 0u, 0u); \
                const bf16x8 pb1 = mk8(pk2(pt01.x, pt01.y), pk2(pt01.z, pt01.w), cvtpk(m0 ? pt11.x : 0.f, m1 ? pt11.y : 0.f), cvtpk(m2 ? pt11.z : 0.f, m3 ? pt11.w : 0.f)); \
                f32x4 o0 = (f32x4){0.f, 0.f, 0.f, 0.f}, o1 = o0; \
                o0 = MFMA16(vf, pb0, o0); o1 = MFMA16(vf, pb1, o1); \
                _Pragma("unroll") \
                for (int s2 = 0; s2 < 4; ++s2) { \
                    const bf16x8 sb = mk8(cvtpk(acc[2 * s2].x, acc[2 * s2].y), cvtpk(acc[2 * s2].z, acc[2 * s2].w), cvtpk(acc[2 * s2 + 1].x, acc[2 * s2 + 1].y), cvtpk(acc[2 * s2 + 1].z, acc[2 * s2 + 1].w)); \
                    o0 = MFMA16(sb, qf[s2], o0); o1 = MFMA16(sb, qf[4 + s2], o1); \
                } \
                LAS float* ow = obuf + (c & 1) * OB + r * 132 + 16 * w + 4 * g; \
                *(LAS f32x4*)ow = o0; *(LAS f32x4*)(ow + 16 * 132) = o1; \
                f32x4 gf[8]; v2u klo[8], khi[8]; \
                _Pragma("unroll") \
                for (int m = 0; m < 8; ++m) { gf[m] = *(const LAS f32x4*)(st + F0_GL + (16 * m + 4 * g) * 4); \
                    klo[m] = *(const LAS v2u*)(st + F0_T + (16 * m + r) * 64 + 8 * g); khi[m] = *(const LAS v2u*)(st + F0_T + (16 * m + r) * 64 + 32 + 8 * g); } \
                SCHED_FENCE(); \
                _Pragma("unroll") \
                for (int m = 0; m < 8; ++m) acc[m] = MFMA16(mk8(klo[m].x, klo[m].y, khi[m].x, khi[m].y), vf, acc[m] * gf[m]); \
                SCHED_FENCE(); \
            } \
            f0_prep(F, F.lds + ((c + 1) & 1) * F0_STG, q2s[PAR ^ 1], f2s[PAR ^ 1], vrs[PAR ^ 1], lb4, bf4); \
            if (USE_AUX) aux_store(F, at_, awv, ascr); \
        } while (0)
        for (int c2 = 0; c2 <= NCH; c2 += 2) { F0_BODY(c2, 0); F0_BODY(c2 + 1, 1); }
#undef F0_BODY
#undef QCH
        asm volatile("s_waitcnt vmcnt(0) lgkmcnt(0)" ::: "memory");
        __builtin_amdgcn_s_barrier();
    }
}

struct Args { const float* in[17]; float* out; unsigned char* ws; int ph_lo, ph_hi, li, pad; };
__global__ void __launch_bounds__(NWAVES * 64, 2) mk_fwd(Args args) {
    extern __shared__ __attribute__((aligned(16))) unsigned char lds[];
    Frame F;
    F.lds = (LAS unsigned char*)lds;
    F.MISC = (volatile LAS unsigned*)(F.lds + MISC_OFF);
    F.tid = threadIdx.x; F.lane = F.tid & 63; F.wave = __builtin_amdgcn_readfirstlane(F.tid >> 6);
    F.G = gridDim.x; { const int bx = blockIdx.x; F.vcu = (F.G % 8 == 0) ? (bx % 8) * (F.G / 8) + bx / 8 : bx; }
    unsigned char* ws = args.ws;
    F.ctl = (gu32*)(ws + WS_CTL);
    F.x = args.in[0]; F.meta = args.in[1]; F.lb_logits = args.in[2];
    F.w0in = args.in[3]; F.b_f = args.in[4]; F.ng0 = args.in[5]; F.w0out = args.in[6]; F.ln0g = args.in[7]; F.ln0b = args.in[8];
    F.w1in = args.in[9]; F.wg1 = args.in[10]; F.wg2 = args.in[11]; F.b_g = args.in[12]; F.ng1 = args.in[13]; F.w1out = args.in[14]; F.ln1g = args.in[15]; F.ln1b = args.in[16];
    F.out = args.out;
    F.LB0 = (float*)(ws + WS_LB0); F.G1 = (float*)(ws + WS_G1); F.PRE = (float*)(ws + WS_PRE); F.O1 = (float*)(ws + WS_O1); F.WG1T = (bf16*)(ws + WS_WG1T); F.W2F = (bf16*)(ws + WS_W2F); F.SS = (float*)(ws + WS_REC + 525 * MiB); F.Q0 = (bf16*)(ws + WS_Q0); F.Y0 = (bf16*)(ws + WS_Y0); F.REC0 = ws + WS_REC; F.REC1 = ws + WS_REC1; F.VF1 = ws + WS_VF1;
    F.WT0IN = (bf16*)(ws + WS_WT0IN); F.WT0OUT = (bf16*)(ws + WS_WT0OUT); F.WT1IN = (bf16*)(ws + WS_WT1IN); F.WT1OUT = (bf16*)(ws + WS_WT1OUT);
    F.XB = (bf16*)(ws + WS_XB); F.H1B = (bf16*)(ws + WS_H1B); F.QFIZ = (bf16*)(ws + WS_QFIZ); F.Y = (bf16*)(ws + WS_Y);
    for (int u = F.tid; u < (LDS_BYTES - LDSCTL_OFF) / 4; u += NWAVES * 64) ((LAS unsigned*)(F.lds + LDSCTL_OFF))[u] = 0u;
    __syncthreads();
    int vb = (int)blockIdx.x;
    if (USE_TICKETS && N_LAUNCHES == 1 && (F.G % 8) == 0) {
        if (F.tid == 0) {
            const unsigned per = (unsigned)F.G / 8u; unsigned x = xb_xcc_id() & 7u, got = 0xffffffffu;
            for (unsigned tr = 0; tr < 8u; ++tr) { const unsigned y = (x + tr) & 7u; const unsigned t = xb_add((unsigned*)(F.ctl + CW_POOL) + 64 * y, 1u); if (t < per) { got = y + 8u * t; break; } }
            F.MISC[12] = (got == 0xffffffffu) ? blockIdx.x : got;
        }
        __syncthreads();
        vb = (int)F.MISC[12];
    }
    { F.vcu = (F.G % 8 == 0) ? (vb % 8) * (F.G / 8) + vb / 8 : vb; }
    XcdBarrier bar; bar.bar = (unsigned*)(F.ctl + CW_BAR); bar.x = 0; bar.st = nullptr;
    if (N_LAUNCHES == 1) bar = xcd_barrier_post((unsigned*)(F.ctl + CW_BAR), F.MISC + 8);
#define GRID_BAR() do { if (N_LAUNCHES == 1) xcd_barrier(bar); } while (0)
    const int lo = args.ph_lo, hi = args.ph_hi;
    unsigned long long pclk0 = 0, pclkn = 0; (void)pclk0;
    unsigned long long st_prev = STAMP_MASK ? __builtin_amdgcn_s_memrealtime() : 0ull, st_acc = 0ull;
#define STAMP(k) do { if (STAMP_MASK) { const unsigned long long t_ = __builtin_amdgcn_s_memrealtime(); if ((STAMP_MASK >> (k)) & 1) st_acc += t_ - st_prev; st_prev = t_; } } while (0)
#ifdef ONLY_PHASE
#define IN(k) ((k) == ONLY_PHASE && lo <= (k) && (k) < hi)
#else
#define IN(k) (lo <= (k) && (k) < hi)
#endif
#define BOTH(k) (IN(k) && IN((k) + 1))

    if (IN(0)) { for (int rep = 0; rep < REP(0); ++rep) { p0_prologue(F); if (rep + 1 < REP(0)) GRID_BAR(); } if (BOTH(0)) GRID_BAR(); }
    STAMP(0);
    if (IN(1)) {
        skinny<1, 0>(F, F.XB + (size_t)MX * D, F.WT0IN, D, 0, N0 / 16, (USE_L0_MFMA == 2) ? F.Q0 + (size_t)16 * N0 : F.QFIZ + (size_t)MX * N0, N0, nullptr, nullptr);
        pg8::Gemm g{F.XB, F.WT0IN, MX, N0, D}; pg8::StaticOrder S; S.init(MX, N0, F.G, vb);
        pg8::EpiBf16<0> E{F.QFIZ, N0, nullptr, 0, 0, 1.f};
        if (PROBE_CLK == 1) pclk0 = __builtin_amdgcn_s_memtime();
        for (int rep = 0; rep < REP(1); ++rep) { pg8::gemm_phase<pg8::EpiBf16<0>, pg8::StaticOrder, PG8_ALIGN, PG8_SP2>(F.lds + RING_OFF, g, S, E); if (rep + 1 < REP(1)) GRID_BAR(); }
        if (PROBE_CLK == 1) pclkn = __builtin_amdgcn_s_memtime() - pclk0;
        if (BOTH(1)) GRID_BAR();
    }
    STAMP(1);
#if USE_L0_MFMA == 2
    STAMP(2);
    if (IN(3)) { for (int rep = 0; rep < REP(3); ++rep) { l0_fused(F, F.REC0); if (rep + 1 < REP(3)) GRID_BAR(); } if (BOTH(3)) GRID_BAR(); }
#elif USE_L0_MFMA
    if (IN(2)) { for (int rep = 0; rep < REP(2); ++rep) { l0_prep(F, F.REC0); if (rep + 1 < REP(2)) GRID_BAR(); } if (BOTH(2)) GRID_BAR(); }
    STAMP(2);
    if (IN(3)) { for (int rep = 0; rep < REP(3); ++rep) { l0_seq(F, F.REC0); if (rep + 1 < REP(3)) GRID_BAR(); } if (BOTH(3)) GRID_BAR(); }
#else
    if (IN(2)) { if (BOTH(2)) GRID_BAR(); }
    if (IN(3)) { for (int rep = 0; rep < REP(3); ++rep) { p2_l0_rec_naive(F); if (rep + 1 < REP(3)) GRID_BAR(); } if (BOTH(3)) GRID_BAR(); }
#endif
    STAMP(3);
    if (IN(4)) {
        skinny<4, 1>(F, (USE_L0_MFMA == 2) ? F.Y0 + (size_t)16 * DI : F.Y + (size_t)MX * DI, F.WT0OUT, DI, 0, D / 16, nullptr, 0, F.PRE + (size_t)MX * D, F.meta);
        pg8::Gemm g{F.Y, F.WT0OUT, MX, D, DI}; pg8::StaticOrder S; S.init(MX, D, F.G, vb);
        pg8::EpiResid E{F.PRE, D, F.x, F.meta, MX, MX, ALPHA};
        for (int rep = 0; rep < REP(4); ++rep) { pg8::gemm_phase<pg8::EpiResid, pg8::StaticOrder, PG8_ALIGN, PG8_SP2>(F.lds + RING_OFF, g, S, E); if (rep + 1 < REP(4)) GRID_BAR(); }
        if (BOTH(4)) GRID_BAR();
    }
    STAMP(4);
    if (IN(5)) { for (int rep = 0; rep < REP(5); ++rep) { ln_phase(F, F.PRE, MR, F.ln0g, F.ln0b, F.PRE, F.H1B, nullptr); if (rep + 1 < REP(5)) GRID_BAR(); } if (BOTH(5)) GRID_BAR(); }
    STAMP(5);
    if (IN(6)) {
        gate_proj(F, F.WG1T);
        skinny<2, 0>(F, F.H1B + (size_t)MX * D, F.WT1IN, D, 4096, (N1 - 4096 - DI) / 16, F.QFIZ + (size_t)MX * N1, N1, nullptr, nullptr);
        pg8::Gemm g{F.H1B, F.WT1IN, MX, N1, D}; pg8::StaticOrder S; S.init(MX, N1, F.G, vb);
        pg8::EpiBf16<0> E{F.QFIZ, N1, nullptr, 0, 0, 1.f};
        for (int rep = 0; rep < REP(6); ++rep) { pg8::gemm_phase<pg8::EpiBf16<0>, pg8::StaticOrder, PG8_ALIGN, PG8_SP2>(F.lds + RING_OFF, g, S, E); if (rep + 1 < REP(6)) GRID_BAR(); }
        if (BOTH(6)) GRID_BAR();
    }
    STAMP(6);
#if USE_L1_MFMA
    if (IN(7)) { for (int rep = 0; rep < REP(7); ++rep) { l1_prep(F, F.REC1, F.VF1, F.W2F); if (rep + 1 < REP(7)) GRID_BAR(); } if (BOTH(7)) GRID_BAR(); }
    STAMP(7);
#if USE_L1_SEQ2
    if (IN(8)) { l1_seq2(F, F.REC1); if (BOTH(8)) GRID_BAR(); }
#else
    if (IN(8)) { l1_seq<0>(F, F.REC1, F.VF1, F.O1, F.SS); if (REP(8) > 1) { GRID_BAR(); l1_seq<PROBE_VAR>(F, F.REC1, F.VF1, F.O1, F.SS); } if (BOTH(8)) GRID_BAR(); }
#endif
#else
    if (IN(7)) { if (BOTH(7)) GRID_BAR(); }
    if (IN(8)) { for (int rep = 0; rep < REP(8); ++rep) { p6_l1_rec_naive(F); if (rep + 1 < REP(8)) GRID_BAR(); } if (BOTH(8)) GRID_BAR(); }
#endif
    STAMP(8);
#if !(USE_FUSED_NORM && USE_L1_MFMA && !USE_L1_SEQ2)
    if (IN(9)) { for (int rep = 0; rep < REP(9); ++rep) { p7_normgate(F); if (rep + 1 < REP(9)) GRID_BAR(); } if (BOTH(9)) GRID_BAR(); }
#endif
    STAMP(9);
    if (IN(10)) {
        pg8::Gemm g{F.Y, F.WT1OUT, MX, D, DI}; pg8::StaticOrder S; S.init(MX, D, F.G, vb);
#if USE_FUSED_NORM && USE_L1_MFMA && !USE_L1_SEQ2
        pg8::EpiResidScale E{F.PRE, D, F.PRE, ALPHA, F.SS, RMS_EPS};
        for (int rep = 0; rep < REP(10); ++rep) { pg8::gemm_phase<pg8::EpiResidScale, pg8::StaticOrder, PG8_ALIGN, PG8_SP2>(F.lds + RING_OFF, g, S, E); if (rep + 1 < REP(10)) GRID_BAR(); }
#else
        pg8::EpiResid E{F.PRE, D, F.PRE, F.PRE, MX, MX, ALPHA};
        if (PROBE_CLK == 10) pclk0 = __builtin_amdgcn_s_memtime();
        for (int rep = 0; rep < REP(10); ++rep) { pg8::gemm_phase<pg8::EpiResid, pg8::StaticOrder, PG8_ALIGN, PG8_SP2>(F.lds + RING_OFF, g, S, E); if (rep + 1 < REP(10)) GRID_BAR(); }
        if (PROBE_CLK == 10) pclkn = __builtin_amdgcn_s_memtime() - pclk0;
#endif
        if (BOTH(10)) GRID_BAR();
    }
    STAMP(10);
    if (IN(11)) { for (int rep = 0; rep < REP(11); ++rep) { ln_phase(F, F.PRE, MX, F.ln1g, F.ln1b, F.out, nullptr, nullptr); if (rep + 1 < REP(11)) GRID_BAR(); } }
    STAMP(11);
    if (STAMP_MASK && blockIdx.x == 0 && F.tid == 0) { const unsigned long long t0 = __builtin_amdgcn_s_memrealtime(); while (__builtin_amdgcn_s_memrealtime() - t0 < st_acc) __builtin_amdgcn_s_sleep(8); }
    if (PROBE_CLK && blockIdx.x == 0 && F.tid == 0) { const unsigned long long t0 = __builtin_amdgcn_s_memrealtime(); while (__builtin_amdgcn_s_memrealtime() - t0 < pclkn / (PROBE_CLK == 10 ? 10ull : 100ull)) __builtin_amdgcn_s_sleep(8); }
#undef IN
#undef BOTH
}

extern "C" void kernel_launch(void* const* d_in, const int* in_sizes, int n_in, void* d_out, int out_size, void* d_ws, size_t ws_size, hipStream_t stream) {
    static int grid = 0;
    if (grid == 0) {
        if (n_in != 17 || in_sizes[0] != MX * D || out_size != MX * D || ws_size < WS_END) { fprintf(stderr, "kernel_launch: unexpected problem (n_in %d, in0 %d, out %d, ws %zu < %zu); nothing launched\n", n_in, n_in > 0 ? in_sizes[0] : -1, out_size, ws_size, (size_t)WS_END); grid = -1; return; }
        int dev = 0, cus = 0, per_cu = 0;
        if (hipGetDevice(&dev) != hipSuccess || hipDeviceGetAttribute(&cus, hipDeviceAttributeMultiprocessorCount, dev) != hipSuccess) { fprintf(stderr, "kernel_launch: device query failed\n"); grid = -1; return; }
        if (hipFuncSetAttribute((const void*)mk_fwd, hipFuncAttributeMaxDynamicSharedMemorySize, LDS_BYTES) != hipSuccess) { fprintf(stderr, "kernel_launch: hipFuncSetAttribute failed\n"); grid = -1; return; }
        if (hipOccupancyMaxActiveBlocksPerMultiprocessor(&per_cu, (const void*)mk_fwd, NWAVES * 64, LDS_BYTES) != hipSuccess || per_cu < 1)
            fprintf(stderr, "kernel_launch: note: occupancy query reports %d workgroups per CU\n", per_cu);
        (void)hipGetLastError();
        grid = cus;
    }
    if (grid < 0) return;
    if (hipMemsetAsync((char*)d_ws + WS_CTL, 0, CTL_ZERO_BYTES, stream) != hipSuccess) { fprintf(stderr, "kernel_launch: memset failed\n"); return; }
    Args a{};
    for (int i = 0; i < 17; ++i) a.in[i] = (const float*)d_in[i];
    a.out = (float*)d_out; a.ws = (unsigned char*)d_ws;
    for (int li = 0; li < N_LAUNCHES; ++li) {
        a.ph_lo = (N_LAUNCHES == 1) ? 0 : li; a.ph_hi = (N_LAUNCHES == 1) ? PER_PHASE : li + 1; a.li = li; a.pad = 0;
        hipLaunchKernelGGL(mk_fwd, dim3(grid), dim3(NWAVES * 64), LDS_BYTES, stream, a);
        const hipError_t le = hipPeekAtLastError();
        if (le != hipSuccess) { fprintf(stderr, "kernel_launch: launch %d failed: %s\n", li, hipGetErrorName(le)); break; }
    }
}
```

```cpp
#include <hip/hip_runtime.h>
#include <cstdio>
#include <cstdint>
#define MK_N_LAUNCHES 1
#define USE_L0_MFMA 2
#define USE_L1_MFMA 1
namespace pg8 {
#define PG8_LAS __attribute__((address_space(3)))
typedef unsigned short bf16_t;
typedef short bf16x8 __attribute__((ext_vector_type(8)));
typedef float f32x4 __attribute__((ext_vector_type(4)));
typedef unsigned u32x4 __attribute__((ext_vector_type(4)));
constexpr int BM = 256, BK = 64, HALF = 128, HTB = HALF * BK * 2  , STAGE_BYTES = 8 * HTB, NXCD = 8, WGM = 8;

__host__ __device__ __forceinline__ int lds_byte(int r, int c) { const int st = (r >> 4) * 2 + (c >> 5), rr = r & 15, cc = c & 31, ob = rr * 64 + cc * 2; return st * 1024 + (ob ^ (((ob >> 9) & 1) << 5)); }
__host__ __device__ __forceinline__ void stage_rc(int b, int& R, int& C) { const int st = b / 1024, sb = b % 1024, swz = sb ^ (((sb >> 9) & 1) << 5); R = (st >> 1) * 16 + swz / 64; C = (st & 1) * 32 + (swz % 64) / 2; }
__host__ __device__ __forceinline__ int perm32(int rho) { const int n = rho >> 4, i = rho & 15; return 8 * (i >> 2) + 4 * n + (i & 3); }

struct Unit { int pm, pn; };
struct Gemm { const bf16_t* A; const bf16_t* Bt; int M, N, K; };

struct StaticOrder {
    int nM, nN, nwg, G, c;
    __host__ __device__ void init(int M, int N, int G_, int c_) { nM = M / BM; nN = N / BM; nwg = nM * nN; G = G_; c = c_; }
    __host__ __device__ bool next(int i, Unit& u) const {
        const long L = (long)i * G + c; if (L >= nwg) return false;
        int wgid = (int)L; { const int q = nwg / NXCD, r = nwg % NXCD, xcd = wgid % NXCD, off = wgid / NXCD; wgid = (xcd < r ? xcd * (q + 1) : r * (q + 1) + (xcd - r) * q) + off; }
        const int nig = WGM * nN, gid = wgid / nig, fm = gid * WGM, gsz = (nM - fm) < WGM ? (nM - fm) : WGM;
        u.pm = fm + ((wgid % nig) % gsz); u.pn = (wgid % nig) / gsz; return true;
    }
    __device__ __forceinline__ void a_ready(const Unit&) const {}
    __device__ __forceinline__ void done(const Unit&) const {}
};

__device__ __forceinline__ unsigned cvt_pk_bf16(float lo, float hi) { unsigned r; asm volatile("v_cvt_pk_bf16_f32 %0, %1, %2" : "=v"(r) : "v"(lo), "v"(hi)); return r; }
typedef float f32x2 __attribute__((ext_vector_type(2)));
__device__ __forceinline__ f32x2 gelu_pk(f32x2 v) {
    const f32x2 av = __builtin_elementwise_abs(v), d = av * 0.2316418882f + 1.0f;
    f32x2 t; t.x = __builtin_amdgcn_rcpf(d.x); t.y = __builtin_amdgcn_rcpf(d.y);
    f32x2 q = t * 0.5307027145f + (-0.7265760135f); q = q * t + 0.7107068705f; q = q * t + (-0.142248368f); q = q * t + 0.127414796f; q = q * t;
    const f32x2 s = (v * v) * (-0.72134752044f);
    f32x2 e; e.x = __builtin_amdgcn_exp2f(s.x); e.y = __builtin_amdgcn_exp2f(s.y);
    const f32x2 m = v * (q * e), r = v - m;
    f32x2 o; o.x = v.x < 0.f ? m.x : r.x; o.y = v.y < 0.f ? m.y : r.y; return o;
}

template <int ACT  > struct EpiBf16 {
    static constexpr bool PERM = true, AFTER_DRAIN = false, KHOOK = false; static_assert(ACT == 0 || ACT == 1, "EpiBf16: ACT is 0 (none) or 1 (gelu_pk)");
    bf16_t* O; int ldc; const float* bias; int split_cols; size_t split_stride; float scale0;
    __device__ __forceinline__ void operator()(const f32x4 (&acc)[2][2][4][2], const Unit& u, int wr, int wc, int fr, int fq) const {
        const int row0 = u.pm * BM + wr * 64 + fr; int colt = u.pn * BM; bf16_t* base = O;
        float sc = 1.f; if (split_cols) { const int t = colt / split_cols; base += (size_t)t * split_stride; colt -= t * split_cols; if (t == 0) sc = scale0; }
        const int col0 = colt + wc * 32 + 8 * fq, bcol0 = u.pn * BM + wc * 32 + 8 * fq;
        f32x4 bv[2][2];
#pragma unroll
        for (int bj = 0; bj < 2; ++bj)
#pragma unroll
            for (int n = 0; n < 2; ++n) bv[bj][n] = bias ? *(const f32x4*)(bias + bcol0 + bj * HALF + 4 * n) : (f32x4){0.f, 0.f, 0.f, 0.f};
#pragma unroll
        for (int ai = 0; ai < 2; ++ai)
#pragma unroll
            for (int m = 0; m < 4; ++m) { bf16_t* rowp = base + (size_t)(row0 + ai * HALF + m * 16) * ldc + col0;
#pragma unroll
                for (int bj = 0; bj < 2; ++bj) { f32x4 v0 = acc[ai][bj][m][0] + bv[bj][0], v1 = acc[ai][bj][m][1] + bv[bj][1];
                    if (ACT == 1) { f32x2 a = gelu_pk((f32x2){v0[0], v0[1]}), b = gelu_pk((f32x2){v0[2], v0[3]}), c = gelu_pk((f32x2){v1[0], v1[1]}), d = gelu_pk((f32x2){v1[2], v1[3]});
                        v0 = (f32x4){a.x, a.y, b.x, b.y}; v1 = (f32x4){c.x, c.y, d.x, d.y}; }
                    v0 = v0 * sc; v1 = v1 * sc; u32x4 w; w.x = cvt_pk_bf16(v0[0], v0[1]); w.y = cvt_pk_bf16(v0[2], v0[3]); w.z = cvt_pk_bf16(v1[0], v1[1]); w.w = cvt_pk_bf16(v1[2], v1[3]);
                    *(u32x4*)(rowp + bj * HALF) = w; } }
    }
};
struct EpiResid {
    static constexpr bool PERM = false, AFTER_DRAIN = false, KHOOK = false;
    float* C; int ldc; const float* resA; const float* resB; int rowsA; int rowsValid; float alpha;
    __device__ __forceinline__ void operator()(const f32x4 (&acc)[2][2][4][2], const Unit& u, int wr, int wc, int fr, int fq) const {
        const int row0 = u.pm * BM + wr * 64 + fr, col0 = u.pn * BM + wc * 32 + 4 * fq;
#pragma unroll
        for (int ai = 0; ai < 2; ++ai)
#pragma unroll
            for (int m = 0; m < 4; ++m) { const int r = row0 + ai * HALF + m * 16;
                if (r < rowsValid) {
                    const float* rp = (r < rowsA) ? resA + (size_t)r * ldc + col0 : resB + (size_t)(r - rowsA) * ldc + col0;
                    float* cp = C + (size_t)r * ldc + col0;
#pragma unroll
                    for (int bj = 0; bj < 2; ++bj)
#pragma unroll
                        for (int n = 0; n < 2; ++n) { const f32x4 rv = *(const f32x4*)(rp + bj * HALF + n * 16); *(f32x4*)(cp + bj * HALF + n * 16) = rv * alpha + acc[ai][bj][m][n]; } }
                asm volatile("" ::: "memory"); }
    }
};

struct EpiResidScale {
    static constexpr bool PERM = false, AFTER_DRAIN = false, KHOOK = true;
    float* C; int ldc; const float* res; float alpha; const float* SS; float eps;
    __device__ __forceinline__ void unit_begin(const Unit& u, int par, PG8_LAS unsigned char* lds) const {
        const int tid = threadIdx.x, row = tid >> 1, hh = 4 * (tid & 1);
        float sv[4];
        { const f32x4* sp = (const f32x4*)(SS + ((size_t)(u.pm * BM + row) * 8 + hh) * 8);
#pragma unroll
          for (int q = 0; q < 4; ++q) { const f32x4 a = sp[2 * q], b = sp[2 * q + 1]; sv[q] = (a.x + a.y) + (a.z + a.w) + (b.x + b.y) + (b.z + b.w); asm volatile("" ::: "memory"); } }
        const f32x4 s = (f32x4){sv[0], sv[1], sv[2], sv[3]};
        f32x4 rs; rs.x = __builtin_amdgcn_rsqf(s.x * (1.f / 1024.f) + eps); rs.y = __builtin_amdgcn_rsqf(s.y * (1.f / 1024.f) + eps); rs.z = __builtin_amdgcn_rsqf(s.z * (1.f / 1024.f) + eps); rs.w = __builtin_amdgcn_rsqf(s.w * (1.f / 1024.f) + eps);
        *(PG8_LAS f32x4*)(lds + 131072 + par * 8192 + (row * 8 + hh) * 4) = rs;
    }
    __device__ __forceinline__ void khook(f32x4 (&acc)[2][2][4][2], int par, int hb, int wr, int fr, PG8_LAS unsigned char* lds) const {
        const PG8_LAS float* T = (const PG8_LAS float*)(lds + 131072 + par * 8192);
        asm volatile("s_nop 15\n\ts_nop 15" ::: "memory");
#pragma unroll
        for (int ai = 0; ai < 2; ++ai)
#pragma unroll
            for (int m = 0; m < 4; ++m) { const int row = ai * HALF + wr * 64 + m * 16 + fr;
                typedef float f32x2h __attribute__((ext_vector_type(2))); f32x2h tv;
                asm volatile("ds_read2_b32 %0, %1 offset1:1\n\ts_waitcnt lgkmcnt(0)" : "=&v"(tv) : "v"((unsigned)(size_t)(T + row * 8 + hb - 1)) : "memory");
                const float ratio = tv.x * __builtin_amdgcn_rcpf(tv.y);
#pragma unroll
                for (int bj = 0; bj < 2; ++bj)
#pragma unroll
                    for (int n = 0; n < 2; ++n) { f32x4& a = acc[ai][bj][m][n];
                        asm volatile("v_mul_f32 %0, %0, %4\n\tv_mul_f32 %1, %1, %4\n\tv_mul_f32 %2, %2, %4\n\tv_mul_f32 %3, %3, %4\n\ts_nop 1" : "+v"(a.x), "+v"(a.y), "+v"(a.z), "+v"(a.w) : "v"(ratio)); } }
    }
    __device__ __forceinline__ void epi(const f32x4 (&acc)[2][2][4][2], const Unit& u, int wr, int wc, int fr, int fq, int par, PG8_LAS unsigned char* lds) const {
        const PG8_LAS float* T = (const PG8_LAS float*)(lds + 131072 + par * 8192);
        const int row0 = u.pm * BM + wr * 64 + fr, col0 = u.pn * BM + wc * 32 + 4 * fq;
#pragma unroll
        for (int ai = 0; ai < 2; ++ai)
#pragma unroll
            for (int m = 0; m < 4; ++m) { const int r = row0 + ai * HALF + m * 16; const float sc = T[(ai * HALF + wr * 64 + m * 16 + fr) * 8 + 7];
                const float* rp = res + (size_t)r * ldc + col0; float* cp = C + (size_t)r * ldc + col0;
#pragma unroll
                for (int bj = 0; bj < 2; ++bj)
#pragma unroll
                    for (int n = 0; n < 2; ++n) { const f32x4 rv = *(const f32x4*)(rp + bj * HALF + n * 16); *(f32x4*)(cp + bj * HALF + n * 16) = rv * alpha + acc[ai][bj][m][n] * sc; }
                asm volatile("" ::: "memory"); }
    }
};


template <class Epi, class Sched, bool ALIGN_EPI = false, bool SP2 = false>
__device__ __forceinline__ void gemm_phase(PG8_LAS unsigned char* lds, const Gemm g, const Sched& S, const Epi& E) {
    const int tid = threadIdx.x, wid = __builtin_amdgcn_readfirstlane(tid >> 6), lane = tid & 63, wr = wid >> 2, wc = wid & 3, fr = lane & 15, fq = lane >> 4;
    const int K = g.K, nt = K / BK;
    unsigned voffA[2], voffB[2];
#pragma unroll
    for (int i = 0; i < 2; ++i) { int R, C; stage_rc(tid * 16 + i * 8192, R, C); const int Rb = Epi::PERM ? ((R & ~31) + perm32(R & 31)) : R;
        voffA[i] = (unsigned)(R * K + C) * 2u; voffB[i] = (unsigned)(Rb * K + C) * 2u; }
    const size_t kstep = (size_t)(BK * 2);
    const size_t hstep = (size_t)HALF * K * 2;
    const size_t tstep = 2 * hstep;
    const unsigned ldsw = (unsigned)wid * 1024u;
    const int aoff = lds_byte(wr * 64 + fr, fq * 8), boff = lds_byte(wc * 32 + fr, fq * 8);
#define PG8_SA(b, h) (((b) * 2 + (h)) * HTB)
#define PG8_SB(b, h) ((4 + (b) * 2 + (h)) * HTB)
#define PG8_STAGE(bufoff, gbase, voff) do { _Pragma("unroll") for (int _i = 0; _i < 2; ++_i) \
        __builtin_amdgcn_global_load_lds((const unsigned*)((const char*)(gbase) + (voff)[_i]), (PG8_LAS unsigned*)(lds + (bufoff) + ldsw + _i * 8192), 16, 0, 0); } while (0)
#define PG8_LDA(dst, b, h) do { _Pragma("unroll") for (int m = 0; m < 4; ++m) _Pragma("unroll") for (int k = 0; k < 2; ++k) dst[m][k] = *(const PG8_LAS bf16x8*)(lds + PG8_SA(b, h) + aoff + m * 2048 + k * 1024); } while (0)
#define PG8_LDB(dst, b, h) do { _Pragma("unroll") for (int n = 0; n < 2; ++n) _Pragma("unroll") for (int k = 0; k < 2; ++k) dst[n][k] = *(const PG8_LAS bf16x8*)(lds + PG8_SB(b, h) + boff + n * 2048 + k * 1024); } while (0)
#define PG8_MMA(ai, bj, At, Bt) do { __builtin_amdgcn_s_setprio(1); _Pragma("unroll") for (int m = 0; m < 4; ++m) _Pragma("unroll") for (int n = 0; n < 2; ++n) _Pragma("unroll") for (int k = 0; k < 2; ++k) \
        acc[ai][bj][m][n] = __builtin_amdgcn_mfma_f32_16x16x32_bf16(Bt[n][k], At[m][k], acc[ai][bj][m][n], 0, 0, 0); __builtin_amdgcn_s_setprio(0); } while (0)
#define PG8_WAIT_V(n) asm volatile("s_waitcnt vmcnt(" #n ")" ::: "memory")
#define PG8_WAIT_L(n) asm volatile("s_waitcnt lgkmcnt(" #n ")" ::: "memory")
#define PG8_BAR __builtin_amdgcn_s_barrier()
#define PG8_SCHED __builtin_amdgcn_sched_barrier(0)
    Unit cur, nxt; int ui = 0;
    if (!S.next(0, cur)) return;
    f32x4 acc[2][2][4][2];
#pragma unroll
    for (int a = 0; a < 2; ++a)
#pragma unroll
        for (int b = 0; b < 2; ++b)
#pragma unroll
            for (int m = 0; m < 4; ++m)
#pragma unroll
                for (int n = 0; n < 2; ++n) acc[a][b][m][n] = (f32x4){0.f, 0.f, 0.f, 0.f};
    bf16x8 At[4][2], B0[2][2], B1[2][2];
    const char* cA = (const char*)g.A + (size_t)cur.pm * tstep; const char* cB = (const char*)g.Bt + (size_t)cur.pn * tstep;
    if constexpr (Epi::KHOOK) E.unit_begin(cur, ui & 1, lds);
    S.a_ready(cur);
    if constexpr (SP2) {
        PG8_STAGE(PG8_SB(0, 0), cB, voffB); PG8_STAGE(PG8_SB(0, 1), cB + hstep, voffB); PG8_STAGE(PG8_SA(0, 0), cA, voffA); PG8_STAGE(PG8_SA(0, 1), cA + hstep, voffA);
        if (wr == 1) PG8_BAR;
        PG8_WAIT_V(2); PG8_BAR;
        PG8_STAGE(PG8_SB(1, 0), cB + kstep, voffB); PG8_STAGE(PG8_SA(1, 0), cA + kstep, voffA); PG8_STAGE(PG8_SB(1, 1), cB + hstep + kstep, voffB);
        PG8_WAIT_V(6); PG8_BAR;
    } else {
        PG8_STAGE(PG8_SB(0, 0), cB, voffB); PG8_STAGE(PG8_SA(0, 0), cA, voffA); PG8_STAGE(PG8_SB(0, 1), cB + hstep, voffB); PG8_STAGE(PG8_SA(0, 1), cA + hstep, voffA);
        if (wr == 1) PG8_BAR;
        PG8_WAIT_V(4); PG8_BAR;
        PG8_STAGE(PG8_SB(1, 0), cB + kstep, voffB); PG8_STAGE(PG8_SA(1, 0), cA + kstep, voffA); PG8_STAGE(PG8_SB(1, 1), cB + hstep + kstep, voffB);
        PG8_WAIT_V(6); PG8_BAR;
    }
    for (;;) {
        const bool has_next = S.next(ui + 1, nxt);
        const char* nA = has_next ? (const char*)g.A + (size_t)nxt.pm * tstep : cA; const char* nB = has_next ? (const char*)g.Bt + (size_t)nxt.pn * tstep : cB;
        const int tseg = Epi::KHOOK ? 16 : nt;
        for (int tb = 0; tb < nt; tb += tseg) {
        if constexpr (Epi::KHOOK) { if (tb != 0) { PG8_SCHED; E.khook(acc, ui & 1, tb >> 4, wr, fr, lds); PG8_SCHED; } }
        for (int t = tb; t < tb + tseg; t += 2) {
            const bool last = (t == nt - 2);
            const char* a1 = cA + (size_t)(t + 1) * kstep;
            const char* a2 = last ? nA : cA + (size_t)(t + 2) * kstep; const char* b2 = last ? nB : cB + (size_t)(t + 2) * kstep;
            const char* a3 = a2 + kstep; const char* b3 = b2 + kstep;
            if (last && has_next) S.a_ready(nxt);
            if constexpr (SP2) {
            PG8_LDB(B0, 0, 0); PG8_LDB(B1, 0, 1); PG8_SCHED; PG8_LDA(At, 0, 0); PG8_STAGE(PG8_SA(1, 1), a1 + hstep, voffA);
            PG8_WAIT_V(8); PG8_WAIT_L(0); PG8_BAR; PG8_MMA(0, 0, At, B0); PG8_MMA(0, 1, At, B1); PG8_BAR; PG8_SCHED;
            PG8_LDA(At, 0, 1); PG8_STAGE(PG8_SB(0, 0), b2, voffB); PG8_STAGE(PG8_SB(0, 1), b2 + hstep, voffB); PG8_STAGE(PG8_SA(0, 0), a2, voffA);
            PG8_WAIT_V(8); PG8_WAIT_L(0); PG8_BAR; PG8_MMA(1, 0, At, B0); PG8_MMA(1, 1, At, B1); PG8_BAR; PG8_SCHED;
            PG8_LDB(B0, 1, 0); PG8_LDB(B1, 1, 1); PG8_SCHED; PG8_LDA(At, 1, 0); PG8_STAGE(PG8_SA(0, 1), a2 + hstep, voffA);
            PG8_WAIT_V(8); PG8_WAIT_L(0); PG8_BAR; PG8_MMA(0, 0, At, B0); PG8_MMA(0, 1, At, B1); PG8_BAR; PG8_SCHED;
            PG8_LDA(At, 1, 1); PG8_STAGE(PG8_SB(1, 0), b3, voffB); PG8_STAGE(PG8_SB(1, 1), b3 + hstep, voffB); PG8_STAGE(PG8_SA(1, 0), a3, voffA);
            PG8_WAIT_V(8); PG8_WAIT_L(0); PG8_BAR; PG8_MMA(1, 0, At, B0); PG8_MMA(1, 1, At, B1); PG8_BAR; PG8_SCHED;
            } else {
            PG8_LDB(B0, 0, 0); PG8_SCHED; PG8_LDA(At, 0, 0); PG8_STAGE(PG8_SA(1, 1), a1 + hstep, voffA);
            PG8_WAIT_L(8); PG8_BAR; PG8_WAIT_L(0); PG8_MMA(0, 0, At, B0); PG8_BAR; PG8_SCHED;
            PG8_LDB(B1, 0, 1); PG8_STAGE(PG8_SB(0, 0), b2, voffB);
            PG8_BAR; PG8_WAIT_L(0); PG8_MMA(0, 1, At, B1); PG8_BAR;
            PG8_LDA(At, 0, 1); PG8_STAGE(PG8_SA(0, 0), a2, voffA);
            PG8_BAR; PG8_WAIT_L(0); PG8_MMA(1, 0, At, B0); PG8_BAR; PG8_SCHED;
            PG8_STAGE(PG8_SB(0, 1), b2 + hstep, voffB);
            PG8_WAIT_V(6); PG8_BAR; PG8_MMA(1, 1, At, B1); PG8_BAR;
            PG8_LDB(B0, 1, 0); PG8_SCHED; PG8_LDA(At, 1, 0); PG8_STAGE(PG8_SA(0, 1), a2 + hstep, voffA);
            PG8_WAIT_L(8); PG8_BAR; PG8_WAIT_L(0); PG8_MMA(0, 0, At, B0); PG8_BAR; PG8_SCHED;
            PG8_LDB(B1, 1, 1); PG8_STAGE(PG8_SB(1, 0), b3, voffB);
            PG8_BAR; PG8_WAIT_L(0); PG8_MMA(0, 1, At, B1); PG8_BAR;
            PG8_LDA(At, 1, 1); PG8_STAGE(PG8_SA(1, 0), a3, voffA);
            PG8_BAR; PG8_WAIT_L(0); PG8_MMA(1, 0, At, B0); PG8_BAR; PG8_SCHED;
            PG8_STAGE(PG8_SB(1, 1), b3 + hstep, voffB);
            PG8_WAIT_V(6); PG8_BAR; PG8_MMA(1, 1, At, B1); PG8_BAR;
            }
        }
        }
        if constexpr (ALIGN_EPI) { if (wr == 0) PG8_BAR; }
        if constexpr (Epi::KHOOK) { E.epi(acc, cur, wr, wc, fr, fq, ui & 1, lds); S.done(cur); }
        else if constexpr (!Epi::AFTER_DRAIN) { E(acc, cur, wr, wc, fr, fq); S.done(cur); }
        if (!has_next) break;
#pragma unroll
        for (int a = 0; a < 2; ++a)
#pragma unroll
            for (int b = 0; b < 2; ++b)
#pragma unroll
                for (int m = 0; m < 4; ++m)
#pragma unroll
                    for (int n = 0; n < 2; ++n) acc[a][b][m][n] = (f32x4){0.f, 0.f, 0.f, 0.f};
        cur = nxt; cA = nA; cB = nB; ++ui;
        if constexpr (Epi::KHOOK) E.unit_begin(cur, ui & 1, lds);
        if constexpr (ALIGN_EPI) { if (wr == 1) PG8_BAR; }
    }
    PG8_WAIT_V(0);
    if constexpr (!ALIGN_EPI) { if (wr == 0) PG8_BAR; }
    PG8_BAR;
    if constexpr (Epi::AFTER_DRAIN) { E.fused(acc, cur, wr, wc, fr, fq, lds, wid, lane); S.done(cur); }
#undef PG8_SA
#undef PG8_SB
#undef PG8_STAGE
#undef PG8_LDA
#undef PG8_LDB
#undef PG8_MMA
#undef PG8_WAIT_V
#undef PG8_WAIT_L
#undef PG8_BAR
#undef PG8_SCHED
}
}
#ifndef PG8_SP2
#define PG8_SP2 true
#endif
#ifndef PG8_ALIGN
#define PG8_ALIGN true
#endif

constexpr int NWAVES = 8;
constexpr int PER_PHASE = 12;
#ifndef MK_N_LAUNCHES
#define MK_N_LAUNCHES 1
#endif
#ifndef PROBE_MASK
#define PROBE_MASK 0
#endif
#define REP(k) (((PROBE_MASK >> (k)) & 1) + 1)
#ifndef PROBE_VAR
#define PROBE_VAR 0
#endif
#ifndef PROBE_CLK
#define PROBE_CLK 0
#endif
#ifndef STAMP_MASK
#define STAMP_MASK 0
#endif
#ifndef USE_AUX
#define USE_AUX 0
#endif
#ifndef USE_TILE_TRANSPOSE
#define USE_TILE_TRANSPOSE 0
#endif
#ifndef USE_L1_SEQ2
#define USE_L1_SEQ2 0
#endif
#ifndef USE_FUSED_NORM
#define USE_FUSED_NORM 1
#endif
#ifndef P0_META_FOLD
#define P0_META_FOLD (USE_L0_MFMA == 2 && !USE_TILE_TRANSPOSE)
#endif
#ifndef USE_TICKETS
#define USE_TICKETS 0
#endif
constexpr int N_LAUNCHES = MK_N_LAUNCHES;

constexpr int D = 4096, NB = 4, SEQ = 2048, NMETA = 16, DI = 8192;
constexpr int MX = NB * SEQ;
constexpr int MR = MX + NMETA;
constexpr int MP = 8448;
constexpr int N0 = 4 * DI;
constexpr int N1 = 2 * 4096 + 2 * DI;
constexpr int HG_H = 64, HG_DK = 128;
constexpr int GL_H = 8, GL_DK = 512, GL_DV = 1024, GL_R = 16;
constexpr float LN_EPS = 1e-5f, RMS_EPS = 1e-6f;
constexpr float ALPHA = 1.41421356237309515f;

constexpr size_t MiB = 1u << 20;
constexpr size_t WS_CTL = 0, CTL_ZERO_BYTES = 1 * MiB;
constexpr size_t WS_LB0 = 1 * MiB;
constexpr size_t WS_G1 = 2 * MiB;
constexpr size_t WS_WG1T = 3 * MiB;
constexpr size_t WS_W2F = 3 * MiB + 256 * 1024;
constexpr size_t WS_WT0IN = 4 * MiB;
constexpr size_t WS_WT0OUT = WS_WT0IN + 256 * MiB;
constexpr size_t WS_WT1IN = WS_WT0OUT + 64 * MiB;
constexpr size_t WS_WT1OUT = WS_WT1IN + 192 * MiB;
constexpr size_t WS_XB = WS_WT1OUT + 64 * MiB;
constexpr size_t WS_H1B = WS_XB + 66 * MiB;
constexpr size_t WS_QFIZ = WS_H1B + 66 * MiB;
constexpr size_t WS_Y = WS_QFIZ + 528 * MiB;
constexpr size_t WS_PRE = WS_Y + 132 * MiB;
constexpr size_t WS_REC = WS_PRE + 132 * MiB;
constexpr size_t WS_Q0 = WS_REC + 520 * MiB;
constexpr size_t WS_Y0 = WS_REC + 523 * MiB;
constexpr size_t WS_REC1 = WS_REC, WS_VF1 = WS_REC + 139 * MiB, WS_O1 = WS_REC + 270 * MiB;
constexpr size_t WS_END = WS_REC + 528 * MiB;
static_assert((size_t)MP * D * 2 <= 66 * MiB && (size_t)MP * N0 * 2 <= 528 * MiB && (size_t)MP * DI * 2 <= 132 * MiB && (size_t)MP * D * 4 <= 132 * MiB && (size_t)MR * DI * 4 <= 258 * MiB, "d_ws map");
static_assert((size_t)256 * 65 * 27648 <= 440 * MiB && (size_t)32 * 65 * 69632 <= 139 * MiB && (size_t)32 * 65 * 65536 <= 131 * MiB, "record map");
constexpr int CW_BAR = 4096, CW_POOL = 8192;

constexpr int RING_OFF = 0, RING_BYTES = 155648;
constexpr int LDSCTL_OFF = RING_BYTES, MISC_OFF = LDSCTL_OFF + 320;
constexpr int LDS_BYTES = 163840;
static_assert(MISC_OFF + 128 <= LDS_BYTES, "LDS map");

#define GAS __attribute__((address_space(1)))
#define LAS __attribute__((address_space(3)))
typedef unsigned short bf16;
typedef unsigned v4u __attribute__((ext_vector_type(4)));
typedef unsigned v2u __attribute__((ext_vector_type(2)));
typedef float f32x4 __attribute__((ext_vector_type(4)));
typedef GAS unsigned gu32;
#define RLX_AGENT __ATOMIC_RELAXED, __HIP_MEMORY_SCOPE_AGENT
#define LDS_WAIT() asm volatile("s_waitcnt lgkmcnt(0)" ::: "memory")
#define DI_ __device__ __forceinline__
DI_ unsigned f2bf(float f) { unsigned u = __builtin_bit_cast(unsigned, f); return (u + 0x7fffu + ((u >> 16) & 1u)) >> 16; }
DI_ unsigned pk2(float lo, float hi) { return f2bf(lo) | (f2bf(hi) << 16); }
DI_ unsigned hwpk(float lo, float hi) { unsigned r; asm volatile("v_cvt_pk_bf16_f32 %0, %1, %2" : "=v"(r) : "v"(lo), "v"(hi)); return r; }
DI_ float bflo(unsigned w) { return __builtin_bit_cast(float, w << 16); }
DI_ float bfhi(unsigned w) { return __builtin_bit_cast(float, w & 0xffff0000u); }
DI_ float bf2f(bf16 b) { return __builtin_bit_cast(float, (unsigned)b << 16); }
DI_ float sigm(float x) { return __builtin_amdgcn_rcpf(1.f + __builtin_amdgcn_exp2f(x * -1.4426950408889634f)); }
DI_ float silu(float x) { return x * __builtin_amdgcn_rcpf(1.f + __builtin_amdgcn_exp2f(x * -1.4426950408889634f)); }

#define XB_TMO      128
#define XB_XCNT(j)  (256  + 64 * (j))
#define XB_XSUB(j)  (1280 + 64 * (j))
#define XB_XGEN(j)  (2304 + 64 * (j))
#define XB_TOP      3328
#define XB_TOPGEN   3392
#define XCD_BAR_WORDS 3456
#define XB_SPIN_CAP (1u << 18)

__device__ __forceinline__ unsigned xb_ld(unsigned* p)              { return __hip_atomic_load(p, __ATOMIC_RELAXED, __HIP_MEMORY_SCOPE_AGENT); }
__device__ __forceinline__ unsigned xb_add(unsigned* p, unsigned v) { return __hip_atomic_fetch_add(p, v, __ATOMIC_RELAXED, __HIP_MEMORY_SCOPE_AGENT); }
__device__ __forceinline__ unsigned xb_xcc_id() { return (unsigned)__builtin_amdgcn_s_getreg((3 << 11) | 20) & 0xFu; }
#define XB_SPIN(cond, bar) do { unsigned _sp = 0; while (cond) { __builtin_amdgcn_s_sleep(1); \
    if ((++_sp & 255u) == 0u) { if (xb_ld(&(bar)[XB_TMO])) break; if (_sp > XB_SPIN_CAP) { atomicAdd(&(bar)[XB_TMO], 1u); break; } } } } while (0)

struct XcdBarrier {
    unsigned* bar; unsigned x;
    volatile LAS unsigned* st;
};
__device__ __forceinline__ XcdBarrier xcd_barrier_post(unsigned* bar, volatile LAS unsigned* st) {
    XcdBarrier b; b.bar = bar; b.x = xb_xcc_id(); b.st = st;
    if (threadIdx.x == 0) (void)xb_add(&bar[XB_XCNT(b.x)], 1u);
    return b;
}
__device__ __forceinline__ void xcd_barrier_complete(unsigned* bar, unsigned x, unsigned& nloc, unsigned& nx) {
    const unsigned G = gridDim.x * gridDim.y * gridDim.z;
    unsigned sum, cnt, mine, sp = 0u;
    for (;;) {
        sum = 0u; cnt = 0u; mine = 0u;
#pragma unroll
        for (unsigned j = 0; j < 16; ++j) { const unsigned c = xb_ld(&bar[XB_XCNT(j)]); sum += c; cnt += (c > 0u) ? 1u : 0u; mine = (j == x) ? c : mine; }
        if (sum == G) break;
        __builtin_amdgcn_s_sleep(1);
        if ((++sp & 255u) == 0u) { if (xb_ld(&bar[XB_TMO])) break; if (sp > XB_SPIN_CAP) { atomicAdd(&bar[XB_TMO], 1u); break; } }
    }
    nloc = mine > 0u ? mine : 1u; nx = cnt > 0u ? cnt : 1u;
}
__device__ __forceinline__ void xcd_barrier(const XcdBarrier& b) {
    asm volatile("s_waitcnt vmcnt(0)" ::: "memory");
    __syncthreads();
    if (threadIdx.x == 0) {
        unsigned* bar = b.bar;
        __builtin_amdgcn_s_waitcnt(0);
        unsigned nloc = b.st[0], nx = b.st[1];
        if (nloc == 0u) { xcd_barrier_complete(bar, b.x, nloc, nx); b.st[0] = nloc; b.st[1] = nx; }
        const unsigned old = xb_add(&bar[XB_XSUB(b.x)], 1u);
        const unsigned gen = old / nloc;
        if (old + 1u == (gen + 1u) * nloc) {
            __builtin_amdgcn_fence(__ATOMIC_RELEASE, "agent");
            asm volatile("s_waitcnt vmcnt(0)" ::: "memory");
            const unsigned og = xb_add(&bar[XB_TOP], 1u);
            const unsigned tg = og / nx;
            if (og + 1u == (tg + 1u) * nx) xb_add(&bar[XB_TOPGEN], 1u);
            else XB_SPIN(xb_ld(&bar[XB_TOPGEN]) == tg, bar);
            __builtin_amdgcn_fence(__ATOMIC_ACQUIRE, "agent");
            xb_add(&bar[XB_XGEN(b.x)], 1u);
            asm volatile("s_waitcnt vmcnt(0)" ::: "memory");
        } else {
            XB_SPIN(xb_ld(&bar[XB_XGEN(b.x)]) == gen, bar);
            __builtin_amdgcn_fence(__ATOMIC_ACQUIRE, "agent");
            asm volatile("s_waitcnt vmcnt(0)" ::: "memory");
        }
    }
    __syncthreads();
}

struct Frame {
    LAS unsigned char* lds;
    volatile LAS unsigned* MISC;
    gu32* ctl;
    int tid, lane, wave;
    int vcu, G;
    const float *x, *meta, *lb_logits;
    const float *w0in, *b_f, *ng0, *w0out, *ln0g, *ln0b;
    const float *w1in, *wg1, *wg2, *b_g, *ng1, *w1out, *ln1g, *ln1b;
    float* out;
    float *LB0, *G1, *PRE, *O1;
    unsigned char *REC0, *REC1, *VF1;
    bf16 *WG1T, *W2F, *Q0, *Y0;
    float* SS;
    bf16 *WT0IN, *WT0OUT, *WT1IN, *WT1OUT, *XB, *H1B, *QFIZ, *Y;
};

DI_ float wave_sum(float v) {
#pragma unroll
    for (int o = 1; o < 64; o <<= 1) v += __shfl_xor(v, o);
    return v;
}

typedef short p0_bf16x8 __attribute__((ext_vector_type(8)));
template <bool META>
DI_ void p0_transpose_item_t(const float* W, int K, int N, bf16* WT, LAS float* scr, int item_kb, int item_nb, int lane, const float* meta, f32x4 (&macc)[2]) {
    const int k0 = 64 * item_kb, n0 = 32 * item_nb;
    float wv[32];
#pragma unroll
    for (int i = 0; i < 32; ++i) wv[i] = W[(size_t)(k0 + 2 * i + (lane >> 5)) * N + n0 + (lane & 31)];
    v4u ma[2][2];
    if (META) {
#pragma unroll
        for (int ks = 0; ks < 2; ++ks) { const GAS f32x4* mp = (const GAS f32x4*)(meta + (size_t)(lane & 15) * D + k0 + 32 * ks + 8 * (lane >> 4)); const f32x4 a = mp[0], b = mp[1];
            ma[ks][0] = (v4u){hwpk(a.x, a.y), hwpk(a.z, a.w), hwpk(b.x, b.y), hwpk(b.z, b.w)}; }
    }
#pragma unroll
    for (int i = 0; i < 32; ++i) scr[(2 * i + (lane >> 5)) * 33 + (lane & 31)] = wv[i];
    LDS_WAIT(); asm volatile("" ::: "memory");
    if (META) {
        const int r = lane & 15, g = lane >> 4;
#pragma unroll
        for (int ks = 0; ks < 2; ++ks)
#pragma unroll
            for (int nh = 0; nh < 2; ++nh) { const LAS float* s = scr + (32 * ks + 8 * g) * 33 + 16 * nh + r;
                const v4u bf = (v4u){hwpk(s[0 * 33], s[1 * 33]), hwpk(s[2 * 33], s[3 * 33]), hwpk(s[4 * 33], s[5 * 33]), hwpk(s[6 * 33], s[7 * 33])};
                macc[nh] = __builtin_amdgcn_mfma_f32_16x16x32_bf16(__builtin_bit_cast(p0_bf16x8, ma[ks][0]), __builtin_bit_cast(p0_bf16x8, bf), macc[nh], 0, 0, 0); }
    }
    const int c = lane & 7;
#pragma unroll
    for (int j = 0; j < 4; ++j) { const int n = (lane >> 3) + 8 * j; const LAS float* s = scr + (8 * c) * 33 + n;
        v4u o; o.x = hwpk(s[0 * 33], s[1 * 33]); o.y = hwpk(s[2 * 33], s[3 * 33]); o.z = hwpk(s[4 * 33], s[5 * 33]); o.w = hwpk(s[6 * 33], s[7 * 33]);
        *(GAS v4u*)(WT + (size_t)(n0 + n) * K + k0 + 8 * c) = o; }
    LDS_WAIT(); asm volatile("" ::: "memory");
}
DI_ void p0_transpose_item(const float* W, int K, int N, bf16* WT, LAS float* scr, int item, int lane) {
    f32x4 dummy[2]; const int nblk = N / 32;
    p0_transpose_item_t<false>(W, K, N, WT, scr, item / nblk, item % nblk, lane, nullptr, dummy);
}

DI_ void p0_tile_load(const float* W, int N, int k0, int n0, int tid, f32x4 (&wv)[8]) {
    const int row = tid >> 5, c4 = tid & 31;
#pragma unroll
    for (int i = 0; i < 8; ++i) wv[i] = *(const GAS f32x4*)(W + (size_t)(k0 + row + 16 * i) * N + n0 + 4 * c4);
}
DI_ void p0_tile_to_lds(int tid, const f32x4 (&wv)[8], LAS unsigned char* img) {
    const int row = tid >> 5, c4 = tid & 31;
#pragma unroll
    for (int i = 0; i < 8; ++i) { const int k = row + 16 * i; const int col = (2 * c4) ^ (2 * ((k >> 3) & 15));
        *(LAS v2u*)(img + k * 256 + col * 4) = (v2u){hwpk(wv[i].x, wv[i].y), hwpk(wv[i].z, wv[i].w)}; }
}
DI_ void p0_tile_from_lds(bf16* WT, int K, int k0, int n0, int tid, LAS unsigned char* img) {
    __syncthreads();
    const int kc = tid & 15;
#pragma unroll
    for (int j = 0; j < 4; ++j) { const int n = (tid >> 4) + 32 * j; unsigned short hv[8];
#pragma unroll
        for (int e = 0; e < 8; ++e) hv[e] = *(const LAS unsigned short*)(img + (8 * kc + e) * 256 + ((((n >> 1) ^ (2 * kc)) << 2) | ((n & 1) << 1)));
        v4u o; o.x = hv[0] | ((unsigned)hv[1] << 16); o.y = hv[2] | ((unsigned)hv[3] << 16); o.z = hv[4] | ((unsigned)hv[5] << 16); o.w = hv[6] | ((unsigned)hv[7] << 16);
        *(GAS v4u*)(WT + (size_t)(n0 + n) * K + k0 + 8 * kc) = o; }
    __syncthreads();
}
struct P0Tile { const float* W; bf16* WT; int K, N, k0, n0; };
DI_ P0Tile p0_tile_decode(Frame& F, int t) {
    constexpr int T_0 = (D / 128) * (N0 / 128), T_1 = (DI / 128) * (D / 128), T_2 = (D / 128) * (N1 / 128);
    P0Tile p;
    if (t < T_0) { p.W = F.w0in; p.WT = F.WT0IN; p.K = D; p.N = N0; }
    else if (t < T_0 + T_1) { t -= T_0; p.W = F.w0out; p.WT = F.WT0OUT; p.K = DI; p.N = D; }
    else if (t < T_0 + T_1 + T_2) { t -= T_0 + T_1; p.W = F.w1in; p.WT = F.WT1IN; p.K = D; p.N = N1; }
    else { t -= T_0 + T_1 + T_2; p.W = F.w1out; p.WT = F.WT1OUT; p.K = DI; p.N = D; }
    const int nt = p.N / 128, kb = t / nt, nb = t - kb * nt; p.k0 = 128 * kb; p.n0 = 128 * nb; return p;
}
DI_ void p0_transpose_all(Frame& F) {
    constexpr int NT = (D / 128) * (N0 / 128) + 2 * (DI / 128) * (D / 128) + (D / 128) * (N1 / 128);
    f32x4 wv[8];
    int t = F.vcu;
    if (t < NT) { const P0Tile p = p0_tile_decode(F, t); p0_tile_load(p.W, p.N, p.k0, p.n0, F.tid, wv); }
    for (; t < NT; t += F.G) {
        const P0Tile p = p0_tile_decode(F, t);
        p0_tile_to_lds(F.tid, wv, F.lds);
        if (t + F.G < NT) { const P0Tile q = p0_tile_decode(F, t + F.G); p0_tile_load(q.W, q.N, q.k0, q.n0, F.tid, wv); }
        p0_tile_from_lds(p.WT, p.K, p.k0, p.n0, F.tid, F.lds);
    }
}

DI_ void p0_prologue(Frame& F) {
    LAS float* scr = (LAS float*)(F.lds + RING_OFF + F.wave * 16384);
    const int gw = F.vcu * NWAVES + F.wave, NGW = F.G * NWAVES;
    constexpr int I_0 = (D / 64) * (N0 / 32), I_1 = (DI / 64) * (D / 32), I_2 = (D / 64) * (N1 / 32), I_3 = I_1;
    constexpr int NITEMS = I_0 + I_1 + I_2 + I_3;
#if USE_TILE_TRANSPOSE
    p0_transpose_all(F);
#else
    if (P0_META_FOLD && F.G == 256) {
        constexpr int OTH = I_1 + I_2 + I_3;
        int o_lo, o_hi;
        if (gw < 1024) {
            f32x4 macc[2]; macc[0] = (f32x4){0.f, 0.f, 0.f, 0.f}; macc[1] = macc[0];
            for (int kb = 0; kb < D / 64; ++kb) p0_transpose_item_t<true>(F.w0in, D, N0, F.WT0IN, scr, kb, gw, F.lane, F.meta, macc);
            const int r = F.lane & 15, g = F.lane >> 4;
#pragma unroll
            for (int nh = 0; nh < 2; ++nh) { const float mv[4] = {macc[nh].x, macc[nh].y, macc[nh].z, macc[nh].w};
#pragma unroll
                for (int jj = 0; jj < 4; ++jj) F.Q0[(size_t)(16 + 4 * g + jj) * N0 + 32 * gw + 16 * nh + r] = (bf16)f2bf(mv[jj]); }
            o_lo = gw * 8; o_hi = o_lo + 8;
        } else { o_lo = 8192 + (gw - 1024) * 72; o_hi = o_lo + 72; }
        static_assert(OTH == 8192 + 1024 * 72, "tile split");
        for (int it = o_lo; it < o_hi; ++it) {
            int r = it;
            if (r < I_1) { p0_transpose_item(F.w0out, DI, D, F.WT0OUT, scr, r, F.lane); continue; } r -= I_1;
            if (r < I_2) { p0_transpose_item(F.w1in, D, N1, F.WT1IN, scr, r, F.lane); continue; } r -= I_2;
            p0_transpose_item(F.w1out, DI, D, F.WT1OUT, scr, r, F.lane);
        }
    } else
    for (int it = gw; it < NITEMS; it += NGW) {
        int r = it;
        if (r < I_0) { p0_transpose_item(F.w0in, D, N0, F.WT0IN, scr, r, F.lane); continue; } r -= I_0;
        if (USE_AUX && USE_L0_MFMA == 2 && F.G == 256) break;
        if (r < I_1) { p0_transpose_item(F.w0out, DI, D, F.WT0OUT, scr, r, F.lane); continue; } r -= I_1;
        if (r < I_2) { p0_transpose_item(F.w1in, D, N1, F.WT1IN, scr, r, F.lane); continue; } r -= I_2;
        p0_transpose_item(F.w1out, DI, D, F.WT1OUT, scr, r, F.lane);
    }
#endif
    for (int m = gw; m < MP; m += NGW) {
        GAS unsigned long long* o8 = (GAS unsigned long long*)(F.XB + (size_t)m * D) + F.lane;
        if (m < MR) {
            const float* src = (m < MX) ? F.x + (size_t)m * D : F.meta + (size_t)(m - MX) * D;
            const GAS f32x4* xr = (const GAS f32x4*)src + F.lane;
#pragma unroll 4
            for (int j = 0; j < 16; ++j) { const f32x4 v = xr[64 * j]; o8[64 * j] = (unsigned long long)hwpk(v.x, v.y) | ((unsigned long long)hwpk(v.z, v.w) << 32); }
        } else {
#pragma unroll 4
            for (int j = 0; j < 16; ++j) o8[64 * j] = 0ull;
        }
    }
    for (int m = MR + gw; m < MP; m += NGW) {
        GAS unsigned long long* o8 = (GAS unsigned long long*)(F.H1B + (size_t)m * D) + F.lane;
#pragma unroll 4
        for (int j = 0; j < 16; ++j) o8[64 * j] = 0ull;
    }
    for (int i = gw * 64 + F.lane; i < 16 * N0 / 8; i += NGW * 64) { const int col8 = i % (N0 / 8); const unsigned v = (col8 >= DI / 8 && col8 < 2 * DI / 8) ? 0x47004700u : 0u;
        *((GAS v4u*)F.Q0 + i) = (v4u){v, v, v, v}; }
    for (int i = gw * 64 + F.lane; i < GL_R * D; i += NGW * 64) { const int n = i / D, k = i - n * D; F.WG1T[i] = (bf16)f2bf(F.wg1[(size_t)k * GL_R + n]); }
    for (int i = gw * 64 + F.lane; i < 8 * 16 * 2 * 64 * 8; i += NGW * 64) {
        const int e = i & 7, ln = (i >> 3) & 63, fr = i >> 9, m2 = fr & 1, s2 = (fr >> 1) & 15, hh = fr >> 5, rA = ln & 15, gA = ln >> 4;
        float v = 0.f; if (gA < 2) v = F.wg2[(size_t)(8 * gA + e) * 4096 + hh * 512 + 32 * s2 + 8 * (rA >> 2) + 4 * m2 + (rA & 3)];
        F.W2F[i] = (bf16)f2bf(v);
    }
    for (int c = gw * 64 + F.lane; c < DI; c += NGW * 64) {
        const float l0 = F.lb_logits[c], l1 = F.lb_logits[DI + c], l2 = F.lb_logits[2 * DI + c];
        const float mx = fmaxf(l0, fmaxf(l1, l2));
        const float e0 = __expf(l0 - mx), e1 = __expf(l1 - mx), e2 = __expf(l2 - mx);
        F.LB0[c] = e0 / (e0 + e1 + e2);
    }
}

DI_ void p2_l0_rec_naive(Frame& F) {
    LAS float* qs = (LAS float*)(F.lds);
    LAS float* fs = qs + 2048;
    LAS float* ks = fs + 2048;
    LAS float* vs = ks + 2048;
    LAS float* pb = vs + 2048;
    const int tid = F.tid, dv = tid & 127, kg = tid >> 7;
    const int lj = tid >> 5, lc = (tid & 31) * 4;
    for (int u = blockIdx.x; u < NB * HG_H; u += F.G) {
        const int b = u >> 6, h = u & 63;
        float S[32];
#pragma unroll
        for (int i = 0; i < 32; ++i) S[i] = 0.f;
        float lbv[4], bfv[4], ngv[4];
#pragma unroll
        for (int i = 0; i < 4; ++i) { lbv[i] = F.LB0[h * 128 + lc + i]; bfv[i] = F.b_f[h * 128 + lc + i]; ngv[i] = F.ng0[h * 128 + lc + i]; }
        for (int tb = 0; tb < 129; ++tb) {
            const int rbase = (tb == 0) ? MX : b * SEQ + 16 * (tb - 1);
            const bf16* row = F.QFIZ + (size_t)(rbase + lj) * N0 + h * 128 + lc;
            {
                const v2u q4 = *(const GAS v2u*)(row), f4 = *(const GAS v2u*)(row + DI), i4 = *(const GAS v2u*)(row + 2 * DI);
                const float qv[4] = {bflo(q4.x), bfhi(q4.x), bflo(q4.y), bfhi(q4.y)};
                const float fv[4] = {bflo(f4.x), bfhi(f4.x), bflo(f4.y), bfhi(f4.y)};
                const float iv[4] = {bflo(i4.x), bfhi(i4.x), bflo(i4.y), bfhi(i4.y)};
#pragma unroll
                for (int i = 0; i < 4; ++i) {
                    const float fg = lbv[i] + (1.f - lbv[i]) * sigm(fv[i] + bfv[i]);
                    qs[lj * 128 + lc + i] = silu(qv[i]); fs[lj * 128 + lc + i] = fg; ks[lj * 128 + lc + i] = 1.f - fg; vs[lj * 128 + lc + i] = iv[i];
                }
            }
            __syncthreads();
            for (int j = 0; j < 16; ++j) {
                const float vj = vs[j * 128 + dv]; float po = 0.f;
#pragma unroll
                for (int i = 0; i < 32; i += 4) {
                    const f32x4 f4 = *(const LAS f32x4*)(fs + j * 128 + kg * 32 + i), k4 = *(const LAS f32x4*)(ks + j * 128 + kg * 32 + i), q4 = *(const LAS f32x4*)(qs + j * 128 + kg * 32 + i);
                    S[i + 0] = f4.x * S[i + 0] + k4.x * vj; po += q4.x * S[i + 0];
                    S[i + 1] = f4.y * S[i + 1] + k4.y * vj; po += q4.y * S[i + 1];
                    S[i + 2] = f4.z * S[i + 2] + k4.z * vj; po += q4.z * S[i + 2];
                    S[i + 3] = f4.w * S[i + 3] + k4.w * vj; po += q4.w * S[i + 3];
                }
                pb[(j * 4 + kg) * 128 + dv] = po;
            }
            __syncthreads();
            {
                f32x4 o = *(const LAS f32x4*)(pb + (lj * 4 + 0) * 128 + lc);
                o += *(const LAS f32x4*)(pb + (lj * 4 + 1) * 128 + lc);
                o += *(const LAS f32x4*)(pb + (lj * 4 + 2) * 128 + lc);
                o += *(const LAS f32x4*)(pb + (lj * 4 + 3) * 128 + lc);
                float ss = o.x * o.x + o.y * o.y + o.z * o.z + o.w * o.w;
                ss += __shfl_xor(ss, 16); ss += __shfl_xor(ss, 8); ss += __shfl_xor(ss, 4); ss += __shfl_xor(ss, 2); ss += __shfl_xor(ss, 1);
                const float rs = rsqrtf(ss * (1.f / 128.f) + RMS_EPS);
                const v2u z4 = *(const GAS v2u*)(row + 3 * DI);
                const float y0 = o.x * rs * ngv[0] * silu(bflo(z4.x)), y1 = o.y * rs * ngv[1] * silu(bfhi(z4.x));
                const float y2 = o.z * rs * ngv[2] * silu(bflo(z4.y)), y3 = o.w * rs * ngv[3] * silu(bfhi(z4.y));
                if (tb > 0 || b == 0) { v2u w; w.x = pk2(y0, y1); w.y = pk2(y2, y3); *(GAS v2u*)(F.Y + (size_t)(rbase + lj) * DI + h * 128 + lc) = w; }
            }
        }
        __syncthreads();
    }
}

DI_ void ln_phase(Frame& F, const float* src, int nrows, const float* g, const float* bt, float* dst32, bf16* dstb, float* G1) {
    const int gw = F.vcu * NWAVES + F.wave, NGW = F.G * NWAVES;
    for (int r = gw; r < nrows; r += NGW) {
        const GAS f32x4* s = (const GAS f32x4*)(src + (size_t)r * D) + F.lane;
        f32x4 v[16]; float sm = 0.f;
#pragma unroll
        for (int j = 0; j < 16; ++j) { v[j] = s[64 * j]; sm += (v[j].x + v[j].y) + (v[j].z + v[j].w); }
        const float mean = wave_sum(sm) * (1.f / D); float s2 = 0.f;
#pragma unroll
        for (int j = 0; j < 16; ++j) { v[j] = v[j] - mean; s2 += (v[j].x * v[j].x + v[j].y * v[j].y) + (v[j].z * v[j].z + v[j].w * v[j].w); }
        const float rstd = rsqrtf(wave_sum(s2) * (1.f / D) + LN_EPS);
#pragma unroll
        for (int j = 0; j < 16; ++j) {
            const f32x4 gg = *((const GAS f32x4*)g + F.lane + 64 * j), bb = *((const GAS f32x4*)bt + F.lane + 64 * j);
            v[j] = v[j] * rstd * gg + bb;
            if (dst32) *((GAS f32x4*)(dst32 + (size_t)r * D) + F.lane + 64 * j) = v[j];
            if (dstb) { v2u w; w.x = hwpk(v[j].x, v[j].y); w.y = hwpk(v[j].z, v[j].w); *((GAS v2u*)(dstb + (size_t)r * D) + F.lane + 64 * j) = w; }
            if ((j & 3) == 3) asm volatile("" ::: "memory");
        }
        if (G1) {
            LAS float* rowbuf = (LAS float*)(F.lds + RING_OFF + F.wave * 16384);
#pragma unroll
            for (int j = 0; j < 16; ++j) *(LAS f32x4*)(rowbuf + 256 * j + 4 * F.lane) = v[j];
            LDS_WAIT(); asm volatile("" ::: "memory");
            float a[16];
#pragma unroll
            for (int q = 0; q < 16; ++q) a[q] = 0.f;
#pragma unroll 2
            for (int i = 0; i < 64; ++i) {
                const int k = 64 * i + F.lane;
                const float e = rowbuf[k];
                const GAS f32x4* w = (const GAS f32x4*)(F.wg1 + (size_t)k * GL_R);
                const f32x4 w0 = w[0], w1 = w[1], w2 = w[2], w3 = w[3];
                a[0] += e * w0.x; a[1] += e * w0.y; a[2] += e * w0.z; a[3] += e * w0.w;
                a[4] += e * w1.x; a[5] += e * w1.y; a[6] += e * w1.z; a[7] += e * w1.w;
                a[8] += e * w2.x; a[9] += e * w2.y; a[10] += e * w2.z; a[11] += e * w2.w;
                a[12] += e * w3.x; a[13] += e * w3.y; a[14] += e * w3.z; a[15] += e * w3.w;
            }
#pragma unroll
            for (int q = 0; q < 16; ++q) a[q] = wave_sum(a[q]);
            if (F.lane == 0) {
#pragma unroll
                for (int q = 0; q < 16; q += 4) *(GAS f32x4*)(G1 + (size_t)r * GL_R + q) = (f32x4){a[q], a[q + 1], a[q + 2], a[q + 3]};
            }
            LDS_WAIT(); asm volatile("" ::: "memory");
        }
    }
}

DI_ void p6_l1_rec_naive(Frame& F) {
    LAS float* qs = (LAS float*)(F.lds);
    LAS float* ks = qs + 4096;
    LAS float* gs = ks + 4096;
    LAS float* vs = gs + 4096;
    LAS float* pb = vs + 512;
    const int tid = F.tid, dv = tid & 63, kg = tid >> 6;
    const float qscale = 0.04419417382415922f;
    for (int u = blockIdx.x; u < NB * GL_H * 16; u += F.G) {
        const int dvs = u & 15, bh = u >> 4, b = bh >> 3, h = bh & 7;
        float S[64];
#pragma unroll
        for (int i = 0; i < 64; ++i) S[i] = 0.f;
        float w2[16];
#pragma unroll
        for (int r = 0; r < 16; ++r) w2[r] = F.wg2[(size_t)r * 4096 + h * 512 + tid];
        const float bg = F.b_g[h * 512 + tid];
        for (int tb = 0; tb < 258; ++tb) {
            const int rbase = (tb < 2) ? MX + 8 * tb : b * SEQ + 8 * (tb - 2);
            for (int j = 0; j < 8; ++j) {
                const size_t r = (size_t)(rbase + j);
                const float q = bf2f(F.QFIZ[r * N1 + h * 512 + tid]) * qscale, k = bf2f(F.QFIZ[r * N1 + 4096 + h * 512 + tid]);
                const float* g1 = F.G1 + r * GL_R;
                float xg = bg;
#pragma unroll
                for (int rr = 0; rr < 16; ++rr) xg += g1[rr] * w2[rr];
                const float ls = fminf(xg, 0.f) - log1pf(__expf(-fabsf(xg)));
                qs[j * 512 + tid] = q; ks[j * 512 + tid] = k; gs[j * 512 + tid] = __expf(ls * (1.f / 16.f));
            }
            vs[tid] = bf2f(F.QFIZ[(size_t)(rbase + (tid >> 6)) * N1 + 8192 + h * 1024 + dvs * 64 + (tid & 63)]);
            __syncthreads();
            for (int j = 0; j < 8; ++j) {
                const float vj = vs[j * 64 + dv]; float po = 0.f;
#pragma unroll
                for (int i = 0; i < 64; i += 4) {
                    const f32x4 g4 = *(const LAS f32x4*)(gs + j * 512 + kg * 64 + i), k4 = *(const LAS f32x4*)(ks + j * 512 + kg * 64 + i), q4 = *(const LAS f32x4*)(qs + j * 512 + kg * 64 + i);
                    S[i + 0] = g4.x * S[i + 0] + k4.x * vj; po += q4.x * S[i + 0];
                    S[i + 1] = g4.y * S[i + 1] + k4.y * vj; po += q4.y * S[i + 1];
                    S[i + 2] = g4.z * S[i + 2] + k4.z * vj; po += q4.z * S[i + 2];
                    S[i + 3] = g4.w * S[i + 3] + k4.w * vj; po += q4.w * S[i + 3];
                    if ((i & 12) == 12) asm volatile("" ::: "memory");
                }
                pb[(j * 8 + kg) * 64 + dv] = po;
            }
            __syncthreads();
            {
                const int j = tid >> 6, d = tid & 63; float o = 0.f;
#pragma unroll
                for (int g = 0; g < 8; ++g) o += pb[(j * 8 + g) * 64 + d];
                if (tb >= 2 || b == 0) F.O1[(size_t)(rbase + j) * DI + h * 1024 + dvs * 64 + d] = o;
            }
        }
        __syncthreads();
    }
}

DI_ void p7_normgate(Frame& F) {
    const int gw = F.vcu * NWAVES + F.wave, NGW = F.G * NWAVES;
    for (int it = gw; it < MX * GL_H; it += NGW) {
        const int r = it >> 3, h = it & 7;
        const GAS v4u* o = (const GAS v4u*)((const bf16*)F.O1 + (size_t)r * DI + h * 1024) + F.lane;
        const GAS v4u* zp = (const GAS v4u*)(F.QFIZ + (size_t)r * N1 + 16384 + h * 1024) + F.lane;
        v4u ov[2], zv[2]; float ss = 0.f;
#pragma unroll
        for (int j = 0; j < 2; ++j) { ov[j] = o[64 * j]; zv[j] = zp[64 * j]; }
        float x[2][8];
#pragma unroll
        for (int j = 0; j < 2; ++j) { x[j][0] = bflo(ov[j].x); x[j][1] = bfhi(ov[j].x); x[j][2] = bflo(ov[j].y); x[j][3] = bfhi(ov[j].y); x[j][4] = bflo(ov[j].z); x[j][5] = bfhi(ov[j].z); x[j][6] = bflo(ov[j].w); x[j][7] = bfhi(ov[j].w);
#pragma unroll
            for (int e = 0; e < 8; ++e) ss += x[j][e] * x[j][e]; }
        const float rs = rsqrtf(wave_sum(ss) * (1.f / 1024.f) + RMS_EPS);
#pragma unroll
        for (int j = 0; j < 2; ++j) {
            const int c = h * 1024 + 512 * j + 8 * F.lane;
            const f32x4 n0 = *(const GAS f32x4*)(F.ng1 + c), n1 = *(const GAS f32x4*)(F.ng1 + c + 4);
            const float z[8] = {bflo(zv[j].x), bfhi(zv[j].x), bflo(zv[j].y), bfhi(zv[j].y), bflo(zv[j].z), bfhi(zv[j].z), bflo(zv[j].w), bfhi(zv[j].w)};
            v4u wv; wv.x = pk2(x[j][0] * rs * n0.x * silu(z[0]), x[j][1] * rs * n0.y * silu(z[1])); wv.y = pk2(x[j][2] * rs * n0.z * silu(z[2]), x[j][3] * rs * n0.w * silu(z[3]));
            wv.z = pk2(x[j][4] * rs * n1.x * silu(z[4]), x[j][5] * rs * n1.y * silu(z[5])); wv.w = pk2(x[j][6] * rs * n1.z * silu(z[6]), x[j][7] * rs * n1.w * silu(z[7]));
            *(GAS v4u*)(F.Y + (size_t)r * DI + c) = wv;
        }
    }
}

typedef short bf16x8 __attribute__((ext_vector_type(8)));
#ifndef USE_FUSED_NORM
#define USE_FUSED_NORM 1
#endif
constexpr int NCH = 65;
constexpr int SSP_OFF = 155648 + 512;
constexpr float LOG2E = 1.4426950408889634f;
constexpr int R1_QD = 0, R1_KD = 32768, R1_P = 65536, R1_GL = 67584, R1_SH = 69632;
constexpr int ST1 = R1_SH + 8192;
constexpr int R0_QD = 0, R0_KD = 8192, R0_P = 16384, R0_V = 18432, R0_GL = 26624, R0_SZ = 27648;
constexpr int ST0 = R0_SZ;

DI_ unsigned cvtpk(float lo, float hi) { unsigned r; asm volatile("v_cvt_pk_bf16_f32 %0, %1, %2" : "=v"(r) : "v"(lo), "v"(hi)); return r; }
template <int N> DI_ float row_shr(float x) { return __builtin_bit_cast(float, __builtin_amdgcn_update_dpp(0, __builtin_bit_cast(int, x), 0x110 + N, 0xF, 0xF, true)); }
DI_ float bcast15(float x) { return __builtin_bit_cast(float, __builtin_amdgcn_update_dpp(0, __builtin_bit_cast(int, x), 0x15F, 0xF, 0xF, true)); }
DI_ float scan16(float x) { x += row_shr<1>(x); x += row_shr<2>(x); x += row_shr<4>(x); x += row_shr<8>(x); return x; }
DI_ float ex2(float x) { return __builtin_amdgcn_exp2f(x); }
DI_ float lg2(float x) { return __builtin_amdgcn_logf(x); }
DI_ int row_of(int b, int c, int tok) { return c == 0 ? MX + tok - 16 : b * SEQ + 32 * (c - 1) + tok; }
DI_ bf16x8 mk8(unsigned a, unsigned b, unsigned c, unsigned d) { v4u t; t.x = a; t.y = b; t.z = c; t.w = d; return __builtin_bit_cast(bf16x8, t); }
#define MFMA16(a, b, c) __builtin_amdgcn_mfma_f32_16x16x32_bf16((a), (b), (c), 0, 0, 0)

DI_ void l1_prep(Frame& F, unsigned char* REC1, unsigned char* VF1, const bf16* W2F) {
    const int lane = F.lane, w = F.wave, r = lane & 15, g = lane >> 4;
    LAS unsigned char* T = F.lds + w * 16384;
    LAS unsigned char* Tv = F.lds + w * 16384 + 4096;
    LAS f32x4* Pp = (LAS f32x4*)(F.lds + 131072);
    const float qscale = 0.04419417382415922f;
    for (int it = blockIdx.x; it < NB * GL_H * NCH; it += F.G) {
        const int bh = it / NCH, c = it - bh * NCH, b = bh >> 3, h = bh & 7;
        unsigned char* rec = REC1 + (size_t)it * R1_SH;
        int row[2]; bool nul[2];
#pragma unroll
        for (int ti = 0; ti < 2; ++ti) { const int tok = 16 * ti + r; nul[ti] = (c == 0 && tok < 16); row[ti] = nul[ti] ? 0 : row_of(b, c, tok); }
        bf16x8 g1f[2];
#pragma unroll
        for (int ti = 0; ti < 2; ++ti) {
            f32x4 t0 = (f32x4){0.f, 0.f, 0.f, 0.f}, t1 = t0;
            if (g < 2) { const GAS f32x4* gp = (const GAS f32x4*)(F.G1 + (size_t)row[ti] * GL_R + 8 * g); t0 = gp[0]; t1 = gp[1]; }
            g1f[ti] = mk8(pk2(t0.x, t0.y), pk2(t0.z, t0.w), pk2(t1.x, t1.y), pk2(t1.z, t1.w));
        }
        f32x4 pacc[3];
#pragma unroll
        for (int t = 0; t < 3; ++t) pacc[t] = (f32x4){0.f, 0.f, 0.f, 0.f};
        v4u qraw[2][2], kraw[2][2];
#pragma unroll
        for (int si = 0; si < 2; ++si)
#pragma unroll
            for (int ti = 0; ti < 2; ++ti) { const bf16* rp = F.QFIZ + (size_t)row[ti] * N1 + h * 512 + 32 * (2 * w + si) + 8 * g; qraw[si][ti] = *(const GAS v4u*)rp; kraw[si][ti] = *(const GAS v4u*)(rp + 4096); }
        asm volatile("" ::: "memory");
#pragma unroll
        for (int si = 0; si < 2; ++si) {
            const int s = 2 * w + si, col = h * 512 + 32 * s + 8 * g;
            float xg[2][8];
            { const f32x4 b0 = *(const GAS f32x4*)(F.b_g + col), b1 = *(const GAS f32x4*)(F.b_g + col + 4);
              const bf16x8 wa = *(const GAS bf16x8*)(W2F + ((size_t)((h * 16 + s) * 2 + 0) * 64 + lane) * 8), wb = *(const GAS bf16x8*)(W2F + ((size_t)((h * 16 + s) * 2 + 1) * 64 + lane) * 8);
#pragma unroll
              for (int ti = 0; ti < 2; ++ti) { const f32x4 xa = MFMA16(wa, g1f[ti], b0), xb = MFMA16(wb, g1f[ti], b1);
                  xg[ti][0] = xa.x; xg[ti][1] = xa.y; xg[ti][2] = xa.z; xg[ti][3] = xa.w; xg[ti][4] = xb.x; xg[ti][5] = xb.y; xg[ti][6] = xb.z; xg[ti][7] = xb.w; } }
            float qv[2][8], kv[2][8];
#pragma unroll
            for (int ti = 0; ti < 2; ++ti) {
                const v4u q4 = qraw[si][ti], k4 = kraw[si][ti];
                qv[ti][0] = bflo(q4.x); qv[ti][1] = bfhi(q4.x); qv[ti][2] = bflo(q4.y); qv[ti][3] = bfhi(q4.y); qv[ti][4] = bflo(q4.z); qv[ti][5] = bfhi(q4.z); qv[ti][6] = bflo(q4.w); qv[ti][7] = bfhi(q4.w);
                kv[ti][0] = bflo(k4.x); kv[ti][1] = bfhi(k4.x); kv[ti][2] = bflo(k4.y); kv[ti][3] = bfhi(k4.y); kv[ti][4] = bflo(k4.z); kv[ti][5] = bfhi(k4.z); kv[ti][6] = bflo(k4.w); kv[ti][7] = bfhi(k4.w);
            }
            unsigned qd[2][4], ki[2][4], kd[2][4]; float gl[8];
#pragma unroll
            for (int e = 0; e < 8; e += 2) {
                float bb[2][2], BB[2];
#pragma unroll
                for (int u = 0; u < 2; ++u) {
                    float L0 = nul[0] ? 0.f : (fminf(xg[0][e + u], 0.f) * LOG2E - lg2(1.f + ex2(-fabsf(xg[0][e + u]) * LOG2E))) * (1.f / 16.f);
                    float L1 = nul[1] ? 0.f : (fminf(xg[1][e + u], 0.f) * LOG2E - lg2(1.f + ex2(-fabsf(xg[1][e + u]) * LOG2E))) * (1.f / 16.f);
                    const float b0 = scan16(L0);
                    const float b1 = scan16(L1) + bcast15(b0);
                    bb[0][u] = b0; bb[1][u] = b1; BB[u] = bcast15(b1);
                    gl[e + u] = ex2(BB[u]);
                }
#pragma unroll
                for (int ti = 0; ti < 2; ++ti) {
                    const float q0 = nul[ti] ? 0.f : qv[ti][e] * qscale, q1 = nul[ti] ? 0.f : qv[ti][e + 1] * qscale;
                    const float k0 = nul[ti] ? 0.f : kv[ti][e], k1 = nul[ti] ? 0.f : kv[ti][e + 1];
                    qd[ti][e >> 1] = cvtpk(q0 * ex2(bb[ti][0]), q1 * ex2(bb[ti][1]));
                    ki[ti][e >> 1] = cvtpk(k0 * ex2(-bb[ti][0]), k1 * ex2(-bb[ti][1]));
                    kd[ti][e >> 1] = cvtpk(k0 * ex2(BB[0] - bb[ti][0]), k1 * ex2(BB[1] - bb[ti][1]));
                }
            }
            const bf16x8 qf0 = mk8(qd[0][0], qd[0][1], qd[0][2], qd[0][3]), qf1 = mk8(qd[1][0], qd[1][1], qd[1][2], qd[1][3]);
            const bf16x8 kf0 = mk8(ki[0][0], ki[0][1], ki[0][2], ki[0][3]), kf1 = mk8(ki[1][0], ki[1][1], ki[1][2], ki[1][3]);
            pacc[0] = MFMA16(kf0, qf0, pacc[0]);
            pacc[1] = MFMA16(kf0, qf1, pacc[1]);
            pacc[2] = MFMA16(kf1, qf1, pacc[2]);
#pragma unroll
            for (int ti = 0; ti < 2; ++ti)
#pragma unroll
                for (int h2 = 0; h2 < 2; ++h2) {
                    const int lp = (2 * (g & 1) + h2) * 16 + r;
                    v2u d; d.x = qd[ti][2 * h2]; d.y = qd[ti][2 * h2 + 1];
                    *(GAS v2u*)(rec + R1_QD + ((ti * 16 + s) * 64 + lp) * 16 + (g >> 1) * 8) = d;
                }
#pragma unroll
            for (int ti = 0; ti < 2; ++ti)
#pragma unroll
                for (int e = 0; e < 8; ++e) {
                    const unsigned wd = kd[ti][e >> 1]; const unsigned short hv = (e & 1) ? (unsigned short)(wd >> 16) : (unsigned short)(wd & 0xffffu);
                    *(LAS unsigned short*)(T + (32 * si + 8 * g + e) * 64 + (16 * ti + r) * 2) = hv;
                }
            if (r == 0) { *(GAS f32x4*)(rec + R1_GL + (32 * s + 8 * g) * 4) = (f32x4){gl[0], gl[1], gl[2], gl[3]}; *(GAS f32x4*)(rec + R1_GL + (32 * s + 8 * g + 4) * 4) = (f32x4){gl[4], gl[5], gl[6], gl[7]}; }
        }
#pragma unroll
        for (int t = 0; t < 3; ++t) Pp[(w * 3 + t) * 64 + lane] = pacc[t];
        LDS_WAIT(); asm volatile("" ::: "memory");
#pragma unroll
        for (int ml = 0; ml < 4; ++ml) { const v4u d = *(const LAS v4u*)(T + (16 * ml + r) * 64 + 16 * g); *(GAS v4u*)(rec + R1_KD + ((4 * w + ml) * 64 + lane) * 16) = d; }
        __syncthreads();
        if (w < 4) {
            const int tj = (w == 2 || w == 3) ? 1 : 0, ti = (w == 1 || w == 2) ? 1 : 0;
            f32x4 sum = (f32x4){0.f, 0.f, 0.f, 0.f};
            if (w < 3) {
#pragma unroll
                for (int ww = 0; ww < 8; ++ww) sum += Pp[(ww * 3 + w) * 64 + lane];
            }
            float pv[4] = {sum.x, sum.y, sum.z, sum.w};
#pragma unroll
            for (int jj = 0; jj < 4; ++jj) { const int j = 16 * tj + 4 * g + jj, i = 16 * ti + r; if (j > i) pv[jj] = 0.f; }
            const int lp = (2 * tj + (g >> 1)) * 16 + r;
            v2u d; d.x = cvtpk(pv[0], pv[1]); d.y = cvtpk(pv[2], pv[3]);
            *(GAS v2u*)(rec + R1_P + (ti * 64 + lp) * 16 + 8 * (g & 1)) = d;
        }
        __syncthreads();
    }
}

template <int VAR> DI_ void l1_seq(Frame& F, const unsigned char* REC1, const unsigned char* VF1, float* O1, float* SS) {
    const int lane = F.lane, w = F.wave, r = lane & 15, g = lane >> 4;
    for (int u = F.vcu; u < NB * GL_H * 8; u += F.G) {
        const int bh = u >> 3, ds = u & 7, b = bh >> 3, h = bh & 7;
        f32x4 acc[32];
#pragma unroll
        for (int m = 0; m < 32; ++m) acc[m] = (f32x4){0.f, 0.f, 0.f, 0.f};
#define L1_DMA(c_) do { const unsigned char* rs_ = REC1 + (size_t)(bh * NCH + (c_)) * R1_SH; LAS unsigned char* st_ = F.lds + ((c_) & 1) * ST1; \
        for (int p_ = w; p_ < 76; p_ += 8) { const unsigned char* src_; \
            if (p_ < 68) src_ = rs_ + p_ * 1024 + lane * 16; \
            else { const int tk_ = 4 * (p_ - 68) + (lane >> 4);         \
                   src_ = ((c_) == 0 && tk_ < 16) ? (const unsigned char*)(F.H1B + (size_t)MR * D) + (lane & 15) * 16 \
                        : (const unsigned char*)(F.QFIZ + (size_t)row_of(b, (c_), tk_) * N1 + 8192 + h * 1024 + ds * 128) + (lane & 15) * 16; } \
            __builtin_amdgcn_global_load_lds((const unsigned*)src_, (LAS unsigned*)(st_ + p_ * 1024), 16, 0, 0); } } while (0)
        const int ycol = h * 1024 + ds * 128 + 16 * w + 4 * g;
        const f32x4 ng4 = *(const GAS f32x4*)(F.ng1 + ycol);
        const bf16* xz = F.QFIZ + (size_t)(b * SEQ - 32) * N1 + 16384 + ycol;
        v2u zc0 = (v2u){0u, 0u}, zc1 = zc0, zn0 = zc0, zn1 = zc0;
        if (VAR != 1) L1_DMA(0);
        for (int c = 0; c < NCH; ++c) {
            asm volatile("s_waitcnt vmcnt(0) lgkmcnt(0)" ::: "memory");
            __builtin_amdgcn_s_barrier();
            asm volatile("" ::: "memory");
            if (VAR != 1 && c + 1 < NCH) L1_DMA(c + 1);
            if (USE_FUSED_NORM && VAR == 0 && c >= 2 && w == 0 && lane < 32) {
                const LAS float* pp = (const LAS float*)(F.lds + SSP_OFF) + ((c - 1) & 1) * 256 + lane; float sm = 0.f;
#pragma unroll
                for (int ww = 0; ww < 8; ++ww) sm += pp[ww * 32];
                SS[(size_t)(b * SEQ + 32 * (c - 2) + lane) * 64 + h * 8 + ds] = sm; }
            if (USE_FUSED_NORM && c + 1 < NCH) { const bf16* zp = xz + (size_t)((c + 1) * 32 + r) * N1; zn0 = *(const GAS v2u*)zp; zn1 = *(const GAS v2u*)(zp + (size_t)16 * N1); }
            if (VAR == 2) continue;
            const LAS unsigned char* st = F.lds + (c & 1) * ST1;
            unsigned short vh[8];
#pragma unroll
            for (int e = 0; e < 8; ++e) vh[e] = *(const LAS unsigned short*)(st + R1_SH + (8 * g + e) * 256 + (16 * w + r) * 2);
            const bf16x8 vf = mk8(vh[0] | ((unsigned)vh[1] << 16), vh[2] | ((unsigned)vh[3] << 16), vh[4] | ((unsigned)vh[5] << 16), vh[6] | ((unsigned)vh[7] << 16));
#define SCHED_FENCE() __builtin_amdgcn_sched_barrier(0)
            if (c > 0) {
                f32x4 o0 = (f32x4){0.f, 0.f, 0.f, 0.f}, o1 = o0;
                bf16x8 qb[2][4];
#define LDQ(buf_, gi_) do { _Pragma("unroll") for (int sl_ = 0; sl_ < 2; ++sl_) { qb[buf_][sl_] = *(const LAS bf16x8*)(st + R1_QD + (2 * (gi_) + sl_) * 1024 + lane * 16); \
                    qb[buf_][2 + sl_] = *(const LAS bf16x8*)(st + R1_QD + (16 + 2 * (gi_) + sl_) * 1024 + lane * 16); } } while (0)
                const bf16x8 p0 = *(const LAS bf16x8*)(st + R1_P + lane * 16), p1 = *(const LAS bf16x8*)(st + R1_P + 1024 + lane * 16);
                LDQ(0, 0);
                SCHED_FENCE();
                o0 = MFMA16(vf, p0, o0); o1 = MFMA16(vf, p1, o1);
#pragma unroll
                for (int gi = 0; gi < 8; ++gi) {
                    if (gi < 7) LDQ((gi + 1) & 1, gi + 1);
                    SCHED_FENCE();
#pragma unroll
                    for (int sl = 0; sl < 2; ++sl) { const int s2 = 2 * gi + sl;
                        const bf16x8 sb = mk8(cvtpk(acc[2 * s2].x, acc[2 * s2].y), cvtpk(acc[2 * s2].z, acc[2 * s2].w), cvtpk(acc[2 * s2 + 1].x, acc[2 * s2 + 1].y), cvtpk(acc[2 * s2 + 1].z, acc[2 * s2 + 1].w));
                        o0 = MFMA16(sb, qb[gi & 1][sl], o0); o1 = MFMA16(sb, qb[gi & 1][2 + sl], o1); }
                    SCHED_FENCE();
                }
#undef LDQ
                if (VAR == 1) { asm volatile("" :: "v"(o0), "v"(o1)); } else if (USE_FUSED_NORM) {
                    float t0 = (o0.x * o0.x + o0.y * o0.y) + (o0.z * o0.z + o0.w * o0.w), t1 = (o1.x * o1.x + o1.y * o1.y) + (o1.z * o1.z + o1.w * o1.w);
                    t0 += __shfl_xor(t0, 16); t1 += __shfl_xor(t1, 16); t0 += __shfl_xor(t0, 32); t1 += __shfl_xor(t1, 32);
                    const int row0 = b * SEQ + 32 * (c - 1) + r;
                    if (g == 0) { LAS float* pp = (LAS float*)(F.lds + SSP_OFF) + ((c & 1) * 8 + w) * 32; pp[r] = t0; pp[16 + r] = t1; }
                    const float y0 = o0.x * ng4.x * silu(bflo(zc0.x)), y1 = o0.y * ng4.y * silu(bfhi(zc0.x)), y2 = o0.z * ng4.z * silu(bflo(zc0.y)), y3 = o0.w * ng4.w * silu(bfhi(zc0.y));
                    const float y4 = o1.x * ng4.x * silu(bflo(zc1.x)), y5 = o1.y * ng4.y * silu(bfhi(zc1.x)), y6 = o1.z * ng4.z * silu(bflo(zc1.y)), y7 = o1.w * ng4.w * silu(bfhi(zc1.y));
                    bf16* op = F.Y + (size_t)row0 * DI + ycol;
                    *(GAS v2u*)op = (v2u){cvtpk(y0, y1), cvtpk(y2, y3)}; *(GAS v2u*)(op + (size_t)16 * DI) = (v2u){cvtpk(y4, y5), cvtpk(y6, y7)};
                } else {
                    bf16* op = (bf16*)O1 + (size_t)(b * SEQ + 32 * (c - 1) + r) * DI + h * 1024 + ds * 128 + 16 * w + 4 * g;
                    *(GAS v2u*)op = (v2u){pk2(o0.x, o0.y), pk2(o0.z, o0.w)}; *(GAS v2u*)(op + (size_t)16 * DI) = (v2u){pk2(o1.x, o1.y), pk2(o1.z, o1.w)}; }
            }
            {
                f32x4 ug[2][4]; bf16x8 uk[2][4];
#define LDU(buf_, gi_) do { _Pragma("unroll") for (int ml_ = 0; ml_ < 4; ++ml_) { const int m_ = 4 * (gi_) + ml_; ug[buf_][ml_] = *(const LAS f32x4*)(st + R1_GL + (16 * m_ + 4 * g) * 4); \
                    uk[buf_][ml_] = *(const LAS bf16x8*)(st + R1_KD + m_ * 1024 + lane * 16); } } while (0)
                LDU(0, 0);
                SCHED_FENCE();
#pragma unroll
                for (int gi = 0; gi < 8; ++gi) {
                    if (gi < 7) LDU((gi + 1) & 1, gi + 1);
                    SCHED_FENCE();
#pragma unroll
                    for (int ml = 0; ml < 4; ++ml) { const int m = 4 * gi + ml; acc[m] = MFMA16(uk[gi & 1][ml], vf, acc[m] * ug[gi & 1][ml]); }
                    SCHED_FENCE();
                }
#undef LDU
            }
            if (USE_FUSED_NORM) { zc0 = zn0; zc1 = zn1; }
        }
#undef L1_DMA
        if (VAR == 1) { _Pragma("unroll") for (int m = 0; m < 32; ++m) asm volatile("" :: "v"(acc[m])); }
        asm volatile("s_waitcnt vmcnt(0) lgkmcnt(0)" ::: "memory");
        __builtin_amdgcn_s_barrier();
        if (USE_FUSED_NORM && VAR == 0 && w == 0 && lane < 32) {
            const LAS float* pp = (const LAS float*)(F.lds + SSP_OFF) + ((NCH - 1) & 1) * 256 + lane; float sm = 0.f;
#pragma unroll
            for (int ww = 0; ww < 8; ++ww) sm += pp[ww * 32];
            SS[(size_t)(b * SEQ + 32 * (NCH - 2) + lane) * 64 + h * 8 + ds] = sm; }
        asm volatile("s_waitcnt vmcnt(0) lgkmcnt(0)" ::: "memory");
    }
}

constexpr int R2_QD = 0, R2_KD = 32768, R2_P = 65536, R2_GL = 67584, ST2 = 69632, X2_OFF = 2 * ST2;
DI_ void l1_seq2(Frame& F, const unsigned char* REC1) {
    const int lane = F.lane, w = F.wave, r = lane & 15, g = lane >> 4, dkh = w >> 2, dvq = w & 3;
    for (int u = F.vcu; u < NB * GL_H * 8; u += F.G) {
        const int bh = u >> 3, ds = u & 7, b = bh >> 3, h = bh & 7;
        f32x4 acc[16][2];
#pragma unroll
        for (int m = 0; m < 16; ++m) { acc[m][0] = (f32x4){0.f, 0.f, 0.f, 0.f}; acc[m][1] = acc[m][0]; }
        const int vcol = 8192 + h * 1024 + ds * 128 + 32 * dvq + r;
        int voff[8];
#pragma unroll
        for (int e = 0; e < 8; ++e) voff[e] = (8 * g + e) * N1 + vcol;
        const bf16* xv = F.QFIZ + (size_t)(b * SEQ - 32) * N1;
#define VCH(c_) (((c_) == 0) ? F.QFIZ + (size_t)(MX - 16) * N1 : xv + (size_t)(c_) * 32 * N1)
#define L2_DMA(c_) do { const unsigned char* rs_ = REC1 + (size_t)(bh * NCH + (c_)) * R1_SH; LAS unsigned char* st_ = F.lds + ((c_) & 1) * ST2; \
        _Pragma("unroll") for (int i_ = 0; i_ < 8; ++i_) { const int p_ = w + 8 * i_; __builtin_amdgcn_global_load_lds((const unsigned*)(rs_ + p_ * 1024 + lane * 16), (LAS unsigned*)(st_ + p_ * 1024), 16, 0, 0); } \
        if (w < 4) __builtin_amdgcn_global_load_lds((const unsigned*)(rs_ + (w + 64) * 1024 + lane * 16), (LAS unsigned*)(st_ + (w + 64) * 1024), 16, 0, 0); } while (0)
#define L2_VLOAD(c_, set_) do { const bf16* vb_ = VCH(c_); _Pragma("unroll") for (int e_ = 0; e_ < 8; ++e_) { vr[set_][0][e_] = (unsigned)*(const GAS unsigned short*)(vb_ + voff[e_]); vr[set_][1][e_] = (unsigned)*(const GAS unsigned short*)(vb_ + voff[e_] + 16); } } while (0)
        unsigned vr[2][2][8];
        f32x4 keep[2][2];
        L2_DMA(0); L2_VLOAD(0, 0);
#define L2_BODY(C_, PAR) do { const int c = (C_); \
            asm volatile("s_waitcnt vmcnt(0)" ::: "memory"); \
            __builtin_amdgcn_s_barrier(); \
            asm volatile("" ::: "memory"); \
            if (c >= 2 && c <= NCH) {                                  \
                const v4u px = *(const LAS v4u*)(F.lds + X2_OFF + (PAR ^ 1) * 8192 + (w ^ 4) * 1024 + lane * 16); \
                const f32x4 a0 = keep[PAR ^ 1][0] + (f32x4){bflo(px.x), bfhi(px.x), bflo(px.y), bfhi(px.y)}, a1 = keep[PAR ^ 1][1] + (f32x4){bflo(px.z), bfhi(px.z), bflo(px.w), bfhi(px.w)}; \
                bf16* op = (bf16*)F.O1 + (size_t)(b * SEQ + 32 * (c - 2) + r) * DI + h * 1024 + ds * 128 + 32 * dvq + 16 * dkh + 4 * g; \
                *(GAS v2u*)op = (v2u){pk2(a0.x, a0.y), pk2(a0.z, a0.w)}; *(GAS v2u*)(op + (size_t)16 * DI) = (v2u){pk2(a1.x, a1.y), pk2(a1.z, a1.w)}; } \
            if (c + 1 < NCH) { L2_VLOAD(c + 1, PAR ^ 1); L2_DMA(c + 1); }          \
            if (c < NCH) { \
                const LAS unsigned char* st = F.lds + (c & 1) * ST2; \
                bf16x8 vf[2]; \
                _Pragma("unroll") for (int t_ = 0; t_ < 2; ++t_) { _Pragma("unroll") for (int e_ = 0; e_ < 8; ++e_) asm volatile("" : "+v"(vr[PAR][t_][e_]));     \
                    vf[t_] = mk8(vr[PAR][t_][0] | (vr[PAR][t_][1] << 16), vr[PAR][t_][2] | (vr[PAR][t_][3] << 16), vr[PAR][t_][4] | (vr[PAR][t_][5] << 16), vr[PAR][t_][6] | (vr[PAR][t_][7] << 16)); } \
                const LAS f32x4* glp = (const LAS f32x4*)(st + R2_GL + (256 * dkh + 4 * g) * 4); \
                f32x4 ug[2][2]; bf16x8 uk[2][2]; \
                if (c > 0) { \
                    f32x4 o[2][2]; \
                    _Pragma("unroll") for (int ti = 0; ti < 2; ++ti) { o[ti][0] = (f32x4){0.f, 0.f, 0.f, 0.f}; o[ti][1] = o[ti][0]; } \
                    if (dkh == 0) { const bf16x8 p0 = *(const LAS bf16x8*)(st + R2_P + lane * 16), p1 = *(const LAS bf16x8*)(st + R2_P + 1024 + lane * 16); \
                        o[0][0] = MFMA16(vf[0], p0, o[0][0]); o[0][1] = MFMA16(vf[1], p0, o[0][1]); o[1][0] = MFMA16(vf[0], p1, o[1][0]); o[1][1] = MFMA16(vf[1], p1, o[1][1]); } \
                    bf16x8 qb[2][2]; \
                    qb[0][0] = *(const LAS bf16x8*)(st + R2_QD + (8 * dkh) * 1024 + lane * 16); qb[0][1] = *(const LAS bf16x8*)(st + R2_QD + (16 + 8 * dkh) * 1024 + lane * 16); \
                    SCHED_FENCE(); \
                    _Pragma("unroll") for (int s2 = 0; s2 < 8; ++s2) { \
                        if (s2 < 7) { qb[(s2 + 1) & 1][0] = *(const LAS bf16x8*)(st + R2_QD + (8 * dkh + s2 + 1) * 1024 + lane * 16); qb[(s2 + 1) & 1][1] = *(const LAS bf16x8*)(st + R2_QD + (16 + 8 * dkh + s2 + 1) * 1024 + lane * 16); } \
                        SCHED_FENCE(); \
                        _Pragma("unroll") for (int t_ = 0; t_ < 2; ++t_) { \
                            const bf16x8 sb = mk8(cvtpk(acc[2 * s2][t_].x, acc[2 * s2][t_].y), cvtpk(acc[2 * s2][t_].z, acc[2 * s2][t_].w), cvtpk(acc[2 * s2 + 1][t_].x, acc[2 * s2 + 1][t_].y), cvtpk(acc[2 * s2 + 1][t_].z, acc[2 * s2 + 1][t_].w)); \
                            o[0][t_] = MFMA16(sb, qb[s2 & 1][0], o[0][t_]); o[1][t_] = MFMA16(sb, qb[s2 & 1][1], o[1][t_]); } \
                        SCHED_FENCE(); \
                    } \
                      \
                    { const f32x4 s0 = o[0][dkh ^ 1], s1 = o[1][dkh ^ 1]; \
                      *(LAS v4u*)(F.lds + X2_OFF + PAR * 8192 + w * 1024 + lane * 16) = (v4u){pk2(s0.x, s0.y), pk2(s0.z, s0.w), pk2(s1.x, s1.y), pk2(s1.z, s1.w)}; \
                      keep[PAR][0] = o[0][dkh]; keep[PAR][1] = o[1][dkh]; } \
                } \
                _Pragma("unroll") for (int ml_ = 0; ml_ < 2; ++ml_) { ug[0][ml_] = glp[4 * ml_]; uk[0][ml_] = *(const LAS bf16x8*)(st + R2_KD + (16 * dkh + ml_) * 1024 + lane * 16); } \
                SCHED_FENCE(); \
                _Pragma("unroll") for (int gi = 0; gi < 8; ++gi) { \
                    if (gi < 7) { _Pragma("unroll") for (int ml_ = 0; ml_ < 2; ++ml_) { const int m_ = 2 * (gi + 1) + ml_; ug[(gi + 1) & 1][ml_] = glp[4 * m_]; uk[(gi + 1) & 1][ml_] = *(const LAS bf16x8*)(st + R2_KD + (16 * dkh + m_) * 1024 + lane * 16); } } \
                    SCHED_FENCE(); \
                    _Pragma("unroll") for (int ml = 0; ml < 2; ++ml) { const int m = 2 * gi + ml; \
                        acc[m][0] = MFMA16(uk[gi & 1][ml], vf[0], acc[m][0] * ug[gi & 1][ml]); acc[m][1] = MFMA16(uk[gi & 1][ml], vf[1], acc[m][1] * ug[gi & 1][ml]); } \
                    SCHED_FENCE(); \
                } \
                asm volatile("s_waitcnt lgkmcnt(0)" ::: "memory"); \
            } \
        } while (0)
        for (int c2 = 0; c2 <= NCH; c2 += 2) { L2_BODY(c2, 0); L2_BODY(c2 + 1, 1); }
#undef L2_BODY
#undef L2_VLOAD
#undef L2_DMA
#undef VCH
        asm volatile("s_waitcnt vmcnt(0) lgkmcnt(0)" ::: "memory");
        __builtin_amdgcn_s_barrier();
    }
}

DI_ void l0_prep(Frame& F, unsigned char* REC0) {
    const int lane = F.lane, w = F.wave, r = lane & 15, g = lane >> 4;
    LAS unsigned char* T = F.lds + w * 16640;
    LAS unsigned char* Tv = T + 8192;
    const int gw = F.vcu * NWAVES + w, NGW = F.G * NWAVES;
    for (int it = gw; it < NB * HG_H * NCH; it += NGW) {
        const int bh = it / NCH, c = it - bh * NCH, b = bh >> 6, h = bh & 63;
        unsigned char* rec = REC0 + (size_t)it * R0_SZ;
        int row[2]; bool nul[2];
#pragma unroll
        for (int ti = 0; ti < 2; ++ti) { const int tok = 16 * ti + r; nul[ti] = (c == 0 && tok < 16); row[ti] = nul[ti] ? 0 : row_of(b, c, tok); }
        f32x4 pacc[3];
#pragma unroll
        for (int t = 0; t < 3; ++t) pacc[t] = (f32x4){0.f, 0.f, 0.f, 0.f};
        v4u qraw[4][2], fraw[4][2], vraw[8];
#pragma unroll
        for (int s = 0; s < 4; ++s)
#pragma unroll
            for (int ti = 0; ti < 2; ++ti) { const bf16* rp = F.QFIZ + (size_t)row[ti] * N0 + h * 128 + 32 * s + 8 * g; qraw[s][ti] = *(const GAS v4u*)rp; fraw[s][ti] = *(const GAS v4u*)(rp + DI); }
#pragma unroll
        for (int i = 0; i < 8; ++i) { const int q = lane + 64 * i, tk = q >> 4, c16 = q & 15; const bool nl = (c == 0 && tk < 16);
            vraw[i] = (v4u){0u, 0u, 0u, 0u}; if (!nl) vraw[i] = *(const GAS v4u*)(F.QFIZ + (size_t)row_of(b, c, tk) * N0 + 2 * DI + h * 128 + 8 * c16); }
        asm volatile("" ::: "memory");
#pragma unroll
        for (int s = 0; s < 4; ++s) {
            const int col = h * 128 + 32 * s + 8 * g;
            float lbv[8], bfv[8];
            { const f32x4 a0 = *(const GAS f32x4*)(F.LB0 + col), a1 = *(const GAS f32x4*)(F.LB0 + col + 4), c0 = *(const GAS f32x4*)(F.b_f + col), c1 = *(const GAS f32x4*)(F.b_f + col + 4);
              lbv[0] = a0.x; lbv[1] = a0.y; lbv[2] = a0.z; lbv[3] = a0.w; lbv[4] = a1.x; lbv[5] = a1.y; lbv[6] = a1.z; lbv[7] = a1.w;
              bfv[0] = c0.x; bfv[1] = c0.y; bfv[2] = c0.z; bfv[3] = c0.w; bfv[4] = c1.x; bfv[5] = c1.y; bfv[6] = c1.z; bfv[7] = c1.w; }
            float qv[2][8], fv[2][8];
#pragma unroll
            for (int ti = 0; ti < 2; ++ti) {
                const v4u q4 = qraw[s][ti], f4 = fraw[s][ti];
                qv[ti][0] = bflo(q4.x); qv[ti][1] = bfhi(q4.x); qv[ti][2] = bflo(q4.y); qv[ti][3] = bfhi(q4.y); qv[ti][4] = bflo(q4.z); qv[ti][5] = bfhi(q4.z); qv[ti][6] = bflo(q4.w); qv[ti][7] = bfhi(q4.w);
                fv[ti][0] = bflo(f4.x); fv[ti][1] = bfhi(f4.x); fv[ti][2] = bflo(f4.y); fv[ti][3] = bfhi(f4.y); fv[ti][4] = bflo(f4.z); fv[ti][5] = bfhi(f4.z); fv[ti][6] = bflo(f4.w); fv[ti][7] = bfhi(f4.w);
            }
            unsigned qd[2][4], ki[2][4], kd[2][4]; float gl[8];
#pragma unroll
            for (int e = 0; e < 8; e += 2) {
                float bb[2][2], BB[2], kk[2][2];
#pragma unroll
                for (int u = 0; u < 2; ++u) {
                    const float fg0 = lbv[e + u] + (1.f - lbv[e + u]) * sigm(fv[0][e + u] + bfv[e + u]);
                    const float fg1 = lbv[e + u] + (1.f - lbv[e + u]) * sigm(fv[1][e + u] + bfv[e + u]);
                    const float L0 = nul[0] ? 0.f : lg2(fg0), L1 = nul[1] ? 0.f : lg2(fg1);
                    kk[0][u] = nul[0] ? 0.f : 1.f - fg0; kk[1][u] = nul[1] ? 0.f : 1.f - fg1;
                    const float b0 = scan16(L0);
                    const float b1 = scan16(L1) + bcast15(b0);
                    bb[0][u] = b0; bb[1][u] = b1; BB[u] = bcast15(b1);
                    gl[e + u] = ex2(BB[u]);
                }
#pragma unroll
                for (int ti = 0; ti < 2; ++ti) {
                    const float q0 = nul[ti] ? 0.f : silu(qv[ti][e]), q1 = nul[ti] ? 0.f : silu(qv[ti][e + 1]);
                    qd[ti][e >> 1] = cvtpk(q0 * ex2(bb[ti][0]), q1 * ex2(bb[ti][1]));
                    ki[ti][e >> 1] = cvtpk(kk[ti][0] * ex2(-bb[ti][0]), kk[ti][1] * ex2(-bb[ti][1]));
                    kd[ti][e >> 1] = cvtpk(kk[ti][0] * ex2(BB[0] - bb[ti][0]), kk[ti][1] * ex2(BB[1] - bb[ti][1]));
                }
            }
            const bf16x8 qf0 = mk8(qd[0][0], qd[0][1], qd[0][2], qd[0][3]), qf1 = mk8(qd[1][0], qd[1][1], qd[1][2], qd[1][3]);
            const bf16x8 kf0 = mk8(ki[0][0], ki[0][1], ki[0][2], ki[0][3]), kf1 = mk8(ki[1][0], ki[1][1], ki[1][2], ki[1][3]);
            pacc[0] = MFMA16(kf0, qf0, pacc[0]);
            pacc[1] = MFMA16(kf0, qf1, pacc[1]);
            pacc[2] = MFMA16(kf1, qf1, pacc[2]);
#pragma unroll
            for (int ti = 0; ti < 2; ++ti)
#pragma unroll
                for (int h2 = 0; h2 < 2; ++h2) {
                    const int lp = (2 * (g & 1) + h2) * 16 + r;
                    v2u d; d.x = qd[ti][2 * h2]; d.y = qd[ti][2 * h2 + 1];
                    *(GAS v2u*)(rec + R0_QD + ((ti * 4 + s) * 64 + lp) * 16 + (g >> 1) * 8) = d;
                }
#pragma unroll
            for (int ti = 0; ti < 2; ++ti)
#pragma unroll
                for (int e = 0; e < 8; ++e) {
                    const unsigned wd = kd[ti][e >> 1]; const unsigned short hv = (e & 1) ? (unsigned short)(wd >> 16) : (unsigned short)(wd & 0xffffu);
                    *(LAS unsigned short*)(T + (32 * s + 8 * g + e) * 64 + (16 * ti + r) * 2) = hv;
                }
            if (r == 0) { *(GAS f32x4*)(rec + R0_GL + (32 * s + 8 * g) * 4) = (f32x4){gl[0], gl[1], gl[2], gl[3]}; *(GAS f32x4*)(rec + R0_GL + (32 * s + 8 * g + 4) * 4) = (f32x4){gl[4], gl[5], gl[6], gl[7]}; }
        }
#pragma unroll
        for (int t = 0; t < 4; ++t) {
            const int tj = (t >= 2) ? 1 : 0, ti = (t == 1 || t == 2) ? 1 : 0;
            float pv[4] = {0.f, 0.f, 0.f, 0.f};
            if (t < 3) { pv[0] = pacc[t].x; pv[1] = pacc[t].y; pv[2] = pacc[t].z; pv[3] = pacc[t].w; }
#pragma unroll
            for (int jj = 0; jj < 4; ++jj) { const int j = 16 * tj + 4 * g + jj, i = 16 * ti + r; if (j > i) pv[jj] = 0.f; }
            const int lp = (2 * tj + (g >> 1)) * 16 + r;
            v2u d; d.x = cvtpk(pv[0], pv[1]); d.y = cvtpk(pv[2], pv[3]);
            *(GAS v2u*)(rec + R0_P + (ti * 64 + lp) * 16 + 8 * (g & 1)) = d;
        }
#pragma unroll
        for (int i = 0; i < 8; ++i) {
            const int q = lane + 64 * i, tk = q >> 4, c16 = q & 15; const v4u d = vraw[i];
            *(LAS v2u*)(Tv + tk * 264 + c16 * 16) = (v2u){d.x, d.y}; *(LAS v2u*)(Tv + tk * 264 + c16 * 16 + 8) = (v2u){d.z, d.w};
        }
        LDS_WAIT(); asm volatile("" ::: "memory");
#pragma unroll
        for (int mt = 0; mt < 8; ++mt) { const v4u d = *(const LAS v4u*)(T + (16 * mt + r) * 64 + 16 * g); *(GAS v4u*)(rec + R0_KD + (mt * 64 + lane) * 16) = d; }
#pragma unroll
        for (int sl = 0; sl < 8; ++sl) {
            unsigned short hv[8];
#pragma unroll
            for (int e = 0; e < 8; ++e) hv[e] = *(const LAS unsigned short*)(Tv + (8 * g + e) * 264 + (16 * sl + r) * 2);
            v4u d; d.x = hv[0] | ((unsigned)hv[1] << 16); d.y = hv[2] | ((unsigned)hv[3] << 16); d.z = hv[4] | ((unsigned)hv[5] << 16); d.w = hv[6] | ((unsigned)hv[7] << 16);
            *(GAS v4u*)(rec + R0_V + (sl * 64 + lane) * 16) = d;
        }
        LDS_WAIT(); asm volatile("" ::: "memory");
    }
}

DI_ void l0_seq(Frame& F, const unsigned char* REC0) {
    const int lane = F.lane, w = F.wave, r = lane & 15, g = lane >> 4;
    LAS float* obuf = (LAS float*)(F.lds + 2 * ST0);
    constexpr int OB = 32 * 132;
    for (int u = F.vcu; u < NB * HG_H; u += F.G) {
        const int bh = u, b = bh >> 6, h = bh & 63;
        f32x4 acc[8];
#pragma unroll
        for (int m = 0; m < 8; ++m) acc[m] = (f32x4){0.f, 0.f, 0.f, 0.f};
        const int ntok = 4 * w + g, ndv = 8 * r;
        float ngv[8];
        { const f32x4 a0 = *(const GAS f32x4*)(F.ng0 + h * 128 + ndv), a1 = *(const GAS f32x4*)(F.ng0 + h * 128 + ndv + 4);
          ngv[0] = a0.x; ngv[1] = a0.y; ngv[2] = a0.z; ngv[3] = a0.w; ngv[4] = a1.x; ngv[5] = a1.y; ngv[6] = a1.z; ngv[7] = a1.w; }
#define L0_DMA(c_) do { const unsigned char* rs_ = REC0 + (size_t)(bh * NCH + (c_)) * R0_SZ; LAS unsigned char* st_ = F.lds + ((c_) & 1) * ST0; \
        for (int p_ = w; p_ < 27; p_ += 8) __builtin_amdgcn_global_load_lds((const unsigned*)(rs_ + p_ * 1024 + lane * 16), (LAS unsigned*)(st_ + p_ * 1024), 16, 0, 0); } while (0)
        L0_DMA(0);
        v4u zprev = (v4u){0u, 0u, 0u, 0u};
        for (int c = 0; c <= NCH; ++c) {
            asm volatile("s_waitcnt vmcnt(0)" ::: "memory");
            __builtin_amdgcn_s_barrier();
            asm volatile("" ::: "memory");
            if (c + 1 < NCH) L0_DMA(c + 1);
            v4u zcur = (v4u){0u, 0u, 0u, 0u};
            const bool zvalid = (c < NCH) && !(c == 0 && ntok < 16);
            if (zvalid) zcur = *(const GAS v4u*)(F.QFIZ + (size_t)row_of(b, c, ntok) * N0 + 3 * DI + h * 128 + ndv);
            if (c >= 1) {
                const int cp = c - 1;
                const LAS float* ob = obuf + (cp & 1) * OB + ntok * 132 + ndv;
                const f32x4 x0 = *(const LAS f32x4*)(ob), x1 = *(const LAS f32x4*)(ob + 4);
                float ss = (x0.x * x0.x + x0.y * x0.y) + (x0.z * x0.z + x0.w * x0.w) + (x1.x * x1.x + x1.y * x1.y) + (x1.z * x1.z + x1.w * x1.w);
                ss += __shfl_xor(ss, 8); ss += __shfl_xor(ss, 4); ss += __shfl_xor(ss, 2); ss += __shfl_xor(ss, 1);
                const float rs = rsqrtf(ss * (1.f / 128.f) + RMS_EPS);
                const bool wr = !(cp == 0 && (ntok < 16 || b != 0));
                if (wr) {
                    v4u d;
                    d.x = cvtpk(x0.x * rs * ngv[0] * silu(bflo(zprev.x)), x0.y * rs * ngv[1] * silu(bfhi(zprev.x)));
                    d.y = cvtpk(x0.z * rs * ngv[2] * silu(bflo(zprev.y)), x0.w * rs * ngv[3] * silu(bfhi(zprev.y)));
                    d.z = cvtpk(x1.x * rs * ngv[4] * silu(bflo(zprev.z)), x1.y * rs * ngv[5] * silu(bfhi(zprev.z)));
                    d.w = cvtpk(x1.z * rs * ngv[6] * silu(bflo(zprev.w)), x1.w * rs * ngv[7] * silu(bfhi(zprev.w)));
                    *(GAS v4u*)(F.Y + (size_t)row_of(b, cp, ntok) * DI + h * 128 + ndv) = d;
                }
            }
            zprev = zcur;
            if (c < NCH) {
                const LAS unsigned char* st = F.lds + (c & 1) * ST0;
                const bf16x8 vf = *(const LAS bf16x8*)(st + R0_V + w * 1024 + lane * 16);
                const bf16x8 p0 = *(const LAS bf16x8*)(st + R0_P + lane * 16), p1 = *(const LAS bf16x8*)(st + R0_P + 1024 + lane * 16);
                bf16x8 qf[8], kf[8]; f32x4 gf[8];
#pragma unroll
                for (int q = 0; q < 8; ++q) qf[q] = *(const LAS bf16x8*)(st + R0_QD + q * 1024 + lane * 16);
#pragma unroll
                for (int m = 0; m < 8; ++m) { gf[m] = *(const LAS f32x4*)(st + R0_GL + (16 * m + 4 * g) * 4); kf[m] = *(const LAS bf16x8*)(st + R0_KD + m * 1024 + lane * 16); }
                SCHED_FENCE();
                f32x4 o0 = (f32x4){0.f, 0.f, 0.f, 0.f}, o1 = o0;
                o0 = MFMA16(vf, p0, o0); o1 = MFMA16(vf, p1, o1);
#pragma unroll
                for (int s2 = 0; s2 < 4; ++s2) {
                    const bf16x8 sb = mk8(cvtpk(acc[2 * s2].x, acc[2 * s2].y), cvtpk(acc[2 * s2].z, acc[2 * s2].w), cvtpk(acc[2 * s2 + 1].x, acc[2 * s2 + 1].y), cvtpk(acc[2 * s2 + 1].z, acc[2 * s2 + 1].w));
                    o0 = MFMA16(sb, qf[s2], o0); o1 = MFMA16(sb, qf[4 + s2], o1);
                }
#pragma unroll
                for (int m = 0; m < 8; ++m) acc[m] = MFMA16(kf[m], vf, acc[m] * gf[m]);
                LAS float* ow = obuf + (c & 1) * OB + r * 132 + 16 * w + 4 * g;
                *(LAS f32x4*)ow = o0; *(LAS f32x4*)(ow + 16 * 132) = o1;
                asm volatile("s_waitcnt lgkmcnt(0)" ::: "memory");
            }
        }
#undef L0_DMA
        asm volatile("s_waitcnt vmcnt(0)" ::: "memory");
        __builtin_amdgcn_s_barrier();
    }
}

template <int KS, int MODE>
DI_ void skinny(Frame& F, const bf16* A, const bf16* Bt, int K, int n_first, int n_slices, bf16* Ob, int ldo, float* Of, const float* res) {
    const int lane = F.lane, w = F.wave, r = lane & 15, g = lane >> 4;
    constexpr int SPB = 8 / KS;
    const int kw = w % KS, sw = w / KS, klen = K / KS, kbeg = kw * klen;
    LAS f32x4* red = (LAS f32x4*)F.lds;
    for (int p = F.vcu; p * SPB < n_slices; p += F.G) {
        const int sl = p * SPB + sw, n0 = n_first + 16 * sl;
        f32x4 acc = (f32x4){0.f, 0.f, 0.f, 0.f};
        if (sl < n_slices) {
            const GAS v4u* bp = (const GAS v4u*)(Bt + (size_t)(n0 + r) * K + kbeg + 16 * g);
            const GAS v4u* ap = (const GAS v4u*)(A + (size_t)r * K + kbeg + 16 * g);
            for (int kk = 0; kk < klen; kk += 256) {
                v4u bv[8], av[8];
#pragma unroll
                for (int u = 0; u < 4; ++u) { bv[2 * u] = bp[(kk + 64 * u) / 8]; bv[2 * u + 1] = bp[(kk + 64 * u) / 8 + 1]; av[2 * u] = ap[(kk + 64 * u) / 8]; av[2 * u + 1] = ap[(kk + 64 * u) / 8 + 1]; }
                asm volatile("" ::: "memory");
#pragma unroll
                for (int u = 0; u < 8; ++u) acc = MFMA16(__builtin_bit_cast(bf16x8, bv[u]), __builtin_bit_cast(bf16x8, av[u]), acc);
            }
        }
        if (KS > 1) {
            red[w * 64 + lane] = acc;
            __syncthreads();
            if (kw == 0) {
#pragma unroll
                for (int j = 1; j < KS; ++j) acc += red[(w + j) * 64 + lane];
            }
        }
        if (kw == 0 && sl < n_slices) {
            if (MODE == 0) { v2u d; d.x = pk2(acc.x, acc.y); d.y = pk2(acc.z, acc.w); *(GAS v2u*)(Ob + (size_t)r * ldo + n0 + 4 * g) = d; }
            else { const f32x4 rv = *(const GAS f32x4*)(res + (size_t)r * D + n0 + 4 * g); *(GAS f32x4*)(Of + (size_t)r * D + n0 + 4 * g) = rv * ALPHA + acc; }
        }
        if (KS > 1) __syncthreads();
    }
    asm volatile("s_waitcnt vmcnt(0)" ::: "memory");
}

DI_ void gate_proj(Frame& F, const bf16* WG1T  ) {
    const int lane = F.lane, w = F.wave, r = lane & 15, g = lane >> 4, kw = w & 3, sw = w >> 2;
    LAS f32x4* red = (LAS f32x4*)F.lds;
    for (int p = F.vcu; 2 * p < MR / 16; p += F.G) {
        const int t = 2 * p + sw;
        f32x4 acc = (f32x4){0.f, 0.f, 0.f, 0.f};
        if (t < MR / 16) {
            const GAS v4u* wp = (const GAS v4u*)(WG1T + (size_t)r * D + 1024 * kw + 16 * g);
            const GAS v4u* hp = (const GAS v4u*)(F.H1B + (size_t)(16 * t + r) * D + 1024 * kw + 16 * g);
            for (int kk = 0; kk < 1024; kk += 256) {
                v4u wv[8], hv[8];
#pragma unroll
                for (int u = 0; u < 4; ++u) { wv[2 * u] = wp[(kk + 64 * u) / 8]; wv[2 * u + 1] = wp[(kk + 64 * u) / 8 + 1]; hv[2 * u] = hp[(kk + 64 * u) / 8]; hv[2 * u + 1] = hp[(kk + 64 * u) / 8 + 1]; }
                asm volatile("" ::: "memory");
#pragma unroll
                for (int u = 0; u < 8; ++u) acc = MFMA16(__builtin_bit_cast(bf16x8, wv[u]), __builtin_bit_cast(bf16x8, hv[u]), acc);
            }
        }
        red[w * 64 + lane] = acc;
        __syncthreads();
        if (kw == 0 && t < MR / 16) {
            acc += red[(w + 1) * 64 + lane]; acc += red[(w + 2) * 64 + lane]; acc += red[(w + 3) * 64 + lane];
            *(GAS f32x4*)(F.G1 + (size_t)(16 * t + r) * GL_R + 4 * g) = acc;
        }
        __syncthreads();
    }
    asm volatile("s_waitcnt vmcnt(0)" ::: "memory");
}

#ifndef USE_AUX
#define USE_AUX 0
#endif
struct AuxT { const float* src; bf16* dst; int N, K; };
DI_ AuxT aux_decode(Frame& F, int it, unsigned char* dummy) {
    constexpr int I_1 = (DI / 64) * (D / 32), I_2 = (D / 64) * (N1 / 32), I_3 = I_1, AUX_ITERS = (I_1 + I_2 + I_3) / (256 * NWAVES);
    static_assert((I_1 + I_2 + I_3) % (256 * NWAVES) == 0, "aux tiles divide over the waves");
    const int gw = F.vcu * NWAVES + F.wave;
    AuxT t;
    if (it >= AUX_ITERS || F.G != 256) { t.src = (const float*)(dummy + (size_t)gw * 8192); t.dst = (bf16*)(dummy + 32 * MiB + (size_t)gw * 8192); t.N = 32; t.K = 64; return t; }
    int r_ = it * (256 * NWAVES) + gw; const float* W; bf16* WT; int K, N;
    if (r_ < I_1) { W = F.w0out; WT = F.WT0OUT; K = DI; N = D; }
    else if (r_ < I_1 + I_2) { r_ -= I_1; W = F.w1in; WT = F.WT1IN; K = D; N = N1; }
    else { r_ -= I_1 + I_2; W = F.w1out; WT = F.WT1OUT; K = DI; N = D; }
    const int nblk = N / 32, kb = r_ / nblk, nb = r_ - kb * nblk;
    t.src = W + (size_t)(64 * kb) * N + 32 * nb; t.dst = WT + (size_t)(32 * nb) * K + 64 * kb; t.N = N; t.K = K; return t;
}
DI_ void aux_load(Frame& F, const AuxT& t, f32x4 (&wv)[8]) {
    const int rowi = F.lane >> 3, c4 = F.lane & 7;
#pragma unroll
    for (int i = 0; i < 8; ++i) wv[i] = *(const GAS f32x4*)(t.src + (size_t)(8 * i + rowi) * t.N + 4 * c4);
}
DI_ void aux_store(Frame& F, const AuxT& t, const f32x4 (&wv)[8], LAS unsigned char* scr  ) {
    const int lane = F.lane, rowi = lane >> 3, c4 = lane & 7;
#pragma unroll
    for (int i = 0; i < 8; ++i) { LAS unsigned* p = (LAS unsigned*)(scr + (8 * i + rowi) * 68 + c4 * 8); p[0] = cvtpk(wv[i].x, wv[i].y); p[1] = cvtpk(wv[i].z, wv[i].w); }
    LDS_WAIT(); asm volatile("" ::: "memory");
    const int kc = lane & 7;
#pragma unroll
    for (int j = 0; j < 4; ++j) { const int n = (lane >> 3) + 8 * j; unsigned short hv[8];
#pragma unroll
        for (int e = 0; e < 8; ++e) hv[e] = *(const LAS unsigned short*)(scr + (8 * kc + e) * 68 + n * 2);
        v4u o; o.x = hv[0] | ((unsigned)hv[1] << 16); o.y = hv[2] | ((unsigned)hv[3] << 16); o.z = hv[4] | ((unsigned)hv[5] << 16); o.w = hv[6] | ((unsigned)hv[7] << 16);
        *(GAS v4u*)(t.dst + (size_t)n * t.K + 8 * kc) = o; }
    LDS_WAIT(); asm volatile("" ::: "memory");
}

constexpr int F0_QD = 0, F0_KI = 8192, F0_T = 16384, F0_GL = 24576, F0_TV = 25088, F0_STG = 33536;
DI_ void f0_load(const bf16* cb, const int (&oq)[2], int ov, v2u (&q2)[2], v2u (&f2)[2], v4u& vraw) {
#pragma unroll
    for (int ti = 0; ti < 2; ++ti) { q2[ti] = *(const GAS v2u*)(cb + oq[ti]); f2[ti] = *(const GAS v2u*)(cb + oq[ti] + DI); }
    vraw = *(const GAS v4u*)(cb + ov);
}
DI_ void f0_prep(Frame& F, LAS unsigned char* st, const v2u (&q2)[2], const v2u (&f2)[2], const v4u& vraw, const f32x4& lb4, const f32x4& bf4) {
    const int lane = F.lane, w = F.wave, r = lane & 15, g = lane >> 4, ps = w >> 1, hf = w & 1;
    const float lbv[4] = {lb4.x, lb4.y, lb4.z, lb4.w}, bfv[4] = {bf4.x, bf4.y, bf4.z, bf4.w};
    float Lv[2][4], qq[2][4], kk[2][4];
#pragma unroll
    for (int ti = 0; ti < 2; ++ti) {
        const float qv[4] = {bflo(q2[ti].x), bfhi(q2[ti].x), bflo(q2[ti].y), bfhi(q2[ti].y)}, fv[4] = {bflo(f2[ti].x), bfhi(f2[ti].x), bflo(f2[ti].y), bfhi(f2[ti].y)};
#pragma unroll
        for (int x = 0; x < 4; ++x) { const float fg = lbv[x] + (1.f - lbv[x]) * sigm(fv[x] + bfv[x]);
            Lv[ti][x] = lg2(fg); kk[ti][x] = 1.f - fg; qq[ti][x] = silu(qv[x]); }
    }
    float qd[2][4], ki[2][4], kd[2][4], gl[4];
#pragma unroll
    for (int x = 0; x < 4; ++x) {
        const float b0 = scan16(Lv[0][x]);
        const float b1 = scan16(Lv[1][x]) + bcast15(b0);
        const float BB = bcast15(b1);
        gl[x] = ex2(BB);
        qd[0][x] = qq[0][x] * ex2(b0); ki[0][x] = kk[0][x] * ex2(-b0); kd[0][x] = ki[0][x] * gl[x];
        qd[1][x] = qq[1][x] * ex2(b1); ki[1][x] = kk[1][x] * ex2(-b1); kd[1][x] = ki[1][x] * gl[x];
    }
    const int lp = (2 * (g & 1) + hf) * 16 + r;
#pragma unroll
    for (int ti = 0; ti < 2; ++ti) {
        *(LAS v2u*)(st + F0_QD + ((ti * 4 + ps) * 64 + lp) * 16 + (g >> 1) * 8) = (v2u){cvtpk(qd[ti][0], qd[ti][1]), cvtpk(qd[ti][2], qd[ti][3])};
        *(LAS v2u*)(st + F0_KI + ((ti * 4 + ps) * 64 + lp) * 16 + (g >> 1) * 8) = (v2u){cvtpk(ki[ti][0], ki[ti][1]), cvtpk(ki[ti][2], ki[ti][3])};
        const unsigned k01 = cvtpk(kd[ti][0], kd[ti][1]), k23 = cvtpk(kd[ti][2], kd[ti][3]);
        LAS unsigned char* tp = st + F0_T + (32 * ps + 8 * g + 4 * hf) * 64 + (16 * ti + r) * 2;
        *(LAS unsigned short*)(tp) = (unsigned short)(k01 & 0xffffu); *(LAS unsigned short*)(tp + 64) = (unsigned short)(k01 >> 16);
        *(LAS unsigned short*)(tp + 128) = (unsigned short)(k23 & 0xffffu); *(LAS unsigned short*)(tp + 192) = (unsigned short)(k23 >> 16);
    }
    if (r == 0) *(LAS f32x4*)(st + F0_GL + (32 * ps + 8 * g + 4 * hf) * 4) = (f32x4){gl[0], gl[1], gl[2], gl[3]};
    { const int tk = 4 * w + (lane >> 4), c16 = lane & 15;
      *(LAS v2u*)(st + F0_TV + tk * 264 + c16 * 16) = (v2u){vraw.x, vraw.y}; *(LAS v2u*)(st + F0_TV + tk * 264 + c16 * 16 + 8) = (v2u){vraw.z, vraw.w}; }
}
DI_ void l0_fused(Frame& F, unsigned char* dummy) {
    const int lane = F.lane, w = F.wave, r = lane & 15, g = lane >> 4, ps = w >> 1, hf = w & 1;
    LAS float* obuf = (LAS float*)(F.lds + 2 * F0_STG);
    constexpr int OB = 32 * 132;
    for (int u = F.vcu; u < NB * HG_H; u += F.G) {
        const int bh = u, b = bh >> 6, h = bh & 63;
        f32x4 acc[8];
#pragma unroll
        for (int m = 0; m < 8; ++m) acc[m] = (f32x4){0.f, 0.f, 0.f, 0.f};
        const int ntok = 4 * w + g, ndv = 8 * r;
        float ngv[8];
        { const f32x4 a0 = *(const GAS f32x4*)(F.ng0 + h * 128 + ndv), a1 = *(const GAS f32x4*)(F.ng0 + h * 128 + ndv + 4);
          ngv[0] = a0.x; ngv[1] = a0.y; ngv[2] = a0.z; ngv[3] = a0.w; ngv[4] = a1.x; ngv[5] = a1.y; ngv[6] = a1.z; ngv[7] = a1.w; }
        const int colp = h * 128 + 32 * ps + 8 * g + 4 * hf;
        const f32x4 lb4 = *(const GAS f32x4*)(F.LB0 + colp), bf4 = *(const GAS f32x4*)(F.b_f + colp);
        v2u q2s[2][2], f2s[2][2]; v4u vrs[2];
        const int oq[2] = {r * N0 + colp, (16 + r) * N0 + colp};
        const int ov = (4 * w + (lane >> 4)) * N0 + 2 * DI + h * 128 + 8 * (lane & 15), oz = ntok * N0 + 3 * DI + h * 128 + ndv, oy = ntok * DI + h * 128 + ndv;
        const bf16* xq = F.QFIZ + (size_t)(b * SEQ - 32) * N0;
        bf16* xy = F.Y + (size_t)(b * SEQ - 32) * DI;
        bf16* y0 = (b == 0) ? F.Y0 : F.Y0 + (size_t)32 * DI;
#define QCH(c_) (((c_) == 0) ? (const bf16*)F.Q0 : xq + (size_t)(c_) * 32 * N0)
        f0_load(QCH(0), oq, ov, q2s[0], f2s[0], vrs[0]);
        f0_prep(F, F.lds, q2s[0], f2s[0], vrs[0], lb4, bf4);
        f0_load(QCH(1), oq, ov, q2s[1], f2s[1], vrs[1]);
        LAS unsigned char* ascr = F.lds + 2 * F0_STG + 33792 + w * 4352;
        f32x4 awv[8];
        v4u zs[2]; zs[0] = (v4u){0u, 0u, 0u, 0u}; zs[1] = zs[0];
#define F0_BODY(C_, PAR) do { const int c = (C_); \
            asm volatile("s_waitcnt lgkmcnt(0)" ::: "memory"); \
            __builtin_amdgcn_s_barrier(); \
            asm volatile("" ::: "memory"); \
            f0_load(QCH((c + 2 < NCH) ? c + 2 : NCH - 1), oq, ov, q2s[PAR], f2s[PAR], vrs[PAR]); \
            AuxT at_; if (USE_AUX) { at_ = aux_decode(F, c, dummy); aux_load(F, at_, awv); } \
            { const int cz = (c < NCH) ? c : NCH - 1; zs[PAR] = *(const GAS v4u*)(QCH(cz) + oz); } \
            { \
                const int cp = c - 1; \
                const LAS float* ob = obuf + (cp & 1) * OB + ntok * 132 + ndv; \
                const f32x4 x0 = *(const LAS f32x4*)(ob), x1 = *(const LAS f32x4*)(ob + 4); \
                float ss = (x0.x * x0.x + x0.y * x0.y) + (x0.z * x0.z + x0.w * x0.w) + (x1.x * x1.x + x1.y * x1.y) + (x1.z * x1.z + x1.w * x1.w); \
                ss = bcast15(scan16(ss)); \
                const float rs = rsqrtf(ss * (1.f / 128.f) + RMS_EPS); \
                bf16* yb = (cp <= 0) ? ((cp == 0) ? y0 : F.Y0 + (size_t)32 * DI) : xy + (size_t)cp * 32 * DI; \
                { \
                    v4u d; \
                    d.x = cvtpk(x0.x * rs * ngv[0] * silu(bflo(zs[PAR ^ 1].x)), x0.y * rs * ngv[1] * silu(bfhi(zs[PAR ^ 1].x))); \
                    d.y = cvtpk(x0.z * rs * ngv[2] * silu(bflo(zs[PAR ^ 1].y)), x0.w * rs * ngv[3] * silu(bfhi(zs[PAR ^ 1].y))); \
                    d.z = cvtpk(x1.x * rs * ngv[4] * silu(bflo(zs[PAR ^ 1].z)), x1.y * rs * ngv[5] * silu(bfhi(zs[PAR ^ 1].z))); \
                    d.w = cvtpk(x1.z * rs * ngv[6] * silu(bflo(zs[PAR ^ 1].w)), x1.w * rs * ngv[7] * silu(bfhi(zs[PAR ^ 1].w))); \
                    *(GAS v4u*)(yb + oy) = d; \
                } \
            } \
             \
            { \
                const LAS unsigned char* st = F.lds + (c & 1) * F0_STG; \
 \
                unsigned short hv[8]; \
                _Pragma("unroll") \
                for (int e = 0; e < 8; ++e) hv[e] = *(const LAS unsigned short*)(st + F0_TV + (16 * (e >> 2) + 4 * g + (e & 3)) * 264 + (16 * w + r) * 2); \
                const bf16x8 vf = mk8(hv[0] | ((unsigned)hv[1] << 16), hv[2] | ((unsigned)hv[3] << 16), hv[4] | ((unsigned)hv[5] << 16), hv[6] | ((unsigned)hv[7] << 16)); \
                bf16x8 qf[8], kf[8]; \
                _Pragma("unroll") \
                for (int q = 0; q < 8; ++q) { qf[q] = *(const LAS bf16x8*)(st + F0_QD + q * 1024 + lane * 16); kf[q] = *(const LAS bf16x8*)(st + F0_KI + q * 1024 + lane * 16); } \
                SCHED_FENCE(); \
 \
                f32x4 pt00 = (f32x4){0.f, 0.f, 0.f, 0.f}, pt01 = pt00, pt11 = pt00; \
                _Pragma("unroll") \
                for (int s2 = 0; s2 < 4; ++s2) { pt00 = MFMA16(kf[s2], qf[s2], pt00); pt01 = MFMA16(kf[s2], qf[4 + s2], pt01); pt11 = MFMA16(kf[4 + s2], qf[4 + s2], pt11); } \
                const bool m0 = (4 * g + 0 <= r), m1 = (4 * g + 1 <= r), m2 = (4 * g + 2 <= r), m3 = (4 * g + 3 <= r); \
 \
                                const bf16x8 pb0 = mk8(cvtpk(m0 ? pt00.x : 0.f, m1 ? pt00.y : 0.f), cvtpk(m2 ? pt00.z : 0.f, m3 ? pt00.w : 0.f), 0u, 0u); \
                const bf16x8 pb1 = mk8(pk2(pt01.x, pt01.y), pk2(pt01.z, pt01.w), cvtpk(m0 ? pt11.x : 0.f, m1 ? pt11.y : 0.f), cvtpk(m2 ? pt11.z : 0.f, m3 ? pt11.w : 0.f)); \
                f32x4 o0 = (f32x4){0.f, 0.f, 0.f, 0.f}, o1 = o0; \
                o0 = MFMA16(vf, pb0, o0); o1 = MFMA16(vf, pb1, o1); \
                _Pragma("unroll") \
                for (int s2 = 0; s2 < 4; ++s2) { \
                    const bf16x8 sb = mk8(cvtpk(acc[2 * s2].x, acc[2 * s2].y), cvtpk(acc[2 * s2].z, acc[2 * s2].w), cvtpk(acc[2 * s2 + 1].x, acc[2 * s2 + 1].y), cvtpk(acc[2 * s2 + 1].z, acc[2 * s2 + 1].w)); \
                    o0 = MFMA16(sb, qf[s2], o0); o1 = MFMA16(sb, qf[4 + s2], o1); \
                } \
                LAS float* ow = obuf + (c & 1) * OB + r * 132 + 16 * w + 4 * g; \
                *(LAS f32x4*)ow = o0; *(LAS f32x4*)(ow + 16 * 132) = o1; \
                f32x4 gf[8]; v2u klo[8], khi[8]; \
                _Pragma("unroll") \
                for (int m = 0; m < 8; ++m) { gf[m] = *(const LAS f32x4*)(st + F0_GL + (16 * m + 4 * g) * 4); \
                    klo[m] = *(const LAS v2u*)(st + F0_T + (16 * m + r) * 64 + 8 * g); khi[m] = *(const LAS v2u*)(st + F0_T + (16 * m + r) * 64 + 32 + 8 * g); } \
                SCHED_FENCE(); \
                _Pragma("unroll") \
                for (int m = 0; m < 8; ++m) acc[m] = MFMA16(mk8(klo[m].x, klo[m].y, khi[m].x, khi[m].y), vf, acc[m] * gf[m]); \
                SCHED_FENCE(); \
            } \
            f0_prep(F, F.lds + ((c + 1) & 1) * F0_STG, q2s[PAR ^ 1], f2s[PAR ^ 1], vrs[PAR ^ 1], lb4, bf4); \
            if (USE_AUX) aux_store(F, at_, awv, ascr); \
        } while (0)
        for (int c2 = 0; c2 <= NCH; c2 += 2) { F0_BODY(c2, 0); F0_BODY(c2 + 1, 1); }
#undef F0_BODY
#undef QCH
        asm volatile("s_waitcnt vmcnt(0) lgkmcnt(0)" ::: "memory");
        __builtin_amdgcn_s_barrier();
    }
}

struct Args { const float* in[17]; float* out; unsigned char* ws; int ph_lo, ph_hi, li, pad; };
__global__ void __launch_bounds__(NWAVES * 64, 2) mk_fwd(Args args) {
    extern __shared__ __attribute__((aligned(16))) unsigned char lds[];
    Frame F;
    F.lds = (LAS unsigned char*)lds;
    F.MISC = (volatile LAS unsigned*)(F.lds + MISC_OFF);
    F.tid = threadIdx.x; F.lane = F.tid & 63; F.wave = __builtin_amdgcn_readfirstlane(F.tid >> 6);
    F.G = gridDim.x; { const int bx = blockIdx.x; F.vcu = (F.G % 8 == 0) ? (bx % 8) * (F.G / 8) + bx / 8 : bx; }
    unsigned char* ws = args.ws;
    F.ctl = (gu32*)(ws + WS_CTL);
    F.x = args.in[0]; F.meta = args.in[1]; F.lb_logits = args.in[2];
    F.w0in = args.in[3]; F.b_f = args.in[4]; F.ng0 = args.in[5]; F.w0out = args.in[6]; F.ln0g = args.in[7]; F.ln0b = args.in[8];
    F.w1in = args.in[9]; F.wg1 = args.in[10]; F.wg2 = args.in[11]; F.b_g = args.in[12]; F.ng1 = args.in[13]; F.w1out = args.in[14]; F.ln1g = args.in[15]; F.ln1b = args.in[16];
    F.out = args.out;
    F.LB0 = (float*)(ws + WS_LB0); F.G1 = (float*)(ws + WS_G1); F.PRE = (float*)(ws + WS_PRE); F.O1 = (float*)(ws + WS_O1); F.WG1T = (bf16*)(ws + WS_WG1T); F.W2F = (bf16*)(ws + WS_W2F); F.SS = (float*)(ws + WS_REC + 525 * MiB); F.Q0 = (bf16*)(ws + WS_Q0); F.Y0 = (bf16*)(ws + WS_Y0); F.REC0 = ws + WS_REC; F.REC1 = ws + WS_REC1; F.VF1 = ws + WS_VF1;
    F.WT0IN = (bf16*)(ws + WS_WT0IN); F.WT0OUT = (bf16*)(ws + WS_WT0OUT); F.WT1IN = (bf16*)(ws + WS_WT1IN); F.WT1OUT = (bf16*)(ws + WS_WT1OUT);
    F.XB = (bf16*)(ws + WS_XB); F.H1B = (bf16*)(ws + WS_H1B); F.QFIZ = (bf16*)(ws + WS_QFIZ); F.Y = (bf16*)(ws + WS_Y);
    for (int u = F.tid; u < (LDS_BYTES - LDSCTL_OFF) / 4; u += NWAVES * 64) ((LAS unsigned*)(F.lds + LDSCTL_OFF))[u] = 0u;
    __syncthreads();
    int vb = (int)blockIdx.x;
    if (USE_TICKETS && N_LAUNCHES == 1 && (F.G % 8) == 0) {
        if (F.tid == 0) {
            const unsigned per = (unsigned)F.G / 8u; unsigned x = xb_xcc_id() & 7u, got = 0xffffffffu;
            for (unsigned tr = 0; tr < 8u; ++tr) { const unsigned y = (x + tr) & 7u; const unsigned t = xb_add((unsigned*)(F.ctl + CW_POOL) + 64 * y, 1u); if (t < per) { got = y + 8u * t; break; } }
            F.MISC[12] = (got == 0xffffffffu) ? blockIdx.x : got;
        }
        __syncthreads();
        vb = (int)F.MISC[12];
    }
    { F.vcu = (F.G % 8 == 0) ? (vb % 8) * (F.G / 8) + vb / 8 : vb; }
    XcdBarrier bar; bar.bar = (unsigned*)(F.ctl + CW_BAR); bar.x = 0; bar.st = nullptr;
    if (N_LAUNCHES == 1) bar = xcd_barrier_post((unsigned*)(F.ctl + CW_BAR), F.MISC + 8);
#define GRID_BAR() do { if (N_LAUNCHES == 1) xcd_barrier(bar); } while (0)
    const int lo = args.ph_lo, hi = args.ph_hi;
    unsigned long long pclk0 = 0, pclkn = 0; (void)pclk0;
    unsigned long long st_prev = STAMP_MASK ? __builtin_amdgcn_s_memrealtime() : 0ull, st_acc = 0ull;
#define STAMP(k) do { if (STAMP_MASK) { const unsigned long long t_ = __builtin_amdgcn_s_memrealtime(); if ((STAMP_MASK >> (k)) & 1) st_acc += t_ - st_prev; st_prev = t_; } } while (0)
#ifdef ONLY_PHASE
#define IN(k) ((k) == ONLY_PHASE && lo <= (k) && (k) < hi)
#else
#define IN(k) (lo <= (k) && (k) < hi)
#endif
#define BOTH(k) (IN(k) && IN((k) + 1))

    if (IN(0)) { for (int rep = 0; rep < REP(0); ++rep) { p0_prologue(F); if (rep + 1 < REP(0)) GRID_BAR(); } if (BOTH(0)) GRID_BAR(); }
    STAMP(0);
    if (IN(1)) {
        if (!(P0_META_FOLD && F.G == 256)) skinny<1, 0>(F, F.XB + (size_t)MX * D, F.WT0IN, D, 0, N0 / 16, (USE_L0_MFMA == 2) ? F.Q0 + (size_t)16 * N0 : F.QFIZ + (size_t)MX * N0, N0, nullptr, nullptr);
        pg8::Gemm g{F.XB, F.WT0IN, MX, N0, D}; pg8::StaticOrder S; S.init(MX, N0, F.G, vb);
        pg8::EpiBf16<0> E{F.QFIZ, N0, nullptr, 0, 0, 1.f};
        if (PROBE_CLK == 1) pclk0 = __builtin_amdgcn_s_memtime();
        for (int rep = 0; rep < REP(1); ++rep) { pg8::gemm_phase<pg8::EpiBf16<0>, pg8::StaticOrder, PG8_ALIGN, PG8_SP2>(F.lds + RING_OFF, g, S, E); if (rep + 1 < REP(1)) GRID_BAR(); }
        if (PROBE_CLK == 1) pclkn = __builtin_amdgcn_s_memtime() - pclk0;
        if (BOTH(1)) GRID_BAR();
    }
    STAMP(1);
#if USE_L0_MFMA == 2
    STAMP(2);
    if (IN(3)) { for (int rep = 0; rep < REP(3); ++rep) { l0_fused(F, F.REC0); if (rep + 1 < REP(3)) GRID_BAR(); } if (BOTH(3)) GRID_BAR(); }
#elif USE_L0_MFMA
    if (IN(2)) { for (int rep = 0; rep < REP(2); ++rep) { l0_prep(F, F.REC0); if (rep + 1 < REP(2)) GRID_BAR(); } if (BOTH(2)) GRID_BAR(); }
    STAMP(2);
    if (IN(3)) { for (int rep = 0; rep < REP(3); ++rep) { l0_seq(F, F.REC0); if (rep + 1 < REP(3)) GRID_BAR(); } if (BOTH(3)) GRID_BAR(); }
#else
    if (IN(2)) { if (BOTH(2)) GRID_BAR(); }
    if (IN(3)) { for (int rep = 0; rep < REP(3); ++rep) { p2_l0_rec_naive(F); if (rep + 1 < REP(3)) GRID_BAR(); } if (BOTH(3)) GRID_BAR(); }
#endif
    STAMP(3);
    if (IN(4)) {
        skinny<4, 1>(F, (USE_L0_MFMA == 2) ? F.Y0 + (size_t)16 * DI : F.Y + (size_t)MX * DI, F.WT0OUT, DI, 0, D / 16, nullptr, 0, F.PRE + (size_t)MX * D, F.meta);
        pg8::Gemm g{F.Y, F.WT0OUT, MX, D, DI}; pg8::StaticOrder S; S.init(MX, D, F.G, vb);
        pg8::EpiResid E{F.PRE, D, F.x, F.meta, MX, MX, ALPHA};
        for (int rep = 0; rep < REP(4); ++rep) { pg8::gemm_phase<pg8::EpiResid, pg8::StaticOrder, PG8_ALIGN, PG8_SP2>(F.lds + RING_OFF, g, S, E); if (rep + 1 < REP(4)) GRID_BAR(); }
        if (BOTH(4)) GRID_BAR();
    }
    STAMP(4);
    if (IN(5)) { for (int rep = 0; rep < REP(5); ++rep) { ln_phase(F, F.PRE, MR, F.ln0g, F.ln0b, F.PRE, F.H1B, nullptr); if (rep + 1 < REP(5)) GRID_BAR(); } if (BOTH(5)) GRID_BAR(); }
    STAMP(5);
    if (IN(6)) {
        gate_proj(F, F.WG1T);
        skinny<2, 0>(F, F.H1B + (size_t)MX * D, F.WT1IN, D, 4096, (N1 - 4096 - DI) / 16, F.QFIZ + (size_t)MX * N1, N1, nullptr, nullptr);
        pg8::Gemm g{F.H1B, F.WT1IN, MX, N1, D}; pg8::StaticOrder S; S.init(MX, N1, F.G, vb);
        pg8::EpiBf16<0> E{F.QFIZ, N1, nullptr, 0, 0, 1.f};
        for (int rep = 0; rep < REP(6); ++rep) { pg8::gemm_phase<pg8::EpiBf16<0>, pg8::StaticOrder, PG8_ALIGN, PG8_SP2>(F.lds + RING_OFF, g, S, E); if (rep + 1 < REP(6)) GRID_BAR(); }
        if (BOTH(6)) GRID_BAR();
    }
    STAMP(6);
#if USE_L1_MFMA
    if (IN(7)) { for (int rep = 0; rep < REP(7); ++rep) { l1_prep(F, F.REC1, F.VF1, F.W2F); if (rep + 1 < REP(7)) GRID_BAR(); } if (BOTH(7)) GRID_BAR(); }
    STAMP(7);
#if USE_L1_SEQ2
    if (IN(8)) { l1_seq2(F, F.REC1); if (BOTH(8)) GRID_BAR(); }
#else
    if (IN(8)) { l1_seq<0>(F, F.REC1, F.VF1, F.O1, F.SS); if (REP(8) > 1) { GRID_BAR(); l1_seq<PROBE_VAR>(F, F.REC1, F.VF1, F.O1, F.SS); } if (BOTH(8)) GRID_BAR(); }
#endif
#else
    if (IN(7)) { if (BOTH(7)) GRID_BAR(); }
    if (IN(8)) { for (int rep = 0; rep < REP(8); ++rep) { p6_l1_rec_naive(F); if (rep + 1 < REP(8)) GRID_BAR(); } if (BOTH(8)) GRID_BAR(); }
#endif
    STAMP(8);
#if !(USE_FUSED_NORM && USE_L1_MFMA && !USE_L1_SEQ2)
    if (IN(9)) { for (int rep = 0; rep < REP(9); ++rep) { p7_normgate(F); if (rep + 1 < REP(9)) GRID_BAR(); } if (BOTH(9)) GRID_BAR(); }
#endif
    STAMP(9);
    if (IN(10)) {
        pg8::Gemm g{F.Y, F.WT1OUT, MX, D, DI}; pg8::StaticOrder S; S.init(MX, D, F.G, vb);
#if USE_FUSED_NORM && USE_L1_MFMA && !USE_L1_SEQ2
        pg8::EpiResidScale E{F.PRE, D, F.PRE, ALPHA, F.SS, RMS_EPS};
        for (int rep = 0; rep < REP(10); ++rep) { pg8::gemm_phase<pg8::EpiResidScale, pg8::StaticOrder, PG8_ALIGN, PG8_SP2>(F.lds + RING_OFF, g, S, E); if (rep + 1 < REP(10)) GRID_BAR(); }
#else
        pg8::EpiResid E{F.PRE, D, F.PRE, F.PRE, MX, MX, ALPHA};
        if (PROBE_CLK == 10) pclk0 = __builtin_amdgcn_s_memtime();
        for (int rep = 0; rep < REP(10); ++rep) { pg8::gemm_phase<pg8::EpiResid, pg8::StaticOrder, PG8_ALIGN, PG8_SP2>(F.lds + RING_OFF, g, S, E); if (rep + 1 < REP(10)) GRID_BAR(); }
        if (PROBE_CLK == 10) pclkn = __builtin_amdgcn_s_memtime() - pclk0;
#endif
        if (BOTH(10)) GRID_BAR();
    }
    STAMP(10);
    if (IN(11)) { for (int rep = 0; rep < REP(11); ++rep) { ln_phase(F, F.PRE, MX, F.ln1g, F.ln1b, F.out, nullptr, nullptr); if (rep + 1 < REP(11)) GRID_BAR(); } }
    STAMP(11);
    if (STAMP_MASK && blockIdx.x == 0 && F.tid == 0) { const unsigned long long t0 = __builtin_amdgcn_s_memrealtime(); while (__builtin_amdgcn_s_memrealtime() - t0 < st_acc) __builtin_amdgcn_s_sleep(8); }
    if (PROBE_CLK && blockIdx.x == 0 && F.tid == 0) { const unsigned long long t0 = __builtin_amdgcn_s_memrealtime(); while (__builtin_amdgcn_s_memrealtime() - t0 < pclkn / (PROBE_CLK == 10 ? 10ull : 100ull)) __builtin_amdgcn_s_sleep(8); }
#undef IN
#undef BOTH
}

extern "C" void kernel_launch(void* const* d_in, const int* in_sizes, int n_in, void* d_out, int out_size, void* d_ws, size_t ws_size, hipStream_t stream) {
    static int grid = 0;
    if (grid == 0) {
        if (n_in != 17 || in_sizes[0] != MX * D || out_size != MX * D || ws_size < WS_END) { fprintf(stderr, "kernel_launch: unexpected problem (n_in %d, in0 %d, out %d, ws %zu < %zu); nothing launched\n", n_in, n_in > 0 ? in_sizes[0] : -1, out_size, ws_size, (size_t)WS_END); grid = -1; return; }
        int dev = 0, cus = 0, per_cu = 0;
        if (hipGetDevice(&dev) != hipSuccess || hipDeviceGetAttribute(&cus, hipDeviceAttributeMultiprocessorCount, dev) != hipSuccess) { fprintf(stderr, "kernel_launch: device query failed\n"); grid = -1; return; }
        if (hipFuncSetAttribute((const void*)mk_fwd, hipFuncAttributeMaxDynamicSharedMemorySize, LDS_BYTES) != hipSuccess) { fprintf(stderr, "kernel_launch: hipFuncSetAttribute failed\n"); grid = -1; return; }
        if (hipOccupancyMaxActiveBlocksPerMultiprocessor(&per_cu, (const void*)mk_fwd, NWAVES * 64, LDS_BYTES) != hipSuccess || per_cu < 1)
            fprintf(stderr, "kernel_launch: note: occupancy query reports %d workgroups per CU\n", per_cu);
        (void)hipGetLastError();
        grid = cus;
    }
    if (grid < 0) return;
    if (hipMemsetAsync((char*)d_ws + WS_CTL, 0, CTL_ZERO_BYTES, stream) != hipSuccess) { fprintf(stderr, "kernel_launch: memset failed\n"); return; }
    Args a{};
    for (int i = 0; i < 17; ++i) a.in[i] = (const float*)d_in[i];
    a.out = (float*)d_out; a.ws = (unsigned char*)d_ws;
    for (int li = 0; li < N_LAUNCHES; ++li) {
        a.ph_lo = (N_LAUNCHES == 1) ? 0 : li; a.ph_hi = (N_LAUNCHES == 1) ? PER_PHASE : li + 1; a.li = li; a.pad = 0;
        hipLaunchKernelGGL(mk_fwd, dim3(grid), dim3(NWAVES * 64), LDS_BYTES, stream, a);
        const hipError_t le = hipPeekAtLastError();
        if (le != hipSuccess) { fprintf(stderr, "kernel_launch: launch %d failed: %s\n", li, hipGetErrorName(le)); break; }
    }
}
```

```cpp
#include <hip/hip_runtime.h>
#include <cstdio>
#include <cstdint>
#define MK_N_LAUNCHES 1
#define USE_L0_MFMA 2
#define USE_L1_MFMA 1
namespace pg8 {
#define PG8_LAS __attribute__((address_space(3)))
typedef unsigned short bf16_t;
typedef short bf16x8 __attribute__((ext_vector_type(8)));
typedef float f32x4 __attribute__((ext_vector_type(4)));
typedef unsigned u32x4 __attribute__((ext_vector_type(4)));
constexpr int BM = 256, BK = 64, HALF = 128, HTB = HALF * BK * 2  , STAGE_BYTES = 8 * HTB, NXCD = 8, WGM = 8;

__host__ __device__ __forceinline__ int lds_byte(int r, int c) { const int st = (r >> 4) * 2 + (c >> 5), rr = r & 15, cc = c & 31, ob = rr * 64 + cc * 2; return st * 1024 + (ob ^ (((ob >> 9) & 1) << 5)); }
__host__ __device__ __forceinline__ void stage_rc(int b, int& R, int& C) { const int st = b / 1024, sb = b % 1024, swz = sb ^ (((sb >> 9) & 1) << 5); R = (st >> 1) * 16 + swz / 64; C = (st & 1) * 32 + (swz % 64) / 2; }
__host__ __device__ __forceinline__ int perm32(int rho) { const int n = rho >> 4, i = rho & 15; return 8 * (i >> 2) + 4 * n + (i & 3); }

struct Unit { int pm, pn; };
struct Gemm { const bf16_t* A; const bf16_t* Bt; int M, N, K; };

struct StaticOrder {
    int nM, nN, nwg, G, c;
    __host__ __device__ void init(int M, int N, int G_, int c_) { nM = M / BM; nN = N / BM; nwg = nM * nN; G = G_; c = c_; }
    __host__ __device__ bool next(int i, Unit& u) const {
        const long L = (long)i * G + c; if (L >= nwg) return false;
        int wgid = (int)L; { const int q = nwg / NXCD, r = nwg % NXCD, xcd = wgid % NXCD, off = wgid / NXCD; wgid = (xcd < r ? xcd * (q + 1) : r * (q + 1) + (xcd - r) * q) + off; }
        const int nig = WGM * nN, gid = wgid / nig, fm = gid * WGM, gsz = (nM - fm) < WGM ? (nM - fm) : WGM;
        u.pm = fm + ((wgid % nig) % gsz); u.pn = (wgid % nig) / gsz; return true;
    }
    __device__ __forceinline__ void a_ready(const Unit&) const {}
    __device__ __forceinline__ void done(const Unit&) const {}
};

__device__ __forceinline__ unsigned cvt_pk_bf16(float lo, float hi) { unsigned r; asm volatile("v_cvt_pk_bf16_f32 %0, %1, %2" : "=v"(r) : "v"(lo), "v"(hi)); return r; }
typedef float f32x2 __attribute__((ext_vector_type(2)));
__device__ __forceinline__ f32x2 gelu_pk(f32x2 v) {
    const f32x2 av = __builtin_elementwise_abs(v), d = av * 0.2316418882f + 1.0f;
    f32x2 t; t.x = __builtin_amdgcn_rcpf(d.x); t.y = __builtin_amdgcn_rcpf(d.y);
    f32x2 q = t * 0.5307027145f + (-0.7265760135f); q = q * t + 0.7107068705f; q = q * t + (-0.142248368f); q = q * t + 0.127414796f; q = q * t;
    const f32x2 s = (v * v) * (-0.72134752044f);
    f32x2 e; e.x = __builtin_amdgcn_exp2f(s.x); e.y = __builtin_amdgcn_exp2f(s.y);
    const f32x2 m = v * (q * e), r = v - m;
    f32x2 o; o.x = v.x < 0.f ? m.x : r.x; o.y = v.y < 0.f ? m.y : r.y; return o;
}

template <int ACT  > struct EpiBf16 {
    static constexpr bool PERM = true, AFTER_DRAIN = false, KHOOK = false; static_assert(ACT == 0 || ACT == 1, "EpiBf16: ACT is 0 (none) or 1 (gelu_pk)");
    bf16_t* O; int ldc; const float* bias; int split_cols; size_t split_stride; float scale0;
    __device__ __forceinline__ void operator()(const f32x4 (&acc)[2][2][4][2], const Unit& u, int wr, int wc, int fr, int fq) const {
        const int row0 = u.pm * BM + wr * 64 + fr; int colt = u.pn * BM; bf16_t* base = O;
        float sc = 1.f; if (split_cols) { const int t = colt / split_cols; base += (size_t)t * split_stride; colt -= t * split_cols; if (t == 0) sc = scale0; }
        const int col0 = colt + wc * 32 + 8 * fq, bcol0 = u.pn * BM + wc * 32 + 8 * fq;
        f32x4 bv[2][2];
#pragma unroll
        for (int bj = 0; bj < 2; ++bj)
#pragma unroll
            for (int n = 0; n < 2; ++n) bv[bj][n] = bias ? *(const f32x4*)(bias + bcol0 + bj * HALF + 4 * n) : (f32x4){0.f, 0.f, 0.f, 0.f};
#pragma unroll
        for (int ai = 0; ai < 2; ++ai)
#pragma unroll
            for (int m = 0; m < 4; ++m) { bf16_t* rowp = base + (size_t)(row0 + ai * HALF + m * 16) * ldc + col0;
#pragma unroll
                for (int bj = 0; bj < 2; ++bj) { f32x4 v0 = acc[ai][bj][m][0] + bv[bj][0], v1 = acc[ai][bj][m][1] + bv[bj][1];
                    if (ACT == 1) { f32x2 a = gelu_pk((f32x2){v0[0], v0[1]}), b = gelu_pk((f32x2){v0[2], v0[3]}), c = gelu_pk((f32x2){v1[0], v1[1]}), d = gelu_pk((f32x2){v1[2], v1[3]});
                        v0 = (f32x4){a.x, a.y, b.x, b.y}; v1 = (f32x4){c.x, c.y, d.x, d.y}; }
                    v0 = v0 * sc; v1 = v1 * sc; u32x4 w; w.x = cvt_pk_bf16(v0[0], v0[1]); w.y = cvt_pk_bf16(v0[2], v0[3]); w.z = cvt_pk_bf16(v1[0], v1[1]); w.w = cvt_pk_bf16(v1[2], v1[3]);
                    *(u32x4*)(rowp + bj * HALF) = w; } }
    }
};
struct EpiResid {
    static constexpr bool PERM = false, AFTER_DRAIN = false, KHOOK = false;
    float* C; int ldc; const float* resA; const float* resB; int rowsA; int rowsValid; float alpha;
    __device__ __forceinline__ void operator()(const f32x4 (&acc)[2][2][4][2], const Unit& u, int wr, int wc, int fr, int fq) const {
        const int row0 = u.pm * BM + wr * 64 + fr, col0 = u.pn * BM + wc * 32 + 4 * fq;
#pragma unroll
        for (int ai = 0; ai < 2; ++ai)
#pragma unroll
            for (int m = 0; m < 4; ++m) { const int r = row0 + ai * HALF + m * 16;
                if (r < rowsValid) {
                    const float* rp = (r < rowsA) ? resA + (size_t)r * ldc + col0 : resB + (size_t)(r - rowsA) * ldc + col0;
                    float* cp = C + (size_t)r * ldc + col0;
#pragma unroll
                    for (int bj = 0; bj < 2; ++bj)
#pragma unroll
                        for (int n = 0; n < 2; ++n) { const f32x4 rv = *(const f32x4*)(rp + bj * HALF + n * 16); *(f32x4*)(cp + bj * HALF + n * 16) = rv * alpha + acc[ai][bj][m][n]; } }
                asm volatile("" ::: "memory"); }
    }
};

struct EpiResidScale {
    static constexpr bool PERM = false, AFTER_DRAIN = false, KHOOK = true;
    float* C; int ldc; const float* res; float alpha; const float* SS; float eps;
    __device__ __forceinline__ void unit_begin(const Unit& u, int par, PG8_LAS unsigned char* lds) const {
        const int tid = threadIdx.x, row = tid >> 1, hh = 4 * (tid & 1);
        float sv[4];
        { const f32x4* sp = (const f32x4*)(SS + ((size_t)(u.pm * BM + row) * 8 + hh) * 8);
#pragma unroll
          for (int q = 0; q < 4; ++q) { const f32x4 a = sp[2 * q], b = sp[2 * q + 1]; sv[q] = (a.x + a.y) + (a.z + a.w) + (b.x + b.y) + (b.z + b.w); asm volatile("" ::: "memory"); } }
        const f32x4 s = (f32x4){sv[0], sv[1], sv[2], sv[3]};
        f32x4 rs; rs.x = __builtin_amdgcn_rsqf(s.x * (1.f / 1024.f) + eps); rs.y = __builtin_amdgcn_rsqf(s.y * (1.f / 1024.f) + eps); rs.z = __builtin_amdgcn_rsqf(s.z * (1.f / 1024.f) + eps); rs.w = __builtin_amdgcn_rsqf(s.w * (1.f / 1024.f) + eps);
        *(PG8_LAS f32x4*)(lds + 131072 + par * 8192 + (row * 8 + hh) * 4) = rs;
    }
    __device__ __forceinline__ void khook(f32x4 (&acc)[2][2][4][2], int par, int hb, int wr, int fr, PG8_LAS unsigned char* lds) const {
        const PG8_LAS float* T = (const PG8_LAS float*)(lds + 131072 + par * 8192);
        typedef float f32x2h __attribute__((ext_vector_type(2)));
        f32x2h tv[8]; unsigned ad[8];
#pragma unroll
        for (int i = 0; i < 8; ++i) ad[i] = (unsigned)(size_t)(T + ((i >> 2) * HALF + wr * 64 + (i & 3) * 16 + fr) * 8 + hb - 1);
        asm volatile("ds_read2_b32 %0, %8 offset1:1\n\tds_read2_b32 %1, %9 offset1:1\n\tds_read2_b32 %2, %10 offset1:1\n\tds_read2_b32 %3, %11 offset1:1\n\t"
                     "ds_read2_b32 %4, %12 offset1:1\n\tds_read2_b32 %5, %13 offset1:1\n\tds_read2_b32 %6, %14 offset1:1\n\tds_read2_b32 %7, %15 offset1:1\n\ts_waitcnt lgkmcnt(0)\n\ts_nop 15\n\ts_nop 15"
                     : "=&v"(tv[0]), "=&v"(tv[1]), "=&v"(tv[2]), "=&v"(tv[3]), "=&v"(tv[4]), "=&v"(tv[5]), "=&v"(tv[6]), "=&v"(tv[7])
                     : "v"(ad[0]), "v"(ad[1]), "v"(ad[2]), "v"(ad[3]), "v"(ad[4]), "v"(ad[5]), "v"(ad[6]), "v"(ad[7]) : "memory");
#pragma unroll
        for (int ai = 0; ai < 2; ++ai)
#pragma unroll
            for (int m = 0; m < 4; ++m) { const float ratio = tv[ai * 4 + m].x * __builtin_amdgcn_rcpf(tv[ai * 4 + m].y);
#pragma unroll
                for (int bj = 0; bj < 2; ++bj)
#pragma unroll
                    for (int n = 0; n < 2; ++n) { f32x4& a = acc[ai][bj][m][n];
                        asm volatile("v_mul_f32 %0, %0, %4\n\tv_mul_f32 %1, %1, %4\n\tv_mul_f32 %2, %2, %4\n\tv_mul_f32 %3, %3, %4\n\ts_nop 1" : "+v"(a.x), "+v"(a.y), "+v"(a.z), "+v"(a.w) : "v"(ratio)); } }
    }
    __device__ __forceinline__ void epi(const f32x4 (&acc)[2][2][4][2], const Unit& u, int wr, int wc, int fr, int fq, int par, PG8_LAS unsigned char* lds) const {
        const PG8_LAS float* T = (const PG8_LAS float*)(lds + 131072 + par * 8192);
        const int row0 = u.pm * BM + wr * 64 + fr, col0 = u.pn * BM + wc * 32 + 4 * fq;
#pragma unroll
        for (int ai = 0; ai < 2; ++ai)
#pragma unroll
            for (int m = 0; m < 4; ++m) { const int r = row0 + ai * HALF + m * 16; const float sc = T[(ai * HALF + wr * 64 + m * 16 + fr) * 8 + 7];
                const float* rp = res + (size_t)r * ldc + col0; float* cp = C + (size_t)r * ldc + col0;
#pragma unroll
                for (int bj = 0; bj < 2; ++bj)
#pragma unroll
                    for (int n = 0; n < 2; ++n) { const f32x4 rv = *(const f32x4*)(rp + bj * HALF + n * 16); *(f32x4*)(cp + bj * HALF + n * 16) = rv * alpha + acc[ai][bj][m][n] * sc; }
                asm volatile("" ::: "memory"); }
    }
};


template <class Epi, class Sched, bool ALIGN_EPI = false, bool SP2 = false>
__device__ __forceinline__ void gemm_phase(PG8_LAS unsigned char* lds, const Gemm g, const Sched& S, const Epi& E) {
    const int tid = threadIdx.x, wid = __builtin_amdgcn_readfirstlane(tid >> 6), lane = tid & 63, wr = wid >> 2, wc = wid & 3, fr = lane & 15, fq = lane >> 4;
    const int K = g.K, nt = K / BK;
    unsigned voffA[2], voffB[2];
#pragma unroll
    for (int i = 0; i < 2; ++i) { int R, C; stage_rc(tid * 16 + i * 8192, R, C); const int Rb = Epi::PERM ? ((R & ~31) + perm32(R & 31)) : R;
        voffA[i] = (unsigned)(R * K + C) * 2u; voffB[i] = (unsigned)(Rb * K + C) * 2u; }
    const size_t kstep = (size_t)(BK * 2);
    const size_t hstep = (size_t)HALF * K * 2;
    const size_t tstep = 2 * hstep;
    const unsigned ldsw = (unsigned)wid * 1024u;
    const int aoff = lds_byte(wr * 64 + fr, fq * 8), boff = lds_byte(wc * 32 + fr, fq * 8);
#define PG8_SA(b, h) (((b) * 2 + (h)) * HTB)
#define PG8_SB(b, h) ((4 + (b) * 2 + (h)) * HTB)
#define PG8_STAGE(bufoff, gbase, voff) do { _Pragma("unroll") for (int _i = 0; _i < 2; ++_i) \
        __builtin_amdgcn_global_load_lds((const unsigned*)((const char*)(gbase) + (voff)[_i]), (PG8_LAS unsigned*)(lds + (bufoff) + ldsw + _i * 8192), 16, 0, 0); } while (0)
#define PG8_LDA(dst, b, h) do { _Pragma("unroll") for (int m = 0; m < 4; ++m) _Pragma("unroll") for (int k = 0; k < 2; ++k) dst[m][k] = *(const PG8_LAS bf16x8*)(lds + PG8_SA(b, h) + aoff + m * 2048 + k * 1024); } while (0)
#define PG8_LDB(dst, b, h) do { _Pragma("unroll") for (int n = 0; n < 2; ++n) _Pragma("unroll") for (int k = 0; k < 2; ++k) dst[n][k] = *(const PG8_LAS bf16x8*)(lds + PG8_SB(b, h) + boff + n * 2048 + k * 1024); } while (0)
#define PG8_MMA(ai, bj, At, Bt) do { __builtin_amdgcn_s_setprio(1); _Pragma("unroll") for (int m = 0; m < 4; ++m) _Pragma("unroll") for (int n = 0; n < 2; ++n) _Pragma("unroll") for (int k = 0; k < 2; ++k) \
        acc[ai][bj][m][n] = __builtin_amdgcn_mfma_f32_16x16x32_bf16(Bt[n][k], At[m][k], acc[ai][bj][m][n], 0, 0, 0); __builtin_amdgcn_s_setprio(0); } while (0)
#define PG8_WAIT_V(n) asm volatile("s_waitcnt vmcnt(" #n ")" ::: "memory")
#define PG8_WAIT_L(n) asm volatile("s_waitcnt lgkmcnt(" #n ")" ::: "memory")
#define PG8_BAR __builtin_amdgcn_s_barrier()
#define PG8_SCHED __builtin_amdgcn_sched_barrier(0)
    Unit cur, nxt; int ui = 0;
    if (!S.next(0, cur)) return;
    f32x4 acc[2][2][4][2];
#pragma unroll
    for (int a = 0; a < 2; ++a)
#pragma unroll
        for (int b = 0; b < 2; ++b)
#pragma unroll
            for (int m = 0; m < 4; ++m)
#pragma unroll
                for (int n = 0; n < 2; ++n) acc[a][b][m][n] = (f32x4){0.f, 0.f, 0.f, 0.f};
    bf16x8 At[4][2], B0[2][2], B1[2][2];
    const char* cA = (const char*)g.A + (size_t)cur.pm * tstep; const char* cB = (const char*)g.Bt + (size_t)cur.pn * tstep;
    if constexpr (Epi::KHOOK) E.unit_begin(cur, ui & 1, lds);
    S.a_ready(cur);
    if constexpr (SP2) {
        PG8_STAGE(PG8_SB(0, 0), cB, voffB); PG8_STAGE(PG8_SB(0, 1), cB + hstep, voffB); PG8_STAGE(PG8_SA(0, 0), cA, voffA); PG8_STAGE(PG8_SA(0, 1), cA + hstep, voffA);
        if (wr == 1) PG8_BAR;
        PG8_WAIT_V(2); PG8_BAR;
        PG8_STAGE(PG8_SB(1, 0), cB + kstep, voffB); PG8_STAGE(PG8_SA(1, 0), cA + kstep, voffA); PG8_STAGE(PG8_SB(1, 1), cB + hstep + kstep, voffB);
        PG8_WAIT_V(6); PG8_BAR;
    } else {
        PG8_STAGE(PG8_SB(0, 0), cB, voffB); PG8_STAGE(PG8_SA(0, 0), cA, voffA); PG8_STAGE(PG8_SB(0, 1), cB + hstep, voffB); PG8_STAGE(PG8_SA(0, 1), cA + hstep, voffA);
        if (wr == 1) PG8_BAR;
        PG8_WAIT_V(4); PG8_BAR;
        PG8_STAGE(PG8_SB(1, 0), cB + kstep, voffB); PG8_STAGE(PG8_SA(1, 0), cA + kstep, voffA); PG8_STAGE(PG8_SB(1, 1), cB + hstep + kstep, voffB);
        PG8_WAIT_V(6); PG8_BAR;
    }
    for (;;) {
        const bool has_next = S.next(ui + 1, nxt);
        const char* nA = has_next ? (const char*)g.A + (size_t)nxt.pm * tstep : cA; const char* nB = has_next ? (const char*)g.Bt + (size_t)nxt.pn * tstep : cB;
        const int tseg = Epi::KHOOK ? 16 : nt;
        for (int tb = 0; tb < nt; tb += tseg) {
        if constexpr (Epi::KHOOK) { if (tb != 0) { PG8_SCHED; E.khook(acc, ui & 1, tb >> 4, wr, fr, lds); PG8_SCHED; } }
        for (int t = tb; t < tb + tseg; t += 2) {
            const bool last = (t == nt - 2);
            const char* a1 = cA + (size_t)(t + 1) * kstep;
            const char* a2 = last ? nA : cA + (size_t)(t + 2) * kstep; const char* b2 = last ? nB : cB + (size_t)(t + 2) * kstep;
            const char* a3 = a2 + kstep; const char* b3 = b2 + kstep;
            if (last && has_next) S.a_ready(nxt);
            if constexpr (SP2) {
            PG8_LDB(B0, 0, 0); PG8_LDB(B1, 0, 1); PG8_SCHED; PG8_LDA(At, 0, 0); PG8_STAGE(PG8_SA(1, 1), a1 + hstep, voffA);
            PG8_WAIT_V(8); PG8_WAIT_L(0); PG8_BAR; PG8_MMA(0, 0, At, B0); PG8_MMA(0, 1, At, B1); PG8_BAR; PG8_SCHED;
            PG8_LDA(At, 0, 1); PG8_STAGE(PG8_SB(0, 0), b2, voffB); PG8_STAGE(PG8_SB(0, 1), b2 + hstep, voffB); PG8_STAGE(PG8_SA(0, 0), a2, voffA);
            PG8_WAIT_V(8); PG8_WAIT_L(0); PG8_BAR; PG8_MMA(1, 0, At, B0); PG8_MMA(1, 1, At, B1); PG8_BAR; PG8_SCHED;
            PG8_LDB(B0, 1, 0); PG8_LDB(B1, 1, 1); PG8_SCHED; PG8_LDA(At, 1, 0); PG8_STAGE(PG8_SA(0, 1), a2 + hstep, voffA);
            PG8_WAIT_V(8); PG8_WAIT_L(0); PG8_BAR; PG8_MMA(0, 0, At, B0); PG8_MMA(0, 1, At, B1); PG8_BAR; PG8_SCHED;
            PG8_LDA(At, 1, 1); PG8_STAGE(PG8_SB(1, 0), b3, voffB); PG8_STAGE(PG8_SB(1, 1), b3 + hstep, voffB); PG8_STAGE(PG8_SA(1, 0), a3, voffA);
            PG8_WAIT_V(8); PG8_WAIT_L(0); PG8_BAR; PG8_MMA(1, 0, At, B0); PG8_MMA(1, 1, At, B1); PG8_BAR; PG8_SCHED;
            } else {
            PG8_LDB(B0, 0, 0); PG8_SCHED; PG8_LDA(At, 0, 0); PG8_STAGE(PG8_SA(1, 1), a1 + hstep, voffA);
            PG8_WAIT_L(8); PG8_BAR; PG8_WAIT_L(0); PG8_MMA(0, 0, At, B0); PG8_BAR; PG8_SCHED;
            PG8_LDB(B1, 0, 1); PG8_STAGE(PG8_SB(0, 0), b2, voffB);
            PG8_BAR; PG8_WAIT_L(0); PG8_MMA(0, 1, At, B1); PG8_BAR;
            PG8_LDA(At, 0, 1); PG8_STAGE(PG8_SA(0, 0), a2, voffA);
            PG8_BAR; PG8_WAIT_L(0); PG8_MMA(1, 0, At, B0); PG8_BAR; PG8_SCHED;
            PG8_STAGE(PG8_SB(0, 1), b2 + hstep, voffB);
            PG8_WAIT_V(6); PG8_BAR; PG8_MMA(1, 1, At, B1); PG8_BAR;
            PG8_LDB(B0, 1, 0); PG8_SCHED; PG8_LDA(At, 1, 0); PG8_STAGE(PG8_SA(0, 1), a2 + hstep, voffA);
            PG8_WAIT_L(8); PG8_BAR; PG8_WAIT_L(0); PG8_MMA(0, 0, At, B0); PG8_BAR; PG8_SCHED;
            PG8_LDB(B1, 1, 1); PG8_STAGE(PG8_SB(1, 0), b3, voffB);
            PG8_BAR; PG8_WAIT_L(0); PG8_MMA(0, 1, At, B1); PG8_BAR;
            PG8_LDA(At, 1, 1); PG8_STAGE(PG8_SA(1, 0), a3, voffA);
            PG8_BAR; PG8_WAIT_L(0); PG8_MMA(1, 0, At, B0); PG8_BAR; PG8_SCHED;
            PG8_STAGE(PG8_SB(1, 1), b3 + hstep, voffB);
            PG8_WAIT_V(6); PG8_BAR; PG8_MMA(1, 1, At, B1); PG8_BAR;
            }
        }
        }
        if constexpr (ALIGN_EPI) { if (wr == 0) PG8_BAR; }
        if constexpr (Epi::KHOOK) { E.epi(acc, cur, wr, wc, fr, fq, ui & 1, lds); S.done(cur); }
        else if constexpr (!Epi::AFTER_DRAIN) { E(acc, cur, wr, wc, fr, fq); S.done(cur); }
        if (!has_next) break;
#pragma unroll
        for (int a = 0; a < 2; ++a)
#pragma unroll
            for (int b = 0; b < 2; ++b)
#pragma unroll
                for (int m = 0; m < 4; ++m)
#pragma unroll
                    for (int n = 0; n < 2; ++n) acc[a][b][m][n] = (f32x4){0.f, 0.f, 0.f, 0.f};
        cur = nxt; cA = nA; cB = nB; ++ui;
        if constexpr (Epi::KHOOK) E.unit_begin(cur, ui & 1, lds);
        if constexpr (ALIGN_EPI) { if (wr == 1) PG8_BAR; }
    }
    PG8_WAIT_V(0);
    if constexpr (!ALIGN_EPI) { if (wr == 0) PG8_BAR; }
    PG8_BAR;
    if constexpr (Epi::AFTER_DRAIN) { E.fused(acc, cur, wr, wc, fr, fq, lds, wid, lane); S.done(cur); }
#undef PG8_SA
#undef PG8_SB
#undef PG8_STAGE
#undef PG8_LDA
#undef PG8_LDB
#undef PG8_MMA
#undef PG8_WAIT_V
#undef PG8_WAIT_L
#undef PG8_BAR
#undef PG8_SCHED
}
}
#ifndef PG8_SP2
#define PG8_SP2 true
#endif
#ifndef PG8_ALIGN
#define PG8_ALIGN true
#endif

constexpr int NWAVES = 8;
constexpr int PER_PHASE = 12;
#ifndef MK_N_LAUNCHES
#define MK_N_LAUNCHES 1
#endif
#ifndef PROBE_MASK
#define PROBE_MASK 0
#endif
#define REP(k) (((PROBE_MASK >> (k)) & 1) + 1)
#ifndef PROBE_VAR
#define PROBE_VAR 0
#endif
#ifndef PROBE_CLK
#define PROBE_CLK 0
#endif
#ifndef STAMP_MASK
#define STAMP_MASK 0
#endif
#ifndef USE_AUX
#define USE_AUX 0
#endif
#ifndef USE_TILE_TRANSPOSE
#define USE_TILE_TRANSPOSE 0
#endif
#ifndef USE_L1_SEQ2
#define USE_L1_SEQ2 0
#endif
#ifndef USE_FUSED_NORM
#define USE_FUSED_NORM 1
#endif
#ifndef P0_META_FOLD
#define P0_META_FOLD (USE_L0_MFMA == 2 && !USE_TILE_TRANSPOSE)
#endif
#ifndef USE_TICKETS
#define USE_TICKETS 0
#endif
constexpr int N_LAUNCHES = MK_N_LAUNCHES;

constexpr int D = 4096, NB = 4, SEQ = 2048, NMETA = 16, DI = 8192;
constexpr int MX = NB * SEQ;
constexpr int MR = MX + NMETA;
constexpr int MP = 8448;
constexpr int N0 = 4 * DI;
constexpr int N1 = 2 * 4096 + 2 * DI;
constexpr int HG_H = 64, HG_DK = 128;
constexpr int GL_H = 8, GL_DK = 512, GL_DV = 1024, GL_R = 16;
constexpr float LN_EPS = 1e-5f, RMS_EPS = 1e-6f;
constexpr float ALPHA = 1.41421356237309515f;

constexpr size_t MiB = 1u << 20;
constexpr size_t WS_CTL = 0, CTL_ZERO_BYTES = 1 * MiB;
constexpr size_t WS_LB0 = 1 * MiB;
constexpr size_t WS_G1 = 2 * MiB;
constexpr size_t WS_WG1T = 3 * MiB;
constexpr size_t WS_W2F = 3 * MiB + 256 * 1024;
constexpr size_t WS_WT0IN = 4 * MiB;
constexpr size_t WS_WT0OUT = WS_WT0IN + 256 * MiB;
constexpr size_t WS_WT1IN = WS_WT0OUT + 64 * MiB;
constexpr size_t WS_WT1OUT = WS_WT1IN + 192 * MiB;
constexpr size_t WS_XB = WS_WT1OUT + 64 * MiB;
constexpr size_t WS_H1B = WS_XB + 66 * MiB;
constexpr size_t WS_QFIZ = WS_H1B + 66 * MiB;
constexpr size_t WS_Y = WS_QFIZ + 528 * MiB;
constexpr size_t WS_PRE = WS_Y + 132 * MiB;
constexpr size_t WS_REC = WS_PRE + 132 * MiB;
constexpr size_t WS_Q0 = WS_REC + 520 * MiB;
constexpr size_t WS_Y0 = WS_REC + 523 * MiB;
constexpr size_t WS_REC1 = WS_REC, WS_VF1 = WS_REC + 139 * MiB, WS_O1 = WS_REC + 270 * MiB;
constexpr size_t WS_END = WS_REC + 528 * MiB;
static_assert((size_t)MP * D * 2 <= 66 * MiB && (size_t)MP * N0 * 2 <= 528 * MiB && (size_t)MP * DI * 2 <= 132 * MiB && (size_t)MP * D * 4 <= 132 * MiB && (size_t)MR * DI * 4 <= 258 * MiB, "d_ws map");
static_assert((size_t)256 * 65 * 27648 <= 440 * MiB && (size_t)32 * 65 * 69632 <= 139 * MiB && (size_t)32 * 65 * 65536 <= 131 * MiB, "record map");
constexpr int CW_BAR = 4096, CW_POOL = 8192;

constexpr int RING_OFF = 0, RING_BYTES = 155648;
constexpr int LDSCTL_OFF = RING_BYTES, MISC_OFF = LDSCTL_OFF + 320;
constexpr int LDS_BYTES = 163840;
static_assert(MISC_OFF + 128 <= LDS_BYTES, "LDS map");

#define GAS __attribute__((address_space(1)))
#define LAS __attribute__((address_space(3)))
typedef unsigned short bf16;
typedef unsigned v4u __attribute__((ext_vector_type(4)));
typedef unsigned v2u __attribute__((ext_vector_type(2)));
typedef float f32x4 __attribute__((ext_vector_type(4)));
typedef GAS unsigned gu32;
#define RLX_AGENT __ATOMIC_RELAXED, __HIP_MEMORY_SCOPE_AGENT
#define LDS_WAIT() asm volatile("s_waitcnt lgkmcnt(0)" ::: "memory")
#define DI_ __device__ __forceinline__
DI_ unsigned f2bf(float f) { unsigned u = __builtin_bit_cast(unsigned, f); return (u + 0x7fffu + ((u >> 16) & 1u)) >> 16; }
DI_ unsigned pk2(float lo, float hi) { return f2bf(lo) | (f2bf(hi) << 16); }
DI_ unsigned hwpk(float lo, float hi) { unsigned r; asm volatile("v_cvt_pk_bf16_f32 %0, %1, %2" : "=v"(r) : "v"(lo), "v"(hi)); return r; }
DI_ float bflo(unsigned w) { return __builtin_bit_cast(float, w << 16); }
DI_ float bfhi(unsigned w) { return __builtin_bit_cast(float, w & 0xffff0000u); }
DI_ float bf2f(bf16 b) { return __builtin_bit_cast(float, (unsigned)b << 16); }
DI_ float sigm(float x) { return __builtin_amdgcn_rcpf(1.f + __builtin_amdgcn_exp2f(x * -1.4426950408889634f)); }
DI_ float silu(float x) { return x * __builtin_amdgcn_rcpf(1.f + __builtin_amdgcn_exp2f(x * -1.4426950408889634f)); }

#define XB_TMO      128
#define XB_XCNT(j)  (256  + 64 * (j))
#define XB_XSUB(j)  (1280 + 64 * (j))
#define XB_XGEN(j)  (2304 + 64 * (j))
#define XB_TOP      3328
#define XB_TOPGEN   3392
#define XCD_BAR_WORDS 3456
#define XB_SPIN_CAP (1u << 18)

__device__ __forceinline__ unsigned xb_ld(unsigned* p)              { return __hip_atomic_load(p, __ATOMIC_RELAXED, __HIP_MEMORY_SCOPE_AGENT); }
__device__ __forceinline__ unsigned xb_add(unsigned* p, unsigned v) { return __hip_atomic_fetch_add(p, v, __ATOMIC_RELAXED, __HIP_MEMORY_SCOPE_AGENT); }
__device__ __forceinline__ unsigned xb_xcc_id() { return (unsigned)__builtin_amdgcn_s_getreg((3 << 11) | 20) & 0xFu; }
#define XB_SPIN(cond, bar) do { unsigned _sp = 0; while (cond) { __builtin_amdgcn_s_sleep(1); \
    if ((++_sp & 255u) == 0u) { if (xb_ld(&(bar)[XB_TMO])) break; if (_sp > XB_SPIN_CAP) { atomicAdd(&(bar)[XB_TMO], 1u); break; } } } } while (0)

struct XcdBarrier {
    unsigned* bar; unsigned x;
    volatile LAS unsigned* st;
};
__device__ __forceinline__ XcdBarrier xcd_barrier_post(unsigned* bar, volatile LAS unsigned* st) {
    XcdBarrier b; b.bar = bar; b.x = xb_xcc_id(); b.st = st;
    if (threadIdx.x == 0) (void)xb_add(&bar[XB_XCNT(b.x)], 1u);
    return b;
}
__device__ __forceinline__ void xcd_barrier_complete(unsigned* bar, unsigned x, unsigned& nloc, unsigned& nx) {
    const unsigned G = gridDim.x * gridDim.y * gridDim.z;
    unsigned sum, cnt, mine, sp = 0u;
    for (;;) {
        sum = 0u; cnt = 0u; mine = 0u;
#pragma unroll
        for (unsigned j = 0; j < 16; ++j) { const unsigned c = xb_ld(&bar[XB_XCNT(j)]); sum += c; cnt += (c > 0u) ? 1u : 0u; mine = (j == x) ? c : mine; }
        if (sum == G) break;
        __builtin_amdgcn_s_sleep(1);
        if ((++sp & 255u) == 0u) { if (xb_ld(&bar[XB_TMO])) break; if (sp > XB_SPIN_CAP) { atomicAdd(&bar[XB_TMO], 1u); break; } }
    }
    nloc = mine > 0u ? mine : 1u; nx = cnt > 0u ? cnt : 1u;
}
__device__ __forceinline__ void xcd_barrier(const XcdBarrier& b) {
    asm volatile("s_waitcnt vmcnt(0)" ::: "memory");
    __syncthreads();
    if (threadIdx.x == 0) {
        unsigned* bar = b.bar;
        __builtin_amdgcn_s_waitcnt(0);
        unsigned nloc = b.st[0], nx = b.st[1];
        if (nloc == 0u) { xcd_barrier_complete(bar, b.x, nloc, nx); b.st[0] = nloc; b.st[1] = nx; }
        const unsigned old = xb_add(&bar[XB_XSUB(b.x)], 1u);
        const unsigned gen = old / nloc;
        if (old + 1u == (gen + 1u) * nloc) {
            __builtin_amdgcn_fence(__ATOMIC_RELEASE, "agent");
            asm volatile("s_waitcnt vmcnt(0)" ::: "memory");
            const unsigned og = xb_add(&bar[XB_TOP], 1u);
            const unsigned tg = og / nx;
            if (og + 1u == (tg + 1u) * nx) xb_add(&bar[XB_TOPGEN], 1u);
            else XB_SPIN(xb_ld(&bar[XB_TOPGEN]) == tg, bar);
            __builtin_amdgcn_fence(__ATOMIC_ACQUIRE, "agent");
            xb_add(&bar[XB_XGEN(b.x)], 1u);
            asm volatile("s_waitcnt vmcnt(0)" ::: "memory");
        } else {
            XB_SPIN(xb_ld(&bar[XB_XGEN(b.x)]) == gen, bar);
            __builtin_amdgcn_fence(__ATOMIC_ACQUIRE, "agent");
            asm volatile("s_waitcnt vmcnt(0)" ::: "memory");
        }
    }
    __syncthreads();
}

struct Frame {
    LAS unsigned char* lds;
    volatile LAS unsigned* MISC;
    gu32* ctl;
    int tid, lane, wave;
    int vcu, G;
    const float *x, *meta, *lb_logits;
    const float *w0in, *b_f, *ng0, *w0out, *ln0g, *ln0b;
    const float *w1in, *wg1, *wg2, *b_g, *ng1, *w1out, *ln1g, *ln1b;
    float* out;
    float *LB0, *G1, *PRE, *O1;
    unsigned char *REC0, *REC1, *VF1;
    bf16 *WG1T, *W2F, *Q0, *Y0;
    float* SS;
    bf16 *WT0IN, *WT0OUT, *WT1IN, *WT1OUT, *XB, *H1B, *QFIZ, *Y;
};

DI_ float wave_sum(float v) {
#pragma unroll
    for (int o = 1; o < 64; o <<= 1) v += __shfl_xor(v, o);
    return v;
}

typedef short p0_bf16x8 __attribute__((ext_vector_type(8)));
template <bool META>
DI_ void p0_transpose_item_t(const float* W, int K, int N, bf16* WT, LAS float* scr, int item_kb, int item_nb, int lane, const float* meta, f32x4 (&macc)[2]) {
    const int k0 = 64 * item_kb, n0 = 32 * item_nb;
    float wv[32];
#pragma unroll
    for (int i = 0; i < 32; ++i) wv[i] = __builtin_nontemporal_load(W + (size_t)(k0 + 2 * i + (lane >> 5)) * N + n0 + (lane & 31));
    v4u ma[2][2];
    if (META) {
#pragma unroll
        for (int ks = 0; ks < 2; ++ks) { const GAS f32x4* mp = (const GAS f32x4*)(meta + (size_t)(lane & 15) * D + k0 + 32 * ks + 8 * (lane >> 4)); const f32x4 a = mp[0], b = mp[1];
            ma[ks][0] = (v4u){hwpk(a.x, a.y), hwpk(a.z, a.w), hwpk(b.x, b.y), hwpk(b.z, b.w)}; }
    }
#pragma unroll
    for (int i = 0; i < 32; ++i) scr[(2 * i + (lane >> 5)) * 33 + (lane & 31)] = wv[i];
    LDS_WAIT(); asm volatile("" ::: "memory");
    if (META) {
        const int r = lane & 15, g = lane >> 4;
#pragma unroll
        for (int ks = 0; ks < 2; ++ks)
#pragma unroll
            for (int nh = 0; nh < 2; ++nh) { const LAS float* s = scr + (32 * ks + 8 * g) * 33 + 16 * nh + r;
                const v4u bf = (v4u){hwpk(s[0 * 33], s[1 * 33]), hwpk(s[2 * 33], s[3 * 33]), hwpk(s[4 * 33], s[5 * 33]), hwpk(s[6 * 33], s[7 * 33])};
                macc[nh] = __builtin_amdgcn_mfma_f32_16x16x32_bf16(__builtin_bit_cast(p0_bf16x8, ma[ks][0]), __builtin_bit_cast(p0_bf16x8, bf), macc[nh], 0, 0, 0); }
    }
    const int c = lane & 7;
#pragma unroll
    for (int j = 0; j < 4; ++j) { const int n = (lane >> 3) + 8 * j; const LAS float* s = scr + (8 * c) * 33 + n;
        v4u o; o.x = hwpk(s[0 * 33], s[1 * 33]); o.y = hwpk(s[2 * 33], s[3 * 33]); o.z = hwpk(s[4 * 33], s[5 * 33]); o.w = hwpk(s[6 * 33], s[7 * 33]);
        *(GAS v4u*)(WT + (size_t)(n0 + n) * K + k0 + 8 * c) = o; }
    LDS_WAIT(); asm volatile("" ::: "memory");
}
DI_ void p0_transpose_item(const float* W, int K, int N, bf16* WT, LAS float* scr, int item, int lane) {
    f32x4 dummy[2]; const int nblk = N / 32;
    p0_transpose_item_t<false>(W, K, N, WT, scr, item / nblk, item % nblk, lane, nullptr, dummy);
}

DI_ void p0_tile_load(const float* W, int N, int k0, int n0, int tid, f32x4 (&wv)[8]) {
    const int row = tid >> 5, c4 = tid & 31;
#pragma unroll
    for (int i = 0; i < 8; ++i) wv[i] = *(const GAS f32x4*)(W + (size_t)(k0 + row + 16 * i) * N + n0 + 4 * c4);
}
DI_ void p0_tile_to_lds(int tid, const f32x4 (&wv)[8], LAS unsigned char* img) {
    const int row = tid >> 5, c4 = tid & 31;
#pragma unroll
    for (int i = 0; i < 8; ++i) { const int k = row + 16 * i; const int col = (2 * c4) ^ (2 * ((k >> 3) & 15));
        *(LAS v2u*)(img + k * 256 + col * 4) = (v2u){hwpk(wv[i].x, wv[i].y), hwpk(wv[i].z, wv[i].w)}; }
}
DI_ void p0_tile_from_lds(bf16* WT, int K, int k0, int n0, int tid, LAS unsigned char* img) {
    __syncthreads();
    const int kc = tid & 15;
#pragma unroll
    for (int j = 0; j < 4; ++j) { const int n = (tid >> 4) + 32 * j; unsigned short hv[8];
#pragma unroll
        for (int e = 0; e < 8; ++e) hv[e] = *(const LAS unsigned short*)(img + (8 * kc + e) * 256 + ((((n >> 1) ^ (2 * kc)) << 2) | ((n & 1) << 1)));
        v4u o; o.x = hv[0] | ((unsigned)hv[1] << 16); o.y = hv[2] | ((unsigned)hv[3] << 16); o.z = hv[4] | ((unsigned)hv[5] << 16); o.w = hv[6] | ((unsigned)hv[7] << 16);
        *(GAS v4u*)(WT + (size_t)(n0 + n) * K + k0 + 8 * kc) = o; }
    __syncthreads();
}
struct P0Tile { const float* W; bf16* WT; int K, N, k0, n0; };
DI_ P0Tile p0_tile_decode(Frame& F, int t) {
    constexpr int T_0 = (D / 128) * (N0 / 128), T_1 = (DI / 128) * (D / 128), T_2 = (D / 128) * (N1 / 128);
    P0Tile p;
    if (t < T_0) { p.W = F.w0in; p.WT = F.WT0IN; p.K = D; p.N = N0; }
    else if (t < T_0 + T_1) { t -= T_0; p.W = F.w0out; p.WT = F.WT0OUT; p.K = DI; p.N = D; }
    else if (t < T_0 + T_1 + T_2) { t -= T_0 + T_1; p.W = F.w1in; p.WT = F.WT1IN; p.K = D; p.N = N1; }
    else { t -= T_0 + T_1 + T_2; p.W = F.w1out; p.WT = F.WT1OUT; p.K = DI; p.N = D; }
    const int nt = p.N / 128, kb = t / nt, nb = t - kb * nt; p.k0 = 128 * kb; p.n0 = 128 * nb; return p;
}
DI_ void p0_transpose_all(Frame& F) {
    constexpr int NT = (D / 128) * (N0 / 128) + 2 * (DI / 128) * (D / 128) + (D / 128) * (N1 / 128);
    f32x4 wv[8];
    int t = F.vcu;
    if (t < NT) { const P0Tile p = p0_tile_decode(F, t); p0_tile_load(p.W, p.N, p.k0, p.n0, F.tid, wv); }
    for (; t < NT; t += F.G) {
        const P0Tile p = p0_tile_decode(F, t);
        p0_tile_to_lds(F.tid, wv, F.lds);
        if (t + F.G < NT) { const P0Tile q = p0_tile_decode(F, t + F.G); p0_tile_load(q.W, q.N, q.k0, q.n0, F.tid, wv); }
        p0_tile_from_lds(p.WT, p.K, p.k0, p.n0, F.tid, F.lds);
    }
}

DI_ void p0_prologue(Frame& F) {
    LAS float* scr = (LAS float*)(F.lds + RING_OFF + F.wave * 16384);
    const int gw = F.vcu * NWAVES + F.wave, NGW = F.G * NWAVES;
    constexpr int I_0 = (D / 64) * (N0 / 32), I_1 = (DI / 64) * (D / 32), I_2 = (D / 64) * (N1 / 32), I_3 = I_1;
    constexpr int NITEMS = I_0 + I_1 + I_2 + I_3;
#if USE_TILE_TRANSPOSE
    p0_transpose_all(F);
#else
    if (P0_META_FOLD && F.G == 256) {
        constexpr int OTH = I_1 + I_2 + I_3;
        int o_lo, o_hi;
        if (gw < 1024) {
            f32x4 macc[2]; macc[0] = (f32x4){0.f, 0.f, 0.f, 0.f}; macc[1] = macc[0];
            for (int kb = 0; kb < D / 64; ++kb) p0_transpose_item_t<true>(F.w0in, D, N0, F.WT0IN, scr, kb, gw, F.lane, F.meta, macc);
            const int r = F.lane & 15, g = F.lane >> 4;
#pragma unroll
            for (int nh = 0; nh < 2; ++nh) { const float mv[4] = {macc[nh].x, macc[nh].y, macc[nh].z, macc[nh].w};
#pragma unroll
                for (int jj = 0; jj < 4; ++jj) F.Q0[(size_t)(16 + 4 * g + jj) * N0 + 32 * gw + 16 * nh + r] = (bf16)f2bf(mv[jj]); }
            o_lo = gw * 8; o_hi = o_lo + 8;
        } else { o_lo = 8192 + (gw - 1024) * 72; o_hi = o_lo + 72; }
        static_assert(OTH == 8192 + 1024 * 72, "tile split");
        for (int it = o_lo; it < o_hi; ++it) {
            int r = it;
            if (r < I_1) { p0_transpose_item(F.w0out, DI, D, F.WT0OUT, scr, r, F.lane); continue; } r -= I_1;
            if (r < I_2) { p0_transpose_item(F.w1in, D, N1, F.WT1IN, scr, r, F.lane); continue; } r -= I_2;
            p0_transpose_item(F.w1out, DI, D, F.WT1OUT, scr, r, F.lane);
        }
    } else
    for (int it = gw; it < NITEMS; it += NGW) {
        int r = it;
        if (r < I_0) { p0_transpose_item(F.w0in, D, N0, F.WT0IN, scr, r, F.lane); continue; } r -= I_0;
        if (USE_AUX && USE_L0_MFMA == 2 && F.G == 256) break;
        if (r < I_1) { p0_transpose_item(F.w0out, DI, D, F.WT0OUT, scr, r, F.lane); continue; } r -= I_1;
        if (r < I_2) { p0_transpose_item(F.w1in, D, N1, F.WT1IN, scr, r, F.lane); continue; } r -= I_2;
        p0_transpose_item(F.w1out, DI, D, F.WT1OUT, scr, r, F.lane);
    }
#endif
    for (int m = gw; m < MP; m += NGW) {
        GAS unsigned long long* o8 = (GAS unsigned long long*)(F.XB + (size_t)m * D) + F.lane;
        if (m < MR) {
            const float* src = (m < MX) ? F.x + (size_t)m * D : F.meta + (size_t)(m - MX) * D;
            const GAS f32x4* xr = (const GAS f32x4*)src + F.lane;
#pragma unroll 4
            for (int j = 0; j < 16; ++j) { const f32x4 v = xr[64 * j]; o8[64 * j] = (unsigned long long)hwpk(v.x, v.y) | ((unsigned long long)hwpk(v.z, v.w) << 32); }
        } else {
#pragma unroll 4
            for (int j = 0; j < 16; ++j) o8[64 * j] = 0ull;
        }
    }
    for (int m = MR + gw; m < MP; m += NGW) {
        GAS unsigned long long* o8 = (GAS unsigned long long*)(F.H1B + (size_t)m * D) + F.lane;
#pragma unroll 4
        for (int j = 0; j < 16; ++j) o8[64 * j] = 0ull;
    }
    for (int i = gw * 64 + F.lane; i < 16 * N0 / 8; i += NGW * 64) { const int col8 = i % (N0 / 8); const unsigned v = (col8 >= DI / 8 && col8 < 2 * DI / 8) ? 0x47004700u : 0u;
        *((GAS v4u*)F.Q0 + i) = (v4u){v, v, v, v}; }
    for (int i = gw * 64 + F.lane; i < GL_R * D; i += NGW * 64) { const int n = i / D, k = i - n * D; F.WG1T[i] = (bf16)f2bf(F.wg1[(size_t)k * GL_R + n]); }
    for (int i = gw * 64 + F.lane; i < 8 * 16 * 2 * 64 * 8; i += NGW * 64) {
        const int e = i & 7, ln = (i >> 3) & 63, fr = i >> 9, m2 = fr & 1, s2 = (fr >> 1) & 15, hh = fr >> 5, rA = ln & 15, gA = ln >> 4;
        float v = 0.f; if (gA < 2) v = F.wg2[(size_t)(8 * gA + e) * 4096 + hh * 512 + 32 * s2 + 8 * (rA >> 2) + 4 * m2 + (rA & 3)];
        F.W2F[i] = (bf16)f2bf(v);
    }
    for (int c = gw * 64 + F.lane; c < DI; c += NGW * 64) {
        const float l0 = F.lb_logits[c], l1 = F.lb_logits[DI + c], l2 = F.lb_logits[2 * DI + c];
        const float mx = fmaxf(l0, fmaxf(l1, l2));
        const float e0 = __expf(l0 - mx), e1 = __expf(l1 - mx), e2 = __expf(l2 - mx);
        F.LB0[c] = e0 / (e0 + e1 + e2);
    }
}

DI_ void p2_l0_rec_naive(Frame& F) {
    LAS float* qs = (LAS float*)(F.lds);
    LAS float* fs = qs + 2048;
    LAS float* ks = fs + 2048;
    LAS float* vs = ks + 2048;
    LAS float* pb = vs + 2048;
    const int tid = F.tid, dv = tid & 127, kg = tid >> 7;
    const int lj = tid >> 5, lc = (tid & 31) * 4;
    for (int u = blockIdx.x; u < NB * HG_H; u += F.G) {
        const int b = u >> 6, h = u & 63;
        float S[32];
#pragma unroll
        for (int i = 0; i < 32; ++i) S[i] = 0.f;
        float lbv[4], bfv[4], ngv[4];
#pragma unroll
        for (int i = 0; i < 4; ++i) { lbv[i] = F.LB0[h * 128 + lc + i]; bfv[i] = F.b_f[h * 128 + lc + i]; ngv[i] = F.ng0[h * 128 + lc + i]; }
        for (int tb = 0; tb < 129; ++tb) {
            const int rbase = (tb == 0) ? MX : b * SEQ + 16 * (tb - 1);
            const bf16* row = F.QFIZ + (size_t)(rbase + lj) * N0 + h * 128 + lc;
            {
                const v2u q4 = *(const GAS v2u*)(row), f4 = *(const GAS v2u*)(row + DI), i4 = *(const GAS v2u*)(row + 2 * DI);
                const float qv[4] = {bflo(q4.x), bfhi(q4.x), bflo(q4.y), bfhi(q4.y)};
                const float fv[4] = {bflo(f4.x), bfhi(f4.x), bflo(f4.y), bfhi(f4.y)};
                const float iv[4] = {bflo(i4.x), bfhi(i4.x), bflo(i4.y), bfhi(i4.y)};
#pragma unroll
                for (int i = 0; i < 4; ++i) {
                    const float fg = lbv[i] + (1.f - lbv[i]) * sigm(fv[i] + bfv[i]);
                    qs[lj * 128 + lc + i] = silu(qv[i]); fs[lj * 128 + lc + i] = fg; ks[lj * 128 + lc + i] = 1.f - fg; vs[lj * 128 + lc + i] = iv[i];
                }
            }
            __syncthreads();
            for (int j = 0; j < 16; ++j) {
                const float vj = vs[j * 128 + dv]; float po = 0.f;
#pragma unroll
                for (int i = 0; i < 32; i += 4) {
                    const f32x4 f4 = *(const LAS f32x4*)(fs + j * 128 + kg * 32 + i), k4 = *(const LAS f32x4*)(ks + j * 128 + kg * 32 + i), q4 = *(const LAS f32x4*)(qs + j * 128 + kg * 32 + i);
                    S[i + 0] = f4.x * S[i + 0] + k4.x * vj; po += q4.x * S[i + 0];
                    S[i + 1] = f4.y * S[i + 1] + k4.y * vj; po += q4.y * S[i + 1];
                    S[i + 2] = f4.z * S[i + 2] + k4.z * vj; po += q4.z * S[i + 2];
                    S[i + 3] = f4.w * S[i + 3] + k4.w * vj; po += q4.w * S[i + 3];
                }
                pb[(j * 4 + kg) * 128 + dv] = po;
            }
            __syncthreads();
            {
                f32x4 o = *(const LAS f32x4*)(pb + (lj * 4 + 0) * 128 + lc);
                o += *(const LAS f32x4*)(pb + (lj * 4 + 1) * 128 + lc);
                o += *(const LAS f32x4*)(pb + (lj * 4 + 2) * 128 + lc);
                o += *(const LAS f32x4*)(pb + (lj * 4 + 3) * 128 + lc);
                float ss = o.x * o.x + o.y * o.y + o.z * o.z + o.w * o.w;
                ss += __shfl_xor(ss, 16); ss += __shfl_xor(ss, 8); ss += __shfl_xor(ss, 4); ss += __shfl_xor(ss, 2); ss += __shfl_xor(ss, 1);
                const float rs = rsqrtf(ss * (1.f / 128.f) + RMS_EPS);
                const v2u z4 = *(const GAS v2u*)(row + 3 * DI);
                const float y0 = o.x * rs * ngv[0] * silu(bflo(z4.x)), y1 = o.y * rs * ngv[1] * silu(bfhi(z4.x));
                const float y2 = o.z * rs * ngv[2] * silu(bflo(z4.y)), y3 = o.w * rs * ngv[3] * silu(bfhi(z4.y));
                if (tb > 0 || b == 0) { v2u w; w.x = pk2(y0, y1); w.y = pk2(y2, y3); *(GAS v2u*)(F.Y + (size_t)(rbase + lj) * DI + h * 128 + lc) = w; }
            }
        }
        __syncthreads();
    }
}

DI_ void ln_phase(Frame& F, const float* src, int nrows, const float* g, const float* bt, float* dst32, bf16* dstb, float* G1) {
    const int gw = F.vcu * NWAVES + F.wave, NGW = F.G * NWAVES;
    for (int r = gw; r < nrows; r += NGW) {
        const GAS f32x4* s = (const GAS f32x4*)(src + (size_t)r * D) + F.lane;
        f32x4 v[16]; float sm = 0.f;
#pragma unroll
        for (int j = 0; j < 16; ++j) { v[j] = s[64 * j]; sm += (v[j].x + v[j].y) + (v[j].z + v[j].w); }
        const float mean = wave_sum(sm) * (1.f / D); float s2 = 0.f;
#pragma unroll
        for (int j = 0; j < 16; ++j) { v[j] = v[j] - mean; s2 += (v[j].x * v[j].x + v[j].y * v[j].y) + (v[j].z * v[j].z + v[j].w * v[j].w); }
        const float rstd = rsqrtf(wave_sum(s2) * (1.f / D) + LN_EPS);
#pragma unroll
        for (int j = 0; j < 16; ++j) {
            const f32x4 gg = *((const GAS f32x4*)g + F.lane + 64 * j), bb = *((const GAS f32x4*)bt + F.lane + 64 * j);
            v[j] = v[j] * rstd * gg + bb;
            if (dst32) *((GAS f32x4*)(dst32 + (size_t)r * D) + F.lane + 64 * j) = v[j];
            if (dstb) { v2u w; w.x = hwpk(v[j].x, v[j].y); w.y = hwpk(v[j].z, v[j].w); *((GAS v2u*)(dstb + (size_t)r * D) + F.lane + 64 * j) = w; }
            if ((j & 3) == 3) asm volatile("" ::: "memory");
        }
        if (G1) {
            LAS float* rowbuf = (LAS float*)(F.lds + RING_OFF + F.wave * 16384);
#pragma unroll
            for (int j = 0; j < 16; ++j) *(LAS f32x4*)(rowbuf + 256 * j + 4 * F.lane) = v[j];
            LDS_WAIT(); asm volatile("" ::: "memory");
            float a[16];
#pragma unroll
            for (int q = 0; q < 16; ++q) a[q] = 0.f;
#pragma unroll 2
            for (int i = 0; i < 64; ++i) {
                const int k = 64 * i + F.lane;
                const float e = rowbuf[k];
                const GAS f32x4* w = (const GAS f32x4*)(F.wg1 + (size_t)k * GL_R);
                const f32x4 w0 = w[0], w1 = w[1], w2 = w[2], w3 = w[3];
                a[0] += e * w0.x; a[1] += e * w0.y; a[2] += e * w0.z; a[3] += e * w0.w;
                a[4] += e * w1.x; a[5] += e * w1.y; a[6] += e * w1.z; a[7] += e * w1.w;
                a[8] += e * w2.x; a[9] += e * w2.y; a[10] += e * w2.z; a[11] += e * w2.w;
                a[12] += e * w3.x; a[13] += e * w3.y; a[14] += e * w3.z; a[15] += e * w3.w;
            }
#pragma unroll
            for (int q = 0; q < 16; ++q) a[q] = wave_sum(a[q]);
            if (F.lane == 0) {
#pragma unroll
                for (int q = 0; q < 16; q += 4) *(GAS f32x4*)(G1 + (size_t)r * GL_R + q) = (f32x4){a[q], a[q + 1], a[q + 2], a[q + 3]};
            }
            LDS_WAIT(); asm volatile("" ::: "memory");
        }
    }
}

DI_ void p6_l1_rec_naive(Frame& F) {
    LAS float* qs = (LAS float*)(F.lds);
    LAS float* ks = qs + 4096;
    LAS float* gs = ks + 4096;
    LAS float* vs = gs + 4096;
    LAS float* pb = vs + 512;
    const int tid = F.tid, dv = tid & 63, kg = tid >> 6;
    const float qscale = 0.04419417382415922f;
    for (int u = blockIdx.x; u < NB * GL_H * 16; u += F.G) {
        const int dvs = u & 15, bh = u >> 4, b = bh >> 3, h = bh & 7;
        float S[64];
#pragma unroll
        for (int i = 0; i < 64; ++i) S[i] = 0.f;
        float w2[16];
#pragma unroll
        for (int r = 0; r < 16; ++r) w2[r] = F.wg2[(size_t)r * 4096 + h * 512 + tid];
        const float bg = F.b_g[h * 512 + tid];
        for (int tb = 0; tb < 258; ++tb) {
            const int rbase = (tb < 2) ? MX + 8 * tb : b * SEQ + 8 * (tb - 2);
            for (int j = 0; j < 8; ++j) {
                const size_t r = (size_t)(rbase + j);
                const float q = bf2f(F.QFIZ[r * N1 + h * 512 + tid]) * qscale, k = bf2f(F.QFIZ[r * N1 + 4096 + h * 512 + tid]);
                const float* g1 = F.G1 + r * GL_R;
                float xg = bg;
#pragma unroll
                for (int rr = 0; rr < 16; ++rr) xg += g1[rr] * w2[rr];
                const float ls = fminf(xg, 0.f) - log1pf(__expf(-fabsf(xg)));
                qs[j * 512 + tid] = q; ks[j * 512 + tid] = k; gs[j * 512 + tid] = __expf(ls * (1.f / 16.f));
            }
            vs[tid] = bf2f(F.QFIZ[(size_t)(rbase + (tid >> 6)) * N1 + 8192 + h * 1024 + dvs * 64 + (tid & 63)]);
            __syncthreads();
            for (int j = 0; j < 8; ++j) {
                const float vj = vs[j * 64 + dv]; float po = 0.f;
#pragma unroll
                for (int i = 0; i < 64; i += 4) {
                    const f32x4 g4 = *(const LAS f32x4*)(gs + j * 512 + kg * 64 + i), k4 = *(const LAS f32x4*)(ks + j * 512 + kg * 64 + i), q4 = *(const LAS f32x4*)(qs + j * 512 + kg * 64 + i);
                    S[i + 0] = g4.x * S[i + 0] + k4.x * vj; po += q4.x * S[i + 0];
                    S[i + 1] = g4.y * S[i + 1] + k4.y * vj; po += q4.y * S[i + 1];
                    S[i + 2] = g4.z * S[i + 2] + k4.z * vj; po += q4.z * S[i + 2];
                    S[i + 3] = g4.w * S[i + 3] + k4.w * vj; po += q4.w * S[i + 3];
                    if ((i & 12) == 12) asm volatile("" ::: "memory");
                }
                pb[(j * 8 + kg) * 64 + dv] = po;
            }
            __syncthreads();
            {
                const int j = tid >> 6, d = tid & 63; float o = 0.f;
#pragma unroll
                for (int g = 0; g < 8; ++g) o += pb[(j * 8 + g) * 64 + d];
                if (tb >= 2 || b == 0) F.O1[(size_t)(rbase + j) * DI + h * 1024 + dvs * 64 + d] = o;
            }
        }
        __syncthreads();
    }
}

DI_ void p7_normgate(Frame& F) {
    const int gw = F.vcu * NWAVES + F.wave, NGW = F.G * NWAVES;
    for (int it = gw; it < MX * GL_H; it += NGW) {
        const int r = it >> 3, h = it & 7;
        const GAS v4u* o = (const GAS v4u*)((const bf16*)F.O1 + (size_t)r * DI + h * 1024) + F.lane;
        const GAS v4u* zp = (const GAS v4u*)(F.QFIZ + (size_t)r * N1 + 16384 + h * 1024) + F.lane;
        v4u ov[2], zv[2]; float ss = 0.f;
#pragma unroll
        for (int j = 0; j < 2; ++j) { ov[j] = o[64 * j]; zv[j] = zp[64 * j]; }
        float x[2][8];
#pragma unroll
        for (int j = 0; j < 2; ++j) { x[j][0] = bflo(ov[j].x); x[j][1] = bfhi(ov[j].x); x[j][2] = bflo(ov[j].y); x[j][3] = bfhi(ov[j].y); x[j][4] = bflo(ov[j].z); x[j][5] = bfhi(ov[j].z); x[j][6] = bflo(ov[j].w); x[j][7] = bfhi(ov[j].w);
#pragma unroll
            for (int e = 0; e < 8; ++e) ss += x[j][e] * x[j][e]; }
        const float rs = rsqrtf(wave_sum(ss) * (1.f / 1024.f) + RMS_EPS);
#pragma unroll
        for (int j = 0; j < 2; ++j) {
            const int c = h * 1024 + 512 * j + 8 * F.lane;
            const f32x4 n0 = *(const GAS f32x4*)(F.ng1 + c), n1 = *(const GAS f32x4*)(F.ng1 + c + 4);
            const float z[8] = {bflo(zv[j].x), bfhi(zv[j].x), bflo(zv[j].y), bfhi(zv[j].y), bflo(zv[j].z), bfhi(zv[j].z), bflo(zv[j].w), bfhi(zv[j].w)};
            v4u wv; wv.x = pk2(x[j][0] * rs * n0.x * silu(z[0]), x[j][1] * rs * n0.y * silu(z[1])); wv.y = pk2(x[j][2] * rs * n0.z * silu(z[2]), x[j][3] * rs * n0.w * silu(z[3]));
            wv.z = pk2(x[j][4] * rs * n1.x * silu(z[4]), x[j][5] * rs * n1.y * silu(z[5])); wv.w = pk2(x[j][6] * rs * n1.z * silu(z[6]), x[j][7] * rs * n1.w * silu(z[7]));
            *(GAS v4u*)(F.Y + (size_t)r * DI + c) = wv;
        }
    }
}

typedef short bf16x8 __attribute__((ext_vector_type(8)));
#ifndef USE_FUSED_NORM
#define USE_FUSED_NORM 1
#endif
constexpr int NCH = 65;
constexpr int SSP_OFF = 155648 + 512;
constexpr float LOG2E = 1.4426950408889634f;
constexpr int R1_QD = 0, R1_KD = 32768, R1_P = 65536, R1_GL = 67584, R1_SH = 69632;
constexpr int ST1 = R1_SH + 8192;
constexpr int R0_QD = 0, R0_KD = 8192, R0_P = 16384, R0_V = 18432, R0_GL = 26624, R0_SZ = 27648;
constexpr int ST0 = R0_SZ;

DI_ unsigned cvtpk(float lo, float hi) { unsigned r; asm volatile("v_cvt_pk_bf16_f32 %0, %1, %2" : "=v"(r) : "v"(lo), "v"(hi)); return r; }
template <int N> DI_ float row_shr(float x) { return __builtin_bit_cast(float, __builtin_amdgcn_update_dpp(0, __builtin_bit_cast(int, x), 0x110 + N, 0xF, 0xF, true)); }
DI_ float bcast15(float x) { return __builtin_bit_cast(float, __builtin_amdgcn_update_dpp(0, __builtin_bit_cast(int, x), 0x15F, 0xF, 0xF, true)); }
DI_ float scan16(float x) { x += row_shr<1>(x); x += row_shr<2>(x); x += row_shr<4>(x); x += row_shr<8>(x); return x; }
DI_ float ex2(float x) { return __builtin_amdgcn_exp2f(x); }
DI_ float lg2(float x) { return __builtin_amdgcn_logf(x); }
DI_ int row_of(int b, int c, int tok) { return c == 0 ? MX + tok - 16 : b * SEQ + 32 * (c - 1) + tok; }
DI_ bf16x8 mk8(unsigned a, unsigned b, unsigned c, unsigned d) { v4u t; t.x = a; t.y = b; t.z = c; t.w = d; return __builtin_bit_cast(bf16x8, t); }
#define MFMA16(a, b, c) __builtin_amdgcn_mfma_f32_16x16x32_bf16((a), (b), (c), 0, 0, 0)

DI_ void l1_prep(Frame& F, unsigned char* REC1, unsigned char* VF1, const bf16* W2F) {
    const int lane = F.lane, w = F.wave, r = lane & 15, g = lane >> 4;
    LAS unsigned char* T = F.lds + w * 16384;
    LAS unsigned char* Tv = F.lds + w * 16384 + 4096;
    LAS f32x4* Pp = (LAS f32x4*)(F.lds + 131072);
    const float qscale = 0.04419417382415922f;
    for (int it = blockIdx.x; it < NB * GL_H * NCH; it += F.G) {
        const int bh = it / NCH, c = it - bh * NCH, b = bh >> 3, h = bh & 7;
        unsigned char* rec = REC1 + (size_t)it * R1_SH;
        int row[2]; bool nul[2];
#pragma unroll
        for (int ti = 0; ti < 2; ++ti) { const int tok = 16 * ti + r; nul[ti] = (c == 0 && tok < 16); row[ti] = nul[ti] ? 0 : row_of(b, c, tok); }
        bf16x8 g1f[2];
#pragma unroll
        for (int ti = 0; ti < 2; ++ti) {
            f32x4 t0 = (f32x4){0.f, 0.f, 0.f, 0.f}, t1 = t0;
            if (g < 2) { const GAS f32x4* gp = (const GAS f32x4*)(F.G1 + (size_t)row[ti] * GL_R + 8 * g); t0 = gp[0]; t1 = gp[1]; }
            g1f[ti] = mk8(pk2(t0.x, t0.y), pk2(t0.z, t0.w), pk2(t1.x, t1.y), pk2(t1.z, t1.w));
        }
        f32x4 pacc[3];
#pragma unroll
        for (int t = 0; t < 3; ++t) pacc[t] = (f32x4){0.f, 0.f, 0.f, 0.f};
        v4u qraw[2][2], kraw[2][2];
#pragma unroll
        for (int si = 0; si < 2; ++si)
#pragma unroll
            for (int ti = 0; ti < 2; ++ti) { const bf16* rp = F.QFIZ + (size_t)row[ti] * N1 + h * 512 + 32 * (2 * w + si) + 8 * g; qraw[si][ti] = *(const GAS v4u*)rp; kraw[si][ti] = *(const GAS v4u*)(rp + 4096); }
        asm volatile("" ::: "memory");
#pragma unroll
        for (int si = 0; si < 2; ++si) {
            const int s = 2 * w + si, col = h * 512 + 32 * s + 8 * g;
            float xg[2][8];
            { const f32x4 b0 = *(const GAS f32x4*)(F.b_g + col), b1 = *(const GAS f32x4*)(F.b_g + col + 4);
              const bf16x8 wa = *(const GAS bf16x8*)(W2F + ((size_t)((h * 16 + s) * 2 + 0) * 64 + lane) * 8), wb = *(const GAS bf16x8*)(W2F + ((size_t)((h * 16 + s) * 2 + 1) * 64 + lane) * 8);
#pragma unroll
              for (int ti = 0; ti < 2; ++ti) { const f32x4 xa = MFMA16(wa, g1f[ti], b0), xb = MFMA16(wb, g1f[ti], b1);
                  xg[ti][0] = xa.x; xg[ti][1] = xa.y; xg[ti][2] = xa.z; xg[ti][3] = xa.w; xg[ti][4] = xb.x; xg[ti][5] = xb.y; xg[ti][6] = xb.z; xg[ti][7] = xb.w; } }
            float qv[2][8], kv[2][8];
#pragma unroll
            for (int ti = 0; ti < 2; ++ti) {
                const v4u q4 = qraw[si][ti], k4 = kraw[si][ti];
                qv[ti][0] = bflo(q4.x); qv[ti][1] = bfhi(q4.x); qv[ti][2] = bflo(q4.y); qv[ti][3] = bfhi(q4.y); qv[ti][4] = bflo(q4.z); qv[ti][5] = bfhi(q4.z); qv[ti][6] = bflo(q4.w); qv[ti][7] = bfhi(q4.w);
                kv[ti][0] = bflo(k4.x); kv[ti][1] = bfhi(k4.x); kv[ti][2] = bflo(k4.y); kv[ti][3] = bfhi(k4.y); kv[ti][4] = bflo(k4.z); kv[ti][5] = bfhi(k4.z); kv[ti][6] = bflo(k4.w); kv[ti][7] = bfhi(k4.w);
            }
            unsigned qd[2][4], ki[2][4], kd[2][4]; float gl[8];
#pragma unroll
            for (int e = 0; e < 8; e += 2) {
                float bb[2][2], BB[2];
#pragma unroll
                for (int u = 0; u < 2; ++u) {
                    float L0 = nul[0] ? 0.f : (fminf(xg[0][e + u], 0.f) * LOG2E - lg2(1.f + ex2(-fabsf(xg[0][e + u]) * LOG2E))) * (1.f / 16.f);
                    float L1 = nul[1] ? 0.f : (fminf(xg[1][e + u], 0.f) * LOG2E - lg2(1.f + ex2(-fabsf(xg[1][e + u]) * LOG2E))) * (1.f / 16.f);
                    const float b0 = scan16(L0);
                    const float b1 = scan16(L1) + bcast15(b0);
                    bb[0][u] = b0; bb[1][u] = b1; BB[u] = bcast15(b1);
                    gl[e + u] = ex2(BB[u]);
                }
#pragma unroll
                for (int ti = 0; ti < 2; ++ti) {
                    const float q0 = nul[ti] ? 0.f : qv[ti][e] * qscale, q1 = nul[ti] ? 0.f : qv[ti][e + 1] * qscale;
                    const float k0 = nul[ti] ? 0.f : kv[ti][e], k1 = nul[ti] ? 0.f : kv[ti][e + 1];
                    const float ki0 = k0 * ex2(-bb[ti][0]), ki1 = k1 * ex2(-bb[ti][1]);
                    qd[ti][e >> 1] = cvtpk(q0 * ex2(bb[ti][0]), q1 * ex2(bb[ti][1]));
                    ki[ti][e >> 1] = cvtpk(ki0, ki1);
                    kd[ti][e >> 1] = cvtpk(ki0 * gl[e], ki1 * gl[e + 1]);
                }
            }
            const bf16x8 qf0 = mk8(qd[0][0], qd[0][1], qd[0][2], qd[0][3]), qf1 = mk8(qd[1][0], qd[1][1], qd[1][2], qd[1][3]);
            const bf16x8 kf0 = mk8(ki[0][0], ki[0][1], ki[0][2], ki[0][3]), kf1 = mk8(ki[1][0], ki[1][1], ki[1][2], ki[1][3]);
            pacc[0] = MFMA16(kf0, qf0, pacc[0]);
            pacc[1] = MFMA16(kf0, qf1, pacc[1]);
            pacc[2] = MFMA16(kf1, qf1, pacc[2]);
#pragma unroll
            for (int ti = 0; ti < 2; ++ti)
#pragma unroll
                for (int h2 = 0; h2 < 2; ++h2) {
                    const int lp = (2 * (g & 1) + h2) * 16 + r;
                    v2u d; d.x = qd[ti][2 * h2]; d.y = qd[ti][2 * h2 + 1];
                    *(GAS v2u*)(rec + R1_QD + ((ti * 16 + s) * 64 + lp) * 16 + (g >> 1) * 8) = d;
                }
#pragma unroll
            for (int ti = 0; ti < 2; ++ti)
#pragma unroll
                for (int e = 0; e < 8; ++e) {
                    const unsigned wd = kd[ti][e >> 1]; const unsigned short hv = (e & 1) ? (unsigned short)(wd >> 16) : (unsigned short)(wd & 0xffffu);
                    *(LAS unsigned short*)(T + (32 * si + 8 * g + e) * 64 + (16 * ti + r) * 2) = hv;
                }
            if (r == 0) { *(GAS f32x4*)(rec + R1_GL + (32 * s + 8 * g) * 4) = (f32x4){gl[0], gl[1], gl[2], gl[3]}; *(GAS f32x4*)(rec + R1_GL + (32 * s + 8 * g + 4) * 4) = (f32x4){gl[4], gl[5], gl[6], gl[7]}; }
        }
#pragma unroll
        for (int t = 0; t < 3; ++t) Pp[(w * 3 + t) * 64 + lane] = pacc[t];
        LDS_WAIT(); asm volatile("" ::: "memory");
#pragma unroll
        for (int ml = 0; ml < 4; ++ml) { const v4u d = *(const LAS v4u*)(T + (16 * ml + r) * 64 + 16 * g); *(GAS v4u*)(rec + R1_KD + ((4 * w + ml) * 64 + lane) * 16) = d; }
        __syncthreads();
        if (w < 4) {
            const int tj = (w == 2 || w == 3) ? 1 : 0, ti = (w == 1 || w == 2) ? 1 : 0;
            f32x4 sum = (f32x4){0.f, 0.f, 0.f, 0.f};
            if (w < 3) {
#pragma unroll
                for (int ww = 0; ww < 8; ++ww) sum += Pp[(ww * 3 + w) * 64 + lane];
            }
            float pv[4] = {sum.x, sum.y, sum.z, sum.w};
#pragma unroll
            for (int jj = 0; jj < 4; ++jj) { const int j = 16 * tj + 4 * g + jj, i = 16 * ti + r; if (j > i) pv[jj] = 0.f; }
            const int lp = (2 * tj + (g >> 1)) * 16 + r;
            v2u d; d.x = cvtpk(pv[0], pv[1]); d.y = cvtpk(pv[2], pv[3]);
            *(GAS v2u*)(rec + R1_P + (ti * 64 + lp) * 16 + 8 * (g & 1)) = d;
        }
        __syncthreads();
    }
}

template <int VAR> DI_ void l1_seq(Frame& F, const unsigned char* REC1, const unsigned char* VF1, float* O1, float* SS) {
    const int lane = F.lane, w = F.wave, r = lane & 15, g = lane >> 4;
    for (int u = F.vcu; u < NB * GL_H * 8; u += F.G) {
        const int bh = u >> 3, ds = u & 7, b = bh >> 3, h = bh & 7;
        f32x4 acc[32];
#pragma unroll
        for (int m = 0; m < 32; ++m) acc[m] = (f32x4){0.f, 0.f, 0.f, 0.f};
#define L1_DMA(c_) do { const unsigned char* rs_ = REC1 + (size_t)(bh * NCH + (c_)) * R1_SH; LAS unsigned char* st_ = F.lds + ((c_) & 1) * ST1; \
        for (int p_ = w; p_ < 76; p_ += 8) { const unsigned char* src_; \
            if (p_ < 68) src_ = rs_ + p_ * 1024 + lane * 16; \
            else { const int tk_ = 4 * (p_ - 68) + (lane >> 4);         \
                   src_ = ((c_) == 0 && tk_ < 16) ? (const unsigned char*)(F.H1B + (size_t)MR * D) + (lane & 15) * 16 \
                        : (const unsigned char*)(F.QFIZ + (size_t)row_of(b, (c_), tk_) * N1 + 8192 + h * 1024 + ds * 128) + (lane & 15) * 16; } \
            __builtin_amdgcn_global_load_lds((const unsigned*)src_, (LAS unsigned*)(st_ + p_ * 1024), 16, 0, 0); } } while (0)
        const int ycol = h * 1024 + ds * 128 + 16 * w + 4 * g;
        const f32x4 ng4 = *(const GAS f32x4*)(F.ng1 + ycol);
        const bf16* xz = F.QFIZ + (size_t)(b * SEQ - 32) * N1 + 16384 + ycol;
        v2u zc0 = (v2u){0u, 0u}, zc1 = zc0, zn0 = zc0, zn1 = zc0;
        if (VAR != 1) L1_DMA(0);
        for (int c = 0; c < NCH; ++c) {
            asm volatile("s_waitcnt vmcnt(0) lgkmcnt(0)" ::: "memory");
            __builtin_amdgcn_s_barrier();
            asm volatile("" ::: "memory");
            if (VAR != 1 && c + 1 < NCH) L1_DMA(c + 1);
            if (USE_FUSED_NORM && VAR == 0 && c >= 2 && w == 0 && lane < 32) {
                const LAS float* pp = (const LAS float*)(F.lds + SSP_OFF) + ((c - 1) & 1) * 256 + lane; float sm = 0.f;
#pragma unroll
                for (int ww = 0; ww < 8; ++ww) sm += pp[ww * 32];
                SS[(size_t)(b * SEQ + 32 * (c - 2) + lane) * 64 + h * 8 + ds] = sm; }
            if (USE_FUSED_NORM && c + 1 < NCH) { const bf16* zp = xz + (size_t)((c + 1) * 32 + r) * N1; zn0 = *(const GAS v2u*)zp; zn1 = *(const GAS v2u*)(zp + (size_t)16 * N1); }
            if (VAR == 2) continue;
            const LAS unsigned char* st = F.lds + (c & 1) * ST1;
            unsigned short vh[8];
#pragma unroll
            for (int e = 0; e < 8; ++e) vh[e] = *(const LAS unsigned short*)(st + R1_SH + (8 * g + e) * 256 + (16 * w + r) * 2);
            const bf16x8 vf = mk8(vh[0] | ((unsigned)vh[1] << 16), vh[2] | ((unsigned)vh[3] << 16), vh[4] | ((unsigned)vh[5] << 16), vh[6] | ((unsigned)vh[7] << 16));
#define SCHED_FENCE() __builtin_amdgcn_sched_barrier(0)
            if (c > 0) {
                f32x4 o0 = (f32x4){0.f, 0.f, 0.f, 0.f}, o1 = o0;
                bf16x8 qb[2][4];
#define LDQ(buf_, gi_) do { _Pragma("unroll") for (int sl_ = 0; sl_ < 2; ++sl_) { qb[buf_][sl_] = *(const LAS bf16x8*)(st + R1_QD + (2 * (gi_) + sl_) * 1024 + lane * 16); \
                    qb[buf_][2 + sl_] = *(const LAS bf16x8*)(st + R1_QD + (16 + 2 * (gi_) + sl_) * 1024 + lane * 16); } } while (0)
                const bf16x8 p0 = *(const LAS bf16x8*)(st + R1_P + lane * 16), p1 = *(const LAS bf16x8*)(st + R1_P + 1024 + lane * 16);
                LDQ(0, 0);
                SCHED_FENCE();
                o0 = MFMA16(vf, p0, o0); o1 = MFMA16(vf, p1, o1);
#pragma unroll
                for (int gi = 0; gi < 8; ++gi) {
                    if (gi < 7) LDQ((gi + 1) & 1, gi + 1);
                    SCHED_FENCE();
#pragma unroll
                    for (int sl = 0; sl < 2; ++sl) { const int s2 = 2 * gi + sl;
                        const bf16x8 sb = mk8(cvtpk(acc[2 * s2].x, acc[2 * s2].y), cvtpk(acc[2 * s2].z, acc[2 * s2].w), cvtpk(acc[2 * s2 + 1].x, acc[2 * s2 + 1].y), cvtpk(acc[2 * s2 + 1].z, acc[2 * s2 + 1].w));
                        o0 = MFMA16(sb, qb[gi & 1][sl], o0); o1 = MFMA16(sb, qb[gi & 1][2 + sl], o1); }
                    SCHED_FENCE();
                }
#undef LDQ
                if (VAR == 1) { asm volatile("" :: "v"(o0), "v"(o1)); } else if (USE_FUSED_NORM) {
                    float t0 = (o0.x * o0.x + o0.y * o0.y) + (o0.z * o0.z + o0.w * o0.w), t1 = (o1.x * o1.x + o1.y * o1.y) + (o1.z * o1.z + o1.w * o1.w);
                    t0 += __shfl_xor(t0, 16); t1 += __shfl_xor(t1, 16); t0 += __shfl_xor(t0, 32); t1 += __shfl_xor(t1, 32);
                    const int row0 = b * SEQ + 32 * (c - 1) + r;
                    if (g == 0) { LAS float* pp = (LAS float*)(F.lds + SSP_OFF) + ((c & 1) * 8 + w) * 32; pp[r] = t0; pp[16 + r] = t1; }
                    const float y0 = o0.x * ng4.x * silu(bflo(zc0.x)), y1 = o0.y * ng4.y * silu(bfhi(zc0.x)), y2 = o0.z * ng4.z * silu(bflo(zc0.y)), y3 = o0.w * ng4.w * silu(bfhi(zc0.y));
                    const float y4 = o1.x * ng4.x * silu(bflo(zc1.x)), y5 = o1.y * ng4.y * silu(bfhi(zc1.x)), y6 = o1.z * ng4.z * silu(bflo(zc1.y)), y7 = o1.w * ng4.w * silu(bfhi(zc1.y));
                    bf16* op = F.Y + (size_t)row0 * DI + ycol;
                    *(GAS v2u*)op = (v2u){cvtpk(y0, y1), cvtpk(y2, y3)}; *(GAS v2u*)(op + (size_t)16 * DI) = (v2u){cvtpk(y4, y5), cvtpk(y6, y7)};
                } else {
                    bf16* op = (bf16*)O1 + (size_t)(b * SEQ + 32 * (c - 1) + r) * DI + h * 1024 + ds * 128 + 16 * w + 4 * g;
                    *(GAS v2u*)op = (v2u){pk2(o0.x, o0.y), pk2(o0.z, o0.w)}; *(GAS v2u*)(op + (size_t)16 * DI) = (v2u){pk2(o1.x, o1.y), pk2(o1.z, o1.w)}; }
            }
            {
                f32x4 ug[2][4]; bf16x8 uk[2][4];
#define LDU(buf_, gi_) do { _Pragma("unroll") for (int ml_ = 0; ml_ < 4; ++ml_) { const int m_ = 4 * (gi_) + ml_; ug[buf_][ml_] = *(const LAS f32x4*)(st + R1_GL + (16 * m_ + 4 * g) * 4); \
                    uk[buf_][ml_] = *(const LAS bf16x8*)(st + R1_KD + m_ * 1024 + lane * 16); } } while (0)
                LDU(0, 0);
                SCHED_FENCE();
#pragma unroll
                for (int gi = 0; gi < 8; ++gi) {
                    if (gi < 7) LDU((gi + 1) & 1, gi + 1);
                    SCHED_FENCE();
#pragma unroll
                    for (int ml = 0; ml < 4; ++ml) { const int m = 4 * gi + ml; acc[m] = MFMA16(uk[gi & 1][ml], vf, acc[m] * ug[gi & 1][ml]); }
                    SCHED_FENCE();
                }
#undef LDU
            }
            if (USE_FUSED_NORM) { zc0 = zn0; zc1 = zn1; }
        }
#undef L1_DMA
        if (VAR == 1) { _Pragma("unroll") for (int m = 0; m < 32; ++m) asm volatile("" :: "v"(acc[m])); }
        asm volatile("s_waitcnt vmcnt(0) lgkmcnt(0)" ::: "memory");
        __builtin_amdgcn_s_barrier();
        if (USE_FUSED_NORM && VAR == 0 && w == 0 && lane < 32) {
            const LAS float* pp = (const LAS float*)(F.lds + SSP_OFF) + ((NCH - 1) & 1) * 256 + lane; float sm = 0.f;
#pragma unroll
            for (int ww = 0; ww < 8; ++ww) sm += pp[ww * 32];
            SS[(size_t)(b * SEQ + 32 * (NCH - 2) + lane) * 64 + h * 8 + ds] = sm; }
        asm volatile("s_waitcnt vmcnt(0) lgkmcnt(0)" ::: "memory");
    }
}

constexpr int R2_QD = 0, R2_KD = 32768, R2_P = 65536, R2_GL = 67584, ST2 = 69632, X2_OFF = 2 * ST2;
DI_ void l1_seq2(Frame& F, const unsigned char* REC1) {
    const int lane = F.lane, w = F.wave, r = lane & 15, g = lane >> 4, dkh = w >> 2, dvq = w & 3;
    for (int u = F.vcu; u < NB * GL_H * 8; u += F.G) {
        const int bh = u >> 3, ds = u & 7, b = bh >> 3, h = bh & 7;
        f32x4 acc[16][2];
#pragma unroll
        for (int m = 0; m < 16; ++m) { acc[m][0] = (f32x4){0.f, 0.f, 0.f, 0.f}; acc[m][1] = acc[m][0]; }
        const int vcol = 8192 + h * 1024 + ds * 128 + 32 * dvq + r;
        int voff[8];
#pragma unroll
        for (int e = 0; e < 8; ++e) voff[e] = (8 * g + e) * N1 + vcol;
        const bf16* xv = F.QFIZ + (size_t)(b * SEQ - 32) * N1;
#define VCH(c_) (((c_) == 0) ? F.QFIZ + (size_t)(MX - 16) * N1 : xv + (size_t)(c_) * 32 * N1)
#define L2_DMA(c_) do { const unsigned char* rs_ = REC1 + (size_t)(bh * NCH + (c_)) * R1_SH; LAS unsigned char* st_ = F.lds + ((c_) & 1) * ST2; \
        _Pragma("unroll") for (int i_ = 0; i_ < 8; ++i_) { const int p_ = w + 8 * i_; __builtin_amdgcn_global_load_lds((const unsigned*)(rs_ + p_ * 1024 + lane * 16), (LAS unsigned*)(st_ + p_ * 1024), 16, 0, 0); } \
        if (w < 4) __builtin_amdgcn_global_load_lds((const unsigned*)(rs_ + (w + 64) * 1024 + lane * 16), (LAS unsigned*)(st_ + (w + 64) * 1024), 16, 0, 0); } while (0)
#define L2_VLOAD(c_, set_) do { const bf16* vb_ = VCH(c_); _Pragma("unroll") for (int e_ = 0; e_ < 8; ++e_) { vr[set_][0][e_] = (unsigned)*(const GAS unsigned short*)(vb_ + voff[e_]); vr[set_][1][e_] = (unsigned)*(const GAS unsigned short*)(vb_ + voff[e_] + 16); } } while (0)
        unsigned vr[2][2][8];
        f32x4 keep[2][2];
        L2_DMA(0); L2_VLOAD(0, 0);
#define L2_BODY(C_, PAR) do { const int c = (C_); \
            asm volatile("s_waitcnt vmcnt(0)" ::: "memory"); \
            __builtin_amdgcn_s_barrier(); \
            asm volatile("" ::: "memory"); \
            if (c >= 2 && c <= NCH) {                                  \
                const v4u px = *(const LAS v4u*)(F.lds + X2_OFF + (PAR ^ 1) * 8192 + (w ^ 4) * 1024 + lane * 16); \
                const f32x4 a0 = keep[PAR ^ 1][0] + (f32x4){bflo(px.x), bfhi(px.x), bflo(px.y), bfhi(px.y)}, a1 = keep[PAR ^ 1][1] + (f32x4){bflo(px.z), bfhi(px.z), bflo(px.w), bfhi(px.w)}; \
                bf16* op = (bf16*)F.O1 + (size_t)(b * SEQ + 32 * (c - 2) + r) * DI + h * 1024 + ds * 128 + 32 * dvq + 16 * dkh + 4 * g; \
                *(GAS v2u*)op = (v2u){pk2(a0.x, a0.y), pk2(a0.z, a0.w)}; *(GAS v2u*)(op + (size_t)16 * DI) = (v2u){pk2(a1.x, a1.y), pk2(a1.z, a1.w)}; } \
            if (c + 1 < NCH) { L2_VLOAD(c + 1, PAR ^ 1); L2_DMA(c + 1); }          \
            if (c < NCH) { \
                const LAS unsigned char* st = F.lds + (c & 1) * ST2; \
                bf16x8 vf[2]; \
                _Pragma("unroll") for (int t_ = 0; t_ < 2; ++t_) { _Pragma("unroll") for (int e_ = 0; e_ < 8; ++e_) asm volatile("" : "+v"(vr[PAR][t_][e_]));     \
                    vf[t_] = mk8(vr[PAR][t_][0] | (vr[PAR][t_][1] << 16), vr[PAR][t_][2] | (vr[PAR][t_][3] << 16), vr[PAR][t_][4] | (vr[PAR][t_][5] << 16), vr[PAR][t_][6] | (vr[PAR][t_][7] << 16)); } \
                const LAS f32x4* glp = (const LAS f32x4*)(st + R2_GL + (256 * dkh + 4 * g) * 4); \
                f32x4 ug[2][2]; bf16x8 uk[2][2]; \
                if (c > 0) { \
                    f32x4 o[2][2]; \
                    _Pragma("unroll") for (int ti = 0; ti < 2; ++ti) { o[ti][0] = (f32x4){0.f, 0.f, 0.f, 0.f}; o[ti][1] = o[ti][0]; } \
                    if (dkh == 0) { const bf16x8 p0 = *(const LAS bf16x8*)(st + R2_P + lane * 16), p1 = *(const LAS bf16x8*)(st + R2_P + 1024 + lane * 16); \
                        o[0][0] = MFMA16(vf[0], p0, o[0][0]); o[0][1] = MFMA16(vf[1], p0, o[0][1]); o[1][0] = MFMA16(vf[0], p1, o[1][0]); o[1][1] = MFMA16(vf[1], p1, o[1][1]); } \
                    bf16x8 qb[2][2]; \
                    qb[0][0] = *(const LAS bf16x8*)(st + R2_QD + (8 * dkh) * 1024 + lane * 16); qb[0][1] = *(const LAS bf16x8*)(st + R2_QD + (16 + 8 * dkh) * 1024 + lane * 16); \
                    SCHED_FENCE(); \
                    _Pragma("unroll") for (int s2 = 0; s2 < 8; ++s2) { \
                        if (s2 < 7) { qb[(s2 + 1) & 1][0] = *(const LAS bf16x8*)(st + R2_QD + (8 * dkh + s2 + 1) * 1024 + lane * 16); qb[(s2 + 1) & 1][1] = *(const LAS bf16x8*)(st + R2_QD + (16 + 8 * dkh + s2 + 1) * 1024 + lane * 16); } \
                        SCHED_FENCE(); \
                        _Pragma("unroll") for (int t_ = 0; t_ < 2; ++t_) { \
                            const bf16x8 sb = mk8(cvtpk(acc[2 * s2][t_].x, acc[2 * s2][t_].y), cvtpk(acc[2 * s2][t_].z, acc[2 * s2][t_].w), cvtpk(acc[2 * s2 + 1][t_].x, acc[2 * s2 + 1][t_].y), cvtpk(acc[2 * s2 + 1][t_].z, acc[2 * s2 + 1][t_].w)); \
                            o[0][t_] = MFMA16(sb, qb[s2 & 1][0], o[0][t_]); o[1][t_] = MFMA16(sb, qb[s2 & 1][1], o[1][t_]); } \
                        SCHED_FENCE(); \
                    } \
                      \
                    { const f32x4 s0 = o[0][dkh ^ 1], s1 = o[1][dkh ^ 1]; \
                      *(LAS v4u*)(F.lds + X2_OFF + PAR * 8192 + w * 1024 + lane * 16) = (v4u){pk2(s0.x, s0.y), pk2(s0.z, s0.w), pk2(s1.x, s1.y), pk2(s1.z, s1.w)}; \
                      keep[PAR][0] = o[0][dkh]; keep[PAR][1] = o[1][dkh]; } \
                } \
                _Pragma("unroll") for (int ml_ = 0; ml_ < 2; ++ml_) { ug[0][ml_] = glp[4 * ml_]; uk[0][ml_] = *(const LAS bf16x8*)(st + R2_KD + (16 * dkh + ml_) * 1024 + lane * 16); } \
                SCHED_FENCE(); \
                _Pragma("unroll") for (int gi = 0; gi < 8; ++gi) { \
                    if (gi < 7) { _Pragma("unroll") for (int ml_ = 0; ml_ < 2; ++ml_) { const int m_ = 2 * (gi + 1) + ml_; ug[(gi + 1) & 1][ml_] = glp[4 * m_]; uk[(gi + 1) & 1][ml_] = *(const LAS bf16x8*)(st + R2_KD + (16 * dkh + m_) * 1024 + lane * 16); } } \
                    SCHED_FENCE(); \
                    _Pragma("unroll") for (int ml = 0; ml < 2; ++ml) { const int m = 2 * gi + ml; \
                        acc[m][0] = MFMA16(uk[gi & 1][ml], vf[0], acc[m][0] * ug[gi & 1][ml]); acc[m][1] = MFMA16(uk[gi & 1][ml], vf[1], acc[m][1] * ug[gi & 1][ml]); } \
                    SCHED_FENCE(); \
                } \
                asm volatile("s_waitcnt lgkmcnt(0)" ::: "memory"); \
            } \
        } while (0)
        for (int c2 = 0; c2 <= NCH; c2 += 2) { L2_BODY(c2, 0); L2_BODY(c2 + 1, 1); }
#undef L2_BODY
#undef L2_VLOAD
#undef L2_DMA
#undef VCH
        asm volatile("s_waitcnt vmcnt(0) lgkmcnt(0)" ::: "memory");
        __builtin_amdgcn_s_barrier();
    }
}

DI_ void l0_prep(Frame& F, unsigned char* REC0) {
    const int lane = F.lane, w = F.wave, r = lane & 15, g = lane >> 4;
    LAS unsigned char* T = F.lds + w * 16640;
    LAS unsigned char* Tv = T + 8192;
    const int gw = F.vcu * NWAVES + w, NGW = F.G * NWAVES;
    for (int it = gw; it < NB * HG_H * NCH; it += NGW) {
        const int bh = it / NCH, c = it - bh * NCH, b = bh >> 6, h = bh & 63;
        unsigned char* rec = REC0 + (size_t)it * R0_SZ;
        int row[2]; bool nul[2];
#pragma unroll
        for (int ti = 0; ti < 2; ++ti) { const int tok = 16 * ti + r; nul[ti] = (c == 0 && tok < 16); row[ti] = nul[ti] ? 0 : row_of(b, c, tok); }
        f32x4 pacc[3];
#pragma unroll
        for (int t = 0; t < 3; ++t) pacc[t] = (f32x4){0.f, 0.f, 0.f, 0.f};
        v4u qraw[4][2], fraw[4][2], vraw[8];
#pragma unroll
        for (int s = 0; s < 4; ++s)
#pragma unroll
            for (int ti = 0; ti < 2; ++ti) { const bf16* rp = F.QFIZ + (size_t)row[ti] * N0 + h * 128 + 32 * s + 8 * g; qraw[s][ti] = *(const GAS v4u*)rp; fraw[s][ti] = *(const GAS v4u*)(rp + DI); }
#pragma unroll
        for (int i = 0; i < 8; ++i) { const int q = lane + 64 * i, tk = q >> 4, c16 = q & 15; const bool nl = (c == 0 && tk < 16);
            vraw[i] = (v4u){0u, 0u, 0u, 0u}; if (!nl) vraw[i] = *(const GAS v4u*)(F.QFIZ + (size_t)row_of(b, c, tk) * N0 + 2 * DI + h * 128 + 8 * c16); }
        asm volatile("" ::: "memory");
#pragma unroll
        for (int s = 0; s < 4; ++s) {
            const int col = h * 128 + 32 * s + 8 * g;
            float lbv[8], bfv[8];
            { const f32x4 a0 = *(const GAS f32x4*)(F.LB0 + col), a1 = *(const GAS f32x4*)(F.LB0 + col + 4), c0 = *(const GAS f32x4*)(F.b_f + col), c1 = *(const GAS f32x4*)(F.b_f + col + 4);
              lbv[0] = a0.x; lbv[1] = a0.y; lbv[2] = a0.z; lbv[3] = a0.w; lbv[4] = a1.x; lbv[5] = a1.y; lbv[6] = a1.z; lbv[7] = a1.w;
              bfv[0] = c0.x; bfv[1] = c0.y; bfv[2] = c0.z; bfv[3] = c0.w; bfv[4] = c1.x; bfv[5] = c1.y; bfv[6] = c1.z; bfv[7] = c1.w; }
            float qv[2][8], fv[2][8];
#pragma unroll
            for (int ti = 0; ti < 2; ++ti) {
                const v4u q4 = qraw[s][ti], f4 = fraw[s][ti];
                qv[ti][0] = bflo(q4.x); qv[ti][1] = bfhi(q4.x); qv[ti][2] = bflo(q4.y); qv[ti][3] = bfhi(q4.y); qv[ti][4] = bflo(q4.z); qv[ti][5] = bfhi(q4.z); qv[ti][6] = bflo(q4.w); qv[ti][7] = bfhi(q4.w);
                fv[ti][0] = bflo(f4.x); fv[ti][1] = bfhi(f4.x); fv[ti][2] = bflo(f4.y); fv[ti][3] = bfhi(f4.y); fv[ti][4] = bflo(f4.z); fv[ti][5] = bfhi(f4.z); fv[ti][6] = bflo(f4.w); fv[ti][7] = bfhi(f4.w);
            }
            unsigned qd[2][4], ki[2][4], kd[2][4]; float gl[8];
#pragma unroll
            for (int e = 0; e < 8; e += 2) {
                float bb[2][2], BB[2], kk[2][2];
#pragma unroll
                for (int u = 0; u < 2; ++u) {
                    const float fg0 = lbv[e + u] + (1.f - lbv[e + u]) * sigm(fv[0][e + u] + bfv[e + u]);
                    const float fg1 = lbv[e + u] + (1.f - lbv[e + u]) * sigm(fv[1][e + u] + bfv[e + u]);
                    const float L0 = nul[0] ? 0.f : lg2(fg0), L1 = nul[1] ? 0.f : lg2(fg1);
                    kk[0][u] = nul[0] ? 0.f : 1.f - fg0; kk[1][u] = nul[1] ? 0.f : 1.f - fg1;
                    const float b0 = scan16(L0);
                    const float b1 = scan16(L1) + bcast15(b0);
                    bb[0][u] = b0; bb[1][u] = b1; BB[u] = bcast15(b1);
                    gl[e + u] = ex2(BB[u]);
                }
#pragma unroll
                for (int ti = 0; ti < 2; ++ti) {
                    const float q0 = nul[ti] ? 0.f : silu(qv[ti][e]), q1 = nul[ti] ? 0.f : silu(qv[ti][e + 1]);
                    qd[ti][e >> 1] = cvtpk(q0 * ex2(bb[ti][0]), q1 * ex2(bb[ti][1]));
                    ki[ti][e >> 1] = cvtpk(kk[ti][0] * ex2(-bb[ti][0]), kk[ti][1] * ex2(-bb[ti][1]));
                    kd[ti][e >> 1] = cvtpk(kk[ti][0] * ex2(BB[0] - bb[ti][0]), kk[ti][1] * ex2(BB[1] - bb[ti][1]));
                }
            }
            const bf16x8 qf0 = mk8(qd[0][0], qd[0][1], qd[0][2], qd[0][3]), qf1 = mk8(qd[1][0], qd[1][1], qd[1][2], qd[1][3]);
            const bf16x8 kf0 = mk8(ki[0][0], ki[0][1], ki[0][2], ki[0][3]), kf1 = mk8(ki[1][0], ki[1][1], ki[1][2], ki[1][3]);
            pacc[0] = MFMA16(kf0, qf0, pacc[0]);
            pacc[1] = MFMA16(kf0, qf1, pacc[1]);
            pacc[2] = MFMA16(kf1, qf1, pacc[2]);
#pragma unroll
            for (int ti = 0; ti < 2; ++ti)
#pragma unroll
                for (int h2 = 0; h2 < 2; ++h2) {
                    const int lp = (2 * (g & 1) + h2) * 16 + r;
                    v2u d; d.x = qd[ti][2 * h2]; d.y = qd[ti][2 * h2 + 1];
                    *(GAS v2u*)(rec + R0_QD + ((ti * 4 + s) * 64 + lp) * 16 + (g >> 1) * 8) = d;
                }
#pragma unroll
            for (int ti = 0; ti < 2; ++ti)
#pragma unroll
                for (int e = 0; e < 8; ++e) {
                    const unsigned wd = kd[ti][e >> 1]; const unsigned short hv = (e & 1) ? (unsigned short)(wd >> 16) : (unsigned short)(wd & 0xffffu);
                    *(LAS unsigned short*)(T + (32 * s + 8 * g + e) * 64 + (16 * ti + r) * 2) = hv;
                }
            if (r == 0) { *(GAS f32x4*)(rec + R0_GL + (32 * s + 8 * g) * 4) = (f32x4){gl[0], gl[1], gl[2], gl[3]}; *(GAS f32x4*)(rec + R0_GL + (32 * s + 8 * g + 4) * 4) = (f32x4){gl[4], gl[5], gl[6], gl[7]}; }
        }
#pragma unroll
        for (int t = 0; t < 4; ++t) {
            const int tj = (t >= 2) ? 1 : 0, ti = (t == 1 || t == 2) ? 1 : 0;
            float pv[4] = {0.f, 0.f, 0.f, 0.f};
            if (t < 3) { pv[0] = pacc[t].x; pv[1] = pacc[t].y; pv[2] = pacc[t].z; pv[3] = pacc[t].w; }
#pragma unroll
            for (int jj = 0; jj < 4; ++jj) { const int j = 16 * tj + 4 * g + jj, i = 16 * ti + r; if (j > i) pv[jj] = 0.f; }
            const int lp = (2 * tj + (g >> 1)) * 16 + r;
            v2u d; d.x = cvtpk(pv[0], pv[1]); d.y = cvtpk(pv[2], pv[3]);
            *(GAS v2u*)(rec + R0_P + (ti * 64 + lp) * 16 + 8 * (g & 1)) = d;
        }
#pragma unroll
        for (int i = 0; i < 8; ++i) {
            const int q = lane + 64 * i, tk = q >> 4, c16 = q & 15; const v4u d = vraw[i];
            *(LAS v2u*)(Tv + tk * 264 + c16 * 16) = (v2u){d.x, d.y}; *(LAS v2u*)(Tv + tk * 264 + c16 * 16 + 8) = (v2u){d.z, d.w};
        }
        LDS_WAIT(); asm volatile("" ::: "memory");
#pragma unroll
        for (int mt = 0; mt < 8; ++mt) { const v4u d = *(const LAS v4u*)(T + (16 * mt + r) * 64 + 16 * g); *(GAS v4u*)(rec + R0_KD + (mt * 64 + lane) * 16) = d; }
#pragma unroll
        for (int sl = 0; sl < 8; ++sl) {
            unsigned short hv[8];
#pragma unroll
            for (int e = 0; e < 8; ++e) hv[e] = *(const LAS unsigned short*)(Tv + (8 * g + e) * 264 + (16 * sl + r) * 2);
            v4u d; d.x = hv[0] | ((unsigned)hv[1] << 16); d.y = hv[2] | ((unsigned)hv[3] << 16); d.z = hv[4] | ((unsigned)hv[5] << 16); d.w = hv[6] | ((unsigned)hv[7] << 16);
            *(GAS v4u*)(rec + R0_V + (sl * 64 + lane) * 16) = d;
        }
        LDS_WAIT(); asm volatile("" ::: "memory");
    }
}

DI_ void l0_seq(Frame& F, const unsigned char* REC0) {
    const int lane = F.lane, w = F.wave, r = lane & 15, g = lane >> 4;
    LAS float* obuf = (LAS float*)(F.lds + 2 * ST0);
    constexpr int OB = 32 * 132;
    for (int u = F.vcu; u < NB * HG_H; u += F.G) {
        const int bh = u, b = bh >> 6, h = bh & 63;
        f32x4 acc[8];
#pragma unroll
        for (int m = 0; m < 8; ++m) acc[m] = (f32x4){0.f, 0.f, 0.f, 0.f};
        const int ntok = 4 * w + g, ndv = 8 * r;
        float ngv[8];
        { const f32x4 a0 = *(const GAS f32x4*)(F.ng0 + h * 128 + ndv), a1 = *(const GAS f32x4*)(F.ng0 + h * 128 + ndv + 4);
          ngv[0] = a0.x; ngv[1] = a0.y; ngv[2] = a0.z; ngv[3] = a0.w; ngv[4] = a1.x; ngv[5] = a1.y; ngv[6] = a1.z; ngv[7] = a1.w; }
#define L0_DMA(c_) do { const unsigned char* rs_ = REC0 + (size_t)(bh * NCH + (c_)) * R0_SZ; LAS unsigned char* st_ = F.lds + ((c_) & 1) * ST0; \
        for (int p_ = w; p_ < 27; p_ += 8) __builtin_amdgcn_global_load_lds((const unsigned*)(rs_ + p_ * 1024 + lane * 16), (LAS unsigned*)(st_ + p_ * 1024), 16, 0, 0); } while (0)
        L0_DMA(0);
        v4u zprev = (v4u){0u, 0u, 0u, 0u};
        for (int c = 0; c <= NCH; ++c) {
            asm volatile("s_waitcnt vmcnt(0)" ::: "memory");
            __builtin_amdgcn_s_barrier();
            asm volatile("" ::: "memory");
            if (c + 1 < NCH) L0_DMA(c + 1);
            v4u zcur = (v4u){0u, 0u, 0u, 0u};
            const bool zvalid = (c < NCH) && !(c == 0 && ntok < 16);
            if (zvalid) zcur = *(const GAS v4u*)(F.QFIZ + (size_t)row_of(b, c, ntok) * N0 + 3 * DI + h * 128 + ndv);
            if (c >= 1) {
                const int cp = c - 1;
                const LAS float* ob = obuf + (cp & 1) * OB + ntok * 132 + ndv;
                const f32x4 x0 = *(const LAS f32x4*)(ob), x1 = *(const LAS f32x4*)(ob + 4);
                float ss = (x0.x * x0.x + x0.y * x0.y) + (x0.z * x0.z + x0.w * x0.w) + (x1.x * x1.x + x1.y * x1.y) + (x1.z * x1.z + x1.w * x1.w);
                ss += __shfl_xor(ss, 8); ss += __shfl_xor(ss, 4); ss += __shfl_xor(ss, 2); ss += __shfl_xor(ss, 1);
                const float rs = rsqrtf(ss * (1.f / 128.f) + RMS_EPS);
                const bool wr = !(cp == 0 && (ntok < 16 || b != 0));
                if (wr) {
                    v4u d;
                    d.x = cvtpk(x0.x * rs * ngv[0] * silu(bflo(zprev.x)), x0.y * rs * ngv[1] * silu(bfhi(zprev.x)));
                    d.y = cvtpk(x0.z * rs * ngv[2] * silu(bflo(zprev.y)), x0.w * rs * ngv[3] * silu(bfhi(zprev.y)));
                    d.z = cvtpk(x1.x * rs * ngv[4] * silu(bflo(zprev.z)), x1.y * rs * ngv[5] * silu(bfhi(zprev.z)));
                    d.w = cvtpk(x1.z * rs * ngv[6] * silu(bflo(zprev.w)), x1.w * rs * ngv[7] * silu(bfhi(zprev.w)));
                    *(GAS v4u*)(F.Y + (size_t)row_of(b, cp, ntok) * DI + h * 128 + ndv) = d;
                }
            }
            zprev = zcur;
            if (c < NCH) {
                const LAS unsigned char* st = F.lds + (c & 1) * ST0;
                const bf16x8 vf = *(const LAS bf16x8*)(st + R0_V + w * 1024 + lane * 16);
                const bf16x8 p0 = *(const LAS bf16x8*)(st + R0_P + lane * 16), p1 = *(const LAS bf16x8*)(st + R0_P + 1024 + lane * 16);
                bf16x8 qf[8], kf[8]; f32x4 gf[8];
#pragma unroll
                for (int q = 0; q < 8; ++q) qf[q] = *(const LAS bf16x8*)(st + R0_QD + q * 1024 + lane * 16);
#pragma unroll
                for (int m = 0; m < 8; ++m) { gf[m] = *(const LAS f32x4*)(st + R0_GL + (16 * m + 4 * g) * 4); kf[m] = *(const LAS bf16x8*)(st + R0_KD + m * 1024 + lane * 16); }
                SCHED_FENCE();
                f32x4 o0 = (f32x4){0.f, 0.f, 0.f, 0.f}, o1 = o0;
                o0 = MFMA16(vf, p0, o0); o1 = MFMA16(vf, p1, o1);
#pragma unroll
                for (int s2 = 0; s2 < 4; ++s2) {
                    const bf16x8 sb = mk8(cvtpk(acc[2 * s2].x, acc[2 * s2].y), cvtpk(acc[2 * s2].z, acc[2 * s2].w), cvtpk(acc[2 * s2 + 1].x, acc[2 * s2 + 1].y), cvtpk(acc[2 * s2 + 1].z, acc[2 * s2 + 1].w));
                    o0 = MFMA16(sb, qf[s2], o0); o1 = MFMA16(sb, qf[4 + s2], o1);
                }
#pragma unroll
                for (int m = 0; m < 8; ++m) acc[m] = MFMA16(kf[m], vf, acc[m] * gf[m]);
                LAS float* ow = obuf + (c & 1) * OB + r * 132 + 16 * w + 4 * g;
                *(LAS f32x4*)ow = o0; *(LAS f32x4*)(ow + 16 * 132) = o1;
                asm volatile("s_waitcnt lgkmcnt(0)" ::: "memory");
            }
        }
#undef L0_DMA
        asm volatile("s_waitcnt vmcnt(0)" ::: "memory");
        __builtin_amdgcn_s_barrier();
    }
}

template <int KS, int MODE>
DI_ void skinny(Frame& F, const bf16* A, const bf16* Bt, int K, int n_first, int n_slices, bf16* Ob, int ldo, float* Of, const float* res) {
    const int lane = F.lane, w = F.wave, r = lane & 15, g = lane >> 4;
    constexpr int SPB = 8 / KS;
    const int kw = w % KS, sw = w / KS, klen = K / KS, kbeg = kw * klen;
    LAS f32x4* red = (LAS f32x4*)F.lds;
    for (int p = F.vcu; p * SPB < n_slices; p += F.G) {
        const int sl = p * SPB + sw, n0 = n_first + 16 * sl;
        f32x4 acc = (f32x4){0.f, 0.f, 0.f, 0.f};
        if (sl < n_slices) {
            const GAS v4u* bp = (const GAS v4u*)(Bt + (size_t)(n0 + r) * K + kbeg + 16 * g);
            const GAS v4u* ap = (const GAS v4u*)(A + (size_t)r * K + kbeg + 16 * g);
            for (int kk = 0; kk < klen; kk += 256) {
                v4u bv[8], av[8];
#pragma unroll
                for (int u = 0; u < 4; ++u) { bv[2 * u] = bp[(kk + 64 * u) / 8]; bv[2 * u + 1] = bp[(kk + 64 * u) / 8 + 1]; av[2 * u] = ap[(kk + 64 * u) / 8]; av[2 * u + 1] = ap[(kk + 64 * u) / 8 + 1]; }
                asm volatile("" ::: "memory");
#pragma unroll
                for (int u = 0; u < 8; ++u) acc = MFMA16(__builtin_bit_cast(bf16x8, bv[u]), __builtin_bit_cast(bf16x8, av[u]), acc);
            }
        }
        if (KS > 1) {
            red[w * 64 + lane] = acc;
            __syncthreads();
            if (kw == 0) {
#pragma unroll
                for (int j = 1; j < KS; ++j) acc += red[(w + j) * 64 + lane];
            }
        }
        if (kw == 0 && sl < n_slices) {
            if (MODE == 0) { v2u d; d.x = pk2(acc.x, acc.y); d.y = pk2(acc.z, acc.w); *(GAS v2u*)(Ob + (size_t)r * ldo + n0 + 4 * g) = d; }
            else { const f32x4 rv = *(const GAS f32x4*)(res + (size_t)r * D + n0 + 4 * g); *(GAS f32x4*)(Of + (size_t)r * D + n0 + 4 * g) = rv * ALPHA + acc; }
        }
        if (KS > 1) __syncthreads();
    }
    asm volatile("s_waitcnt vmcnt(0)" ::: "memory");
}

DI_ void gate_proj(Frame& F, const bf16* WG1T  ) {
    const int lane = F.lane, w = F.wave, r = lane & 15, g = lane >> 4, kw = w & 3, sw = w >> 2;
    LAS f32x4* red = (LAS f32x4*)F.lds;
    for (int p = F.vcu; 2 * p < MR / 16; p += F.G) {
        const int t = 2 * p + sw;
        f32x4 acc = (f32x4){0.f, 0.f, 0.f, 0.f};
        if (t < MR / 16) {
            const GAS v4u* wp = (const GAS v4u*)(WG1T + (size_t)r * D + 1024 * kw + 16 * g);
            const GAS v4u* hp = (const GAS v4u*)(F.H1B + (size_t)(16 * t + r) * D + 1024 * kw + 16 * g);
            for (int kk = 0; kk < 1024; kk += 256) {
                v4u wv[8], hv[8];
#pragma unroll
                for (int u = 0; u < 4; ++u) { wv[2 * u] = wp[(kk + 64 * u) / 8]; wv[2 * u + 1] = wp[(kk + 64 * u) / 8 + 1]; hv[2 * u] = hp[(kk + 64 * u) / 8]; hv[2 * u + 1] = hp[(kk + 64 * u) / 8 + 1]; }
                asm volatile("" ::: "memory");
#pragma unroll
                for (int u = 0; u < 8; ++u) acc = MFMA16(__builtin_bit_cast(bf16x8, wv[u]), __builtin_bit_cast(bf16x8, hv[u]), acc);
            }
        }
        red[w * 64 + lane] = acc;
        __syncthreads();
        if (kw == 0 && t < MR / 16) {
            acc += red[(w + 1) * 64 + lane]; acc += red[(w + 2) * 64 + lane]; acc += red[(w + 3) * 64 + lane];
            *(GAS f32x4*)(F.G1 + (size_t)(16 * t + r) * GL_R + 4 * g) = acc;
        }
        __syncthreads();
    }
    asm volatile("s_waitcnt vmcnt(0)" ::: "memory");
}

#ifndef USE_AUX
#define USE_AUX 0
#endif
struct AuxT { const float* src; bf16* dst; int N, K; };
DI_ AuxT aux_decode(Frame& F, int it, unsigned char* dummy) {
    constexpr int I_1 = (DI / 64) * (D / 32), I_2 = (D / 64) * (N1 / 32), I_3 = I_1, AUX_ITERS = (I_1 + I_2 + I_3) / (256 * NWAVES);
    static_assert((I_1 + I_2 + I_3) % (256 * NWAVES) == 0, "aux tiles divide over the waves");
    const int gw = F.vcu * NWAVES + F.wave;
    AuxT t;
    if (it >= AUX_ITERS || F.G != 256) { t.src = (const float*)(dummy + (size_t)gw * 8192); t.dst = (bf16*)(dummy + 32 * MiB + (size_t)gw * 8192); t.N = 32; t.K = 64; return t; }
    int r_ = it * (256 * NWAVES) + gw; const float* W; bf16* WT; int K, N;
    if (r_ < I_1) { W = F.w0out; WT = F.WT0OUT; K = DI; N = D; }
    else if (r_ < I_1 + I_2) { r_ -= I_1; W = F.w1in; WT = F.WT1IN; K = D; N = N1; }
    else { r_ -= I_1 + I_2; W = F.w1out; WT = F.WT1OUT; K = DI; N = D; }
    const int nblk = N / 32, kb = r_ / nblk, nb = r_ - kb * nblk;
    t.src = W + (size_t)(64 * kb) * N + 32 * nb; t.dst = WT + (size_t)(32 * nb) * K + 64 * kb; t.N = N; t.K = K; return t;
}
DI_ void aux_load(Frame& F, const AuxT& t, f32x4 (&wv)[8]) {
    const int rowi = F.lane >> 3, c4 = F.lane & 7;
#pragma unroll
    for (int i = 0; i < 8; ++i) wv[i] = *(const GAS f32x4*)(t.src + (size_t)(8 * i + rowi) * t.N + 4 * c4);
}
DI_ void aux_store(Frame& F, const AuxT& t, const f32x4 (&wv)[8], LAS unsigned char* scr  ) {
    const int lane = F.lane, rowi = lane >> 3, c4 = lane & 7;
#pragma unroll
    for (int i = 0; i < 8; ++i) { LAS unsigned* p = (LAS unsigned*)(scr + (8 * i + rowi) * 68 + c4 * 8); p[0] = cvtpk(wv[i].x, wv[i].y); p[1] = cvtpk(wv[i].z, wv[i].w); }
    LDS_WAIT(); asm volatile("" ::: "memory");
    const int kc = lane & 7;
#pragma unroll
    for (int j = 0; j < 4; ++j) { const int n = (lane >> 3) + 8 * j; unsigned short hv[8];
#pragma unroll
        for (int e = 0; e < 8; ++e) hv[e] = *(const LAS unsigned short*)(scr + (8 * kc + e) * 68 + n * 2);
        v4u o; o.x = hv[0] | ((unsigned)hv[1] << 16); o.y = hv[2] | ((unsigned)hv[3] << 16); o.z = hv[4] | ((unsigned)hv[5] << 16); o.w = hv[6] | ((unsigned)hv[7] << 16);
        *(GAS v4u*)(t.dst + (size_t)n * t.K + 8 * kc) = o; }
    LDS_WAIT(); asm volatile("" ::: "memory");
}

constexpr int F0_QD = 0, F0_KI = 8192, F0_T = 16384, F0_GL = 24576, F0_TV = 25088, F0_STG = 33536;
DI_ void f0_load(const bf16* cb, const int (&oq)[2], int ov, v2u (&q2)[2], v2u (&f2)[2], v4u& vraw) {
#pragma unroll
    for (int ti = 0; ti < 2; ++ti) { q2[ti] = *(const GAS v2u*)(cb + oq[ti]); f2[ti] = *(const GAS v2u*)(cb + oq[ti] + DI); }
    vraw = *(const GAS v4u*)(cb + ov);
}
DI_ void f0_prep(Frame& F, LAS unsigned char* st, const v2u (&q2)[2], const v2u (&f2)[2], const v4u& vraw, const f32x4& lb4, const f32x4& bf4) {
    const int lane = F.lane, w = F.wave, r = lane & 15, g = lane >> 4, ps = w >> 1, hf = w & 1;
    const float lbv[4] = {lb4.x, lb4.y, lb4.z, lb4.w}, bfv[4] = {bf4.x, bf4.y, bf4.z, bf4.w};
    float Lv[2][4], qq[2][4], kk[2][4];
#pragma unroll
    for (int ti = 0; ti < 2; ++ti) {
        const float qv[4] = {bflo(q2[ti].x), bfhi(q2[ti].x), bflo(q2[ti].y), bfhi(q2[ti].y)}, fv[4] = {bflo(f2[ti].x), bfhi(f2[ti].x), bflo(f2[ti].y), bfhi(f2[ti].y)};
#pragma unroll
        for (int x = 0; x < 4; ++x) { const float fg = lbv[x] + (1.f - lbv[x]) * sigm(fv[x] + bfv[x]);
            Lv[ti][x] = lg2(fg); kk[ti][x] = 1.f - fg; qq[ti][x] = silu(qv[x]); }
    }
    float qd[2][4], ki[2][4], kd[2][4], gl[4];
#pragma unroll
    for (int x = 0; x < 4; ++x) {
        const float b0 = scan16(Lv[0][x]);
        const float b1 = scan16(Lv[1][x]) + bcast15(b0);
        const float BB = bcast15(b1);
        gl[x] = ex2(BB);
        qd[0][x] = qq[0][x] * ex2(b0); ki[0][x] = kk[0][x] * ex2(-b0); kd[0][x] = ki[0][x] * gl[x];
        qd[1][x] = qq[1][x] * ex2(b1); ki[1][x] = kk[1][x] * ex2(-b1); kd[1][x] = ki[1][x] * gl[x];
    }
    const int lp = (2 * (g & 1) + hf) * 16 + r;
#pragma unroll
    for (int ti = 0; ti < 2; ++ti) {
        *(LAS v2u*)(st + F0_QD + ((ti * 4 + ps) * 64 + lp) * 16 + (g >> 1) * 8) = (v2u){cvtpk(qd[ti][0], qd[ti][1]), cvtpk(qd[ti][2], qd[ti][3])};
        *(LAS v2u*)(st + F0_KI + ((ti * 4 + ps) * 64 + lp) * 16 + (g >> 1) * 8) = (v2u){cvtpk(ki[ti][0], ki[ti][1]), cvtpk(ki[ti][2], ki[ti][3])};
        const unsigned k01 = cvtpk(kd[ti][0], kd[ti][1]), k23 = cvtpk(kd[ti][2], kd[ti][3]);
        LAS unsigned char* tp = st + F0_T + (32 * ps + 8 * g + 4 * hf) * 64 + (16 * ti + r) * 2;
        *(LAS unsigned short*)(tp) = (unsigned short)(k01 & 0xffffu); *(LAS unsigned short*)(tp + 64) = (unsigned short)(k01 >> 16);
        *(LAS unsigned short*)(tp + 128) = (unsigned short)(k23 & 0xffffu); *(LAS unsigned short*)(tp + 192) = (unsigned short)(k23 >> 16);
    }
    if (r == 0) *(LAS f32x4*)(st + F0_GL + (32 * ps + 8 * g + 4 * hf) * 4) = (f32x4){gl[0], gl[1], gl[2], gl[3]};
    { const int tk = 4 * w + (lane >> 4), c16 = lane & 15;
      *(LAS v2u*)(st + F0_TV + tk * 264 + c16 * 16) = (v2u){vraw.x, vraw.y}; *(LAS v2u*)(st + F0_TV + tk * 264 + c16 * 16 + 8) = (v2u){vraw.z, vraw.w}; }
}
DI_ void l0_fused(Frame& F, unsigned char* dummy) {
    const int lane = F.lane, w = F.wave, r = lane & 15, g = lane >> 4, ps = w >> 1, hf = w & 1;
    LAS float* obuf = (LAS float*)(F.lds + 2 * F0_STG);
    constexpr int OB = 32 * 132;
    for (int u = F.vcu; u < NB * HG_H; u += F.G) {
        const int bh = u, b = bh >> 6, h = bh & 63;
        f32x4 acc[8];
#pragma unroll
        for (int m = 0; m < 8; ++m) acc[m] = (f32x4){0.f, 0.f, 0.f, 0.f};
        const int ntok = 4 * w + g, ndv = 8 * r;
        float ngv[8];
        { const f32x4 a0 = *(const GAS f32x4*)(F.ng0 + h * 128 + ndv), a1 = *(const GAS f32x4*)(F.ng0 + h * 128 + ndv + 4);
          ngv[0] = a0.x; ngv[1] = a0.y; ngv[2] = a0.z; ngv[3] = a0.w; ngv[4] = a1.x; ngv[5] = a1.y; ngv[6] = a1.z; ngv[7] = a1.w; }
        const int colp = h * 128 + 32 * ps + 8 * g + 4 * hf;
        const f32x4 lb4 = *(const GAS f32x4*)(F.LB0 + colp), bf4 = *(const GAS f32x4*)(F.b_f + colp);
        v2u q2s[2][2], f2s[2][2]; v4u vrs[2];
        const int oq[2] = {r * N0 + colp, (16 + r) * N0 + colp};
        const int ov = (4 * w + (lane >> 4)) * N0 + 2 * DI + h * 128 + 8 * (lane & 15), oz = ntok * N0 + 3 * DI + h * 128 + ndv, oy = ntok * DI + h * 128 + ndv;
        const bf16* xq = F.QFIZ + (size_t)(b * SEQ - 32) * N0;
        bf16* xy = F.Y + (size_t)(b * SEQ - 32) * DI;
        bf16* y0 = (b == 0) ? F.Y0 : F.Y0 + (size_t)32 * DI;
#define QCH(c_) (((c_) == 0) ? (const bf16*)F.Q0 : xq + (size_t)(c_) * 32 * N0)
        f0_load(QCH(0), oq, ov, q2s[0], f2s[0], vrs[0]);
        f0_prep(F, F.lds, q2s[0], f2s[0], vrs[0], lb4, bf4);
        f0_load(QCH(1), oq, ov, q2s[1], f2s[1], vrs[1]);
        LAS unsigned char* ascr = F.lds + 2 * F0_STG + 33792 + w * 4352;
        f32x4 awv[8];
        v4u zs[2]; zs[0] = (v4u){0u, 0u, 0u, 0u}; zs[1] = zs[0];
#define F0_BODY(C_, PAR) do { const int c = (C_); \
            asm volatile("s_waitcnt lgkmcnt(0)" ::: "memory"); \
            __builtin_amdgcn_s_barrier(); \
            asm volatile("" ::: "memory"); \
            f0_load(QCH((c + 2 < NCH) ? c + 2 : NCH - 1), oq, ov, q2s[PAR], f2s[PAR], vrs[PAR]); \
            AuxT at_; if (USE_AUX) { at_ = aux_decode(F, c, dummy); aux_load(F, at_, awv); } \
            { const int cz = (c < NCH) ? c : NCH - 1; zs[PAR] = *(const GAS v4u*)(QCH(cz) + oz); } \
            { \
                const int cp = c - 1; \
                const LAS float* ob = obuf + (cp & 1) * OB + ntok * 132 + ndv; \
                const f32x4 x0 = *(const LAS f32x4*)(ob), x1 = *(const LAS f32x4*)(ob + 4); \
                float ss = (x0.x * x0.x + x0.y * x0.y) + (x0.z * x0.z + x0.w * x0.w) + (x1.x * x1.x + x1.y * x1.y) + (x1.z * x1.z + x1.w * x1.w); \
                ss = bcast15(scan16(ss)); \
                const float rs = rsqrtf(ss * (1.f / 128.f) + RMS_EPS); \
                bf16* yb = (cp <= 0) ? ((cp == 0) ? y0 : F.Y0 + (size_t)32 * DI) : xy + (size_t)cp * 32 * DI; \
                { \
                    v4u d; \
                    d.x = cvtpk(x0.x * rs * ngv[0] * silu(bflo(zs[PAR ^ 1].x)), x0.y * rs * ngv[1] * silu(bfhi(zs[PAR ^ 1].x))); \
                    d.y = cvtpk(x0.z * rs * ngv[2] * silu(bflo(zs[PAR ^ 1].y)), x0.w * rs * ngv[3] * silu(bfhi(zs[PAR ^ 1].y))); \
                    d.z = cvtpk(x1.x * rs * ngv[4] * silu(bflo(zs[PAR ^ 1].z)), x1.y * rs * ngv[5] * silu(bfhi(zs[PAR ^ 1].z))); \
                    d.w = cvtpk(x1.z * rs * ngv[6] * silu(bflo(zs[PAR ^ 1].w)), x1.w * rs * ngv[7] * silu(bfhi(zs[PAR ^ 1].w))); \
                    *(GAS v4u*)(yb + oy) = d; \
                } \
            } \
             \
            { \
                const LAS unsigned char* st = F.lds + (c & 1) * F0_STG; \
 \
                unsigned short hv[8]; \
                _Pragma("unroll") \
                for (int e = 0; e < 8; ++e) hv[e] = *(const LAS unsigned short*)(st + F0_TV + (16 * (e >> 2) + 4 * g + (e & 3)) * 264 + (16 * w + r) * 2); \
                const bf16x8 vf = mk8(hv[0] | ((unsigned)hv[1] << 16), hv[2] | ((unsigned)hv[3] << 16), hv[4] | ((unsigned)hv[5] << 16), hv[6] | ((unsigned)hv[7] << 16)); \
                bf16x8 qf[8], kf[8]; \
                _Pragma("unroll") \
                for (int q = 0; q < 8; ++q) { qf[q] = *(const LAS bf16x8*)(st + F0_QD + q * 1024 + lane * 16); kf[q] = *(const LAS bf16x8*)(st + F0_KI + q * 1024 + lane * 16); } \
                SCHED_FENCE(); \
 \
                f32x4 pt00 = (f32x4){0.f, 0.f, 0.f, 0.f}, pt01 = pt00, pt11 = pt00; \
                _Pragma("unroll") \
                for (int s2 = 0; s2 < 4; ++s2) { pt00 = MFMA16(kf[s2], qf[s2], pt00); pt01 = MFMA16(kf[s2], qf[4 + s2], pt01); pt11 = MFMA16(kf[4 + s2], qf[4 + s2], pt11); } \
                const bool m0 = (4 * g + 0 <= r), m1 = (4 * g + 1 <= r), m2 = (4 * g + 2 <= r), m3 = (4 * g + 3 <= r); \
 \
                                const bf16x8 pb0 = mk8(cvtpk(m0 ? pt00.x : 0.f, m1 ? pt00.y : 0.f), cvtpk(m2 ? pt00.z : 0.f, m3 ? pt00.w : 0.f), 0u, 0u); \
                const bf16x8 pb1 = mk8(pk2(pt01.x, pt01.y), pk2(pt01.z, pt01.w), cvtpk(m0 ? pt11.x : 0.f, m1 ? pt11.y : 0.f), cvtpk(m2 ? pt11.z : 0.f, m3 ? pt11.w : 0.f)); \
                f32x4 o0 = (f32x4){0.f, 0.f, 0.f, 0.f}, o1 = o0; \
                o0 = MFMA16(vf, pb0, o0); o1 = MFMA16(vf, pb1, o1); \
                _Pragma("unroll") \
                for (int s2 = 0; s2 < 4; ++s2) { \
                    const bf16x8 sb = mk8(cvtpk(acc[2 * s2].x, acc[2 * s2].y), cvtpk(acc[2 * s2].z, acc[2 * s2].w), cvtpk(acc[2 * s2 + 1].x, acc[2 * s2 + 1].y), cvtpk(acc[2 * s2 + 1].z, acc[2 * s2 + 1].w)); \
                    o0 = MFMA16(sb, qf[s2], o0); o1 = MFMA16(sb, qf[4 + s2], o1); \
                } \
                LAS float* ow = obuf + (c & 1) * OB + r * 132 + 16 * w + 4 * g; \
                *(LAS f32x4*)ow = o0; *(LAS f32x4*)(ow + 16 * 132) = o1; \
                f32x4 gf[8]; v2u klo[8], khi[8]; \
                _Pragma("unroll") \
                for (int m = 0; m < 8; ++m) { gf[m] = *(const LAS f32x4*)(st + F0_GL + (16 * m + 4 * g) * 4); \
                    klo[m] = *(const LAS v2u*)(st + F0_T + (16 * m + r) * 64 + 8 * g); khi[m] = *(const LAS v2u*)(st + F0_T + (16 * m + r) * 64 + 32 + 8 * g); } \
                SCHED_FENCE(); \
                _Pragma("unroll") \
                for (int m = 0; m < 8; ++m) acc[m] = MFMA16(mk8(klo[m].x, klo[m].y, khi[m].x, khi[m].y), vf, acc[m] * gf[m]); \
                SCHED_FENCE(); \
            } \
            f0_prep(F, F.lds + ((c + 1) & 1) * F0_STG, q2s[PAR ^ 1], f2s[PAR ^ 1], vrs[PAR ^ 1], lb4, bf4); \
            if (USE_AUX) aux_store(F, at_, awv, ascr); \
        } while (0)
        for (int c2 = 0; c2 <= NCH; c2 += 2) { F0_BODY(c2, 0); F0_BODY(c2 + 1, 1); }
#undef F0_BODY
#undef QCH
        asm volatile("s_waitcnt vmcnt(0) lgkmcnt(0)" ::: "memory");
        __builtin_amdgcn_s_barrier();
    }
}

struct Args { const float* in[17]; float* out; unsigned char* ws; int ph_lo, ph_hi, li, pad; };
__global__ void __launch_bounds__(NWAVES * 64, 2) mk_fwd(Args args) {
    extern __shared__ __attribute__((aligned(16))) unsigned char lds[];
    Frame F;
    F.lds = (LAS unsigned char*)lds;
    F.MISC = (volatile LAS unsigned*)(F.lds + MISC_OFF);
    F.tid = threadIdx.x; F.lane = F.tid & 63; F.wave = __builtin_amdgcn_readfirstlane(F.tid >> 6);
    F.G = gridDim.x; { const int bx = blockIdx.x; F.vcu = (F.G % 8 == 0) ? (bx % 8) * (F.G / 8) + bx / 8 : bx; }
    unsigned char* ws = args.ws;
    F.ctl = (gu32*)(ws + WS_CTL);
    F.x = args.in[0]; F.meta = args.in[1]; F.lb_logits = args.in[2];
    F.w0in = args.in[3]; F.b_f = args.in[4]; F.ng0 = args.in[5]; F.w0out = args.in[6]; F.ln0g = args.in[7]; F.ln0b = args.in[8];
    F.w1in = args.in[9]; F.wg1 = args.in[10]; F.wg2 = args.in[11]; F.b_g = args.in[12]; F.ng1 = args.in[13]; F.w1out = args.in[14]; F.ln1g = args.in[15]; F.ln1b = args.in[16];
    F.out = args.out;
    F.LB0 = (float*)(ws + WS_LB0); F.G1 = (float*)(ws + WS_G1); F.PRE = (float*)(ws + WS_PRE); F.O1 = (float*)(ws + WS_O1); F.WG1T = (bf16*)(ws + WS_WG1T); F.W2F = (bf16*)(ws + WS_W2F); F.SS = (float*)(ws + WS_REC + 525 * MiB); F.Q0 = (bf16*)(ws + WS_Q0); F.Y0 = (bf16*)(ws + WS_Y0); F.REC0 = ws + WS_REC; F.REC1 = ws + WS_REC1; F.VF1 = ws + WS_VF1;
    F.WT0IN = (bf16*)(ws + WS_WT0IN); F.WT0OUT = (bf16*)(ws + WS_WT0OUT); F.WT1IN = (bf16*)(ws + WS_WT1IN); F.WT1OUT = (bf16*)(ws + WS_WT1OUT);
    F.XB = (bf16*)(ws + WS_XB); F.H1B = (bf16*)(ws + WS_H1B); F.QFIZ = (bf16*)(ws + WS_QFIZ); F.Y = (bf16*)(ws + WS_Y);
    for (int u = F.tid; u < (LDS_BYTES - LDSCTL_OFF) / 4; u += NWAVES * 64) ((LAS unsigned*)(F.lds + LDSCTL_OFF))[u] = 0u;
    __syncthreads();
    int vb = (int)blockIdx.x;
    if (USE_TICKETS && N_LAUNCHES == 1 && (F.G % 8) == 0) {
        if (F.tid == 0) {
            const unsigned per = (unsigned)F.G / 8u; unsigned x = xb_xcc_id() & 7u, got = 0xffffffffu;
            for (unsigned tr = 0; tr < 8u; ++tr) { const unsigned y = (x + tr) & 7u; const unsigned t = xb_add((unsigned*)(F.ctl + CW_POOL) + 64 * y, 1u); if (t < per) { got = y + 8u * t; break; } }
            F.MISC[12] = (got == 0xffffffffu) ? blockIdx.x : got;
        }
        __syncthreads();
        vb = (int)F.MISC[12];
    }
    { F.vcu = (F.G % 8 == 0) ? (vb % 8) * (F.G / 8) + vb / 8 : vb; }
    XcdBarrier bar; bar.bar = (unsigned*)(F.ctl + CW_BAR); bar.x = 0; bar.st = nullptr;
    if (N_LAUNCHES == 1) bar = xcd_barrier_post((unsigned*)(F.ctl + CW_BAR), F.MISC + 8);
#define GRID_BAR() do { if (N_LAUNCHES == 1) xcd_barrier(bar); } while (0)
    const int lo = args.ph_lo, hi = args.ph_hi;
    unsigned long long pclk0 = 0, pclkn = 0; (void)pclk0;
    unsigned long long st_prev = STAMP_MASK ? __builtin_amdgcn_s_memrealtime() : 0ull, st_acc = 0ull;
#define STAMP(k) do { if (STAMP_MASK) { const unsigned long long t_ = __builtin_amdgcn_s_memrealtime(); if ((STAMP_MASK >> (k)) & 1) st_acc += t_ - st_prev; st_prev = t_; } } while (0)
#ifdef ONLY_PHASE
#define IN(k) ((k) == ONLY_PHASE && lo <= (k) && (k) < hi)
#else
#define IN(k) (lo <= (k) && (k) < hi)
#endif
#define BOTH(k) (IN(k) && IN((k) + 1))

    if (IN(0)) { for (int rep = 0; rep < REP(0); ++rep) { p0_prologue(F); if (rep + 1 < REP(0)) GRID_BAR(); } if (BOTH(0)) GRID_BAR(); }
    STAMP(0);
    if (IN(1)) {
        if (!(P0_META_FOLD && F.G == 256)) skinny<1, 0>(F, F.XB + (size_t)MX * D, F.WT0IN, D, 0, N0 / 16, (USE_L0_MFMA == 2) ? F.Q0 + (size_t)16 * N0 : F.QFIZ + (size_t)MX * N0, N0, nullptr, nullptr);
        pg8::Gemm g{F.XB, F.WT0IN, MX, N0, D}; pg8::StaticOrder S; S.init(MX, N0, F.G, vb);
        pg8::EpiBf16<0> E{F.QFIZ, N0, nullptr, 0, 0, 1.f};
        if (PROBE_CLK == 1) pclk0 = __builtin_amdgcn_s_memtime();
        for (int rep = 0; rep < REP(1); ++rep) { pg8::gemm_phase<pg8::EpiBf16<0>, pg8::StaticOrder, PG8_ALIGN, PG8_SP2>(F.lds + RING_OFF, g, S, E); if (rep + 1 < REP(1)) GRID_BAR(); }
        if (PROBE_CLK == 1) pclkn = __builtin_amdgcn_s_memtime() - pclk0;
        if (BOTH(1)) GRID_BAR();
    }
    STAMP(1);
#if USE_L0_MFMA == 2
    STAMP(2);
    if (IN(3)) { for (int rep = 0; rep < REP(3); ++rep) { l0_fused(F, F.REC0); if (rep + 1 < REP(3)) GRID_BAR(); } if (BOTH(3)) GRID_BAR(); }
#elif USE_L0_MFMA
    if (IN(2)) { for (int rep = 0; rep < REP(2); ++rep) { l0_prep(F, F.REC0); if (rep + 1 < REP(2)) GRID_BAR(); } if (BOTH(2)) GRID_BAR(); }
    STAMP(2);
    if (IN(3)) { for (int rep = 0; rep < REP(3); ++rep) { l0_seq(F, F.REC0); if (rep + 1 < REP(3)) GRID_BAR(); } if (BOTH(3)) GRID_BAR(); }
#else
    if (IN(2)) { if (BOTH(2)) GRID_BAR(); }
    if (IN(3)) { for (int rep = 0; rep < REP(3); ++rep) { p2_l0_rec_naive(F); if (rep + 1 < REP(3)) GRID_BAR(); } if (BOTH(3)) GRID_BAR(); }
#endif
    STAMP(3);
    if (IN(4)) {
        skinny<4, 1>(F, (USE_L0_MFMA == 2) ? F.Y0 + (size_t)16 * DI : F.Y + (size_t)MX * DI, F.WT0OUT, DI, 0, D / 16, nullptr, 0, F.PRE + (size_t)MX * D, F.meta);
        pg8::Gemm g{F.Y, F.WT0OUT, MX, D, DI}; pg8::StaticOrder S; S.init(MX, D, F.G, vb);
        pg8::EpiResid E{F.PRE, D, F.x, F.meta, MX, MX, ALPHA};
        for (int rep = 0; rep < REP(4); ++rep) { pg8::gemm_phase<pg8::EpiResid, pg8::StaticOrder, PG8_ALIGN, PG8_SP2>(F.lds + RING_OFF, g, S, E); if (rep + 1 < REP(4)) GRID_BAR(); }
        if (BOTH(4)) GRID_BAR();
    }
    STAMP(4);
    if (IN(5)) { for (int rep = 0; rep < REP(5); ++rep) { ln_phase(F, F.PRE, MR, F.ln0g, F.ln0b, F.PRE, F.H1B, nullptr); if (rep + 1 < REP(5)) GRID_BAR(); } if (BOTH(5)) GRID_BAR(); }
    STAMP(5);
    if (IN(6)) {
        gate_proj(F, F.WG1T);
        skinny<2, 0>(F, F.H1B + (size_t)MX * D, F.WT1IN, D, 4096, (N1 - 4096 - DI) / 16, F.QFIZ + (size_t)MX * N1, N1, nullptr, nullptr);
        pg8::Gemm g{F.H1B, F.WT1IN, MX, N1, D}; pg8::StaticOrder S; S.init(MX, N1, F.G, vb);
        pg8::EpiBf16<0> E{F.QFIZ, N1, nullptr, 0, 0, 1.f};
        for (int rep = 0; rep < REP(6); ++rep) { pg8::gemm_phase<pg8::EpiBf16<0>, pg8::StaticOrder, PG8_ALIGN, PG8_SP2>(F.lds + RING_OFF, g, S, E); if (rep + 1 < REP(6)) GRID_BAR(); }
        if (BOTH(6)) GRID_BAR();
    }
    STAMP(6);
#if USE_L1_MFMA
    if (IN(7)) { for (int rep = 0; rep < REP(7); ++rep) { l1_prep(F, F.REC1, F.VF1, F.W2F); if (rep + 1 < REP(7)) GRID_BAR(); } if (BOTH(7)) GRID_BAR(); }
    STAMP(7);
#if USE_L1_SEQ2
    if (IN(8)) { l1_seq2(F, F.REC1); if (BOTH(8)) GRID_BAR(); }
#else
    if (IN(8)) { l1_seq<0>(F, F.REC1, F.VF1, F.O1, F.SS); if (REP(8) > 1) { GRID_BAR(); l1_seq<PROBE_VAR>(F, F.REC1, F.VF1, F.O1, F.SS); } if (BOTH(8)) GRID_BAR(); }
#endif
#else
    if (IN(7)) { if (BOTH(7)) GRID_BAR(); }
    if (IN(8)) { for (int rep = 0; rep < REP(8); ++rep) { p6_l1_rec_naive(F); if (rep + 1 < REP(8)) GRID_BAR(); } if (BOTH(8)) GRID_BAR(); }
#endif
    STAMP(8);
#if !(USE_FUSED_NORM && USE_L1_MFMA && !USE_L1_SEQ2)
    if (IN(9)) { for (int rep = 0; rep < REP(9); ++rep) { p7_normgate(F); if (rep + 1 < REP(9)) GRID_BAR(); } if (BOTH(9)) GRID_BAR(); }
#endif
    STAMP(9);
    if (IN(10)) {
        pg8::Gemm g{F.Y, F.WT1OUT, MX, D, DI}; pg8::StaticOrder S; S.init(MX, D, F.G, vb);
#if USE_FUSED_NORM && USE_L1_MFMA && !USE_L1_SEQ2
        pg8::EpiResidScale E{F.PRE, D, F.PRE, ALPHA, F.SS, RMS_EPS};
        for (int rep = 0; rep < REP(10); ++rep) { pg8::gemm_phase<pg8::EpiResidScale, pg8::StaticOrder, PG8_ALIGN, PG8_SP2>(F.lds + RING_OFF, g, S, E); if (rep + 1 < REP(10)) GRID_BAR(); }
#else
        pg8::EpiResid E{F.PRE, D, F.PRE, F.PRE, MX, MX, ALPHA};
        if (PROBE_CLK == 10) pclk0 = __builtin_amdgcn_s_memtime();
        for (int rep = 0; rep < REP(10); ++rep) { pg8::gemm_phase<pg8::EpiResid, pg8::StaticOrder, PG8_ALIGN, PG8_SP2>(F.lds + RING_OFF, g, S, E); if (rep + 1 < REP(10)) GRID_BAR(); }
        if (PROBE_CLK == 10) pclkn = __builtin_amdgcn_s_memtime() - pclk0;
#endif
        if (BOTH(10)) GRID_BAR();
    }
    STAMP(10);
    if (IN(11)) { for (int rep = 0; rep < REP(11); ++rep) { ln_phase(F, F.PRE, MX, F.ln1g, F.ln1b, F.out, nullptr, nullptr); if (rep + 1 < REP(11)) GRID_BAR(); } }
    STAMP(11);
    if (STAMP_MASK && blockIdx.x == 0 && F.tid == 0) { const unsigned long long t0 = __builtin_amdgcn_s_memrealtime(); while (__builtin_amdgcn_s_memrealtime() - t0 < st_acc) __builtin_amdgcn_s_sleep(8); }
    if (PROBE_CLK && blockIdx.x == 0 && F.tid == 0) { const unsigned long long t0 = __builtin_amdgcn_s_memrealtime(); while (__builtin_amdgcn_s_memrealtime() - t0 < pclkn / (PROBE_CLK == 10 ? 10ull : 100ull)) __builtin_amdgcn_s_sleep(8); }
#undef IN
#undef BOTH
}

extern "C" void kernel_launch(void* const* d_in, const int* in_sizes, int n_in, void* d_out, int out_size, void* d_ws, size_t ws_size, hipStream_t stream) {
    static int grid = 0;
    if (grid == 0) {
        if (n_in != 17 || in_sizes[0] != MX * D || out_size != MX * D || ws_size < WS_END) { fprintf(stderr, "kernel_launch: unexpected problem (n_in %d, in0 %d, out %d, ws %zu < %zu); nothing launched\n", n_in, n_in > 0 ? in_sizes[0] : -1, out_size, ws_size, (size_t)WS_END); grid = -1; return; }
        int dev = 0, cus = 0, per_cu = 0;
        if (hipGetDevice(&dev) != hipSuccess || hipDeviceGetAttribute(&cus, hipDeviceAttributeMultiprocessorCount, dev) != hipSuccess) { fprintf(stderr, "kernel_launch: device query failed\n"); grid = -1; return; }
        if (hipFuncSetAttribute((const void*)mk_fwd, hipFuncAttributeMaxDynamicSharedMemorySize, LDS_BYTES) != hipSuccess) { fprintf(stderr, "kernel_launch: hipFuncSetAttribute failed\n"); grid = -1; return; }
        if (hipOccupancyMaxActiveBlocksPerMultiprocessor(&per_cu, (const void*)mk_fwd, NWAVES * 64, LDS_BYTES) != hipSuccess || per_cu < 1)
            fprintf(stderr, "kernel_launch: note: occupancy query reports %d workgroups per CU\n", per_cu);
        (void)hipGetLastError();
        grid = cus;
    }
    if (grid < 0) return;
    if (hipMemsetAsync((char*)d_ws + WS_CTL, 0, CTL_ZERO_BYTES, stream) != hipSuccess) { fprintf(stderr, "kernel_launch: memset failed\n"); return; }
    Args a{};
    for (int i = 0; i < 17; ++i) a.in[i] = (const float*)d_in[i];
    a.out = (float*)d_out; a.ws = (unsigned char*)d_ws;
    for (int li = 0; li < N_LAUNCHES; ++li) {
        a.ph_lo = (N_LAUNCHES == 1) ? 0 : li; a.ph_hi = (N_LAUNCHES == 1) ? PER_PHASE : li + 1; a.li = li; a.pad = 0;
        hipLaunchKernelGGL(mk_fwd, dim3(grid), dim3(NWAVES * 64), LDS_BYTES, stream, a);
        const hipError_t le = hipPeekAtLastError();
        if (le != hipSuccess) { fprintf(stderr, "kernel_launch: launch %d failed: %s\n", li, hipGetErrorName(le)); break; }
    }
}
```

```cpp
#include <hip/hip_runtime.h>
#include <cstdio>
#include <cstdint>
#define MK_N_LAUNCHES 1
#define USE_L0_MFMA 2
#define USE_L1_MFMA 1
namespace pg8 {
#define PG8_LAS __attribute__((address_space(3)))
typedef unsigned short bf16_t;
typedef short bf16x8 __attribute__((ext_vector_type(8)));
typedef float f32x4 __attribute__((ext_vector_type(4)));
typedef unsigned u32x4 __attribute__((ext_vector_type(4)));
constexpr int BM = 256, BK = 64, HALF = 128, HTB = HALF * BK * 2  , STAGE_BYTES = 8 * HTB, NXCD = 8, WGM = 8;

__host__ __device__ __forceinline__ int lds_byte(int r, int c) { const int st = (r >> 4) * 2 + (c >> 5), rr = r & 15, cc = c & 31, ob = rr * 64 + cc * 2; return st * 1024 + (ob ^ (((ob >> 9) & 1) << 5)); }
__host__ __device__ __forceinline__ void stage_rc(int b, int& R, int& C) { const int st = b / 1024, sb = b % 1024, swz = sb ^ (((sb >> 9) & 1) << 5); R = (st >> 1) * 16 + swz / 64; C = (st & 1) * 32 + (swz % 64) / 2; }
__host__ __device__ __forceinline__ int perm32(int rho) { const int n = rho >> 4, i = rho & 15; return 8 * (i >> 2) + 4 * n + (i & 3); }

struct Unit { int pm, pn; };
struct Gemm { const bf16_t* A; const bf16_t* Bt; int M, N, K; };

struct StaticOrder {
    int nM, nN, nwg, G, c;
    __host__ __device__ void init(int M, int N, int G_, int c_) { nM = M / BM; nN = N / BM; nwg = nM * nN; G = G_; c = c_; }
    __host__ __device__ bool next(int i, Unit& u) const {
        const long L = (long)i * G + c; if (L >= nwg) return false;
        int wgid = (int)L; { const int q = nwg / NXCD, r = nwg % NXCD, xcd = wgid % NXCD, off = wgid / NXCD; wgid = (xcd < r ? xcd * (q + 1) : r * (q + 1) + (xcd - r) * q) + off; }
        const int nig = WGM * nN, gid = wgid / nig, fm = gid * WGM, gsz = (nM - fm) < WGM ? (nM - fm) : WGM;
        u.pm = fm + ((wgid % nig) % gsz); u.pn = (wgid % nig) / gsz; return true;
    }
    __device__ __forceinline__ void a_ready(const Unit&) const {}
    __device__ __forceinline__ void done(const Unit&) const {}
};

__device__ __forceinline__ unsigned cvt_pk_bf16(float lo, float hi) { unsigned r; asm volatile("v_cvt_pk_bf16_f32 %0, %1, %2" : "=v"(r) : "v"(lo), "v"(hi)); return r; }
typedef float f32x2 __attribute__((ext_vector_type(2)));
__device__ __forceinline__ f32x2 gelu_pk(f32x2 v) {
    const f32x2 av = __builtin_elementwise_abs(v), d = av * 0.2316418882f + 1.0f;
    f32x2 t; t.x = __builtin_amdgcn_rcpf(d.x); t.y = __builtin_amdgcn_rcpf(d.y);
    f32x2 q = t * 0.5307027145f + (-0.7265760135f); q = q * t + 0.7107068705f; q = q * t + (-0.142248368f); q = q * t + 0.127414796f; q = q * t;
    const f32x2 s = (v * v) * (-0.72134752044f);
    f32x2 e; e.x = __builtin_amdgcn_exp2f(s.x); e.y = __builtin_amdgcn_exp2f(s.y);
    const f32x2 m = v * (q * e), r = v - m;
    f32x2 o; o.x = v.x < 0.f ? m.x : r.x; o.y = v.y < 0.f ? m.y : r.y; return o;
}

template <int ACT  > struct EpiBf16 {
    static constexpr bool PERM = true, AFTER_DRAIN = false, KHOOK = false; static_assert(ACT == 0 || ACT == 1, "EpiBf16: ACT is 0 (none) or 1 (gelu_pk)");
    bf16_t* O; int ldc; const float* bias; int split_cols; size_t split_stride; float scale0;
    __device__ __forceinline__ void operator()(const f32x4 (&acc)[2][2][4][2], const Unit& u, int wr, int wc, int fr, int fq) const {
        const int row0 = u.pm * BM + wr * 64 + fr; int colt = u.pn * BM; bf16_t* base = O;
        float sc = 1.f; if (split_cols) { const int t = colt / split_cols; base += (size_t)t * split_stride; colt -= t * split_cols; if (t == 0) sc = scale0; }
        const int col0 = colt + wc * 32 + 8 * fq, bcol0 = u.pn * BM + wc * 32 + 8 * fq;
        f32x4 bv[2][2];
#pragma unroll
        for (int bj = 0; bj < 2; ++bj)
#pragma unroll
            for (int n = 0; n < 2; ++n) bv[bj][n] = bias ? *(const f32x4*)(bias + bcol0 + bj * HALF + 4 * n) : (f32x4){0.f, 0.f, 0.f, 0.f};
#pragma unroll
        for (int ai = 0; ai < 2; ++ai)
#pragma unroll
            for (int m = 0; m < 4; ++m) { bf16_t* rowp = base + (size_t)(row0 + ai * HALF + m * 16) * ldc + col0;
#pragma unroll
                for (int bj = 0; bj < 2; ++bj) { f32x4 v0 = acc[ai][bj][m][0] + bv[bj][0], v1 = acc[ai][bj][m][1] + bv[bj][1];
                    if (ACT == 1) { f32x2 a = gelu_pk((f32x2){v0[0], v0[1]}), b = gelu_pk((f32x2){v0[2], v0[3]}), c = gelu_pk((f32x2){v1[0], v1[1]}), d = gelu_pk((f32x2){v1[2], v1[3]});
                        v0 = (f32x4){a.x, a.y, b.x, b.y}; v1 = (f32x4){c.x, c.y, d.x, d.y}; }
                    v0 = v0 * sc; v1 = v1 * sc; u32x4 w; w.x = cvt_pk_bf16(v0[0], v0[1]); w.y = cvt_pk_bf16(v0[2], v0[3]); w.z = cvt_pk_bf16(v1[0], v1[1]); w.w = cvt_pk_bf16(v1[2], v1[3]);
                    *(u32x4*)(rowp + bj * HALF) = w; } }
    }
};
struct EpiResid {
    static constexpr bool PERM = false, AFTER_DRAIN = false, KHOOK = false;
    float* C; int ldc; const float* resA; const float* resB; int rowsA; int rowsValid; float alpha;
    __device__ __forceinline__ void operator()(const f32x4 (&acc)[2][2][4][2], const Unit& u, int wr, int wc, int fr, int fq) const {
        const int row0 = u.pm * BM + wr * 64 + fr, col0 = u.pn * BM + wc * 32 + 4 * fq;
#pragma unroll
        for (int ai = 0; ai < 2; ++ai)
#pragma unroll
            for (int m = 0; m < 4; ++m) { const int r = row0 + ai * HALF + m * 16;
                if (r < rowsValid) {
                    const float* rp = (r < rowsA) ? resA + (size_t)r * ldc + col0 : resB + (size_t)(r - rowsA) * ldc + col0;
                    float* cp = C + (size_t)r * ldc + col0;
#pragma unroll
                    for (int bj = 0; bj < 2; ++bj)
#pragma unroll
                        for (int n = 0; n < 2; ++n) { const f32x4 rv = *(const f32x4*)(rp + bj * HALF + n * 16); *(f32x4*)(cp + bj * HALF + n * 16) = rv * alpha + acc[ai][bj][m][n]; } }
                asm volatile("" ::: "memory"); }
    }
};

struct EpiResidScale {
    static constexpr bool PERM = false, AFTER_DRAIN = false, KHOOK = true;
    float* C; int ldc; const unsigned short* res; float alpha; const float* SS; float eps;
    __device__ __forceinline__ void unit_begin(const Unit& u, int par, PG8_LAS unsigned char* lds) const {
        const int tid = threadIdx.x, row = tid >> 1, hh = 4 * (tid & 1);
        float sv[4];
        { const f32x4* sp = (const f32x4*)(SS + ((size_t)(u.pm * BM + row) * 8 + hh) * 8);
#pragma unroll
          for (int q = 0; q < 4; ++q) { const f32x4 a = sp[2 * q], b = sp[2 * q + 1]; sv[q] = (a.x + a.y) + (a.z + a.w) + (b.x + b.y) + (b.z + b.w); asm volatile("" ::: "memory"); } }
        const f32x4 s = (f32x4){sv[0], sv[1], sv[2], sv[3]};
        f32x4 rs; rs.x = __builtin_amdgcn_rsqf(s.x * (1.f / 1024.f) + eps); rs.y = __builtin_amdgcn_rsqf(s.y * (1.f / 1024.f) + eps); rs.z = __builtin_amdgcn_rsqf(s.z * (1.f / 1024.f) + eps); rs.w = __builtin_amdgcn_rsqf(s.w * (1.f / 1024.f) + eps);
        *(PG8_LAS f32x4*)(lds + 131072 + par * 8192 + (row * 8 + hh) * 4) = rs;
    }
    __device__ __forceinline__ void khook(f32x4 (&acc)[2][2][4][2], int par, int hb, int wr, int fr, PG8_LAS unsigned char* lds) const {
        const PG8_LAS float* T = (const PG8_LAS float*)(lds + 131072 + par * 8192);
        typedef float f32x2h __attribute__((ext_vector_type(2)));
        f32x2h tv[8]; unsigned ad[8];
#pragma unroll
        for (int i = 0; i < 8; ++i) ad[i] = (unsigned)(size_t)(T + ((i >> 2) * HALF + wr * 64 + (i & 3) * 16 + fr) * 8 + hb - 1);
        asm volatile("ds_read2_b32 %0, %8 offset1:1\n\tds_read2_b32 %1, %9 offset1:1\n\tds_read2_b32 %2, %10 offset1:1\n\tds_read2_b32 %3, %11 offset1:1\n\t"
                     "ds_read2_b32 %4, %12 offset1:1\n\tds_read2_b32 %5, %13 offset1:1\n\tds_read2_b32 %6, %14 offset1:1\n\tds_read2_b32 %7, %15 offset1:1\n\ts_waitcnt lgkmcnt(0)\n\ts_nop 15\n\ts_nop 15"
                     : "=&v"(tv[0]), "=&v"(tv[1]), "=&v"(tv[2]), "=&v"(tv[3]), "=&v"(tv[4]), "=&v"(tv[5]), "=&v"(tv[6]), "=&v"(tv[7])
                     : "v"(ad[0]), "v"(ad[1]), "v"(ad[2]), "v"(ad[3]), "v"(ad[4]), "v"(ad[5]), "v"(ad[6]), "v"(ad[7]) : "memory");
#pragma unroll
        for (int ai = 0; ai < 2; ++ai)
#pragma unroll
            for (int m = 0; m < 4; ++m) { const float ratio = tv[ai * 4 + m].x * __builtin_amdgcn_rcpf(tv[ai * 4 + m].y);
#pragma unroll
                for (int bj = 0; bj < 2; ++bj)
#pragma unroll
                    for (int n = 0; n < 2; ++n) { f32x4& a = acc[ai][bj][m][n];
                        asm volatile("v_mul_f32 %0, %0, %4\n\tv_mul_f32 %1, %1, %4\n\tv_mul_f32 %2, %2, %4\n\tv_mul_f32 %3, %3, %4\n\ts_nop 1" : "+v"(a.x), "+v"(a.y), "+v"(a.z), "+v"(a.w) : "v"(ratio)); } }
    }
    __device__ __forceinline__ void epi(const f32x4 (&acc)[2][2][4][2], const Unit& u, int wr, int wc, int fr, int fq, int par, PG8_LAS unsigned char* lds) const {
        const PG8_LAS float* T = (const PG8_LAS float*)(lds + 131072 + par * 8192);
        const int row0 = u.pm * BM + wr * 64 + fr, col0 = u.pn * BM + wc * 32 + 4 * fq;
#pragma unroll
        for (int ai = 0; ai < 2; ++ai)
#pragma unroll
            for (int m = 0; m < 4; ++m) { const int r = row0 + ai * HALF + m * 16; const float sc = T[(ai * HALF + wr * 64 + m * 16 + fr) * 8 + 7];
                const unsigned short* rp = res + (size_t)r * ldc + col0; float* cp = C + (size_t)r * ldc + col0;
#pragma unroll
                for (int bj = 0; bj < 2; ++bj)
#pragma unroll
                    for (int n = 0; n < 2; ++n) { const uint2 rb = *(const uint2*)(rp + bj * HALF + n * 16);
                        const f32x4 rv = (f32x4){__builtin_bit_cast(float, rb.x << 16), __builtin_bit_cast(float, rb.x & 0xffff0000u), __builtin_bit_cast(float, rb.y << 16), __builtin_bit_cast(float, rb.y & 0xffff0000u)};
                        *(f32x4*)(cp + bj * HALF + n * 16) = rv * alpha + acc[ai][bj][m][n] * sc; }
                asm volatile("" ::: "memory"); }
    }
};


template <class Epi, class Sched, bool ALIGN_EPI = false, bool SP2 = false>
__device__ __forceinline__ void gemm_phase(PG8_LAS unsigned char* lds, const Gemm g, const Sched& S, const Epi& E) {
    const int tid = threadIdx.x, wid = __builtin_amdgcn_readfirstlane(tid >> 6), lane = tid & 63, wr = wid >> 2, wc = wid & 3, fr = lane & 15, fq = lane >> 4;
    const int K = g.K, nt = K / BK;
    unsigned voffA[2], voffB[2];
#pragma unroll
    for (int i = 0; i < 2; ++i) { int R, C; stage_rc(tid * 16 + i * 8192, R, C); const int Rb = Epi::PERM ? ((R & ~31) + perm32(R & 31)) : R;
        voffA[i] = (unsigned)(R * K + C) * 2u; voffB[i] = (unsigned)(Rb * K + C) * 2u; }
    const size_t kstep = (size_t)(BK * 2);
    const size_t hstep = (size_t)HALF * K * 2;
    const size_t tstep = 2 * hstep;
    const unsigned ldsw = (unsigned)wid * 1024u;
    const int aoff = lds_byte(wr * 64 + fr, fq * 8), boff = lds_byte(wc * 32 + fr, fq * 8);
#define PG8_SA(b, h) (((b) * 2 + (h)) * HTB)
#define PG8_SB(b, h) ((4 + (b) * 2 + (h)) * HTB)
#define PG8_STAGE(bufoff, gbase, voff) do { _Pragma("unroll") for (int _i = 0; _i < 2; ++_i) \
        __builtin_amdgcn_global_load_lds((const unsigned*)((const char*)(gbase) + (voff)[_i]), (PG8_LAS unsigned*)(lds + (bufoff) + ldsw + _i * 8192), 16, 0, 0); } while (0)
#define PG8_LDA(dst, b, h) do { _Pragma("unroll") for (int m = 0; m < 4; ++m) _Pragma("unroll") for (int k = 0; k < 2; ++k) dst[m][k] = *(const PG8_LAS bf16x8*)(lds + PG8_SA(b, h) + aoff + m * 2048 + k * 1024); } while (0)
#define PG8_LDB(dst, b, h) do { _Pragma("unroll") for (int n = 0; n < 2; ++n) _Pragma("unroll") for (int k = 0; k < 2; ++k) dst[n][k] = *(const PG8_LAS bf16x8*)(lds + PG8_SB(b, h) + boff + n * 2048 + k * 1024); } while (0)
#define PG8_MMA(ai, bj, At, Bt) do { __builtin_amdgcn_s_setprio(1); _Pragma("unroll") for (int m = 0; m < 4; ++m) _Pragma("unroll") for (int n = 0; n < 2; ++n) _Pragma("unroll") for (int k = 0; k < 2; ++k) \
        acc[ai][bj][m][n] = __builtin_amdgcn_mfma_f32_16x16x32_bf16(Bt[n][k], At[m][k], acc[ai][bj][m][n], 0, 0, 0); __builtin_amdgcn_s_setprio(0); } while (0)
#define PG8_WAIT_V(n) asm volatile("s_waitcnt vmcnt(" #n ")" ::: "memory")
#define PG8_WAIT_L(n) asm volatile("s_waitcnt lgkmcnt(" #n ")" ::: "memory")
#define PG8_BAR __builtin_amdgcn_s_barrier()
#define PG8_SCHED __builtin_amdgcn_sched_barrier(0)
    Unit cur, nxt; int ui = 0;
    if (!S.next(0, cur)) return;
    f32x4 acc[2][2][4][2];
#pragma unroll
    for (int a = 0; a < 2; ++a)
#pragma unroll
        for (int b = 0; b < 2; ++b)
#pragma unroll
            for (int m = 0; m < 4; ++m)
#pragma unroll
                for (int n = 0; n < 2; ++n) acc[a][b][m][n] = (f32x4){0.f, 0.f, 0.f, 0.f};
    bf16x8 At[4][2], B0[2][2], B1[2][2];
    const char* cA = (const char*)g.A + (size_t)cur.pm * tstep; const char* cB = (const char*)g.Bt + (size_t)cur.pn * tstep;
    if constexpr (Epi::KHOOK) E.unit_begin(cur, ui & 1, lds);
    S.a_ready(cur);
    if constexpr (SP2) {
        PG8_STAGE(PG8_SB(0, 0), cB, voffB); PG8_STAGE(PG8_SB(0, 1), cB + hstep, voffB); PG8_STAGE(PG8_SA(0, 0), cA, voffA); PG8_STAGE(PG8_SA(0, 1), cA + hstep, voffA);
        if (wr == 1) PG8_BAR;
        PG8_WAIT_V(2); PG8_BAR;
        PG8_STAGE(PG8_SB(1, 0), cB + kstep, voffB); PG8_STAGE(PG8_SA(1, 0), cA + kstep, voffA); PG8_STAGE(PG8_SB(1, 1), cB + hstep + kstep, voffB);
        PG8_WAIT_V(6); PG8_BAR;
    } else {
        PG8_STAGE(PG8_SB(0, 0), cB, voffB); PG8_STAGE(PG8_SA(0, 0), cA, voffA); PG8_STAGE(PG8_SB(0, 1), cB + hstep, voffB); PG8_STAGE(PG8_SA(0, 1), cA + hstep, voffA);
        if (wr == 1) PG8_BAR;
        PG8_WAIT_V(4); PG8_BAR;
        PG8_STAGE(PG8_SB(1, 0), cB + kstep, voffB); PG8_STAGE(PG8_SA(1, 0), cA + kstep, voffA); PG8_STAGE(PG8_SB(1, 1), cB + hstep + kstep, voffB);
        PG8_WAIT_V(6); PG8_BAR;
    }
    for (;;) {
        const bool has_next = S.next(ui + 1, nxt);
        const char* nA = has_next ? (const char*)g.A + (size_t)nxt.pm * tstep : cA; const char* nB = has_next ? (const char*)g.Bt + (size_t)nxt.pn * tstep : cB;
        const int tseg = Epi::KHOOK ? 16 : nt;
        for (int tb = 0; tb < nt; tb += tseg) {
        if constexpr (Epi::KHOOK) { if (tb != 0) { PG8_SCHED; E.khook(acc, ui & 1, tb >> 4, wr, fr, lds); PG8_SCHED; } }
        for (int t = tb; t < tb + tseg; t += 2) {
            const bool last = (t == nt - 2);
            const char* a1 = cA + (size_t)(t + 1) * kstep;
            const char* a2 = last ? nA : cA + (size_t)(t + 2) * kstep; const char* b2 = last ? nB : cB + (size_t)(t + 2) * kstep;
            const char* a3 = a2 + kstep; const char* b3 = b2 + kstep;
            if (last && has_next) S.a_ready(nxt);
            if constexpr (SP2) {
            PG8_LDB(B0, 0, 0); PG8_LDB(B1, 0, 1); PG8_SCHED; PG8_LDA(At, 0, 0); PG8_STAGE(PG8_SA(1, 1), a1 + hstep, voffA);
            PG8_WAIT_V(8); PG8_WAIT_L(0); PG8_BAR; PG8_MMA(0, 0, At, B0); PG8_MMA(0, 1, At, B1); PG8_BAR; PG8_SCHED;
            PG8_LDA(At, 0, 1); PG8_STAGE(PG8_SB(0, 0), b2, voffB); PG8_STAGE(PG8_SB(0, 1), b2 + hstep, voffB); PG8_STAGE(PG8_SA(0, 0), a2, voffA);
            PG8_WAIT_V(8); PG8_WAIT_L(0); PG8_BAR; PG8_MMA(1, 0, At, B0); PG8_MMA(1, 1, At, B1); PG8_BAR; PG8_SCHED;
            PG8_LDB(B0, 1, 0); PG8_LDB(B1, 1, 1); PG8_SCHED; PG8_LDA(At, 1, 0); PG8_STAGE(PG8_SA(0, 1), a2 + hstep, voffA);
            PG8_WAIT_V(8); PG8_WAIT_L(0); PG8_BAR; PG8_MMA(0, 0, At, B0); PG8_MMA(0, 1, At, B1); PG8_BAR; PG8_SCHED;
            PG8_LDA(At, 1, 1); PG8_STAGE(PG8_SB(1, 0), b3, voffB); PG8_STAGE(PG8_SB(1, 1), b3 + hstep, voffB); PG8_STAGE(PG8_SA(1, 0), a3, voffA);
            PG8_WAIT_V(8); PG8_WAIT_L(0); PG8_BAR; PG8_MMA(1, 0, At, B0); PG8_MMA(1, 1, At, B1); PG8_BAR; PG8_SCHED;
            } else {
            PG8_LDB(B0, 0, 0); PG8_SCHED; PG8_LDA(At, 0, 0); PG8_STAGE(PG8_SA(1, 1), a1 + hstep, voffA);
            PG8_WAIT_L(8); PG8_BAR; PG8_WAIT_L(0); PG8_MMA(0, 0, At, B0); PG8_BAR; PG8_SCHED;
            PG8_LDB(B1, 0, 1); PG8_STAGE(PG8_SB(0, 0), b2, voffB);
            PG8_BAR; PG8_WAIT_L(0); PG8_MMA(0, 1, At, B1); PG8_BAR;
            PG8_LDA(At, 0, 1); PG8_STAGE(PG8_SA(0, 0), a2, voffA);
            PG8_BAR; PG8_WAIT_L(0); PG8_MMA(1, 0, At, B0); PG8_BAR; PG8_SCHED;
            PG8_STAGE(PG8_SB(0, 1), b2 + hstep, voffB);
            PG8_WAIT_V(6); PG8_BAR; PG8_MMA(1, 1, At, B1); PG8_BAR;
            PG8_LDB(B0, 1, 0); PG8_SCHED; PG8_LDA(At, 1, 0); PG8_STAGE(PG8_SA(0, 1), a2 + hstep, voffA);
            PG8_WAIT_L(8); PG8_BAR; PG8_WAIT_L(0); PG8_MMA(0, 0, At, B0); PG8_BAR; PG8_SCHED;
            PG8_LDB(B1, 1, 1); PG8_STAGE(PG8_SB(1, 0), b3, voffB);
            PG8_BAR; PG8_WAIT_L(0); PG8_MMA(0, 1, At, B1); PG8_BAR;
            PG8_LDA(At, 1, 1); PG8_STAGE(PG8_SA(1, 0), a3, voffA);
            PG8_BAR; PG8_WAIT_L(0); PG8_MMA(1, 0, At, B0); PG8_BAR; PG8_SCHED;
            PG8_STAGE(PG8_SB(1, 1), b3 + hstep, voffB);
            PG8_WAIT_V(6); PG8_BAR; PG8_MMA(1, 1, At, B1); PG8_BAR;
            }
        }
        }
        if constexpr (ALIGN_EPI) { if (wr == 0) PG8_BAR; }
        if constexpr (Epi::KHOOK) { E.epi(acc, cur, wr, wc, fr, fq, ui & 1, lds); S.done(cur); }
        else if constexpr (!Epi::AFTER_DRAIN) { E(acc, cur, wr, wc, fr, fq); S.done(cur); }
        if (!has_next) break;
#pragma unroll
        for (int a = 0; a < 2; ++a)
#pragma unroll
            for (int b = 0; b < 2; ++b)
#pragma unroll
                for (int m = 0; m < 4; ++m)
#pragma unroll
                    for (int n = 0; n < 2; ++n) acc[a][b][m][n] = (f32x4){0.f, 0.f, 0.f, 0.f};
        cur = nxt; cA = nA; cB = nB; ++ui;
        if constexpr (Epi::KHOOK) E.unit_begin(cur, ui & 1, lds);
        if constexpr (ALIGN_EPI) { if (wr == 1) PG8_BAR; }
    }
    PG8_WAIT_V(0);
    if constexpr (!ALIGN_EPI) { if (wr == 0) PG8_BAR; }
    PG8_BAR;
    if constexpr (Epi::AFTER_DRAIN) { E.fused(acc, cur, wr, wc, fr, fq, lds, wid, lane); S.done(cur); }
#undef PG8_SA
#undef PG8_SB
#undef PG8_STAGE
#undef PG8_LDA
#undef PG8_LDB
#undef PG8_MMA
#undef PG8_WAIT_V
#undef PG8_WAIT_L
#undef PG8_BAR
#undef PG8_SCHED
}
}
#ifndef PG8_SP2
#define PG8_SP2 true
#endif
#ifndef PG8_ALIGN
#define PG8_ALIGN true
#endif

constexpr int NWAVES = 8;
constexpr int PER_PHASE = 12;
#ifndef MK_N_LAUNCHES
#define MK_N_LAUNCHES 1
#endif
#ifndef PROBE_MASK
#define PROBE_MASK 0
#endif
#define REP(k) (((PROBE_MASK >> (k)) & 1) + 1)
#ifndef PROBE_VAR
#define PROBE_VAR 0
#endif
#ifndef PROBE_CLK
#define PROBE_CLK 0
#endif
#ifndef STAMP_MASK
#define STAMP_MASK 0
#endif
#ifndef USE_AUX
#define USE_AUX 0
#endif
#ifndef USE_TILE_TRANSPOSE
#define USE_TILE_TRANSPOSE 0
#endif
#ifndef USE_L1_SEQ2
#define USE_L1_SEQ2 0
#endif
#ifndef USE_FUSED_NORM
#define USE_FUSED_NORM 1
#define RES_BF16 (USE_FUSED_NORM && USE_L1_MFMA)
#endif
#ifndef P0_META_FOLD
#define P0_META_FOLD (USE_L0_MFMA == 2 && !USE_TILE_TRANSPOSE)
#endif
#ifndef USE_TICKETS
#define USE_TICKETS 0
#endif
constexpr int N_LAUNCHES = MK_N_LAUNCHES;

constexpr int D = 4096, NB = 4, SEQ = 2048, NMETA = 16, DI = 8192;
constexpr int MX = NB * SEQ;
constexpr int MR = MX + NMETA;
constexpr int MP = 8448;
constexpr int N0 = 4 * DI;
constexpr int N1 = 2 * 4096 + 2 * DI;
constexpr int HG_H = 64, HG_DK = 128;
constexpr int GL_H = 8, GL_DK = 512, GL_DV = 1024, GL_R = 16;
constexpr float LN_EPS = 1e-5f, RMS_EPS = 1e-6f;
constexpr float ALPHA = 1.41421356237309515f;

constexpr size_t MiB = 1u << 20;
constexpr size_t WS_CTL = 0, CTL_ZERO_BYTES = 1 * MiB;
constexpr size_t WS_LB0 = 1 * MiB;
constexpr size_t WS_G1 = 2 * MiB;
constexpr size_t WS_WG1T = 3 * MiB;
constexpr size_t WS_W2F = 3 * MiB + 256 * 1024;
constexpr size_t WS_WT0IN = 4 * MiB;
constexpr size_t WS_WT0OUT = WS_WT0IN + 256 * MiB;
constexpr size_t WS_WT1IN = WS_WT0OUT + 64 * MiB;
constexpr size_t WS_WT1OUT = WS_WT1IN + 192 * MiB;
constexpr size_t WS_XB = WS_WT1OUT + 64 * MiB;
constexpr size_t WS_H1B = WS_XB + 66 * MiB;
constexpr size_t WS_QFIZ = WS_H1B + 66 * MiB;
constexpr size_t WS_Y = WS_QFIZ + 528 * MiB;
constexpr size_t WS_PRE = WS_Y + 132 * MiB;
constexpr size_t WS_REC = WS_PRE + 132 * MiB;
constexpr size_t WS_Q0 = WS_REC + 520 * MiB;
constexpr size_t WS_Y0 = WS_REC + 523 * MiB;
constexpr size_t WS_REC1 = WS_REC, WS_VF1 = WS_REC + 139 * MiB, WS_O1 = WS_REC + 270 * MiB;
constexpr size_t WS_END = WS_REC + 528 * MiB;
static_assert((size_t)MP * D * 2 <= 66 * MiB && (size_t)MP * N0 * 2 <= 528 * MiB && (size_t)MP * DI * 2 <= 132 * MiB && (size_t)MP * D * 4 <= 132 * MiB && (size_t)MR * DI * 4 <= 258 * MiB, "d_ws map");
static_assert((size_t)256 * 65 * 27648 <= 440 * MiB && (size_t)32 * 65 * 69632 <= 139 * MiB && (size_t)32 * 65 * 65536 <= 131 * MiB, "record map");
constexpr int CW_BAR = 4096, CW_POOL = 8192;

constexpr int RING_OFF = 0, RING_BYTES = 155648;
constexpr int LDSCTL_OFF = RING_BYTES, MISC_OFF = LDSCTL_OFF + 320;
constexpr int LDS_BYTES = 163840;
static_assert(MISC_OFF + 128 <= LDS_BYTES, "LDS map");

#define GAS __attribute__((address_space(1)))
#define LAS __attribute__((address_space(3)))
typedef unsigned short bf16;
typedef unsigned v4u __attribute__((ext_vector_type(4)));
typedef unsigned v2u __attribute__((ext_vector_type(2)));
typedef float f32x4 __attribute__((ext_vector_type(4)));
typedef GAS unsigned gu32;
#define RLX_AGENT __ATOMIC_RELAXED, __HIP_MEMORY_SCOPE_AGENT
#define LDS_WAIT() asm volatile("s_waitcnt lgkmcnt(0)" ::: "memory")
#define DI_ __device__ __forceinline__
DI_ unsigned f2bf(float f) { unsigned u = __builtin_bit_cast(unsigned, f); return (u + 0x7fffu + ((u >> 16) & 1u)) >> 16; }
DI_ unsigned pk2(float lo, float hi) { return f2bf(lo) | (f2bf(hi) << 16); }
DI_ unsigned hwpk(float lo, float hi) { unsigned r; asm volatile("v_cvt_pk_bf16_f32 %0, %1, %2" : "=v"(r) : "v"(lo), "v"(hi)); return r; }
DI_ float bflo(unsigned w) { return __builtin_bit_cast(float, w << 16); }
DI_ float bfhi(unsigned w) { return __builtin_bit_cast(float, w & 0xffff0000u); }
DI_ float bf2f(bf16 b) { return __builtin_bit_cast(float, (unsigned)b << 16); }
DI_ float sigm(float x) { return __builtin_amdgcn_rcpf(1.f + __builtin_amdgcn_exp2f(x * -1.4426950408889634f)); }
DI_ float silu(float x) { return x * __builtin_amdgcn_rcpf(1.f + __builtin_amdgcn_exp2f(x * -1.4426950408889634f)); }

#define XB_TMO      128
#define XB_XCNT(j)  (256  + 64 * (j))
#define XB_XSUB(j)  (1280 + 64 * (j))
#define XB_XGEN(j)  (2304 + 64 * (j))
#define XB_TOP      3328
#define XB_TOPGEN   3392
#define XCD_BAR_WORDS 3456
#define XB_SPIN_CAP (1u << 18)

__device__ __forceinline__ unsigned xb_ld(unsigned* p)              { return __hip_atomic_load(p, __ATOMIC_RELAXED, __HIP_MEMORY_SCOPE_AGENT); }
__device__ __forceinline__ unsigned xb_add(unsigned* p, unsigned v) { return __hip_atomic_fetch_add(p, v, __ATOMIC_RELAXED, __HIP_MEMORY_SCOPE_AGENT); }
__device__ __forceinline__ unsigned xb_xcc_id() { return (unsigned)__builtin_amdgcn_s_getreg((3 << 11) | 20) & 0xFu; }
#define XB_SPIN(cond, bar) do { unsigned _sp = 0; while (cond) { __builtin_amdgcn_s_sleep(1); \
    if ((++_sp & 255u) == 0u) { if (xb_ld(&(bar)[XB_TMO])) break; if (_sp > XB_SPIN_CAP) { atomicAdd(&(bar)[XB_TMO], 1u); break; } } } } while (0)

struct XcdBarrier {
    unsigned* bar; unsigned x;
    volatile LAS unsigned* st;
};
__device__ __forceinline__ XcdBarrier xcd_barrier_post(unsigned* bar, volatile LAS unsigned* st) {
    XcdBarrier b; b.bar = bar; b.x = xb_xcc_id(); b.st = st;
    if (threadIdx.x == 0) (void)xb_add(&bar[XB_XCNT(b.x)], 1u);
    return b;
}
__device__ __forceinline__ void xcd_barrier_complete(unsigned* bar, unsigned x, unsigned& nloc, unsigned& nx) {
    const unsigned G = gridDim.x * gridDim.y * gridDim.z;
    unsigned sum, cnt, mine, sp = 0u;
    for (;;) {
        sum = 0u; cnt = 0u; mine = 0u;
#pragma unroll
        for (unsigned j = 0; j < 16; ++j) { const unsigned c = xb_ld(&bar[XB_XCNT(j)]); sum += c; cnt += (c > 0u) ? 1u : 0u; mine = (j == x) ? c : mine; }
        if (sum == G) break;
        __builtin_amdgcn_s_sleep(1);
        if ((++sp & 255u) == 0u) { if (xb_ld(&bar[XB_TMO])) break; if (sp > XB_SPIN_CAP) { atomicAdd(&bar[XB_TMO], 1u); break; } }
    }
    nloc = mine > 0u ? mine : 1u; nx = cnt > 0u ? cnt : 1u;
}
__device__ __forceinline__ void xcd_barrier(const XcdBarrier& b) {
    asm volatile("s_waitcnt vmcnt(0)" ::: "memory");
    __syncthreads();
    if (threadIdx.x == 0) {
        unsigned* bar = b.bar;
        __builtin_amdgcn_s_waitcnt(0);
        unsigned nloc = b.st[0], nx = b.st[1];
        if (nloc == 0u) { xcd_barrier_complete(bar, b.x, nloc, nx); b.st[0] = nloc; b.st[1] = nx; }
        const unsigned old = xb_add(&bar[XB_XSUB(b.x)], 1u);
        const unsigned gen = old / nloc;
        if (old + 1u == (gen + 1u) * nloc) {
            __builtin_amdgcn_fence(__ATOMIC_RELEASE, "agent");
            asm volatile("s_waitcnt vmcnt(0)" ::: "memory");
            const unsigned og = xb_add(&bar[XB_TOP], 1u);
            const unsigned tg = og / nx;
            if (og + 1u == (tg + 1u) * nx) xb_add(&bar[XB_TOPGEN], 1u);
            else XB_SPIN(xb_ld(&bar[XB_TOPGEN]) == tg, bar);
            __builtin_amdgcn_fence(__ATOMIC_ACQUIRE, "agent");
            xb_add(&bar[XB_XGEN(b.x)], 1u);
            asm volatile("s_waitcnt vmcnt(0)" ::: "memory");
        } else {
            XB_SPIN(xb_ld(&bar[XB_XGEN(b.x)]) == gen, bar);
            __builtin_amdgcn_fence(__ATOMIC_ACQUIRE, "agent");
            asm volatile("s_waitcnt vmcnt(0)" ::: "memory");
        }
    }
    __syncthreads();
}

struct Frame {
    LAS unsigned char* lds;
    volatile LAS unsigned* MISC;
    gu32* ctl;
    int tid, lane, wave;
    int vcu, G;
    const float *x, *meta, *lb_logits;
    const float *w0in, *b_f, *ng0, *w0out, *ln0g, *ln0b;
    const float *w1in, *wg1, *wg2, *b_g, *ng1, *w1out, *ln1g, *ln1b;
    float* out;
    float *LB0, *G1, *PRE, *O1;
    unsigned char *REC0, *REC1, *VF1;
    bf16 *WG1T, *W2F, *Q0, *Y0;
    float* SS;
    bf16 *WT0IN, *WT0OUT, *WT1IN, *WT1OUT, *XB, *H1B, *QFIZ, *Y;
};

DI_ float wave_sum(float v) {
#pragma unroll
    for (int o = 1; o < 64; o <<= 1) v += __shfl_xor(v, o);
    return v;
}

typedef short p0_bf16x8 __attribute__((ext_vector_type(8)));
template <bool META>
DI_ void p0_transpose_item_t(const float* W, int K, int N, bf16* WT, LAS float* scr, int item_kb, int item_nb, int lane, const float* meta, f32x4 (&macc)[2]) {
    const int k0 = 64 * item_kb, n0 = 32 * item_nb;
    float wv[32];
#pragma unroll
    for (int i = 0; i < 32; ++i) wv[i] = __builtin_nontemporal_load(W + (size_t)(k0 + 2 * i + (lane >> 5)) * N + n0 + (lane & 31));
    v4u ma[2][2];
    if (META) {
#pragma unroll
        for (int ks = 0; ks < 2; ++ks) { const GAS f32x4* mp = (const GAS f32x4*)(meta + (size_t)(lane & 15) * D + k0 + 32 * ks + 8 * (lane >> 4)); const f32x4 a = mp[0], b = mp[1];
            ma[ks][0] = (v4u){hwpk(a.x, a.y), hwpk(a.z, a.w), hwpk(b.x, b.y), hwpk(b.z, b.w)}; }
    }
#pragma unroll
    for (int i = 0; i < 32; ++i) scr[(2 * i + (lane >> 5)) * 33 + (lane & 31)] = wv[i];
    LDS_WAIT(); asm volatile("" ::: "memory");
    if (META) {
        const int r = lane & 15, g = lane >> 4;
#pragma unroll
        for (int ks = 0; ks < 2; ++ks)
#pragma unroll
            for (int nh = 0; nh < 2; ++nh) { const LAS float* s = scr + (32 * ks + 8 * g) * 33 + 16 * nh + r;
                const v4u bf = (v4u){hwpk(s[0 * 33], s[1 * 33]), hwpk(s[2 * 33], s[3 * 33]), hwpk(s[4 * 33], s[5 * 33]), hwpk(s[6 * 33], s[7 * 33])};
                macc[nh] = __builtin_amdgcn_mfma_f32_16x16x32_bf16(__builtin_bit_cast(p0_bf16x8, ma[ks][0]), __builtin_bit_cast(p0_bf16x8, bf), macc[nh], 0, 0, 0); }
    }
    const int c = lane & 7;
#pragma unroll
    for (int j = 0; j < 4; ++j) { const int n = (lane >> 3) + 8 * j; const LAS float* s = scr + (8 * c) * 33 + n;
        v4u o; o.x = hwpk(s[0 * 33], s[1 * 33]); o.y = hwpk(s[2 * 33], s[3 * 33]); o.z = hwpk(s[4 * 33], s[5 * 33]); o.w = hwpk(s[6 * 33], s[7 * 33]);
        *(GAS v4u*)(WT + (size_t)(n0 + n) * K + k0 + 8 * c) = o; }
    LDS_WAIT(); asm volatile("" ::: "memory");
}
struct P0Item { const float* src; bf16* dst; int N, K; };
template <bool META, bool PREF>
DI_ void p0_item_pipe(const P0Item cur, const P0Item nxt, float (&wv)[32], f32x4 (&mraw)[4], LAS float* scr, int lane, const float* meta_nxt, f32x4 (&macc)[2]) {
#pragma unroll
    for (int i = 0; i < 32; ++i) scr[(2 * i + (lane >> 5)) * 33 + (lane & 31)] = wv[i];
    v4u ma[2];
    if (META) {
#pragma unroll
        for (int ks = 0; ks < 2; ++ks) { const f32x4 a = mraw[2 * ks], b = mraw[2 * ks + 1]; ma[ks] = (v4u){pk2(a.x, a.y), pk2(a.z, a.w), pk2(b.x, b.y), pk2(b.z, b.w)}; }
    }
    if (PREF) {
        if (META) {
#pragma unroll
            for (int ks = 0; ks < 2; ++ks) { const GAS f32x4* mp = (const GAS f32x4*)(meta_nxt + (size_t)(lane & 15) * D + 32 * ks + 8 * (lane >> 4)); mraw[2 * ks] = mp[0]; mraw[2 * ks + 1] = mp[1]; }
        }
#pragma unroll
        for (int i = 0; i < 32; ++i) wv[i] = __builtin_nontemporal_load(nxt.src + (size_t)(2 * i + (lane >> 5)) * nxt.N + (lane & 31));
    }
    LDS_WAIT(); asm volatile("" ::: "memory");
    if (META) {
        const int r = lane & 15, g = lane >> 4;
#pragma unroll
        for (int ks = 0; ks < 2; ++ks)
#pragma unroll
            for (int nh = 0; nh < 2; ++nh) { const LAS float* s = scr + (32 * ks + 8 * g) * 33 + 16 * nh + r;
                const v4u bf = (v4u){hwpk(s[0 * 33], s[1 * 33]), hwpk(s[2 * 33], s[3 * 33]), hwpk(s[4 * 33], s[5 * 33]), hwpk(s[6 * 33], s[7 * 33])};
                macc[nh] = __builtin_amdgcn_mfma_f32_16x16x32_bf16(__builtin_bit_cast(p0_bf16x8, ma[ks]), __builtin_bit_cast(p0_bf16x8, bf), macc[nh], 0, 0, 0); }
    }
    const int c = lane & 7;
#pragma unroll
    for (int j = 0; j < 4; ++j) { const int n = (lane >> 3) + 8 * j; const LAS float* s = scr + (8 * c) * 33 + n;
        v4u o; o.x = hwpk(s[0 * 33], s[1 * 33]); o.y = hwpk(s[2 * 33], s[3 * 33]); o.z = hwpk(s[4 * 33], s[5 * 33]); o.w = hwpk(s[6 * 33], s[7 * 33]);
        *(GAS v4u*)(cur.dst + (size_t)n * cur.K + 8 * c) = o; }
    LDS_WAIT(); asm volatile("" ::: "memory");
}
DI_ void p0_transpose_item(const float* W, int K, int N, bf16* WT, LAS float* scr, int item, int lane) {
    f32x4 dummy[2]; const int nblk = N / 32;
    p0_transpose_item_t<false>(W, K, N, WT, scr, item / nblk, item % nblk, lane, nullptr, dummy);
}

DI_ void p0_tile_load(const float* W, int N, int k0, int n0, int tid, f32x4 (&wv)[8]) {
    const int row = tid >> 5, c4 = tid & 31;
#pragma unroll
    for (int i = 0; i < 8; ++i) wv[i] = *(const GAS f32x4*)(W + (size_t)(k0 + row + 16 * i) * N + n0 + 4 * c4);
}
DI_ void p0_tile_to_lds(int tid, const f32x4 (&wv)[8], LAS unsigned char* img) {
    const int row = tid >> 5, c4 = tid & 31;
#pragma unroll
    for (int i = 0; i < 8; ++i) { const int k = row + 16 * i; const int col = (2 * c4) ^ (2 * ((k >> 3) & 15));
        *(LAS v2u*)(img + k * 256 + col * 4) = (v2u){hwpk(wv[i].x, wv[i].y), hwpk(wv[i].z, wv[i].w)}; }
}
DI_ void p0_tile_from_lds(bf16* WT, int K, int k0, int n0, int tid, LAS unsigned char* img) {
    __syncthreads();
    const int kc = tid & 15;
#pragma unroll
    for (int j = 0; j < 4; ++j) { const int n = (tid >> 4) + 32 * j; unsigned short hv[8];
#pragma unroll
        for (int e = 0; e < 8; ++e) hv[e] = *(const LAS unsigned short*)(img + (8 * kc + e) * 256 + ((((n >> 1) ^ (2 * kc)) << 2) | ((n & 1) << 1)));
        v4u o; o.x = hv[0] | ((unsigned)hv[1] << 16); o.y = hv[2] | ((unsigned)hv[3] << 16); o.z = hv[4] | ((unsigned)hv[5] << 16); o.w = hv[6] | ((unsigned)hv[7] << 16);
        *(GAS v4u*)(WT + (size_t)(n0 + n) * K + k0 + 8 * kc) = o; }
    __syncthreads();
}
struct P0Tile { const float* W; bf16* WT; int K, N, k0, n0; };
DI_ P0Tile p0_tile_decode(Frame& F, int t) {
    constexpr int T_0 = (D / 128) * (N0 / 128), T_1 = (DI / 128) * (D / 128), T_2 = (D / 128) * (N1 / 128);
    P0Tile p;
    if (t < T_0) { p.W = F.w0in; p.WT = F.WT0IN; p.K = D; p.N = N0; }
    else if (t < T_0 + T_1) { t -= T_0; p.W = F.w0out; p.WT = F.WT0OUT; p.K = DI; p.N = D; }
    else if (t < T_0 + T_1 + T_2) { t -= T_0 + T_1; p.W = F.w1in; p.WT = F.WT1IN; p.K = D; p.N = N1; }
    else { t -= T_0 + T_1 + T_2; p.W = F.w1out; p.WT = F.WT1OUT; p.K = DI; p.N = D; }
    const int nt = p.N / 128, kb = t / nt, nb = t - kb * nt; p.k0 = 128 * kb; p.n0 = 128 * nb; return p;
}
DI_ void p0_transpose_all(Frame& F) {
    constexpr int NT = (D / 128) * (N0 / 128) + 2 * (DI / 128) * (D / 128) + (D / 128) * (N1 / 128);
    f32x4 wv[8];
    int t = F.vcu;
    if (t < NT) { const P0Tile p = p0_tile_decode(F, t); p0_tile_load(p.W, p.N, p.k0, p.n0, F.tid, wv); }
    for (; t < NT; t += F.G) {
        const P0Tile p = p0_tile_decode(F, t);
        p0_tile_to_lds(F.tid, wv, F.lds);
        if (t + F.G < NT) { const P0Tile q = p0_tile_decode(F, t + F.G); p0_tile_load(q.W, q.N, q.k0, q.n0, F.tid, wv); }
        p0_tile_from_lds(p.WT, p.K, p.k0, p.n0, F.tid, F.lds);
    }
}

DI_ void p0_prologue(Frame& F) {
    LAS float* scr = (LAS float*)(F.lds + RING_OFF + F.wave * 16384);
    const int gw = F.vcu * NWAVES + F.wave, NGW = F.G * NWAVES;
    constexpr int I_0 = (D / 64) * (N0 / 32), I_1 = (DI / 64) * (D / 32), I_2 = (D / 64) * (N1 / 32), I_3 = I_1;
    constexpr int NITEMS = I_0 + I_1 + I_2 + I_3;
#if USE_TILE_TRANSPOSE
    p0_transpose_all(F);
#else
    if (P0_META_FOLD && F.G == 256) {
        constexpr int OTH = I_1 + I_2 + I_3;
        static_assert(OTH == 8192 + 1024 * 72, "tile split");
        auto other = [&](int r) -> P0Item {
            const float* W; bf16* WT; int K, N;
            if (r < I_1) { W = F.w0out; WT = F.WT0OUT; K = DI; N = D; }
            else if (r < I_1 + I_2) { r -= I_1; W = F.w1in; WT = F.WT1IN; K = D; N = N1; }
            else { r -= I_1 + I_2; W = F.w1out; WT = F.WT1OUT; K = DI; N = D; }
            const int nblk = N / 32, kb = r / nblk, nb = r - kb * nblk;
            return P0Item{W + (size_t)(64 * kb) * N + 32 * nb, WT + (size_t)(32 * nb) * K + 64 * kb, N, K};
        };
        float wv[32]; f32x4 mraw[4]; f32x4 macc[2]; macc[0] = (f32x4){0.f, 0.f, 0.f, 0.f}; macc[1] = macc[0];
        const int lane = F.lane;
        int o_lo, o_hi;
        P0Item cur;
        if (gw < 1024) {
            cur = P0Item{F.w0in + 32 * gw, F.WT0IN + (size_t)(32 * gw) * D, N0, D};
#pragma unroll
            for (int ks = 0; ks < 2; ++ks) { const GAS f32x4* mp = (const GAS f32x4*)(F.meta + (size_t)(lane & 15) * D + 32 * ks + 8 * (lane >> 4)); mraw[2 * ks] = mp[0]; mraw[2 * ks + 1] = mp[1]; }
            o_lo = gw * 8; o_hi = o_lo + 8;
        } else { o_lo = 8192 + (gw - 1024) * 72; o_hi = o_lo + 72; cur = other(o_lo); }
#pragma unroll
        for (int i = 0; i < 32; ++i) wv[i] = __builtin_nontemporal_load(cur.src + (size_t)(2 * i + (lane >> 5)) * cur.N + (lane & 31));
        if (gw < 1024) {
            for (int kb = 0; kb < D / 64 - 1; ++kb) {
                const P0Item nxt = P0Item{cur.src + (size_t)64 * N0, cur.dst + 64, N0, D};
                p0_item_pipe<true, true>(cur, nxt, wv, mraw, scr, lane, F.meta + 64 * (kb + 1), macc); cur = nxt; }
            { const P0Item nxt = other(o_lo); p0_item_pipe<true, true>(cur, nxt, wv, mraw, scr, lane, F.meta, macc); cur = nxt; }
            const int r = lane & 15, g = lane >> 4;
#pragma unroll
            for (int nh = 0; nh < 2; ++nh) { const float mv[4] = {macc[nh].x, macc[nh].y, macc[nh].z, macc[nh].w};
#pragma unroll
                for (int jj = 0; jj < 4; ++jj) F.Q0[(size_t)(16 + 4 * g + jj) * N0 + 32 * gw + 16 * nh + r] = (bf16)f2bf(mv[jj]); }
        }
        for (int it = o_lo; it < o_hi - 1; ++it) { const P0Item nxt = other(it + 1); p0_item_pipe<false, true>(cur, nxt, wv, mraw, scr, lane, nullptr, macc); cur = nxt; }
        p0_item_pipe<false, false>(cur, cur, wv, mraw, scr, lane, nullptr, macc);
    } else
    for (int it = gw; it < NITEMS; it += NGW) {
        int r = it;
        if (r < I_0) { p0_transpose_item(F.w0in, D, N0, F.WT0IN, scr, r, F.lane); continue; } r -= I_0;
        if (USE_AUX && USE_L0_MFMA == 2 && F.G == 256) break;
        if (r < I_1) { p0_transpose_item(F.w0out, DI, D, F.WT0OUT, scr, r, F.lane); continue; } r -= I_1;
        if (r < I_2) { p0_transpose_item(F.w1in, D, N1, F.WT1IN, scr, r, F.lane); continue; } r -= I_2;
        p0_transpose_item(F.w1out, DI, D, F.WT1OUT, scr, r, F.lane);
    }
#endif
    for (int m = gw; m < MP; m += NGW) {
        GAS unsigned long long* o8 = (GAS unsigned long long*)(F.XB + (size_t)m * D) + F.lane;
        if (m < MR) {
            const float* src = (m < MX) ? F.x + (size_t)m * D : F.meta + (size_t)(m - MX) * D;
            const GAS f32x4* xr = (const GAS f32x4*)src + F.lane;
            f32x4 xv[16];
#pragma unroll
            for (int j = 0; j < 16; ++j) xv[j] = __builtin_nontemporal_load(xr + 64 * j);
#pragma unroll
            for (int j = 0; j < 16; ++j) { const f32x4 v = xv[j]; o8[64 * j] = (unsigned long long)hwpk(v.x, v.y) | ((unsigned long long)hwpk(v.z, v.w) << 32); }
        } else {
#pragma unroll 4
            for (int j = 0; j < 16; ++j) o8[64 * j] = 0ull;
        }
    }
    for (int m = MR + gw; m < MP; m += NGW) {
        GAS unsigned long long* o8 = (GAS unsigned long long*)(F.H1B + (size_t)m * D) + F.lane;
#pragma unroll 4
        for (int j = 0; j < 16; ++j) o8[64 * j] = 0ull;
    }
    for (int i = gw * 64 + F.lane; i < 16 * N0 / 8; i += NGW * 64) { const int col8 = i % (N0 / 8); const unsigned v = (col8 >= DI / 8 && col8 < 2 * DI / 8) ? 0x47004700u : 0u;
        *((GAS v4u*)F.Q0 + i) = (v4u){v, v, v, v}; }
    for (int i = gw * 64 + F.lane; i < GL_R * D; i += NGW * 64) { const int n = i / D, k = i - n * D; F.WG1T[i] = (bf16)f2bf(F.wg1[(size_t)k * GL_R + n]); }
    for (int i = gw * 64 + F.lane; i < 8 * 16 * 2 * 64 * 8; i += NGW * 64) {
        const int e = i & 7, ln = (i >> 3) & 63, fr = i >> 9, m2 = fr & 1, s2 = (fr >> 1) & 15, hh = fr >> 5, rA = ln & 15, gA = ln >> 4;
        float v = 0.f; if (gA < 2) v = F.wg2[(size_t)(8 * gA + e) * 4096 + hh * 512 + 32 * s2 + 8 * (rA >> 2) + 4 * m2 + (rA & 3)];
        F.W2F[i] = (bf16)f2bf(v);
    }
    for (int c = gw * 64 + F.lane; c < DI; c += NGW * 64) {
        const float l0 = F.lb_logits[c], l1 = F.lb_logits[DI + c], l2 = F.lb_logits[2 * DI + c];
        const float mx = fmaxf(l0, fmaxf(l1, l2));
        const float e0 = __expf(l0 - mx), e1 = __expf(l1 - mx), e2 = __expf(l2 - mx);
        F.LB0[c] = e0 / (e0 + e1 + e2);
    }
}

DI_ void p2_l0_rec_naive(Frame& F) {
    LAS float* qs = (LAS float*)(F.lds);
    LAS float* fs = qs + 2048;
    LAS float* ks = fs + 2048;
    LAS float* vs = ks + 2048;
    LAS float* pb = vs + 2048;
    const int tid = F.tid, dv = tid & 127, kg = tid >> 7;
    const int lj = tid >> 5, lc = (tid & 31) * 4;
    for (int u = blockIdx.x; u < NB * HG_H; u += F.G) {
        const int b = u >> 6, h = u & 63;
        float S[32];
#pragma unroll
        for (int i = 0; i < 32; ++i) S[i] = 0.f;
        float lbv[4], bfv[4], ngv[4];
#pragma unroll
        for (int i = 0; i < 4; ++i) { lbv[i] = F.LB0[h * 128 + lc + i]; bfv[i] = F.b_f[h * 128 + lc + i]; ngv[i] = F.ng0[h * 128 + lc + i]; }
        for (int tb = 0; tb < 129; ++tb) {
            const int rbase = (tb == 0) ? MX : b * SEQ + 16 * (tb - 1);
            const bf16* row = F.QFIZ + (size_t)(rbase + lj) * N0 + h * 128 + lc;
            {
                const v2u q4 = *(const GAS v2u*)(row), f4 = *(const GAS v2u*)(row + DI), i4 = *(const GAS v2u*)(row + 2 * DI);
                const float qv[4] = {bflo(q4.x), bfhi(q4.x), bflo(q4.y), bfhi(q4.y)};
                const float fv[4] = {bflo(f4.x), bfhi(f4.x), bflo(f4.y), bfhi(f4.y)};
                const float iv[4] = {bflo(i4.x), bfhi(i4.x), bflo(i4.y), bfhi(i4.y)};
#pragma unroll
                for (int i = 0; i < 4; ++i) {
                    const float fg = lbv[i] + (1.f - lbv[i]) * sigm(fv[i] + bfv[i]);
                    qs[lj * 128 + lc + i] = silu(qv[i]); fs[lj * 128 + lc + i] = fg; ks[lj * 128 + lc + i] = 1.f - fg; vs[lj * 128 + lc + i] = iv[i];
                }
            }
            __syncthreads();
            for (int j = 0; j < 16; ++j) {
                const float vj = vs[j * 128 + dv]; float po = 0.f;
#pragma unroll
                for (int i = 0; i < 32; i += 4) {
                    const f32x4 f4 = *(const LAS f32x4*)(fs + j * 128 + kg * 32 + i), k4 = *(const LAS f32x4*)(ks + j * 128 + kg * 32 + i), q4 = *(const LAS f32x4*)(qs + j * 128 + kg * 32 + i);
                    S[i + 0] = f4.x * S[i + 0] + k4.x * vj; po += q4.x * S[i + 0];
                    S[i + 1] = f4.y * S[i + 1] + k4.y * vj; po += q4.y * S[i + 1];
                    S[i + 2] = f4.z * S[i + 2] + k4.z * vj; po += q4.z * S[i + 2];
                    S[i + 3] = f4.w * S[i + 3] + k4.w * vj; po += q4.w * S[i + 3];
                }
                pb[(j * 4 + kg) * 128 + dv] = po;
            }
            __syncthreads();
            {
                f32x4 o = *(const LAS f32x4*)(pb + (lj * 4 + 0) * 128 + lc);
                o += *(const LAS f32x4*)(pb + (lj * 4 + 1) * 128 + lc);
                o += *(const LAS f32x4*)(pb + (lj * 4 + 2) * 128 + lc);
                o += *(const LAS f32x4*)(pb + (lj * 4 + 3) * 128 + lc);
                float ss = o.x * o.x + o.y * o.y + o.z * o.z + o.w * o.w;
                ss += __shfl_xor(ss, 16); ss += __shfl_xor(ss, 8); ss += __shfl_xor(ss, 4); ss += __shfl_xor(ss, 2); ss += __shfl_xor(ss, 1);
                const float rs = rsqrtf(ss * (1.f / 128.f) + RMS_EPS);
                const v2u z4 = *(const GAS v2u*)(row + 3 * DI);
                const float y0 = o.x * rs * ngv[0] * silu(bflo(z4.x)), y1 = o.y * rs * ngv[1] * silu(bfhi(z4.x));
                const float y2 = o.z * rs * ngv[2] * silu(bflo(z4.y)), y3 = o.w * rs * ngv[3] * silu(bfhi(z4.y));
                if (tb > 0 || b == 0) { v2u w; w.x = pk2(y0, y1); w.y = pk2(y2, y3); *(GAS v2u*)(F.Y + (size_t)(rbase + lj) * DI + h * 128 + lc) = w; }
            }
        }
        __syncthreads();
    }
}

DI_ void ln_phase(Frame& F, const float* src, int nrows, const float* g, const float* bt, float* dst32, bf16* dstb, float* G1) {
    const int gw = F.vcu * NWAVES + F.wave, NGW = F.G * NWAVES;
    for (int r = gw; r < nrows; r += NGW) {
        const GAS f32x4* s = (const GAS f32x4*)(src + (size_t)r * D) + F.lane;
        f32x4 v[16]; float sm = 0.f;
#pragma unroll
        for (int j = 0; j < 16; ++j) { v[j] = s[64 * j]; sm += (v[j].x + v[j].y) + (v[j].z + v[j].w); }
        const float mean = wave_sum(sm) * (1.f / D); float s2 = 0.f;
#pragma unroll
        for (int j = 0; j < 16; ++j) { v[j] = v[j] - mean; s2 += (v[j].x * v[j].x + v[j].y * v[j].y) + (v[j].z * v[j].z + v[j].w * v[j].w); }
        const float rstd = rsqrtf(wave_sum(s2) * (1.f / D) + LN_EPS);
#pragma unroll
        for (int j = 0; j < 16; ++j) {
            const f32x4 gg = *((const GAS f32x4*)g + F.lane + 64 * j), bb = *((const GAS f32x4*)bt + F.lane + 64 * j);
            v[j] = v[j] * rstd * gg + bb;
            if (dst32) *((GAS f32x4*)(dst32 + (size_t)r * D) + F.lane + 64 * j) = v[j];
            if (dstb) { v2u w; w.x = hwpk(v[j].x, v[j].y); w.y = hwpk(v[j].z, v[j].w); *((GAS v2u*)(dstb + (size_t)r * D) + F.lane + 64 * j) = w; }
            if ((j & 3) == 3) asm volatile("" ::: "memory");
        }
        if (G1) {
            LAS float* rowbuf = (LAS float*)(F.lds + RING_OFF + F.wave * 16384);
#pragma unroll
            for (int j = 0; j < 16; ++j) *(LAS f32x4*)(rowbuf + 256 * j + 4 * F.lane) = v[j];
            LDS_WAIT(); asm volatile("" ::: "memory");
            float a[16];
#pragma unroll
            for (int q = 0; q < 16; ++q) a[q] = 0.f;
#pragma unroll 2
            for (int i = 0; i < 64; ++i) {
                const int k = 64 * i + F.lane;
                const float e = rowbuf[k];
                const GAS f32x4* w = (const GAS f32x4*)(F.wg1 + (size_t)k * GL_R);
                const f32x4 w0 = w[0], w1 = w[1], w2 = w[2], w3 = w[3];
                a[0] += e * w0.x; a[1] += e * w0.y; a[2] += e * w0.z; a[3] += e * w0.w;
                a[4] += e * w1.x; a[5] += e * w1.y; a[6] += e * w1.z; a[7] += e * w1.w;
                a[8] += e * w2.x; a[9] += e * w2.y; a[10] += e * w2.z; a[11] += e * w2.w;
                a[12] += e * w3.x; a[13] += e * w3.y; a[14] += e * w3.z; a[15] += e * w3.w;
            }
#pragma unroll
            for (int q = 0; q < 16; ++q) a[q] = wave_sum(a[q]);
            if (F.lane == 0) {
#pragma unroll
                for (int q = 0; q < 16; q += 4) *(GAS f32x4*)(G1 + (size_t)r * GL_R + q) = (f32x4){a[q], a[q + 1], a[q + 2], a[q + 3]};
            }
            LDS_WAIT(); asm volatile("" ::: "memory");
        }
    }
}

DI_ void ln_phase2(Frame& F, const float* src, int nrows, const float* g, const float* bt, float* dst32, bf16* dstb) {
    const int gw = F.vcu * NWAVES + F.wave, NGW = F.G * NWAVES;
    LAS float* gL = (LAS float*)(F.lds + RING_OFF); LAS float* bL = gL + D;
    for (int i = F.tid; i < D / 4; i += NWAVES * 64) { *(LAS f32x4*)(gL + 4 * i) = *((const GAS f32x4*)g + i); *(LAS f32x4*)(bL + 4 * i) = *((const GAS f32x4*)bt + i); }
    __syncthreads();
    f32x4 va[16], vb[16];
#define LN_LOAD(v_, r_) do { const GAS f32x4* s_ = (const GAS f32x4*)(((r_) < nrows) ? src + (size_t)(r_) * D : g) + F.lane; \
        _Pragma("unroll") for (int j = 0; j < 16; ++j) v_[j] = s_[64 * j]; } while (0)
#define LN_PROC(v_, r_) do { float sm = 0.f; \
        _Pragma("unroll") for (int j = 0; j < 16; ++j) sm += (v_[j].x + v_[j].y) + (v_[j].z + v_[j].w); \
        const float mean = wave_sum(sm) * (1.f / D); float s2 = 0.f; \
        _Pragma("unroll") for (int j = 0; j < 16; ++j) { v_[j] = v_[j] - mean; s2 += (v_[j].x * v_[j].x + v_[j].y * v_[j].y) + (v_[j].z * v_[j].z + v_[j].w * v_[j].w); } \
        const float rstd = rsqrtf(wave_sum(s2) * (1.f / D) + LN_EPS); \
        _Pragma("unroll") for (int j = 0; j < 16; ++j) { \
            const f32x4 gg = *(const LAS f32x4*)(gL + 4 * (F.lane + 64 * j)), bb = *(const LAS f32x4*)(bL + 4 * (F.lane + 64 * j)); \
            const f32x4 o_ = v_[j] * rstd * gg + bb; \
            if (dst32) *((GAS f32x4*)(dst32 + (size_t)(r_) * D) + F.lane + 64 * j) = o_; \
            if (dstb) { v2u w_; w_.x = pk2(o_.x, o_.y); w_.y = pk2(o_.z, o_.w); *((GAS v2u*)(dstb + (size_t)(r_) * D) + F.lane + 64 * j) = w_; } \
            if ((j & 3) == 3) asm volatile("" ::: "memory"); } } while (0)
    int r = gw;
    LN_LOAD(va, r);
    while (r < nrows) {
        LN_LOAD(vb, r + NGW);
        LN_PROC(va, r);
        r += NGW; if (r >= nrows) break;
        LN_LOAD(va, r + NGW);
        LN_PROC(vb, r);
        r += NGW;
    }
#undef LN_LOAD
#undef LN_PROC
}

DI_ void p6_l1_rec_naive(Frame& F) {
    LAS float* qs = (LAS float*)(F.lds);
    LAS float* ks = qs + 4096;
    LAS float* gs = ks + 4096;
    LAS float* vs = gs + 4096;
    LAS float* pb = vs + 512;
    const int tid = F.tid, dv = tid & 63, kg = tid >> 6;
    const float qscale = 0.04419417382415922f;
    for (int u = blockIdx.x; u < NB * GL_H * 16; u += F.G) {
        const int dvs = u & 15, bh = u >> 4, b = bh >> 3, h = bh & 7;
        float S[64];
#pragma unroll
        for (int i = 0; i < 64; ++i) S[i] = 0.f;
        float w2[16];
#pragma unroll
        for (int r = 0; r < 16; ++r) w2[r] = F.wg2[(size_t)r * 4096 + h * 512 + tid];
        const float bg = F.b_g[h * 512 + tid];
        for (int tb = 0; tb < 258; ++tb) {
            const int rbase = (tb < 2) ? MX + 8 * tb : b * SEQ + 8 * (tb - 2);
            for (int j = 0; j < 8; ++j) {
                const size_t r = (size_t)(rbase + j);
                const float q = bf2f(F.QFIZ[r * N1 + h * 512 + tid]) * qscale, k = bf2f(F.QFIZ[r * N1 + 4096 + h * 512 + tid]);
                const float* g1 = F.G1 + r * GL_R;
                float xg = bg;
#pragma unroll
                for (int rr = 0; rr < 16; ++rr) xg += g1[rr] * w2[rr];
                const float ls = fminf(xg, 0.f) - log1pf(__expf(-fabsf(xg)));
                qs[j * 512 + tid] = q; ks[j * 512 + tid] = k; gs[j * 512 + tid] = __expf(ls * (1.f / 16.f));
            }
            vs[tid] = bf2f(F.QFIZ[(size_t)(rbase + (tid >> 6)) * N1 + 8192 + h * 1024 + dvs * 64 + (tid & 63)]);
            __syncthreads();
            for (int j = 0; j < 8; ++j) {
                const float vj = vs[j * 64 + dv]; float po = 0.f;
#pragma unroll
                for (int i = 0; i < 64; i += 4) {
                    const f32x4 g4 = *(const LAS f32x4*)(gs + j * 512 + kg * 64 + i), k4 = *(const LAS f32x4*)(ks + j * 512 + kg * 64 + i), q4 = *(const LAS f32x4*)(qs + j * 512 + kg * 64 + i);
                    S[i + 0] = g4.x * S[i + 0] + k4.x * vj; po += q4.x * S[i + 0];
                    S[i + 1] = g4.y * S[i + 1] + k4.y * vj; po += q4.y * S[i + 1];
                    S[i + 2] = g4.z * S[i + 2] + k4.z * vj; po += q4.z * S[i + 2];
                    S[i + 3] = g4.w * S[i + 3] + k4.w * vj; po += q4.w * S[i + 3];
                    if ((i & 12) == 12) asm volatile("" ::: "memory");
                }
                pb[(j * 8 + kg) * 64 + dv] = po;
            }
            __syncthreads();
            {
                const int j = tid >> 6, d = tid & 63; float o = 0.f;
#pragma unroll
                for (int g = 0; g < 8; ++g) o += pb[(j * 8 + g) * 64 + d];
                if (tb >= 2 || b == 0) F.O1[(size_t)(rbase + j) * DI + h * 1024 + dvs * 64 + d] = o;
            }
        }
        __syncthreads();
    }
}

DI_ void p7_normgate(Frame& F) {
    const int gw = F.vcu * NWAVES + F.wave, NGW = F.G * NWAVES;
    for (int it = gw; it < MX * GL_H; it += NGW) {
        const int r = it >> 3, h = it & 7;
        const GAS v4u* o = (const GAS v4u*)((const bf16*)F.O1 + (size_t)r * DI + h * 1024) + F.lane;
        const GAS v4u* zp = (const GAS v4u*)(F.QFIZ + (size_t)r * N1 + 16384 + h * 1024) + F.lane;
        v4u ov[2], zv[2]; float ss = 0.f;
#pragma unroll
        for (int j = 0; j < 2; ++j) { ov[j] = o[64 * j]; zv[j] = zp[64 * j]; }
        float x[2][8];
#pragma unroll
        for (int j = 0; j < 2; ++j) { x[j][0] = bflo(ov[j].x); x[j][1] = bfhi(ov[j].x); x[j][2] = bflo(ov[j].y); x[j][3] = bfhi(ov[j].y); x[j][4] = bflo(ov[j].z); x[j][5] = bfhi(ov[j].z); x[j][6] = bflo(ov[j].w); x[j][7] = bfhi(ov[j].w);
#pragma unroll
            for (int e = 0; e < 8; ++e) ss += x[j][e] * x[j][e]; }
        const float rs = rsqrtf(wave_sum(ss) * (1.f / 1024.f) + RMS_EPS);
#pragma unroll
        for (int j = 0; j < 2; ++j) {
            const int c = h * 1024 + 512 * j + 8 * F.lane;
            const f32x4 n0 = *(const GAS f32x4*)(F.ng1 + c), n1 = *(const GAS f32x4*)(F.ng1 + c + 4);
            const float z[8] = {bflo(zv[j].x), bfhi(zv[j].x), bflo(zv[j].y), bfhi(zv[j].y), bflo(zv[j].z), bfhi(zv[j].z), bflo(zv[j].w), bfhi(zv[j].w)};
            v4u wv; wv.x = pk2(x[j][0] * rs * n0.x * silu(z[0]), x[j][1] * rs * n0.y * silu(z[1])); wv.y = pk2(x[j][2] * rs * n0.z * silu(z[2]), x[j][3] * rs * n0.w * silu(z[3]));
            wv.z = pk2(x[j][4] * rs * n1.x * silu(z[4]), x[j][5] * rs * n1.y * silu(z[5])); wv.w = pk2(x[j][6] * rs * n1.z * silu(z[6]), x[j][7] * rs * n1.w * silu(z[7]));
            *(GAS v4u*)(F.Y + (size_t)r * DI + c) = wv;
        }
    }
}

typedef short bf16x8 __attribute__((ext_vector_type(8)));
#ifndef USE_FUSED_NORM
#define USE_FUSED_NORM 1
#endif
constexpr int NCH = 65;
constexpr int SSP_OFF = 155648 + 512;
constexpr float LOG2E = 1.4426950408889634f;
constexpr int R1_QD = 0, R1_KD = 32768, R1_P = 65536, R1_GL = 67584, R1_SH = 69632;
constexpr int ST1 = R1_SH + 8192;
constexpr int R0_QD = 0, R0_KD = 8192, R0_P = 16384, R0_V = 18432, R0_GL = 26624, R0_SZ = 27648;
constexpr int ST0 = R0_SZ;

DI_ unsigned cvtpk(float lo, float hi) { unsigned r; asm volatile("v_cvt_pk_bf16_f32 %0, %1, %2" : "=v"(r) : "v"(lo), "v"(hi)); return r; }
template <int N> DI_ float row_shr(float x) { return __builtin_bit_cast(float, __builtin_amdgcn_update_dpp(0, __builtin_bit_cast(int, x), 0x110 + N, 0xF, 0xF, true)); }
DI_ float bcast15(float x) { return __builtin_bit_cast(float, __builtin_amdgcn_update_dpp(0, __builtin_bit_cast(int, x), 0x15F, 0xF, 0xF, true)); }
DI_ float scan16(float x) { x += row_shr<1>(x); x += row_shr<2>(x); x += row_shr<4>(x); x += row_shr<8>(x); return x; }
DI_ float ex2(float x) { return __builtin_amdgcn_exp2f(x); }
DI_ float lg2(float x) { return __builtin_amdgcn_logf(x); }
DI_ int row_of(int b, int c, int tok) { return c == 0 ? MX + tok - 16 : b * SEQ + 32 * (c - 1) + tok; }
DI_ bf16x8 mk8(unsigned a, unsigned b, unsigned c, unsigned d) { v4u t; t.x = a; t.y = b; t.z = c; t.w = d; return __builtin_bit_cast(bf16x8, t); }
#define MFMA16(a, b, c) __builtin_amdgcn_mfma_f32_16x16x32_bf16((a), (b), (c), 0, 0, 0)

DI_ void l1_prep(Frame& F, unsigned char* REC1, unsigned char* VF1, const bf16* W2F) {
    const int lane = F.lane, w = F.wave, r = lane & 15, g = lane >> 4;
    LAS unsigned char* T = F.lds + w * 16384;
    LAS unsigned char* Tv = F.lds + w * 16384 + 4096;
    LAS f32x4* Pp = (LAS f32x4*)(F.lds + 131072);
    const float qscale = 0.04419417382415922f;
    for (int it = blockIdx.x; it < NB * GL_H * NCH; it += F.G) {
        const int bh = it / NCH, c = it - bh * NCH, b = bh >> 3, h = bh & 7;
        unsigned char* rec = REC1 + (size_t)it * R1_SH;
        int row[2]; bool nul[2];
#pragma unroll
        for (int ti = 0; ti < 2; ++ti) { const int tok = 16 * ti + r; nul[ti] = (c == 0 && tok < 16); row[ti] = nul[ti] ? 0 : row_of(b, c, tok); }
        bf16x8 g1f[2];
#pragma unroll
        for (int ti = 0; ti < 2; ++ti) {
            f32x4 t0 = (f32x4){0.f, 0.f, 0.f, 0.f}, t1 = t0;
            if (g < 2) { const GAS f32x4* gp = (const GAS f32x4*)(F.G1 + (size_t)row[ti] * GL_R + 8 * g); t0 = gp[0]; t1 = gp[1]; }
            g1f[ti] = mk8(pk2(t0.x, t0.y), pk2(t0.z, t0.w), pk2(t1.x, t1.y), pk2(t1.z, t1.w));
        }
        f32x4 pacc[3];
#pragma unroll
        for (int t = 0; t < 3; ++t) pacc[t] = (f32x4){0.f, 0.f, 0.f, 0.f};
        v4u qraw[2][2], kraw[2][2];
#pragma unroll
        for (int si = 0; si < 2; ++si)
#pragma unroll
            for (int ti = 0; ti < 2; ++ti) { const bf16* rp = F.QFIZ + (size_t)row[ti] * N1 + h * 512 + 32 * (2 * w + si) + 8 * g; qraw[si][ti] = *(const GAS v4u*)rp; kraw[si][ti] = *(const GAS v4u*)(rp + 4096); }
        v4u vraw[8];
        if (USE_L1_SEQ2) {
#pragma unroll
            for (int i2 = 0; i2 < 8; ++i2) { const int q = lane + 64 * i2, tk = q >> 4, c16 = q & 15; const int vrow = (c == 0) ? MX - 16 + tk : b * SEQ + 32 * (c - 1) + tk;
                vraw[i2] = *(const GAS v4u*)(F.QFIZ + (size_t)vrow * N1 + 8192 + h * 1024 + 128 * w + 8 * c16); }
        }
        asm volatile("" ::: "memory");
#pragma unroll
        for (int si = 0; si < 2; ++si) {
            const int s = 2 * w + si, col = h * 512 + 32 * s + 8 * g;
            float xg[2][8];
            { const f32x4 b0 = *(const GAS f32x4*)(F.b_g + col), b1 = *(const GAS f32x4*)(F.b_g + col + 4);
              const bf16x8 wa = *(const GAS bf16x8*)(W2F + ((size_t)((h * 16 + s) * 2 + 0) * 64 + lane) * 8), wb = *(const GAS bf16x8*)(W2F + ((size_t)((h * 16 + s) * 2 + 1) * 64 + lane) * 8);
#pragma unroll
              for (int ti = 0; ti < 2; ++ti) { const f32x4 xa = MFMA16(wa, g1f[ti], b0), xb = MFMA16(wb, g1f[ti], b1);
                  xg[ti][0] = xa.x; xg[ti][1] = xa.y; xg[ti][2] = xa.z; xg[ti][3] = xa.w; xg[ti][4] = xb.x; xg[ti][5] = xb.y; xg[ti][6] = xb.z; xg[ti][7] = xb.w; } }
            float qv[2][8], kv[2][8];
#pragma unroll
            for (int ti = 0; ti < 2; ++ti) {
                const v4u q4 = qraw[si][ti], k4 = kraw[si][ti];
                qv[ti][0] = bflo(q4.x); qv[ti][1] = bfhi(q4.x); qv[ti][2] = bflo(q4.y); qv[ti][3] = bfhi(q4.y); qv[ti][4] = bflo(q4.z); qv[ti][5] = bfhi(q4.z); qv[ti][6] = bflo(q4.w); qv[ti][7] = bfhi(q4.w);
                kv[ti][0] = bflo(k4.x); kv[ti][1] = bfhi(k4.x); kv[ti][2] = bflo(k4.y); kv[ti][3] = bfhi(k4.y); kv[ti][4] = bflo(k4.z); kv[ti][5] = bfhi(k4.z); kv[ti][6] = bflo(k4.w); kv[ti][7] = bfhi(k4.w);
            }
            unsigned qd[2][4], ki[2][4], kd[2][4]; float gl[8];
#pragma unroll
            for (int e = 0; e < 8; e += 2) {
                float bb[2][2], BB[2];
#pragma unroll
                for (int u = 0; u < 2; ++u) {
                    float L0 = nul[0] ? 0.f : (fminf(xg[0][e + u], 0.f) * LOG2E - lg2(1.f + ex2(-fabsf(xg[0][e + u]) * LOG2E))) * (1.f / 16.f);
                    float L1 = nul[1] ? 0.f : (fminf(xg[1][e + u], 0.f) * LOG2E - lg2(1.f + ex2(-fabsf(xg[1][e + u]) * LOG2E))) * (1.f / 16.f);
                    const float b0 = scan16(L0);
                    const float b1 = scan16(L1) + bcast15(b0);
                    bb[0][u] = b0; bb[1][u] = b1; BB[u] = bcast15(b1);
                    gl[e + u] = ex2(BB[u]);
                }
#pragma unroll
                for (int ti = 0; ti < 2; ++ti) {
                    const float q0 = nul[ti] ? 0.f : qv[ti][e] * qscale, q1 = nul[ti] ? 0.f : qv[ti][e + 1] * qscale;
                    const float k0 = nul[ti] ? 0.f : kv[ti][e], k1 = nul[ti] ? 0.f : kv[ti][e + 1];
                    const float ki0 = k0 * ex2(-bb[ti][0]), ki1 = k1 * ex2(-bb[ti][1]);
                    qd[ti][e >> 1] = cvtpk(q0 * ex2(bb[ti][0]), q1 * ex2(bb[ti][1]));
                    ki[ti][e >> 1] = cvtpk(ki0, ki1);
                    kd[ti][e >> 1] = cvtpk(ki0 * gl[e], ki1 * gl[e + 1]);
                }
            }
            const bf16x8 qf0 = mk8(qd[0][0], qd[0][1], qd[0][2], qd[0][3]), qf1 = mk8(qd[1][0], qd[1][1], qd[1][2], qd[1][3]);
            const bf16x8 kf0 = mk8(ki[0][0], ki[0][1], ki[0][2], ki[0][3]), kf1 = mk8(ki[1][0], ki[1][1], ki[1][2], ki[1][3]);
            pacc[0] = MFMA16(kf0, qf0, pacc[0]);
            pacc[1] = MFMA16(kf0, qf1, pacc[1]);
            pacc[2] = MFMA16(kf1, qf1, pacc[2]);
#pragma unroll
            for (int ti = 0; ti < 2; ++ti)
#pragma unroll
                for (int h2 = 0; h2 < 2; ++h2) {
                    const int lp = (2 * (g & 1) + h2) * 16 + r;
                    v2u d; d.x = qd[ti][2 * h2]; d.y = qd[ti][2 * h2 + 1];
                    *(GAS v2u*)(rec + R1_QD + ((ti * 16 + s) * 64 + lp) * 16 + (g >> 1) * 8) = d;
                }
#pragma unroll
            for (int ti = 0; ti < 2; ++ti)
#pragma unroll
                for (int e = 0; e < 8; ++e) {
                    const unsigned wd = kd[ti][e >> 1]; const unsigned short hv = (e & 1) ? (unsigned short)(wd >> 16) : (unsigned short)(wd & 0xffffu);
                    *(LAS unsigned short*)(T + (32 * si + 8 * g + e) * 64 + (16 * ti + r) * 2) = hv;
                }
            if (r == 0) { *(GAS f32x4*)(rec + R1_GL + (32 * s + 8 * g) * 4) = (f32x4){gl[0], gl[1], gl[2], gl[3]}; *(GAS f32x4*)(rec + R1_GL + (32 * s + 8 * g + 4) * 4) = (f32x4){gl[4], gl[5], gl[6], gl[7]}; }
        }
#pragma unroll
        for (int t = 0; t < 3; ++t) Pp[(w * 3 + t) * 64 + lane] = pacc[t];
        if (USE_L1_SEQ2) {
#pragma unroll
            for (int i2 = 0; i2 < 8; ++i2) { const int q = lane + 64 * i2, tk = q >> 4, c16 = q & 15; const v4u d = vraw[i2];
                *(LAS v2u*)(Tv + tk * 264 + c16 * 16) = (v2u){d.x, d.y}; *(LAS v2u*)(Tv + tk * 264 + c16 * 16 + 8) = (v2u){d.z, d.w}; }
        }
        LDS_WAIT(); asm volatile("" ::: "memory");
        if (USE_L1_SEQ2) {
#pragma unroll
            for (int sl = 0; sl < 8; ++sl) { unsigned short hv[8];
#pragma unroll
                for (int e = 0; e < 8; ++e) hv[e] = *(const LAS unsigned short*)(Tv + (8 * g + e) * 264 + (16 * sl + r) * 2);
                v4u d; d.x = hv[0] | ((unsigned)hv[1] << 16); d.y = hv[2] | ((unsigned)hv[3] << 16); d.z = hv[4] | ((unsigned)hv[5] << 16); d.w = hv[6] | ((unsigned)hv[7] << 16);
                *(GAS v4u*)(VF1 + ((size_t)it * 64 + 8 * w + sl) * 1024 + lane * 16) = d; }
        }
#pragma unroll
        for (int ml = 0; ml < 4; ++ml) { const v4u d = *(const LAS v4u*)(T + (16 * ml + r) * 64 + 16 * g); *(GAS v4u*)(rec + R1_KD + ((4 * w + ml) * 64 + lane) * 16) = d; }
        __syncthreads();
        if (w < 4) {
            const int tj = (w == 2 || w == 3) ? 1 : 0, ti = (w == 1 || w == 2) ? 1 : 0;
            f32x4 sum = (f32x4){0.f, 0.f, 0.f, 0.f};
            if (w < 3) {
#pragma unroll
                for (int ww = 0; ww < 8; ++ww) sum += Pp[(ww * 3 + w) * 64 + lane];
            }
            float pv[4] = {sum.x, sum.y, sum.z, sum.w};
#pragma unroll
            for (int jj = 0; jj < 4; ++jj) { const int j = 16 * tj + 4 * g + jj, i = 16 * ti + r; if (j > i) pv[jj] = 0.f; }
            const int lp = (2 * tj + (g >> 1)) * 16 + r;
            v2u d; d.x = cvtpk(pv[0], pv[1]); d.y = cvtpk(pv[2], pv[3]);
            *(GAS v2u*)(rec + R1_P + (ti * 64 + lp) * 16 + 8 * (g & 1)) = d;
        }
        __syncthreads();
    }
}

template <int VAR> DI_ void l1_seq(Frame& F, const unsigned char* REC1, const unsigned char* VF1, float* O1, float* SS) {
    const int lane = F.lane, w = F.wave, r = lane & 15, g = lane >> 4;
    for (int u = F.vcu; u < NB * GL_H * 8; u += F.G) {
        const int bh = u >> 3, ds = u & 7, b = bh >> 3, h = bh & 7;
        f32x4 acc[32];
#pragma unroll
        for (int m = 0; m < 32; ++m) acc[m] = (f32x4){0.f, 0.f, 0.f, 0.f};
#define L1_DMA(c_) do { const unsigned char* rs_ = REC1 + (size_t)(bh * NCH + (c_)) * R1_SH; LAS unsigned char* st_ = F.lds + ((c_) & 1) * ST1; \
        for (int p_ = w; p_ < 76; p_ += 8) { const unsigned char* src_; \
            if (p_ < 68) src_ = rs_ + p_ * 1024 + lane * 16; \
            else { const int tk_ = 4 * (p_ - 68) + (lane >> 4);         \
                   src_ = ((c_) == 0 && tk_ < 16) ? (const unsigned char*)(F.H1B + (size_t)MR * D) + (lane & 15) * 16 \
                        : (const unsigned char*)(F.QFIZ + (size_t)row_of(b, (c_), tk_) * N1 + 8192 + h * 1024 + ds * 128) + (lane & 15) * 16; } \
            __builtin_amdgcn_global_load_lds((const unsigned*)src_, (LAS unsigned*)(st_ + p_ * 1024), 16, 0, 0); } } while (0)
        const int ycol = h * 1024 + ds * 128 + 16 * w + 4 * g;
        const f32x4 ng4 = *(const GAS f32x4*)(F.ng1 + ycol);
        const bf16* xz = F.QFIZ + (size_t)(b * SEQ - 32) * N1 + 16384 + ycol;
        v2u zc0 = (v2u){0u, 0u}, zc1 = zc0, zn0 = zc0, zn1 = zc0;
        if (VAR != 1) L1_DMA(0);
        for (int c = 0; c < NCH; ++c) {
            asm volatile("s_waitcnt vmcnt(0) lgkmcnt(0)" ::: "memory");
            __builtin_amdgcn_s_barrier();
            asm volatile("" ::: "memory");
            if (VAR != 1 && c + 1 < NCH) L1_DMA(c + 1);
            if (USE_FUSED_NORM && VAR == 0 && c >= 2 && w == 0 && lane < 32) {
                const LAS float* pp = (const LAS float*)(F.lds + SSP_OFF) + ((c - 1) & 1) * 256 + lane; float sm = 0.f;
#pragma unroll
                for (int ww = 0; ww < 8; ++ww) sm += pp[ww * 32];
                SS[(size_t)(b * SEQ + 32 * (c - 2) + lane) * 64 + h * 8 + ds] = sm; }
            if (USE_FUSED_NORM && c + 1 < NCH) { const bf16* zp = xz + (size_t)((c + 1) * 32 + r) * N1; zn0 = *(const GAS v2u*)zp; zn1 = *(const GAS v2u*)(zp + (size_t)16 * N1); }
            if (VAR == 2) continue;
            const LAS unsigned char* st = F.lds + (c & 1) * ST1;
            unsigned short vh[8];
#pragma unroll
            for (int e = 0; e < 8; ++e) vh[e] = *(const LAS unsigned short*)(st + R1_SH + (8 * g + e) * 256 + (16 * w + r) * 2);
            const bf16x8 vf = mk8(vh[0] | ((unsigned)vh[1] << 16), vh[2] | ((unsigned)vh[3] << 16), vh[4] | ((unsigned)vh[5] << 16), vh[6] | ((unsigned)vh[7] << 16));
#define SCHED_FENCE() __builtin_amdgcn_sched_barrier(0)
            if (c > 0) {
                f32x4 o0 = (f32x4){0.f, 0.f, 0.f, 0.f}, o1 = o0;
                bf16x8 qb[2][4];
#define LDQ(buf_, gi_) do { _Pragma("unroll") for (int sl_ = 0; sl_ < 2; ++sl_) { qb[buf_][sl_] = *(const LAS bf16x8*)(st + R1_QD + (2 * (gi_) + sl_) * 1024 + lane * 16); \
                    qb[buf_][2 + sl_] = *(const LAS bf16x8*)(st + R1_QD + (16 + 2 * (gi_) + sl_) * 1024 + lane * 16); } } while (0)
                const bf16x8 p0 = *(const LAS bf16x8*)(st + R1_P + lane * 16), p1 = *(const LAS bf16x8*)(st + R1_P + 1024 + lane * 16);
                LDQ(0, 0);
                SCHED_FENCE();
                o0 = MFMA16(vf, p0, o0); o1 = MFMA16(vf, p1, o1);
#pragma unroll
                for (int gi = 0; gi < 8; ++gi) {
                    if (gi < 7) LDQ((gi + 1) & 1, gi + 1);
                    SCHED_FENCE();
#pragma unroll
                    for (int sl = 0; sl < 2; ++sl) { const int s2 = 2 * gi + sl;
                        const bf16x8 sb = mk8(cvtpk(acc[2 * s2].x, acc[2 * s2].y), cvtpk(acc[2 * s2].z, acc[2 * s2].w), cvtpk(acc[2 * s2 + 1].x, acc[2 * s2 + 1].y), cvtpk(acc[2 * s2 + 1].z, acc[2 * s2 + 1].w));
                        o0 = MFMA16(sb, qb[gi & 1][sl], o0); o1 = MFMA16(sb, qb[gi & 1][2 + sl], o1); }
                    SCHED_FENCE();
                }
#undef LDQ
                if (VAR == 1) { asm volatile("" :: "v"(o0), "v"(o1)); } else if (USE_FUSED_NORM) {
                    float t0 = (o0.x * o0.x + o0.y * o0.y) + (o0.z * o0.z + o0.w * o0.w), t1 = (o1.x * o1.x + o1.y * o1.y) + (o1.z * o1.z + o1.w * o1.w);
                    t0 += __shfl_xor(t0, 16); t1 += __shfl_xor(t1, 16); t0 += __shfl_xor(t0, 32); t1 += __shfl_xor(t1, 32);
                    const int row0 = b * SEQ + 32 * (c - 1) + r;
                    if (g == 0) { LAS float* pp = (LAS float*)(F.lds + SSP_OFF) + ((c & 1) * 8 + w) * 32; pp[r] = t0; pp[16 + r] = t1; }
                    const float y0 = o0.x * ng4.x * silu(bflo(zc0.x)), y1 = o0.y * ng4.y * silu(bfhi(zc0.x)), y2 = o0.z * ng4.z * silu(bflo(zc0.y)), y3 = o0.w * ng4.w * silu(bfhi(zc0.y));
                    const float y4 = o1.x * ng4.x * silu(bflo(zc1.x)), y5 = o1.y * ng4.y * silu(bfhi(zc1.x)), y6 = o1.z * ng4.z * silu(bflo(zc1.y)), y7 = o1.w * ng4.w * silu(bfhi(zc1.y));
                    bf16* op = F.Y + (size_t)row0 * DI + ycol;
                    *(GAS v2u*)op = (v2u){cvtpk(y0, y1), cvtpk(y2, y3)}; *(GAS v2u*)(op + (size_t)16 * DI) = (v2u){cvtpk(y4, y5), cvtpk(y6, y7)};
                } else {
                    bf16* op = (bf16*)O1 + (size_t)(b * SEQ + 32 * (c - 1) + r) * DI + h * 1024 + ds * 128 + 16 * w + 4 * g;
                    *(GAS v2u*)op = (v2u){pk2(o0.x, o0.y), pk2(o0.z, o0.w)}; *(GAS v2u*)(op + (size_t)16 * DI) = (v2u){pk2(o1.x, o1.y), pk2(o1.z, o1.w)}; }
            }
            {
                f32x4 ug[2][4]; bf16x8 uk[2][4];
#define LDU(buf_, gi_) do { _Pragma("unroll") for (int ml_ = 0; ml_ < 4; ++ml_) { const int m_ = 4 * (gi_) + ml_; ug[buf_][ml_] = *(const LAS f32x4*)(st + R1_GL + (16 * m_ + 4 * g) * 4); \
                    uk[buf_][ml_] = *(const LAS bf16x8*)(st + R1_KD + m_ * 1024 + lane * 16); } } while (0)
                LDU(0, 0);
                SCHED_FENCE();
#pragma unroll
                for (int gi = 0; gi < 8; ++gi) {
                    if (gi < 7) LDU((gi + 1) & 1, gi + 1);
                    SCHED_FENCE();
#pragma unroll
                    for (int ml = 0; ml < 4; ++ml) { const int m = 4 * gi + ml; acc[m] = MFMA16(uk[gi & 1][ml], vf, acc[m] * ug[gi & 1][ml]); }
                    SCHED_FENCE();
                }
#undef LDU
            }
            if (USE_FUSED_NORM) { zc0 = zn0; zc1 = zn1; }
        }
#undef L1_DMA
        if (VAR == 1) { _Pragma("unroll") for (int m = 0; m < 32; ++m) asm volatile("" :: "v"(acc[m])); }
        asm volatile("s_waitcnt vmcnt(0) lgkmcnt(0)" ::: "memory");
        __builtin_amdgcn_s_barrier();
        if (USE_FUSED_NORM && VAR == 0 && w == 0 && lane < 32) {
            const LAS float* pp = (const LAS float*)(F.lds + SSP_OFF) + ((NCH - 1) & 1) * 256 + lane; float sm = 0.f;
#pragma unroll
            for (int ww = 0; ww < 8; ++ww) sm += pp[ww * 32];
            SS[(size_t)(b * SEQ + 32 * (NCH - 2) + lane) * 64 + h * 8 + ds] = sm; }
        asm volatile("s_waitcnt vmcnt(0) lgkmcnt(0)" ::: "memory");
    }
}

constexpr int R2_QD = 0, R2_KD = 32768, R2_P = 65536, R2_GL = 67584, ST2 = 69632, X2_OFF = 2 * ST2;
DI_ void l1_seq2(Frame& F, const unsigned char* REC1, const unsigned char* VF1, float* SS) {
    const int lane = F.lane, w = F.wave, r = lane & 15, g = lane >> 4, dkh = w >> 2, dvq = w & 3;
    for (int u = F.vcu; u < NB * GL_H * 8; u += F.G) {
        const int bh = u >> 3, ds = u & 7, b = bh >> 3, h = bh & 7;
        f32x4 acc[16][2];
#pragma unroll
        for (int m = 0; m < 16; ++m) { acc[m][0] = (f32x4){0.f, 0.f, 0.f, 0.f}; acc[m][1] = acc[m][0]; }
        const int ycol = h * 1024 + ds * 128 + 32 * dvq + 16 * dkh + 4 * g;
        const f32x4 ng4 = *(const GAS f32x4*)(F.ng1 + ycol);
        const bf16* xz = F.QFIZ + (size_t)(b * SEQ - 32) * N1 + 16384 + ycol;
        const unsigned char* vfb = VF1 + ((size_t)bh * NCH * 64 + ds * 8 + 2 * dvq) * 1024 + lane * 16;
#define L2_DMA(c_) do { const unsigned char* rs_ = REC1 + (size_t)(bh * NCH + (c_)) * R1_SH; LAS unsigned char* st_ = F.lds + ((c_) & 1) * ST2; \
        _Pragma("unroll") for (int i_ = 0; i_ < 8; ++i_) { const int p_ = w + 8 * i_; __builtin_amdgcn_global_load_lds((const unsigned*)(rs_ + p_ * 1024 + lane * 16), (LAS unsigned*)(st_ + p_ * 1024), 16, 0, 0); } \
        if (w < 4) __builtin_amdgcn_global_load_lds((const unsigned*)(rs_ + (w + 64) * 1024 + lane * 16), (LAS unsigned*)(st_ + (w + 64) * 1024), 16, 0, 0); } while (0)
        v4u vfr[2][2];
        v2u zr[2][2];
        f32x4 keep[2][2];
        vfr[0][0] = *(const GAS v4u*)(vfb); vfr[0][1] = *(const GAS v4u*)(vfb + 1024);
        zr[0][0] = (v2u){0u, 0u}; zr[0][1] = zr[0][0];
        L2_DMA(0);
#define L2_BODY(C_, PAR) do { const int c = (C_); \
            asm volatile("s_waitcnt vmcnt(0) lgkmcnt(0)" ::: "memory"); \
            __builtin_amdgcn_s_barrier(); \
            asm volatile("" ::: "memory"); \
            if (c >= 3 && c <= NCH + 1 && w == 0 && lane < 32) {                  \
                const LAS float* pp = (const LAS float*)(F.lds + SSP_OFF) + PAR * 256 + lane; float sm = 0.f; \
                _Pragma("unroll") for (int ww = 0; ww < 8; ++ww) sm += pp[ww * 32]; \
                SS[(size_t)(b * SEQ + 32 * (c - 3) + lane) * 64 + h * 8 + ds] = sm; } \
            if (c >= 2 && c <= NCH) {                                  \
                const v4u px = *(const LAS v4u*)(F.lds + X2_OFF + (PAR ^ 1) * 8192 + (w ^ 4) * 1024 + lane * 16); \
                const f32x4 a0 = keep[PAR ^ 1][0] + (f32x4){bflo(px.x), bfhi(px.x), bflo(px.y), bfhi(px.y)}, a1 = keep[PAR ^ 1][1] + (f32x4){bflo(px.z), bfhi(px.z), bflo(px.w), bfhi(px.w)}; \
                float t0 = (a0.x * a0.x + a0.y * a0.y) + (a0.z * a0.z + a0.w * a0.w), t1 = (a1.x * a1.x + a1.y * a1.y) + (a1.z * a1.z + a1.w * a1.w); \
                t0 += __shfl_xor(t0, 16); t1 += __shfl_xor(t1, 16); t0 += __shfl_xor(t0, 32); t1 += __shfl_xor(t1, 32); \
                if (g == 0) { LAS float* pp = (LAS float*)(F.lds + SSP_OFF) + ((PAR ^ 1) * 8 + w) * 32; pp[r] = t0; pp[16 + r] = t1; } \
                const v2u z0 = zr[PAR ^ 1][0], z1 = zr[PAR ^ 1][1]; \
                bf16* op = F.Y + (size_t)(b * SEQ + 32 * (c - 2) + r) * DI + ycol; \
                *(GAS v2u*)op = (v2u){cvtpk(a0.x * ng4.x * silu(bflo(z0.x)), a0.y * ng4.y * silu(bfhi(z0.x))), cvtpk(a0.z * ng4.z * silu(bflo(z0.y)), a0.w * ng4.w * silu(bfhi(z0.y)))}; \
                *(GAS v2u*)(op + (size_t)16 * DI) = (v2u){cvtpk(a1.x * ng4.x * silu(bflo(z1.x)), a1.y * ng4.y * silu(bfhi(z1.x))), cvtpk(a1.z * ng4.z * silu(bflo(z1.y)), a1.w * ng4.w * silu(bfhi(z1.y)))}; } \
            if (c + 1 < NCH) {                                         \
                vfr[PAR ^ 1][0] = *(const GAS v4u*)(vfb + (size_t)(c + 1) * 65536); vfr[PAR ^ 1][1] = *(const GAS v4u*)(vfb + (size_t)(c + 1) * 65536 + 1024); \
                { const bf16* zp = xz + (size_t)((c + 1) * 32 + r) * N1; zr[PAR ^ 1][0] = *(const GAS v2u*)zp; zr[PAR ^ 1][1] = *(const GAS v2u*)(zp + (size_t)16 * N1); } \
                L2_DMA(c + 1); } \
            if (c < NCH) { \
                const LAS unsigned char* st = F.lds + (c & 1) * ST2; \
                bf16x8 vf[2]; vf[0] = __builtin_bit_cast(bf16x8, vfr[PAR][0]); vf[1] = __builtin_bit_cast(bf16x8, vfr[PAR][1]); \
                const LAS f32x4* glp = (const LAS f32x4*)(st + R2_GL + (256 * dkh + 4 * g) * 4); \
                f32x4 ug[2][2]; bf16x8 uk[2][2]; \
                if (c > 0) { \
                    f32x4 o[2][2]; \
                    _Pragma("unroll") for (int ti = 0; ti < 2; ++ti) { o[ti][0] = (f32x4){0.f, 0.f, 0.f, 0.f}; o[ti][1] = o[ti][0]; } \
                    if (dkh == 0) { const bf16x8 p0 = *(const LAS bf16x8*)(st + R2_P + lane * 16), p1 = *(const LAS bf16x8*)(st + R2_P + 1024 + lane * 16); \
                        o[0][0] = MFMA16(vf[0], p0, o[0][0]); o[0][1] = MFMA16(vf[1], p0, o[0][1]); o[1][0] = MFMA16(vf[0], p1, o[1][0]); o[1][1] = MFMA16(vf[1], p1, o[1][1]); } \
                    bf16x8 qb[2][2]; \
                    qb[0][0] = *(const LAS bf16x8*)(st + R2_QD + (8 * dkh) * 1024 + lane * 16); qb[0][1] = *(const LAS bf16x8*)(st + R2_QD + (16 + 8 * dkh) * 1024 + lane * 16); \
                    SCHED_FENCE(); \
                    _Pragma("unroll") for (int s2 = 0; s2 < 8; ++s2) { \
                        if (s2 < 7) { qb[(s2 + 1) & 1][0] = *(const LAS bf16x8*)(st + R2_QD + (8 * dkh + s2 + 1) * 1024 + lane * 16); qb[(s2 + 1) & 1][1] = *(const LAS bf16x8*)(st + R2_QD + (16 + 8 * dkh + s2 + 1) * 1024 + lane * 16); } \
                        SCHED_FENCE(); \
                        _Pragma("unroll") for (int t_ = 0; t_ < 2; ++t_) { \
                            const bf16x8 sb = mk8(cvtpk(acc[2 * s2][t_].x, acc[2 * s2][t_].y), cvtpk(acc[2 * s2][t_].z, acc[2 * s2][t_].w), cvtpk(acc[2 * s2 + 1][t_].x, acc[2 * s2 + 1][t_].y), cvtpk(acc[2 * s2 + 1][t_].z, acc[2 * s2 + 1][t_].w)); \
                            o[0][t_] = MFMA16(sb, qb[s2 & 1][0], o[0][t_]); o[1][t_] = MFMA16(sb, qb[s2 & 1][1], o[1][t_]); } \
                        SCHED_FENCE(); \
                    } \
                    { const f32x4 s0 = o[0][dkh ^ 1], s1 = o[1][dkh ^ 1];                    \
                      *(LAS v4u*)(F.lds + X2_OFF + PAR * 8192 + w * 1024 + lane * 16) = (v4u){pk2(s0.x, s0.y), pk2(s0.z, s0.w), pk2(s1.x, s1.y), pk2(s1.z, s1.w)}; \
                      keep[PAR][0] = o[0][dkh]; keep[PAR][1] = o[1][dkh]; } \
                } \
                _Pragma("unroll") for (int ml_ = 0; ml_ < 2; ++ml_) { ug[0][ml_] = glp[4 * ml_]; uk[0][ml_] = *(const LAS bf16x8*)(st + R2_KD + (16 * dkh + ml_) * 1024 + lane * 16); } \
                SCHED_FENCE(); \
                _Pragma("unroll") for (int gi = 0; gi < 8; ++gi) { \
                    if (gi < 7) { _Pragma("unroll") for (int ml_ = 0; ml_ < 2; ++ml_) { const int m_ = 2 * (gi + 1) + ml_; ug[(gi + 1) & 1][ml_] = glp[4 * m_]; uk[(gi + 1) & 1][ml_] = *(const LAS bf16x8*)(st + R2_KD + (16 * dkh + m_) * 1024 + lane * 16); } } \
                    SCHED_FENCE(); \
                    _Pragma("unroll") for (int ml = 0; ml < 2; ++ml) { const int m = 2 * gi + ml; \
                        acc[m][0] = MFMA16(uk[gi & 1][ml], vf[0], acc[m][0] * ug[gi & 1][ml]); acc[m][1] = MFMA16(uk[gi & 1][ml], vf[1], acc[m][1] * ug[gi & 1][ml]); } \
                    SCHED_FENCE(); \
                } \
            } \
            asm volatile("" : "+v"(vfr[PAR ^ 1][0]), "+v"(vfr[PAR ^ 1][1]), "+v"(zr[PAR ^ 1][0]), "+v"(zr[PAR ^ 1][1]));        \
        } while (0)
        for (int c2 = 0; c2 <= NCH + 1; c2 += 2) { L2_BODY(c2, 0); L2_BODY(c2 + 1, 1); }
#undef L2_BODY
#undef L2_DMA
        asm volatile("s_waitcnt vmcnt(0) lgkmcnt(0)" ::: "memory");
        __builtin_amdgcn_s_barrier();
    }
}

DI_ void l0_prep(Frame& F, unsigned char* REC0) {
    const int lane = F.lane, w = F.wave, r = lane & 15, g = lane >> 4;
    LAS unsigned char* T = F.lds + w * 16640;
    LAS unsigned char* Tv = T + 8192;
    const int gw = F.vcu * NWAVES + w, NGW = F.G * NWAVES;
    for (int it = gw; it < NB * HG_H * NCH; it += NGW) {
        const int bh = it / NCH, c = it - bh * NCH, b = bh >> 6, h = bh & 63;
        unsigned char* rec = REC0 + (size_t)it * R0_SZ;
        int row[2]; bool nul[2];
#pragma unroll
        for (int ti = 0; ti < 2; ++ti) { const int tok = 16 * ti + r; nul[ti] = (c == 0 && tok < 16); row[ti] = nul[ti] ? 0 : row_of(b, c, tok); }
        f32x4 pacc[3];
#pragma unroll
        for (int t = 0; t < 3; ++t) pacc[t] = (f32x4){0.f, 0.f, 0.f, 0.f};
        v4u qraw[4][2], fraw[4][2], vraw[8];
#pragma unroll
        for (int s = 0; s < 4; ++s)
#pragma unroll
            for (int ti = 0; ti < 2; ++ti) { const bf16* rp = F.QFIZ + (size_t)row[ti] * N0 + h * 128 + 32 * s + 8 * g; qraw[s][ti] = *(const GAS v4u*)rp; fraw[s][ti] = *(const GAS v4u*)(rp + DI); }
#pragma unroll
        for (int i = 0; i < 8; ++i) { const int q = lane + 64 * i, tk = q >> 4, c16 = q & 15; const bool nl = (c == 0 && tk < 16);
            vraw[i] = (v4u){0u, 0u, 0u, 0u}; if (!nl) vraw[i] = *(const GAS v4u*)(F.QFIZ + (size_t)row_of(b, c, tk) * N0 + 2 * DI + h * 128 + 8 * c16); }
        asm volatile("" ::: "memory");
#pragma unroll
        for (int s = 0; s < 4; ++s) {
            const int col = h * 128 + 32 * s + 8 * g;
            float lbv[8], bfv[8];
            { const f32x4 a0 = *(const GAS f32x4*)(F.LB0 + col), a1 = *(const GAS f32x4*)(F.LB0 + col + 4), c0 = *(const GAS f32x4*)(F.b_f + col), c1 = *(const GAS f32x4*)(F.b_f + col + 4);
              lbv[0] = a0.x; lbv[1] = a0.y; lbv[2] = a0.z; lbv[3] = a0.w; lbv[4] = a1.x; lbv[5] = a1.y; lbv[6] = a1.z; lbv[7] = a1.w;
              bfv[0] = c0.x; bfv[1] = c0.y; bfv[2] = c0.z; bfv[3] = c0.w; bfv[4] = c1.x; bfv[5] = c1.y; bfv[6] = c1.z; bfv[7] = c1.w; }
            float qv[2][8], fv[2][8];
#pragma unroll
            for (int ti = 0; ti < 2; ++ti) {
                const v4u q4 = qraw[s][ti], f4 = fraw[s][ti];
                qv[ti][0] = bflo(q4.x); qv[ti][1] = bfhi(q4.x); qv[ti][2] = bflo(q4.y); qv[ti][3] = bfhi(q4.y); qv[ti][4] = bflo(q4.z); qv[ti][5] = bfhi(q4.z); qv[ti][6] = bflo(q4.w); qv[ti][7] = bfhi(q4.w);
                fv[ti][0] = bflo(f4.x); fv[ti][1] = bfhi(f4.x); fv[ti][2] = bflo(f4.y); fv[ti][3] = bfhi(f4.y); fv[ti][4] = bflo(f4.z); fv[ti][5] = bfhi(f4.z); fv[ti][6] = bflo(f4.w); fv[ti][7] = bfhi(f4.w);
            }
            unsigned qd[2][4], ki[2][4], kd[2][4]; float gl[8];
#pragma unroll
            for (int e = 0; e < 8; e += 2) {
                float bb[2][2], BB[2], kk[2][2];
#pragma unroll
                for (int u = 0; u < 2; ++u) {
                    const float fg0 = lbv[e + u] + (1.f - lbv[e + u]) * sigm(fv[0][e + u] + bfv[e + u]);
                    const float fg1 = lbv[e + u] + (1.f - lbv[e + u]) * sigm(fv[1][e + u] + bfv[e + u]);
                    const float L0 = nul[0] ? 0.f : lg2(fg0), L1 = nul[1] ? 0.f : lg2(fg1);
                    kk[0][u] = nul[0] ? 0.f : 1.f - fg0; kk[1][u] = nul[1] ? 0.f : 1.f - fg1;
                    const float b0 = scan16(L0);
                    const float b1 = scan16(L1) + bcast15(b0);
                    bb[0][u] = b0; bb[1][u] = b1; BB[u] = bcast15(b1);
                    gl[e + u] = ex2(BB[u]);
                }
#pragma unroll
                for (int ti = 0; ti < 2; ++ti) {
                    const float q0 = nul[ti] ? 0.f : silu(qv[ti][e]), q1 = nul[ti] ? 0.f : silu(qv[ti][e + 1]);
                    qd[ti][e >> 1] = cvtpk(q0 * ex2(bb[ti][0]), q1 * ex2(bb[ti][1]));
                    ki[ti][e >> 1] = cvtpk(kk[ti][0] * ex2(-bb[ti][0]), kk[ti][1] * ex2(-bb[ti][1]));
                    kd[ti][e >> 1] = cvtpk(kk[ti][0] * ex2(BB[0] - bb[ti][0]), kk[ti][1] * ex2(BB[1] - bb[ti][1]));
                }
            }
            const bf16x8 qf0 = mk8(qd[0][0], qd[0][1], qd[0][2], qd[0][3]), qf1 = mk8(qd[1][0], qd[1][1], qd[1][2], qd[1][3]);
            const bf16x8 kf0 = mk8(ki[0][0], ki[0][1], ki[0][2], ki[0][3]), kf1 = mk8(ki[1][0], ki[1][1], ki[1][2], ki[1][3]);
            pacc[0] = MFMA16(kf0, qf0, pacc[0]);
            pacc[1] = MFMA16(kf0, qf1, pacc[1]);
            pacc[2] = MFMA16(kf1, qf1, pacc[2]);
#pragma unroll
            for (int ti = 0; ti < 2; ++ti)
#pragma unroll
                for (int h2 = 0; h2 < 2; ++h2) {
                    const int lp = (2 * (g & 1) + h2) * 16 + r;
                    v2u d; d.x = qd[ti][2 * h2]; d.y = qd[ti][2 * h2 + 1];
                    *(GAS v2u*)(rec + R0_QD + ((ti * 4 + s) * 64 + lp) * 16 + (g >> 1) * 8) = d;
                }
#pragma unroll
            for (int ti = 0; ti < 2; ++ti)
#pragma unroll
                for (int e = 0; e < 8; ++e) {
                    const unsigned wd = kd[ti][e >> 1]; const unsigned short hv = (e & 1) ? (unsigned short)(wd >> 16) : (unsigned short)(wd & 0xffffu);
                    *(LAS unsigned short*)(T + (32 * s + 8 * g + e) * 64 + (16 * ti + r) * 2) = hv;
                }
            if (r == 0) { *(GAS f32x4*)(rec + R0_GL + (32 * s + 8 * g) * 4) = (f32x4){gl[0], gl[1], gl[2], gl[3]}; *(GAS f32x4*)(rec + R0_GL + (32 * s + 8 * g + 4) * 4) = (f32x4){gl[4], gl[5], gl[6], gl[7]}; }
        }
#pragma unroll
        for (int t = 0; t < 4; ++t) {
            const int tj = (t >= 2) ? 1 : 0, ti = (t == 1 || t == 2) ? 1 : 0;
            float pv[4] = {0.f, 0.f, 0.f, 0.f};
            if (t < 3) { pv[0] = pacc[t].x; pv[1] = pacc[t].y; pv[2] = pacc[t].z; pv[3] = pacc[t].w; }
#pragma unroll
            for (int jj = 0; jj < 4; ++jj) { const int j = 16 * tj + 4 * g + jj, i = 16 * ti + r; if (j > i) pv[jj] = 0.f; }
            const int lp = (2 * tj + (g >> 1)) * 16 + r;
            v2u d; d.x = cvtpk(pv[0], pv[1]); d.y = cvtpk(pv[2], pv[3]);
            *(GAS v2u*)(rec + R0_P + (ti * 64 + lp) * 16 + 8 * (g & 1)) = d;
        }
#pragma unroll
        for (int i = 0; i < 8; ++i) {
            const int q = lane + 64 * i, tk = q >> 4, c16 = q & 15; const v4u d = vraw[i];
            *(LAS v2u*)(Tv + tk * 264 + c16 * 16) = (v2u){d.x, d.y}; *(LAS v2u*)(Tv + tk * 264 + c16 * 16 + 8) = (v2u){d.z, d.w};
        }
        LDS_WAIT(); asm volatile("" ::: "memory");
#pragma unroll
        for (int mt = 0; mt < 8; ++mt) { const v4u d = *(const LAS v4u*)(T + (16 * mt + r) * 64 + 16 * g); *(GAS v4u*)(rec + R0_KD + (mt * 64 + lane) * 16) = d; }
#pragma unroll
        for (int sl = 0; sl < 8; ++sl) {
            unsigned short hv[8];
#pragma unroll
            for (int e = 0; e < 8; ++e) hv[e] = *(const LAS unsigned short*)(Tv + (8 * g + e) * 264 + (16 * sl + r) * 2);
            v4u d; d.x = hv[0] | ((unsigned)hv[1] << 16); d.y = hv[2] | ((unsigned)hv[3] << 16); d.z = hv[4] | ((unsigned)hv[5] << 16); d.w = hv[6] | ((unsigned)hv[7] << 16);
            *(GAS v4u*)(rec + R0_V + (sl * 64 + lane) * 16) = d;
        }
        LDS_WAIT(); asm volatile("" ::: "memory");
    }
}

DI_ void l0_seq(Frame& F, const unsigned char* REC0) {
    const int lane = F.lane, w = F.wave, r = lane & 15, g = lane >> 4;
    LAS float* obuf = (LAS float*)(F.lds + 2 * ST0);
    constexpr int OB = 32 * 132;
    for (int u = F.vcu; u < NB * HG_H; u += F.G) {
        const int bh = u, b = bh >> 6, h = bh & 63;
        f32x4 acc[8];
#pragma unroll
        for (int m = 0; m < 8; ++m) acc[m] = (f32x4){0.f, 0.f, 0.f, 0.f};
        const int ntok = 4 * w + g, ndv = 8 * r;
        float ngv[8];
        { const f32x4 a0 = *(const GAS f32x4*)(F.ng0 + h * 128 + ndv), a1 = *(const GAS f32x4*)(F.ng0 + h * 128 + ndv + 4);
          ngv[0] = a0.x; ngv[1] = a0.y; ngv[2] = a0.z; ngv[3] = a0.w; ngv[4] = a1.x; ngv[5] = a1.y; ngv[6] = a1.z; ngv[7] = a1.w; }
#define L0_DMA(c_) do { const unsigned char* rs_ = REC0 + (size_t)(bh * NCH + (c_)) * R0_SZ; LAS unsigned char* st_ = F.lds + ((c_) & 1) * ST0; \
        for (int p_ = w; p_ < 27; p_ += 8) __builtin_amdgcn_global_load_lds((const unsigned*)(rs_ + p_ * 1024 + lane * 16), (LAS unsigned*)(st_ + p_ * 1024), 16, 0, 0); } while (0)
        L0_DMA(0);
        v4u zprev = (v4u){0u, 0u, 0u, 0u};
        for (int c = 0; c <= NCH; ++c) {
            asm volatile("s_waitcnt vmcnt(0)" ::: "memory");
            __builtin_amdgcn_s_barrier();
            asm volatile("" ::: "memory");
            if (c + 1 < NCH) L0_DMA(c + 1);
            v4u zcur = (v4u){0u, 0u, 0u, 0u};
            const bool zvalid = (c < NCH) && !(c == 0 && ntok < 16);
            if (zvalid) zcur = *(const GAS v4u*)(F.QFIZ + (size_t)row_of(b, c, ntok) * N0 + 3 * DI + h * 128 + ndv);
            if (c >= 1) {
                const int cp = c - 1;
                const LAS float* ob = obuf + (cp & 1) * OB + ntok * 132 + ndv;
                const f32x4 x0 = *(const LAS f32x4*)(ob), x1 = *(const LAS f32x4*)(ob + 4);
                float ss = (x0.x * x0.x + x0.y * x0.y) + (x0.z * x0.z + x0.w * x0.w) + (x1.x * x1.x + x1.y * x1.y) + (x1.z * x1.z + x1.w * x1.w);
                ss += __shfl_xor(ss, 8); ss += __shfl_xor(ss, 4); ss += __shfl_xor(ss, 2); ss += __shfl_xor(ss, 1);
                const float rs = rsqrtf(ss * (1.f / 128.f) + RMS_EPS);
                const bool wr = !(cp == 0 && (ntok < 16 || b != 0));
                if (wr) {
                    v4u d;
                    d.x = cvtpk(x0.x * rs * ngv[0] * silu(bflo(zprev.x)), x0.y * rs * ngv[1] * silu(bfhi(zprev.x)));
                    d.y = cvtpk(x0.z * rs * ngv[2] * silu(bflo(zprev.y)), x0.w * rs * ngv[3] * silu(bfhi(zprev.y)));
                    d.z = cvtpk(x1.x * rs * ngv[4] * silu(bflo(zprev.z)), x1.y * rs * ngv[5] * silu(bfhi(zprev.z)));
                    d.w = cvtpk(x1.z * rs * ngv[6] * silu(bflo(zprev.w)), x1.w * rs * ngv[7] * silu(bfhi(zprev.w)));
                    *(GAS v4u*)(F.Y + (size_t)row_of(b, cp, ntok) * DI + h * 128 + ndv) = d;
                }
            }
            zprev = zcur;
            if (c < NCH) {
                const LAS unsigned char* st = F.lds + (c & 1) * ST0;
                const bf16x8 vf = *(const LAS bf16x8*)(st + R0_V + w * 1024 + lane * 16);
                const bf16x8 p0 = *(const LAS bf16x8*)(st + R0_P + lane * 16), p1 = *(const LAS bf16x8*)(st + R0_P + 1024 + lane * 16);
                bf16x8 qf[8], kf[8]; f32x4 gf[8];
#pragma unroll
                for (int q = 0; q < 8; ++q) qf[q] = *(const LAS bf16x8*)(st + R0_QD + q * 1024 + lane * 16);
#pragma unroll
                for (int m = 0; m < 8; ++m) { gf[m] = *(const LAS f32x4*)(st + R0_GL + (16 * m + 4 * g) * 4); kf[m] = *(const LAS bf16x8*)(st + R0_KD + m * 1024 + lane * 16); }
                SCHED_FENCE();
                f32x4 o0 = (f32x4){0.f, 0.f, 0.f, 0.f}, o1 = o0;
                o0 = MFMA16(vf, p0, o0); o1 = MFMA16(vf, p1, o1);
#pragma unroll
                for (int s2 = 0; s2 < 4; ++s2) {
                    const bf16x8 sb = mk8(cvtpk(acc[2 * s2].x, acc[2 * s2].y), cvtpk(acc[2 * s2].z, acc[2 * s2].w), cvtpk(acc[2 * s2 + 1].x, acc[2 * s2 + 1].y), cvtpk(acc[2 * s2 + 1].z, acc[2 * s2 + 1].w));
                    o0 = MFMA16(sb, qf[s2], o0); o1 = MFMA16(sb, qf[4 + s2], o1);
                }
#pragma unroll
                for (int m = 0; m < 8; ++m) acc[m] = MFMA16(kf[m], vf, acc[m] * gf[m]);
                LAS float* ow = obuf + (c & 1) * OB + r * 132 + 16 * w + 4 * g;
                *(LAS f32x4*)ow = o0; *(LAS f32x4*)(ow + 16 * 132) = o1;
                asm volatile("s_waitcnt lgkmcnt(0)" ::: "memory");
            }
        }
#undef L0_DMA
        asm volatile("s_waitcnt vmcnt(0)" ::: "memory");
        __builtin_amdgcn_s_barrier();
    }
}

template <int KS, int MODE>
DI_ void skinny(Frame& F, const bf16* A, const bf16* Bt, int K, int n_first, int n_slices, bf16* Ob, int ldo, float* Of, const float* res) {
    const int lane = F.lane, w = F.wave, r = lane & 15, g = lane >> 4;
    constexpr int SPB = 8 / KS;
    const int kw = w % KS, sw = w / KS, klen = K / KS, kbeg = kw * klen;
    LAS f32x4* red = (LAS f32x4*)F.lds;
    for (int p = F.vcu; p * SPB < n_slices; p += F.G) {
        const int sl = p * SPB + sw, n0 = n_first + 16 * sl;
        f32x4 acc = (f32x4){0.f, 0.f, 0.f, 0.f};
        if (sl < n_slices) {
            const GAS v4u* bp = (const GAS v4u*)(Bt + (size_t)(n0 + r) * K + kbeg + 16 * g);
            const GAS v4u* ap = (const GAS v4u*)(A + (size_t)r * K + kbeg + 16 * g);
            for (int kk = 0; kk < klen; kk += 256) {
                v4u bv[8], av[8];
#pragma unroll
                for (int u = 0; u < 4; ++u) { bv[2 * u] = bp[(kk + 64 * u) / 8]; bv[2 * u + 1] = bp[(kk + 64 * u) / 8 + 1]; av[2 * u] = ap[(kk + 64 * u) / 8]; av[2 * u + 1] = ap[(kk + 64 * u) / 8 + 1]; }
                asm volatile("" ::: "memory");
#pragma unroll
                for (int u = 0; u < 8; ++u) acc = MFMA16(__builtin_bit_cast(bf16x8, bv[u]), __builtin_bit_cast(bf16x8, av[u]), acc);
            }
        }
        if (KS > 1) {
            red[w * 64 + lane] = acc;
            __syncthreads();
            if (kw == 0) {
#pragma unroll
                for (int j = 1; j < KS; ++j) acc += red[(w + j) * 64 + lane];
            }
        }
        if (kw == 0 && sl < n_slices) {
            if (MODE == 0) { v2u d; d.x = pk2(acc.x, acc.y); d.y = pk2(acc.z, acc.w); *(GAS v2u*)(Ob + (size_t)r * ldo + n0 + 4 * g) = d; }
            else { const f32x4 rv = *(const GAS f32x4*)(res + (size_t)r * D + n0 + 4 * g); *(GAS f32x4*)(Of + (size_t)r * D + n0 + 4 * g) = rv * ALPHA + acc; }
        }
        if (KS > 1) __syncthreads();
    }
    asm volatile("s_waitcnt vmcnt(0)" ::: "memory");
}

DI_ void gate_proj(Frame& F, const bf16* WG1T  ) {
    const int lane = F.lane, w = F.wave, r = lane & 15, g = lane >> 4, kw = w & 3, sw = w >> 2;
    LAS f32x4* red = (LAS f32x4*)F.lds;
    for (int p = F.vcu; 2 * p < MR / 16; p += F.G) {
        const int t = 2 * p + sw;
        f32x4 acc = (f32x4){0.f, 0.f, 0.f, 0.f};
        if (t < MR / 16) {
            const GAS v4u* wp = (const GAS v4u*)(WG1T + (size_t)r * D + 1024 * kw + 16 * g);
            const GAS v4u* hp = (const GAS v4u*)(F.H1B + (size_t)(16 * t + r) * D + 1024 * kw + 16 * g);
            for (int kk = 0; kk < 1024; kk += 256) {
                v4u wv[8], hv[8];
#pragma unroll
                for (int u = 0; u < 4; ++u) { wv[2 * u] = wp[(kk + 64 * u) / 8]; wv[2 * u + 1] = wp[(kk + 64 * u) / 8 + 1]; hv[2 * u] = hp[(kk + 64 * u) / 8]; hv[2 * u + 1] = hp[(kk + 64 * u) / 8 + 1]; }
                asm volatile("" ::: "memory");
#pragma unroll
                for (int u = 0; u < 8; ++u) acc = MFMA16(__builtin_bit_cast(bf16x8, wv[u]), __builtin_bit_cast(bf16x8, hv[u]), acc);
            }
        }
        red[w * 64 + lane] = acc;
        __syncthreads();
        if (kw == 0 && t < MR / 16) {
            acc += red[(w + 1) * 64 + lane]; acc += red[(w + 2) * 64 + lane]; acc += red[(w + 3) * 64 + lane];
            *(GAS f32x4*)(F.G1 + (size_t)(16 * t + r) * GL_R + 4 * g) = acc;
        }
        __syncthreads();
    }
    asm volatile("s_waitcnt vmcnt(0)" ::: "memory");
}

#ifndef USE_AUX
#define USE_AUX 0
#endif
struct AuxT { const float* src; bf16* dst; int N, K; };
DI_ AuxT aux_decode(Frame& F, int it, unsigned char* dummy) {
    constexpr int I_1 = (DI / 64) * (D / 32), I_2 = (D / 64) * (N1 / 32), I_3 = I_1, AUX_ITERS = (I_1 + I_2 + I_3) / (256 * NWAVES);
    static_assert((I_1 + I_2 + I_3) % (256 * NWAVES) == 0, "aux tiles divide over the waves");
    const int gw = F.vcu * NWAVES + F.wave;
    AuxT t;
    if (it >= AUX_ITERS || F.G != 256) { t.src = (const float*)(dummy + (size_t)gw * 8192); t.dst = (bf16*)(dummy + 32 * MiB + (size_t)gw * 8192); t.N = 32; t.K = 64; return t; }
    int r_ = it * (256 * NWAVES) + gw; const float* W; bf16* WT; int K, N;
    if (r_ < I_1) { W = F.w0out; WT = F.WT0OUT; K = DI; N = D; }
    else if (r_ < I_1 + I_2) { r_ -= I_1; W = F.w1in; WT = F.WT1IN; K = D; N = N1; }
    else { r_ -= I_1 + I_2; W = F.w1out; WT = F.WT1OUT; K = DI; N = D; }
    const int nblk = N / 32, kb = r_ / nblk, nb = r_ - kb * nblk;
    t.src = W + (size_t)(64 * kb) * N + 32 * nb; t.dst = WT + (size_t)(32 * nb) * K + 64 * kb; t.N = N; t.K = K; return t;
}
DI_ void aux_load(Frame& F, const AuxT& t, f32x4 (&wv)[8]) {
    const int rowi = F.lane >> 3, c4 = F.lane & 7;
#pragma unroll
    for (int i = 0; i < 8; ++i) wv[i] = *(const GAS f32x4*)(t.src + (size_t)(8 * i + rowi) * t.N + 4 * c4);
}
DI_ void aux_store(Frame& F, const AuxT& t, const f32x4 (&wv)[8], LAS unsigned char* scr  ) {
    const int lane = F.lane, rowi = lane >> 3, c4 = lane & 7;
#pragma unroll
    for (int i = 0; i < 8; ++i) { LAS unsigned* p = (LAS unsigned*)(scr + (8 * i + rowi) * 68 + c4 * 8); p[0] = cvtpk(wv[i].x, wv[i].y); p[1] = cvtpk(wv[i].z, wv[i].w); }
    LDS_WAIT(); asm volatile("" ::: "memory");
    const int kc = lane & 7;
#pragma unroll
    for (int j = 0; j < 4; ++j) { const int n = (lane >> 3) + 8 * j; unsigned short hv[8];
#pragma unroll
        for (int e = 0; e < 8; ++e) hv[e] = *(const LAS unsigned short*)(scr + (8 * kc + e) * 68 + n * 2);
        v4u o; o.x = hv[0] | ((unsigned)hv[1] << 16); o.y = hv[2] | ((unsigned)hv[3] << 16); o.z = hv[4] | ((unsigned)hv[5] << 16); o.w = hv[6] | ((unsigned)hv[7] << 16);
        *(GAS v4u*)(t.dst + (size_t)n * t.K + 8 * kc) = o; }
    LDS_WAIT(); asm volatile("" ::: "memory");
}

constexpr int F0_QD = 0, F0_KI = 8192, F0_T = 16384, F0_GL = 24576, F0_TV = 25088, F0_STG = 33536;
DI_ void f0_load(const bf16* cb, const int (&oq)[2], int ov, v2u (&q2)[2], v2u (&f2)[2], v4u& vraw) {
#pragma unroll
    for (int ti = 0; ti < 2; ++ti) { q2[ti] = *(const GAS v2u*)(cb + oq[ti]); f2[ti] = *(const GAS v2u*)(cb + oq[ti] + DI); }
    vraw = *(const GAS v4u*)(cb + ov);
}
DI_ void f0_prep(Frame& F, LAS unsigned char* st, const v2u (&q2)[2], const v2u (&f2)[2], const v4u& vraw, const f32x4& lb4, const f32x4& bf4) {
    const int lane = F.lane, w = F.wave, r = lane & 15, g = lane >> 4, ps = w >> 1, hf = w & 1;
    const float lbv[4] = {lb4.x, lb4.y, lb4.z, lb4.w}, bfv[4] = {bf4.x, bf4.y, bf4.z, bf4.w};
    float Lv[2][4], qq[2][4], kk[2][4];
#pragma unroll
    for (int ti = 0; ti < 2; ++ti) {
        const float qv[4] = {bflo(q2[ti].x), bfhi(q2[ti].x), bflo(q2[ti].y), bfhi(q2[ti].y)}, fv[4] = {bflo(f2[ti].x), bfhi(f2[ti].x), bflo(f2[ti].y), bfhi(f2[ti].y)};
#pragma unroll
        for (int x = 0; x < 4; ++x) { const float fg = lbv[x] + (1.f - lbv[x]) * sigm(fv[x] + bfv[x]);
            Lv[ti][x] = lg2(fg); kk[ti][x] = 1.f - fg; qq[ti][x] = silu(qv[x]); }
    }
    float qd[2][4], ki[2][4], kd[2][4], gl[4];
#pragma unroll
    for (int x = 0; x < 4; ++x) {
        const float b0 = scan16(Lv[0][x]);
        const float b1 = scan16(Lv[1][x]) + bcast15(b0);
        const float BB = bcast15(b1);
        gl[x] = ex2(BB);
        qd[0][x] = qq[0][x] * ex2(b0); ki[0][x] = kk[0][x] * ex2(-b0); kd[0][x] = ki[0][x] * gl[x];
        qd[1][x] = qq[1][x] * ex2(b1); ki[1][x] = kk[1][x] * ex2(-b1); kd[1][x] = ki[1][x] * gl[x];
    }
    const int lp = (2 * (g & 1) + hf) * 16 + r;
#pragma unroll
    for (int ti = 0; ti < 2; ++ti) {
        *(LAS v2u*)(st + F0_QD + ((ti * 4 + ps) * 64 + lp) * 16 + (g >> 1) * 8) = (v2u){cvtpk(qd[ti][0], qd[ti][1]), cvtpk(qd[ti][2], qd[ti][3])};
        *(LAS v2u*)(st + F0_KI + ((ti * 4 + ps) * 64 + lp) * 16 + (g >> 1) * 8) = (v2u){cvtpk(ki[ti][0], ki[ti][1]), cvtpk(ki[ti][2], ki[ti][3])};
        const unsigned k01 = cvtpk(kd[ti][0], kd[ti][1]), k23 = cvtpk(kd[ti][2], kd[ti][3]);
        LAS unsigned char* tp = st + F0_T + (32 * ps + 8 * g + 4 * hf) * 64 + (16 * ti + r) * 2;
        *(LAS unsigned short*)(tp) = (unsigned short)(k01 & 0xffffu); *(LAS unsigned short*)(tp + 64) = (unsigned short)(k01 >> 16);
        *(LAS unsigned short*)(tp + 128) = (unsigned short)(k23 & 0xffffu); *(LAS unsigned short*)(tp + 192) = (unsigned short)(k23 >> 16);
    }
    if (r == 0) *(LAS f32x4*)(st + F0_GL + (32 * ps + 8 * g + 4 * hf) * 4) = (f32x4){gl[0], gl[1], gl[2], gl[3]};
    { const int tk = 4 * w + (lane >> 4), c16 = lane & 15;
      *(LAS v2u*)(st + F0_TV + tk * 264 + c16 * 16) = (v2u){vraw.x, vraw.y}; *(LAS v2u*)(st + F0_TV + tk * 264 + c16 * 16 + 8) = (v2u){vraw.z, vraw.w}; }
}
DI_ void l0_fused(Frame& F, unsigned char* dummy) {
    const int lane = F.lane, w = F.wave, r = lane & 15, g = lane >> 4, ps = w >> 1, hf = w & 1;
    LAS float* obuf = (LAS float*)(F.lds + 2 * F0_STG);
    constexpr int OB = 32 * 132;
    for (int u = F.vcu; u < NB * HG_H; u += F.G) {
        const int bh = u, b = bh >> 6, h = bh & 63;
        f32x4 acc[8];
#pragma unroll
        for (int m = 0; m < 8; ++m) acc[m] = (f32x4){0.f, 0.f, 0.f, 0.f};
        const int ntok = 4 * w + g, ndv = 8 * r;
        float ngv[8];
        { const f32x4 a0 = *(const GAS f32x4*)(F.ng0 + h * 128 + ndv), a1 = *(const GAS f32x4*)(F.ng0 + h * 128 + ndv + 4);
          ngv[0] = a0.x; ngv[1] = a0.y; ngv[2] = a0.z; ngv[3] = a0.w; ngv[4] = a1.x; ngv[5] = a1.y; ngv[6] = a1.z; ngv[7] = a1.w; }
        const int colp = h * 128 + 32 * ps + 8 * g + 4 * hf;
        const f32x4 lb4 = *(const GAS f32x4*)(F.LB0 + colp), bf4 = *(const GAS f32x4*)(F.b_f + colp);
        v2u q2s[2][2], f2s[2][2]; v4u vrs[2];
        const int oq[2] = {r * N0 + colp, (16 + r) * N0 + colp};
        const int ov = (4 * w + (lane >> 4)) * N0 + 2 * DI + h * 128 + 8 * (lane & 15), oz = ntok * N0 + 3 * DI + h * 128 + ndv, oy = ntok * DI + h * 128 + ndv;
        const bf16* xq = F.QFIZ + (size_t)(b * SEQ - 32) * N0;
        bf16* xy = F.Y + (size_t)(b * SEQ - 32) * DI;
        bf16* y0 = (b == 0) ? F.Y0 : F.Y0 + (size_t)32 * DI;
#define QCH(c_) (((c_) == 0) ? (const bf16*)F.Q0 : xq + (size_t)(c_) * 32 * N0)
        f0_load(QCH(0), oq, ov, q2s[0], f2s[0], vrs[0]);
        f0_prep(F, F.lds, q2s[0], f2s[0], vrs[0], lb4, bf4);
        f0_load(QCH(1), oq, ov, q2s[1], f2s[1], vrs[1]);
        LAS unsigned char* ascr = F.lds + 2 * F0_STG + 33792 + w * 4352;
        f32x4 awv[8];
        v4u zs[2]; zs[0] = (v4u){0u, 0u, 0u, 0u}; zs[1] = zs[0];
#define F0_BODY(C_, PAR) do { const int c = (C_); \
            asm volatile("s_waitcnt lgkmcnt(0)" ::: "memory"); \
            __builtin_amdgcn_s_barrier(); \
            asm volatile("" ::: "memory"); \
            f0_load(QCH((c + 2 < NCH) ? c + 2 : NCH - 1), oq, ov, q2s[PAR], f2s[PAR], vrs[PAR]); \
            AuxT at_; if (USE_AUX) { at_ = aux_decode(F, c, dummy); aux_load(F, at_, awv); } \
            { const int cz = (c < NCH) ? c : NCH - 1; zs[PAR] = *(const GAS v4u*)(QCH(cz) + oz); } \
            { \
                const int cp = c - 1; \
                const LAS float* ob = obuf + (cp & 1) * OB + ntok * 132 + ndv; \
                const f32x4 x0 = *(const LAS f32x4*)(ob), x1 = *(const LAS f32x4*)(ob + 4); \
                float ss = (x0.x * x0.x + x0.y * x0.y) + (x0.z * x0.z + x0.w * x0.w) + (x1.x * x1.x + x1.y * x1.y) + (x1.z * x1.z + x1.w * x1.w); \
                ss = bcast15(scan16(ss)); \
                const float rs = rsqrtf(ss * (1.f / 128.f) + RMS_EPS); \
                bf16* yb = (cp <= 0) ? ((cp == 0) ? y0 : F.Y0 + (size_t)32 * DI) : xy + (size_t)cp * 32 * DI; \
                { \
                    v4u d; \
                    d.x = cvtpk(x0.x * rs * ngv[0] * silu(bflo(zs[PAR ^ 1].x)), x0.y * rs * ngv[1] * silu(bfhi(zs[PAR ^ 1].x))); \
                    d.y = cvtpk(x0.z * rs * ngv[2] * silu(bflo(zs[PAR ^ 1].y)), x0.w * rs * ngv[3] * silu(bfhi(zs[PAR ^ 1].y))); \
                    d.z = cvtpk(x1.x * rs * ngv[4] * silu(bflo(zs[PAR ^ 1].z)), x1.y * rs * ngv[5] * silu(bfhi(zs[PAR ^ 1].z))); \
                    d.w = cvtpk(x1.z * rs * ngv[6] * silu(bflo(zs[PAR ^ 1].w)), x1.w * rs * ngv[7] * silu(bfhi(zs[PAR ^ 1].w))); \
                    *(GAS v4u*)(yb + oy) = d; \
                } \
            } \
             \
            { \
                const LAS unsigned char* st = F.lds + (c & 1) * F0_STG; \
 \
                unsigned short hv[8]; \
                _Pragma("unroll") \
                for (int e = 0; e < 8; ++e) hv[e] = *(const LAS unsigned short*)(st + F0_TV + (16 * (e >> 2) + 4 * g + (e & 3)) * 264 + (16 * w + r) * 2); \
                const bf16x8 vf = mk8(hv[0] | ((unsigned)hv[1] << 16), hv[2] | ((unsigned)hv[3] << 16), hv[4] | ((unsigned)hv[5] << 16), hv[6] | ((unsigned)hv[7] << 16)); \
                bf16x8 qf[8], kf[8]; \
                _Pragma("unroll") \
                for (int q = 0; q < 8; ++q) { qf[q] = *(const LAS bf16x8*)(st + F0_QD + q * 1024 + lane * 16); kf[q] = *(const LAS bf16x8*)(st + F0_KI + q * 1024 + lane * 16); } \
                SCHED_FENCE(); \
 \
                f32x4 pt00 = (f32x4){0.f, 0.f, 0.f, 0.f}, pt01 = pt00, pt11 = pt00; \
                _Pragma("unroll") \
                for (int s2 = 0; s2 < 4; ++s2) { pt00 = MFMA16(kf[s2], qf[s2], pt00); pt01 = MFMA16(kf[s2], qf[4 + s2], pt01); pt11 = MFMA16(kf[4 + s2], qf[4 + s2], pt11); } \
                const bool m0 = (4 * g + 0 <= r), m1 = (4 * g + 1 <= r), m2 = (4 * g + 2 <= r), m3 = (4 * g + 3 <= r); \
 \
                                const bf16x8 pb0 = mk8(cvtpk(m0 ? pt00.x : 0.f, m1 ? pt00.y : 0.f), cvtpk(m2 ? pt00.z : 0.f, m3 ? pt00.w : 0.f), 0u, 0u); \
                const bf16x8 pb1 = mk8(pk2(pt01.x, pt01.y), pk2(pt01.z, pt01.w), cvtpk(m0 ? pt11.x : 0.f, m1 ? pt11.y : 0.f), cvtpk(m2 ? pt11.z : 0.f, m3 ? pt11.w : 0.f)); \
                f32x4 o0 = (f32x4){0.f, 0.f, 0.f, 0.f}, o1 = o0; \
                o0 = MFMA16(vf, pb0, o0); o1 = MFMA16(vf, pb1, o1); \
                _Pragma("unroll") \
                for (int s2 = 0; s2 < 4; ++s2) { \
                    const bf16x8 sb = mk8(cvtpk(acc[2 * s2].x, acc[2 * s2].y), cvtpk(acc[2 * s2].z, acc[2 * s2].w), cvtpk(acc[2 * s2 + 1].x, acc[2 * s2 + 1].y), cvtpk(acc[2 * s2 + 1].z, acc[2 * s2 + 1].w)); \
                    o0 = MFMA16(sb, qf[s2], o0); o1 = MFMA16(sb, qf[4 + s2], o1); \
                } \
                LAS float* ow = obuf + (c & 1) * OB + r * 132 + 16 * w + 4 * g; \
                *(LAS f32x4*)ow = o0; *(LAS f32x4*)(ow + 16 * 132) = o1; \
                f32x4 gf[8]; v2u klo[8], khi[8]; \
                _Pragma("unroll") \
                for (int m = 0; m < 8; ++m) { gf[m] = *(const LAS f32x4*)(st + F0_GL + (16 * m + 4 * g) * 4); \
                    klo[m] = *(const LAS v2u*)(st + F0_T + (16 * m + r) * 64 + 8 * g); khi[m] = *(const LAS v2u*)(st + F0_T + (16 * m + r) * 64 + 32 + 8 * g); } \
                SCHED_FENCE(); \
                _Pragma("unroll") \
                for (int m = 0; m < 8; ++m) acc[m] = MFMA16(mk8(klo[m].x, klo[m].y, khi[m].x, khi[m].y), vf, acc[m] * gf[m]); \
                SCHED_FENCE(); \
            } \
            f0_prep(F, F.lds + ((c + 1) & 1) * F0_STG, q2s[PAR ^ 1], f2s[PAR ^ 1], vrs[PAR ^ 1], lb4, bf4); \
            if (USE_AUX) aux_store(F, at_, awv, ascr); \
        } while (0)
        for (int c2 = 0; c2 <= NCH; c2 += 2) { F0_BODY(c2, 0); F0_BODY(c2 + 1, 1); }
#undef F0_BODY
#undef QCH
        asm volatile("s_waitcnt vmcnt(0) lgkmcnt(0)" ::: "memory");
        __builtin_amdgcn_s_barrier();
    }
}

struct Args { const float* in[17]; float* out; unsigned char* ws; int ph_lo, ph_hi, li, pad; };
__global__ void __launch_bounds__(NWAVES * 64, 2) mk_fwd(Args args) {
    extern __shared__ __attribute__((aligned(16))) unsigned char lds[];
    Frame F;
    F.lds = (LAS unsigned char*)lds;
    F.MISC = (volatile LAS unsigned*)(F.lds + MISC_OFF);
    F.tid = threadIdx.x; F.lane = F.tid & 63; F.wave = __builtin_amdgcn_readfirstlane(F.tid >> 6);
    F.G = gridDim.x; { const int bx = blockIdx.x; F.vcu = (F.G % 8 == 0) ? (bx % 8) * (F.G / 8) + bx / 8 : bx; }
    unsigned char* ws = args.ws;
    F.ctl = (gu32*)(ws + WS_CTL);
    F.x = args.in[0]; F.meta = args.in[1]; F.lb_logits = args.in[2];
    F.w0in = args.in[3]; F.b_f = args.in[4]; F.ng0 = args.in[5]; F.w0out = args.in[6]; F.ln0g = args.in[7]; F.ln0b = args.in[8];
    F.w1in = args.in[9]; F.wg1 = args.in[10]; F.wg2 = args.in[11]; F.b_g = args.in[12]; F.ng1 = args.in[13]; F.w1out = args.in[14]; F.ln1g = args.in[15]; F.ln1b = args.in[16];
    F.out = args.out;
    F.LB0 = (float*)(ws + WS_LB0); F.G1 = (float*)(ws + WS_G1); F.PRE = (float*)(ws + WS_PRE); F.O1 = (float*)(ws + WS_O1); F.WG1T = (bf16*)(ws + WS_WG1T); F.W2F = (bf16*)(ws + WS_W2F); F.SS = (float*)(ws + WS_REC + 525 * MiB); F.Q0 = (bf16*)(ws + WS_Q0); F.Y0 = (bf16*)(ws + WS_Y0); F.REC0 = ws + WS_REC; F.REC1 = ws + WS_REC1; F.VF1 = ws + WS_VF1;
    F.WT0IN = (bf16*)(ws + WS_WT0IN); F.WT0OUT = (bf16*)(ws + WS_WT0OUT); F.WT1IN = (bf16*)(ws + WS_WT1IN); F.WT1OUT = (bf16*)(ws + WS_WT1OUT);
    F.XB = (bf16*)(ws + WS_XB); F.H1B = (bf16*)(ws + WS_H1B); F.QFIZ = (bf16*)(ws + WS_QFIZ); F.Y = (bf16*)(ws + WS_Y);
    for (int u = F.tid; u < (LDS_BYTES - LDSCTL_OFF) / 4; u += NWAVES * 64) ((LAS unsigned*)(F.lds + LDSCTL_OFF))[u] = 0u;
    __syncthreads();
    int vb = (int)blockIdx.x;
    if (USE_TICKETS && N_LAUNCHES == 1 && (F.G % 8) == 0) {
        if (F.tid == 0) {
            const unsigned per = (unsigned)F.G / 8u; unsigned x = xb_xcc_id() & 7u, got = 0xffffffffu;
            for (unsigned tr = 0; tr < 8u; ++tr) { const unsigned y = (x + tr) & 7u; const unsigned t = xb_add((unsigned*)(F.ctl + CW_POOL) + 64 * y, 1u); if (t < per) { got = y + 8u * t; break; } }
            F.MISC[12] = (got == 0xffffffffu) ? blockIdx.x : got;
        }
        __syncthreads();
        vb = (int)F.MISC[12];
    }
    { F.vcu = (F.G % 8 == 0) ? (vb % 8) * (F.G / 8) + vb / 8 : vb; }
    XcdBarrier bar; bar.bar = (unsigned*)(F.ctl + CW_BAR); bar.x = 0; bar.st = nullptr;
    if (N_LAUNCHES == 1) bar = xcd_barrier_post((unsigned*)(F.ctl + CW_BAR), F.MISC + 8);
#define GRID_BAR() do { if (N_LAUNCHES == 1) xcd_barrier(bar); } while (0)
    const int lo = args.ph_lo, hi = args.ph_hi;
    unsigned long long pclk0 = 0, pclkn = 0; (void)pclk0;
    unsigned long long st_prev = STAMP_MASK ? __builtin_amdgcn_s_memrealtime() : 0ull, st_acc = 0ull;
#define STAMP(k) do { if (STAMP_MASK) { const unsigned long long t_ = __builtin_amdgcn_s_memrealtime(); if ((STAMP_MASK >> (k)) & 1) st_acc += t_ - st_prev; st_prev = t_; } } while (0)
#ifdef ONLY_PHASE
#define IN(k) ((k) == ONLY_PHASE && lo <= (k) && (k) < hi)
#else
#define IN(k) (lo <= (k) && (k) < hi)
#endif
#define BOTH(k) (IN(k) && IN((k) + 1))

    if (IN(0)) { for (int rep = 0; rep < REP(0); ++rep) { p0_prologue(F); if (rep + 1 < REP(0)) GRID_BAR(); } if (BOTH(0)) GRID_BAR(); }
    STAMP(0);
    if (IN(1)) {
        if (!(P0_META_FOLD && F.G == 256)) skinny<1, 0>(F, F.XB + (size_t)MX * D, F.WT0IN, D, 0, N0 / 16, (USE_L0_MFMA == 2) ? F.Q0 + (size_t)16 * N0 : F.QFIZ + (size_t)MX * N0, N0, nullptr, nullptr);
        pg8::Gemm g{F.XB, F.WT0IN, MX, N0, D}; pg8::StaticOrder S; S.init(MX, N0, F.G, vb);
        pg8::EpiBf16<0> E{F.QFIZ, N0, nullptr, 0, 0, 1.f};
        if (PROBE_CLK == 1) pclk0 = __builtin_amdgcn_s_memtime();
        for (int rep = 0; rep < REP(1); ++rep) { pg8::gemm_phase<pg8::EpiBf16<0>, pg8::StaticOrder, PG8_ALIGN, PG8_SP2>(F.lds + RING_OFF, g, S, E); if (rep + 1 < REP(1)) GRID_BAR(); }
        if (PROBE_CLK == 1) pclkn = __builtin_amdgcn_s_memtime() - pclk0;
        if (BOTH(1)) GRID_BAR();
    }
    STAMP(1);
#if USE_L0_MFMA == 2
    STAMP(2);
    if (IN(3)) { for (int rep = 0; rep < REP(3); ++rep) { l0_fused(F, F.REC0); if (rep + 1 < REP(3)) GRID_BAR(); } if (BOTH(3)) GRID_BAR(); }
#elif USE_L0_MFMA
    if (IN(2)) { for (int rep = 0; rep < REP(2); ++rep) { l0_prep(F, F.REC0); if (rep + 1 < REP(2)) GRID_BAR(); } if (BOTH(2)) GRID_BAR(); }
    STAMP(2);
    if (IN(3)) { for (int rep = 0; rep < REP(3); ++rep) { l0_seq(F, F.REC0); if (rep + 1 < REP(3)) GRID_BAR(); } if (BOTH(3)) GRID_BAR(); }
#else
    if (IN(2)) { if (BOTH(2)) GRID_BAR(); }
    if (IN(3)) { for (int rep = 0; rep < REP(3); ++rep) { p2_l0_rec_naive(F); if (rep + 1 < REP(3)) GRID_BAR(); } if (BOTH(3)) GRID_BAR(); }
#endif
    STAMP(3);
    if (IN(4)) {
        skinny<4, 1>(F, (USE_L0_MFMA == 2) ? F.Y0 + (size_t)16 * DI : F.Y + (size_t)MX * DI, F.WT0OUT, DI, 0, D / 16, nullptr, 0, F.PRE + (size_t)MX * D, F.meta);
        pg8::Gemm g{F.Y, F.WT0OUT, MX, D, DI}; pg8::StaticOrder S; S.init(MX, D, F.G, vb);
        pg8::EpiResid E{F.PRE, D, F.x, F.meta, MX, MX, ALPHA};
        for (int rep = 0; rep < REP(4); ++rep) { pg8::gemm_phase<pg8::EpiResid, pg8::StaticOrder, PG8_ALIGN, PG8_SP2>(F.lds + RING_OFF, g, S, E); if (rep + 1 < REP(4)) GRID_BAR(); }
        if (BOTH(4)) GRID_BAR();
    }
    STAMP(4);
    if (IN(5)) { for (int rep = 0; rep < REP(5); ++rep) { ln_phase2(F, F.PRE, MR, F.ln0g, F.ln0b, RES_BF16 ? nullptr : F.PRE, F.H1B); if (rep + 1 < REP(5)) GRID_BAR(); } if (BOTH(5)) GRID_BAR(); }
    STAMP(5);
    if (IN(6)) {
        gate_proj(F, F.WG1T);
        skinny<2, 0>(F, F.H1B + (size_t)MX * D, F.WT1IN, D, 4096, (N1 - 4096 - DI) / 16, F.QFIZ + (size_t)MX * N1, N1, nullptr, nullptr);
        pg8::Gemm g{F.H1B, F.WT1IN, MX, N1, D}; pg8::StaticOrder S; S.init(MX, N1, F.G, vb);
        pg8::EpiBf16<0> E{F.QFIZ, N1, nullptr, 0, 0, 1.f};
        for (int rep = 0; rep < REP(6); ++rep) { pg8::gemm_phase<pg8::EpiBf16<0>, pg8::StaticOrder, PG8_ALIGN, PG8_SP2>(F.lds + RING_OFF, g, S, E); if (rep + 1 < REP(6)) GRID_BAR(); }
        if (BOTH(6)) GRID_BAR();
    }
    STAMP(6);
#if USE_L1_MFMA
    if (IN(7)) { for (int rep = 0; rep < REP(7); ++rep) { l1_prep(F, F.REC1, F.VF1, F.W2F); if (rep + 1 < REP(7)) GRID_BAR(); } if (BOTH(7)) GRID_BAR(); }
    STAMP(7);
#if USE_L1_SEQ2
    if (IN(8)) { l1_seq2(F, F.REC1, F.VF1, F.SS); if (BOTH(8)) GRID_BAR(); }
#else
    if (IN(8)) { l1_seq<0>(F, F.REC1, F.VF1, F.O1, F.SS); if (REP(8) > 1) { GRID_BAR(); l1_seq<PROBE_VAR>(F, F.REC1, F.VF1, F.O1, F.SS); } if (BOTH(8)) GRID_BAR(); }
#endif
#else
    if (IN(7)) { if (BOTH(7)) GRID_BAR(); }
    if (IN(8)) { for (int rep = 0; rep < REP(8); ++rep) { p6_l1_rec_naive(F); if (rep + 1 < REP(8)) GRID_BAR(); } if (BOTH(8)) GRID_BAR(); }
#endif
    STAMP(8);
#if !(USE_FUSED_NORM && USE_L1_MFMA)
    if (IN(9)) { for (int rep = 0; rep < REP(9); ++rep) { p7_normgate(F); if (rep + 1 < REP(9)) GRID_BAR(); } if (BOTH(9)) GRID_BAR(); }
#endif
    STAMP(9);
    if (IN(10)) {
        pg8::Gemm g{F.Y, F.WT1OUT, MX, D, DI}; pg8::StaticOrder S; S.init(MX, D, F.G, vb);
#if USE_FUSED_NORM && USE_L1_MFMA
        pg8::EpiResidScale E{F.PRE, D, F.H1B, ALPHA, F.SS, RMS_EPS};
        for (int rep = 0; rep < REP(10); ++rep) { pg8::gemm_phase<pg8::EpiResidScale, pg8::StaticOrder, PG8_ALIGN, PG8_SP2>(F.lds + RING_OFF, g, S, E); if (rep + 1 < REP(10)) GRID_BAR(); }
#else
        pg8::EpiResid E{F.PRE, D, F.PRE, F.PRE, MX, MX, ALPHA};
        if (PROBE_CLK == 10) pclk0 = __builtin_amdgcn_s_memtime();
        for (int rep = 0; rep < REP(10); ++rep) { pg8::gemm_phase<pg8::EpiResid, pg8::StaticOrder, PG8_ALIGN, PG8_SP2>(F.lds + RING_OFF, g, S, E); if (rep + 1 < REP(10)) GRID_BAR(); }
        if (PROBE_CLK == 10) pclkn = __builtin_amdgcn_s_memtime() - pclk0;
#endif
        if (BOTH(10)) GRID_BAR();
    }
    STAMP(10);
    if (IN(11)) { for (int rep = 0; rep < REP(11); ++rep) { ln_phase2(F, F.PRE, MX, F.ln1g, F.ln1b, F.out, nullptr); if (rep + 1 < REP(11)) GRID_BAR(); } }
    STAMP(11);
    if (STAMP_MASK && blockIdx.x == 0 && F.tid == 0) { const unsigned long long t0 = __builtin_amdgcn_s_memrealtime(); while (__builtin_amdgcn_s_memrealtime() - t0 < st_acc) __builtin_amdgcn_s_sleep(8); }
    if (PROBE_CLK && blockIdx.x == 0 && F.tid == 0) { const unsigned long long t0 = __builtin_amdgcn_s_memrealtime(); while (__builtin_amdgcn_s_memrealtime() - t0 < pclkn / (PROBE_CLK == 10 ? 10ull : 100ull)) __builtin_amdgcn_s_sleep(8); }
#undef IN
#undef BOTH
}

extern "C" void kernel_launch(void* const* d_in, const int* in_sizes, int n_in, void* d_out, int out_size, void* d_ws, size_t ws_size, hipStream_t stream) {
    static int grid = 0;
    if (grid == 0) {
        if (n_in != 17 || in_sizes[0] != MX * D || out_size != MX * D || ws_size < WS_END) { fprintf(stderr, "kernel_launch: unexpected problem (n_in %d, in0 %d, out %d, ws %zu < %zu); nothing launched\n", n_in, n_in > 0 ? in_sizes[0] : -1, out_size, ws_size, (size_t)WS_END); grid = -1; return; }
        int dev = 0, cus = 0, per_cu = 0;
        if (hipGetDevice(&dev) != hipSuccess || hipDeviceGetAttribute(&cus, hipDeviceAttributeMultiprocessorCount, dev) != hipSuccess) { fprintf(stderr, "kernel_launch: device query failed\n"); grid = -1; return; }
        if (hipFuncSetAttribute((const void*)mk_fwd, hipFuncAttributeMaxDynamicSharedMemorySize, LDS_BYTES) != hipSuccess) { fprintf(stderr, "kernel_launch: hipFuncSetAttribute failed\n"); grid = -1; return; }
        if (hipOccupancyMaxActiveBlocksPerMultiprocessor(&per_cu, (const void*)mk_fwd, NWAVES * 64, LDS_BYTES) != hipSuccess || per_cu < 1)
            fprintf(stderr, "kernel_launch: note: occupancy query reports %d workgroups per CU\n", per_cu);
        (void)hipGetLastError();
        grid = cus;
    }
    if (grid < 0) return;
    if (hipMemsetAsync((char*)d_ws + WS_CTL, 0, CTL_ZERO_BYTES, stream) != hipSuccess) { fprintf(stderr, "kernel_launch: memset failed\n"); return; }
    Args a{};
    for (int i = 0; i < 17; ++i) a.in[i] = (const float*)d_in[i];
    a.out = (float*)d_out; a.ws = (unsigned char*)d_ws;
    for (int li = 0; li < N_LAUNCHES; ++li) {
        a.ph_lo = (N_LAUNCHES == 1) ? 0 : li; a.ph_hi = (N_LAUNCHES == 1) ? PER_PHASE : li + 1; a.li = li; a.pad = 0;
        hipLaunchKernelGGL(mk_fwd, dim3(grid), dim3(NWAVES * 64), LDS_BYTES, stream, a);
        const hipError_t le = hipPeekAtLastError();
        if (le != hipSuccess) { fprintf(stderr, "kernel_launch: launch %d failed: %s\n", li, hipGetErrorName(le)); break; }
    }
}
```

```cpp
#include <hip/hip_runtime.h>
#include <cstdio>
#include <cstdint>
#define MK_N_LAUNCHES 1
#define USE_L0_MFMA 2
#define USE_L1_MFMA 1
namespace pg8 {
#define PG8_LAS __attribute__((address_space(3)))
typedef unsigned short bf16_t;
typedef short bf16x8 __attribute__((ext_vector_type(8)));
typedef float f32x4 __attribute__((ext_vector_type(4)));
typedef unsigned u32x4 __attribute__((ext_vector_type(4)));
constexpr int BM = 256, BK = 64, HALF = 128, HTB = HALF * BK * 2  , STAGE_BYTES = 8 * HTB, NXCD = 8, WGM = 8;

__host__ __device__ __forceinline__ int lds_byte(int r, int c) { const int st = (r >> 4) * 2 + (c >> 5), rr = r & 15, cc = c & 31, ob = rr * 64 + cc * 2; return st * 1024 + (ob ^ (((ob >> 9) & 1) << 5)); }
__host__ __device__ __forceinline__ void stage_rc(int b, int& R, int& C) { const int st = b / 1024, sb = b % 1024, swz = sb ^ (((sb >> 9) & 1) << 5); R = (st >> 1) * 16 + swz / 64; C = (st & 1) * 32 + (swz % 64) / 2; }
__host__ __device__ __forceinline__ int perm32(int rho) { const int n = rho >> 4, i = rho & 15; return 8 * (i >> 2) + 4 * n + (i & 3); }

struct Unit { int pm, pn; };
struct Gemm { const bf16_t* A; const bf16_t* Bt; int M, N, K; };

struct StaticOrder {
    int nM, nN, nwg, G, c;
    __host__ __device__ void init(int M, int N, int G_, int c_) { nM = M / BM; nN = N / BM; nwg = nM * nN; G = G_; c = c_; }
    __host__ __device__ bool next(int i, Unit& u) const {
        const long L = (long)i * G + c; if (L >= nwg) return false;
        int wgid = (int)L; { const int q = nwg / NXCD, r = nwg % NXCD, xcd = wgid % NXCD, off = wgid / NXCD; wgid = (xcd < r ? xcd * (q + 1) : r * (q + 1) + (xcd - r) * q) + off; }
        const int nig = WGM * nN, gid = wgid / nig, fm = gid * WGM, gsz = (nM - fm) < WGM ? (nM - fm) : WGM;
        u.pm = fm + ((wgid % nig) % gsz); u.pn = (wgid % nig) / gsz; return true;
    }
    __device__ __forceinline__ void a_ready(const Unit&) const {}
    __device__ __forceinline__ void done(const Unit&) const {}
};

__device__ __forceinline__ unsigned cvt_pk_bf16(float lo, float hi) { unsigned r; asm volatile("v_cvt_pk_bf16_f32 %0, %1, %2" : "=v"(r) : "v"(lo), "v"(hi)); return r; }
typedef float f32x2 __attribute__((ext_vector_type(2)));
__device__ __forceinline__ f32x2 gelu_pk(f32x2 v) {
    const f32x2 av = __builtin_elementwise_abs(v), d = av * 0.2316418882f + 1.0f;
    f32x2 t; t.x = __builtin_amdgcn_rcpf(d.x); t.y = __builtin_amdgcn_rcpf(d.y);
    f32x2 q = t * 0.5307027145f + (-0.7265760135f); q = q * t + 0.7107068705f; q = q * t + (-0.142248368f); q = q * t + 0.127414796f; q = q * t;
    const f32x2 s = (v * v) * (-0.72134752044f);
    f32x2 e; e.x = __builtin_amdgcn_exp2f(s.x); e.y = __builtin_amdgcn_exp2f(s.y);
    const f32x2 m = v * (q * e), r = v - m;
    f32x2 o; o.x = v.x < 0.f ? m.x : r.x; o.y = v.y < 0.f ? m.y : r.y; return o;
}

template <int ACT  > struct EpiBf16 {
    static constexpr bool PERM = true, AFTER_DRAIN = false, KHOOK = false; static_assert(ACT == 0 || ACT == 1, "EpiBf16: ACT is 0 (none) or 1 (gelu_pk)");
    bf16_t* O; int ldc; const float* bias; int split_cols; size_t split_stride; float scale0;
    __device__ __forceinline__ void operator()(const f32x4 (&acc)[2][2][4][2], const Unit& u, int wr, int wc, int fr, int fq) const {
        const int row0 = u.pm * BM + wr * 64 + fr; int colt = u.pn * BM; bf16_t* base = O;
        float sc = 1.f; if (split_cols) { const int t = colt / split_cols; base += (size_t)t * split_stride; colt -= t * split_cols; if (t == 0) sc = scale0; }
        const int col0 = colt + wc * 32 + 8 * fq, bcol0 = u.pn * BM + wc * 32 + 8 * fq;
        f32x4 bv[2][2];
#pragma unroll
        for (int bj = 0; bj < 2; ++bj)
#pragma unroll
            for (int n = 0; n < 2; ++n) bv[bj][n] = bias ? *(const f32x4*)(bias + bcol0 + bj * HALF + 4 * n) : (f32x4){0.f, 0.f, 0.f, 0.f};
#pragma unroll
        for (int ai = 0; ai < 2; ++ai)
#pragma unroll
            for (int m = 0; m < 4; ++m) { bf16_t* rowp = base + (size_t)(row0 + ai * HALF + m * 16) * ldc + col0;
#pragma unroll
                for (int bj = 0; bj < 2; ++bj) { f32x4 v0 = acc[ai][bj][m][0] + bv[bj][0], v1 = acc[ai][bj][m][1] + bv[bj][1];
                    if (ACT == 1) { f32x2 a = gelu_pk((f32x2){v0[0], v0[1]}), b = gelu_pk((f32x2){v0[2], v0[3]}), c = gelu_pk((f32x2){v1[0], v1[1]}), d = gelu_pk((f32x2){v1[2], v1[3]});
                        v0 = (f32x4){a.x, a.y, b.x, b.y}; v1 = (f32x4){c.x, c.y, d.x, d.y}; }
                    v0 = v0 * sc; v1 = v1 * sc; u32x4 w; w.x = cvt_pk_bf16(v0[0], v0[1]); w.y = cvt_pk_bf16(v0[2], v0[3]); w.z = cvt_pk_bf16(v1[0], v1[1]); w.w = cvt_pk_bf16(v1[2], v1[3]);
                    *(u32x4*)(rowp + bj * HALF) = w; } }
    }
};
struct EpiResid {
    static constexpr bool PERM = false, AFTER_DRAIN = false, KHOOK = false;
    float* C; int ldc; const float* resA; const float* resB; int rowsA; int rowsValid; float alpha;
    __device__ __forceinline__ void operator()(const f32x4 (&acc)[2][2][4][2], const Unit& u, int wr, int wc, int fr, int fq) const {
        const int row0 = u.pm * BM + wr * 64 + fr, col0 = u.pn * BM + wc * 32 + 4 * fq;
#pragma unroll
        for (int ai = 0; ai < 2; ++ai)
#pragma unroll
            for (int m = 0; m < 4; ++m) { const int r = row0 + ai * HALF + m * 16;
                if (r < rowsValid) {
                    const float* rp = (r < rowsA) ? resA + (size_t)r * ldc + col0 : resB + (size_t)(r - rowsA) * ldc + col0;
                    float* cp = C + (size_t)r * ldc + col0;
#pragma unroll
                    for (int bj = 0; bj < 2; ++bj)
#pragma unroll
                        for (int n = 0; n < 2; ++n) { const f32x4 rv = *(const f32x4*)(rp + bj * HALF + n * 16); *(f32x4*)(cp + bj * HALF + n * 16) = rv * alpha + acc[ai][bj][m][n]; } }
                asm volatile("" ::: "memory"); }
    }
};

struct EpiResidScale {
    static constexpr bool PERM = false, AFTER_DRAIN = false, KHOOK = true;
    float* C; int ldc; const unsigned short* res; float alpha; const float* SS; float eps;
    __device__ __forceinline__ void unit_begin(const Unit& u, int par, PG8_LAS unsigned char* lds) const {
        const int tid = threadIdx.x, row = tid >> 1, hh = 4 * (tid & 1);
        float sv[4];
        { const f32x4* sp = (const f32x4*)(SS + ((size_t)(u.pm * BM + row) * 8 + hh) * 8);
#pragma unroll
          for (int q = 0; q < 4; ++q) { const f32x4 a = sp[2 * q], b = sp[2 * q + 1]; sv[q] = (a.x + a.y) + (a.z + a.w) + (b.x + b.y) + (b.z + b.w); asm volatile("" ::: "memory"); } }
        const f32x4 s = (f32x4){sv[0], sv[1], sv[2], sv[3]};
        f32x4 rs; rs.x = __builtin_amdgcn_rsqf(s.x * (1.f / 1024.f) + eps); rs.y = __builtin_amdgcn_rsqf(s.y * (1.f / 1024.f) + eps); rs.z = __builtin_amdgcn_rsqf(s.z * (1.f / 1024.f) + eps); rs.w = __builtin_amdgcn_rsqf(s.w * (1.f / 1024.f) + eps);
        *(PG8_LAS f32x4*)(lds + 131072 + par * 8192 + (row * 8 + hh) * 4) = rs;
    }
    __device__ __forceinline__ void khook(f32x4 (&acc)[2][2][4][2], int par, int hb, int wr, int fr, PG8_LAS unsigned char* lds) const {
        const PG8_LAS float* T = (const PG8_LAS float*)(lds + 131072 + par * 8192);
        typedef float f32x2h __attribute__((ext_vector_type(2)));
        f32x2h tv[8]; unsigned ad[8];
#pragma unroll
        for (int i = 0; i < 8; ++i) ad[i] = (unsigned)(size_t)(T + ((i >> 2) * HALF + wr * 64 + (i & 3) * 16 + fr) * 8 + hb - 1);
        asm volatile("ds_read2_b32 %0, %8 offset1:1\n\tds_read2_b32 %1, %9 offset1:1\n\tds_read2_b32 %2, %10 offset1:1\n\tds_read2_b32 %3, %11 offset1:1\n\t"
                     "ds_read2_b32 %4, %12 offset1:1\n\tds_read2_b32 %5, %13 offset1:1\n\tds_read2_b32 %6, %14 offset1:1\n\tds_read2_b32 %7, %15 offset1:1\n\ts_waitcnt lgkmcnt(0)\n\ts_nop 15\n\ts_nop 15"
                     : "=&v"(tv[0]), "=&v"(tv[1]), "=&v"(tv[2]), "=&v"(tv[3]), "=&v"(tv[4]), "=&v"(tv[5]), "=&v"(tv[6]), "=&v"(tv[7])
                     : "v"(ad[0]), "v"(ad[1]), "v"(ad[2]), "v"(ad[3]), "v"(ad[4]), "v"(ad[5]), "v"(ad[6]), "v"(ad[7]) : "memory");
#pragma unroll
        for (int ai = 0; ai < 2; ++ai)
#pragma unroll
            for (int m = 0; m < 4; ++m) { const float ratio = tv[ai * 4 + m].x * __builtin_amdgcn_rcpf(tv[ai * 4 + m].y);
#pragma unroll
                for (int bj = 0; bj < 2; ++bj)
#pragma unroll
                    for (int n = 0; n < 2; ++n) { f32x4& a = acc[ai][bj][m][n];
                        asm volatile("v_mul_f32 %0, %0, %4\n\tv_mul_f32 %1, %1, %4\n\tv_mul_f32 %2, %2, %4\n\tv_mul_f32 %3, %3, %4\n\ts_nop 1" : "+v"(a.x), "+v"(a.y), "+v"(a.z), "+v"(a.w) : "v"(ratio)); } }
    }
    __device__ __forceinline__ void epi(const f32x4 (&acc)[2][2][4][2], const Unit& u, int wr, int wc, int fr, int fq, int par, PG8_LAS unsigned char* lds) const {
        const PG8_LAS float* T = (const PG8_LAS float*)(lds + 131072 + par * 8192);
        const int row0 = u.pm * BM + wr * 64 + fr, col0 = u.pn * BM + wc * 32 + 4 * fq;
#pragma unroll
        for (int ai = 0; ai < 2; ++ai)
#pragma unroll
            for (int m = 0; m < 4; ++m) { const int r = row0 + ai * HALF + m * 16; const float sc = T[(ai * HALF + wr * 64 + m * 16 + fr) * 8 + 7];
                const unsigned short* rp = res + (size_t)r * ldc + col0; float* cp = C + (size_t)r * ldc + col0;
#pragma unroll
                for (int bj = 0; bj < 2; ++bj)
#pragma unroll
                    for (int n = 0; n < 2; ++n) { const uint2 rb = *(const uint2*)(rp + bj * HALF + n * 16);
                        const f32x4 rv = (f32x4){__builtin_bit_cast(float, rb.x << 16), __builtin_bit_cast(float, rb.x & 0xffff0000u), __builtin_bit_cast(float, rb.y << 16), __builtin_bit_cast(float, rb.y & 0xffff0000u)};
                        *(f32x4*)(cp + bj * HALF + n * 16) = rv * alpha + acc[ai][bj][m][n] * sc; }
                asm volatile("" ::: "memory"); }
    }
};


template <class Epi, class Sched, bool ALIGN_EPI = false, bool SP2 = false>
__device__ __forceinline__ void gemm_phase(PG8_LAS unsigned char* lds, const Gemm g, const Sched& S, const Epi& E) {
    const int tid = threadIdx.x, wid = __builtin_amdgcn_readfirstlane(tid >> 6), lane = tid & 63, wr = wid >> 2, wc = wid & 3, fr = lane & 15, fq = lane >> 4;
    const int K = g.K, nt = K / BK;
    unsigned voffA[2], voffB[2];
#pragma unroll
    for (int i = 0; i < 2; ++i) { int R, C; stage_rc(tid * 16 + i * 8192, R, C); const int Rb = Epi::PERM ? ((R & ~31) + perm32(R & 31)) : R;
        voffA[i] = (unsigned)(R * K + C) * 2u; voffB[i] = (unsigned)(Rb * K + C) * 2u; }
    const size_t kstep = (size_t)(BK * 2);
    const size_t hstep = (size_t)HALF * K * 2;
    const size_t tstep = 2 * hstep;
    const unsigned ldsw = (unsigned)wid * 1024u;
    const int aoff = lds_byte(wr * 64 + fr, fq * 8), boff = lds_byte(wc * 32 + fr, fq * 8);
#define PG8_SA(b, h) (((b) * 2 + (h)) * HTB)
#define PG8_SB(b, h) ((4 + (b) * 2 + (h)) * HTB)
#define PG8_STAGE(bufoff, gbase, voff) do { _Pragma("unroll") for (int _i = 0; _i < 2; ++_i) \
        __builtin_amdgcn_global_load_lds((const unsigned*)((const char*)(gbase) + (voff)[_i]), (PG8_LAS unsigned*)(lds + (bufoff) + ldsw + _i * 8192), 16, 0, 0); } while (0)
#define PG8_LDA(dst, b, h) do { _Pragma("unroll") for (int m = 0; m < 4; ++m) _Pragma("unroll") for (int k = 0; k < 2; ++k) dst[m][k] = *(const PG8_LAS bf16x8*)(lds + PG8_SA(b, h) + aoff + m * 2048 + k * 1024); } while (0)
#define PG8_LDB(dst, b, h) do { _Pragma("unroll") for (int n = 0; n < 2; ++n) _Pragma("unroll") for (int k = 0; k < 2; ++k) dst[n][k] = *(const PG8_LAS bf16x8*)(lds + PG8_SB(b, h) + boff + n * 2048 + k * 1024); } while (0)
#define PG8_MMA(ai, bj, At, Bt) do { __builtin_amdgcn_s_setprio(1); _Pragma("unroll") for (int m = 0; m < 4; ++m) _Pragma("unroll") for (int n = 0; n < 2; ++n) _Pragma("unroll") for (int k = 0; k < 2; ++k) \
        acc[ai][bj][m][n] = __builtin_amdgcn_mfma_f32_16x16x32_bf16(Bt[n][k], At[m][k], acc[ai][bj][m][n], 0, 0, 0); __builtin_amdgcn_s_setprio(0); } while (0)
#define PG8_WAIT_V(n) asm volatile("s_waitcnt vmcnt(" #n ")" ::: "memory")
#define PG8_WAIT_L(n) asm volatile("s_waitcnt lgkmcnt(" #n ")" ::: "memory")
#define PG8_BAR __builtin_amdgcn_s_barrier()
#define PG8_SCHED __builtin_amdgcn_sched_barrier(0)
    Unit cur, nxt; int ui = 0;
    if (!S.next(0, cur)) return;
    f32x4 acc[2][2][4][2];
#pragma unroll
    for (int a = 0; a < 2; ++a)
#pragma unroll
        for (int b = 0; b < 2; ++b)
#pragma unroll
            for (int m = 0; m < 4; ++m)
#pragma unroll
                for (int n = 0; n < 2; ++n) acc[a][b][m][n] = (f32x4){0.f, 0.f, 0.f, 0.f};
    bf16x8 At[4][2], B0[2][2], B1[2][2];
    const char* cA = (const char*)g.A + (size_t)cur.pm * tstep; const char* cB = (const char*)g.Bt + (size_t)cur.pn * tstep;
    if constexpr (Epi::KHOOK) E.unit_begin(cur, ui & 1, lds);
    S.a_ready(cur);
    if constexpr (SP2) {
        PG8_STAGE(PG8_SB(0, 0), cB, voffB); PG8_STAGE(PG8_SB(0, 1), cB + hstep, voffB); PG8_STAGE(PG8_SA(0, 0), cA, voffA); PG8_STAGE(PG8_SA(0, 1), cA + hstep, voffA);
        if (wr == 1) PG8_BAR;
        PG8_WAIT_V(2); PG8_BAR;
        PG8_STAGE(PG8_SB(1, 0), cB + kstep, voffB); PG8_STAGE(PG8_SA(1, 0), cA + kstep, voffA); PG8_STAGE(PG8_SB(1, 1), cB + hstep + kstep, voffB);
        PG8_WAIT_V(6); PG8_BAR;
    } else {
        PG8_STAGE(PG8_SB(0, 0), cB, voffB); PG8_STAGE(PG8_SA(0, 0), cA, voffA); PG8_STAGE(PG8_SB(0, 1), cB + hstep, voffB); PG8_STAGE(PG8_SA(0, 1), cA + hstep, voffA);
        if (wr == 1) PG8_BAR;
        PG8_WAIT_V(4); PG8_BAR;
        PG8_STAGE(PG8_SB(1, 0), cB + kstep, voffB); PG8_STAGE(PG8_SA(1, 0), cA + kstep, voffA); PG8_STAGE(PG8_SB(1, 1), cB + hstep + kstep, voffB);
        PG8_WAIT_V(6); PG8_BAR;
    }
    for (;;) {
        const bool has_next = S.next(ui + 1, nxt);
        const char* nA = has_next ? (const char*)g.A + (size_t)nxt.pm * tstep : cA; const char* nB = has_next ? (const char*)g.Bt + (size_t)nxt.pn * tstep : cB;
        const int tseg = Epi::KHOOK ? 16 : nt;
        for (int tb = 0; tb < nt; tb += tseg) {
        if constexpr (Epi::KHOOK) { if (tb != 0) { PG8_SCHED; E.khook(acc, ui & 1, tb >> 4, wr, fr, lds); PG8_SCHED; } }
        for (int t = tb; t < tb + tseg; t += 2) {
            const bool last = (t == nt - 2);
            const char* a1 = cA + (size_t)(t + 1) * kstep;
            const char* a2 = last ? nA : cA + (size_t)(t + 2) * kstep; const char* b2 = last ? nB : cB + (size_t)(t + 2) * kstep;
            const char* a3 = a2 + kstep; const char* b3 = b2 + kstep;
            if (last && has_next) S.a_ready(nxt);
            if constexpr (SP2) {
            PG8_LDB(B0, 0, 0); PG8_LDB(B1, 0, 1); PG8_SCHED; PG8_LDA(At, 0, 0); PG8_STAGE(PG8_SA(1, 1), a1 + hstep, voffA);
            PG8_WAIT_V(8); PG8_WAIT_L(0); PG8_BAR; PG8_MMA(0, 0, At, B0); PG8_MMA(0, 1, At, B1); PG8_BAR; PG8_SCHED;
            PG8_LDA(At, 0, 1); PG8_STAGE(PG8_SB(0, 0), b2, voffB); PG8_STAGE(PG8_SB(0, 1), b2 + hstep, voffB); PG8_STAGE(PG8_SA(0, 0), a2, voffA);
            PG8_WAIT_V(8); PG8_WAIT_L(0); PG8_BAR; PG8_MMA(1, 0, At, B0); PG8_MMA(1, 1, At, B1); PG8_BAR; PG8_SCHED;
            PG8_LDB(B0, 1, 0); PG8_LDB(B1, 1, 1); PG8_SCHED; PG8_LDA(At, 1, 0); PG8_STAGE(PG8_SA(0, 1), a2 + hstep, voffA);
            PG8_WAIT_V(8); PG8_WAIT_L(0); PG8_BAR; PG8_MMA(0, 0, At, B0); PG8_MMA(0, 1, At, B1); PG8_BAR; PG8_SCHED;
            PG8_LDA(At, 1, 1); PG8_STAGE(PG8_SB(1, 0), b3, voffB); PG8_STAGE(PG8_SB(1, 1), b3 + hstep, voffB); PG8_STAGE(PG8_SA(1, 0), a3, voffA);
            PG8_WAIT_V(8); PG8_WAIT_L(0); PG8_BAR; PG8_MMA(1, 0, At, B0); PG8_MMA(1, 1, At, B1); PG8_BAR; PG8_SCHED;
            } else {
            PG8_LDB(B0, 0, 0); PG8_SCHED; PG8_LDA(At, 0, 0); PG8_STAGE(PG8_SA(1, 1), a1 + hstep, voffA);
            PG8_WAIT_L(8); PG8_BAR; PG8_WAIT_L(0); PG8_MMA(0, 0, At, B0); PG8_BAR; PG8_SCHED;
            PG8_LDB(B1, 0, 1); PG8_STAGE(PG8_SB(0, 0), b2, voffB);
            PG8_BAR; PG8_WAIT_L(0); PG8_MMA(0, 1, At, B1); PG8_BAR;
            PG8_LDA(At, 0, 1); PG8_STAGE(PG8_SA(0, 0), a2, voffA);
            PG8_BAR; PG8_WAIT_L(0); PG8_MMA(1, 0, At, B0); PG8_BAR; PG8_SCHED;
            PG8_STAGE(PG8_SB(0, 1), b2 + hstep, voffB);
            PG8_WAIT_V(6); PG8_BAR; PG8_MMA(1, 1, At, B1); PG8_BAR;
            PG8_LDB(B0, 1, 0); PG8_SCHED; PG8_LDA(At, 1, 0); PG8_STAGE(PG8_SA(0, 1), a2 + hstep, voffA);
            PG8_WAIT_L(8); PG8_BAR; PG8_WAIT_L(0); PG8_MMA(0, 0, At, B0); PG8_BAR; PG8_SCHED;
            PG8_LDB(B1, 1, 1); PG8_STAGE(PG8_SB(1, 0), b3, voffB);
            PG8_BAR; PG8_WAIT_L(0); PG8_MMA(0, 1, At, B1); PG8_BAR;
            PG8_LDA(At, 1, 1); PG8_STAGE(PG8_SA(1, 0), a3, voffA);
            PG8_BAR; PG8_WAIT_L(0); PG8_MMA(1, 0, At, B0); PG8_BAR; PG8_SCHED;
            PG8_STAGE(PG8_SB(1, 1), b3 + hstep, voffB);
            PG8_WAIT_V(6); PG8_BAR; PG8_MMA(1, 1, At, B1); PG8_BAR;
            }
        }
        }
        if constexpr (ALIGN_EPI) { if (wr == 0) PG8_BAR; }
        if constexpr (Epi::KHOOK) { E.epi(acc, cur, wr, wc, fr, fq, ui & 1, lds); S.done(cur); }
        else if constexpr (!Epi::AFTER_DRAIN) { E(acc, cur, wr, wc, fr, fq); S.done(cur); }
        if (!has_next) break;
#pragma unroll
        for (int a = 0; a < 2; ++a)
#pragma unroll
            for (int b = 0; b < 2; ++b)
#pragma unroll
                for (int m = 0; m < 4; ++m)
#pragma unroll
                    for (int n = 0; n < 2; ++n) acc[a][b][m][n] = (f32x4){0.f, 0.f, 0.f, 0.f};
        cur = nxt; cA = nA; cB = nB; ++ui;
        if constexpr (Epi::KHOOK) E.unit_begin(cur, ui & 1, lds);
        if constexpr (ALIGN_EPI) { if (wr == 1) PG8_BAR; }
    }
    PG8_WAIT_V(0);
    if constexpr (!ALIGN_EPI) { if (wr == 0) PG8_BAR; }
    PG8_BAR;
    if constexpr (Epi::AFTER_DRAIN) { E.fused(acc, cur, wr, wc, fr, fq, lds, wid, lane); S.done(cur); }
#undef PG8_SA
#undef PG8_SB
#undef PG8_STAGE
#undef PG8_LDA
#undef PG8_LDB
#undef PG8_MMA
#undef PG8_WAIT_V
#undef PG8_WAIT_L
#undef PG8_BAR
#undef PG8_SCHED
}
}
#ifndef PG8_SP2
#define PG8_SP2 true
#endif
#ifndef PG8_ALIGN
#define PG8_ALIGN true
#endif

constexpr int NWAVES = 8;
constexpr int PER_PHASE = 12;
#ifndef MK_N_LAUNCHES
#define MK_N_LAUNCHES 1
#endif
#ifndef PROBE_MASK
#define PROBE_MASK 0
#endif
#define REP(k) (((PROBE_MASK >> (k)) & 1) + 1)
#ifndef PROBE_VAR
#define PROBE_VAR 0
#endif
#ifndef PROBE_CLK
#define PROBE_CLK 0
#endif
#ifndef STAMP_MASK
#define STAMP_MASK 0
#endif
#ifndef USE_AUX
#define USE_AUX 0
#endif
#ifndef USE_TILE_TRANSPOSE
#define USE_TILE_TRANSPOSE 0
#endif
#ifndef USE_L1_SEQ2
#define USE_L1_SEQ2 0
#endif
#ifndef USE_FUSED_NORM
#define USE_FUSED_NORM 1
#define RES_BF16 (USE_FUSED_NORM && USE_L1_MFMA)
#endif
#ifndef P0_META_FOLD
#define P0_META_FOLD (USE_L0_MFMA == 2 && !USE_TILE_TRANSPOSE)
#endif
#ifndef USE_TICKETS
#define USE_TICKETS 0
#endif
constexpr int N_LAUNCHES = MK_N_LAUNCHES;

constexpr int D = 4096, NB = 4, SEQ = 2048, NMETA = 16, DI = 8192;
constexpr int MX = NB * SEQ;
constexpr int MR = MX + NMETA;
constexpr int MP = 8448;
constexpr int N0 = 4 * DI;
constexpr int N1 = 2 * 4096 + 2 * DI;
constexpr int HG_H = 64, HG_DK = 128;
constexpr int GL_H = 8, GL_DK = 512, GL_DV = 1024, GL_R = 16;
constexpr float LN_EPS = 1e-5f, RMS_EPS = 1e-6f;
constexpr float ALPHA = 1.41421356237309515f;

constexpr size_t MiB = 1u << 20;
constexpr size_t WS_CTL = 0, CTL_ZERO_BYTES = 1 * MiB;
constexpr size_t WS_LB0 = 1 * MiB;
constexpr size_t WS_G1 = 2 * MiB;
constexpr size_t WS_WG1T = 3 * MiB;
constexpr size_t WS_W2F = 3 * MiB + 256 * 1024;
constexpr size_t WS_WT0IN = 4 * MiB;
constexpr size_t WS_WT0OUT = WS_WT0IN + 256 * MiB;
constexpr size_t WS_WT1IN = WS_WT0OUT + 64 * MiB;
constexpr size_t WS_WT1OUT = WS_WT1IN + 192 * MiB;
constexpr size_t WS_XB = WS_WT1OUT + 64 * MiB;
constexpr size_t WS_H1B = WS_XB + 66 * MiB;
constexpr size_t WS_QFIZ = WS_H1B + 66 * MiB;
constexpr size_t WS_Y = WS_QFIZ + 528 * MiB;
constexpr size_t WS_PRE = WS_Y + 132 * MiB;
constexpr size_t WS_REC = WS_PRE + 132 * MiB;
constexpr size_t WS_Q0 = WS_REC + 520 * MiB;
constexpr size_t WS_Y0 = WS_REC + 523 * MiB;
constexpr size_t WS_REC1 = WS_REC, WS_VF1 = WS_REC + 139 * MiB, WS_O1 = WS_REC + 270 * MiB;
constexpr size_t WS_END = WS_REC + 528 * MiB;
static_assert((size_t)MP * D * 2 <= 66 * MiB && (size_t)MP * N0 * 2 <= 528 * MiB && (size_t)MP * DI * 2 <= 132 * MiB && (size_t)MP * D * 4 <= 132 * MiB && (size_t)MR * DI * 4 <= 258 * MiB, "d_ws map");
static_assert((size_t)256 * 65 * 27648 <= 440 * MiB && (size_t)32 * 65 * 69632 <= 139 * MiB && (size_t)32 * 65 * 65536 <= 131 * MiB, "record map");
constexpr int CW_BAR = 4096, CW_POOL = 8192;

constexpr int RING_OFF = 0, RING_BYTES = 155648;
constexpr int LDSCTL_OFF = RING_BYTES, MISC_OFF = LDSCTL_OFF + 320;
constexpr int LDS_BYTES = 163840;
static_assert(MISC_OFF + 128 <= LDS_BYTES, "LDS map");

#define GAS __attribute__((address_space(1)))
#define LAS __attribute__((address_space(3)))
typedef unsigned short bf16;
typedef unsigned v4u __attribute__((ext_vector_type(4)));
typedef unsigned v2u __attribute__((ext_vector_type(2)));
typedef float f32x4 __attribute__((ext_vector_type(4)));
typedef GAS unsigned gu32;
#define RLX_AGENT __ATOMIC_RELAXED, __HIP_MEMORY_SCOPE_AGENT
#define LDS_WAIT() asm volatile("s_waitcnt lgkmcnt(0)" ::: "memory")
#define DI_ __device__ __forceinline__
DI_ unsigned f2bf(float f) { unsigned u = __builtin_bit_cast(unsigned, f); return (u + 0x7fffu + ((u >> 16) & 1u)) >> 16; }
DI_ unsigned pk2(float lo, float hi) { return f2bf(lo) | (f2bf(hi) << 16); }
DI_ unsigned hwpk(float lo, float hi) { unsigned r; asm volatile("v_cvt_pk_bf16_f32 %0, %1, %2" : "=v"(r) : "v"(lo), "v"(hi)); return r; }
DI_ float bflo(unsigned w) { return __builtin_bit_cast(float, w << 16); }
DI_ float bfhi(unsigned w) { return __builtin_bit_cast(float, w & 0xffff0000u); }
DI_ float bf2f(bf16 b) { return __builtin_bit_cast(float, (unsigned)b << 16); }
DI_ float sigm(float x) { return __builtin_amdgcn_rcpf(1.f + __builtin_amdgcn_exp2f(x * -1.4426950408889634f)); }
DI_ float silu(float x) { return x * __builtin_amdgcn_rcpf(1.f + __builtin_amdgcn_exp2f(x * -1.4426950408889634f)); }

#define XB_TMO      128
#define XB_XCNT(j)  (256  + 64 * (j))
#define XB_XSUB(j)  (1280 + 64 * (j))
#define XB_XGEN(j)  (2304 + 64 * (j))
#define XB_TOP      3328
#define XB_TOPGEN   3392
#define XCD_BAR_WORDS 3456
#define XB_SPIN_CAP (1u << 18)

__device__ __forceinline__ unsigned xb_ld(unsigned* p)              { return __hip_atomic_load(p, __ATOMIC_RELAXED, __HIP_MEMORY_SCOPE_AGENT); }
__device__ __forceinline__ unsigned xb_add(unsigned* p, unsigned v) { return __hip_atomic_fetch_add(p, v, __ATOMIC_RELAXED, __HIP_MEMORY_SCOPE_AGENT); }
__device__ __forceinline__ unsigned xb_xcc_id() { return (unsigned)__builtin_amdgcn_s_getreg((3 << 11) | 20) & 0xFu; }
#define XB_SPIN(cond, bar) do { unsigned _sp = 0; while (cond) { __builtin_amdgcn_s_sleep(1); \
    if ((++_sp & 255u) == 0u) { if (xb_ld(&(bar)[XB_TMO])) break; if (_sp > XB_SPIN_CAP) { atomicAdd(&(bar)[XB_TMO], 1u); break; } } } } while (0)

struct XcdBarrier {
    unsigned* bar; unsigned x;
    volatile LAS unsigned* st;
};
__device__ __forceinline__ XcdBarrier xcd_barrier_post(unsigned* bar, volatile LAS unsigned* st) {
    XcdBarrier b; b.bar = bar; b.x = xb_xcc_id(); b.st = st;
    if (threadIdx.x == 0) (void)xb_add(&bar[XB_XCNT(b.x)], 1u);
    return b;
}
__device__ __forceinline__ void xcd_barrier_complete(unsigned* bar, unsigned x, unsigned& nloc, unsigned& nx) {
    const unsigned G = gridDim.x * gridDim.y * gridDim.z;
    unsigned sum, cnt, mine, sp = 0u;
    for (;;) {
        sum = 0u; cnt = 0u; mine = 0u;
#pragma unroll
        for (unsigned j = 0; j < 16; ++j) { const unsigned c = xb_ld(&bar[XB_XCNT(j)]); sum += c; cnt += (c > 0u) ? 1u : 0u; mine = (j == x) ? c : mine; }
        if (sum == G) break;
        __builtin_amdgcn_s_sleep(1);
        if ((++sp & 255u) == 0u) { if (xb_ld(&bar[XB_TMO])) break; if (sp > XB_SPIN_CAP) { atomicAdd(&bar[XB_TMO], 1u); break; } }
    }
    nloc = mine > 0u ? mine : 1u; nx = cnt > 0u ? cnt : 1u;
}
__device__ __forceinline__ void xcd_barrier(const XcdBarrier& b) {
    asm volatile("s_waitcnt vmcnt(0)" ::: "memory");
    __syncthreads();
    if (threadIdx.x == 0) {
        unsigned* bar = b.bar;
        __builtin_amdgcn_s_waitcnt(0);
        unsigned nloc = b.st[0], nx = b.st[1];
        if (nloc == 0u) { xcd_barrier_complete(bar, b.x, nloc, nx); b.st[0] = nloc; b.st[1] = nx; }
        const unsigned old = xb_add(&bar[XB_XSUB(b.x)], 1u);
        const unsigned gen = old / nloc;
        if (old + 1u == (gen + 1u) * nloc) {
            __builtin_amdgcn_fence(__ATOMIC_RELEASE, "agent");
            asm volatile("s_waitcnt vmcnt(0)" ::: "memory");
            const unsigned og = xb_add(&bar[XB_TOP], 1u);
            const unsigned tg = og / nx;
            if (og + 1u == (tg + 1u) * nx) xb_add(&bar[XB_TOPGEN], 1u);
            else XB_SPIN(xb_ld(&bar[XB_TOPGEN]) == tg, bar);
            __builtin_amdgcn_fence(__ATOMIC_ACQUIRE, "agent");
            xb_add(&bar[XB_XGEN(b.x)], 1u);
            asm volatile("s_waitcnt vmcnt(0)" ::: "memory");
        } else {
            XB_SPIN(xb_ld(&bar[XB_XGEN(b.x)]) == gen, bar);
            __builtin_amdgcn_fence(__ATOMIC_ACQUIRE, "agent");
            asm volatile("s_waitcnt vmcnt(0)" ::: "memory");
        }
    }
    __syncthreads();
}

struct Frame {
    LAS unsigned char* lds;
    volatile LAS unsigned* MISC;
    gu32* ctl;
    int tid, lane, wave;
    int vcu, G;
    const float *x, *meta, *lb_logits;
    const float *w0in, *b_f, *ng0, *w0out, *ln0g, *ln0b;
    const float *w1in, *wg1, *wg2, *b_g, *ng1, *w1out, *ln1g, *ln1b;
    float* out;
    float *LB0, *G1, *PRE, *O1;
    unsigned char *REC0, *REC1, *VF1;
    bf16 *WG1T, *W2F, *Q0, *Y0;
    float* SS;
    bf16 *WT0IN, *WT0OUT, *WT1IN, *WT1OUT, *XB, *H1B, *QFIZ, *Y;
};

DI_ float wave_sum(float v) {
#pragma unroll
    for (int o = 1; o < 64; o <<= 1) v += __shfl_xor(v, o);
    return v;
}

typedef short p0_bf16x8 __attribute__((ext_vector_type(8)));
template <bool META>
DI_ void p0_transpose_item_t(const float* W, int K, int N, bf16* WT, LAS float* scr, int item_kb, int item_nb, int lane, const float* meta, f32x4 (&macc)[2]) {
    const int k0 = 64 * item_kb, n0 = 32 * item_nb;
    float wv[32];
#pragma unroll
    for (int i = 0; i < 32; ++i) wv[i] = __builtin_nontemporal_load(W + (size_t)(k0 + 2 * i + (lane >> 5)) * N + n0 + (lane & 31));
    v4u ma[2][2];
    if (META) {
#pragma unroll
        for (int ks = 0; ks < 2; ++ks) { const GAS f32x4* mp = (const GAS f32x4*)(meta + (size_t)(lane & 15) * D + k0 + 32 * ks + 8 * (lane >> 4)); const f32x4 a = mp[0], b = mp[1];
            ma[ks][0] = (v4u){hwpk(a.x, a.y), hwpk(a.z, a.w), hwpk(b.x, b.y), hwpk(b.z, b.w)}; }
    }
#pragma unroll
    for (int i = 0; i < 32; ++i) scr[(2 * i + (lane >> 5)) * 33 + (lane & 31)] = wv[i];
    LDS_WAIT(); asm volatile("" ::: "memory");
    if (META) {
        const int r = lane & 15, g = lane >> 4;
#pragma unroll
        for (int ks = 0; ks < 2; ++ks)
#pragma unroll
            for (int nh = 0; nh < 2; ++nh) { const LAS float* s = scr + (32 * ks + 8 * g) * 33 + 16 * nh + r;
                const v4u bf = (v4u){hwpk(s[0 * 33], s[1 * 33]), hwpk(s[2 * 33], s[3 * 33]), hwpk(s[4 * 33], s[5 * 33]), hwpk(s[6 * 33], s[7 * 33])};
                macc[nh] = __builtin_amdgcn_mfma_f32_16x16x32_bf16(__builtin_bit_cast(p0_bf16x8, ma[ks][0]), __builtin_bit_cast(p0_bf16x8, bf), macc[nh], 0, 0, 0); }
    }
    const int c = lane & 7;
#pragma unroll
    for (int j = 0; j < 4; ++j) { const int n = (lane >> 3) + 8 * j; const LAS float* s = scr + (8 * c) * 33 + n;
        v4u o; o.x = hwpk(s[0 * 33], s[1 * 33]); o.y = hwpk(s[2 * 33], s[3 * 33]); o.z = hwpk(s[4 * 33], s[5 * 33]); o.w = hwpk(s[6 * 33], s[7 * 33]);
        *(GAS v4u*)(WT + (size_t)(n0 + n) * K + k0 + 8 * c) = o; }
    LDS_WAIT(); asm volatile("" ::: "memory");
}
struct P0Item { const float* src; bf16* dst; int N, K; };
template <bool META, bool PREF>
DI_ void p0_item_pipe(const P0Item cur, const P0Item nxt, float (&wv)[32], f32x4 (&mraw)[4], LAS float* scr, int lane, const float* meta_nxt, f32x4 (&macc)[2]) {
#pragma unroll
    for (int i = 0; i < 32; ++i) scr[(2 * i + (lane >> 5)) * 33 + (lane & 31)] = wv[i];
    v4u ma[2];
    if (META) {
#pragma unroll
        for (int ks = 0; ks < 2; ++ks) { const f32x4 a = mraw[2 * ks], b = mraw[2 * ks + 1]; ma[ks] = (v4u){pk2(a.x, a.y), pk2(a.z, a.w), pk2(b.x, b.y), pk2(b.z, b.w)}; }
    }
    if (PREF) {
        if (META) {
#pragma unroll
            for (int ks = 0; ks < 2; ++ks) { const GAS f32x4* mp = (const GAS f32x4*)(meta_nxt + (size_t)(lane & 15) * D + 32 * ks + 8 * (lane >> 4)); mraw[2 * ks] = mp[0]; mraw[2 * ks + 1] = mp[1]; }
        }
#pragma unroll
        for (int i = 0; i < 32; ++i) wv[i] = __builtin_nontemporal_load(nxt.src + (size_t)(2 * i + (lane >> 5)) * nxt.N + (lane & 31));
    }
    LDS_WAIT(); asm volatile("" ::: "memory");
    if (META) {
        const int r = lane & 15, g = lane >> 4;
#pragma unroll
        for (int ks = 0; ks < 2; ++ks)
#pragma unroll
            for (int nh = 0; nh < 2; ++nh) { const LAS float* s = scr + (32 * ks + 8 * g) * 33 + 16 * nh + r;
                const v4u bf = (v4u){hwpk(s[0 * 33], s[1 * 33]), hwpk(s[2 * 33], s[3 * 33]), hwpk(s[4 * 33], s[5 * 33]), hwpk(s[6 * 33], s[7 * 33])};
                macc[nh] = __builtin_amdgcn_mfma_f32_16x16x32_bf16(__builtin_bit_cast(p0_bf16x8, ma[ks]), __builtin_bit_cast(p0_bf16x8, bf), macc[nh], 0, 0, 0); }
    }
    const int c = lane & 7;
#pragma unroll
    for (int j = 0; j < 4; ++j) { const int n = (lane >> 3) + 8 * j; const LAS float* s = scr + (8 * c) * 33 + n;
        v4u o; o.x = hwpk(s[0 * 33], s[1 * 33]); o.y = hwpk(s[2 * 33], s[3 * 33]); o.z = hwpk(s[4 * 33], s[5 * 33]); o.w = hwpk(s[6 * 33], s[7 * 33]);
        *(GAS v4u*)(cur.dst + (size_t)n * cur.K + 8 * c) = o; }
    LDS_WAIT(); asm volatile("" ::: "memory");
}
DI_ void p0_transpose_item(const float* W, int K, int N, bf16* WT, LAS float* scr, int item, int lane) {
    f32x4 dummy[2]; const int nblk = N / 32;
    p0_transpose_item_t<false>(W, K, N, WT, scr, item / nblk, item % nblk, lane, nullptr, dummy);
}

DI_ void p0_tile_load(const float* W, int N, int k0, int n0, int tid, f32x4 (&wv)[8]) {
    const int row = tid >> 5, c4 = tid & 31;
#pragma unroll
    for (int i = 0; i < 8; ++i) wv[i] = *(const GAS f32x4*)(W + (size_t)(k0 + row + 16 * i) * N + n0 + 4 * c4);
}
DI_ void p0_tile_to_lds(int tid, const f32x4 (&wv)[8], LAS unsigned char* img) {
    const int row = tid >> 5, c4 = tid & 31;
#pragma unroll
    for (int i = 0; i < 8; ++i) { const int k = row + 16 * i; const int col = (2 * c4) ^ (2 * ((k >> 3) & 15));
        *(LAS v2u*)(img + k * 256 + col * 4) = (v2u){hwpk(wv[i].x, wv[i].y), hwpk(wv[i].z, wv[i].w)}; }
}
DI_ void p0_tile_from_lds(bf16* WT, int K, int k0, int n0, int tid, LAS unsigned char* img) {
    __syncthreads();
    const int kc = tid & 15;
#pragma unroll
    for (int j = 0; j < 4; ++j) { const int n = (tid >> 4) + 32 * j; unsigned short hv[8];
#pragma unroll
        for (int e = 0; e < 8; ++e) hv[e] = *(const LAS unsigned short*)(img + (8 * kc + e) * 256 + ((((n >> 1) ^ (2 * kc)) << 2) | ((n & 1) << 1)));
        v4u o; o.x = hv[0] | ((unsigned)hv[1] << 16); o.y = hv[2] | ((unsigned)hv[3] << 16); o.z = hv[4] | ((unsigned)hv[5] << 16); o.w = hv[6] | ((unsigned)hv[7] << 16);
        *(GAS v4u*)(WT + (size_t)(n0 + n) * K + k0 + 8 * kc) = o; }
    __syncthreads();
}
struct P0Tile { const float* W; bf16* WT; int K, N, k0, n0; };
DI_ P0Tile p0_tile_decode(Frame& F, int t) {
    constexpr int T_0 = (D / 128) * (N0 / 128), T_1 = (DI / 128) * (D / 128), T_2 = (D / 128) * (N1 / 128);
    P0Tile p;
    if (t < T_0) { p.W = F.w0in; p.WT = F.WT0IN; p.K = D; p.N = N0; }
    else if (t < T_0 + T_1) { t -= T_0; p.W = F.w0out; p.WT = F.WT0OUT; p.K = DI; p.N = D; }
    else if (t < T_0 + T_1 + T_2) { t -= T_0 + T_1; p.W = F.w1in; p.WT = F.WT1IN; p.K = D; p.N = N1; }
    else { t -= T_0 + T_1 + T_2; p.W = F.w1out; p.WT = F.WT1OUT; p.K = DI; p.N = D; }
    const int nt = p.N / 128, kb = t / nt, nb = t - kb * nt; p.k0 = 128 * kb; p.n0 = 128 * nb; return p;
}
DI_ void p0_transpose_all(Frame& F) {
    constexpr int NT = (D / 128) * (N0 / 128) + 2 * (DI / 128) * (D / 128) + (D / 128) * (N1 / 128);
    f32x4 wv[8];
    int t = F.vcu;
    if (t < NT) { const P0Tile p = p0_tile_decode(F, t); p0_tile_load(p.W, p.N, p.k0, p.n0, F.tid, wv); }
    for (; t < NT; t += F.G) {
        const P0Tile p = p0_tile_decode(F, t);
        p0_tile_to_lds(F.tid, wv, F.lds);
        if (t + F.G < NT) { const P0Tile q = p0_tile_decode(F, t + F.G); p0_tile_load(q.W, q.N, q.k0, q.n0, F.tid, wv); }
        p0_tile_from_lds(p.WT, p.K, p.k0, p.n0, F.tid, F.lds);
    }
}

DI_ void p0_prologue(Frame& F) {
    LAS float* scr = (LAS float*)(F.lds + RING_OFF + F.wave * 16384);
    const int gw = F.vcu * NWAVES + F.wave, NGW = F.G * NWAVES;
    constexpr int I_0 = (D / 64) * (N0 / 32), I_1 = (DI / 64) * (D / 32), I_2 = (D / 64) * (N1 / 32), I_3 = I_1;
    constexpr int NITEMS = I_0 + I_1 + I_2 + I_3;
#if USE_TILE_TRANSPOSE
    p0_transpose_all(F);
#else
    if (P0_META_FOLD && F.G == 256) {
        constexpr int OTH = I_1 + I_2 + I_3;
        static_assert(OTH == 8192 + 1024 * 72, "tile split");
        auto other = [&](int r) -> P0Item {
            const float* W; bf16* WT; int K, N;
            if (r < I_1) { W = F.w0out; WT = F.WT0OUT; K = DI; N = D; }
            else if (r < I_1 + I_2) { r -= I_1; W = F.w1in; WT = F.WT1IN; K = D; N = N1; }
            else { r -= I_1 + I_2; W = F.w1out; WT = F.WT1OUT; K = DI; N = D; }
            const int nblk = N / 32, kb = r / nblk, nb = r - kb * nblk;
            return P0Item{W + (size_t)(64 * kb) * N + 32 * nb, WT + (size_t)(32 * nb) * K + 64 * kb, N, K};
        };
        float wv[32]; f32x4 mraw[4]; f32x4 macc[2]; macc[0] = (f32x4){0.f, 0.f, 0.f, 0.f}; macc[1] = macc[0];
        const int lane = F.lane;
        int o_lo, o_hi;
        P0Item cur;
        if (gw < 1024) {
            cur = P0Item{F.w0in + 32 * gw, F.WT0IN + (size_t)(32 * gw) * D, N0, D};
#pragma unroll
            for (int ks = 0; ks < 2; ++ks) { const GAS f32x4* mp = (const GAS f32x4*)(F.meta + (size_t)(lane & 15) * D + 32 * ks + 8 * (lane >> 4)); mraw[2 * ks] = mp[0]; mraw[2 * ks + 1] = mp[1]; }
            o_lo = gw * 8; o_hi = o_lo + 8;
        } else { o_lo = 8192 + (gw - 1024) * 72; o_hi = o_lo + 72; cur = other(o_lo); }
#pragma unroll
        for (int i = 0; i < 32; ++i) wv[i] = __builtin_nontemporal_load(cur.src + (size_t)(2 * i + (lane >> 5)) * cur.N + (lane & 31));
        if (gw < 1024) {
            for (int kb = 0; kb < D / 64 - 1; ++kb) {
                const P0Item nxt = P0Item{cur.src + (size_t)64 * N0, cur.dst + 64, N0, D};
                p0_item_pipe<true, true>(cur, nxt, wv, mraw, scr, lane, F.meta + 64 * (kb + 1), macc); cur = nxt; }
            { const P0Item nxt = other(o_lo); p0_item_pipe<true, true>(cur, nxt, wv, mraw, scr, lane, F.meta, macc); cur = nxt; }
            const int r = lane & 15, g = lane >> 4;
#pragma unroll
            for (int nh = 0; nh < 2; ++nh) { const float mv[4] = {macc[nh].x, macc[nh].y, macc[nh].z, macc[nh].w};
#pragma unroll
                for (int jj = 0; jj < 4; ++jj) F.Q0[(size_t)(16 + 4 * g + jj) * N0 + 32 * gw + 16 * nh + r] = (bf16)f2bf(mv[jj]); }
        }
        for (int it = o_lo; it < o_hi - 1; ++it) { const P0Item nxt = other(it + 1); p0_item_pipe<false, true>(cur, nxt, wv, mraw, scr, lane, nullptr, macc); cur = nxt; }
        p0_item_pipe<false, false>(cur, cur, wv, mraw, scr, lane, nullptr, macc);
    } else
    for (int it = gw; it < NITEMS; it += NGW) {
        int r = it;
        if (r < I_0) { p0_transpose_item(F.w0in, D, N0, F.WT0IN, scr, r, F.lane); continue; } r -= I_0;
        if (USE_AUX && USE_L0_MFMA == 2 && F.G == 256) break;
        if (r < I_1) { p0_transpose_item(F.w0out, DI, D, F.WT0OUT, scr, r, F.lane); continue; } r -= I_1;
        if (r < I_2) { p0_transpose_item(F.w1in, D, N1, F.WT1IN, scr, r, F.lane); continue; } r -= I_2;
        p0_transpose_item(F.w1out, DI, D, F.WT1OUT, scr, r, F.lane);
    }
#endif
    for (int m = gw; m < MP; m += NGW) {
        GAS unsigned long long* o8 = (GAS unsigned long long*)(F.XB + (size_t)m * D) + F.lane;
        if (m < MR) {
            const float* src = (m < MX) ? F.x + (size_t)m * D : F.meta + (size_t)(m - MX) * D;
            const GAS f32x4* xr = (const GAS f32x4*)src + F.lane;
            f32x4 xv[16];
#pragma unroll
            for (int j = 0; j < 16; ++j) xv[j] = __builtin_nontemporal_load(xr + 64 * j);
#pragma unroll
            for (int j = 0; j < 16; ++j) { const f32x4 v = xv[j]; o8[64 * j] = (unsigned long long)hwpk(v.x, v.y) | ((unsigned long long)hwpk(v.z, v.w) << 32); }
        } else {
#pragma unroll 4
            for (int j = 0; j < 16; ++j) o8[64 * j] = 0ull;
        }
    }
    for (int m = MR + gw; m < MP; m += NGW) {
        GAS unsigned long long* o8 = (GAS unsigned long long*)(F.H1B + (size_t)m * D) + F.lane;
#pragma unroll 4
        for (int j = 0; j < 16; ++j) o8[64 * j] = 0ull;
    }
    for (int i = gw * 64 + F.lane; i < 16 * N0 / 8; i += NGW * 64) { const int col8 = i % (N0 / 8); const unsigned v = (col8 >= DI / 8 && col8 < 2 * DI / 8) ? 0x47004700u : 0u;
        *((GAS v4u*)F.Q0 + i) = (v4u){v, v, v, v}; }
    for (int i = gw * 64 + F.lane; i < GL_R * D; i += NGW * 64) { const int n = i / D, k = i - n * D; F.WG1T[i] = (bf16)f2bf(F.wg1[(size_t)k * GL_R + n]); }
    for (int i = gw * 64 + F.lane; i < 8 * 16 * 2 * 64 * 8; i += NGW * 64) {
        const int e = i & 7, ln = (i >> 3) & 63, fr = i >> 9, m2 = fr & 1, s2 = (fr >> 1) & 15, hh = fr >> 5, rA = ln & 15, gA = ln >> 4;
        float v = 0.f; if (gA < 2) v = F.wg2[(size_t)(8 * gA + e) * 4096 + hh * 512 + 32 * s2 + 8 * (rA >> 2) + 4 * m2 + (rA & 3)];
        F.W2F[i] = (bf16)f2bf(v);
    }
    for (int c = gw * 64 + F.lane; c < DI; c += NGW * 64) {
        const float l0 = F.lb_logits[c], l1 = F.lb_logits[DI + c], l2 = F.lb_logits[2 * DI + c];
        const float mx = fmaxf(l0, fmaxf(l1, l2));
        const float e0 = __expf(l0 - mx), e1 = __expf(l1 - mx), e2 = __expf(l2 - mx);
        F.LB0[c] = e0 / (e0 + e1 + e2);
    }
}

DI_ void p2_l0_rec_naive(Frame& F) {
    LAS float* qs = (LAS float*)(F.lds);
    LAS float* fs = qs + 2048;
    LAS float* ks = fs + 2048;
    LAS float* vs = ks + 2048;
    LAS float* pb = vs + 2048;
    const int tid = F.tid, dv = tid & 127, kg = tid >> 7;
    const int lj = tid >> 5, lc = (tid & 31) * 4;
    for (int u = blockIdx.x; u < NB * HG_H; u += F.G) {
        const int b = u >> 6, h = u & 63;
        float S[32];
#pragma unroll
        for (int i = 0; i < 32; ++i) S[i] = 0.f;
        float lbv[4], bfv[4], ngv[4];
#pragma unroll
        for (int i = 0; i < 4; ++i) { lbv[i] = F.LB0[h * 128 + lc + i]; bfv[i] = F.b_f[h * 128 + lc + i]; ngv[i] = F.ng0[h * 128 + lc + i]; }
        for (int tb = 0; tb < 129; ++tb) {
            const int rbase = (tb == 0) ? MX : b * SEQ + 16 * (tb - 1);
            const bf16* row = F.QFIZ + (size_t)(rbase + lj) * N0 + h * 128 + lc;
            {
                const v2u q4 = *(const GAS v2u*)(row), f4 = *(const GAS v2u*)(row + DI), i4 = *(const GAS v2u*)(row + 2 * DI);
                const float qv[4] = {bflo(q4.x), bfhi(q4.x), bflo(q4.y), bfhi(q4.y)};
                const float fv[4] = {bflo(f4.x), bfhi(f4.x), bflo(f4.y), bfhi(f4.y)};
                const float iv[4] = {bflo(i4.x), bfhi(i4.x), bflo(i4.y), bfhi(i4.y)};
#pragma unroll
                for (int i = 0; i < 4; ++i) {
                    const float fg = lbv[i] + (1.f - lbv[i]) * sigm(fv[i] + bfv[i]);
                    qs[lj * 128 + lc + i] = silu(qv[i]); fs[lj * 128 + lc + i] = fg; ks[lj * 128 + lc + i] = 1.f - fg; vs[lj * 128 + lc + i] = iv[i];
                }
            }
            __syncthreads();
            for (int j = 0; j < 16; ++j) {
                const float vj = vs[j * 128 + dv]; float po = 0.f;
#pragma unroll
                for (int i = 0; i < 32; i += 4) {
                    const f32x4 f4 = *(const LAS f32x4*)(fs + j * 128 + kg * 32 + i), k4 = *(const LAS f32x4*)(ks + j * 128 + kg * 32 + i), q4 = *(const LAS f32x4*)(qs + j * 128 + kg * 32 + i);
                    S[i + 0] = f4.x * S[i + 0] + k4.x * vj; po += q4.x * S[i + 0];
                    S[i + 1] = f4.y * S[i + 1] + k4.y * vj; po += q4.y * S[i + 1];
                    S[i + 2] = f4.z * S[i + 2] + k4.z * vj; po += q4.z * S[i + 2];
                    S[i + 3] = f4.w * S[i + 3] + k4.w * vj; po += q4.w * S[i + 3];
                }
                pb[(j * 4 + kg) * 128 + dv] = po;
            }
            __syncthreads();
            {
                f32x4 o = *(const LAS f32x4*)(pb + (lj * 4 + 0) * 128 + lc);
                o += *(const LAS f32x4*)(pb + (lj * 4 + 1) * 128 + lc);
                o += *(const LAS f32x4*)(pb + (lj * 4 + 2) * 128 + lc);
                o += *(const LAS f32x4*)(pb + (lj * 4 + 3) * 128 + lc);
                float ss = o.x * o.x + o.y * o.y + o.z * o.z + o.w * o.w;
                ss += __shfl_xor(ss, 16); ss += __shfl_xor(ss, 8); ss += __shfl_xor(ss, 4); ss += __shfl_xor(ss, 2); ss += __shfl_xor(ss, 1);
                const float rs = rsqrtf(ss * (1.f / 128.f) + RMS_EPS);
                const v2u z4 = *(const GAS v2u*)(row + 3 * DI);
                const float y0 = o.x * rs * ngv[0] * silu(bflo(z4.x)), y1 = o.y * rs * ngv[1] * silu(bfhi(z4.x));
                const float y2 = o.z * rs * ngv[2] * silu(bflo(z4.y)), y3 = o.w * rs * ngv[3] * silu(bfhi(z4.y));
                if (tb > 0 || b == 0) { v2u w; w.x = pk2(y0, y1); w.y = pk2(y2, y3); *(GAS v2u*)(F.Y + (size_t)(rbase + lj) * DI + h * 128 + lc) = w; }
            }
        }
        __syncthreads();
    }
}

DI_ void ln_phase(Frame& F, const float* src, int nrows, const float* g, const float* bt, float* dst32, bf16* dstb, float* G1) {
    const int gw = F.vcu * NWAVES + F.wave, NGW = F.G * NWAVES;
    for (int r = gw; r < nrows; r += NGW) {
        const GAS f32x4* s = (const GAS f32x4*)(src + (size_t)r * D) + F.lane;
        f32x4 v[16]; float sm = 0.f;
#pragma unroll
        for (int j = 0; j < 16; ++j) { v[j] = s[64 * j]; sm += (v[j].x + v[j].y) + (v[j].z + v[j].w); }
        const float mean = wave_sum(sm) * (1.f / D); float s2 = 0.f;
#pragma unroll
        for (int j = 0; j < 16; ++j) { v[j] = v[j] - mean; s2 += (v[j].x * v[j].x + v[j].y * v[j].y) + (v[j].z * v[j].z + v[j].w * v[j].w); }
        const float rstd = rsqrtf(wave_sum(s2) * (1.f / D) + LN_EPS);
#pragma unroll
        for (int j = 0; j < 16; ++j) {
            const f32x4 gg = *((const GAS f32x4*)g + F.lane + 64 * j), bb = *((const GAS f32x4*)bt + F.lane + 64 * j);
            v[j] = v[j] * rstd * gg + bb;
            if (dst32) *((GAS f32x4*)(dst32 + (size_t)r * D) + F.lane + 64 * j) = v[j];
            if (dstb) { v2u w; w.x = hwpk(v[j].x, v[j].y); w.y = hwpk(v[j].z, v[j].w); *((GAS v2u*)(dstb + (size_t)r * D) + F.lane + 64 * j) = w; }
            if ((j & 3) == 3) asm volatile("" ::: "memory");
        }
        if (G1) {
            LAS float* rowbuf = (LAS float*)(F.lds + RING_OFF + F.wave * 16384);
#pragma unroll
            for (int j = 0; j < 16; ++j) *(LAS f32x4*)(rowbuf + 256 * j + 4 * F.lane) = v[j];
            LDS_WAIT(); asm volatile("" ::: "memory");
            float a[16];
#pragma unroll
            for (int q = 0; q < 16; ++q) a[q] = 0.f;
#pragma unroll 2
            for (int i = 0; i < 64; ++i) {
                const int k = 64 * i + F.lane;
                const float e = rowbuf[k];
                const GAS f32x4* w = (const GAS f32x4*)(F.wg1 + (size_t)k * GL_R);
                const f32x4 w0 = w[0], w1 = w[1], w2 = w[2], w3 = w[3];
                a[0] += e * w0.x; a[1] += e * w0.y; a[2] += e * w0.z; a[3] += e * w0.w;
                a[4] += e * w1.x; a[5] += e * w1.y; a[6] += e * w1.z; a[7] += e * w1.w;
                a[8] += e * w2.x; a[9] += e * w2.y; a[10] += e * w2.z; a[11] += e * w2.w;
                a[12] += e * w3.x; a[13] += e * w3.y; a[14] += e * w3.z; a[15] += e * w3.w;
            }
#pragma unroll
            for (int q = 0; q < 16; ++q) a[q] = wave_sum(a[q]);
            if (F.lane == 0) {
#pragma unroll
                for (int q = 0; q < 16; q += 4) *(GAS f32x4*)(G1 + (size_t)r * GL_R + q) = (f32x4){a[q], a[q + 1], a[q + 2], a[q + 3]};
            }
            LDS_WAIT(); asm volatile("" ::: "memory");
        }
    }
}

DI_ void ln_phase2(Frame& F, const float* src, int nrows, const float* g, const float* bt, float* dst32, bf16* dstb) {
    const int gw = F.vcu * NWAVES + F.wave, NGW = F.G * NWAVES;
    LAS float* gL = (LAS float*)(F.lds + RING_OFF); LAS float* bL = gL + D;
    for (int i = F.tid; i < D / 4; i += NWAVES * 64) { *(LAS f32x4*)(gL + 4 * i) = *((const GAS f32x4*)g + i); *(LAS f32x4*)(bL + 4 * i) = *((const GAS f32x4*)bt + i); }
    __syncthreads();
    f32x4 va[16], vb[16];
#define LN_LOAD(v_, r_) do { const GAS f32x4* s_ = (const GAS f32x4*)(((r_) < nrows) ? src + (size_t)(r_) * D : g) + F.lane; \
        _Pragma("unroll") for (int j = 0; j < 16; ++j) v_[j] = s_[64 * j]; } while (0)
#define LN_PROC(v_, r_) do { float sm = 0.f; \
        _Pragma("unroll") for (int j = 0; j < 16; ++j) sm += (v_[j].x + v_[j].y) + (v_[j].z + v_[j].w); \
        const float mean = wave_sum(sm) * (1.f / D); float s2 = 0.f; \
        _Pragma("unroll") for (int j = 0; j < 16; ++j) { v_[j] = v_[j] - mean; s2 += (v_[j].x * v_[j].x + v_[j].y * v_[j].y) + (v_[j].z * v_[j].z + v_[j].w * v_[j].w); } \
        const float rstd = rsqrtf(wave_sum(s2) * (1.f / D) + LN_EPS); \
        _Pragma("unroll") for (int j = 0; j < 16; ++j) { \
            const f32x4 gg = *(const LAS f32x4*)(gL + 4 * (F.lane + 64 * j)), bb = *(const LAS f32x4*)(bL + 4 * (F.lane + 64 * j)); \
            const f32x4 o_ = v_[j] * rstd * gg + bb; \
            if (dst32) *((GAS f32x4*)(dst32 + (size_t)(r_) * D) + F.lane + 64 * j) = o_; \
            if (dstb) { v2u w_; w_.x = pk2(o_.x, o_.y); w_.y = pk2(o_.z, o_.w); *((GAS v2u*)(dstb + (size_t)(r_) * D) + F.lane + 64 * j) = w_; } \
            if ((j & 3) == 3) asm volatile("" ::: "memory"); } } while (0)
    int r = gw;
    LN_LOAD(va, r);
    while (r < nrows) {
        LN_LOAD(vb, r + NGW);
        LN_PROC(va, r);
        r += NGW; if (r >= nrows) break;
        LN_LOAD(va, r + NGW);
        LN_PROC(vb, r);
        r += NGW;
    }
#undef LN_LOAD
#undef LN_PROC
}

DI_ void p6_l1_rec_naive(Frame& F) {
    LAS float* qs = (LAS float*)(F.lds);
    LAS float* ks = qs + 4096;
    LAS float* gs = ks + 4096;
    LAS float* vs = gs + 4096;
    LAS float* pb = vs + 512;
    const int tid = F.tid, dv = tid & 63, kg = tid >> 6;
    const float qscale = 0.04419417382415922f;
    for (int u = blockIdx.x; u < NB * GL_H * 16; u += F.G) {
        const int dvs = u & 15, bh = u >> 4, b = bh >> 3, h = bh & 7;
        float S[64];
#pragma unroll
        for (int i = 0; i < 64; ++i) S[i] = 0.f;
        float w2[16];
#pragma unroll
        for (int r = 0; r < 16; ++r) w2[r] = F.wg2[(size_t)r * 4096 + h * 512 + tid];
        const float bg = F.b_g[h * 512 + tid];
        for (int tb = 0; tb < 258; ++tb) {
            const int rbase = (tb < 2) ? MX + 8 * tb : b * SEQ + 8 * (tb - 2);
            for (int j = 0; j < 8; ++j) {
                const size_t r = (size_t)(rbase + j);
                const float q = bf2f(F.QFIZ[r * N1 + h * 512 + tid]) * qscale, k = bf2f(F.QFIZ[r * N1 + 4096 + h * 512 + tid]);
                const float* g1 = F.G1 + r * GL_R;
                float xg = bg;
#pragma unroll
                for (int rr = 0; rr < 16; ++rr) xg += g1[rr] * w2[rr];
                const float ls = fminf(xg, 0.f) - log1pf(__expf(-fabsf(xg)));
                qs[j * 512 + tid] = q; ks[j * 512 + tid] = k; gs[j * 512 + tid] = __expf(ls * (1.f / 16.f));
            }
            vs[tid] = bf2f(F.QFIZ[(size_t)(rbase + (tid >> 6)) * N1 + 8192 + h * 1024 + dvs * 64 + (tid & 63)]);
            __syncthreads();
            for (int j = 0; j < 8; ++j) {
                const float vj = vs[j * 64 + dv]; float po = 0.f;
#pragma unroll
                for (int i = 0; i < 64; i += 4) {
                    const f32x4 g4 = *(const LAS f32x4*)(gs + j * 512 + kg * 64 + i), k4 = *(const LAS f32x4*)(ks + j * 512 + kg * 64 + i), q4 = *(const LAS f32x4*)(qs + j * 512 + kg * 64 + i);
                    S[i + 0] = g4.x * S[i + 0] + k4.x * vj; po += q4.x * S[i + 0];
                    S[i + 1] = g4.y * S[i + 1] + k4.y * vj; po += q4.y * S[i + 1];
                    S[i + 2] = g4.z * S[i + 2] + k4.z * vj; po += q4.z * S[i + 2];
                    S[i + 3] = g4.w * S[i + 3] + k4.w * vj; po += q4.w * S[i + 3];
                    if ((i & 12) == 12) asm volatile("" ::: "memory");
                }
                pb[(j * 8 + kg) * 64 + dv] = po;
            }
            __syncthreads();
            {
                const int j = tid >> 6, d = tid & 63; float o = 0.f;
#pragma unroll
                for (int g = 0; g < 8; ++g) o += pb[(j * 8 + g) * 64 + d];
                if (tb >= 2 || b == 0) F.O1[(size_t)(rbase + j) * DI + h * 1024 + dvs * 64 + d] = o;
            }
        }
        __syncthreads();
    }
}

DI_ void p7_normgate(Frame& F) {
    const int gw = F.vcu * NWAVES + F.wave, NGW = F.G * NWAVES;
    for (int it = gw; it < MX * GL_H; it += NGW) {
        const int r = it >> 3, h = it & 7;
        const GAS v4u* o = (const GAS v4u*)((const bf16*)F.O1 + (size_t)r * DI + h * 1024) + F.lane;
        const GAS v4u* zp = (const GAS v4u*)(F.QFIZ + (size_t)r * N1 + 16384 + h * 1024) + F.lane;
        v4u ov[2], zv[2]; float ss = 0.f;
#pragma unroll
        for (int j = 0; j < 2; ++j) { ov[j] = o[64 * j]; zv[j] = zp[64 * j]; }
        float x[2][8];
#pragma unroll
        for (int j = 0; j < 2; ++j) { x[j][0] = bflo(ov[j].x); x[j][1] = bfhi(ov[j].x); x[j][2] = bflo(ov[j].y); x[j][3] = bfhi(ov[j].y); x[j][4] = bflo(ov[j].z); x[j][5] = bfhi(ov[j].z); x[j][6] = bflo(ov[j].w); x[j][7] = bfhi(ov[j].w);
#pragma unroll
            for (int e = 0; e < 8; ++e) ss += x[j][e] * x[j][e]; }
        const float rs = rsqrtf(wave_sum(ss) * (1.f / 1024.f) + RMS_EPS);
#pragma unroll
        for (int j = 0; j < 2; ++j) {
            const int c = h * 1024 + 512 * j + 8 * F.lane;
            const f32x4 n0 = *(const GAS f32x4*)(F.ng1 + c), n1 = *(const GAS f32x4*)(F.ng1 + c + 4);
            const float z[8] = {bflo(zv[j].x), bfhi(zv[j].x), bflo(zv[j].y), bfhi(zv[j].y), bflo(zv[j].z), bfhi(zv[j].z), bflo(zv[j].w), bfhi(zv[j].w)};
            v4u wv; wv.x = pk2(x[j][0] * rs * n0.x * silu(z[0]), x[j][1] * rs * n0.y * silu(z[1])); wv.y = pk2(x[j][2] * rs * n0.z * silu(z[2]), x[j][3] * rs * n0.w * silu(z[3]));
            wv.z = pk2(x[j][4] * rs * n1.x * silu(z[4]), x[j][5] * rs * n1.y * silu(z[5])); wv.w = pk2(x[j][6] * rs * n1.z * silu(z[6]), x[j][7] * rs * n1.w * silu(z[7]));
            *(GAS v4u*)(F.Y + (size_t)r * DI + c) = wv;
        }
    }
}

typedef short bf16x8 __attribute__((ext_vector_type(8)));
#ifndef USE_FUSED_NORM
#define USE_FUSED_NORM 1
#endif
constexpr int NCH = 65;
constexpr int SSP_OFF = 155648 + 512;
constexpr float LOG2E = 1.4426950408889634f;
constexpr int R1_QD = 0, R1_KD = 32768, R1_P = 65536, R1_GL = 67584, R1_SH = 69632;
constexpr int ST1 = R1_SH + 8192;
constexpr int R0_QD = 0, R0_KD = 8192, R0_P = 16384, R0_V = 18432, R0_GL = 26624, R0_SZ = 27648;
constexpr int ST0 = R0_SZ;

DI_ unsigned cvtpk(float lo, float hi) { unsigned r; asm volatile("v_cvt_pk_bf16_f32 %0, %1, %2" : "=v"(r) : "v"(lo), "v"(hi)); return r; }
template <int N> DI_ float row_shr(float x) { return __builtin_bit_cast(float, __builtin_amdgcn_update_dpp(0, __builtin_bit_cast(int, x), 0x110 + N, 0xF, 0xF, true)); }
DI_ float bcast15(float x) { return __builtin_bit_cast(float, __builtin_amdgcn_update_dpp(0, __builtin_bit_cast(int, x), 0x15F, 0xF, 0xF, true)); }
DI_ float scan16(float x) { x += row_shr<1>(x); x += row_shr<2>(x); x += row_shr<4>(x); x += row_shr<8>(x); return x; }
DI_ float ex2(float x) { return __builtin_amdgcn_exp2f(x); }
DI_ float lg2(float x) { return __builtin_amdgcn_logf(x); }
DI_ int row_of(int b, int c, int tok) { return c == 0 ? MX + tok - 16 : b * SEQ + 32 * (c - 1) + tok; }
DI_ bf16x8 mk8(unsigned a, unsigned b, unsigned c, unsigned d) { v4u t; t.x = a; t.y = b; t.z = c; t.w = d; return __builtin_bit_cast(bf16x8, t); }
#define MFMA16(a, b, c) __builtin_amdgcn_mfma_f32_16x16x32_bf16((a), (b), (c), 0, 0, 0)

DI_ void l1_prep(Frame& F, unsigned char* REC1, unsigned char* VF1, const bf16* W2F) {
    const int lane = F.lane, w = F.wave, r = lane & 15, g = lane >> 4;
    LAS unsigned char* T = F.lds + w * 16384;
    LAS unsigned char* Tv = F.lds + w * 16384 + 4096;
    LAS f32x4* Pp = (LAS f32x4*)(F.lds + 131072);
    const float qscale = 0.04419417382415922f;
    v4u qn[2][2], kn[2][2]; f32x4 gn[2][2];
#define L1P_LOAD(it_) do { const int bh_ = (it_) / NCH, c_ = (it_) - bh_ * NCH, b_ = bh_ >> 3, h_ = bh_ & 7; \
        _Pragma("unroll") for (int ti = 0; ti < 2; ++ti) { const int tok_ = 16 * ti + r; const int row_ = (c_ == 0 && tok_ < 16) ? 0 : row_of(b_, c_, tok_); \
            const GAS f32x4* gp = (const GAS f32x4*)(F.G1 + (size_t)row_ * GL_R + 8 * (g & 1)); gn[ti][0] = gp[0]; gn[ti][1] = gp[1]; \
            _Pragma("unroll") for (int si = 0; si < 2; ++si) { const bf16* rp = F.QFIZ + (size_t)row_ * N1 + h_ * 512 + 32 * (2 * w + si) + 8 * g; qn[si][ti] = *(const GAS v4u*)rp; kn[si][ti] = *(const GAS v4u*)(rp + 4096); } } } while (0)
    if ((int)blockIdx.x < NB * GL_H * NCH) L1P_LOAD((int)blockIdx.x);
    for (int it = blockIdx.x; it < NB * GL_H * NCH; it += F.G) {
        const int bh = it / NCH, c = it - bh * NCH, b = bh >> 3, h = bh & 7;
        unsigned char* rec = REC1 + (size_t)it * R1_SH;
        bool nul[2];
#pragma unroll
        for (int ti = 0; ti < 2; ++ti) { const int tok = 16 * ti + r; nul[ti] = (c == 0 && tok < 16); }
        bf16x8 g1f[2];
#pragma unroll
        for (int ti = 0; ti < 2; ++ti) {
            const f32x4 t0 = (g < 2) ? gn[ti][0] : (f32x4){0.f, 0.f, 0.f, 0.f}, t1 = (g < 2) ? gn[ti][1] : (f32x4){0.f, 0.f, 0.f, 0.f};
            g1f[ti] = mk8(pk2(t0.x, t0.y), pk2(t0.z, t0.w), pk2(t1.x, t1.y), pk2(t1.z, t1.w));
        }
        f32x4 pacc[3];
#pragma unroll
        for (int t = 0; t < 3; ++t) pacc[t] = (f32x4){0.f, 0.f, 0.f, 0.f};
        v4u qraw[2][2], kraw[2][2];
#pragma unroll
        for (int si = 0; si < 2; ++si)
#pragma unroll
            for (int ti = 0; ti < 2; ++ti) { qraw[si][ti] = qn[si][ti]; kraw[si][ti] = kn[si][ti]; }
        f32x4 bg[2][2]; bf16x8 wfr[2][2];
#pragma unroll
        for (int si = 0; si < 2; ++si) { const int s = 2 * w + si, col = h * 512 + 32 * s + 8 * g;
            bg[si][0] = *(const GAS f32x4*)(F.b_g + col); bg[si][1] = *(const GAS f32x4*)(F.b_g + col + 4);
            wfr[si][0] = *(const GAS bf16x8*)(W2F + ((size_t)((h * 16 + s) * 2 + 0) * 64 + lane) * 8); wfr[si][1] = *(const GAS bf16x8*)(W2F + ((size_t)((h * 16 + s) * 2 + 1) * 64 + lane) * 8); }
        { const int nx = (it + F.G < NB * GL_H * NCH) ? it + F.G : it; L1P_LOAD(nx); }
        v4u vraw[8];
        if (USE_L1_SEQ2) {
#pragma unroll
            for (int i2 = 0; i2 < 8; ++i2) { const int q = lane + 64 * i2, tk = q >> 4, c16 = q & 15; const int vrow = (c == 0) ? MX - 16 + tk : b * SEQ + 32 * (c - 1) + tk;
                vraw[i2] = *(const GAS v4u*)(F.QFIZ + (size_t)vrow * N1 + 8192 + h * 1024 + 128 * w + 8 * c16); }
        }
        asm volatile("" ::: "memory");
#pragma unroll
        for (int si = 0; si < 2; ++si) {
            const int s = 2 * w + si, col = h * 512 + 32 * s + 8 * g;
            float xg[2][8];
            { const f32x4 b0 = bg[si][0], b1 = bg[si][1];
              const bf16x8 wa = wfr[si][0], wb = wfr[si][1];
#pragma unroll
              for (int ti = 0; ti < 2; ++ti) { const f32x4 xa = MFMA16(wa, g1f[ti], b0), xb = MFMA16(wb, g1f[ti], b1);
                  xg[ti][0] = xa.x; xg[ti][1] = xa.y; xg[ti][2] = xa.z; xg[ti][3] = xa.w; xg[ti][4] = xb.x; xg[ti][5] = xb.y; xg[ti][6] = xb.z; xg[ti][7] = xb.w; } }
            float qv[2][8], kv[2][8];
#pragma unroll
            for (int ti = 0; ti < 2; ++ti) {
                const v4u q4 = qraw[si][ti], k4 = kraw[si][ti];
                qv[ti][0] = bflo(q4.x); qv[ti][1] = bfhi(q4.x); qv[ti][2] = bflo(q4.y); qv[ti][3] = bfhi(q4.y); qv[ti][4] = bflo(q4.z); qv[ti][5] = bfhi(q4.z); qv[ti][6] = bflo(q4.w); qv[ti][7] = bfhi(q4.w);
                kv[ti][0] = bflo(k4.x); kv[ti][1] = bfhi(k4.x); kv[ti][2] = bflo(k4.y); kv[ti][3] = bfhi(k4.y); kv[ti][4] = bflo(k4.z); kv[ti][5] = bfhi(k4.z); kv[ti][6] = bflo(k4.w); kv[ti][7] = bfhi(k4.w);
            }
            unsigned qd[2][4], ki[2][4], kd[2][4]; float gl[8];
#pragma unroll
            for (int e = 0; e < 8; e += 2) {
                float bb[2][2], BB[2];
#pragma unroll
                for (int u = 0; u < 2; ++u) {
                    float L0 = nul[0] ? 0.f : (fminf(xg[0][e + u], 0.f) * LOG2E - lg2(1.f + ex2(-fabsf(xg[0][e + u]) * LOG2E))) * (1.f / 16.f);
                    float L1 = nul[1] ? 0.f : (fminf(xg[1][e + u], 0.f) * LOG2E - lg2(1.f + ex2(-fabsf(xg[1][e + u]) * LOG2E))) * (1.f / 16.f);
                    const float b0 = scan16(L0);
                    const float b1 = scan16(L1) + bcast15(b0);
                    bb[0][u] = b0; bb[1][u] = b1; BB[u] = bcast15(b1);
                    gl[e + u] = ex2(BB[u]);
                }
#pragma unroll
                for (int ti = 0; ti < 2; ++ti) {
                    const float q0 = nul[ti] ? 0.f : qv[ti][e] * qscale, q1 = nul[ti] ? 0.f : qv[ti][e + 1] * qscale;
                    const float k0 = nul[ti] ? 0.f : kv[ti][e], k1 = nul[ti] ? 0.f : kv[ti][e + 1];
                    const float ki0 = k0 * ex2(-bb[ti][0]), ki1 = k1 * ex2(-bb[ti][1]);
                    qd[ti][e >> 1] = cvtpk(q0 * ex2(bb[ti][0]), q1 * ex2(bb[ti][1]));
                    ki[ti][e >> 1] = cvtpk(ki0, ki1);
                    kd[ti][e >> 1] = cvtpk(ki0 * gl[e], ki1 * gl[e + 1]);
                }
            }
            const bf16x8 qf0 = mk8(qd[0][0], qd[0][1], qd[0][2], qd[0][3]), qf1 = mk8(qd[1][0], qd[1][1], qd[1][2], qd[1][3]);
            const bf16x8 kf0 = mk8(ki[0][0], ki[0][1], ki[0][2], ki[0][3]), kf1 = mk8(ki[1][0], ki[1][1], ki[1][2], ki[1][3]);
            pacc[0] = MFMA16(kf0, qf0, pacc[0]);
            pacc[1] = MFMA16(kf0, qf1, pacc[1]);
            pacc[2] = MFMA16(kf1, qf1, pacc[2]);
#pragma unroll
            for (int ti = 0; ti < 2; ++ti)
#pragma unroll
                for (int h2 = 0; h2 < 2; ++h2) {
                    const int lp = (2 * (g & 1) + h2) * 16 + r;
                    v2u d; d.x = qd[ti][2 * h2]; d.y = qd[ti][2 * h2 + 1];
                    *(GAS v2u*)(rec + R1_QD + ((ti * 16 + s) * 64 + lp) * 16 + (g >> 1) * 8) = d;
                }
#pragma unroll
            for (int ti = 0; ti < 2; ++ti)
#pragma unroll
                for (int e = 0; e < 8; ++e) {
                    const unsigned wd = kd[ti][e >> 1]; const unsigned short hv = (e & 1) ? (unsigned short)(wd >> 16) : (unsigned short)(wd & 0xffffu);
                    *(LAS unsigned short*)(T + (32 * si + 8 * g + e) * 64 + (16 * ti + r) * 2) = hv;
                }
            if (r == 0) { *(GAS f32x4*)(rec + R1_GL + (32 * s + 8 * g) * 4) = (f32x4){gl[0], gl[1], gl[2], gl[3]}; *(GAS f32x4*)(rec + R1_GL + (32 * s + 8 * g + 4) * 4) = (f32x4){gl[4], gl[5], gl[6], gl[7]}; }
        }
#pragma unroll
        for (int t = 0; t < 3; ++t) Pp[(w * 3 + t) * 64 + lane] = pacc[t];
        if (USE_L1_SEQ2) {
#pragma unroll
            for (int i2 = 0; i2 < 8; ++i2) { const int q = lane + 64 * i2, tk = q >> 4, c16 = q & 15; const v4u d = vraw[i2];
                *(LAS v2u*)(Tv + tk * 264 + c16 * 16) = (v2u){d.x, d.y}; *(LAS v2u*)(Tv + tk * 264 + c16 * 16 + 8) = (v2u){d.z, d.w}; }
        }
        LDS_WAIT(); asm volatile("" ::: "memory");
        if (USE_L1_SEQ2) {
#pragma unroll
            for (int sl = 0; sl < 8; ++sl) { unsigned short hv[8];
#pragma unroll
                for (int e = 0; e < 8; ++e) hv[e] = *(const LAS unsigned short*)(Tv + (8 * g + e) * 264 + (16 * sl + r) * 2);
                v4u d; d.x = hv[0] | ((unsigned)hv[1] << 16); d.y = hv[2] | ((unsigned)hv[3] << 16); d.z = hv[4] | ((unsigned)hv[5] << 16); d.w = hv[6] | ((unsigned)hv[7] << 16);
                *(GAS v4u*)(VF1 + ((size_t)it * 64 + 8 * w + sl) * 1024 + lane * 16) = d; }
        }
#pragma unroll
        for (int ml = 0; ml < 4; ++ml) { const v4u d = *(const LAS v4u*)(T + (16 * ml + r) * 64 + 16 * g); *(GAS v4u*)(rec + R1_KD + ((4 * w + ml) * 64 + lane) * 16) = d; }
        __syncthreads();
        if (w < 4) {
            const int tj = (w == 2 || w == 3) ? 1 : 0, ti = (w == 1 || w == 2) ? 1 : 0;
            f32x4 sum = (f32x4){0.f, 0.f, 0.f, 0.f};
            if (w < 3) {
#pragma unroll
                for (int ww = 0; ww < 8; ++ww) sum += Pp[(ww * 3 + w) * 64 + lane];
            }
            float pv[4] = {sum.x, sum.y, sum.z, sum.w};
#pragma unroll
            for (int jj = 0; jj < 4; ++jj) { const int j = 16 * tj + 4 * g + jj, i = 16 * ti + r; if (j > i) pv[jj] = 0.f; }
            const int lp = (2 * tj + (g >> 1)) * 16 + r;
            v2u d; d.x = cvtpk(pv[0], pv[1]); d.y = cvtpk(pv[2], pv[3]);
            *(GAS v2u*)(rec + R1_P + (ti * 64 + lp) * 16 + 8 * (g & 1)) = d;
        }
        __syncthreads();
    }
}
#undef L1P_LOAD

template <int VAR> DI_ void l1_seq(Frame& F, const unsigned char* REC1, const unsigned char* VF1, float* O1, float* SS) {
    const int lane = F.lane, w = F.wave, r = lane & 15, g = lane >> 4;
    for (int u = F.vcu; u < NB * GL_H * 8; u += F.G) {
        const int bh = u >> 3, ds = u & 7, b = bh >> 3, h = bh & 7;
        f32x4 acc[32];
#pragma unroll
        for (int m = 0; m < 32; ++m) acc[m] = (f32x4){0.f, 0.f, 0.f, 0.f};
#define L1_DMA(c_) do { const unsigned char* rs_ = REC1 + (size_t)(bh * NCH + (c_)) * R1_SH; LAS unsigned char* st_ = F.lds + ((c_) & 1) * ST1; \
        for (int p_ = w; p_ < 76; p_ += 8) { const unsigned char* src_; \
            if (p_ < 68) src_ = rs_ + p_ * 1024 + lane * 16; \
            else { const int tk_ = 4 * (p_ - 68) + (lane >> 4);         \
                   src_ = ((c_) == 0 && tk_ < 16) ? (const unsigned char*)(F.H1B + (size_t)MR * D) + (lane & 15) * 16 \
                        : (const unsigned char*)(F.QFIZ + (size_t)row_of(b, (c_), tk_) * N1 + 8192 + h * 1024 + ds * 128) + (lane & 15) * 16; } \
            __builtin_amdgcn_global_load_lds((const unsigned*)src_, (LAS unsigned*)(st_ + p_ * 1024), 16, 0, 0); } } while (0)
        const int ycol = h * 1024 + ds * 128 + 16 * w + 4 * g;
        const f32x4 ng4 = *(const GAS f32x4*)(F.ng1 + ycol);
        const bf16* xz = F.QFIZ + (size_t)(b * SEQ - 32) * N1 + 16384 + ycol;
        v2u zc0 = (v2u){0u, 0u}, zc1 = zc0, zn0 = zc0, zn1 = zc0;
        if (VAR != 1) L1_DMA(0);
        for (int c = 0; c < NCH; ++c) {
            asm volatile("s_waitcnt vmcnt(0) lgkmcnt(0)" ::: "memory");
            __builtin_amdgcn_s_barrier();
            asm volatile("" ::: "memory");
            if (VAR != 1 && c + 1 < NCH) L1_DMA(c + 1);
            if (USE_FUSED_NORM && VAR == 0 && c >= 2 && w == 0 && lane < 32) {
                const LAS float* pp = (const LAS float*)(F.lds + SSP_OFF) + ((c - 1) & 1) * 256 + lane; float sm = 0.f;
#pragma unroll
                for (int ww = 0; ww < 8; ++ww) sm += pp[ww * 32];
                SS[(size_t)(b * SEQ + 32 * (c - 2) + lane) * 64 + h * 8 + ds] = sm; }
            if (USE_FUSED_NORM && c + 1 < NCH) { const bf16* zp = xz + (size_t)((c + 1) * 32 + r) * N1; zn0 = *(const GAS v2u*)zp; zn1 = *(const GAS v2u*)(zp + (size_t)16 * N1); }
            if (VAR == 2) continue;
            const LAS unsigned char* st = F.lds + (c & 1) * ST1;
            unsigned short vh[8];
#pragma unroll
            for (int e = 0; e < 8; ++e) vh[e] = *(const LAS unsigned short*)(st + R1_SH + (8 * g + e) * 256 + (16 * w + r) * 2);
            const bf16x8 vf = mk8(vh[0] | ((unsigned)vh[1] << 16), vh[2] | ((unsigned)vh[3] << 16), vh[4] | ((unsigned)vh[5] << 16), vh[6] | ((unsigned)vh[7] << 16));
#define SCHED_FENCE() __builtin_amdgcn_sched_barrier(0)
            if (c > 0) {
                f32x4 o0 = (f32x4){0.f, 0.f, 0.f, 0.f}, o1 = o0;
                bf16x8 qb[2][4];
#define LDQ(buf_, gi_) do { _Pragma("unroll") for (int sl_ = 0; sl_ < 2; ++sl_) { qb[buf_][sl_] = *(const LAS bf16x8*)(st + R1_QD + (2 * (gi_) + sl_) * 1024 + lane * 16); \
                    qb[buf_][2 + sl_] = *(const LAS bf16x8*)(st + R1_QD + (16 + 2 * (gi_) + sl_) * 1024 + lane * 16); } } while (0)
                const bf16x8 p0 = *(const LAS bf16x8*)(st + R1_P + lane * 16), p1 = *(const LAS bf16x8*)(st + R1_P + 1024 + lane * 16);
                LDQ(0, 0);
                SCHED_FENCE();
                o0 = MFMA16(vf, p0, o0); o1 = MFMA16(vf, p1, o1);
#pragma unroll
                for (int gi = 0; gi < 8; ++gi) {
                    if (gi < 7) LDQ((gi + 1) & 1, gi + 1);
                    SCHED_FENCE();
#pragma unroll
                    for (int sl = 0; sl < 2; ++sl) { const int s2 = 2 * gi + sl;
                        const bf16x8 sb = mk8(cvtpk(acc[2 * s2].x, acc[2 * s2].y), cvtpk(acc[2 * s2].z, acc[2 * s2].w), cvtpk(acc[2 * s2 + 1].x, acc[2 * s2 + 1].y), cvtpk(acc[2 * s2 + 1].z, acc[2 * s2 + 1].w));
                        o0 = MFMA16(sb, qb[gi & 1][sl], o0); o1 = MFMA16(sb, qb[gi & 1][2 + sl], o1); }
                    SCHED_FENCE();
                }
#undef LDQ
                if (VAR == 1) { asm volatile("" :: "v"(o0), "v"(o1)); } else if (USE_FUSED_NORM) {
                    float t0 = (o0.x * o0.x + o0.y * o0.y) + (o0.z * o0.z + o0.w * o0.w), t1 = (o1.x * o1.x + o1.y * o1.y) + (o1.z * o1.z + o1.w * o1.w);
                    t0 += __shfl_xor(t0, 16); t1 += __shfl_xor(t1, 16); t0 += __shfl_xor(t0, 32); t1 += __shfl_xor(t1, 32);
                    const int row0 = b * SEQ + 32 * (c - 1) + r;
                    if (g == 0) { LAS float* pp = (LAS float*)(F.lds + SSP_OFF) + ((c & 1) * 8 + w) * 32; pp[r] = t0; pp[16 + r] = t1; }
                    const float y0 = o0.x * ng4.x * silu(bflo(zc0.x)), y1 = o0.y * ng4.y * silu(bfhi(zc0.x)), y2 = o0.z * ng4.z * silu(bflo(zc0.y)), y3 = o0.w * ng4.w * silu(bfhi(zc0.y));
                    const float y4 = o1.x * ng4.x * silu(bflo(zc1.x)), y5 = o1.y * ng4.y * silu(bfhi(zc1.x)), y6 = o1.z * ng4.z * silu(bflo(zc1.y)), y7 = o1.w * ng4.w * silu(bfhi(zc1.y));
                    bf16* op = F.Y + (size_t)row0 * DI + ycol;
                    *(GAS v2u*)op = (v2u){cvtpk(y0, y1), cvtpk(y2, y3)}; *(GAS v2u*)(op + (size_t)16 * DI) = (v2u){cvtpk(y4, y5), cvtpk(y6, y7)};
                } else {
                    bf16* op = (bf16*)O1 + (size_t)(b * SEQ + 32 * (c - 1) + r) * DI + h * 1024 + ds * 128 + 16 * w + 4 * g;
                    *(GAS v2u*)op = (v2u){pk2(o0.x, o0.y), pk2(o0.z, o0.w)}; *(GAS v2u*)(op + (size_t)16 * DI) = (v2u){pk2(o1.x, o1.y), pk2(o1.z, o1.w)}; }
            }
            {
                f32x4 ug[2][4]; bf16x8 uk[2][4];
#define LDU(buf_, gi_) do { _Pragma("unroll") for (int ml_ = 0; ml_ < 4; ++ml_) { const int m_ = 4 * (gi_) + ml_; ug[buf_][ml_] = *(const LAS f32x4*)(st + R1_GL + (16 * m_ + 4 * g) * 4); \
                    uk[buf_][ml_] = *(const LAS bf16x8*)(st + R1_KD + m_ * 1024 + lane * 16); } } while (0)
                LDU(0, 0);
                SCHED_FENCE();
#pragma unroll
                for (int gi = 0; gi < 8; ++gi) {
                    if (gi < 7) LDU((gi + 1) & 1, gi + 1);
                    SCHED_FENCE();
#pragma unroll
                    for (int ml = 0; ml < 4; ++ml) { const int m = 4 * gi + ml; acc[m] = MFMA16(uk[gi & 1][ml], vf, acc[m] * ug[gi & 1][ml]); }
                    SCHED_FENCE();
                }
#undef LDU
            }
            if (USE_FUSED_NORM) { zc0 = zn0; zc1 = zn1; }
        }
#undef L1_DMA
        if (VAR == 1) { _Pragma("unroll") for (int m = 0; m < 32; ++m) asm volatile("" :: "v"(acc[m])); }
        asm volatile("s_waitcnt vmcnt(0) lgkmcnt(0)" ::: "memory");
        __builtin_amdgcn_s_barrier();
        if (USE_FUSED_NORM && VAR == 0 && w == 0 && lane < 32) {
            const LAS float* pp = (const LAS float*)(F.lds + SSP_OFF) + ((NCH - 1) & 1) * 256 + lane; float sm = 0.f;
#pragma unroll
            for (int ww = 0; ww < 8; ++ww) sm += pp[ww * 32];
            SS[(size_t)(b * SEQ + 32 * (NCH - 2) + lane) * 64 + h * 8 + ds] = sm; }
        asm volatile("s_waitcnt vmcnt(0) lgkmcnt(0)" ::: "memory");
    }
}

constexpr int R2_QD = 0, R2_KD = 32768, R2_P = 65536, R2_GL = 67584, ST2 = 69632, X2_OFF = 2 * ST2;
DI_ void l1_seq2(Frame& F, const unsigned char* REC1, const unsigned char* VF1, float* SS) {
    const int lane = F.lane, w = F.wave, r = lane & 15, g = lane >> 4, dkh = w >> 2, dvq = w & 3;
    for (int u = F.vcu; u < NB * GL_H * 8; u += F.G) {
        const int bh = u >> 3, ds = u & 7, b = bh >> 3, h = bh & 7;
        f32x4 acc[16][2];
#pragma unroll
        for (int m = 0; m < 16; ++m) { acc[m][0] = (f32x4){0.f, 0.f, 0.f, 0.f}; acc[m][1] = acc[m][0]; }
        const int ycol = h * 1024 + ds * 128 + 32 * dvq + 16 * dkh + 4 * g;
        const f32x4 ng4 = *(const GAS f32x4*)(F.ng1 + ycol);
        const bf16* xz = F.QFIZ + (size_t)(b * SEQ - 32) * N1 + 16384 + ycol;
        const unsigned char* vfb = VF1 + ((size_t)bh * NCH * 64 + ds * 8 + 2 * dvq) * 1024 + lane * 16;
#define L2_DMA(c_) do { const unsigned char* rs_ = REC1 + (size_t)(bh * NCH + (c_)) * R1_SH; LAS unsigned char* st_ = F.lds + ((c_) & 1) * ST2; \
        _Pragma("unroll") for (int i_ = 0; i_ < 8; ++i_) { const int p_ = w + 8 * i_; __builtin_amdgcn_global_load_lds((const unsigned*)(rs_ + p_ * 1024 + lane * 16), (LAS unsigned*)(st_ + p_ * 1024), 16, 0, 0); } \
        if (w < 4) __builtin_amdgcn_global_load_lds((const unsigned*)(rs_ + (w + 64) * 1024 + lane * 16), (LAS unsigned*)(st_ + (w + 64) * 1024), 16, 0, 0); } while (0)
        v4u vfr[2][2];
        v2u zr[2][2];
        f32x4 keep[2][2];
        vfr[0][0] = *(const GAS v4u*)(vfb); vfr[0][1] = *(const GAS v4u*)(vfb + 1024);
        zr[0][0] = (v2u){0u, 0u}; zr[0][1] = zr[0][0];
        L2_DMA(0);
#define L2_BODY(C_, PAR) do { const int c = (C_); \
            asm volatile("s_waitcnt vmcnt(0) lgkmcnt(0)" ::: "memory"); \
            __builtin_amdgcn_s_barrier(); \
            asm volatile("" ::: "memory"); \
            if (c >= 3 && c <= NCH + 1 && w == 0 && lane < 32) {                  \
                const LAS float* pp = (const LAS float*)(F.lds + SSP_OFF) + PAR * 256 + lane; float sm = 0.f; \
                _Pragma("unroll") for (int ww = 0; ww < 8; ++ww) sm += pp[ww * 32]; \
                SS[(size_t)(b * SEQ + 32 * (c - 3) + lane) * 64 + h * 8 + ds] = sm; } \
            if (c >= 2 && c <= NCH) {                                  \
                const v4u px = *(const LAS v4u*)(F.lds + X2_OFF + (PAR ^ 1) * 8192 + (w ^ 4) * 1024 + lane * 16); \
                const f32x4 a0 = keep[PAR ^ 1][0] + (f32x4){bflo(px.x), bfhi(px.x), bflo(px.y), bfhi(px.y)}, a1 = keep[PAR ^ 1][1] + (f32x4){bflo(px.z), bfhi(px.z), bflo(px.w), bfhi(px.w)}; \
                float t0 = (a0.x * a0.x + a0.y * a0.y) + (a0.z * a0.z + a0.w * a0.w), t1 = (a1.x * a1.x + a1.y * a1.y) + (a1.z * a1.z + a1.w * a1.w); \
                t0 += __shfl_xor(t0, 16); t1 += __shfl_xor(t1, 16); t0 += __shfl_xor(t0, 32); t1 += __shfl_xor(t1, 32); \
                if (g == 0) { LAS float* pp = (LAS float*)(F.lds + SSP_OFF) + ((PAR ^ 1) * 8 + w) * 32; pp[r] = t0; pp[16 + r] = t1; } \
                const v2u z0 = zr[PAR ^ 1][0], z1 = zr[PAR ^ 1][1]; \
                bf16* op = F.Y + (size_t)(b * SEQ + 32 * (c - 2) + r) * DI + ycol; \
                *(GAS v2u*)op = (v2u){cvtpk(a0.x * ng4.x * silu(bflo(z0.x)), a0.y * ng4.y * silu(bfhi(z0.x))), cvtpk(a0.z * ng4.z * silu(bflo(z0.y)), a0.w * ng4.w * silu(bfhi(z0.y)))}; \
                *(GAS v2u*)(op + (size_t)16 * DI) = (v2u){cvtpk(a1.x * ng4.x * silu(bflo(z1.x)), a1.y * ng4.y * silu(bfhi(z1.x))), cvtpk(a1.z * ng4.z * silu(bflo(z1.y)), a1.w * ng4.w * silu(bfhi(z1.y)))}; } \
            if (c + 1 < NCH) {                                         \
                vfr[PAR ^ 1][0] = *(const GAS v4u*)(vfb + (size_t)(c + 1) * 65536); vfr[PAR ^ 1][1] = *(const GAS v4u*)(vfb + (size_t)(c + 1) * 65536 + 1024); \
                { const bf16* zp = xz + (size_t)((c + 1) * 32 + r) * N1; zr[PAR ^ 1][0] = *(const GAS v2u*)zp; zr[PAR ^ 1][1] = *(const GAS v2u*)(zp + (size_t)16 * N1); } \
                L2_DMA(c + 1); } \
            if (c < NCH) { \
                const LAS unsigned char* st = F.lds + (c & 1) * ST2; \
                bf16x8 vf[2]; vf[0] = __builtin_bit_cast(bf16x8, vfr[PAR][0]); vf[1] = __builtin_bit_cast(bf16x8, vfr[PAR][1]); \
                const LAS f32x4* glp = (const LAS f32x4*)(st + R2_GL + (256 * dkh + 4 * g) * 4); \
                f32x4 ug[2][2]; bf16x8 uk[2][2]; \
                if (c > 0) { \
                    f32x4 o[2][2]; \
                    _Pragma("unroll") for (int ti = 0; ti < 2; ++ti) { o[ti][0] = (f32x4){0.f, 0.f, 0.f, 0.f}; o[ti][1] = o[ti][0]; } \
                    if (dkh == 0) { const bf16x8 p0 = *(const LAS bf16x8*)(st + R2_P + lane * 16), p1 = *(const LAS bf16x8*)(st + R2_P + 1024 + lane * 16); \
                        o[0][0] = MFMA16(vf[0], p0, o[0][0]); o[0][1] = MFMA16(vf[1], p0, o[0][1]); o[1][0] = MFMA16(vf[0], p1, o[1][0]); o[1][1] = MFMA16(vf[1], p1, o[1][1]); } \
                    bf16x8 qb[2][2]; \
                    qb[0][0] = *(const LAS bf16x8*)(st + R2_QD + (8 * dkh) * 1024 + lane * 16); qb[0][1] = *(const LAS bf16x8*)(st + R2_QD + (16 + 8 * dkh) * 1024 + lane * 16); \
                    SCHED_FENCE(); \
                    _Pragma("unroll") for (int s2 = 0; s2 < 8; ++s2) { \
                        if (s2 < 7) { qb[(s2 + 1) & 1][0] = *(const LAS bf16x8*)(st + R2_QD + (8 * dkh + s2 + 1) * 1024 + lane * 16); qb[(s2 + 1) & 1][1] = *(const LAS bf16x8*)(st + R2_QD + (16 + 8 * dkh + s2 + 1) * 1024 + lane * 16); } \
                        SCHED_FENCE(); \
                        _Pragma("unroll") for (int t_ = 0; t_ < 2; ++t_) { \
                            const bf16x8 sb = mk8(cvtpk(acc[2 * s2][t_].x, acc[2 * s2][t_].y), cvtpk(acc[2 * s2][t_].z, acc[2 * s2][t_].w), cvtpk(acc[2 * s2 + 1][t_].x, acc[2 * s2 + 1][t_].y), cvtpk(acc[2 * s2 + 1][t_].z, acc[2 * s2 + 1][t_].w)); \
                            o[0][t_] = MFMA16(sb, qb[s2 & 1][0], o[0][t_]); o[1][t_] = MFMA16(sb, qb[s2 & 1][1], o[1][t_]); } \
                        SCHED_FENCE(); \
                    } \
                    { const f32x4 s0 = o[0][dkh ^ 1], s1 = o[1][dkh ^ 1];                    \
                      *(LAS v4u*)(F.lds + X2_OFF + PAR * 8192 + w * 1024 + lane * 16) = (v4u){pk2(s0.x, s0.y), pk2(s0.z, s0.w), pk2(s1.x, s1.y), pk2(s1.z, s1.w)}; \
                      keep[PAR][0] = o[0][dkh]; keep[PAR][1] = o[1][dkh]; } \
                } \
                _Pragma("unroll") for (int ml_ = 0; ml_ < 2; ++ml_) { ug[0][ml_] = glp[4 * ml_]; uk[0][ml_] = *(const LAS bf16x8*)(st + R2_KD + (16 * dkh + ml_) * 1024 + lane * 16); } \
                SCHED_FENCE(); \
                _Pragma("unroll") for (int gi = 0; gi < 8; ++gi) { \
                    if (gi < 7) { _Pragma("unroll") for (int ml_ = 0; ml_ < 2; ++ml_) { const int m_ = 2 * (gi + 1) + ml_; ug[(gi + 1) & 1][ml_] = glp[4 * m_]; uk[(gi + 1) & 1][ml_] = *(const LAS bf16x8*)(st + R2_KD + (16 * dkh + m_) * 1024 + lane * 16); } } \
                    SCHED_FENCE(); \
                    _Pragma("unroll") for (int ml = 0; ml < 2; ++ml) { const int m = 2 * gi + ml; \
                        acc[m][0] = MFMA16(uk[gi & 1][ml], vf[0], acc[m][0] * ug[gi & 1][ml]); acc[m][1] = MFMA16(uk[gi & 1][ml], vf[1], acc[m][1] * ug[gi & 1][ml]); } \
                    SCHED_FENCE(); \
                } \
            } \
            asm volatile("" : "+v"(vfr[PAR ^ 1][0]), "+v"(vfr[PAR ^ 1][1]), "+v"(zr[PAR ^ 1][0]), "+v"(zr[PAR ^ 1][1]));        \
        } while (0)
        for (int c2 = 0; c2 <= NCH + 1; c2 += 2) { L2_BODY(c2, 0); L2_BODY(c2 + 1, 1); }
#undef L2_BODY
#undef L2_DMA
        asm volatile("s_waitcnt vmcnt(0) lgkmcnt(0)" ::: "memory");
        __builtin_amdgcn_s_barrier();
    }
}

DI_ void l0_prep(Frame& F, unsigned char* REC0) {
    const int lane = F.lane, w = F.wave, r = lane & 15, g = lane >> 4;
    LAS unsigned char* T = F.lds + w * 16640;
    LAS unsigned char* Tv = T + 8192;
    const int gw = F.vcu * NWAVES + w, NGW = F.G * NWAVES;
    for (int it = gw; it < NB * HG_H * NCH; it += NGW) {
        const int bh = it / NCH, c = it - bh * NCH, b = bh >> 6, h = bh & 63;
        unsigned char* rec = REC0 + (size_t)it * R0_SZ;
        int row[2]; bool nul[2];
#pragma unroll
        for (int ti = 0; ti < 2; ++ti) { const int tok = 16 * ti + r; nul[ti] = (c == 0 && tok < 16); row[ti] = nul[ti] ? 0 : row_of(b, c, tok); }
        f32x4 pacc[3];
#pragma unroll
        for (int t = 0; t < 3; ++t) pacc[t] = (f32x4){0.f, 0.f, 0.f, 0.f};
        v4u qraw[4][2], fraw[4][2], vraw[8];
#pragma unroll
        for (int s = 0; s < 4; ++s)
#pragma unroll
            for (int ti = 0; ti < 2; ++ti) { const bf16* rp = F.QFIZ + (size_t)row[ti] * N0 + h * 128 + 32 * s + 8 * g; qraw[s][ti] = *(const GAS v4u*)rp; fraw[s][ti] = *(const GAS v4u*)(rp + DI); }
#pragma unroll
        for (int i = 0; i < 8; ++i) { const int q = lane + 64 * i, tk = q >> 4, c16 = q & 15; const bool nl = (c == 0 && tk < 16);
            vraw[i] = (v4u){0u, 0u, 0u, 0u}; if (!nl) vraw[i] = *(const GAS v4u*)(F.QFIZ + (size_t)row_of(b, c, tk) * N0 + 2 * DI + h * 128 + 8 * c16); }
        asm volatile("" ::: "memory");
#pragma unroll
        for (int s = 0; s < 4; ++s) {
            const int col = h * 128 + 32 * s + 8 * g;
            float lbv[8], bfv[8];
            { const f32x4 a0 = *(const GAS f32x4*)(F.LB0 + col), a1 = *(const GAS f32x4*)(F.LB0 + col + 4), c0 = *(const GAS f32x4*)(F.b_f + col), c1 = *(const GAS f32x4*)(F.b_f + col + 4);
              lbv[0] = a0.x; lbv[1] = a0.y; lbv[2] = a0.z; lbv[3] = a0.w; lbv[4] = a1.x; lbv[5] = a1.y; lbv[6] = a1.z; lbv[7] = a1.w;
              bfv[0] = c0.x; bfv[1] = c0.y; bfv[2] = c0.z; bfv[3] = c0.w; bfv[4] = c1.x; bfv[5] = c1.y; bfv[6] = c1.z; bfv[7] = c1.w; }
            float qv[2][8], fv[2][8];
#pragma unroll
            for (int ti = 0; ti < 2; ++ti) {
                const v4u q4 = qraw[s][ti], f4 = fraw[s][ti];
                qv[ti][0] = bflo(q4.x); qv[ti][1] = bfhi(q4.x); qv[ti][2] = bflo(q4.y); qv[ti][3] = bfhi(q4.y); qv[ti][4] = bflo(q4.z); qv[ti][5] = bfhi(q4.z); qv[ti][6] = bflo(q4.w); qv[ti][7] = bfhi(q4.w);
                fv[ti][0] = bflo(f4.x); fv[ti][1] = bfhi(f4.x); fv[ti][2] = bflo(f4.y); fv[ti][3] = bfhi(f4.y); fv[ti][4] = bflo(f4.z); fv[ti][5] = bfhi(f4.z); fv[ti][6] = bflo(f4.w); fv[ti][7] = bfhi(f4.w);
            }
            unsigned qd[2][4], ki[2][4], kd[2][4]; float gl[8];
#pragma unroll
            for (int e = 0; e < 8; e += 2) {
                float bb[2][2], BB[2], kk[2][2];
#pragma unroll
                for (int u = 0; u < 2; ++u) {
                    const float fg0 = lbv[e + u] + (1.f - lbv[e + u]) * sigm(fv[0][e + u] + bfv[e + u]);
                    const float fg1 = lbv[e + u] + (1.f - lbv[e + u]) * sigm(fv[1][e + u] + bfv[e + u]);
                    const float L0 = nul[0] ? 0.f : lg2(fg0), L1 = nul[1] ? 0.f : lg2(fg1);
                    kk[0][u] = nul[0] ? 0.f : 1.f - fg0; kk[1][u] = nul[1] ? 0.f : 1.f - fg1;
                    const float b0 = scan16(L0);
                    const float b1 = scan16(L1) + bcast15(b0);
                    bb[0][u] = b0; bb[1][u] = b1; BB[u] = bcast15(b1);
                    gl[e + u] = ex2(BB[u]);
                }
#pragma unroll
                for (int ti = 0; ti < 2; ++ti) {
                    const float q0 = nul[ti] ? 0.f : silu(qv[ti][e]), q1 = nul[ti] ? 0.f : silu(qv[ti][e + 1]);
                    qd[ti][e >> 1] = cvtpk(q0 * ex2(bb[ti][0]), q1 * ex2(bb[ti][1]));
                    ki[ti][e >> 1] = cvtpk(kk[ti][0] * ex2(-bb[ti][0]), kk[ti][1] * ex2(-bb[ti][1]));
                    kd[ti][e >> 1] = cvtpk(kk[ti][0] * ex2(BB[0] - bb[ti][0]), kk[ti][1] * ex2(BB[1] - bb[ti][1]));
                }
            }
            const bf16x8 qf0 = mk8(qd[0][0], qd[0][1], qd[0][2], qd[0][3]), qf1 = mk8(qd[1][0], qd[1][1], qd[1][2], qd[1][3]);
            const bf16x8 kf0 = mk8(ki[0][0], ki[0][1], ki[0][2], ki[0][3]), kf1 = mk8(ki[1][0], ki[1][1], ki[1][2], ki[1][3]);
            pacc[0] = MFMA16(kf0, qf0, pacc[0]);
            pacc[1] = MFMA16(kf0, qf1, pacc[1]);
            pacc[2] = MFMA16(kf1, qf1, pacc[2]);
#pragma unroll
            for (int ti = 0; ti < 2; ++ti)
#pragma unroll
                for (int h2 = 0; h2 < 2; ++h2) {
                    const int lp = (2 * (g & 1) + h2) * 16 + r;
                    v2u d; d.x = qd[ti][2 * h2]; d.y = qd[ti][2 * h2 + 1];
                    *(GAS v2u*)(rec + R0_QD + ((ti * 4 + s) * 64 + lp) * 16 + (g >> 1) * 8) = d;
                }
#pragma unroll
            for (int ti = 0; ti < 2; ++ti)
#pragma unroll
                for (int e = 0; e < 8; ++e) {
                    const unsigned wd = kd[ti][e >> 1]; const unsigned short hv = (e & 1) ? (unsigned short)(wd >> 16) : (unsigned short)(wd & 0xffffu);
                    *(LAS unsigned short*)(T + (32 * s + 8 * g + e) * 64 + (16 * ti + r) * 2) = hv;
                }
            if (r == 0) { *(GAS f32x4*)(rec + R0_GL + (32 * s + 8 * g) * 4) = (f32x4){gl[0], gl[1], gl[2], gl[3]}; *(GAS f32x4*)(rec + R0_GL + (32 * s + 8 * g + 4) * 4) = (f32x4){gl[4], gl[5], gl[6], gl[7]}; }
        }
#pragma unroll
        for (int t = 0; t < 4; ++t) {
            const int tj = (t >= 2) ? 1 : 0, ti = (t == 1 || t == 2) ? 1 : 0;
            float pv[4] = {0.f, 0.f, 0.f, 0.f};
            if (t < 3) { pv[0] = pacc[t].x; pv[1] = pacc[t].y; pv[2] = pacc[t].z; pv[3] = pacc[t].w; }
#pragma unroll
            for (int jj = 0; jj < 4; ++jj) { const int j = 16 * tj + 4 * g + jj, i = 16 * ti + r; if (j > i) pv[jj] = 0.f; }
            const int lp = (2 * tj + (g >> 1)) * 16 + r;
            v2u d; d.x = cvtpk(pv[0], pv[1]); d.y = cvtpk(pv[2], pv[3]);
            *(GAS v2u*)(rec + R0_P + (ti * 64 + lp) * 16 + 8 * (g & 1)) = d;
        }
#pragma unroll
        for (int i = 0; i < 8; ++i) {
            const int q = lane + 64 * i, tk = q >> 4, c16 = q & 15; const v4u d = vraw[i];
            *(LAS v2u*)(Tv + tk * 264 + c16 * 16) = (v2u){d.x, d.y}; *(LAS v2u*)(Tv + tk * 264 + c16 * 16 + 8) = (v2u){d.z, d.w};
        }
        LDS_WAIT(); asm volatile("" ::: "memory");
#pragma unroll
        for (int mt = 0; mt < 8; ++mt) { const v4u d = *(const LAS v4u*)(T + (16 * mt + r) * 64 + 16 * g); *(GAS v4u*)(rec + R0_KD + (mt * 64 + lane) * 16) = d; }
#pragma unroll
        for (int sl = 0; sl < 8; ++sl) {
            unsigned short hv[8];
#pragma unroll
            for (int e = 0; e < 8; ++e) hv[e] = *(const LAS unsigned short*)(Tv + (8 * g + e) * 264 + (16 * sl + r) * 2);
            v4u d; d.x = hv[0] | ((unsigned)hv[1] << 16); d.y = hv[2] | ((unsigned)hv[3] << 16); d.z = hv[4] | ((unsigned)hv[5] << 16); d.w = hv[6] | ((unsigned)hv[7] << 16);
            *(GAS v4u*)(rec + R0_V + (sl * 64 + lane) * 16) = d;
        }
        LDS_WAIT(); asm volatile("" ::: "memory");
    }
}

DI_ void l0_seq(Frame& F, const unsigned char* REC0) {
    const int lane = F.lane, w = F.wave, r = lane & 15, g = lane >> 4;
    LAS float* obuf = (LAS float*)(F.lds + 2 * ST0);
    constexpr int OB = 32 * 132;
    for (int u = F.vcu; u < NB * HG_H; u += F.G) {
        const int bh = u, b = bh >> 6, h = bh & 63;
        f32x4 acc[8];
#pragma unroll
        for (int m = 0; m < 8; ++m) acc[m] = (f32x4){0.f, 0.f, 0.f, 0.f};
        const int ntok = 4 * w + g, ndv = 8 * r;
        float ngv[8];
        { const f32x4 a0 = *(const GAS f32x4*)(F.ng0 + h * 128 + ndv), a1 = *(const GAS f32x4*)(F.ng0 + h * 128 + ndv + 4);
          ngv[0] = a0.x; ngv[1] = a0.y; ngv[2] = a0.z; ngv[3] = a0.w; ngv[4] = a1.x; ngv[5] = a1.y; ngv[6] = a1.z; ngv[7] = a1.w; }
#define L0_DMA(c_) do { const unsigned char* rs_ = REC0 + (size_t)(bh * NCH + (c_)) * R0_SZ; LAS unsigned char* st_ = F.lds + ((c_) & 1) * ST0; \
        for (int p_ = w; p_ < 27; p_ += 8) __builtin_amdgcn_global_load_lds((const unsigned*)(rs_ + p_ * 1024 + lane * 16), (LAS unsigned*)(st_ + p_ * 1024), 16, 0, 0); } while (0)
        L0_DMA(0);
        v4u zprev = (v4u){0u, 0u, 0u, 0u};
        for (int c = 0; c <= NCH; ++c) {
            asm volatile("s_waitcnt vmcnt(0)" ::: "memory");
            __builtin_amdgcn_s_barrier();
            asm volatile("" ::: "memory");
            if (c + 1 < NCH) L0_DMA(c + 1);
            v4u zcur = (v4u){0u, 0u, 0u, 0u};
            const bool zvalid = (c < NCH) && !(c == 0 && ntok < 16);
            if (zvalid) zcur = *(const GAS v4u*)(F.QFIZ + (size_t)row_of(b, c, ntok) * N0 + 3 * DI + h * 128 + ndv);
            if (c >= 1) {
                const int cp = c - 1;
                const LAS float* ob = obuf + (cp & 1) * OB + ntok * 132 + ndv;
                const f32x4 x0 = *(const LAS f32x4*)(ob), x1 = *(const LAS f32x4*)(ob + 4);
                float ss = (x0.x * x0.x + x0.y * x0.y) + (x0.z * x0.z + x0.w * x0.w) + (x1.x * x1.x + x1.y * x1.y) + (x1.z * x1.z + x1.w * x1.w);
                ss += __shfl_xor(ss, 8); ss += __shfl_xor(ss, 4); ss += __shfl_xor(ss, 2); ss += __shfl_xor(ss, 1);
                const float rs = rsqrtf(ss * (1.f / 128.f) + RMS_EPS);
                const bool wr = !(cp == 0 && (ntok < 16 || b != 0));
                if (wr) {
                    v4u d;
                    d.x = cvtpk(x0.x * rs * ngv[0] * silu(bflo(zprev.x)), x0.y * rs * ngv[1] * silu(bfhi(zprev.x)));
                    d.y = cvtpk(x0.z * rs * ngv[2] * silu(bflo(zprev.y)), x0.w * rs * ngv[3] * silu(bfhi(zprev.y)));
                    d.z = cvtpk(x1.x * rs * ngv[4] * silu(bflo(zprev.z)), x1.y * rs * ngv[5] * silu(bfhi(zprev.z)));
                    d.w = cvtpk(x1.z * rs * ngv[6] * silu(bflo(zprev.w)), x1.w * rs * ngv[7] * silu(bfhi(zprev.w)));
                    *(GAS v4u*)(F.Y + (size_t)row_of(b, cp, ntok) * DI + h * 128 + ndv) = d;
                }
            }
            zprev = zcur;
            if (c < NCH) {
                const LAS unsigned char* st = F.lds + (c & 1) * ST0;
                const bf16x8 vf = *(const LAS bf16x8*)(st + R0_V + w * 1024 + lane * 16);
                const bf16x8 p0 = *(const LAS bf16x8*)(st + R0_P + lane * 16), p1 = *(const LAS bf16x8*)(st + R0_P + 1024 + lane * 16);
                bf16x8 qf[8], kf[8]; f32x4 gf[8];
#pragma unroll
                for (int q = 0; q < 8; ++q) qf[q] = *(const LAS bf16x8*)(st + R0_QD + q * 1024 + lane * 16);
#pragma unroll
                for (int m = 0; m < 8; ++m) { gf[m] = *(const LAS f32x4*)(st + R0_GL + (16 * m + 4 * g) * 4); kf[m] = *(const LAS bf16x8*)(st + R0_KD + m * 1024 + lane * 16); }
                SCHED_FENCE();
                f32x4 o0 = (f32x4){0.f, 0.f, 0.f, 0.f}, o1 = o0;
                o0 = MFMA16(vf, p0, o0); o1 = MFMA16(vf, p1, o1);
#pragma unroll
                for (int s2 = 0; s2 < 4; ++s2) {
                    const bf16x8 sb = mk8(cvtpk(acc[2 * s2].x, acc[2 * s2].y), cvtpk(acc[2 * s2].z, acc[2 * s2].w), cvtpk(acc[2 * s2 + 1].x, acc[2 * s2 + 1].y), cvtpk(acc[2 * s2 + 1].z, acc[2 * s2 + 1].w));
                    o0 = MFMA16(sb, qf[s2], o0); o1 = MFMA16(sb, qf[4 + s2], o1);
                }
#pragma unroll
                for (int m = 0; m < 8; ++m) acc[m] = MFMA16(kf[m], vf, acc[m] * gf[m]);
                LAS float* ow = obuf + (c & 1) * OB + r * 132 + 16 * w + 4 * g;
                *(LAS f32x4*)ow = o0; *(LAS f32x4*)(ow + 16 * 132) = o1;
                asm volatile("s_waitcnt lgkmcnt(0)" ::: "memory");
            }
        }
#undef L0_DMA
        asm volatile("s_waitcnt vmcnt(0)" ::: "memory");
        __builtin_amdgcn_s_barrier();
    }
}

template <int KS, int MODE>
DI_ void skinny(Frame& F, const bf16* A, const bf16* Bt, int K, int n_first, int n_slices, bf16* Ob, int ldo, float* Of, const float* res) {
    const int lane = F.lane, w = F.wave, r = lane & 15, g = lane >> 4;
    constexpr int SPB = 8 / KS;
    const int kw = w % KS, sw = w / KS, klen = K / KS, kbeg = kw * klen;
    LAS f32x4* red = (LAS f32x4*)F.lds;
    for (int p = F.vcu; p * SPB < n_slices; p += F.G) {
        const int sl = p * SPB + sw, n0 = n_first + 16 * sl;
        f32x4 acc = (f32x4){0.f, 0.f, 0.f, 0.f};
        if (sl < n_slices) {
            const GAS v4u* bp = (const GAS v4u*)(Bt + (size_t)(n0 + r) * K + kbeg + 16 * g);
            const GAS v4u* ap = (const GAS v4u*)(A + (size_t)r * K + kbeg + 16 * g);
            for (int kk = 0; kk < klen; kk += 256) {
                v4u bv[8], av[8];
#pragma unroll
                for (int u = 0; u < 4; ++u) { bv[2 * u] = bp[(kk + 64 * u) / 8]; bv[2 * u + 1] = bp[(kk + 64 * u) / 8 + 1]; av[2 * u] = ap[(kk + 64 * u) / 8]; av[2 * u + 1] = ap[(kk + 64 * u) / 8 + 1]; }
                asm volatile("" ::: "memory");
#pragma unroll
                for (int u = 0; u < 8; ++u) acc = MFMA16(__builtin_bit_cast(bf16x8, bv[u]), __builtin_bit_cast(bf16x8, av[u]), acc);
            }
        }
        if (KS > 1) {
            red[w * 64 + lane] = acc;
            __syncthreads();
            if (kw == 0) {
#pragma unroll
                for (int j = 1; j < KS; ++j) acc += red[(w + j) * 64 + lane];
            }
        }
        if (kw == 0 && sl < n_slices) {
            if (MODE == 0) { v2u d; d.x = pk2(acc.x, acc.y); d.y = pk2(acc.z, acc.w); *(GAS v2u*)(Ob + (size_t)r * ldo + n0 + 4 * g) = d; }
            else { const f32x4 rv = *(const GAS f32x4*)(res + (size_t)r * D + n0 + 4 * g); *(GAS f32x4*)(Of + (size_t)r * D + n0 + 4 * g) = rv * ALPHA + acc; }
        }
        if (KS > 1) __syncthreads();
    }
    asm volatile("s_waitcnt vmcnt(0)" ::: "memory");
}

DI_ void gate_proj(Frame& F, const bf16* WG1T  ) {
    const int lane = F.lane, w = F.wave, r = lane & 15, g = lane >> 4, kw = w & 3, sw = w >> 2;
    LAS f32x4* red = (LAS f32x4*)F.lds;
    for (int p = F.vcu; 2 * p < MR / 16; p += F.G) {
        const int t = 2 * p + sw;
        f32x4 acc = (f32x4){0.f, 0.f, 0.f, 0.f};
        if (t < MR / 16) {
            const GAS v4u* wp = (const GAS v4u*)(WG1T + (size_t)r * D + 1024 * kw + 16 * g);
            const GAS v4u* hp = (const GAS v4u*)(F.H1B + (size_t)(16 * t + r) * D + 1024 * kw + 16 * g);
            for (int kk = 0; kk < 1024; kk += 256) {
                v4u wv[8], hv[8];
#pragma unroll
                for (int u = 0; u < 4; ++u) { wv[2 * u] = wp[(kk + 64 * u) / 8]; wv[2 * u + 1] = wp[(kk + 64 * u) / 8 + 1]; hv[2 * u] = hp[(kk + 64 * u) / 8]; hv[2 * u + 1] = hp[(kk + 64 * u) / 8 + 1]; }
                asm volatile("" ::: "memory");
#pragma unroll
                for (int u = 0; u < 8; ++u) acc = MFMA16(__builtin_bit_cast(bf16x8, wv[u]), __builtin_bit_cast(bf16x8, hv[u]), acc);
            }
        }
        red[w * 64 + lane] = acc;
        __syncthreads();
        if (kw == 0 && t < MR / 16) {
            acc += red[(w + 1) * 64 + lane]; acc += red[(w + 2) * 64 + lane]; acc += red[(w + 3) * 64 + lane];
            *(GAS f32x4*)(F.G1 + (size_t)(16 * t + r) * GL_R + 4 * g) = acc;
        }
        __syncthreads();
    }
    asm volatile("s_waitcnt vmcnt(0)" ::: "memory");
}

#ifndef USE_AUX
#define USE_AUX 0
#endif
struct AuxT { const float* src; bf16* dst; int N, K; };
DI_ AuxT aux_decode(Frame& F, int it, unsigned char* dummy) {
    constexpr int I_1 = (DI / 64) * (D / 32), I_2 = (D / 64) * (N1 / 32), I_3 = I_1, AUX_ITERS = (I_1 + I_2 + I_3) / (256 * NWAVES);
    static_assert((I_1 + I_2 + I_3) % (256 * NWAVES) == 0, "aux tiles divide over the waves");
    const int gw = F.vcu * NWAVES + F.wave;
    AuxT t;
    if (it >= AUX_ITERS || F.G != 256) { t.src = (const float*)(dummy + (size_t)gw * 8192); t.dst = (bf16*)(dummy + 32 * MiB + (size_t)gw * 8192); t.N = 32; t.K = 64; return t; }
    int r_ = it * (256 * NWAVES) + gw; const float* W; bf16* WT; int K, N;
    if (r_ < I_1) { W = F.w0out; WT = F.WT0OUT; K = DI; N = D; }
    else if (r_ < I_1 + I_2) { r_ -= I_1; W = F.w1in; WT = F.WT1IN; K = D; N = N1; }
    else { r_ -= I_1 + I_2; W = F.w1out; WT = F.WT1OUT; K = DI; N = D; }
    const int nblk = N / 32, kb = r_ / nblk, nb = r_ - kb * nblk;
    t.src = W + (size_t)(64 * kb) * N + 32 * nb; t.dst = WT + (size_t)(32 * nb) * K + 64 * kb; t.N = N; t.K = K; return t;
}
DI_ void aux_load(Frame& F, const AuxT& t, f32x4 (&wv)[8]) {
    const int rowi = F.lane >> 3, c4 = F.lane & 7;
#pragma unroll
    for (int i = 0; i < 8; ++i) wv[i] = *(const GAS f32x4*)(t.src + (size_t)(8 * i + rowi) * t.N + 4 * c4);
}
DI_ void aux_store(Frame& F, const AuxT& t, const f32x4 (&wv)[8], LAS unsigned char* scr  ) {
    const int lane = F.lane, rowi = lane >> 3, c4 = lane & 7;
#pragma unroll
    for (int i = 0; i < 8; ++i) { LAS unsigned* p = (LAS unsigned*)(scr + (8 * i + rowi) * 68 + c4 * 8); p[0] = cvtpk(wv[i].x, wv[i].y); p[1] = cvtpk(wv[i].z, wv[i].w); }
    LDS_WAIT(); asm volatile("" ::: "memory");
    const int kc = lane & 7;
#pragma unroll
    for (int j = 0; j < 4; ++j) { const int n = (lane >> 3) + 8 * j; unsigned short hv[8];
#pragma unroll
        for (int e = 0; e < 8; ++e) hv[e] = *(const LAS unsigned short*)(scr + (8 * kc + e) * 68 + n * 2);
        v4u o; o.x = hv[0] | ((unsigned)hv[1] << 16); o.y = hv[2] | ((unsigned)hv[3] << 16); o.z = hv[4] | ((unsigned)hv[5] << 16); o.w = hv[6] | ((unsigned)hv[7] << 16);
        *(GAS v4u*)(t.dst + (size_t)n * t.K + 8 * kc) = o; }
    LDS_WAIT(); asm volatile("" ::: "memory");
}

constexpr int F0_QD = 0, F0_KI = 8192, F0_T = 16384, F0_GL = 24576, F0_TV = 25088, F0_STG = 33536;
DI_ void f0_load(const bf16* cb, const int (&oq)[2], int ov, v2u (&q2)[2], v2u (&f2)[2], v4u& vraw) {
#pragma unroll
    for (int ti = 0; ti < 2; ++ti) { q2[ti] = *(const GAS v2u*)(cb + oq[ti]); f2[ti] = *(const GAS v2u*)(cb + oq[ti] + DI); }
    vraw = *(const GAS v4u*)(cb + ov);
}
DI_ void f0_prep(Frame& F, LAS unsigned char* st, const v2u (&q2)[2], const v2u (&f2)[2], const v4u& vraw, const f32x4& lb4, const f32x4& bf4) {
    const int lane = F.lane, w = F.wave, r = lane & 15, g = lane >> 4, ps = w >> 1, hf = w & 1;
    const float lbv[4] = {lb4.x, lb4.y, lb4.z, lb4.w}, bfv[4] = {bf4.x, bf4.y, bf4.z, bf4.w};
    float Lv[2][4], qq[2][4], kk[2][4];
#pragma unroll
    for (int ti = 0; ti < 2; ++ti) {
        const float qv[4] = {bflo(q2[ti].x), bfhi(q2[ti].x), bflo(q2[ti].y), bfhi(q2[ti].y)}, fv[4] = {bflo(f2[ti].x), bfhi(f2[ti].x), bflo(f2[ti].y), bfhi(f2[ti].y)};
#pragma unroll
        for (int x = 0; x < 4; ++x) { const float fg = lbv[x] + (1.f - lbv[x]) * sigm(fv[x] + bfv[x]);
            Lv[ti][x] = lg2(fg); kk[ti][x] = 1.f - fg; qq[ti][x] = silu(qv[x]); }
    }
    float qd[2][4], ki[2][4], kd[2][4], gl[4];
#pragma unroll
    for (int x = 0; x < 4; ++x) {
        const float b0 = scan16(Lv[0][x]);
        const float b1 = scan16(Lv[1][x]) + bcast15(b0);
        const float BB = bcast15(b1);
        gl[x] = ex2(BB);
        qd[0][x] = qq[0][x] * ex2(b0); ki[0][x] = kk[0][x] * ex2(-b0); kd[0][x] = ki[0][x] * gl[x];
        qd[1][x] = qq[1][x] * ex2(b1); ki[1][x] = kk[1][x] * ex2(-b1); kd[1][x] = ki[1][x] * gl[x];
    }
    const int lp = (2 * (g & 1) + hf) * 16 + r;
#pragma unroll
    for (int ti = 0; ti < 2; ++ti) {
        *(LAS v2u*)(st + F0_QD + ((ti * 4 + ps) * 64 + lp) * 16 + (g >> 1) * 8) = (v2u){cvtpk(qd[ti][0], qd[ti][1]), cvtpk(qd[ti][2], qd[ti][3])};
        *(LAS v2u*)(st + F0_KI + ((ti * 4 + ps) * 64 + lp) * 16 + (g >> 1) * 8) = (v2u){cvtpk(ki[ti][0], ki[ti][1]), cvtpk(ki[ti][2], ki[ti][3])};
        const unsigned k01 = cvtpk(kd[ti][0], kd[ti][1]), k23 = cvtpk(kd[ti][2], kd[ti][3]);
        LAS unsigned char* tp = st + F0_T + (32 * ps + 8 * g + 4 * hf) * 64 + (16 * ti + r) * 2;
        *(LAS unsigned short*)(tp) = (unsigned short)(k01 & 0xffffu); *(LAS unsigned short*)(tp + 64) = (unsigned short)(k01 >> 16);
        *(LAS unsigned short*)(tp + 128) = (unsigned short)(k23 & 0xffffu); *(LAS unsigned short*)(tp + 192) = (unsigned short)(k23 >> 16);
    }
    if (r == 0) *(LAS f32x4*)(st + F0_GL + (32 * ps + 8 * g + 4 * hf) * 4) = (f32x4){gl[0], gl[1], gl[2], gl[3]};
    { const int tk = 4 * w + (lane >> 4), c16 = lane & 15;
      *(LAS v2u*)(st + F0_TV + tk * 264 + c16 * 16) = (v2u){vraw.x, vraw.y}; *(LAS v2u*)(st + F0_TV + tk * 264 + c16 * 16 + 8) = (v2u){vraw.z, vraw.w}; }
}
DI_ void l0_fused(Frame& F, unsigned char* dummy) {
    const int lane = F.lane, w = F.wave, r = lane & 15, g = lane >> 4, ps = w >> 1, hf = w & 1;
    LAS float* obuf = (LAS float*)(F.lds + 2 * F0_STG);
    constexpr int OB = 32 * 132;
    for (int u = F.vcu; u < NB * HG_H; u += F.G) {
        const int bh = u, b = bh >> 6, h = bh & 63;
        f32x4 acc[8];
#pragma unroll
        for (int m = 0; m < 8; ++m) acc[m] = (f32x4){0.f, 0.f, 0.f, 0.f};
        const int ntok = 4 * w + g, ndv = 8 * r;
        float ngv[8];
        { const f32x4 a0 = *(const GAS f32x4*)(F.ng0 + h * 128 + ndv), a1 = *(const GAS f32x4*)(F.ng0 + h * 128 + ndv + 4);
          ngv[0] = a0.x; ngv[1] = a0.y; ngv[2] = a0.z; ngv[3] = a0.w; ngv[4] = a1.x; ngv[5] = a1.y; ngv[6] = a1.z; ngv[7] = a1.w; }
        const int colp = h * 128 + 32 * ps + 8 * g + 4 * hf;
        const f32x4 lb4 = *(const GAS f32x4*)(F.LB0 + colp), bf4 = *(const GAS f32x4*)(F.b_f + colp);
        v2u q2s[2][2], f2s[2][2]; v4u vrs[2];
        const int oq[2] = {r * N0 + colp, (16 + r) * N0 + colp};
        const int ov = (4 * w + (lane >> 4)) * N0 + 2 * DI + h * 128 + 8 * (lane & 15), oz = ntok * N0 + 3 * DI + h * 128 + ndv, oy = ntok * DI + h * 128 + ndv;
        const bf16* xq = F.QFIZ + (size_t)(b * SEQ - 32) * N0;
        bf16* xy = F.Y + (size_t)(b * SEQ - 32) * DI;
        bf16* y0 = (b == 0) ? F.Y0 : F.Y0 + (size_t)32 * DI;
#define QCH(c_) (((c_) == 0) ? (const bf16*)F.Q0 : xq + (size_t)(c_) * 32 * N0)
        f0_load(QCH(0), oq, ov, q2s[0], f2s[0], vrs[0]);
        f0_prep(F, F.lds, q2s[0], f2s[0], vrs[0], lb4, bf4);
        f0_load(QCH(1), oq, ov, q2s[1], f2s[1], vrs[1]);
        LAS unsigned char* ascr = F.lds + 2 * F0_STG + 33792 + w * 4352;
        f32x4 awv[8];
        v4u zs[2]; zs[0] = (v4u){0u, 0u, 0u, 0u}; zs[1] = zs[0];
#define F0_BODY(C_, PAR) do { const int c = (C_); \
            asm volatile("s_waitcnt lgkmcnt(0)" ::: "memory"); \
            __builtin_amdgcn_s_barrier(); \
            asm volatile("" ::: "memory"); \
            f0_load(QCH((c + 2 < NCH) ? c + 2 : NCH - 1), oq, ov, q2s[PAR], f2s[PAR], vrs[PAR]); \
            AuxT at_; if (USE_AUX) { at_ = aux_decode(F, c, dummy); aux_load(F, at_, awv); } \
            { const int cz = (c < NCH) ? c : NCH - 1; zs[PAR] = *(const GAS v4u*)(QCH(cz) + oz); } \
            { \
                const int cp = c - 1; \
                const LAS float* ob = obuf + (cp & 1) * OB + ntok * 132 + ndv; \
                const f32x4 x0 = *(const LAS f32x4*)(ob), x1 = *(const LAS f32x4*)(ob + 4); \
                float ss = (x0.x * x0.x + x0.y * x0.y) + (x0.z * x0.z + x0.w * x0.w) + (x1.x * x1.x + x1.y * x1.y) + (x1.z * x1.z + x1.w * x1.w); \
                ss = bcast15(scan16(ss)); \
                const float rs = rsqrtf(ss * (1.f / 128.f) + RMS_EPS); \
                bf16* yb = (cp <= 0) ? ((cp == 0) ? y0 : F.Y0 + (size_t)32 * DI) : xy + (size_t)cp * 32 * DI; \
                { \
                    v4u d; \
                    d.x = cvtpk(x0.x * rs * ngv[0] * silu(bflo(zs[PAR ^ 1].x)), x0.y * rs * ngv[1] * silu(bfhi(zs[PAR ^ 1].x))); \
                    d.y = cvtpk(x0.z * rs * ngv[2] * silu(bflo(zs[PAR ^ 1].y)), x0.w * rs * ngv[3] * silu(bfhi(zs[PAR ^ 1].y))); \
                    d.z = cvtpk(x1.x * rs * ngv[4] * silu(bflo(zs[PAR ^ 1].z)), x1.y * rs * ngv[5] * silu(bfhi(zs[PAR ^ 1].z))); \
                    d.w = cvtpk(x1.z * rs * ngv[6] * silu(bflo(zs[PAR ^ 1].w)), x1.w * rs * ngv[7] * silu(bfhi(zs[PAR ^ 1].w))); \
                    *(GAS v4u*)(yb + oy) = d; \
                } \
            } \
             \
            { \
                const LAS unsigned char* st = F.lds + (c & 1) * F0_STG; \
 \
                unsigned short hv[8]; \
                _Pragma("unroll") \
                for (int e = 0; e < 8; ++e) hv[e] = *(const LAS unsigned short*)(st + F0_TV + (16 * (e >> 2) + 4 * g + (e & 3)) * 264 + (16 * w + r) * 2); \
                const bf16x8 vf = mk8(hv[0] | ((unsigned)hv[1] << 16), hv[2] | ((unsigned)hv[3] << 16), hv[4] | ((unsigned)hv[5] << 16), hv[6] | ((unsigned)hv[7] << 16)); \
                bf16x8 qf[8], kf[8]; \
                _Pragma("unroll") \
                for (int q = 0; q < 8; ++q) { qf[q] = *(const LAS bf16x8*)(st + F0_QD + q * 1024 + lane * 16); kf[q] = *(const LAS bf16x8*)(st + F0_KI + q * 1024 + lane * 16); } \
                SCHED_FENCE(); \
 \
                f32x4 pt00 = (f32x4){0.f, 0.f, 0.f, 0.f}, pt01 = pt00, pt11 = pt00; \
                _Pragma("unroll") \
                for (int s2 = 0; s2 < 4; ++s2) { pt00 = MFMA16(kf[s2], qf[s2], pt00); pt01 = MFMA16(kf[s2], qf[4 + s2], pt01); pt11 = MFMA16(kf[4 + s2], qf[4 + s2], pt11); } \
                const bool m0 = (4 * g + 0 <= r), m1 = (4 * g + 1 <= r), m2 = (4 * g + 2 <= r), m3 = (4 * g + 3 <= r); \
 \
                                const bf16x8 pb0 = mk8(cvtpk(m0 ? pt00.x : 0.f, m1 ? pt00.y : 0.f), cvtpk(m2 ? pt00.z : 0.f, m3 ? pt00.w : 0.f), 0u, 0u); \
                const bf16x8 pb1 = mk8(pk2(pt01.x, pt01.y), pk2(pt01.z, pt01.w), cvtpk(m0 ? pt11.x : 0.f, m1 ? pt11.y : 0.f), cvtpk(m2 ? pt11.z : 0.f, m3 ? pt11.w : 0.f)); \
                f32x4 o0 = (f32x4){0.f, 0.f, 0.f, 0.f}, o1 = o0; \
                o0 = MFMA16(vf, pb0, o0); o1 = MFMA16(vf, pb1, o1); \
                _Pragma("unroll") \
                for (int s2 = 0; s2 < 4; ++s2) { \
                    const bf16x8 sb = mk8(cvtpk(acc[2 * s2].x, acc[2 * s2].y), cvtpk(acc[2 * s2].z, acc[2 * s2].w), cvtpk(acc[2 * s2 + 1].x, acc[2 * s2 + 1].y), cvtpk(acc[2 * s2 + 1].z, acc[2 * s2 + 1].w)); \
                    o0 = MFMA16(sb, qf[s2], o0); o1 = MFMA16(sb, qf[4 + s2], o1); \
                } \
                LAS float* ow = obuf + (c & 1) * OB + r * 132 + 16 * w + 4 * g; \
                *(LAS f32x4*)ow = o0; *(LAS f32x4*)(ow + 16 * 132) = o1; \
                f32x4 gf[8]; v2u klo[8], khi[8]; \
                _Pragma("unroll") \
                for (int m = 0; m < 8; ++m) { gf[m] = *(const LAS f32x4*)(st + F0_GL + (16 * m + 4 * g) * 4); \
                    klo[m] = *(const LAS v2u*)(st + F0_T + (16 * m + r) * 64 + 8 * g); khi[m] = *(const LAS v2u*)(st + F0_T + (16 * m + r) * 64 + 32 + 8 * g); } \
                SCHED_FENCE(); \
                _Pragma("unroll") \
                for (int m = 0; m < 8; ++m) acc[m] = MFMA16(mk8(klo[m].x, klo[m].y, khi[m].x, khi[m].y), vf, acc[m] * gf[m]); \
                SCHED_FENCE(); \
            } \
            f0_prep(F, F.lds + ((c + 1) & 1) * F0_STG, q2s[PAR ^ 1], f2s[PAR ^ 1], vrs[PAR ^ 1], lb4, bf4); \
            if (USE_AUX) aux_store(F, at_, awv, ascr); \
        } while (0)
        for (int c2 = 0; c2 <= NCH; c2 += 2) { F0_BODY(c2, 0); F0_BODY(c2 + 1, 1); }
#undef F0_BODY
#undef QCH
        asm volatile("s_waitcnt vmcnt(0) lgkmcnt(0)" ::: "memory");
        __builtin_amdgcn_s_barrier();
    }
}

struct Args { const float* in[17]; float* out; unsigned char* ws; int ph_lo, ph_hi, li, pad; };
__global__ void __launch_bounds__(NWAVES * 64, 2) mk_fwd(Args args) {
    extern __shared__ __attribute__((aligned(16))) unsigned char lds[];
    Frame F;
    F.lds = (LAS unsigned char*)lds;
    F.MISC = (volatile LAS unsigned*)(F.lds + MISC_OFF);
    F.tid = threadIdx.x; F.lane = F.tid & 63; F.wave = __builtin_amdgcn_readfirstlane(F.tid >> 6);
    F.G = gridDim.x; { const int bx = blockIdx.x; F.vcu = (F.G % 8 == 0) ? (bx % 8) * (F.G / 8) + bx / 8 : bx; }
    unsigned char* ws = args.ws;
    F.ctl = (gu32*)(ws + WS_CTL);
    F.x = args.in[0]; F.meta = args.in[1]; F.lb_logits = args.in[2];
    F.w0in = args.in[3]; F.b_f = args.in[4]; F.ng0 = args.in[5]; F.w0out = args.in[6]; F.ln0g = args.in[7]; F.ln0b = args.in[8];
    F.w1in = args.in[9]; F.wg1 = args.in[10]; F.wg2 = args.in[11]; F.b_g = args.in[12]; F.ng1 = args.in[13]; F.w1out = args.in[14]; F.ln1g = args.in[15]; F.ln1b = args.in[16];
    F.out = args.out;
    F.LB0 = (float*)(ws + WS_LB0); F.G1 = (float*)(ws + WS_G1); F.PRE = (float*)(ws + WS_PRE); F.O1 = (float*)(ws + WS_O1); F.WG1T = (bf16*)(ws + WS_WG1T); F.W2F = (bf16*)(ws + WS_W2F); F.SS = (float*)(ws + WS_REC + 525 * MiB); F.Q0 = (bf16*)(ws + WS_Q0); F.Y0 = (bf16*)(ws + WS_Y0); F.REC0 = ws + WS_REC; F.REC1 = ws + WS_REC1; F.VF1 = ws + WS_VF1;
    F.WT0IN = (bf16*)(ws + WS_WT0IN); F.WT0OUT = (bf16*)(ws + WS_WT0OUT); F.WT1IN = (bf16*)(ws + WS_WT1IN); F.WT1OUT = (bf16*)(ws + WS_WT1OUT);
    F.XB = (bf16*)(ws + WS_XB); F.H1B = (bf16*)(ws + WS_H1B); F.QFIZ = (bf16*)(ws + WS_QFIZ); F.Y = (bf16*)(ws + WS_Y);
    for (int u = F.tid; u < (LDS_BYTES - LDSCTL_OFF) / 4; u += NWAVES * 64) ((LAS unsigned*)(F.lds + LDSCTL_OFF))[u] = 0u;
    __syncthreads();
    int vb = (int)blockIdx.x;
    if (USE_TICKETS && N_LAUNCHES == 1 && (F.G % 8) == 0) {
        if (F.tid == 0) {
            const unsigned per = (unsigned)F.G / 8u; unsigned x = xb_xcc_id() & 7u, got = 0xffffffffu;
            for (unsigned tr = 0; tr < 8u; ++tr) { const unsigned y = (x + tr) & 7u; const unsigned t = xb_add((unsigned*)(F.ctl + CW_POOL) + 64 * y, 1u); if (t < per) { got = y + 8u * t; break; } }
            F.MISC[12] = (got == 0xffffffffu) ? blockIdx.x : got;
        }
        __syncthreads();
        vb = (int)F.MISC[12];
    }
    { F.vcu = (F.G % 8 == 0) ? (vb % 8) * (F.G / 8) + vb / 8 : vb; }
    XcdBarrier bar; bar.bar = (unsigned*)(F.ctl + CW_BAR); bar.x = 0; bar.st = nullptr;
    if (N_LAUNCHES == 1) bar = xcd_barrier_post((unsigned*)(F.ctl + CW_BAR), F.MISC + 8);
#define GRID_BAR() do { if (N_LAUNCHES == 1) xcd_barrier(bar); } while (0)
    const int lo = args.ph_lo, hi = args.ph_hi;
    unsigned long long pclk0 = 0, pclkn = 0; (void)pclk0;
    unsigned long long st_prev = STAMP_MASK ? __builtin_amdgcn_s_memrealtime() : 0ull, st_acc = 0ull;
#define STAMP(k) do { if (STAMP_MASK) { const unsigned long long t_ = __builtin_amdgcn_s_memrealtime(); if ((STAMP_MASK >> (k)) & 1) st_acc += t_ - st_prev; st_prev = t_; } } while (0)
#ifdef ONLY_PHASE
#define IN(k) ((k) == ONLY_PHASE && lo <= (k) && (k) < hi)
#else
#define IN(k) (lo <= (k) && (k) < hi)
#endif
#define BOTH(k) (IN(k) && IN((k) + 1))

    if (IN(0)) { for (int rep = 0; rep < REP(0); ++rep) { p0_prologue(F); if (rep + 1 < REP(0)) GRID_BAR(); } if (BOTH(0)) GRID_BAR(); }
    STAMP(0);
    if (IN(1)) {
        if (!(P0_META_FOLD && F.G == 256)) skinny<1, 0>(F, F.XB + (size_t)MX * D, F.WT0IN, D, 0, N0 / 16, (USE_L0_MFMA == 2) ? F.Q0 + (size_t)16 * N0 : F.QFIZ + (size_t)MX * N0, N0, nullptr, nullptr);
        pg8::Gemm g{F.XB, F.WT0IN, MX, N0, D}; pg8::StaticOrder S; S.init(MX, N0, F.G, vb);
        pg8::EpiBf16<0> E{F.QFIZ, N0, nullptr, 0, 0, 1.f};
        if (PROBE_CLK == 1) pclk0 = __builtin_amdgcn_s_memtime();
        for (int rep = 0; rep < REP(1); ++rep) { pg8::gemm_phase<pg8::EpiBf16<0>, pg8::StaticOrder, PG8_ALIGN, PG8_SP2>(F.lds + RING_OFF, g, S, E); if (rep + 1 < REP(1)) GRID_BAR(); }
        if (PROBE_CLK == 1) pclkn = __builtin_amdgcn_s_memtime() - pclk0;
        if (BOTH(1)) GRID_BAR();
    }
    STAMP(1);
#if USE_L0_MFMA == 2
    STAMP(2);
    if (IN(3)) { for (int rep = 0; rep < REP(3); ++rep) { l0_fused(F, F.REC0); if (rep + 1 < REP(3)) GRID_BAR(); } if (BOTH(3)) GRID_BAR(); }
#elif USE_L0_MFMA
    if (IN(2)) { for (int rep = 0; rep < REP(2); ++rep) { l0_prep(F, F.REC0); if (rep + 1 < REP(2)) GRID_BAR(); } if (BOTH(2)) GRID_BAR(); }
    STAMP(2);
    if (IN(3)) { for (int rep = 0; rep < REP(3); ++rep) { l0_seq(F, F.REC0); if (rep + 1 < REP(3)) GRID_BAR(); } if (BOTH(3)) GRID_BAR(); }
#else
    if (IN(2)) { if (BOTH(2)) GRID_BAR(); }
    if (IN(3)) { for (int rep = 0; rep < REP(3); ++rep) { p2_l0_rec_naive(F); if (rep + 1 < REP(3)) GRID_BAR(); } if (BOTH(3)) GRID_BAR(); }
#endif
    STAMP(3);
    if (IN(4)) {
        skinny<4, 1>(F, (USE_L0_MFMA == 2) ? F.Y0 + (size_t)16 * DI : F.Y + (size_t)MX * DI, F.WT0OUT, DI, 0, D / 16, nullptr, 0, F.PRE + (size_t)MX * D, F.meta);
        pg8::Gemm g{F.Y, F.WT0OUT, MX, D, DI}; pg8::StaticOrder S; S.init(MX, D, F.G, vb);
        pg8::EpiResid E{F.PRE, D, F.x, F.meta, MX, MX, ALPHA};
        for (int rep = 0; rep < REP(4); ++rep) { pg8::gemm_phase<pg8::EpiResid, pg8::StaticOrder, PG8_ALIGN, PG8_SP2>(F.lds + RING_OFF, g, S, E); if (rep + 1 < REP(4)) GRID_BAR(); }
        if (BOTH(4)) GRID_BAR();
    }
    STAMP(4);
    if (IN(5)) { for (int rep = 0; rep < REP(5); ++rep) { ln_phase2(F, F.PRE, MR, F.ln0g, F.ln0b, RES_BF16 ? nullptr : F.PRE, F.H1B); if (rep + 1 < REP(5)) GRID_BAR(); } if (BOTH(5)) GRID_BAR(); }
    STAMP(5);
    if (IN(6)) {
        gate_proj(F, F.WG1T);
        skinny<2, 0>(F, F.H1B + (size_t)MX * D, F.WT1IN, D, 4096, (N1 - 4096 - DI) / 16, F.QFIZ + (size_t)MX * N1, N1, nullptr, nullptr);
        pg8::Gemm g{F.H1B, F.WT1IN, MX, N1, D}; pg8::StaticOrder S; S.init(MX, N1, F.G, vb);
        pg8::EpiBf16<0> E{F.QFIZ, N1, nullptr, 0, 0, 1.f};
        for (int rep = 0; rep < REP(6); ++rep) { pg8::gemm_phase<pg8::EpiBf16<0>, pg8::StaticOrder, PG8_ALIGN, PG8_SP2>(F.lds + RING_OFF, g, S, E); if (rep + 1 < REP(6)) GRID_BAR(); }
        if (BOTH(6)) GRID_BAR();
    }
    STAMP(6);
#if USE_L1_MFMA
    if (IN(7)) { for (int rep = 0; rep < REP(7); ++rep) { l1_prep(F, F.REC1, F.VF1, F.W2F); if (rep + 1 < REP(7)) GRID_BAR(); } if (BOTH(7)) GRID_BAR(); }
    STAMP(7);
#if USE_L1_SEQ2
    if (IN(8)) { l1_seq2(F, F.REC1, F.VF1, F.SS); if (BOTH(8)) GRID_BAR(); }
#else
    if (IN(8)) { l1_seq<0>(F, F.REC1, F.VF1, F.O1, F.SS); if (REP(8) > 1) { GRID_BAR(); l1_seq<PROBE_VAR>(F, F.REC1, F.VF1, F.O1, F.SS); } if (BOTH(8)) GRID_BAR(); }
#endif
#else
    if (IN(7)) { if (BOTH(7)) GRID_BAR(); }
    if (IN(8)) { for (int rep = 0; rep < REP(8); ++rep) { p6_l1_rec_naive(F); if (rep + 1 < REP(8)) GRID_BAR(); } if (BOTH(8)) GRID_BAR(); }
#endif
    STAMP(8);
#if !(USE_FUSED_NORM && USE_L1_MFMA)
    if (IN(9)) { for (int rep = 0; rep < REP(9); ++rep) { p7_normgate(F); if (rep + 1 < REP(9)) GRID_BAR(); } if (BOTH(9)) GRID_BAR(); }
#endif
    STAMP(9);
    if (IN(10)) {
        pg8::Gemm g{F.Y, F.WT1OUT, MX, D, DI}; pg8::StaticOrder S; S.init(MX, D, F.G, vb);
#if USE_FUSED_NORM && USE_L1_MFMA
        pg8::EpiResidScale E{F.PRE, D, F.H1B, ALPHA, F.SS, RMS_EPS};
        for (int rep = 0; rep < REP(10); ++rep) { pg8::gemm_phase<pg8::EpiResidScale, pg8::StaticOrder, PG8_ALIGN, PG8_SP2>(F.lds + RING_OFF, g, S, E); if (rep + 1 < REP(10)) GRID_BAR(); }
#else
        pg8::EpiResid E{F.PRE, D, F.PRE, F.PRE, MX, MX, ALPHA};
        if (PROBE_CLK == 10) pclk0 = __builtin_amdgcn_s_memtime();
        for (int rep = 0; rep < REP(10); ++rep) { pg8::gemm_phase<pg8::EpiResid, pg8::StaticOrder, PG8_ALIGN, PG8_SP2>(F.lds + RING_OFF, g, S, E); if (rep + 1 < REP(10)) GRID_BAR(); }
        if (PROBE_CLK == 10) pclkn = __builtin_amdgcn_s_memtime() - pclk0;
#endif
        if (BOTH(10)) GRID_BAR();
    }
    STAMP(10);
    if (IN(11)) { for (int rep = 0; rep < REP(11); ++rep) { ln_phase2(F, F.PRE, MX, F.ln1g, F.ln1b, F.out, nullptr); if (rep + 1 < REP(11)) GRID_BAR(); } }
    STAMP(11);
    if (STAMP_MASK && blockIdx.x == 0 && F.tid == 0) { const unsigned long long t0 = __builtin_amdgcn_s_memrealtime(); while (__builtin_amdgcn_s_memrealtime() - t0 < st_acc) __builtin_amdgcn_s_sleep(8); }
    if (PROBE_CLK && blockIdx.x == 0 && F.tid == 0) { const unsigned long long t0 = __builtin_amdgcn_s_memrealtime(); while (__builtin_amdgcn_s_memrealtime() - t0 < pclkn / (PROBE_CLK == 10 ? 10ull : 100ull)) __builtin_amdgcn_s_sleep(8); }
#undef IN
#undef BOTH
}

extern "C" void kernel_launch(void* const* d_in, const int* in_sizes, int n_in, void* d_out, int out_size, void* d_ws, size_t ws_size, hipStream_t stream) {
    static int grid = 0;
    if (grid == 0) {
        if (n_in != 17 || in_sizes[0] != MX * D || out_size != MX * D || ws_size < WS_END) { fprintf(stderr, "kernel_launch: unexpected problem (n_in %d, in0 %d, out %d, ws %zu < %zu); nothing launched\n", n_in, n_in > 0 ? in_sizes[0] : -1, out_size, ws_size, (size_t)WS_END); grid = -1; return; }
        int dev = 0, cus = 0, per_cu = 0;
        if (hipGetDevice(&dev) != hipSuccess || hipDeviceGetAttribute(&cus, hipDeviceAttributeMultiprocessorCount, dev) != hipSuccess) { fprintf(stderr, "kernel_launch: device query failed\n"); grid = -1; return; }
        if (hipFuncSetAttribute((const void*)mk_fwd, hipFuncAttributeMaxDynamicSharedMemorySize, LDS_BYTES) != hipSuccess) { fprintf(stderr, "kernel_launch: hipFuncSetAttribute failed\n"); grid = -1; return; }
        if (hipOccupancyMaxActiveBlocksPerMultiprocessor(&per_cu, (const void*)mk_fwd, NWAVES * 64, LDS_BYTES) != hipSuccess || per_cu < 1)
            fprintf(stderr, "kernel_launch: note: occupancy query reports %d workgroups per CU\n", per_cu);
        (void)hipGetLastError();
        grid = cus;
    }
    if (grid < 0) return;
    if (hipMemsetAsync((char*)d_ws + WS_CTL, 0, CTL_ZERO_BYTES, stream) != hipSuccess) { fprintf(stderr, "kernel_launch: memset failed\n"); return; }
    Args a{};
    for (int i = 0; i < 17; ++i) a.in[i] = (const float*)d_in[i];
    a.out = (float*)d_out; a.ws = (unsigned char*)d_ws;
    for (int li = 0; li < N_LAUNCHES; ++li) {
        a.ph_lo = (N_LAUNCHES == 1) ? 0 : li; a.ph_hi = (N_LAUNCHES == 1) ? PER_PHASE : li + 1; a.li = li; a.pad = 0;
        hipLaunchKernelGGL(mk_fwd, dim3(grid), dim3(NWAVES * 64), LDS_BYTES, stream, a);
        const hipError_t le = hipPeekAtLastError();
        if (le != hipSuccess) { fprintf(stderr, "kernel_launch: launch %d failed: %s\n", li, hipGetErrorName(le)); break; }
    }
}
```

```cpp
#include <hip/hip_runtime.h>
#include <cstdio>
#include <cstdint>
#define MK_N_LAUNCHES 1
#define USE_L0_MFMA 2
#define USE_L1_MFMA 1
namespace pg8 {
#define PG8_LAS __attribute__((address_space(3)))
typedef unsigned short bf16_t;
typedef short bf16x8 __attribute__((ext_vector_type(8)));
typedef float f32x4 __attribute__((ext_vector_type(4)));
typedef unsigned u32x4 __attribute__((ext_vector_type(4)));
constexpr int BM = 256, BK = 64, HALF = 128, HTB = HALF * BK * 2  , STAGE_BYTES = 8 * HTB, NXCD = 8, WGM = 8;

__host__ __device__ __forceinline__ int lds_byte(int r, int c) { const int st = (r >> 4) * 2 + (c >> 5), rr = r & 15, cc = c & 31, ob = rr * 64 + cc * 2; return st * 1024 + (ob ^ (((ob >> 9) & 1) << 5)); }
__host__ __device__ __forceinline__ void stage_rc(int b, int& R, int& C) { const int st = b / 1024, sb = b % 1024, swz = sb ^ (((sb >> 9) & 1) << 5); R = (st >> 1) * 16 + swz / 64; C = (st & 1) * 32 + (swz % 64) / 2; }
__host__ __device__ __forceinline__ int perm32(int rho) { const int n = rho >> 4, i = rho & 15; return 8 * (i >> 2) + 4 * n + (i & 3); }

struct Unit { int pm, pn; };
struct Gemm { const bf16_t* A; const bf16_t* Bt; int M, N, K; };

struct StaticOrder {
    int nM, nN, nwg, G, c;
    __host__ __device__ void init(int M, int N, int G_, int c_) { nM = M / BM; nN = N / BM; nwg = nM * nN; G = G_; c = c_; }
    __host__ __device__ bool next(int i, Unit& u) const {
        const long L = (long)i * G + c; if (L >= nwg) return false;
        int wgid = (int)L; { const int q = nwg / NXCD, r = nwg % NXCD, xcd = wgid % NXCD, off = wgid / NXCD; wgid = (xcd < r ? xcd * (q + 1) : r * (q + 1) + (xcd - r) * q) + off; }
        const int nig = WGM * nN, gid = wgid / nig, fm = gid * WGM, gsz = (nM - fm) < WGM ? (nM - fm) : WGM;
        u.pm = fm + ((wgid % nig) % gsz); u.pn = (wgid % nig) / gsz; return true;
    }
    __device__ __forceinline__ void a_ready(const Unit&) const {}
    __device__ __forceinline__ void done(const Unit&) const {}
};

__device__ __forceinline__ unsigned cvt_pk_bf16(float lo, float hi) { unsigned r; asm volatile("v_cvt_pk_bf16_f32 %0, %1, %2" : "=v"(r) : "v"(lo), "v"(hi)); return r; }
typedef float f32x2 __attribute__((ext_vector_type(2)));
__device__ __forceinline__ f32x2 gelu_pk(f32x2 v) {
    const f32x2 av = __builtin_elementwise_abs(v), d = av * 0.2316418882f + 1.0f;
    f32x2 t; t.x = __builtin_amdgcn_rcpf(d.x); t.y = __builtin_amdgcn_rcpf(d.y);
    f32x2 q = t * 0.5307027145f + (-0.7265760135f); q = q * t + 0.7107068705f; q = q * t + (-0.142248368f); q = q * t + 0.127414796f; q = q * t;
    const f32x2 s = (v * v) * (-0.72134752044f);
    f32x2 e; e.x = __builtin_amdgcn_exp2f(s.x); e.y = __builtin_amdgcn_exp2f(s.y);
    const f32x2 m = v * (q * e), r = v - m;
    f32x2 o; o.x = v.x < 0.f ? m.x : r.x; o.y = v.y < 0.f ? m.y : r.y; return o;
}

template <int ACT  > struct EpiBf16 {
    static constexpr bool PERM = true, AFTER_DRAIN = false, KHOOK = false; static_assert(ACT == 0 || ACT == 1, "EpiBf16: ACT is 0 (none) or 1 (gelu_pk)");
    bf16_t* O; int ldc; const float* bias; int split_cols; size_t split_stride; float scale0;
    __device__ __forceinline__ void operator()(const f32x4 (&acc)[2][2][4][2], const Unit& u, int wr, int wc, int fr, int fq) const {
        const int row0 = u.pm * BM + wr * 64 + fr; int colt = u.pn * BM; bf16_t* base = O;
        float sc = 1.f; if (split_cols) { const int t = colt / split_cols; base += (size_t)t * split_stride; colt -= t * split_cols; if (t == 0) sc = scale0; }
        const int col0 = colt + wc * 32 + 8 * fq, bcol0 = u.pn * BM + wc * 32 + 8 * fq;
        f32x4 bv[2][2];
#pragma unroll
        for (int bj = 0; bj < 2; ++bj)
#pragma unroll
            for (int n = 0; n < 2; ++n) bv[bj][n] = bias ? *(const f32x4*)(bias + bcol0 + bj * HALF + 4 * n) : (f32x4){0.f, 0.f, 0.f, 0.f};
#pragma unroll
        for (int ai = 0; ai < 2; ++ai)
#pragma unroll
            for (int m = 0; m < 4; ++m) { bf16_t* rowp = base + (size_t)(row0 + ai * HALF + m * 16) * ldc + col0;
#pragma unroll
                for (int bj = 0; bj < 2; ++bj) { f32x4 v0 = acc[ai][bj][m][0] + bv[bj][0], v1 = acc[ai][bj][m][1] + bv[bj][1];
                    if (ACT == 1) { f32x2 a = gelu_pk((f32x2){v0[0], v0[1]}), b = gelu_pk((f32x2){v0[2], v0[3]}), c = gelu_pk((f32x2){v1[0], v1[1]}), d = gelu_pk((f32x2){v1[2], v1[3]});
                        v0 = (f32x4){a.x, a.y, b.x, b.y}; v1 = (f32x4){c.x, c.y, d.x, d.y}; }
                    v0 = v0 * sc; v1 = v1 * sc; u32x4 w; w.x = cvt_pk_bf16(v0[0], v0[1]); w.y = cvt_pk_bf16(v0[2], v0[3]); w.z = cvt_pk_bf16(v1[0], v1[1]); w.w = cvt_pk_bf16(v1[2], v1[3]);
                    *(u32x4*)(rowp + bj * HALF) = w; } }
    }
};
struct EpiResid {
    static constexpr bool PERM = false, AFTER_DRAIN = false, KHOOK = false;
    float* C; int ldc; const float* resA; const float* resB; int rowsA; int rowsValid; float alpha;
    __device__ __forceinline__ void operator()(const f32x4 (&acc)[2][2][4][2], const Unit& u, int wr, int wc, int fr, int fq) const {
        const int row0 = u.pm * BM + wr * 64 + fr, col0 = u.pn * BM + wc * 32 + 4 * fq;
#pragma unroll
        for (int ai = 0; ai < 2; ++ai)
#pragma unroll
            for (int m = 0; m < 4; ++m) { const int r = row0 + ai * HALF + m * 16;
                if (r < rowsValid) {
                    const float* rp = (r < rowsA) ? resA + (size_t)r * ldc + col0 : resB + (size_t)(r - rowsA) * ldc + col0;
                    float* cp = C + (size_t)r * ldc + col0;
#pragma unroll
                    for (int bj = 0; bj < 2; ++bj)
#pragma unroll
                        for (int n = 0; n < 2; ++n) { const f32x4 rv = *(const f32x4*)(rp + bj * HALF + n * 16); *(f32x4*)(cp + bj * HALF + n * 16) = rv * alpha + acc[ai][bj][m][n]; } }
                asm volatile("" ::: "memory"); }
    }
};

struct EpiResidScale {
    static constexpr bool PERM = false, AFTER_DRAIN = false, KHOOK = true;
    float* C; int ldc; const unsigned short* res; float alpha; const float* SS; float eps;
    __device__ __forceinline__ void unit_begin(const Unit& u, int par, PG8_LAS unsigned char* lds) const {
        const int tid = threadIdx.x, row = tid >> 1, hh = 4 * (tid & 1);
        float sv[4];
        { const f32x4* sp = (const f32x4*)(SS + ((size_t)(u.pm * BM + row) * 8 + hh) * 8);
#pragma unroll
          for (int q = 0; q < 4; ++q) { const f32x4 a = sp[2 * q], b = sp[2 * q + 1]; sv[q] = (a.x + a.y) + (a.z + a.w) + (b.x + b.y) + (b.z + b.w); asm volatile("" ::: "memory"); } }
        const f32x4 s = (f32x4){sv[0], sv[1], sv[2], sv[3]};
        f32x4 rs; rs.x = __builtin_amdgcn_rsqf(s.x * (1.f / 1024.f) + eps); rs.y = __builtin_amdgcn_rsqf(s.y * (1.f / 1024.f) + eps); rs.z = __builtin_amdgcn_rsqf(s.z * (1.f / 1024.f) + eps); rs.w = __builtin_amdgcn_rsqf(s.w * (1.f / 1024.f) + eps);
        *(PG8_LAS f32x4*)(lds + 131072 + par * 8192 + (row * 8 + hh) * 4) = rs;
    }
    __device__ __forceinline__ void khook(f32x4 (&acc)[2][2][4][2], int par, int hb, int wr, int fr, PG8_LAS unsigned char* lds) const {
        const PG8_LAS float* T = (const PG8_LAS float*)(lds + 131072 + par * 8192);
        typedef float f32x2h __attribute__((ext_vector_type(2)));
        f32x2h tv[8]; unsigned ad[8];
#pragma unroll
        for (int i = 0; i < 8; ++i) ad[i] = (unsigned)(size_t)(T + ((i >> 2) * HALF + wr * 64 + (i & 3) * 16 + fr) * 8 + hb - 1);
        asm volatile("ds_read2_b32 %0, %8 offset1:1\n\tds_read2_b32 %1, %9 offset1:1\n\tds_read2_b32 %2, %10 offset1:1\n\tds_read2_b32 %3, %11 offset1:1\n\t"
                     "ds_read2_b32 %4, %12 offset1:1\n\tds_read2_b32 %5, %13 offset1:1\n\tds_read2_b32 %6, %14 offset1:1\n\tds_read2_b32 %7, %15 offset1:1\n\ts_waitcnt lgkmcnt(0)\n\ts_nop 15\n\ts_nop 15"
                     : "=&v"(tv[0]), "=&v"(tv[1]), "=&v"(tv[2]), "=&v"(tv[3]), "=&v"(tv[4]), "=&v"(tv[5]), "=&v"(tv[6]), "=&v"(tv[7])
                     : "v"(ad[0]), "v"(ad[1]), "v"(ad[2]), "v"(ad[3]), "v"(ad[4]), "v"(ad[5]), "v"(ad[6]), "v"(ad[7]) : "memory");
#pragma unroll
        for (int ai = 0; ai < 2; ++ai)
#pragma unroll
            for (int m = 0; m < 4; ++m) { const float ratio = tv[ai * 4 + m].x * __builtin_amdgcn_rcpf(tv[ai * 4 + m].y);
#pragma unroll
                for (int bj = 0; bj < 2; ++bj)
#pragma unroll
                    for (int n = 0; n < 2; ++n) { f32x4& a = acc[ai][bj][m][n];
                        asm volatile("v_mul_f32 %0, %0, %4\n\tv_mul_f32 %1, %1, %4\n\tv_mul_f32 %2, %2, %4\n\tv_mul_f32 %3, %3, %4\n\ts_nop 1" : "+v"(a.x), "+v"(a.y), "+v"(a.z), "+v"(a.w) : "v"(ratio)); } }
    }
    __device__ __forceinline__ void epi(const f32x4 (&acc)[2][2][4][2], const Unit& u, int wr, int wc, int fr, int fq, int par, PG8_LAS unsigned char* lds) const {
        const PG8_LAS float* T = (const PG8_LAS float*)(lds + 131072 + par * 8192);
        const int row0 = u.pm * BM + wr * 64 + fr, col0 = u.pn * BM + wc * 32 + 4 * fq;
#pragma unroll
        for (int ai = 0; ai < 2; ++ai)
#pragma unroll
            for (int m = 0; m < 4; ++m) { const int r = row0 + ai * HALF + m * 16; const float sc = T[(ai * HALF + wr * 64 + m * 16 + fr) * 8 + 7];
                const unsigned short* rp = res + (size_t)r * ldc + col0; float* cp = C + (size_t)r * ldc + col0;
#pragma unroll
                for (int bj = 0; bj < 2; ++bj)
#pragma unroll
                    for (int n = 0; n < 2; ++n) { const uint2 rb = *(const uint2*)(rp + bj * HALF + n * 16);
                        const f32x4 rv = (f32x4){__builtin_bit_cast(float, rb.x << 16), __builtin_bit_cast(float, rb.x & 0xffff0000u), __builtin_bit_cast(float, rb.y << 16), __builtin_bit_cast(float, rb.y & 0xffff0000u)};
                        *(f32x4*)(cp + bj * HALF + n * 16) = rv * alpha + acc[ai][bj][m][n] * sc; }
                asm volatile("" ::: "memory"); }
    }
};


template <class Epi, class Sched, bool ALIGN_EPI = false, bool SP2 = false>
__device__ __forceinline__ void gemm_phase(PG8_LAS unsigned char* lds, const Gemm g, const Sched& S, const Epi& E) {
    const int tid = threadIdx.x, wid = __builtin_amdgcn_readfirstlane(tid >> 6), lane = tid & 63, wr = wid >> 2, wc = wid & 3, fr = lane & 15, fq = lane >> 4;
    const int K = g.K, nt = K / BK;
    unsigned voffA[2], voffB[2];
#pragma unroll
    for (int i = 0; i < 2; ++i) { int R, C; stage_rc(tid * 16 + i * 8192, R, C); const int Rb = Epi::PERM ? ((R & ~31) + perm32(R & 31)) : R;
        voffA[i] = (unsigned)(R * K + C) * 2u; voffB[i] = (unsigned)(Rb * K + C) * 2u; }
    const size_t kstep = (size_t)(BK * 2);
    const size_t hstep = (size_t)HALF * K * 2;
    const size_t tstep = 2 * hstep;
    const unsigned ldsw = (unsigned)wid * 1024u;
    const int aoff = lds_byte(wr * 64 + fr, fq * 8), boff = lds_byte(wc * 32 + fr, fq * 8);
#define PG8_SA(b, h) (((b) * 2 + (h)) * HTB)
#define PG8_SB(b, h) ((4 + (b) * 2 + (h)) * HTB)
#define PG8_STAGE(bufoff, gbase, voff) do { _Pragma("unroll") for (int _i = 0; _i < 2; ++_i) \
        __builtin_amdgcn_global_load_lds((const unsigned*)((const char*)(gbase) + (voff)[_i]), (PG8_LAS unsigned*)(lds + (bufoff) + ldsw + _i * 8192), 16, 0, 0); } while (0)
#define PG8_LDA(dst, b, h) do { _Pragma("unroll") for (int m = 0; m < 4; ++m) _Pragma("unroll") for (int k = 0; k < 2; ++k) dst[m][k] = *(const PG8_LAS bf16x8*)(lds + PG8_SA(b, h) + aoff + m * 2048 + k * 1024); } while (0)
#define PG8_LDB(dst, b, h) do { _Pragma("unroll") for (int n = 0; n < 2; ++n) _Pragma("unroll") for (int k = 0; k < 2; ++k) dst[n][k] = *(const PG8_LAS bf16x8*)(lds + PG8_SB(b, h) + boff + n * 2048 + k * 1024); } while (0)
#define PG8_MMA(ai, bj, At, Bt) do { __builtin_amdgcn_s_setprio(1); _Pragma("unroll") for (int m = 0; m < 4; ++m) _Pragma("unroll") for (int n = 0; n < 2; ++n) _Pragma("unroll") for (int k = 0; k < 2; ++k) \
        acc[ai][bj][m][n] = __builtin_amdgcn_mfma_f32_16x16x32_bf16(Bt[n][k], At[m][k], acc[ai][bj][m][n], 0, 0, 0); __builtin_amdgcn_s_setprio(0); } while (0)
#define PG8_WAIT_V(n) asm volatile("s_waitcnt vmcnt(" #n ")" ::: "memory")
#define PG8_WAIT_L(n) asm volatile("s_waitcnt lgkmcnt(" #n ")" ::: "memory")
#define PG8_BAR __builtin_amdgcn_s_barrier()
#define PG8_SCHED __builtin_amdgcn_sched_barrier(0)
    Unit cur, nxt; int ui = 0;
    if (!S.next(0, cur)) return;
    f32x4 acc[2][2][4][2];
#pragma unroll
    for (int a = 0; a < 2; ++a)
#pragma unroll
        for (int b = 0; b < 2; ++b)
#pragma unroll
            for (int m = 0; m < 4; ++m)
#pragma unroll
                for (int n = 0; n < 2; ++n) acc[a][b][m][n] = (f32x4){0.f, 0.f, 0.f, 0.f};
    bf16x8 At[4][2], B0[2][2], B1[2][2];
    const char* cA = (const char*)g.A + (size_t)cur.pm * tstep; const char* cB = (const char*)g.Bt + (size_t)cur.pn * tstep;
    if constexpr (Epi::KHOOK) E.unit_begin(cur, ui & 1, lds);
    S.a_ready(cur);
    if constexpr (SP2) {
        PG8_STAGE(PG8_SB(0, 0), cB, voffB); PG8_STAGE(PG8_SB(0, 1), cB + hstep, voffB); PG8_STAGE(PG8_SA(0, 0), cA, voffA); PG8_STAGE(PG8_SA(0, 1), cA + hstep, voffA);
        if (wr == 1) PG8_BAR;
        PG8_WAIT_V(2); PG8_BAR;
        PG8_STAGE(PG8_SB(1, 0), cB + kstep, voffB); PG8_STAGE(PG8_SA(1, 0), cA + kstep, voffA); PG8_STAGE(PG8_SB(1, 1), cB + hstep + kstep, voffB);
        PG8_WAIT_V(6); PG8_BAR;
    } else {
        PG8_STAGE(PG8_SB(0, 0), cB, voffB); PG8_STAGE(PG8_SA(0, 0), cA, voffA); PG8_STAGE(PG8_SB(0, 1), cB + hstep, voffB); PG8_STAGE(PG8_SA(0, 1), cA + hstep, voffA);
        if (wr == 1) PG8_BAR;
        PG8_WAIT_V(4); PG8_BAR;
        PG8_STAGE(PG8_SB(1, 0), cB + kstep, voffB); PG8_STAGE(PG8_SA(1, 0), cA + kstep, voffA); PG8_STAGE(PG8_SB(1, 1), cB + hstep + kstep, voffB);
        PG8_WAIT_V(6); PG8_BAR;
    }
    for (;;) {
        const bool has_next = S.next(ui + 1, nxt);
        const char* nA = has_next ? (const char*)g.A + (size_t)nxt.pm * tstep : cA; const char* nB = has_next ? (const char*)g.Bt + (size_t)nxt.pn * tstep : cB;
        const int tseg = Epi::KHOOK ? 16 : nt;
        for (int tb = 0; tb < nt; tb += tseg) {
        if constexpr (Epi::KHOOK) { if (tb != 0) { PG8_SCHED; E.khook(acc, ui & 1, tb >> 4, wr, fr, lds); PG8_SCHED; } }
        for (int t = tb; t < tb + tseg; t += 2) {
            const bool last = (t == nt - 2);
            const char* a1 = cA + (size_t)(t + 1) * kstep;
            const char* a2 = last ? nA : cA + (size_t)(t + 2) * kstep; const char* b2 = last ? nB : cB + (size_t)(t + 2) * kstep;
            const char* a3 = a2 + kstep; const char* b3 = b2 + kstep;
            if (last && has_next) S.a_ready(nxt);
            if constexpr (SP2) {
            PG8_LDB(B0, 0, 0); PG8_LDB(B1, 0, 1); PG8_SCHED; PG8_LDA(At, 0, 0); PG8_STAGE(PG8_SA(1, 1), a1 + hstep, voffA);
            PG8_WAIT_V(8); PG8_WAIT_L(0); PG8_BAR; PG8_MMA(0, 0, At, B0); PG8_MMA(0, 1, At, B1); PG8_BAR; PG8_SCHED;
            PG8_LDA(At, 0, 1); PG8_STAGE(PG8_SB(0, 0), b2, voffB); PG8_STAGE(PG8_SB(0, 1), b2 + hstep, voffB); PG8_STAGE(PG8_SA(0, 0), a2, voffA);
            PG8_WAIT_V(8); PG8_WAIT_L(0); PG8_BAR; PG8_MMA(1, 0, At, B0); PG8_MMA(1, 1, At, B1); PG8_BAR; PG8_SCHED;
            PG8_LDB(B0, 1, 0); PG8_LDB(B1, 1, 1); PG8_SCHED; PG8_LDA(At, 1, 0); PG8_STAGE(PG8_SA(0, 1), a2 + hstep, voffA);
            PG8_WAIT_V(8); PG8_WAIT_L(0); PG8_BAR; PG8_MMA(0, 0, At, B0); PG8_MMA(0, 1, At, B1); PG8_BAR; PG8_SCHED;
            PG8_LDA(At, 1, 1); PG8_STAGE(PG8_SB(1, 0), b3, voffB); PG8_STAGE(PG8_SB(1, 1), b3 + hstep, voffB); PG8_STAGE(PG8_SA(1, 0), a3, voffA);
            PG8_WAIT_V(8); PG8_WAIT_L(0); PG8_BAR; PG8_MMA(1, 0, At, B0); PG8_MMA(1, 1, At, B1); PG8_BAR; PG8_SCHED;
            } else {
            PG8_LDB(B0, 0, 0); PG8_SCHED; PG8_LDA(At, 0, 0); PG8_STAGE(PG8_SA(1, 1), a1 + hstep, voffA);
            PG8_WAIT_L(8); PG8_BAR; PG8_WAIT_L(0); PG8_MMA(0, 0, At, B0); PG8_BAR; PG8_SCHED;
            PG8_LDB(B1, 0, 1); PG8_STAGE(PG8_SB(0, 0), b2, voffB);
            PG8_BAR; PG8_WAIT_L(0); PG8_MMA(0, 1, At, B1); PG8_BAR;
            PG8_LDA(At, 0, 1); PG8_STAGE(PG8_SA(0, 0), a2, voffA);
            PG8_BAR; PG8_WAIT_L(0); PG8_MMA(1, 0, At, B0); PG8_BAR; PG8_SCHED;
            PG8_STAGE(PG8_SB(0, 1), b2 + hstep, voffB);
            PG8_WAIT_V(6); PG8_BAR; PG8_MMA(1, 1, At, B1); PG8_BAR;
            PG8_LDB(B0, 1, 0); PG8_SCHED; PG8_LDA(At, 1, 0); PG8_STAGE(PG8_SA(0, 1), a2 + hstep, voffA);
            PG8_WAIT_L(8); PG8_BAR; PG8_WAIT_L(0); PG8_MMA(0, 0, At, B0); PG8_BAR; PG8_SCHED;
            PG8_LDB(B1, 1, 1); PG8_STAGE(PG8_SB(1, 0), b3, voffB);
            PG8_BAR; PG8_WAIT_L(0); PG8_MMA(0, 1, At, B1); PG8_BAR;
            PG8_LDA(At, 1, 1); PG8_STAGE(PG8_SA(1, 0), a3, voffA);
            PG8_BAR; PG8_WAIT_L(0); PG8_MMA(1, 0, At, B0); PG8_BAR; PG8_SCHED;
            PG8_STAGE(PG8_SB(1, 1), b3 + hstep, voffB);
            PG8_WAIT_V(6); PG8_BAR; PG8_MMA(1, 1, At, B1); PG8_BAR;
            }
        }
        }
        if constexpr (ALIGN_EPI) { if (wr == 0) PG8_BAR; }
        if constexpr (Epi::KHOOK) { E.epi(acc, cur, wr, wc, fr, fq, ui & 1, lds); S.done(cur); }
        else if constexpr (!Epi::AFTER_DRAIN) { E(acc, cur, wr, wc, fr, fq); S.done(cur); }
        if (!has_next) break;
#pragma unroll
        for (int a = 0; a < 2; ++a)
#pragma unroll
            for (int b = 0; b < 2; ++b)
#pragma unroll
                for (int m = 0; m < 4; ++m)
#pragma unroll
                    for (int n = 0; n < 2; ++n) acc[a][b][m][n] = (f32x4){0.f, 0.f, 0.f, 0.f};
        cur = nxt; cA = nA; cB = nB; ++ui;
        if constexpr (Epi::KHOOK) E.unit_begin(cur, ui & 1, lds);
        if constexpr (ALIGN_EPI) { if (wr == 1) PG8_BAR; }
    }
    PG8_WAIT_V(0);
    if constexpr (!ALIGN_EPI) { if (wr == 0) PG8_BAR; }
    PG8_BAR;
    if constexpr (Epi::AFTER_DRAIN) { E.fused(acc, cur, wr, wc, fr, fq, lds, wid, lane); S.done(cur); }
#undef PG8_SA
#undef PG8_SB
#undef PG8_STAGE
#undef PG8_LDA
#undef PG8_LDB
#undef PG8_MMA
#undef PG8_WAIT_V
#undef PG8_WAIT_L
#undef PG8_BAR
#undef PG8_SCHED
}
}
#ifndef PG8_SP2
#define PG8_SP2 true
#endif
#ifndef PG8_ALIGN
#define PG8_ALIGN true
#endif

constexpr int NWAVES = 8;
constexpr int PER_PHASE = 12;
#ifndef MK_N_LAUNCHES
#define MK_N_LAUNCHES 1
#endif
#ifndef PROBE_MASK
#define PROBE_MASK 0
#endif
#define REP(k) (((PROBE_MASK >> (k)) & 1) + 1)
#ifndef PROBE_VAR
#define PROBE_VAR 0
#endif
#ifndef PROBE_CLK
#define PROBE_CLK 0
#endif
#ifndef STAMP_MASK
#define STAMP_MASK 0
#endif
#ifndef USE_AUX
#define USE_AUX 0
#endif
#ifndef USE_TILE_TRANSPOSE
#define USE_TILE_TRANSPOSE 0
#endif
#ifndef USE_L1_SEQ2
#define USE_L1_SEQ2 0
#endif
#ifndef USE_FUSED_NORM
#define USE_FUSED_NORM 1
#define RES_BF16 (USE_FUSED_NORM && USE_L1_MFMA)
#endif
#ifndef P0_META_FOLD
#define P0_META_FOLD (USE_L0_MFMA == 2 && !USE_TILE_TRANSPOSE)
#endif
#ifndef USE_TICKETS
#define USE_TICKETS 0
#endif
constexpr int N_LAUNCHES = MK_N_LAUNCHES;

constexpr int D = 4096, NB = 4, SEQ = 2048, NMETA = 16, DI = 8192;
constexpr int MX = NB * SEQ;
constexpr int MR = MX + NMETA;
constexpr int MP = 8448;
constexpr int N0 = 4 * DI;
constexpr int N1 = 2 * 4096 + 2 * DI;
constexpr int HG_H = 64, HG_DK = 128;
constexpr int GL_H = 8, GL_DK = 512, GL_DV = 1024, GL_R = 16;
constexpr float LN_EPS = 1e-5f, RMS_EPS = 1e-6f;
constexpr float ALPHA = 1.41421356237309515f;

constexpr size_t MiB = 1u << 20;
constexpr size_t WS_CTL = 0, CTL_ZERO_BYTES = 1 * MiB;
constexpr size_t WS_LB0 = 1 * MiB;
constexpr size_t WS_G1 = 2 * MiB;
constexpr size_t WS_WG1T = 3 * MiB;
constexpr size_t WS_W2F = 3 * MiB + 256 * 1024;
constexpr size_t WS_WT0IN = 4 * MiB;
constexpr size_t WS_WT0OUT = WS_WT0IN + 256 * MiB;
constexpr size_t WS_WT1IN = WS_WT0OUT + 64 * MiB;
constexpr size_t WS_WT1OUT = WS_WT1IN + 192 * MiB;
constexpr size_t WS_XB = WS_WT1OUT + 64 * MiB;
constexpr size_t WS_H1B = WS_XB + 66 * MiB;
constexpr size_t WS_QFIZ = WS_H1B + 66 * MiB;
constexpr size_t WS_Y = WS_QFIZ + 528 * MiB;
constexpr size_t WS_PRE = WS_Y + 132 * MiB;
constexpr size_t WS_REC = WS_PRE + 132 * MiB;
constexpr size_t WS_Q0 = WS_REC + 520 * MiB;
constexpr size_t WS_Y0 = WS_REC + 523 * MiB;
constexpr size_t WS_REC1 = WS_REC, WS_VF1 = WS_REC + 139 * MiB, WS_O1 = WS_REC + 270 * MiB;
constexpr size_t WS_END = WS_REC + 528 * MiB;
static_assert((size_t)MP * D * 2 <= 66 * MiB && (size_t)MP * N0 * 2 <= 528 * MiB && (size_t)MP * DI * 2 <= 132 * MiB && (size_t)MP * D * 4 <= 132 * MiB && (size_t)MR * DI * 4 <= 258 * MiB, "d_ws map");
static_assert((size_t)256 * 65 * 27648 <= 440 * MiB && (size_t)32 * 65 * 69632 <= 139 * MiB && (size_t)32 * 65 * 65536 <= 131 * MiB, "record map");
constexpr int CW_BAR = 4096, CW_POOL = 8192;

constexpr int RING_OFF = 0, RING_BYTES = 155648;
constexpr int LDSCTL_OFF = RING_BYTES, MISC_OFF = LDSCTL_OFF + 320;
constexpr int LDS_BYTES = 163840;
static_assert(MISC_OFF + 128 <= LDS_BYTES, "LDS map");

#define GAS __attribute__((address_space(1)))
#define LAS __attribute__((address_space(3)))
typedef unsigned short bf16;
typedef unsigned v4u __attribute__((ext_vector_type(4)));
typedef unsigned v2u __attribute__((ext_vector_type(2)));
typedef float f32x4 __attribute__((ext_vector_type(4)));
typedef GAS unsigned gu32;
#define RLX_AGENT __ATOMIC_RELAXED, __HIP_MEMORY_SCOPE_AGENT
#define LDS_WAIT() asm volatile("s_waitcnt lgkmcnt(0)" ::: "memory")
#define DI_ __device__ __forceinline__
DI_ unsigned f2bf(float f) { unsigned u = __builtin_bit_cast(unsigned, f); return (u + 0x7fffu + ((u >> 16) & 1u)) >> 16; }
DI_ unsigned pk2(float lo, float hi) { return f2bf(lo) | (f2bf(hi) << 16); }
DI_ unsigned hwpk(float lo, float hi) { unsigned r; asm volatile("v_cvt_pk_bf16_f32 %0, %1, %2" : "=v"(r) : "v"(lo), "v"(hi)); return r; }
DI_ float bflo(unsigned w) { return __builtin_bit_cast(float, w << 16); }
DI_ float bfhi(unsigned w) { return __builtin_bit_cast(float, w & 0xffff0000u); }
DI_ float bf2f(bf16 b) { return __builtin_bit_cast(float, (unsigned)b << 16); }
DI_ float sigm(float x) { return __builtin_amdgcn_rcpf(1.f + __builtin_amdgcn_exp2f(x * -1.4426950408889634f)); }
DI_ float silu(float x) { return x * __builtin_amdgcn_rcpf(1.f + __builtin_amdgcn_exp2f(x * -1.4426950408889634f)); }

#define XB_TMO      128
#define XB_XCNT(j)  (256  + 64 * (j))
#define XB_XSUB(j)  (1280 + 64 * (j))
#define XB_XGEN(j)  (2304 + 64 * (j))
#define XB_TOP      3328
#define XB_TOPGEN   3392
#define XCD_BAR_WORDS 3456
#define XB_SPIN_CAP (1u << 18)

__device__ __forceinline__ unsigned xb_ld(unsigned* p)              { return __hip_atomic_load(p, __ATOMIC_RELAXED, __HIP_MEMORY_SCOPE_AGENT); }
__device__ __forceinline__ unsigned xb_add(unsigned* p, unsigned v) { return __hip_atomic_fetch_add(p, v, __ATOMIC_RELAXED, __HIP_MEMORY_SCOPE_AGENT); }
__device__ __forceinline__ unsigned xb_xcc_id() { return (unsigned)__builtin_amdgcn_s_getreg((3 << 11) | 20) & 0xFu; }
#define XB_SPIN(cond, bar) do { unsigned _sp = 0; while (cond) { __builtin_amdgcn_s_sleep(1); \
    if ((++_sp & 255u) == 0u) { if (xb_ld(&(bar)[XB_TMO])) break; if (_sp > XB_SPIN_CAP) { atomicAdd(&(bar)[XB_TMO], 1u); break; } } } } while (0)

struct XcdBarrier {
    unsigned* bar; unsigned x;
    volatile LAS unsigned* st;
};
__device__ __forceinline__ XcdBarrier xcd_barrier_post(unsigned* bar, volatile LAS unsigned* st) {
    XcdBarrier b; b.bar = bar; b.x = xb_xcc_id(); b.st = st;
    if (threadIdx.x == 0) (void)xb_add(&bar[XB_XCNT(b.x)], 1u);
    return b;
}
__device__ __forceinline__ void xcd_barrier_complete(unsigned* bar, unsigned x, unsigned& nloc, unsigned& nx) {
    const unsigned G = gridDim.x * gridDim.y * gridDim.z;
    unsigned sum, cnt, mine, sp = 0u;
    for (;;) {
        sum = 0u; cnt = 0u; mine = 0u;
#pragma unroll
        for (unsigned j = 0; j < 16; ++j) { const unsigned c = xb_ld(&bar[XB_XCNT(j)]); sum += c; cnt += (c > 0u) ? 1u : 0u; mine = (j == x) ? c : mine; }
        if (sum == G) break;
        __builtin_amdgcn_s_sleep(1);
        if ((++sp & 255u) == 0u) { if (xb_ld(&bar[XB_TMO])) break; if (sp > XB_SPIN_CAP) { atomicAdd(&bar[XB_TMO], 1u); break; } }
    }
    nloc = mine > 0u ? mine : 1u; nx = cnt > 0u ? cnt : 1u;
}
__device__ __forceinline__ void xcd_barrier(const XcdBarrier& b) {
    asm volatile("s_waitcnt vmcnt(0)" ::: "memory");
    __syncthreads();
    if (threadIdx.x == 0) {
        unsigned* bar = b.bar;
        __builtin_amdgcn_s_waitcnt(0);
        unsigned nloc = b.st[0], nx = b.st[1];
        if (nloc == 0u) { xcd_barrier_complete(bar, b.x, nloc, nx); b.st[0] = nloc; b.st[1] = nx; }
        const unsigned old = xb_add(&bar[XB_XSUB(b.x)], 1u);
        const unsigned gen = old / nloc;
        if (old + 1u == (gen + 1u) * nloc) {
            __builtin_amdgcn_fence(__ATOMIC_RELEASE, "agent");
            asm volatile("s_waitcnt vmcnt(0)" ::: "memory");
            const unsigned og = xb_add(&bar[XB_TOP], 1u);
            const unsigned tg = og / nx;
            if (og + 1u == (tg + 1u) * nx) xb_add(&bar[XB_TOPGEN], 1u);
            else XB_SPIN(xb_ld(&bar[XB_TOPGEN]) == tg, bar);
            __builtin_amdgcn_fence(__ATOMIC_ACQUIRE, "agent");
            xb_add(&bar[XB_XGEN(b.x)], 1u);
            asm volatile("s_waitcnt vmcnt(0)" ::: "memory");
        } else {
            XB_SPIN(xb_ld(&bar[XB_XGEN(b.x)]) == gen, bar);
            __builtin_amdgcn_fence(__ATOMIC_ACQUIRE, "agent");
            asm volatile("s_waitcnt vmcnt(0)" ::: "memory");
        }
    }
    __syncthreads();
}

struct Frame {
    LAS unsigned char* lds;
    volatile LAS unsigned* MISC;
    gu32* ctl;
    int tid, lane, wave;
    int vcu, G;
    const float *x, *meta, *lb_logits;
    const float *w0in, *b_f, *ng0, *w0out, *ln0g, *ln0b;
    const float *w1in, *wg1, *wg2, *b_g, *ng1, *w1out, *ln1g, *ln1b;
    float* out;
    float *LB0, *G1, *PRE, *O1;
    unsigned char *REC0, *REC1, *VF1;
    bf16 *WG1T, *W2F, *Q0, *Y0;
    float* SS;
    bf16 *WT0IN, *WT0OUT, *WT1IN, *WT1OUT, *XB, *H1B, *QFIZ, *Y;
};

DI_ float wave_sum(float v) {
#pragma unroll
    for (int o = 1; o < 64; o <<= 1) v += __shfl_xor(v, o);
    return v;
}

typedef short p0_bf16x8 __attribute__((ext_vector_type(8)));
template <bool META>
DI_ void p0_transpose_item_t(const float* W, int K, int N, bf16* WT, LAS float* scr, int item_kb, int item_nb, int lane, const float* meta, f32x4 (&macc)[2]) {
    const int k0 = 64 * item_kb, n0 = 32 * item_nb;
    float wv[32];
#pragma unroll
    for (int i = 0; i < 32; ++i) wv[i] = __builtin_nontemporal_load(W + (size_t)(k0 + 2 * i + (lane >> 5)) * N + n0 + (lane & 31));
    v4u ma[2][2];
    if (META) {
#pragma unroll
        for (int ks = 0; ks < 2; ++ks) { const GAS f32x4* mp = (const GAS f32x4*)(meta + (size_t)(lane & 15) * D + k0 + 32 * ks + 8 * (lane >> 4)); const f32x4 a = mp[0], b = mp[1];
            ma[ks][0] = (v4u){hwpk(a.x, a.y), hwpk(a.z, a.w), hwpk(b.x, b.y), hwpk(b.z, b.w)}; }
    }
#pragma unroll
    for (int i = 0; i < 32; ++i) scr[(2 * i + (lane >> 5)) * 33 + (lane & 31)] = wv[i];
    LDS_WAIT(); asm volatile("" ::: "memory");
    if (META) {
        const int r = lane & 15, g = lane >> 4;
#pragma unroll
        for (int ks = 0; ks < 2; ++ks)
#pragma unroll
            for (int nh = 0; nh < 2; ++nh) { const LAS float* s = scr + (32 * ks + 8 * g) * 33 + 16 * nh + r;
                const v4u bf = (v4u){hwpk(s[0 * 33], s[1 * 33]), hwpk(s[2 * 33], s[3 * 33]), hwpk(s[4 * 33], s[5 * 33]), hwpk(s[6 * 33], s[7 * 33])};
                macc[nh] = __builtin_amdgcn_mfma_f32_16x16x32_bf16(__builtin_bit_cast(p0_bf16x8, ma[ks][0]), __builtin_bit_cast(p0_bf16x8, bf), macc[nh], 0, 0, 0); }
    }
    const int c = lane & 7;
#pragma unroll
    for (int j = 0; j < 4; ++j) { const int n = (lane >> 3) + 8 * j; const LAS float* s = scr + (8 * c) * 33 + n;
        v4u o; o.x = hwpk(s[0 * 33], s[1 * 33]); o.y = hwpk(s[2 * 33], s[3 * 33]); o.z = hwpk(s[4 * 33], s[5 * 33]); o.w = hwpk(s[6 * 33], s[7 * 33]);
        *(GAS v4u*)(WT + (size_t)(n0 + n) * K + k0 + 8 * c) = o; }
    LDS_WAIT(); asm volatile("" ::: "memory");
}
struct P0Item { const float* src; bf16* dst; int N, K; };
template <bool META, bool PREF>
DI_ void p0_item_pipe(const P0Item cur, const P0Item nxt, float (&wv)[32], f32x4 (&mraw)[4], LAS float* scr, int lane, const float* meta_nxt, f32x4 (&macc)[2]) {
#pragma unroll
    for (int i = 0; i < 32; ++i) scr[(2 * i + (lane >> 5)) * 33 + (lane & 31)] = wv[i];
    v4u ma[2];
    if (META) {
#pragma unroll
        for (int ks = 0; ks < 2; ++ks) { const f32x4 a = mraw[2 * ks], b = mraw[2 * ks + 1]; ma[ks] = (v4u){pk2(a.x, a.y), pk2(a.z, a.w), pk2(b.x, b.y), pk2(b.z, b.w)}; }
    }
    if (PREF) {
        if (META) {
#pragma unroll
            for (int ks = 0; ks < 2; ++ks) { const GAS f32x4* mp = (const GAS f32x4*)(meta_nxt + (size_t)(lane & 15) * D + 32 * ks + 8 * (lane >> 4)); mraw[2 * ks] = mp[0]; mraw[2 * ks + 1] = mp[1]; }
        }
#pragma unroll
        for (int i = 0; i < 32; ++i) wv[i] = __builtin_nontemporal_load(nxt.src + (size_t)(2 * i + (lane >> 5)) * nxt.N + (lane & 31));
    }
    LDS_WAIT(); asm volatile("" ::: "memory");
    if (META) {
        const int r = lane & 15, g = lane >> 4;
#pragma unroll
        for (int ks = 0; ks < 2; ++ks)
#pragma unroll
            for (int nh = 0; nh < 2; ++nh) { const LAS float* s = scr + (32 * ks + 8 * g) * 33 + 16 * nh + r;
                const v4u bf = (v4u){hwpk(s[0 * 33], s[1 * 33]), hwpk(s[2 * 33], s[3 * 33]), hwpk(s[4 * 33], s[5 * 33]), hwpk(s[6 * 33], s[7 * 33])};
                macc[nh] = __builtin_amdgcn_mfma_f32_16x16x32_bf16(__builtin_bit_cast(p0_bf16x8, ma[ks]), __builtin_bit_cast(p0_bf16x8, bf), macc[nh], 0, 0, 0); }
    }
    const int c = lane & 7;
#pragma unroll
    for (int j = 0; j < 4; ++j) { const int n = (lane >> 3) + 8 * j; const LAS float* s = scr + (8 * c) * 33 + n;
        v4u o; o.x = hwpk(s[0 * 33], s[1 * 33]); o.y = hwpk(s[2 * 33], s[3 * 33]); o.z = hwpk(s[4 * 33], s[5 * 33]); o.w = hwpk(s[6 * 33], s[7 * 33]);
        *(GAS v4u*)(cur.dst + (size_t)n * cur.K + 8 * c) = o; }
    LDS_WAIT(); asm volatile("" ::: "memory");
}
struct P0Grp { const float* src; bf16* dst; int N, K; };
template <typename T> DI_ T* p0_uni(T* p) { const unsigned long long a = (unsigned long long)p; const unsigned lo = __builtin_amdgcn_readfirstlane((unsigned)a), hi = __builtin_amdgcn_readfirstlane((unsigned)(a >> 32)); return (T*)(((unsigned long long)hi << 32) | lo); }
DI_ P0Grp p0_uni(const P0Grp& x) { return P0Grp{p0_uni(x.src), p0_uni(x.dst), __builtin_amdgcn_readfirstlane(x.N), __builtin_amdgcn_readfirstlane(x.K)}; }
constexpr int P0_PITCH = 528, P0_TILE = 17408;
template <bool META, bool LAST>
DI_ void p0_group(const P0Grp cur, const P0Grp nxt, float (&wv)[2][32], f32x4 (&mraw)[2][4], LAS unsigned char* tile, int lane, const float* meta_cur, const float* meta_nxt, f32x4 (&macc)[2]) {
    const int half = lane >> 5, n = lane & 31, r = lane & 15, g = lane >> 4;
#pragma unroll
    for (int q = 0; q < 4; ++q) {
        unsigned dw[16];
#pragma unroll
        for (int p = 0; p < 16; ++p) dw[p] = hwpk(wv[q & 1][2 * p], wv[q & 1][2 * p + 1]);
#pragma unroll
        for (int t = 0; t < 4; ++t) *(LAS v4u*)(tile + n * P0_PITCH + (64 * q + 32 * half) * 2 + 16 * t) = (v4u){dw[4 * t], dw[4 * t + 1], dw[4 * t + 2], dw[4 * t + 3]};
        asm volatile("" ::: "memory");
        v4u ma[2];
        if (META) {
#pragma unroll
            for (int ks = 0; ks < 2; ++ks) { const f32x4 a = mraw[q & 1][2 * ks], b = mraw[q & 1][2 * ks + 1]; ma[ks] = (v4u){pk2(a.x, a.y), pk2(a.z, a.w), pk2(b.x, b.y), pk2(b.z, b.w)}; }
        }
        if (!(LAST && q >= 2)) {
            const float* ns = (q < 2) ? cur.src + (size_t)(64 * (q + 2)) * cur.N : nxt.src + (size_t)(64 * (q - 2)) * nxt.N; const int nN = (q < 2) ? cur.N : nxt.N;
            if (META) { const float* mn = (q < 2) ? meta_cur + 64 * (q + 2) : meta_nxt + 64 * (q - 2);
#pragma unroll
                for (int ks = 0; ks < 2; ++ks) { const GAS f32x4* mp = (const GAS f32x4*)(mn + (size_t)r * D + 32 * ks + 8 * g); mraw[q & 1][2 * ks] = mp[0]; mraw[q & 1][2 * ks + 1] = mp[1]; } }
            const unsigned lo_ = (unsigned)(32 * half) * (unsigned)nN + n;
#pragma unroll
            for (int i = 0; i < 32; ++i) wv[q & 1][i] = __builtin_nontemporal_load((const GAS float*)(ns + (size_t)i * nN) + lo_);
        }
        asm volatile("" ::: "memory");
        if (META) {
            LDS_WAIT(); asm volatile("" ::: "memory");
#pragma unroll
            for (int ks = 0; ks < 2; ++ks)
#pragma unroll
                for (int nh = 0; nh < 2; ++nh) { const p0_bf16x8 bf = *(const LAS p0_bf16x8*)(tile + (16 * nh + r) * P0_PITCH + (64 * q + 32 * ks + 8 * g) * 2);
                    macc[nh] = __builtin_amdgcn_mfma_f32_16x16x32_bf16(__builtin_bit_cast(p0_bf16x8, ma[ks]), bf, macc[nh], 0, 0, 0); }
        }
    }
    LDS_WAIT(); asm volatile("" ::: "memory");
    const unsigned so_ = (unsigned)half * (unsigned)cur.K + 8 * n;
#pragma unroll
    for (int j = 0; j < 16; ++j) { const v4u o = *(const LAS v4u*)(tile + (2 * j + half) * P0_PITCH + 16 * n); *(GAS v4u*)((GAS bf16*)(cur.dst + (size_t)(2 * j) * cur.K) + so_) = o; }
    LDS_WAIT(); asm volatile("" ::: "memory");
}
DI_ void p0_transpose_item(const float* W, int K, int N, bf16* WT, LAS float* scr, int item, int lane) {
    f32x4 dummy[2]; const int nblk = N / 32;
    p0_transpose_item_t<false>(W, K, N, WT, scr, item / nblk, item % nblk, lane, nullptr, dummy);
}

DI_ void p0_tile_load(const float* W, int N, int k0, int n0, int tid, f32x4 (&wv)[8]) {
    const int row = tid >> 5, c4 = tid & 31;
#pragma unroll
    for (int i = 0; i < 8; ++i) wv[i] = *(const GAS f32x4*)(W + (size_t)(k0 + row + 16 * i) * N + n0 + 4 * c4);
}
DI_ void p0_tile_to_lds(int tid, const f32x4 (&wv)[8], LAS unsigned char* img) {
    const int row = tid >> 5, c4 = tid & 31;
#pragma unroll
    for (int i = 0; i < 8; ++i) { const int k = row + 16 * i; const int col = (2 * c4) ^ (2 * ((k >> 3) & 15));
        *(LAS v2u*)(img + k * 256 + col * 4) = (v2u){hwpk(wv[i].x, wv[i].y), hwpk(wv[i].z, wv[i].w)}; }
}
DI_ void p0_tile_from_lds(bf16* WT, int K, int k0, int n0, int tid, LAS unsigned char* img) {
    __syncthreads();
    const int kc = tid & 15;
#pragma unroll
    for (int j = 0; j < 4; ++j) { const int n = (tid >> 4) + 32 * j; unsigned short hv[8];
#pragma unroll
        for (int e = 0; e < 8; ++e) hv[e] = *(const LAS unsigned short*)(img + (8 * kc + e) * 256 + ((((n >> 1) ^ (2 * kc)) << 2) | ((n & 1) << 1)));
        v4u o; o.x = hv[0] | ((unsigned)hv[1] << 16); o.y = hv[2] | ((unsigned)hv[3] << 16); o.z = hv[4] | ((unsigned)hv[5] << 16); o.w = hv[6] | ((unsigned)hv[7] << 16);
        *(GAS v4u*)(WT + (size_t)(n0 + n) * K + k0 + 8 * kc) = o; }
    __syncthreads();
}
struct P0Tile { const float* W; bf16* WT; int K, N, k0, n0; };
DI_ P0Tile p0_tile_decode(Frame& F, int t) {
    constexpr int T_0 = (D / 128) * (N0 / 128), T_1 = (DI / 128) * (D / 128), T_2 = (D / 128) * (N1 / 128);
    P0Tile p;
    if (t < T_0) { p.W = F.w0in; p.WT = F.WT0IN; p.K = D; p.N = N0; }
    else if (t < T_0 + T_1) { t -= T_0; p.W = F.w0out; p.WT = F.WT0OUT; p.K = DI; p.N = D; }
    else if (t < T_0 + T_1 + T_2) { t -= T_0 + T_1; p.W = F.w1in; p.WT = F.WT1IN; p.K = D; p.N = N1; }
    else { t -= T_0 + T_1 + T_2; p.W = F.w1out; p.WT = F.WT1OUT; p.K = DI; p.N = D; }
    const int nt = p.N / 128, kb = t / nt, nb = t - kb * nt; p.k0 = 128 * kb; p.n0 = 128 * nb; return p;
}
DI_ void p0_transpose_all(Frame& F) {
    constexpr int NT = (D / 128) * (N0 / 128) + 2 * (DI / 128) * (D / 128) + (D / 128) * (N1 / 128);
    f32x4 wv[8];
    int t = F.vcu;
    if (t < NT) { const P0Tile p = p0_tile_decode(F, t); p0_tile_load(p.W, p.N, p.k0, p.n0, F.tid, wv); }
    for (; t < NT; t += F.G) {
        const P0Tile p = p0_tile_decode(F, t);
        p0_tile_to_lds(F.tid, wv, F.lds);
        if (t + F.G < NT) { const P0Tile q = p0_tile_decode(F, t + F.G); p0_tile_load(q.W, q.N, q.k0, q.n0, F.tid, wv); }
        p0_tile_from_lds(p.WT, p.K, p.k0, p.n0, F.tid, F.lds);
    }
}

DI_ void p0_prologue(Frame& F) {
    LAS float* scr = (LAS float*)(F.lds + RING_OFF + F.wave * 16384);
    const int gw = F.vcu * NWAVES + F.wave, NGW = F.G * NWAVES;
    constexpr int I_0 = (D / 64) * (N0 / 32), I_1 = (DI / 64) * (D / 32), I_2 = (D / 64) * (N1 / 32), I_3 = I_1;
    constexpr int NITEMS = I_0 + I_1 + I_2 + I_3;
#if USE_TILE_TRANSPOSE
    p0_transpose_all(F);
#else
    if (P0_META_FOLD && F.G == 256) {
        constexpr int G_1 = (DI / 256) * (D / 32), G_2 = (D / 256) * (N1 / 32), G_3 = G_1;
        static_assert(G_1 + G_2 + G_3 == 1024 * 2 + 1024 * 18, "group split");
        auto other = [&](int q) -> P0Grp {
            const float* W; bf16* WT; int K, N;
            if (q < G_1) { W = F.w0out; WT = F.WT0OUT; K = DI; N = D; }
            else if (q < G_1 + G_2) { q -= G_1; W = F.w1in; WT = F.WT1IN; K = D; N = N1; }
            else { q -= G_1 + G_2; W = F.w1out; WT = F.WT1OUT; K = DI; N = D; }
            const int nblk = N / 32, kg = q / nblk, nb = q - kg * nblk;
            return p0_uni(P0Grp{W + (size_t)(256 * kg) * N + 32 * nb, WT + (size_t)(32 * nb) * K + 256 * kg, N, K});
        };
        LAS unsigned char* tile = F.lds + RING_OFF + F.wave * P0_TILE;
        float wv[2][32]; f32x4 mraw[2][4]; f32x4 macc[2]; macc[0] = (f32x4){0.f, 0.f, 0.f, 0.f}; macc[1] = macc[0];
        const int lane = F.lane;
        int o_lo, o_hi;
        P0Grp cur;
        if (gw < 1024) {
            cur = p0_uni(P0Grp{F.w0in + 32 * gw, F.WT0IN + (size_t)(32 * gw) * D, N0, D});
#pragma unroll
            for (int q = 0; q < 2; ++q)
#pragma unroll
                for (int ks = 0; ks < 2; ++ks) { const GAS f32x4* mp = (const GAS f32x4*)(F.meta + (size_t)(lane & 15) * D + 64 * q + 32 * ks + 8 * (lane >> 4)); mraw[q][2 * ks] = mp[0]; mraw[q][2 * ks + 1] = mp[1]; }
            o_lo = gw * 2; o_hi = o_lo + 2;
        } else { o_lo = 2048 + (gw - 1024) * 18; o_hi = o_lo + 18; cur = other(o_lo); }
#pragma unroll
        for (int q = 0; q < 2; ++q)
#pragma unroll
            for (int i = 0; i < 32; ++i) wv[q][i] = __builtin_nontemporal_load((const GAS float*)(cur.src + (size_t)(64 * q + i) * cur.N) + ((unsigned)(32 * (lane >> 5)) * (unsigned)cur.N + (lane & 31)));
        if (gw < 1024) {
            for (int kg = 0; kg < D / 256 - 1; ++kg) {
                const P0Grp nxt = P0Grp{cur.src + (size_t)256 * N0, cur.dst + 256, N0, D};
                p0_group<true, false>(cur, nxt, wv, mraw, tile, lane, F.meta + 256 * kg, F.meta + 256 * (kg + 1), macc); cur = nxt; }
            { const P0Grp nxt = other(o_lo); p0_group<true, false>(cur, nxt, wv, mraw, tile, lane, F.meta + 256 * (D / 256 - 1), F.meta, macc); cur = nxt; }
            const int r = lane & 15, g = lane >> 4;
#pragma unroll
            for (int nh = 0; nh < 2; ++nh) { const float mv[4] = {macc[nh].x, macc[nh].y, macc[nh].z, macc[nh].w};
#pragma unroll
                for (int jj = 0; jj < 4; ++jj) F.Q0[(size_t)(16 + 4 * g + jj) * N0 + 32 * gw + 16 * nh + r] = (bf16)f2bf(mv[jj]); }
        }
        for (int it = o_lo; it < o_hi - 1; ++it) { const P0Grp nxt = other(it + 1); p0_group<false, false>(cur, nxt, wv, mraw, tile, lane, nullptr, nullptr, macc); cur = nxt; }
        p0_group<false, true>(cur, cur, wv, mraw, tile, lane, nullptr, nullptr, macc);
    } else
    for (int it = gw; it < NITEMS; it += NGW) {
        int r = it;
        if (r < I_0) { p0_transpose_item(F.w0in, D, N0, F.WT0IN, scr, r, F.lane); continue; } r -= I_0;
        if (USE_AUX && USE_L0_MFMA == 2 && F.G == 256) break;
        if (r < I_1) { p0_transpose_item(F.w0out, DI, D, F.WT0OUT, scr, r, F.lane); continue; } r -= I_1;
        if (r < I_2) { p0_transpose_item(F.w1in, D, N1, F.WT1IN, scr, r, F.lane); continue; } r -= I_2;
        p0_transpose_item(F.w1out, DI, D, F.WT1OUT, scr, r, F.lane);
    }
#endif
    for (int m = gw; m < MP; m += NGW) {
        GAS unsigned long long* o8 = (GAS unsigned long long*)(F.XB + (size_t)m * D) + F.lane;
        if (m < MR) {
            const float* src = (m < MX) ? F.x + (size_t)m * D : F.meta + (size_t)(m - MX) * D;
            const GAS f32x4* xr = (const GAS f32x4*)src + F.lane;
            f32x4 xv[16];
#pragma unroll
            for (int j = 0; j < 16; ++j) xv[j] = __builtin_nontemporal_load(xr + 64 * j);
#pragma unroll
            for (int j = 0; j < 16; ++j) { const f32x4 v = xv[j]; o8[64 * j] = (unsigned long long)hwpk(v.x, v.y) | ((unsigned long long)hwpk(v.z, v.w) << 32); }
        } else {
#pragma unroll 4
            for (int j = 0; j < 16; ++j) o8[64 * j] = 0ull;
        }
    }
    for (int m = MR + gw; m < MP; m += NGW) {
        GAS unsigned long long* o8 = (GAS unsigned long long*)(F.H1B + (size_t)m * D) + F.lane;
#pragma unroll 4
        for (int j = 0; j < 16; ++j) o8[64 * j] = 0ull;
    }
    for (int i = gw * 64 + F.lane; i < 16 * N0 / 8; i += NGW * 64) { const int col8 = i % (N0 / 8); const unsigned v = (col8 >= DI / 8 && col8 < 2 * DI / 8) ? 0x47004700u : 0u;
        *((GAS v4u*)F.Q0 + i) = (v4u){v, v, v, v}; }
    for (int i = gw * 64 + F.lane; i < GL_R * D; i += NGW * 64) { const int n = i / D, k = i - n * D; F.WG1T[i] = (bf16)f2bf(F.wg1[(size_t)k * GL_R + n]); }
    for (int i = gw * 64 + F.lane; i < 8 * 16 * 2 * 64 * 8; i += NGW * 64) {
        const int e = i & 7, ln = (i >> 3) & 63, fr = i >> 9, m2 = fr & 1, s2 = (fr >> 1) & 15, hh = fr >> 5, rA = ln & 15, gA = ln >> 4;
        float v = 0.f; if (gA < 2) v = F.wg2[(size_t)(8 * gA + e) * 4096 + hh * 512 + 32 * s2 + 8 * (rA >> 2) + 4 * m2 + (rA & 3)];
        F.W2F[i] = (bf16)f2bf(v);
    }
    for (int c = gw * 64 + F.lane; c < DI; c += NGW * 64) {
        const float l0 = F.lb_logits[c], l1 = F.lb_logits[DI + c], l2 = F.lb_logits[2 * DI + c];
        const float mx = fmaxf(l0, fmaxf(l1, l2));
        const float e0 = __expf(l0 - mx), e1 = __expf(l1 - mx), e2 = __expf(l2 - mx);
        F.LB0[c] = e0 / (e0 + e1 + e2);
    }
}

DI_ void p2_l0_rec_naive(Frame& F) {
    LAS float* qs = (LAS float*)(F.lds);
    LAS float* fs = qs + 2048;
    LAS float* ks = fs + 2048;
    LAS float* vs = ks + 2048;
    LAS float* pb = vs + 2048;
    const int tid = F.tid, dv = tid & 127, kg = tid >> 7;
    const int lj = tid >> 5, lc = (tid & 31) * 4;
    for (int u = blockIdx.x; u < NB * HG_H; u += F.G) {
        const int b = u >> 6, h = u & 63;
        float S[32];
#pragma unroll
        for (int i = 0; i < 32; ++i) S[i] = 0.f;
        float lbv[4], bfv[4], ngv[4];
#pragma unroll
        for (int i = 0; i < 4; ++i) { lbv[i] = F.LB0[h * 128 + lc + i]; bfv[i] = F.b_f[h * 128 + lc + i]; ngv[i] = F.ng0[h * 128 + lc + i]; }
        for (int tb = 0; tb < 129; ++tb) {
            const int rbase = (tb == 0) ? MX : b * SEQ + 16 * (tb - 1);
            const bf16* row = F.QFIZ + (size_t)(rbase + lj) * N0 + h * 128 + lc;
            {
                const v2u q4 = *(const GAS v2u*)(row), f4 = *(const GAS v2u*)(row + DI), i4 = *(const GAS v2u*)(row + 2 * DI);
                const float qv[4] = {bflo(q4.x), bfhi(q4.x), bflo(q4.y), bfhi(q4.y)};
                const float fv[4] = {bflo(f4.x), bfhi(f4.x), bflo(f4.y), bfhi(f4.y)};
                const float iv[4] = {bflo(i4.x), bfhi(i4.x), bflo(i4.y), bfhi(i4.y)};
#pragma unroll
                for (int i = 0; i < 4; ++i) {
                    const float fg = lbv[i] + (1.f - lbv[i]) * sigm(fv[i] + bfv[i]);
                    qs[lj * 128 + lc + i] = silu(qv[i]); fs[lj * 128 + lc + i] = fg; ks[lj * 128 + lc + i] = 1.f - fg; vs[lj * 128 + lc + i] = iv[i];
                }
            }
            __syncthreads();
            for (int j = 0; j < 16; ++j) {
                const float vj = vs[j * 128 + dv]; float po = 0.f;
#pragma unroll
                for (int i = 0; i < 32; i += 4) {
                    const f32x4 f4 = *(const LAS f32x4*)(fs + j * 128 + kg * 32 + i), k4 = *(const LAS f32x4*)(ks + j * 128 + kg * 32 + i), q4 = *(const LAS f32x4*)(qs + j * 128 + kg * 32 + i);
                    S[i + 0] = f4.x * S[i + 0] + k4.x * vj; po += q4.x * S[i + 0];
                    S[i + 1] = f4.y * S[i + 1] + k4.y * vj; po += q4.y * S[i + 1];
                    S[i + 2] = f4.z * S[i + 2] + k4.z * vj; po += q4.z * S[i + 2];
                    S[i + 3] = f4.w * S[i + 3] + k4.w * vj; po += q4.w * S[i + 3];
                }
                pb[(j * 4 + kg) * 128 + dv] = po;
            }
            __syncthreads();
            {
                f32x4 o = *(const LAS f32x4*)(pb + (lj * 4 + 0) * 128 + lc);
                o += *(const LAS f32x4*)(pb + (lj * 4 + 1) * 128 + lc);
                o += *(const LAS f32x4*)(pb + (lj * 4 + 2) * 128 + lc);
                o += *(const LAS f32x4*)(pb + (lj * 4 + 3) * 128 + lc);
                float ss = o.x * o.x + o.y * o.y + o.z * o.z + o.w * o.w;
                ss += __shfl_xor(ss, 16); ss += __shfl_xor(ss, 8); ss += __shfl_xor(ss, 4); ss += __shfl_xor(ss, 2); ss += __shfl_xor(ss, 1);
                const float rs = rsqrtf(ss * (1.f / 128.f) + RMS_EPS);
                const v2u z4 = *(const GAS v2u*)(row + 3 * DI);
                const float y0 = o.x * rs * ngv[0] * silu(bflo(z4.x)), y1 = o.y * rs * ngv[1] * silu(bfhi(z4.x));
                const float y2 = o.z * rs * ngv[2] * silu(bflo(z4.y)), y3 = o.w * rs * ngv[3] * silu(bfhi(z4.y));
                if (tb > 0 || b == 0) { v2u w; w.x = pk2(y0, y1); w.y = pk2(y2, y3); *(GAS v2u*)(F.Y + (size_t)(rbase + lj) * DI + h * 128 + lc) = w; }
            }
        }
        __syncthreads();
    }
}

DI_ void ln_phase(Frame& F, const float* src, int nrows, const float* g, const float* bt, float* dst32, bf16* dstb, float* G1) {
    const int gw = F.vcu * NWAVES + F.wave, NGW = F.G * NWAVES;
    for (int r = gw; r < nrows; r += NGW) {
        const GAS f32x4* s = (const GAS f32x4*)(src + (size_t)r * D) + F.lane;
        f32x4 v[16]; float sm = 0.f;
#pragma unroll
        for (int j = 0; j < 16; ++j) { v[j] = s[64 * j]; sm += (v[j].x + v[j].y) + (v[j].z + v[j].w); }
        const float mean = wave_sum(sm) * (1.f / D); float s2 = 0.f;
#pragma unroll
        for (int j = 0; j < 16; ++j) { v[j] = v[j] - mean; s2 += (v[j].x * v[j].x + v[j].y * v[j].y) + (v[j].z * v[j].z + v[j].w * v[j].w); }
        const float rstd = rsqrtf(wave_sum(s2) * (1.f / D) + LN_EPS);
#pragma unroll
        for (int j = 0; j < 16; ++j) {
            const f32x4 gg = *((const GAS f32x4*)g + F.lane + 64 * j), bb = *((const GAS f32x4*)bt + F.lane + 64 * j);
            v[j] = v[j] * rstd * gg + bb;
            if (dst32) *((GAS f32x4*)(dst32 + (size_t)r * D) + F.lane + 64 * j) = v[j];
            if (dstb) { v2u w; w.x = hwpk(v[j].x, v[j].y); w.y = hwpk(v[j].z, v[j].w); *((GAS v2u*)(dstb + (size_t)r * D) + F.lane + 64 * j) = w; }
            if ((j & 3) == 3) asm volatile("" ::: "memory");
        }
        if (G1) {
            LAS float* rowbuf = (LAS float*)(F.lds + RING_OFF + F.wave * 16384);
#pragma unroll
            for (int j = 0; j < 16; ++j) *(LAS f32x4*)(rowbuf + 256 * j + 4 * F.lane) = v[j];
            LDS_WAIT(); asm volatile("" ::: "memory");
            float a[16];
#pragma unroll
            for (int q = 0; q < 16; ++q) a[q] = 0.f;
#pragma unroll 2
            for (int i = 0; i < 64; ++i) {
                const int k = 64 * i + F.lane;
                const float e = rowbuf[k];
                const GAS f32x4* w = (const GAS f32x4*)(F.wg1 + (size_t)k * GL_R);
                const f32x4 w0 = w[0], w1 = w[1], w2 = w[2], w3 = w[3];
                a[0] += e * w0.x; a[1] += e * w0.y; a[2] += e * w0.z; a[3] += e * w0.w;
                a[4] += e * w1.x; a[5] += e * w1.y; a[6] += e * w1.z; a[7] += e * w1.w;
                a[8] += e * w2.x; a[9] += e * w2.y; a[10] += e * w2.z; a[11] += e * w2.w;
                a[12] += e * w3.x; a[13] += e * w3.y; a[14] += e * w3.z; a[15] += e * w3.w;
            }
#pragma unroll
            for (int q = 0; q < 16; ++q) a[q] = wave_sum(a[q]);
            if (F.lane == 0) {
#pragma unroll
                for (int q = 0; q < 16; q += 4) *(GAS f32x4*)(G1 + (size_t)r * GL_R + q) = (f32x4){a[q], a[q + 1], a[q + 2], a[q + 3]};
            }
            LDS_WAIT(); asm volatile("" ::: "memory");
        }
    }
}

DI_ void ln_phase2(Frame& F, const float* src, int nrows, const float* g, const float* bt, float* dst32, bf16* dstb) {
    const int gw = F.vcu * NWAVES + F.wave, NGW = F.G * NWAVES;
    LAS float* gL = (LAS float*)(F.lds + RING_OFF); LAS float* bL = gL + D;
    for (int i = F.tid; i < D / 4; i += NWAVES * 64) { *(LAS f32x4*)(gL + 4 * i) = *((const GAS f32x4*)g + i); *(LAS f32x4*)(bL + 4 * i) = *((const GAS f32x4*)bt + i); }
    __syncthreads();
    f32x4 va[16], vb[16];
#define LN_LOAD(v_, r_) do { const GAS f32x4* s_ = (const GAS f32x4*)(((r_) < nrows) ? src + (size_t)(r_) * D : g) + F.lane; \
        _Pragma("unroll") for (int j = 0; j < 16; ++j) v_[j] = s_[64 * j]; } while (0)
#define LN_PROC(v_, r_) do { float sm = 0.f; \
        _Pragma("unroll") for (int j = 0; j < 16; ++j) sm += (v_[j].x + v_[j].y) + (v_[j].z + v_[j].w); \
        const float mean = wave_sum(sm) * (1.f / D); float s2 = 0.f; \
        _Pragma("unroll") for (int j = 0; j < 16; ++j) { v_[j] = v_[j] - mean; s2 += (v_[j].x * v_[j].x + v_[j].y * v_[j].y) + (v_[j].z * v_[j].z + v_[j].w * v_[j].w); } \
        const float rstd = rsqrtf(wave_sum(s2) * (1.f / D) + LN_EPS); \
        _Pragma("unroll") for (int j = 0; j < 16; ++j) { \
            const f32x4 gg = *(const LAS f32x4*)(gL + 4 * (F.lane + 64 * j)), bb = *(const LAS f32x4*)(bL + 4 * (F.lane + 64 * j)); \
            const f32x4 o_ = v_[j] * rstd * gg + bb; \
            if (dst32) *((GAS f32x4*)(dst32 + (size_t)(r_) * D) + F.lane + 64 * j) = o_; \
            if (dstb) { v2u w_; w_.x = pk2(o_.x, o_.y); w_.y = pk2(o_.z, o_.w); *((GAS v2u*)(dstb + (size_t)(r_) * D) + F.lane + 64 * j) = w_; } \
            if ((j & 3) == 3) asm volatile("" ::: "memory"); } } while (0)
    int r = gw;
    LN_LOAD(va, r);
    while (r < nrows) {
        LN_LOAD(vb, r + NGW);
        LN_PROC(va, r);
        r += NGW; if (r >= nrows) break;
        LN_LOAD(va, r + NGW);
        LN_PROC(vb, r);
        r += NGW;
    }
#undef LN_LOAD
#undef LN_PROC
}

DI_ void p6_l1_rec_naive(Frame& F) {
    LAS float* qs = (LAS float*)(F.lds);
    LAS float* ks = qs + 4096;
    LAS float* gs = ks + 4096;
    LAS float* vs = gs + 4096;
    LAS float* pb = vs + 512;
    const int tid = F.tid, dv = tid & 63, kg = tid >> 6;
    const float qscale = 0.04419417382415922f;
    for (int u = blockIdx.x; u < NB * GL_H * 16; u += F.G) {
        const int dvs = u & 15, bh = u >> 4, b = bh >> 3, h = bh & 7;
        float S[64];
#pragma unroll
        for (int i = 0; i < 64; ++i) S[i] = 0.f;
        float w2[16];
#pragma unroll
        for (int r = 0; r < 16; ++r) w2[r] = F.wg2[(size_t)r * 4096 + h * 512 + tid];
        const float bg = F.b_g[h * 512 + tid];
        for (int tb = 0; tb < 258; ++tb) {
            const int rbase = (tb < 2) ? MX + 8 * tb : b * SEQ + 8 * (tb - 2);
            for (int j = 0; j < 8; ++j) {
                const size_t r = (size_t)(rbase + j);
                const float q = bf2f(F.QFIZ[r * N1 + h * 512 + tid]) * qscale, k = bf2f(F.QFIZ[r * N1 + 4096 + h * 512 + tid]);
                const float* g1 = F.G1 + r * GL_R;
                float xg = bg;
#pragma unroll
                for (int rr = 0; rr < 16; ++rr) xg += g1[rr] * w2[rr];
                const float ls = fminf(xg, 0.f) - log1pf(__expf(-fabsf(xg)));
                qs[j * 512 + tid] = q; ks[j * 512 + tid] = k; gs[j * 512 + tid] = __expf(ls * (1.f / 16.f));
            }
            vs[tid] = bf2f(F.QFIZ[(size_t)(rbase + (tid >> 6)) * N1 + 8192 + h * 1024 + dvs * 64 + (tid & 63)]);
            __syncthreads();
            for (int j = 0; j < 8; ++j) {
                const float vj = vs[j * 64 + dv]; float po = 0.f;
#pragma unroll
                for (int i = 0; i < 64; i += 4) {
                    const f32x4 g4 = *(const LAS f32x4*)(gs + j * 512 + kg * 64 + i), k4 = *(const LAS f32x4*)(ks + j * 512 + kg * 64 + i), q4 = *(const LAS f32x4*)(qs + j * 512 + kg * 64 + i);
                    S[i + 0] = g4.x * S[i + 0] + k4.x * vj; po += q4.x * S[i + 0];
                    S[i + 1] = g4.y * S[i + 1] + k4.y * vj; po += q4.y * S[i + 1];
                    S[i + 2] = g4.z * S[i + 2] + k4.z * vj; po += q4.z * S[i + 2];
                    S[i + 3] = g4.w * S[i + 3] + k4.w * vj; po += q4.w * S[i + 3];
                    if ((i & 12) == 12) asm volatile("" ::: "memory");
                }
                pb[(j * 8 + kg) * 64 + dv] = po;
            }
            __syncthreads();
            {
                const int j = tid >> 6, d = tid & 63; float o = 0.f;
#pragma unroll
                for (int g = 0; g < 8; ++g) o += pb[(j * 8 + g) * 64 + d];
                if (tb >= 2 || b == 0) F.O1[(size_t)(rbase + j) * DI + h * 1024 + dvs * 64 + d] = o;
            }
        }
        __syncthreads();
    }
}

DI_ void p7_normgate(Frame& F) {
    const int gw = F.vcu * NWAVES + F.wave, NGW = F.G * NWAVES;
    for (int it = gw; it < MX * GL_H; it += NGW) {
        const int r = it >> 3, h = it & 7;
        const GAS v4u* o = (const GAS v4u*)((const bf16*)F.O1 + (size_t)r * DI + h * 1024) + F.lane;
        const GAS v4u* zp = (const GAS v4u*)(F.QFIZ + (size_t)r * N1 + 16384 + h * 1024) + F.lane;
        v4u ov[2], zv[2]; float ss = 0.f;
#pragma unroll
        for (int j = 0; j < 2; ++j) { ov[j] = o[64 * j]; zv[j] = zp[64 * j]; }
        float x[2][8];
#pragma unroll
        for (int j = 0; j < 2; ++j) { x[j][0] = bflo(ov[j].x); x[j][1] = bfhi(ov[j].x); x[j][2] = bflo(ov[j].y); x[j][3] = bfhi(ov[j].y); x[j][4] = bflo(ov[j].z); x[j][5] = bfhi(ov[j].z); x[j][6] = bflo(ov[j].w); x[j][7] = bfhi(ov[j].w);
#pragma unroll
            for (int e = 0; e < 8; ++e) ss += x[j][e] * x[j][e]; }
        const float rs = rsqrtf(wave_sum(ss) * (1.f / 1024.f) + RMS_EPS);
#pragma unroll
        for (int j = 0; j < 2; ++j) {
            const int c = h * 1024 + 512 * j + 8 * F.lane;
            const f32x4 n0 = *(const GAS f32x4*)(F.ng1 + c), n1 = *(const GAS f32x4*)(F.ng1 + c + 4);
            const float z[8] = {bflo(zv[j].x), bfhi(zv[j].x), bflo(zv[j].y), bfhi(zv[j].y), bflo(zv[j].z), bfhi(zv[j].z), bflo(zv[j].w), bfhi(zv[j].w)};
            v4u wv; wv.x = pk2(x[j][0] * rs * n0.x * silu(z[0]), x[j][1] * rs * n0.y * silu(z[1])); wv.y = pk2(x[j][2] * rs * n0.z * silu(z[2]), x[j][3] * rs * n0.w * silu(z[3]));
            wv.z = pk2(x[j][4] * rs * n1.x * silu(z[4]), x[j][5] * rs * n1.y * silu(z[5])); wv.w = pk2(x[j][6] * rs * n1.z * silu(z[6]), x[j][7] * rs * n1.w * silu(z[7]));
            *(GAS v4u*)(F.Y + (size_t)r * DI + c) = wv;
        }
    }
}

typedef short bf16x8 __attribute__((ext_vector_type(8)));
#ifndef USE_FUSED_NORM
#define USE_FUSED_NORM 1
#endif
constexpr int NCH = 65;
constexpr int SSP_OFF = 155648 + 512;
constexpr float LOG2E = 1.4426950408889634f;
constexpr int R1_QD = 0, R1_KD = 32768, R1_P = 65536, R1_GL = 67584, R1_SH = 69632;
constexpr int ST1 = R1_SH + 8192;
constexpr int R0_QD = 0, R0_KD = 8192, R0_P = 16384, R0_V = 18432, R0_GL = 26624, R0_SZ = 27648;
constexpr int ST0 = R0_SZ;

DI_ unsigned cvtpk(float lo, float hi) { unsigned r; asm volatile("v_cvt_pk_bf16_f32 %0, %1, %2" : "=v"(r) : "v"(lo), "v"(hi)); return r; }
template <int N> DI_ float row_shr(float x) { return __builtin_bit_cast(float, __builtin_amdgcn_update_dpp(0, __builtin_bit_cast(int, x), 0x110 + N, 0xF, 0xF, true)); }
template <int K> DI_ float glb(float x) { return __builtin_bit_cast(float, __builtin_amdgcn_update_dpp(0, __builtin_bit_cast(int, x), 0x150 + K, 0xF, 0xF, true)); }
DI_ float bcast15(float x) { return __builtin_bit_cast(float, __builtin_amdgcn_update_dpp(0, __builtin_bit_cast(int, x), 0x15F, 0xF, 0xF, true)); }
DI_ float scan16(float x) { x += row_shr<1>(x); x += row_shr<2>(x); x += row_shr<4>(x); x += row_shr<8>(x); return x; }
DI_ float ex2(float x) { return __builtin_amdgcn_exp2f(x); }
DI_ float lg2(float x) { return __builtin_amdgcn_logf(x); }
DI_ int row_of(int b, int c, int tok) { return c == 0 ? MX + tok - 16 : b * SEQ + 32 * (c - 1) + tok; }
DI_ bf16x8 mk8(unsigned a, unsigned b, unsigned c, unsigned d) { v4u t; t.x = a; t.y = b; t.z = c; t.w = d; return __builtin_bit_cast(bf16x8, t); }
#define MFMA16(a, b, c) __builtin_amdgcn_mfma_f32_16x16x32_bf16((a), (b), (c), 0, 0, 0)

DI_ void l1_prep(Frame& F, unsigned char* REC1, unsigned char* VF1, const bf16* W2F) {
    const int lane = F.lane, w = F.wave, r = lane & 15, g = lane >> 4;
    LAS unsigned char* T = F.lds + w * 16384;
    LAS unsigned char* Tv = F.lds + w * 16384 + 4096;
    LAS f32x4* Pp = (LAS f32x4*)(F.lds + 131072);
    const float qscale = 0.04419417382415922f;
    v4u qn[2][2], kn[2][2]; f32x4 gn[2][2];
#define L1P_LOAD(it_) do { const int bh_ = (it_) / NCH, c_ = (it_) - bh_ * NCH, b_ = bh_ >> 3, h_ = bh_ & 7; \
        _Pragma("unroll") for (int ti = 0; ti < 2; ++ti) { const int tok_ = 16 * ti + r; const int row_ = (c_ == 0 && tok_ < 16) ? 0 : row_of(b_, c_, tok_); \
            const GAS f32x4* gp = (const GAS f32x4*)(F.G1 + (size_t)row_ * GL_R + 8 * (g & 1)); gn[ti][0] = gp[0]; gn[ti][1] = gp[1]; \
            _Pragma("unroll") for (int si = 0; si < 2; ++si) { const bf16* rp = F.QFIZ + (size_t)row_ * N1 + h_ * 512 + 32 * (2 * w + si) + 8 * g; qn[si][ti] = *(const GAS v4u*)rp; kn[si][ti] = *(const GAS v4u*)(rp + 4096); } } } while (0)
    if ((int)blockIdx.x < NB * GL_H * NCH) L1P_LOAD((int)blockIdx.x);
    for (int it = blockIdx.x; it < NB * GL_H * NCH; it += F.G) {
        const int bh = it / NCH, c = it - bh * NCH, b = bh >> 3, h = bh & 7;
        unsigned char* rec = REC1 + (size_t)it * R1_SH;
        bool nul[2];
#pragma unroll
        for (int ti = 0; ti < 2; ++ti) { const int tok = 16 * ti + r; nul[ti] = (c == 0 && tok < 16); }
        bf16x8 g1f[2];
#pragma unroll
        for (int ti = 0; ti < 2; ++ti) {
            const f32x4 t0 = (g < 2) ? gn[ti][0] : (f32x4){0.f, 0.f, 0.f, 0.f}, t1 = (g < 2) ? gn[ti][1] : (f32x4){0.f, 0.f, 0.f, 0.f};
            g1f[ti] = mk8(pk2(t0.x, t0.y), pk2(t0.z, t0.w), pk2(t1.x, t1.y), pk2(t1.z, t1.w));
        }
        f32x4 pacc[3];
#pragma unroll
        for (int t = 0; t < 3; ++t) pacc[t] = (f32x4){0.f, 0.f, 0.f, 0.f};
        v4u qraw[2][2], kraw[2][2];
#pragma unroll
        for (int si = 0; si < 2; ++si)
#pragma unroll
            for (int ti = 0; ti < 2; ++ti) { qraw[si][ti] = qn[si][ti]; kraw[si][ti] = kn[si][ti]; }
        f32x4 bg[2][2]; bf16x8 wfr[2][2];
#pragma unroll
        for (int si = 0; si < 2; ++si) { const int s = 2 * w + si, col = h * 512 + 32 * s + 8 * g;
            bg[si][0] = *(const GAS f32x4*)(F.b_g + col); bg[si][1] = *(const GAS f32x4*)(F.b_g + col + 4);
            wfr[si][0] = *(const GAS bf16x8*)(W2F + ((size_t)((h * 16 + s) * 2 + 0) * 64 + lane) * 8); wfr[si][1] = *(const GAS bf16x8*)(W2F + ((size_t)((h * 16 + s) * 2 + 1) * 64 + lane) * 8); }
        { const int nx = (it + F.G < NB * GL_H * NCH) ? it + F.G : it; L1P_LOAD(nx); }
        v4u vraw[8];
        if (USE_L1_SEQ2) {
#pragma unroll
            for (int i2 = 0; i2 < 8; ++i2) { const int q = lane + 64 * i2, tk = q >> 4, c16 = q & 15; const int vrow = (c == 0) ? MX - 16 + tk : b * SEQ + 32 * (c - 1) + tk;
                vraw[i2] = *(const GAS v4u*)(F.QFIZ + (size_t)vrow * N1 + 8192 + h * 1024 + 128 * w + 8 * c16); }
        }
        asm volatile("" ::: "memory");
#pragma unroll
        for (int si = 0; si < 2; ++si) {
            const int s = 2 * w + si, col = h * 512 + 32 * s + 8 * g;
            float xg[2][8];
            { const f32x4 b0 = bg[si][0], b1 = bg[si][1];
              const bf16x8 wa = wfr[si][0], wb = wfr[si][1];
#pragma unroll
              for (int ti = 0; ti < 2; ++ti) { const f32x4 xa = MFMA16(wa, g1f[ti], b0), xb = MFMA16(wb, g1f[ti], b1);
                  xg[ti][0] = xa.x; xg[ti][1] = xa.y; xg[ti][2] = xa.z; xg[ti][3] = xa.w; xg[ti][4] = xb.x; xg[ti][5] = xb.y; xg[ti][6] = xb.z; xg[ti][7] = xb.w; } }
            float qv[2][8], kv[2][8];
#pragma unroll
            for (int ti = 0; ti < 2; ++ti) {
                const v4u q4 = qraw[si][ti], k4 = kraw[si][ti];
                qv[ti][0] = bflo(q4.x); qv[ti][1] = bfhi(q4.x); qv[ti][2] = bflo(q4.y); qv[ti][3] = bfhi(q4.y); qv[ti][4] = bflo(q4.z); qv[ti][5] = bfhi(q4.z); qv[ti][6] = bflo(q4.w); qv[ti][7] = bfhi(q4.w);
                kv[ti][0] = bflo(k4.x); kv[ti][1] = bfhi(k4.x); kv[ti][2] = bflo(k4.y); kv[ti][3] = bfhi(k4.y); kv[ti][4] = bflo(k4.z); kv[ti][5] = bfhi(k4.z); kv[ti][6] = bflo(k4.w); kv[ti][7] = bfhi(k4.w);
            }
            unsigned qd[2][4], ki[2][4], kd[2][4]; float gl[8];
#pragma unroll
            for (int e = 0; e < 8; e += 2) {
                float bb[2][2], BB[2];
#pragma unroll
                for (int u = 0; u < 2; ++u) {
                    float L0 = nul[0] ? 0.f : (fminf(xg[0][e + u], 0.f) * LOG2E - lg2(1.f + ex2(-fabsf(xg[0][e + u]) * LOG2E))) * (1.f / 16.f);
                    float L1 = nul[1] ? 0.f : (fminf(xg[1][e + u], 0.f) * LOG2E - lg2(1.f + ex2(-fabsf(xg[1][e + u]) * LOG2E))) * (1.f / 16.f);
                    const float b0 = scan16(L0);
                    const float b1 = scan16(L1) + bcast15(b0);
                    bb[0][u] = b0; bb[1][u] = b1; BB[u] = bcast15(b1);
                    gl[e + u] = ex2(BB[u]);
                }
#pragma unroll
                for (int ti = 0; ti < 2; ++ti) {
                    const float q0 = nul[ti] ? 0.f : qv[ti][e] * qscale, q1 = nul[ti] ? 0.f : qv[ti][e + 1] * qscale;
                    const float k0 = nul[ti] ? 0.f : kv[ti][e], k1 = nul[ti] ? 0.f : kv[ti][e + 1];
                    const float ki0 = k0 * ex2(-bb[ti][0]), ki1 = k1 * ex2(-bb[ti][1]);
                    qd[ti][e >> 1] = cvtpk(q0 * ex2(bb[ti][0]), q1 * ex2(bb[ti][1]));
                    ki[ti][e >> 1] = cvtpk(ki0, ki1);
                    kd[ti][e >> 1] = cvtpk(ki0 * gl[e], ki1 * gl[e + 1]);
                }
            }
            const bf16x8 qf0 = mk8(qd[0][0], qd[0][1], qd[0][2], qd[0][3]), qf1 = mk8(qd[1][0], qd[1][1], qd[1][2], qd[1][3]);
            const bf16x8 kf0 = mk8(ki[0][0], ki[0][1], ki[0][2], ki[0][3]), kf1 = mk8(ki[1][0], ki[1][1], ki[1][2], ki[1][3]);
            pacc[0] = MFMA16(kf0, qf0, pacc[0]);
            pacc[1] = MFMA16(kf0, qf1, pacc[1]);
            pacc[2] = MFMA16(kf1, qf1, pacc[2]);
#pragma unroll
            for (int ti = 0; ti < 2; ++ti)
#pragma unroll
                for (int h2 = 0; h2 < 2; ++h2) {
                    const int lp = (2 * (g & 1) + h2) * 16 + r;
                    v2u d; d.x = qd[ti][2 * h2]; d.y = qd[ti][2 * h2 + 1];
                    *(GAS v2u*)(rec + R1_QD + ((ti * 16 + s) * 64 + lp) * 16 + (g >> 1) * 8) = d;
                }
#pragma unroll
            for (int ti = 0; ti < 2; ++ti)
#pragma unroll
                for (int e = 0; e < 8; ++e) {
                    const unsigned wd = kd[ti][e >> 1]; const unsigned short hv = (e & 1) ? (unsigned short)(wd >> 16) : (unsigned short)(wd & 0xffffu);
                    *(LAS unsigned short*)(T + (32 * si + 8 * g + e) * 64 + (16 * ti + r) * 2) = hv;
                }
            if (r == 0) { *(GAS f32x4*)(rec + R1_GL + (32 * s + 8 * g) * 4) = (f32x4){gl[0], gl[1], gl[2], gl[3]}; *(GAS f32x4*)(rec + R1_GL + (32 * s + 8 * g + 4) * 4) = (f32x4){gl[4], gl[5], gl[6], gl[7]}; }
        }
#pragma unroll
        for (int t = 0; t < 3; ++t) Pp[(w * 3 + t) * 64 + lane] = pacc[t];
        if (USE_L1_SEQ2) {
#pragma unroll
            for (int i2 = 0; i2 < 8; ++i2) { const int q = lane + 64 * i2, tk = q >> 4, c16 = q & 15; const v4u d = vraw[i2];
                *(LAS v2u*)(Tv + tk * 264 + c16 * 16) = (v2u){d.x, d.y}; *(LAS v2u*)(Tv + tk * 264 + c16 * 16 + 8) = (v2u){d.z, d.w}; }
        }
        LDS_WAIT(); asm volatile("" ::: "memory");
        if (USE_L1_SEQ2) {
#pragma unroll
            for (int sl = 0; sl < 8; ++sl) { unsigned short hv[8];
#pragma unroll
                for (int e = 0; e < 8; ++e) hv[e] = *(const LAS unsigned short*)(Tv + (8 * g + e) * 264 + (16 * sl + r) * 2);
                v4u d; d.x = hv[0] | ((unsigned)hv[1] << 16); d.y = hv[2] | ((unsigned)hv[3] << 16); d.z = hv[4] | ((unsigned)hv[5] << 16); d.w = hv[6] | ((unsigned)hv[7] << 16);
                *(GAS v4u*)(VF1 + ((size_t)it * 64 + 8 * w + sl) * 1024 + lane * 16) = d; }
        }
#pragma unroll
        for (int ml = 0; ml < 4; ++ml) { const v4u d = *(const LAS v4u*)(T + (16 * ml + r) * 64 + 16 * g); *(GAS v4u*)(rec + R1_KD + ((4 * w + ml) * 64 + lane) * 16) = d; }
        __syncthreads();
        if (w < 4) {
            const int tj = (w == 2 || w == 3) ? 1 : 0, ti = (w == 1 || w == 2) ? 1 : 0;
            f32x4 sum = (f32x4){0.f, 0.f, 0.f, 0.f};
            if (w < 3) {
#pragma unroll
                for (int ww = 0; ww < 8; ++ww) sum += Pp[(ww * 3 + w) * 64 + lane];
            }
            float pv[4] = {sum.x, sum.y, sum.z, sum.w};
#pragma unroll
            for (int jj = 0; jj < 4; ++jj) { const int j = 16 * tj + 4 * g + jj, i = 16 * ti + r; if (j > i) pv[jj] = 0.f; }
            const int lp = (2 * tj + (g >> 1)) * 16 + r;
            v2u d; d.x = cvtpk(pv[0], pv[1]); d.y = cvtpk(pv[2], pv[3]);
            *(GAS v2u*)(rec + R1_P + (ti * 64 + lp) * 16 + 8 * (g & 1)) = d;
        }
        __syncthreads();
    }
}
#undef L1P_LOAD

template <int VAR> DI_ void l1_seq(Frame& F, const unsigned char* REC1, const unsigned char* VF1, float* O1, float* SS) {
    const int lane = F.lane, w = F.wave, r = lane & 15, g = lane >> 4;
    for (int u = F.vcu; u < NB * GL_H * 8; u += F.G) {
        const int bh = u >> 3, ds = u & 7, b = bh >> 3, h = bh & 7;
        f32x4 acc[32];
#pragma unroll
        for (int m = 0; m < 32; ++m) acc[m] = (f32x4){0.f, 0.f, 0.f, 0.f};
#define L1_DMA(c_) do { const unsigned char* rs_ = REC1 + (size_t)(bh * NCH + (c_)) * R1_SH; LAS unsigned char* st_ = F.lds + ((c_) & 1) * ST1; \
        for (int p_ = w; p_ < 76; p_ += 8) { const unsigned char* src_; \
            if (p_ < 68) src_ = rs_ + p_ * 1024 + lane * 16; \
            else { const int tk_ = 4 * (p_ - 68) + (lane >> 4);         \
                   src_ = ((c_) == 0 && tk_ < 16) ? (const unsigned char*)(F.H1B + (size_t)MR * D) + (lane & 15) * 16 \
                        : (const unsigned char*)(F.QFIZ + (size_t)row_of(b, (c_), tk_) * N1 + 8192 + h * 1024 + ds * 128) + (lane & 15) * 16; } \
            __builtin_amdgcn_global_load_lds((const unsigned*)src_, (LAS unsigned*)(st_ + p_ * 1024), 16, 0, 0); } } while (0)
        const int ycol = h * 1024 + ds * 128 + 16 * w + 4 * g;
        const f32x4 ng4 = *(const GAS f32x4*)(F.ng1 + ycol);
        const bf16* xz = F.QFIZ + (size_t)(b * SEQ - 32) * N1 + 16384 + ycol;
        v2u zc0 = (v2u){0u, 0u}, zc1 = zc0, zn0 = zc0, zn1 = zc0;
        if (VAR != 1) L1_DMA(0);
        for (int c = 0; c < NCH; ++c) {
            asm volatile("s_waitcnt vmcnt(0) lgkmcnt(0)" ::: "memory");
            __builtin_amdgcn_s_barrier();
            asm volatile("" ::: "memory");
            if (VAR != 1 && c + 1 < NCH) L1_DMA(c + 1);
            if (USE_FUSED_NORM && VAR == 0 && c >= 2 && w == 0 && lane < 32) {
                const LAS float* pp = (const LAS float*)(F.lds + SSP_OFF) + ((c - 1) & 1) * 256 + lane; float sm = 0.f;
#pragma unroll
                for (int ww = 0; ww < 8; ++ww) sm += pp[ww * 32];
                SS[(size_t)(b * SEQ + 32 * (c - 2) + lane) * 64 + h * 8 + ds] = sm; }
            if (USE_FUSED_NORM && c + 1 < NCH) { const bf16* zp = xz + (size_t)((c + 1) * 32 + r) * N1; zn0 = *(const GAS v2u*)zp; zn1 = *(const GAS v2u*)(zp + (size_t)16 * N1); }
            if (VAR == 2) continue;
            const LAS unsigned char* st = F.lds + (c & 1) * ST1;
            unsigned short vh[8];
#pragma unroll
            for (int e = 0; e < 8; ++e) vh[e] = *(const LAS unsigned short*)(st + R1_SH + (8 * g + e) * 256 + (16 * w + r) * 2);
            const bf16x8 vf = mk8(vh[0] | ((unsigned)vh[1] << 16), vh[2] | ((unsigned)vh[3] << 16), vh[4] | ((unsigned)vh[5] << 16), vh[6] | ((unsigned)vh[7] << 16));
#define SCHED_FENCE() __builtin_amdgcn_sched_barrier(0)
            if (c > 0) {
                f32x4 o0 = (f32x4){0.f, 0.f, 0.f, 0.f}, o1 = o0;
                bf16x8 qb[2][4];
#define LDQ(buf_, gi_) do { _Pragma("unroll") for (int sl_ = 0; sl_ < 2; ++sl_) { qb[buf_][sl_] = *(const LAS bf16x8*)(st + R1_QD + (2 * (gi_) + sl_) * 1024 + lane * 16); \
                    qb[buf_][2 + sl_] = *(const LAS bf16x8*)(st + R1_QD + (16 + 2 * (gi_) + sl_) * 1024 + lane * 16); } } while (0)
                const bf16x8 p0 = *(const LAS bf16x8*)(st + R1_P + lane * 16), p1 = *(const LAS bf16x8*)(st + R1_P + 1024 + lane * 16);
                LDQ(0, 0);
                SCHED_FENCE();
                o0 = MFMA16(vf, p0, o0); o1 = MFMA16(vf, p1, o1);
#pragma unroll
                for (int gi = 0; gi < 8; ++gi) {
                    if (gi < 7) LDQ((gi + 1) & 1, gi + 1);
                    SCHED_FENCE();
#pragma unroll
                    for (int sl = 0; sl < 2; ++sl) { const int s2 = 2 * gi + sl;
                        const bf16x8 sb = mk8(cvtpk(acc[2 * s2].x, acc[2 * s2].y), cvtpk(acc[2 * s2].z, acc[2 * s2].w), cvtpk(acc[2 * s2 + 1].x, acc[2 * s2 + 1].y), cvtpk(acc[2 * s2 + 1].z, acc[2 * s2 + 1].w));
                        o0 = MFMA16(sb, qb[gi & 1][sl], o0); o1 = MFMA16(sb, qb[gi & 1][2 + sl], o1); }
                    SCHED_FENCE();
                }
#undef LDQ
                if (VAR == 1) { asm volatile("" :: "v"(o0), "v"(o1)); } else if (USE_FUSED_NORM) {
                    float t0 = (o0.x * o0.x + o0.y * o0.y) + (o0.z * o0.z + o0.w * o0.w), t1 = (o1.x * o1.x + o1.y * o1.y) + (o1.z * o1.z + o1.w * o1.w);
                    t0 += __shfl_xor(t0, 16); t1 += __shfl_xor(t1, 16); t0 += __shfl_xor(t0, 32); t1 += __shfl_xor(t1, 32);
                    const int row0 = b * SEQ + 32 * (c - 1) + r;
                    if (g == 0) { LAS float* pp = (LAS float*)(F.lds + SSP_OFF) + ((c & 1) * 8 + w) * 32; pp[r] = t0; pp[16 + r] = t1; }
                    const float y0 = o0.x * ng4.x * silu(bflo(zc0.x)), y1 = o0.y * ng4.y * silu(bfhi(zc0.x)), y2 = o0.z * ng4.z * silu(bflo(zc0.y)), y3 = o0.w * ng4.w * silu(bfhi(zc0.y));
                    const float y4 = o1.x * ng4.x * silu(bflo(zc1.x)), y5 = o1.y * ng4.y * silu(bfhi(zc1.x)), y6 = o1.z * ng4.z * silu(bflo(zc1.y)), y7 = o1.w * ng4.w * silu(bfhi(zc1.y));
                    bf16* op = F.Y + (size_t)row0 * DI + ycol;
                    *(GAS v2u*)op = (v2u){cvtpk(y0, y1), cvtpk(y2, y3)}; *(GAS v2u*)(op + (size_t)16 * DI) = (v2u){cvtpk(y4, y5), cvtpk(y6, y7)};
                } else {
                    bf16* op = (bf16*)O1 + (size_t)(b * SEQ + 32 * (c - 1) + r) * DI + h * 1024 + ds * 128 + 16 * w + 4 * g;
                    *(GAS v2u*)op = (v2u){pk2(o0.x, o0.y), pk2(o0.z, o0.w)}; *(GAS v2u*)(op + (size_t)16 * DI) = (v2u){pk2(o1.x, o1.y), pk2(o1.z, o1.w)}; }
            }
            {
                f32x4 ug[2][4]; bf16x8 uk[2][4];
#define LDU(buf_, gi_) do { _Pragma("unroll") for (int ml_ = 0; ml_ < 4; ++ml_) { const int m_ = 4 * (gi_) + ml_; ug[buf_][ml_] = *(const LAS f32x4*)(st + R1_GL + (16 * m_ + 4 * g) * 4); \
                    uk[buf_][ml_] = *(const LAS bf16x8*)(st + R1_KD + m_ * 1024 + lane * 16); } } while (0)
                LDU(0, 0);
                SCHED_FENCE();
#pragma unroll
                for (int gi = 0; gi < 8; ++gi) {
                    if (gi < 7) LDU((gi + 1) & 1, gi + 1);
                    SCHED_FENCE();
#pragma unroll
                    for (int ml = 0; ml < 4; ++ml) { const int m = 4 * gi + ml; acc[m] = MFMA16(uk[gi & 1][ml], vf, acc[m] * ug[gi & 1][ml]); }
                    SCHED_FENCE();
                }
#undef LDU
            }
            if (USE_FUSED_NORM) { zc0 = zn0; zc1 = zn1; }
        }
#undef L1_DMA
        if (VAR == 1) { _Pragma("unroll") for (int m = 0; m < 32; ++m) asm volatile("" :: "v"(acc[m])); }
        asm volatile("s_waitcnt vmcnt(0) lgkmcnt(0)" ::: "memory");
        __builtin_amdgcn_s_barrier();
        if (USE_FUSED_NORM && VAR == 0 && w == 0 && lane < 32) {
            const LAS float* pp = (const LAS float*)(F.lds + SSP_OFF) + ((NCH - 1) & 1) * 256 + lane; float sm = 0.f;
#pragma unroll
            for (int ww = 0; ww < 8; ++ww) sm += pp[ww * 32];
            SS[(size_t)(b * SEQ + 32 * (NCH - 2) + lane) * 64 + h * 8 + ds] = sm; }
        asm volatile("s_waitcnt vmcnt(0) lgkmcnt(0)" ::: "memory");
    }
}

constexpr int R2_QD = 0, R2_KD = 32768, R2_P = 65536, R2_GL = 67584, ST2 = 69632, X2_OFF = 2 * ST2;
DI_ void l1_seq2(Frame& F, const unsigned char* REC1, const unsigned char* VF1, float* SS) {
    const int lane = F.lane, w = F.wave, r = lane & 15, g = lane >> 4, dkh = w >> 2, dvq = w & 3;
    for (int u = F.vcu; u < NB * GL_H * 8; u += F.G) {
        const int bh = u >> 3, ds = u & 7, b = bh >> 3, h = bh & 7;
        f32x4 acc[16][2];
#pragma unroll
        for (int m = 0; m < 16; ++m) { acc[m][0] = (f32x4){0.f, 0.f, 0.f, 0.f}; acc[m][1] = acc[m][0]; }
        const int ycol = h * 1024 + ds * 128 + 32 * dvq + 16 * dkh + 4 * g;
        const f32x4 ng4 = *(const GAS f32x4*)(F.ng1 + ycol);
        const bf16* xz = F.QFIZ + (size_t)(b * SEQ - 32) * N1 + 16384 + ycol;
        const unsigned char* vfb = VF1 + ((size_t)bh * NCH * 64 + ds * 8 + 2 * dvq) * 1024 + lane * 16;
#define L2_DMA(c_) do { const unsigned char* rs_ = REC1 + (size_t)(bh * NCH + (c_)) * R1_SH; LAS unsigned char* st_ = F.lds + ((c_) & 1) * ST2; \
        _Pragma("unroll") for (int i_ = 0; i_ < 8; ++i_) { const int p_ = w + 8 * i_; __builtin_amdgcn_global_load_lds((const unsigned*)(rs_ + p_ * 1024 + lane * 16), (LAS unsigned*)(st_ + p_ * 1024), 16, 0, 0); } \
        if (w < 4) __builtin_amdgcn_global_load_lds((const unsigned*)(rs_ + (w + 64) * 1024 + lane * 16), (LAS unsigned*)(st_ + (w + 64) * 1024), 16, 0, 0); } while (0)
        v4u vfr[2][2];
        v2u zr[2][2];
        f32x4 keep[2][2];
        vfr[0][0] = *(const GAS v4u*)(vfb); vfr[0][1] = *(const GAS v4u*)(vfb + 1024);
        zr[0][0] = (v2u){0u, 0u}; zr[0][1] = zr[0][0];
        L2_DMA(0);
#define L2_BODY(C_, PAR) do { const int c = (C_); \
            asm volatile("s_waitcnt vmcnt(0) lgkmcnt(0)" ::: "memory"); \
            __builtin_amdgcn_s_barrier(); \
            asm volatile("" ::: "memory"); \
            if (c >= 3 && c <= NCH + 1 && w == 0 && lane < 32) {                  \
                const LAS float* pp = (const LAS float*)(F.lds + SSP_OFF) + PAR * 256 + lane; float sm = 0.f; \
                _Pragma("unroll") for (int ww = 0; ww < 8; ++ww) sm += pp[ww * 32]; \
                SS[(size_t)(b * SEQ + 32 * (c - 3) + lane) * 64 + h * 8 + ds] = sm; } \
            if (c >= 2 && c <= NCH) {                                  \
                const v4u px = *(const LAS v4u*)(F.lds + X2_OFF + (PAR ^ 1) * 8192 + (w ^ 4) * 1024 + lane * 16); \
                const f32x4 a0 = keep[PAR ^ 1][0] + (f32x4){bflo(px.x), bfhi(px.x), bflo(px.y), bfhi(px.y)}, a1 = keep[PAR ^ 1][1] + (f32x4){bflo(px.z), bfhi(px.z), bflo(px.w), bfhi(px.w)}; \
                float t0 = (a0.x * a0.x + a0.y * a0.y) + (a0.z * a0.z + a0.w * a0.w), t1 = (a1.x * a1.x + a1.y * a1.y) + (a1.z * a1.z + a1.w * a1.w); \
                t0 += __shfl_xor(t0, 16); t1 += __shfl_xor(t1, 16); t0 += __shfl_xor(t0, 32); t1 += __shfl_xor(t1, 32); \
                if (g == 0) { LAS float* pp = (LAS float*)(F.lds + SSP_OFF) + ((PAR ^ 1) * 8 + w) * 32; pp[r] = t0; pp[16 + r] = t1; } \
                const v2u z0 = zr[PAR ^ 1][0], z1 = zr[PAR ^ 1][1]; \
                bf16* op = F.Y + (size_t)(b * SEQ + 32 * (c - 2) + r) * DI + ycol; \
                *(GAS v2u*)op = (v2u){cvtpk(a0.x * ng4.x * silu(bflo(z0.x)), a0.y * ng4.y * silu(bfhi(z0.x))), cvtpk(a0.z * ng4.z * silu(bflo(z0.y)), a0.w * ng4.w * silu(bfhi(z0.y)))}; \
                *(GAS v2u*)(op + (size_t)16 * DI) = (v2u){cvtpk(a1.x * ng4.x * silu(bflo(z1.x)), a1.y * ng4.y * silu(bfhi(z1.x))), cvtpk(a1.z * ng4.z * silu(bflo(z1.y)), a1.w * ng4.w * silu(bfhi(z1.y)))}; } \
            if (c + 1 < NCH) {                                         \
                vfr[PAR ^ 1][0] = *(const GAS v4u*)(vfb + (size_t)(c + 1) * 65536); vfr[PAR ^ 1][1] = *(const GAS v4u*)(vfb + (size_t)(c + 1) * 65536 + 1024); \
                { const bf16* zp = xz + (size_t)((c + 1) * 32 + r) * N1; zr[PAR ^ 1][0] = *(const GAS v2u*)zp; zr[PAR ^ 1][1] = *(const GAS v2u*)(zp + (size_t)16 * N1); } \
                L2_DMA(c + 1); } \
            if (c < NCH) { \
                const LAS unsigned char* st = F.lds + (c & 1) * ST2; \
                bf16x8 vf[2]; vf[0] = __builtin_bit_cast(bf16x8, vfr[PAR][0]); vf[1] = __builtin_bit_cast(bf16x8, vfr[PAR][1]); \
                const LAS f32x4* glp = (const LAS f32x4*)(st + R2_GL + (256 * dkh + 4 * g) * 4); \
                f32x4 ug[2][2]; bf16x8 uk[2][2]; \
                if (c > 0) { \
                    f32x4 o[2][2]; \
                    _Pragma("unroll") for (int ti = 0; ti < 2; ++ti) { o[ti][0] = (f32x4){0.f, 0.f, 0.f, 0.f}; o[ti][1] = o[ti][0]; } \
                    if (dkh == 0) { const bf16x8 p0 = *(const LAS bf16x8*)(st + R2_P + lane * 16), p1 = *(const LAS bf16x8*)(st + R2_P + 1024 + lane * 16); \
                        o[0][0] = MFMA16(vf[0], p0, o[0][0]); o[0][1] = MFMA16(vf[1], p0, o[0][1]); o[1][0] = MFMA16(vf[0], p1, o[1][0]); o[1][1] = MFMA16(vf[1], p1, o[1][1]); } \
                    bf16x8 qb[2][2]; \
                    qb[0][0] = *(const LAS bf16x8*)(st + R2_QD + (8 * dkh) * 1024 + lane * 16); qb[0][1] = *(const LAS bf16x8*)(st + R2_QD + (16 + 8 * dkh) * 1024 + lane * 16); \
                    SCHED_FENCE(); \
                    _Pragma("unroll") for (int s2 = 0; s2 < 8; ++s2) { \
                        if (s2 < 7) { qb[(s2 + 1) & 1][0] = *(const LAS bf16x8*)(st + R2_QD + (8 * dkh + s2 + 1) * 1024 + lane * 16); qb[(s2 + 1) & 1][1] = *(const LAS bf16x8*)(st + R2_QD + (16 + 8 * dkh + s2 + 1) * 1024 + lane * 16); } \
                        SCHED_FENCE(); \
                        _Pragma("unroll") for (int t_ = 0; t_ < 2; ++t_) { \
                            const bf16x8 sb = mk8(cvtpk(acc[2 * s2][t_].x, acc[2 * s2][t_].y), cvtpk(acc[2 * s2][t_].z, acc[2 * s2][t_].w), cvtpk(acc[2 * s2 + 1][t_].x, acc[2 * s2 + 1][t_].y), cvtpk(acc[2 * s2 + 1][t_].z, acc[2 * s2 + 1][t_].w)); \
                            o[0][t_] = MFMA16(sb, qb[s2 & 1][0], o[0][t_]); o[1][t_] = MFMA16(sb, qb[s2 & 1][1], o[1][t_]); } \
                        SCHED_FENCE(); \
                    } \
                    { const f32x4 s0 = o[0][dkh ^ 1], s1 = o[1][dkh ^ 1];                    \
                      *(LAS v4u*)(F.lds + X2_OFF + PAR * 8192 + w * 1024 + lane * 16) = (v4u){pk2(s0.x, s0.y), pk2(s0.z, s0.w), pk2(s1.x, s1.y), pk2(s1.z, s1.w)}; \
                      keep[PAR][0] = o[0][dkh]; keep[PAR][1] = o[1][dkh]; } \
                } \
                _Pragma("unroll") for (int ml_ = 0; ml_ < 2; ++ml_) { ug[0][ml_] = glp[4 * ml_]; uk[0][ml_] = *(const LAS bf16x8*)(st + R2_KD + (16 * dkh + ml_) * 1024 + lane * 16); } \
                SCHED_FENCE(); \
                _Pragma("unroll") for (int gi = 0; gi < 8; ++gi) { \
                    if (gi < 7) { _Pragma("unroll") for (int ml_ = 0; ml_ < 2; ++ml_) { const int m_ = 2 * (gi + 1) + ml_; ug[(gi + 1) & 1][ml_] = glp[4 * m_]; uk[(gi + 1) & 1][ml_] = *(const LAS bf16x8*)(st + R2_KD + (16 * dkh + m_) * 1024 + lane * 16); } } \
                    SCHED_FENCE(); \
                    _Pragma("unroll") for (int ml = 0; ml < 2; ++ml) { const int m = 2 * gi + ml; \
                        acc[m][0] = MFMA16(uk[gi & 1][ml], vf[0], acc[m][0] * ug[gi & 1][ml]); acc[m][1] = MFMA16(uk[gi & 1][ml], vf[1], acc[m][1] * ug[gi & 1][ml]); } \
                    SCHED_FENCE(); \
                } \
            } \
            asm volatile("" : "+v"(vfr[PAR ^ 1][0]), "+v"(vfr[PAR ^ 1][1]), "+v"(zr[PAR ^ 1][0]), "+v"(zr[PAR ^ 1][1]));        \
        } while (0)
        for (int c2 = 0; c2 <= NCH + 1; c2 += 2) { L2_BODY(c2, 0); L2_BODY(c2 + 1, 1); }
#undef L2_BODY
#undef L2_DMA
        asm volatile("s_waitcnt vmcnt(0) lgkmcnt(0)" ::: "memory");
        __builtin_amdgcn_s_barrier();
    }
}

DI_ void l0_prep(Frame& F, unsigned char* REC0) {
    const int lane = F.lane, w = F.wave, r = lane & 15, g = lane >> 4;
    LAS unsigned char* T = F.lds + w * 16640;
    LAS unsigned char* Tv = T + 8192;
    const int gw = F.vcu * NWAVES + w, NGW = F.G * NWAVES;
    for (int it = gw; it < NB * HG_H * NCH; it += NGW) {
        const int bh = it / NCH, c = it - bh * NCH, b = bh >> 6, h = bh & 63;
        unsigned char* rec = REC0 + (size_t)it * R0_SZ;
        int row[2]; bool nul[2];
#pragma unroll
        for (int ti = 0; ti < 2; ++ti) { const int tok = 16 * ti + r; nul[ti] = (c == 0 && tok < 16); row[ti] = nul[ti] ? 0 : row_of(b, c, tok); }
        f32x4 pacc[3];
#pragma unroll
        for (int t = 0; t < 3; ++t) pacc[t] = (f32x4){0.f, 0.f, 0.f, 0.f};
        v4u qraw[4][2], fraw[4][2], vraw[8];
#pragma unroll
        for (int s = 0; s < 4; ++s)
#pragma unroll
            for (int ti = 0; ti < 2; ++ti) { const bf16* rp = F.QFIZ + (size_t)row[ti] * N0 + h * 128 + 32 * s + 8 * g; qraw[s][ti] = *(const GAS v4u*)rp; fraw[s][ti] = *(const GAS v4u*)(rp + DI); }
#pragma unroll
        for (int i = 0; i < 8; ++i) { const int q = lane + 64 * i, tk = q >> 4, c16 = q & 15; const bool nl = (c == 0 && tk < 16);
            vraw[i] = (v4u){0u, 0u, 0u, 0u}; if (!nl) vraw[i] = *(const GAS v4u*)(F.QFIZ + (size_t)row_of(b, c, tk) * N0 + 2 * DI + h * 128 + 8 * c16); }
        asm volatile("" ::: "memory");
#pragma unroll
        for (int s = 0; s < 4; ++s) {
            const int col = h * 128 + 32 * s + 8 * g;
            float lbv[8], bfv[8];
            { const f32x4 a0 = *(const GAS f32x4*)(F.LB0 + col), a1 = *(const GAS f32x4*)(F.LB0 + col + 4), c0 = *(const GAS f32x4*)(F.b_f + col), c1 = *(const GAS f32x4*)(F.b_f + col + 4);
              lbv[0] = a0.x; lbv[1] = a0.y; lbv[2] = a0.z; lbv[3] = a0.w; lbv[4] = a1.x; lbv[5] = a1.y; lbv[6] = a1.z; lbv[7] = a1.w;
              bfv[0] = c0.x; bfv[1] = c0.y; bfv[2] = c0.z; bfv[3] = c0.w; bfv[4] = c1.x; bfv[5] = c1.y; bfv[6] = c1.z; bfv[7] = c1.w; }
            float qv[2][8], fv[2][8];
#pragma unroll
            for (int ti = 0; ti < 2; ++ti) {
                const v4u q4 = qraw[s][ti], f4 = fraw[s][ti];
                qv[ti][0] = bflo(q4.x); qv[ti][1] = bfhi(q4.x); qv[ti][2] = bflo(q4.y); qv[ti][3] = bfhi(q4.y); qv[ti][4] = bflo(q4.z); qv[ti][5] = bfhi(q4.z); qv[ti][6] = bflo(q4.w); qv[ti][7] = bfhi(q4.w);
                fv[ti][0] = bflo(f4.x); fv[ti][1] = bfhi(f4.x); fv[ti][2] = bflo(f4.y); fv[ti][3] = bfhi(f4.y); fv[ti][4] = bflo(f4.z); fv[ti][5] = bfhi(f4.z); fv[ti][6] = bflo(f4.w); fv[ti][7] = bfhi(f4.w);
            }
            unsigned qd[2][4], ki[2][4], kd[2][4]; float gl[8];
#pragma unroll
            for (int e = 0; e < 8; e += 2) {
                float bb[2][2], BB[2], kk[2][2];
#pragma unroll
                for (int u = 0; u < 2; ++u) {
                    const float fg0 = lbv[e + u] + (1.f - lbv[e + u]) * sigm(fv[0][e + u] + bfv[e + u]);
                    const float fg1 = lbv[e + u] + (1.f - lbv[e + u]) * sigm(fv[1][e + u] + bfv[e + u]);
                    const float L0 = nul[0] ? 0.f : lg2(fg0), L1 = nul[1] ? 0.f : lg2(fg1);
                    kk[0][u] = nul[0] ? 0.f : 1.f - fg0; kk[1][u] = nul[1] ? 0.f : 1.f - fg1;
                    const float b0 = scan16(L0);
                    const float b1 = scan16(L1) + bcast15(b0);
                    bb[0][u] = b0; bb[1][u] = b1; BB[u] = bcast15(b1);
                    gl[e + u] = ex2(BB[u]);
                }
#pragma unroll
                for (int ti = 0; ti < 2; ++ti) {
                    const float q0 = nul[ti] ? 0.f : silu(qv[ti][e]), q1 = nul[ti] ? 0.f : silu(qv[ti][e + 1]);
                    qd[ti][e >> 1] = cvtpk(q0 * ex2(bb[ti][0]), q1 * ex2(bb[ti][1]));
                    ki[ti][e >> 1] = cvtpk(kk[ti][0] * ex2(-bb[ti][0]), kk[ti][1] * ex2(-bb[ti][1]));
                    kd[ti][e >> 1] = cvtpk(kk[ti][0] * ex2(BB[0] - bb[ti][0]), kk[ti][1] * ex2(BB[1] - bb[ti][1]));
                }
            }
            const bf16x8 qf0 = mk8(qd[0][0], qd[0][1], qd[0][2], qd[0][3]), qf1 = mk8(qd[1][0], qd[1][1], qd[1][2], qd[1][3]);
            const bf16x8 kf0 = mk8(ki[0][0], ki[0][1], ki[0][2], ki[0][3]), kf1 = mk8(ki[1][0], ki[1][1], ki[1][2], ki[1][3]);
            pacc[0] = MFMA16(kf0, qf0, pacc[0]);
            pacc[1] = MFMA16(kf0, qf1, pacc[1]);
            pacc[2] = MFMA16(kf1, qf1, pacc[2]);
#pragma unroll
            for (int ti = 0; ti < 2; ++ti)
#pragma unroll
                for (int h2 = 0; h2 < 2; ++h2) {
                    const int lp = (2 * (g & 1) + h2) * 16 + r;
                    v2u d; d.x = qd[ti][2 * h2]; d.y = qd[ti][2 * h2 + 1];
                    *(GAS v2u*)(rec + R0_QD + ((ti * 4 + s) * 64 + lp) * 16 + (g >> 1) * 8) = d;
                }
#pragma unroll
            for (int ti = 0; ti < 2; ++ti)
#pragma unroll
                for (int e = 0; e < 8; ++e) {
                    const unsigned wd = kd[ti][e >> 1]; const unsigned short hv = (e & 1) ? (unsigned short)(wd >> 16) : (unsigned short)(wd & 0xffffu);
                    *(LAS unsigned short*)(T + (32 * s + 8 * g + e) * 64 + (16 * ti + r) * 2) = hv;
                }
            if (r == 0) { *(GAS f32x4*)(rec + R0_GL + (32 * s + 8 * g) * 4) = (f32x4){gl[0], gl[1], gl[2], gl[3]}; *(GAS f32x4*)(rec + R0_GL + (32 * s + 8 * g + 4) * 4) = (f32x4){gl[4], gl[5], gl[6], gl[7]}; }
        }
#pragma unroll
        for (int t = 0; t < 4; ++t) {
            const int tj = (t >= 2) ? 1 : 0, ti = (t == 1 || t == 2) ? 1 : 0;
            float pv[4] = {0.f, 0.f, 0.f, 0.f};
            if (t < 3) { pv[0] = pacc[t].x; pv[1] = pacc[t].y; pv[2] = pacc[t].z; pv[3] = pacc[t].w; }
#pragma unroll
            for (int jj = 0; jj < 4; ++jj) { const int j = 16 * tj + 4 * g + jj, i = 16 * ti + r; if (j > i) pv[jj] = 0.f; }
            const int lp = (2 * tj + (g >> 1)) * 16 + r;
            v2u d; d.x = cvtpk(pv[0], pv[1]); d.y = cvtpk(pv[2], pv[3]);
            *(GAS v2u*)(rec + R0_P + (ti * 64 + lp) * 16 + 8 * (g & 1)) = d;
        }
#pragma unroll
        for (int i = 0; i < 8; ++i) {
            const int q = lane + 64 * i, tk = q >> 4, c16 = q & 15; const v4u d = vraw[i];
            *(LAS v2u*)(Tv + tk * 264 + c16 * 16) = (v2u){d.x, d.y}; *(LAS v2u*)(Tv + tk * 264 + c16 * 16 + 8) = (v2u){d.z, d.w};
        }
        LDS_WAIT(); asm volatile("" ::: "memory");
#pragma unroll
        for (int mt = 0; mt < 8; ++mt) { const v4u d = *(const LAS v4u*)(T + (16 * mt + r) * 64 + 16 * g); *(GAS v4u*)(rec + R0_KD + (mt * 64 + lane) * 16) = d; }
#pragma unroll
        for (int sl = 0; sl < 8; ++sl) {
            unsigned short hv[8];
#pragma unroll
            for (int e = 0; e < 8; ++e) hv[e] = *(const LAS unsigned short*)(Tv + (8 * g + e) * 264 + (16 * sl + r) * 2);
            v4u d; d.x = hv[0] | ((unsigned)hv[1] << 16); d.y = hv[2] | ((unsigned)hv[3] << 16); d.z = hv[4] | ((unsigned)hv[5] << 16); d.w = hv[6] | ((unsigned)hv[7] << 16);
            *(GAS v4u*)(rec + R0_V + (sl * 64 + lane) * 16) = d;
        }
        LDS_WAIT(); asm volatile("" ::: "memory");
    }
}

DI_ void l0_seq(Frame& F, const unsigned char* REC0) {
    const int lane = F.lane, w = F.wave, r = lane & 15, g = lane >> 4;
    LAS float* obuf = (LAS float*)(F.lds + 2 * ST0);
    constexpr int OB = 32 * 132;
    for (int u = F.vcu; u < NB * HG_H; u += F.G) {
        const int bh = u, b = bh >> 6, h = bh & 63;
        f32x4 acc[8];
#pragma unroll
        for (int m = 0; m < 8; ++m) acc[m] = (f32x4){0.f, 0.f, 0.f, 0.f};
        const int ntok = 4 * w + g, ndv = 8 * r;
        float ngv[8];
        { const f32x4 a0 = *(const GAS f32x4*)(F.ng0 + h * 128 + ndv), a1 = *(const GAS f32x4*)(F.ng0 + h * 128 + ndv + 4);
          ngv[0] = a0.x; ngv[1] = a0.y; ngv[2] = a0.z; ngv[3] = a0.w; ngv[4] = a1.x; ngv[5] = a1.y; ngv[6] = a1.z; ngv[7] = a1.w; }
#define L0_DMA(c_) do { const unsigned char* rs_ = REC0 + (size_t)(bh * NCH + (c_)) * R0_SZ; LAS unsigned char* st_ = F.lds + ((c_) & 1) * ST0; \
        for (int p_ = w; p_ < 27; p_ += 8) __builtin_amdgcn_global_load_lds((const unsigned*)(rs_ + p_ * 1024 + lane * 16), (LAS unsigned*)(st_ + p_ * 1024), 16, 0, 0); } while (0)
        L0_DMA(0);
        v4u zprev = (v4u){0u, 0u, 0u, 0u};
        for (int c = 0; c <= NCH; ++c) {
            asm volatile("s_waitcnt vmcnt(0)" ::: "memory");
            __builtin_amdgcn_s_barrier();
            asm volatile("" ::: "memory");
            if (c + 1 < NCH) L0_DMA(c + 1);
            v4u zcur = (v4u){0u, 0u, 0u, 0u};
            const bool zvalid = (c < NCH) && !(c == 0 && ntok < 16);
            if (zvalid) zcur = *(const GAS v4u*)(F.QFIZ + (size_t)row_of(b, c, ntok) * N0 + 3 * DI + h * 128 + ndv);
            if (c >= 1) {
                const int cp = c - 1;
                const LAS float* ob = obuf + (cp & 1) * OB + ntok * 132 + ndv;
                const f32x4 x0 = *(const LAS f32x4*)(ob), x1 = *(const LAS f32x4*)(ob + 4);
                float ss = (x0.x * x0.x + x0.y * x0.y) + (x0.z * x0.z + x0.w * x0.w) + (x1.x * x1.x + x1.y * x1.y) + (x1.z * x1.z + x1.w * x1.w);
                ss += __shfl_xor(ss, 8); ss += __shfl_xor(ss, 4); ss += __shfl_xor(ss, 2); ss += __shfl_xor(ss, 1);
                const float rs = rsqrtf(ss * (1.f / 128.f) + RMS_EPS);
                const bool wr = !(cp == 0 && (ntok < 16 || b != 0));
                if (wr) {
                    v4u d;
                    d.x = cvtpk(x0.x * rs * ngv[0] * silu(bflo(zprev.x)), x0.y * rs * ngv[1] * silu(bfhi(zprev.x)));
                    d.y = cvtpk(x0.z * rs * ngv[2] * silu(bflo(zprev.y)), x0.w * rs * ngv[3] * silu(bfhi(zprev.y)));
                    d.z = cvtpk(x1.x * rs * ngv[4] * silu(bflo(zprev.z)), x1.y * rs * ngv[5] * silu(bfhi(zprev.z)));
                    d.w = cvtpk(x1.z * rs * ngv[6] * silu(bflo(zprev.w)), x1.w * rs * ngv[7] * silu(bfhi(zprev.w)));
                    *(GAS v4u*)(F.Y + (size_t)row_of(b, cp, ntok) * DI + h * 128 + ndv) = d;
                }
            }
            zprev = zcur;
            if (c < NCH) {
                const LAS unsigned char* st = F.lds + (c & 1) * ST0;
                const bf16x8 vf = *(const LAS bf16x8*)(st + R0_V + w * 1024 + lane * 16);
                const bf16x8 p0 = *(const LAS bf16x8*)(st + R0_P + lane * 16), p1 = *(const LAS bf16x8*)(st + R0_P + 1024 + lane * 16);
                bf16x8 qf[8], kf[8]; f32x4 gf[8];
#pragma unroll
                for (int q = 0; q < 8; ++q) qf[q] = *(const LAS bf16x8*)(st + R0_QD + q * 1024 + lane * 16);
#pragma unroll
                for (int m = 0; m < 8; ++m) { gf[m] = *(const LAS f32x4*)(st + R0_GL + (16 * m + 4 * g) * 4); kf[m] = *(const LAS bf16x8*)(st + R0_KD + m * 1024 + lane * 16); }
                SCHED_FENCE();
                f32x4 o0 = (f32x4){0.f, 0.f, 0.f, 0.f}, o1 = o0;
                o0 = MFMA16(vf, p0, o0); o1 = MFMA16(vf, p1, o1);
#pragma unroll
                for (int s2 = 0; s2 < 4; ++s2) {
                    const bf16x8 sb = mk8(cvtpk(acc[2 * s2].x, acc[2 * s2].y), cvtpk(acc[2 * s2].z, acc[2 * s2].w), cvtpk(acc[2 * s2 + 1].x, acc[2 * s2 + 1].y), cvtpk(acc[2 * s2 + 1].z, acc[2 * s2 + 1].w));
                    o0 = MFMA16(sb, qf[s2], o0); o1 = MFMA16(sb, qf[4 + s2], o1);
                }
#pragma unroll
                for (int m = 0; m < 8; ++m) acc[m] = MFMA16(kf[m], vf, acc[m] * gf[m]);
                LAS float* ow = obuf + (c & 1) * OB + r * 132 + 16 * w + 4 * g;
                *(LAS f32x4*)ow = o0; *(LAS f32x4*)(ow + 16 * 132) = o1;
                asm volatile("s_waitcnt lgkmcnt(0)" ::: "memory");
            }
        }
#undef L0_DMA
        asm volatile("s_waitcnt vmcnt(0)" ::: "memory");
        __builtin_amdgcn_s_barrier();
    }
}

template <int KS, int MODE>
DI_ void skinny(Frame& F, const bf16* A, const bf16* Bt, int K, int n_first, int n_slices, bf16* Ob, int ldo, float* Of, const float* res) {
    const int lane = F.lane, w = F.wave, r = lane & 15, g = lane >> 4;
    constexpr int SPB = 8 / KS;
    const int kw = w % KS, sw = w / KS, klen = K / KS, kbeg = kw * klen;
    LAS f32x4* red = (LAS f32x4*)F.lds;
    for (int p = F.vcu; p * SPB < n_slices; p += F.G) {
        const int sl = p * SPB + sw, n0 = n_first + 16 * sl;
        f32x4 acc = (f32x4){0.f, 0.f, 0.f, 0.f};
        if (sl < n_slices) {
            const GAS v4u* bp = (const GAS v4u*)(Bt + (size_t)(n0 + r) * K + kbeg + 16 * g);
            const GAS v4u* ap = (const GAS v4u*)(A + (size_t)r * K + kbeg + 16 * g);
            for (int kk = 0; kk < klen; kk += 256) {
                v4u bv[8], av[8];
#pragma unroll
                for (int u = 0; u < 4; ++u) { bv[2 * u] = bp[(kk + 64 * u) / 8]; bv[2 * u + 1] = bp[(kk + 64 * u) / 8 + 1]; av[2 * u] = ap[(kk + 64 * u) / 8]; av[2 * u + 1] = ap[(kk + 64 * u) / 8 + 1]; }
                asm volatile("" ::: "memory");
#pragma unroll
                for (int u = 0; u < 8; ++u) acc = MFMA16(__builtin_bit_cast(bf16x8, bv[u]), __builtin_bit_cast(bf16x8, av[u]), acc);
            }
        }
        if (KS > 1) {
            red[w * 64 + lane] = acc;
            __syncthreads();
            if (kw == 0) {
#pragma unroll
                for (int j = 1; j < KS; ++j) acc += red[(w + j) * 64 + lane];
            }
        }
        if (kw == 0 && sl < n_slices) {
            if (MODE == 0) { v2u d; d.x = pk2(acc.x, acc.y); d.y = pk2(acc.z, acc.w); *(GAS v2u*)(Ob + (size_t)r * ldo + n0 + 4 * g) = d; }
            else { const f32x4 rv = *(const GAS f32x4*)(res + (size_t)r * D + n0 + 4 * g); *(GAS f32x4*)(Of + (size_t)r * D + n0 + 4 * g) = rv * ALPHA + acc; }
        }
        if (KS > 1) __syncthreads();
    }
    asm volatile("s_waitcnt vmcnt(0)" ::: "memory");
}

DI_ void gate_proj(Frame& F, const bf16* WG1T  ) {
    const int lane = F.lane, w = F.wave, r = lane & 15, g = lane >> 4, kw = w & 3, sw = w >> 2;
    LAS f32x4* red = (LAS f32x4*)F.lds;
    for (int p = F.vcu; 2 * p < MR / 16; p += F.G) {
        const int t = 2 * p + sw;
        f32x4 acc = (f32x4){0.f, 0.f, 0.f, 0.f};
        if (t < MR / 16) {
            const GAS v4u* wp = (const GAS v4u*)(WG1T + (size_t)r * D + 1024 * kw + 16 * g);
            const GAS v4u* hp = (const GAS v4u*)(F.H1B + (size_t)(16 * t + r) * D + 1024 * kw + 16 * g);
            for (int kk = 0; kk < 1024; kk += 256) {
                v4u wv[8], hv[8];
#pragma unroll
                for (int u = 0; u < 4; ++u) { wv[2 * u] = wp[(kk + 64 * u) / 8]; wv[2 * u + 1] = wp[(kk + 64 * u) / 8 + 1]; hv[2 * u] = hp[(kk + 64 * u) / 8]; hv[2 * u + 1] = hp[(kk + 64 * u) / 8 + 1]; }
                asm volatile("" ::: "memory");
#pragma unroll
                for (int u = 0; u < 8; ++u) acc = MFMA16(__builtin_bit_cast(bf16x8, wv[u]), __builtin_bit_cast(bf16x8, hv[u]), acc);
            }
        }
        red[w * 64 + lane] = acc;
        __syncthreads();
        if (kw == 0 && t < MR / 16) {
            acc += red[(w + 1) * 64 + lane]; acc += red[(w + 2) * 64 + lane]; acc += red[(w + 3) * 64 + lane];
            *(GAS f32x4*)(F.G1 + (size_t)(16 * t + r) * GL_R + 4 * g) = acc;
        }
        __syncthreads();
    }
    asm volatile("s_waitcnt vmcnt(0)" ::: "memory");
}

#ifndef USE_AUX
#define USE_AUX 0
#endif
struct AuxT { const float* src; bf16* dst; int N, K; };
DI_ AuxT aux_decode(Frame& F, int it, unsigned char* dummy) {
    constexpr int I_1 = (DI / 64) * (D / 32), I_2 = (D / 64) * (N1 / 32), I_3 = I_1, AUX_ITERS = (I_1 + I_2 + I_3) / (256 * NWAVES);
    static_assert((I_1 + I_2 + I_3) % (256 * NWAVES) == 0, "aux tiles divide over the waves");
    const int gw = F.vcu * NWAVES + F.wave;
    AuxT t;
    if (it >= AUX_ITERS || F.G != 256) { t.src = (const float*)(dummy + (size_t)gw * 8192); t.dst = (bf16*)(dummy + 32 * MiB + (size_t)gw * 8192); t.N = 32; t.K = 64; return t; }
    int r_ = it * (256 * NWAVES) + gw; const float* W; bf16* WT; int K, N;
    if (r_ < I_1) { W = F.w0out; WT = F.WT0OUT; K = DI; N = D; }
    else if (r_ < I_1 + I_2) { r_ -= I_1; W = F.w1in; WT = F.WT1IN; K = D; N = N1; }
    else { r_ -= I_1 + I_2; W = F.w1out; WT = F.WT1OUT; K = DI; N = D; }
    const int nblk = N / 32, kb = r_ / nblk, nb = r_ - kb * nblk;
    t.src = W + (size_t)(64 * kb) * N + 32 * nb; t.dst = WT + (size_t)(32 * nb) * K + 64 * kb; t.N = N; t.K = K; return t;
}
DI_ void aux_load(Frame& F, const AuxT& t, f32x4 (&wv)[8]) {
    const int rowi = F.lane >> 3, c4 = F.lane & 7;
#pragma unroll
    for (int i = 0; i < 8; ++i) wv[i] = *(const GAS f32x4*)(t.src + (size_t)(8 * i + rowi) * t.N + 4 * c4);
}
DI_ void aux_store(Frame& F, const AuxT& t, const f32x4 (&wv)[8], LAS unsigned char* scr  ) {
    const int lane = F.lane, rowi = lane >> 3, c4 = lane & 7;
#pragma unroll
    for (int i = 0; i < 8; ++i) { LAS unsigned* p = (LAS unsigned*)(scr + (8 * i + rowi) * 68 + c4 * 8); p[0] = cvtpk(wv[i].x, wv[i].y); p[1] = cvtpk(wv[i].z, wv[i].w); }
    LDS_WAIT(); asm volatile("" ::: "memory");
    const int kc = lane & 7;
#pragma unroll
    for (int j = 0; j < 4; ++j) { const int n = (lane >> 3) + 8 * j; unsigned short hv[8];
#pragma unroll
        for (int e = 0; e < 8; ++e) hv[e] = *(const LAS unsigned short*)(scr + (8 * kc + e) * 68 + n * 2);
        v4u o; o.x = hv[0] | ((unsigned)hv[1] << 16); o.y = hv[2] | ((unsigned)hv[3] << 16); o.z = hv[4] | ((unsigned)hv[5] << 16); o.w = hv[6] | ((unsigned)hv[7] << 16);
        *(GAS v4u*)(t.dst + (size_t)n * t.K + 8 * kc) = o; }
    LDS_WAIT(); asm volatile("" ::: "memory");
}

constexpr int F0_QD = 0, F0_KI = 8192, F0_T = 16384, F0_GL = 24576, F0_TV = 25088, F0_STG = 33536;
DI_ void f0_load(const bf16* cb, const int (&oq)[2], int ov, v2u (&q2)[2], v2u (&f2)[2], v4u& vraw) {
#pragma unroll
    for (int ti = 0; ti < 2; ++ti) { q2[ti] = *(const GAS v2u*)(cb + oq[ti]); f2[ti] = *(const GAS v2u*)(cb + oq[ti] + DI); }
    vraw = *(const GAS v4u*)(cb + ov);
}
DI_ void f0_prep(Frame& F, LAS unsigned char* st, const v2u (&q2)[2], const v2u (&f2)[2], const v4u& vraw, const f32x4& lb4, const f32x4& bf4) {
    const int lane = F.lane, w = F.wave, r = lane & 15, g = lane >> 4, ps = w >> 1, hf = w & 1;
    const float lbv[4] = {lb4.x, lb4.y, lb4.z, lb4.w}, bfv[4] = {bf4.x, bf4.y, bf4.z, bf4.w};
    float Lv[2][4], qq[2][4], kk[2][4];
#pragma unroll
    for (int ti = 0; ti < 2; ++ti) {
        const float qv[4] = {bflo(q2[ti].x), bfhi(q2[ti].x), bflo(q2[ti].y), bfhi(q2[ti].y)}, fv[4] = {bflo(f2[ti].x), bfhi(f2[ti].x), bflo(f2[ti].y), bfhi(f2[ti].y)};
#pragma unroll
        for (int x = 0; x < 4; ++x) { const float fg = lbv[x] + (1.f - lbv[x]) * sigm(fv[x] + bfv[x]);
            Lv[ti][x] = lg2(fg); kk[ti][x] = 1.f - fg; qq[ti][x] = silu(qv[x]); }
    }
    float qd[2][4], ki[2][4], kd[2][4], gl[4];
#pragma unroll
    for (int x = 0; x < 4; ++x) {
        const float b0 = scan16(Lv[0][x]);
        const float b1 = scan16(Lv[1][x]) + bcast15(b0);
        const float BB = bcast15(b1);
        gl[x] = ex2(BB);
        qd[0][x] = qq[0][x] * ex2(b0); ki[0][x] = kk[0][x] * ex2(-b0); kd[0][x] = ki[0][x] * gl[x];
        qd[1][x] = qq[1][x] * ex2(b1); ki[1][x] = kk[1][x] * ex2(-b1); kd[1][x] = ki[1][x] * gl[x];
    }
    const int lp = (2 * (g & 1) + hf) * 16 + r;
#pragma unroll
    for (int ti = 0; ti < 2; ++ti) {
        *(LAS v2u*)(st + F0_QD + ((ti * 4 + ps) * 64 + lp) * 16 + (g >> 1) * 8) = (v2u){cvtpk(qd[ti][0], qd[ti][1]), cvtpk(qd[ti][2], qd[ti][3])};
        *(LAS v2u*)(st + F0_KI + ((ti * 4 + ps) * 64 + lp) * 16 + (g >> 1) * 8) = (v2u){cvtpk(ki[ti][0], ki[ti][1]), cvtpk(ki[ti][2], ki[ti][3])};
        const unsigned k01 = cvtpk(kd[ti][0], kd[ti][1]), k23 = cvtpk(kd[ti][2], kd[ti][3]);
        LAS unsigned char* tp = st + F0_T + (32 * ps + 8 * g + 4 * hf) * 64 + (16 * ti + r) * 2;
        *(LAS unsigned short*)(tp) = (unsigned short)(k01 & 0xffffu); *(LAS unsigned short*)(tp + 64) = (unsigned short)(k01 >> 16);
        *(LAS unsigned short*)(tp + 128) = (unsigned short)(k23 & 0xffffu); *(LAS unsigned short*)(tp + 192) = (unsigned short)(k23 >> 16);
    }
    if (r == 0) *(LAS f32x4*)(st + F0_GL + (32 * ps + 8 * g + 4 * hf) * 4) = (f32x4){gl[0], gl[1], gl[2], gl[3]};
    { const int tk = 4 * w + (lane >> 4), c16 = lane & 15;
      *(LAS v2u*)(st + F0_TV + tk * 264 + c16 * 16) = (v2u){vraw.x, vraw.y}; *(LAS v2u*)(st + F0_TV + tk * 264 + c16 * 16 + 8) = (v2u){vraw.z, vraw.w}; }
}
DI_ void l0_fused(Frame& F, unsigned char* dummy) {
    const int lane = F.lane, w = F.wave, r = lane & 15, g = lane >> 4, ps = w >> 1, hf = w & 1;
    LAS float* obuf = (LAS float*)(F.lds + 2 * F0_STG);
    constexpr int OB = 32 * 132;
    for (int u = F.vcu; u < NB * HG_H; u += F.G) {
        const int bh = u, b = bh >> 6, h = bh & 63;
        f32x4 acc[8];
#pragma unroll
        for (int m = 0; m < 8; ++m) acc[m] = (f32x4){0.f, 0.f, 0.f, 0.f};
        const int ntok = 4 * w + g, ndv = 8 * r;
        float ngv[8];
        { const f32x4 a0 = *(const GAS f32x4*)(F.ng0 + h * 128 + ndv), a1 = *(const GAS f32x4*)(F.ng0 + h * 128 + ndv + 4);
          ngv[0] = a0.x; ngv[1] = a0.y; ngv[2] = a0.z; ngv[3] = a0.w; ngv[4] = a1.x; ngv[5] = a1.y; ngv[6] = a1.z; ngv[7] = a1.w; }
        const int colp = h * 128 + 32 * ps + 8 * g + 4 * hf;
        const f32x4 lb4 = *(const GAS f32x4*)(F.LB0 + colp), bf4 = *(const GAS f32x4*)(F.b_f + colp);
        v2u q2s[2][2], f2s[2][2]; v4u vrs[2];
        const int oq[2] = {r * N0 + colp, (16 + r) * N0 + colp};
        const int ov = (4 * w + (lane >> 4)) * N0 + 2 * DI + h * 128 + 8 * (lane & 15), oz = ntok * N0 + 3 * DI + h * 128 + ndv, oy = ntok * DI + h * 128 + ndv;
        const bf16* xq = F.QFIZ + (size_t)(b * SEQ - 32) * N0;
        bf16* xy = F.Y + (size_t)(b * SEQ - 32) * DI;
        bf16* y0 = (b == 0) ? F.Y0 : F.Y0 + (size_t)32 * DI;
#define QCH(c_) (((c_) == 0) ? (const bf16*)F.Q0 : xq + (size_t)(c_) * 32 * N0)
        f0_load(QCH(0), oq, ov, q2s[0], f2s[0], vrs[0]);
        f0_prep(F, F.lds, q2s[0], f2s[0], vrs[0], lb4, bf4);
        f0_load(QCH(1), oq, ov, q2s[1], f2s[1], vrs[1]);
        LAS unsigned char* ascr = F.lds + 2 * F0_STG + 33792 + w * 4352;
        f32x4 awv[8];
        v4u zs[2]; zs[0] = (v4u){0u, 0u, 0u, 0u}; zs[1] = zs[0];
#define F0_BODY(C_, PAR) do { const int c = (C_); \
            asm volatile("s_waitcnt lgkmcnt(0)" ::: "memory"); \
            __builtin_amdgcn_s_barrier(); \
            asm volatile("" ::: "memory"); \
            f0_load(QCH((c + 2 < NCH) ? c + 2 : NCH - 1), oq, ov, q2s[PAR], f2s[PAR], vrs[PAR]); \
            AuxT at_; if (USE_AUX) { at_ = aux_decode(F, c, dummy); aux_load(F, at_, awv); } \
            { const int cz = (c < NCH) ? c : NCH - 1; zs[PAR] = *(const GAS v4u*)(QCH(cz) + oz); } \
            { \
                const int cp = c - 1; \
                const LAS float* ob = obuf + (cp & 1) * OB + ntok * 132 + ndv; \
                const f32x4 x0 = *(const LAS f32x4*)(ob), x1 = *(const LAS f32x4*)(ob + 4); \
                float ss = (x0.x * x0.x + x0.y * x0.y) + (x0.z * x0.z + x0.w * x0.w) + (x1.x * x1.x + x1.y * x1.y) + (x1.z * x1.z + x1.w * x1.w); \
                ss = bcast15(scan16(ss)); \
                const float rs = rsqrtf(ss * (1.f / 128.f) + RMS_EPS); \
                bf16* yb = (cp <= 0) ? ((cp == 0) ? y0 : F.Y0 + (size_t)32 * DI) : xy + (size_t)cp * 32 * DI; \
                { \
                    v4u d; \
                    d.x = cvtpk(x0.x * rs * ngv[0] * silu(bflo(zs[PAR ^ 1].x)), x0.y * rs * ngv[1] * silu(bfhi(zs[PAR ^ 1].x))); \
                    d.y = cvtpk(x0.z * rs * ngv[2] * silu(bflo(zs[PAR ^ 1].y)), x0.w * rs * ngv[3] * silu(bfhi(zs[PAR ^ 1].y))); \
                    d.z = cvtpk(x1.x * rs * ngv[4] * silu(bflo(zs[PAR ^ 1].z)), x1.y * rs * ngv[5] * silu(bfhi(zs[PAR ^ 1].z))); \
                    d.w = cvtpk(x1.z * rs * ngv[6] * silu(bflo(zs[PAR ^ 1].w)), x1.w * rs * ngv[7] * silu(bfhi(zs[PAR ^ 1].w))); \
                    *(GAS v4u*)(yb + oy) = d; \
                } \
            } \
             \
            { \
                const LAS unsigned char* st = F.lds + (c & 1) * F0_STG; \
 \
                unsigned short hv[8]; \
                _Pragma("unroll") \
                for (int e = 0; e < 8; ++e) hv[e] = *(const LAS unsigned short*)(st + F0_TV + (16 * (e >> 2) + 4 * g + (e & 3)) * 264 + (16 * w + r) * 2); \
                const bf16x8 vf = mk8(hv[0] | ((unsigned)hv[1] << 16), hv[2] | ((unsigned)hv[3] << 16), hv[4] | ((unsigned)hv[5] << 16), hv[6] | ((unsigned)hv[7] << 16)); \
                bf16x8 qf[8], kf[8]; \
                _Pragma("unroll") \
                for (int q = 0; q < 8; ++q) { qf[q] = *(const LAS bf16x8*)(st + F0_QD + q * 1024 + lane * 16); kf[q] = *(const LAS bf16x8*)(st + F0_KI + q * 1024 + lane * 16); } \
                SCHED_FENCE(); \
 \
                f32x4 pt00 = (f32x4){0.f, 0.f, 0.f, 0.f}, pt01 = pt00, pt11 = pt00; \
                _Pragma("unroll") \
                for (int s2 = 0; s2 < 4; ++s2) { pt00 = MFMA16(kf[s2], qf[s2], pt00); pt01 = MFMA16(kf[s2], qf[4 + s2], pt01); pt11 = MFMA16(kf[4 + s2], qf[4 + s2], pt11); } \
                const bool m0 = (4 * g + 0 <= r), m1 = (4 * g + 1 <= r), m2 = (4 * g + 2 <= r), m3 = (4 * g + 3 <= r); \
 \
                                const bf16x8 pb0 = mk8(cvtpk(m0 ? pt00.x : 0.f, m1 ? pt00.y : 0.f), cvtpk(m2 ? pt00.z : 0.f, m3 ? pt00.w : 0.f), 0u, 0u); \
                const bf16x8 pb1 = mk8(pk2(pt01.x, pt01.y), pk2(pt01.z, pt01.w), cvtpk(m0 ? pt11.x : 0.f, m1 ? pt11.y : 0.f), cvtpk(m2 ? pt11.z : 0.f, m3 ? pt11.w : 0.f)); \
                f32x4 o0 = (f32x4){0.f, 0.f, 0.f, 0.f}, o1 = o0; \
                o0 = MFMA16(vf, pb0, o0); o1 = MFMA16(vf, pb1, o1); \
                _Pragma("unroll") \
                for (int s2 = 0; s2 < 4; ++s2) { \
                    const bf16x8 sb = mk8(cvtpk(acc[2 * s2].x, acc[2 * s2].y), cvtpk(acc[2 * s2].z, acc[2 * s2].w), cvtpk(acc[2 * s2 + 1].x, acc[2 * s2 + 1].y), cvtpk(acc[2 * s2 + 1].z, acc[2 * s2 + 1].w)); \
                    o0 = MFMA16(sb, qf[s2], o0); o1 = MFMA16(sb, qf[4 + s2], o1); \
                } \
                LAS float* ow = obuf + (c & 1) * OB + r * 132 + 16 * w + 4 * g; \
                *(LAS f32x4*)ow = o0; *(LAS f32x4*)(ow + 16 * 132) = o1; \
                f32x4 gf[8]; v2u klo[8], khi[8]; \
                _Pragma("unroll") \
                for (int m = 0; m < 8; ++m) { gf[m] = *(const LAS f32x4*)(st + F0_GL + (16 * m + 4 * g) * 4); \
                    klo[m] = *(const LAS v2u*)(st + F0_T + (16 * m + r) * 64 + 8 * g); khi[m] = *(const LAS v2u*)(st + F0_T + (16 * m + r) * 64 + 32 + 8 * g); } \
                SCHED_FENCE(); \
                _Pragma("unroll") \
                for (int m = 0; m < 8; ++m) acc[m] = MFMA16(mk8(klo[m].x, klo[m].y, khi[m].x, khi[m].y), vf, acc[m] * gf[m]); \
                SCHED_FENCE(); \
            } \
            f0_prep(F, F.lds + ((c + 1) & 1) * F0_STG, q2s[PAR ^ 1], f2s[PAR ^ 1], vrs[PAR ^ 1], lb4, bf4); \
            if (USE_AUX) aux_store(F, at_, awv, ascr); \
        } while (0)
        for (int c2 = 0; c2 <= NCH; c2 += 2) { F0_BODY(c2, 0); F0_BODY(c2 + 1, 1); }
#undef F0_BODY
#undef QCH
        asm volatile("s_waitcnt vmcnt(0) lgkmcnt(0)" ::: "memory");
        __builtin_amdgcn_s_barrier();
    }
}

struct Args { const float* in[17]; float* out; unsigned char* ws; int ph_lo, ph_hi, li, pad; };
__global__ void __launch_bounds__(NWAVES * 64, 2) mk_fwd(Args args) {
    extern __shared__ __attribute__((aligned(16))) unsigned char lds[];
    Frame F;
    F.lds = (LAS unsigned char*)lds;
    F.MISC = (volatile LAS unsigned*)(F.lds + MISC_OFF);
    F.tid = threadIdx.x; F.lane = F.tid & 63; F.wave = __builtin_amdgcn_readfirstlane(F.tid >> 6);
    F.G = gridDim.x; { const int bx = blockIdx.x; F.vcu = (F.G % 8 == 0) ? (bx % 8) * (F.G / 8) + bx / 8 : bx; }
    unsigned char* ws = args.ws;
    F.ctl = (gu32*)(ws + WS_CTL);
    F.x = args.in[0]; F.meta = args.in[1]; F.lb_logits = args.in[2];
    F.w0in = args.in[3]; F.b_f = args.in[4]; F.ng0 = args.in[5]; F.w0out = args.in[6]; F.ln0g = args.in[7]; F.ln0b = args.in[8];
    F.w1in = args.in[9]; F.wg1 = args.in[10]; F.wg2 = args.in[11]; F.b_g = args.in[12]; F.ng1 = args.in[13]; F.w1out = args.in[14]; F.ln1g = args.in[15]; F.ln1b = args.in[16];
    F.out = args.out;
    F.LB0 = (float*)(ws + WS_LB0); F.G1 = (float*)(ws + WS_G1); F.PRE = (float*)(ws + WS_PRE); F.O1 = (float*)(ws + WS_O1); F.WG1T = (bf16*)(ws + WS_WG1T); F.W2F = (bf16*)(ws + WS_W2F); F.SS = (float*)(ws + WS_REC + 525 * MiB); F.Q0 = (bf16*)(ws + WS_Q0); F.Y0 = (bf16*)(ws + WS_Y0); F.REC0 = ws + WS_REC; F.REC1 = ws + WS_REC1; F.VF1 = ws + WS_VF1;
    F.WT0IN = (bf16*)(ws + WS_WT0IN); F.WT0OUT = (bf16*)(ws + WS_WT0OUT); F.WT1IN = (bf16*)(ws + WS_WT1IN); F.WT1OUT = (bf16*)(ws + WS_WT1OUT);
    F.XB = (bf16*)(ws + WS_XB); F.H1B = (bf16*)(ws + WS_H1B); F.QFIZ = (bf16*)(ws + WS_QFIZ); F.Y = (bf16*)(ws + WS_Y);
    for (int u = F.tid; u < (LDS_BYTES - LDSCTL_OFF) / 4; u += NWAVES * 64) ((LAS unsigned*)(F.lds + LDSCTL_OFF))[u] = 0u;
    __syncthreads();
    int vb = (int)blockIdx.x;
    if (USE_TICKETS && N_LAUNCHES == 1 && (F.G % 8) == 0) {
        if (F.tid == 0) {
            const unsigned per = (unsigned)F.G / 8u; unsigned x = xb_xcc_id() & 7u, got = 0xffffffffu;
            for (unsigned tr = 0; tr < 8u; ++tr) { const unsigned y = (x + tr) & 7u; const unsigned t = xb_add((unsigned*)(F.ctl + CW_POOL) + 64 * y, 1u); if (t < per) { got = y + 8u * t; break; } }
            F.MISC[12] = (got == 0xffffffffu) ? blockIdx.x : got;
        }
        __syncthreads();
        vb = (int)F.MISC[12];
    }
    { F.vcu = (F.G % 8 == 0) ? (vb % 8) * (F.G / 8) + vb / 8 : vb; }
    XcdBarrier bar; bar.bar = (unsigned*)(F.ctl + CW_BAR); bar.x = 0; bar.st = nullptr;
    if (N_LAUNCHES == 1) bar = xcd_barrier_post((unsigned*)(F.ctl + CW_BAR), F.MISC + 8);
#define GRID_BAR() do { if (N_LAUNCHES == 1) xcd_barrier(bar); } while (0)
    const int lo = args.ph_lo, hi = args.ph_hi;
    unsigned long long pclk0 = 0, pclkn = 0; (void)pclk0;
    unsigned long long st_prev = STAMP_MASK ? __builtin_amdgcn_s_memrealtime() : 0ull, st_acc = 0ull;
#define STAMP(k) do { if (STAMP_MASK) { const unsigned long long t_ = __builtin_amdgcn_s_memrealtime(); if ((STAMP_MASK >> (k)) & 1) st_acc += t_ - st_prev; st_prev = t_; } } while (0)
#ifdef ONLY_PHASE
#define IN(k) ((k) == ONLY_PHASE && lo <= (k) && (k) < hi)
#else
#define IN(k) (lo <= (k) && (k) < hi)
#endif
#define BOTH(k) (IN(k) && IN((k) + 1))

    if (IN(0)) { for (int rep = 0; rep < REP(0); ++rep) { p0_prologue(F); if (rep + 1 < REP(0)) GRID_BAR(); } if (BOTH(0)) GRID_BAR(); }
    STAMP(0);
    if (IN(1)) {
        if (!(P0_META_FOLD && F.G == 256)) skinny<1, 0>(F, F.XB + (size_t)MX * D, F.WT0IN, D, 0, N0 / 16, (USE_L0_MFMA == 2) ? F.Q0 + (size_t)16 * N0 : F.QFIZ + (size_t)MX * N0, N0, nullptr, nullptr);
        pg8::Gemm g{F.XB, F.WT0IN, MX, N0, D}; pg8::StaticOrder S; S.init(MX, N0, F.G, vb);
        pg8::EpiBf16<0> E{F.QFIZ, N0, nullptr, 0, 0, 1.f};
        if (PROBE_CLK == 1) pclk0 = __builtin_amdgcn_s_memtime();
        for (int rep = 0; rep < REP(1); ++rep) { pg8::gemm_phase<pg8::EpiBf16<0>, pg8::StaticOrder, PG8_ALIGN, PG8_SP2>(F.lds + RING_OFF, g, S, E); if (rep + 1 < REP(1)) GRID_BAR(); }
        if (PROBE_CLK == 1) pclkn = __builtin_amdgcn_s_memtime() - pclk0;
        if (BOTH(1)) GRID_BAR();
    }
    STAMP(1);
#if USE_L0_MFMA == 2
    STAMP(2);
    if (IN(3)) { for (int rep = 0; rep < REP(3); ++rep) { l0_fused(F, F.REC0); if (rep + 1 < REP(3)) GRID_BAR(); } if (BOTH(3)) GRID_BAR(); }
#elif USE_L0_MFMA
    if (IN(2)) { for (int rep = 0; rep < REP(2); ++rep) { l0_prep(F, F.REC0); if (rep + 1 < REP(2)) GRID_BAR(); } if (BOTH(2)) GRID_BAR(); }
    STAMP(2);
    if (IN(3)) { for (int rep = 0; rep < REP(3); ++rep) { l0_seq(F, F.REC0); if (rep + 1 < REP(3)) GRID_BAR(); } if (BOTH(3)) GRID_BAR(); }
#else
    if (IN(2)) { if (BOTH(2)) GRID_BAR(); }
    if (IN(3)) { for (int rep = 0; rep < REP(3); ++rep) { p2_l0_rec_naive(F); if (rep + 1 < REP(3)) GRID_BAR(); } if (BOTH(3)) GRID_BAR(); }
#endif
    STAMP(3);
    if (IN(4)) {
        skinny<4, 1>(F, (USE_L0_MFMA == 2) ? F.Y0 + (size_t)16 * DI : F.Y + (size_t)MX * DI, F.WT0OUT, DI, 0, D / 16, nullptr, 0, F.PRE + (size_t)MX * D, F.meta);
        pg8::Gemm g{F.Y, F.WT0OUT, MX, D, DI}; pg8::StaticOrder S; S.init(MX, D, F.G, vb);
        pg8::EpiResid E{F.PRE, D, F.x, F.meta, MX, MX, ALPHA};
        for (int rep = 0; rep < REP(4); ++rep) { pg8::gemm_phase<pg8::EpiResid, pg8::StaticOrder, PG8_ALIGN, PG8_SP2>(F.lds + RING_OFF, g, S, E); if (rep + 1 < REP(4)) GRID_BAR(); }
        if (BOTH(4)) GRID_BAR();
    }
    STAMP(4);
    if (IN(5)) { for (int rep = 0; rep < REP(5); ++rep) { ln_phase2(F, F.PRE, MR, F.ln0g, F.ln0b, RES_BF16 ? nullptr : F.PRE, F.H1B); if (rep + 1 < REP(5)) GRID_BAR(); } if (BOTH(5)) GRID_BAR(); }
    STAMP(5);
    if (IN(6)) {
        gate_proj(F, F.WG1T);
        skinny<2, 0>(F, F.H1B + (size_t)MX * D, F.WT1IN, D, 4096, (N1 - 4096 - DI) / 16, F.QFIZ + (size_t)MX * N1, N1, nullptr, nullptr);
        pg8::Gemm g{F.H1B, F.WT1IN, MX, N1, D}; pg8::StaticOrder S; S.init(MX, N1, F.G, vb);
        pg8::EpiBf16<0> E{F.QFIZ, N1, nullptr, 0, 0, 1.f};
        for (int rep = 0; rep < REP(6); ++rep) { pg8::gemm_phase<pg8::EpiBf16<0>, pg8::StaticOrder, PG8_ALIGN, PG8_SP2>(F.lds + RING_OFF, g, S, E); if (rep + 1 < REP(6)) GRID_BAR(); }
        if (BOTH(6)) GRID_BAR();
    }
    STAMP(6);
#if USE_L1_MFMA
    if (IN(7)) { for (int rep = 0; rep < REP(7); ++rep) { l1_prep(F, F.REC1, F.VF1, F.W2F); if (rep + 1 < REP(7)) GRID_BAR(); } if (BOTH(7)) GRID_BAR(); }
    STAMP(7);
#if USE_L1_SEQ2
    if (IN(8)) { l1_seq2(F, F.REC1, F.VF1, F.SS); if (BOTH(8)) GRID_BAR(); }
#else
    if (IN(8)) { l1_seq<0>(F, F.REC1, F.VF1, F.O1, F.SS); if (REP(8) > 1) { GRID_BAR(); l1_seq<PROBE_VAR>(F, F.REC1, F.VF1, F.O1, F.SS); } if (BOTH(8)) GRID_BAR(); }
#endif
#else
    if (IN(7)) { if (BOTH(7)) GRID_BAR(); }
    if (IN(8)) { for (int rep = 0; rep < REP(8); ++rep) { p6_l1_rec_naive(F); if (rep + 1 < REP(8)) GRID_BAR(); } if (BOTH(8)) GRID_BAR(); }
#endif
    STAMP(8);
#if !(USE_FUSED_NORM && USE_L1_MFMA)
    if (IN(9)) { for (int rep = 0; rep < REP(9); ++rep) { p7_normgate(F); if (rep + 1 < REP(9)) GRID_BAR(); } if (BOTH(9)) GRID_BAR(); }
#endif
    STAMP(9);
    if (IN(10)) {
        pg8::Gemm g{F.Y, F.WT1OUT, MX, D, DI}; pg8::StaticOrder S; S.init(MX, D, F.G, vb);
#if USE_FUSED_NORM && USE_L1_MFMA
        pg8::EpiResidScale E{F.PRE, D, F.H1B, ALPHA, F.SS, RMS_EPS};
        for (int rep = 0; rep < REP(10); ++rep) { pg8::gemm_phase<pg8::EpiResidScale, pg8::StaticOrder, PG8_ALIGN, PG8_SP2>(F.lds + RING_OFF, g, S, E); if (rep + 1 < REP(10)) GRID_BAR(); }
#else
        pg8::EpiResid E{F.PRE, D, F.PRE, F.PRE, MX, MX, ALPHA};
        if (PROBE_CLK == 10) pclk0 = __builtin_amdgcn_s_memtime();
        for (int rep = 0; rep < REP(10); ++rep) { pg8::gemm_phase<pg8::EpiResid, pg8::StaticOrder, PG8_ALIGN, PG8_SP2>(F.lds + RING_OFF, g, S, E); if (rep + 1 < REP(10)) GRID_BAR(); }
        if (PROBE_CLK == 10) pclkn = __builtin_amdgcn_s_memtime() - pclk0;
#endif
        if (BOTH(10)) GRID_BAR();
    }
    STAMP(10);
    if (IN(11)) { for (int rep = 0; rep < REP(11); ++rep) { ln_phase2(F, F.PRE, MX, F.ln1g, F.ln1b, F.out, nullptr); if (rep + 1 < REP(11)) GRID_BAR(); } }
    STAMP(11);
    if (STAMP_MASK && blockIdx.x == 0 && F.tid == 0) { const unsigned long long t0 = __builtin_amdgcn_s_memrealtime(); while (__builtin_amdgcn_s_memrealtime() - t0 < st_acc) __builtin_amdgcn_s_sleep(8); }
    if (PROBE_CLK && blockIdx.x == 0 && F.tid == 0) { const unsigned long long t0 = __builtin_amdgcn_s_memrealtime(); while (__builtin_amdgcn_s_memrealtime() - t0 < pclkn / (PROBE_CLK == 10 ? 10ull : 100ull)) __builtin_amdgcn_s_sleep(8); }
#undef IN
#undef BOTH
}

extern "C" void kernel_launch(void* const* d_in, const int* in_sizes, int n_in, void* d_out, int out_size, void* d_ws, size_t ws_size, hipStream_t stream) {
    static int grid = 0;
    if (grid == 0) {
        if (n_in != 17 || in_sizes[0] != MX * D || out_size != MX * D || ws_size < WS_END) { fprintf(stderr, "kernel_launch: unexpected problem (n_in %d, in0 %d, out %d, ws %zu < %zu); nothing launched\n", n_in, n_in > 0 ? in_sizes[0] : -1, out_size, ws_size, (size_t)WS_END); grid = -1; return; }
        int dev = 0, cus = 0, per_cu = 0;
        if (hipGetDevice(&dev) != hipSuccess || hipDeviceGetAttribute(&cus, hipDeviceAttributeMultiprocessorCount, dev) != hipSuccess) { fprintf(stderr, "kernel_launch: device query failed\n"); grid = -1; return; }
        if (hipFuncSetAttribute((const void*)mk_fwd, hipFuncAttributeMaxDynamicSharedMemorySize, LDS_BYTES) != hipSuccess) { fprintf(stderr, "kernel_launch: hipFuncSetAttribute failed\n"); grid = -1; return; }
        if (hipOccupancyMaxActiveBlocksPerMultiprocessor(&per_cu, (const void*)mk_fwd, NWAVES * 64, LDS_BYTES) != hipSuccess || per_cu < 1)
            fprintf(stderr, "kernel_launch: note: occupancy query reports %d workgroups per CU\n", per_cu);
        (void)hipGetLastError();
        grid = cus;
    }
    if (grid < 0) return;
    if (hipMemsetAsync((char*)d_ws + WS_CTL, 0, CTL_ZERO_BYTES, stream) != hipSuccess) { fprintf(stderr, "kernel_launch: memset failed\n"); return; }
    Args a{};
    for (int i = 0; i < 17; ++i) a.in[i] = (const float*)d_in[i];
    a.out = (float*)d_out; a.ws = (unsigned char*)d_ws;
    for (int li = 0; li < N_LAUNCHES; ++li) {
        a.ph_lo = (N_LAUNCHES == 1) ? 0 : li; a.ph_hi = (N_LAUNCHES == 1) ? PER_PHASE : li + 1; a.li = li; a.pad = 0;
        hipLaunchKernelGGL(mk_fwd, dim3(grid), dim3(NWAVES * 64), LDS_BYTES, stream, a);
        const hipError_t le = hipPeekAtLastError();
        if (le != hipSuccess) { fprintf(stderr, "kernel_launch: launch %d failed: %s\n", li, hipGetErrorName(le)); break; }
    }
}
```

```cpp
#include <hip/hip_runtime.h>
#include <cstdio>
#include <cstdint>
#define MK_N_LAUNCHES 1
#define USE_L0_MFMA 2
#define USE_L1_MFMA 1
namespace pg8 {
#define PG8_LAS __attribute__((address_space(3)))
typedef unsigned short bf16_t;
typedef short bf16x8 __attribute__((ext_vector_type(8)));
typedef float f32x4 __attribute__((ext_vector_type(4)));
typedef unsigned u32x4 __attribute__((ext_vector_type(4)));
constexpr int BM = 256, BK = 64, HALF = 128, HTB = HALF * BK * 2  , STAGE_BYTES = 8 * HTB, NXCD = 8, WGM = 8;

__host__ __device__ __forceinline__ int lds_byte(int r, int c) { const int st = (r >> 4) * 2 + (c >> 5), rr = r & 15, cc = c & 31, ob = rr * 64 + cc * 2; return st * 1024 + (ob ^ (((ob >> 9) & 1) << 5)); }
__host__ __device__ __forceinline__ void stage_rc(int b, int& R, int& C) { const int st = b / 1024, sb = b % 1024, swz = sb ^ (((sb >> 9) & 1) << 5); R = (st >> 1) * 16 + swz / 64; C = (st & 1) * 32 + (swz % 64) / 2; }
__host__ __device__ __forceinline__ int perm32(int rho) { const int n = rho >> 4, i = rho & 15; return 8 * (i >> 2) + 4 * n + (i & 3); }

struct Unit { int pm, pn; };
struct Gemm { const bf16_t* A; const bf16_t* Bt; int M, N, K; };

struct StaticOrder {
    int nM, nN, nwg, G, c;
    __host__ __device__ void init(int M, int N, int G_, int c_) { nM = M / BM; nN = N / BM; nwg = nM * nN; G = G_; c = c_; }
    __host__ __device__ bool next(int i, Unit& u) const {
        const long L = (long)i * G + c; if (L >= nwg) return false;
        int wgid = (int)L; { const int q = nwg / NXCD, r = nwg % NXCD, xcd = wgid % NXCD, off = wgid / NXCD; wgid = (xcd < r ? xcd * (q + 1) : r * (q + 1) + (xcd - r) * q) + off; }
        const int nig = WGM * nN, gid = wgid / nig, fm = gid * WGM, gsz = (nM - fm) < WGM ? (nM - fm) : WGM;
        u.pm = fm + ((wgid % nig) % gsz); u.pn = (wgid % nig) / gsz; return true;
    }
    __device__ __forceinline__ void a_ready(const Unit&) const {}
    __device__ __forceinline__ void done(const Unit&) const {}
};

__device__ __forceinline__ unsigned cvt_pk_bf16(float lo, float hi) { unsigned r; asm volatile("v_cvt_pk_bf16_f32 %0, %1, %2" : "=v"(r) : "v"(lo), "v"(hi)); return r; }
typedef float f32x2 __attribute__((ext_vector_type(2)));
__device__ __forceinline__ f32x2 gelu_pk(f32x2 v) {
    const f32x2 av = __builtin_elementwise_abs(v), d = av * 0.2316418882f + 1.0f;
    f32x2 t; t.x = __builtin_amdgcn_rcpf(d.x); t.y = __builtin_amdgcn_rcpf(d.y);
    f32x2 q = t * 0.5307027145f + (-0.7265760135f); q = q * t + 0.7107068705f; q = q * t + (-0.142248368f); q = q * t + 0.127414796f; q = q * t;
    const f32x2 s = (v * v) * (-0.72134752044f);
    f32x2 e; e.x = __builtin_amdgcn_exp2f(s.x); e.y = __builtin_amdgcn_exp2f(s.y);
    const f32x2 m = v * (q * e), r = v - m;
    f32x2 o; o.x = v.x < 0.f ? m.x : r.x; o.y = v.y < 0.f ? m.y : r.y; return o;
}

template <int ACT  > struct EpiBf16 {
    static constexpr bool PERM = true, AFTER_DRAIN = false, KHOOK = false; static_assert(ACT == 0 || ACT == 1, "EpiBf16: ACT is 0 (none) or 1 (gelu_pk)");
    bf16_t* O; int ldc; const float* bias; int split_cols; size_t split_stride; float scale0;
    __device__ __forceinline__ void operator()(const f32x4 (&acc)[2][2][4][2], const Unit& u, int wr, int wc, int fr, int fq) const {
        const int row0 = u.pm * BM + wr * 64 + fr; int colt = u.pn * BM; bf16_t* base = O;
        float sc = 1.f; if (split_cols) { const int t = colt / split_cols; base += (size_t)t * split_stride; colt -= t * split_cols; if (t == 0) sc = scale0; }
        const int col0 = colt + wc * 32 + 8 * fq, bcol0 = u.pn * BM + wc * 32 + 8 * fq;
        f32x4 bv[2][2];
#pragma unroll
        for (int bj = 0; bj < 2; ++bj)
#pragma unroll
            for (int n = 0; n < 2; ++n) bv[bj][n] = bias ? *(const f32x4*)(bias + bcol0 + bj * HALF + 4 * n) : (f32x4){0.f, 0.f, 0.f, 0.f};
#pragma unroll
        for (int ai = 0; ai < 2; ++ai)
#pragma unroll
            for (int m = 0; m < 4; ++m) { bf16_t* rowp = base + (size_t)(row0 + ai * HALF + m * 16) * ldc + col0;
#pragma unroll
                for (int bj = 0; bj < 2; ++bj) { f32x4 v0 = acc[ai][bj][m][0] + bv[bj][0], v1 = acc[ai][bj][m][1] + bv[bj][1];
                    if (ACT == 1) { f32x2 a = gelu_pk((f32x2){v0[0], v0[1]}), b = gelu_pk((f32x2){v0[2], v0[3]}), c = gelu_pk((f32x2){v1[0], v1[1]}), d = gelu_pk((f32x2){v1[2], v1[3]});
                        v0 = (f32x4){a.x, a.y, b.x, b.y}; v1 = (f32x4){c.x, c.y, d.x, d.y}; }
                    v0 = v0 * sc; v1 = v1 * sc; u32x4 w; w.x = cvt_pk_bf16(v0[0], v0[1]); w.y = cvt_pk_bf16(v0[2], v0[3]); w.z = cvt_pk_bf16(v1[0], v1[1]); w.w = cvt_pk_bf16(v1[2], v1[3]);
                    *(u32x4*)(rowp + bj * HALF) = w; } }
    }
};
struct EpiResid {
    static constexpr bool PERM = false, AFTER_DRAIN = false, KHOOK = false;
    float* C; int ldc; const float* resA; const float* resB; int rowsA; int rowsValid; float alpha;
    __device__ __forceinline__ void operator()(const f32x4 (&acc)[2][2][4][2], const Unit& u, int wr, int wc, int fr, int fq) const {
        const int row0 = u.pm * BM + wr * 64 + fr, col0 = u.pn * BM + wc * 32 + 4 * fq;
#pragma unroll
        for (int ai = 0; ai < 2; ++ai)
#pragma unroll
            for (int m = 0; m < 4; ++m) { const int r = row0 + ai * HALF + m * 16;
                if (r < rowsValid) {
                    const float* rp = (r < rowsA) ? resA + (size_t)r * ldc + col0 : resB + (size_t)(r - rowsA) * ldc + col0;
                    float* cp = C + (size_t)r * ldc + col0;
#pragma unroll
                    for (int bj = 0; bj < 2; ++bj)
#pragma unroll
                        for (int n = 0; n < 2; ++n) { const f32x4 rv = *(const f32x4*)(rp + bj * HALF + n * 16); *(f32x4*)(cp + bj * HALF + n * 16) = rv * alpha + acc[ai][bj][m][n]; } }
                asm volatile("" ::: "memory"); }
    }
};

struct EpiResidScale {
    static constexpr bool PERM = false, AFTER_DRAIN = false, KHOOK = true;
    float* C; int ldc; const unsigned short* res; float alpha; const float* SS; float eps;
    __device__ __forceinline__ void unit_begin(const Unit& u, int par, PG8_LAS unsigned char* lds) const {
        const int tid = threadIdx.x, row = tid >> 1, hh = 4 * (tid & 1);
        float sv[4];
        { const f32x4* sp = (const f32x4*)(SS + ((size_t)(u.pm * BM + row) * 8 + hh) * 8);
#pragma unroll
          for (int q = 0; q < 4; ++q) { const f32x4 a = sp[2 * q], b = sp[2 * q + 1]; sv[q] = (a.x + a.y) + (a.z + a.w) + (b.x + b.y) + (b.z + b.w); asm volatile("" ::: "memory"); } }
        const f32x4 s = (f32x4){sv[0], sv[1], sv[2], sv[3]};
        f32x4 rs; rs.x = __builtin_amdgcn_rsqf(s.x * (1.f / 1024.f) + eps); rs.y = __builtin_amdgcn_rsqf(s.y * (1.f / 1024.f) + eps); rs.z = __builtin_amdgcn_rsqf(s.z * (1.f / 1024.f) + eps); rs.w = __builtin_amdgcn_rsqf(s.w * (1.f / 1024.f) + eps);
        *(PG8_LAS f32x4*)(lds + 131072 + par * 8192 + (row * 8 + hh) * 4) = rs;
    }
    __device__ __forceinline__ void khook(f32x4 (&acc)[2][2][4][2], int par, int hb, int wr, int fr, PG8_LAS unsigned char* lds) const {
        const PG8_LAS float* T = (const PG8_LAS float*)(lds + 131072 + par * 8192);
        typedef float f32x2h __attribute__((ext_vector_type(2)));
        f32x2h tv[8]; unsigned ad[8];
#pragma unroll
        for (int i = 0; i < 8; ++i) ad[i] = (unsigned)(size_t)(T + ((i >> 2) * HALF + wr * 64 + (i & 3) * 16 + fr) * 8 + hb - 1);
        asm volatile("ds_read2_b32 %0, %8 offset1:1\n\tds_read2_b32 %1, %9 offset1:1\n\tds_read2_b32 %2, %10 offset1:1\n\tds_read2_b32 %3, %11 offset1:1\n\t"
                     "ds_read2_b32 %4, %12 offset1:1\n\tds_read2_b32 %5, %13 offset1:1\n\tds_read2_b32 %6, %14 offset1:1\n\tds_read2_b32 %7, %15 offset1:1\n\ts_waitcnt lgkmcnt(0)\n\ts_nop 15\n\ts_nop 15"
                     : "=&v"(tv[0]), "=&v"(tv[1]), "=&v"(tv[2]), "=&v"(tv[3]), "=&v"(tv[4]), "=&v"(tv[5]), "=&v"(tv[6]), "=&v"(tv[7])
                     : "v"(ad[0]), "v"(ad[1]), "v"(ad[2]), "v"(ad[3]), "v"(ad[4]), "v"(ad[5]), "v"(ad[6]), "v"(ad[7]) : "memory");
#pragma unroll
        for (int ai = 0; ai < 2; ++ai)
#pragma unroll
            for (int m = 0; m < 4; ++m) { const float ratio = tv[ai * 4 + m].x * __builtin_amdgcn_rcpf(tv[ai * 4 + m].y);
#pragma unroll
                for (int bj = 0; bj < 2; ++bj)
#pragma unroll
                    for (int n = 0; n < 2; ++n) { f32x4& a = acc[ai][bj][m][n];
                        asm volatile("v_mul_f32 %0, %0, %4\n\tv_mul_f32 %1, %1, %4\n\tv_mul_f32 %2, %2, %4\n\tv_mul_f32 %3, %3, %4\n\ts_nop 1" : "+v"(a.x), "+v"(a.y), "+v"(a.z), "+v"(a.w) : "v"(ratio)); } }
    }
    __device__ __forceinline__ void epi(const f32x4 (&acc)[2][2][4][2], const Unit& u, int wr, int wc, int fr, int fq, int par, PG8_LAS unsigned char* lds) const {
        const PG8_LAS float* T = (const PG8_LAS float*)(lds + 131072 + par * 8192);
        const int row0 = u.pm * BM + wr * 64 + fr, col0 = u.pn * BM + wc * 32 + 4 * fq;
#pragma unroll
        for (int ai = 0; ai < 2; ++ai)
#pragma unroll
            for (int m = 0; m < 4; ++m) { const int r = row0 + ai * HALF + m * 16; const float sc = T[(ai * HALF + wr * 64 + m * 16 + fr) * 8 + 7];
                const unsigned short* rp = res + (size_t)r * ldc + col0; float* cp = C + (size_t)r * ldc + col0;
#pragma unroll
                for (int bj = 0; bj < 2; ++bj)
#pragma unroll
                    for (int n = 0; n < 2; ++n) { const uint2 rb = *(const uint2*)(rp + bj * HALF + n * 16);
                        const f32x4 rv = (f32x4){__builtin_bit_cast(float, rb.x << 16), __builtin_bit_cast(float, rb.x & 0xffff0000u), __builtin_bit_cast(float, rb.y << 16), __builtin_bit_cast(float, rb.y & 0xffff0000u)};
                        *(f32x4*)(cp + bj * HALF + n * 16) = rv * alpha + acc[ai][bj][m][n] * sc; }
                asm volatile("" ::: "memory"); }
    }
};


template <class Epi, class Sched, bool ALIGN_EPI = false, bool SP2 = false>
__device__ __forceinline__ void gemm_phase(PG8_LAS unsigned char* lds, const Gemm g, const Sched& S, const Epi& E) {
    const int tid = threadIdx.x, wid = __builtin_amdgcn_readfirstlane(tid >> 6), lane = tid & 63, wr = wid >> 2, wc = wid & 3, fr = lane & 15, fq = lane >> 4;
    const int K = g.K, nt = K / BK;
    unsigned voffA[2], voffB[2];
#pragma unroll
    for (int i = 0; i < 2; ++i) { int R, C; stage_rc(tid * 16 + i * 8192, R, C); const int Rb = Epi::PERM ? ((R & ~31) + perm32(R & 31)) : R;
        voffA[i] = (unsigned)(R * K + C) * 2u; voffB[i] = (unsigned)(Rb * K + C) * 2u; }
    const size_t kstep = (size_t)(BK * 2);
    const size_t hstep = (size_t)HALF * K * 2;
    const size_t tstep = 2 * hstep;
    const unsigned ldsw = (unsigned)wid * 1024u;
    const int aoff = lds_byte(wr * 64 + fr, fq * 8), boff = lds_byte(wc * 32 + fr, fq * 8);
#define PG8_SA(b, h) (((b) * 2 + (h)) * HTB)
#define PG8_SB(b, h) ((4 + (b) * 2 + (h)) * HTB)
#define PG8_STAGE(bufoff, gbase, voff) do { _Pragma("unroll") for (int _i = 0; _i < 2; ++_i) \
        __builtin_amdgcn_global_load_lds((const unsigned*)((const char*)(gbase) + (voff)[_i]), (PG8_LAS unsigned*)(lds + (bufoff) + ldsw + _i * 8192), 16, 0, 0); } while (0)
#define PG8_LDA(dst, b, h) do { _Pragma("unroll") for (int m = 0; m < 4; ++m) _Pragma("unroll") for (int k = 0; k < 2; ++k) dst[m][k] = *(const PG8_LAS bf16x8*)(lds + PG8_SA(b, h) + aoff + m * 2048 + k * 1024); } while (0)
#define PG8_LDB(dst, b, h) do { _Pragma("unroll") for (int n = 0; n < 2; ++n) _Pragma("unroll") for (int k = 0; k < 2; ++k) dst[n][k] = *(const PG8_LAS bf16x8*)(lds + PG8_SB(b, h) + boff + n * 2048 + k * 1024); } while (0)
#define PG8_MMA(ai, bj, At, Bt) do { __builtin_amdgcn_s_setprio(1); _Pragma("unroll") for (int m = 0; m < 4; ++m) _Pragma("unroll") for (int n = 0; n < 2; ++n) _Pragma("unroll") for (int k = 0; k < 2; ++k) \
        acc[ai][bj][m][n] = __builtin_amdgcn_mfma_f32_16x16x32_bf16(Bt[n][k], At[m][k], acc[ai][bj][m][n], 0, 0, 0); __builtin_amdgcn_s_setprio(0); } while (0)
#define PG8_WAIT_V(n) asm volatile("s_waitcnt vmcnt(" #n ")" ::: "memory")
#define PG8_WAIT_L(n) asm volatile("s_waitcnt lgkmcnt(" #n ")" ::: "memory")
#define PG8_BAR __builtin_amdgcn_s_barrier()
#define PG8_SCHED __builtin_amdgcn_sched_barrier(0)
    Unit cur, nxt; int ui = 0;
    if (!S.next(0, cur)) return;
    f32x4 acc[2][2][4][2];
#pragma unroll
    for (int a = 0; a < 2; ++a)
#pragma unroll
        for (int b = 0; b < 2; ++b)
#pragma unroll
            for (int m = 0; m < 4; ++m)
#pragma unroll
                for (int n = 0; n < 2; ++n) acc[a][b][m][n] = (f32x4){0.f, 0.f, 0.f, 0.f};
    bf16x8 At[4][2], B0[2][2], B1[2][2];
    const char* cA = (const char*)g.A + (size_t)cur.pm * tstep; const char* cB = (const char*)g.Bt + (size_t)cur.pn * tstep;
    if constexpr (Epi::KHOOK) E.unit_begin(cur, ui & 1, lds);
    S.a_ready(cur);
    if constexpr (SP2) {
        PG8_STAGE(PG8_SB(0, 0), cB, voffB); PG8_STAGE(PG8_SB(0, 1), cB + hstep, voffB); PG8_STAGE(PG8_SA(0, 0), cA, voffA); PG8_STAGE(PG8_SA(0, 1), cA + hstep, voffA);
        if (wr == 1) PG8_BAR;
        PG8_WAIT_V(2); PG8_BAR;
        PG8_STAGE(PG8_SB(1, 0), cB + kstep, voffB); PG8_STAGE(PG8_SA(1, 0), cA + kstep, voffA); PG8_STAGE(PG8_SB(1, 1), cB + hstep + kstep, voffB);
        PG8_WAIT_V(6); PG8_BAR;
    } else {
        PG8_STAGE(PG8_SB(0, 0), cB, voffB); PG8_STAGE(PG8_SA(0, 0), cA, voffA); PG8_STAGE(PG8_SB(0, 1), cB + hstep, voffB); PG8_STAGE(PG8_SA(0, 1), cA + hstep, voffA);
        if (wr == 1) PG8_BAR;
        PG8_WAIT_V(4); PG8_BAR;
        PG8_STAGE(PG8_SB(1, 0), cB + kstep, voffB); PG8_STAGE(PG8_SA(1, 0), cA + kstep, voffA); PG8_STAGE(PG8_SB(1, 1), cB + hstep + kstep, voffB);
        PG8_WAIT_V(6); PG8_BAR;
    }
    for (;;) {
        const bool has_next = S.next(ui + 1, nxt);
        const char* nA = has_next ? (const char*)g.A + (size_t)nxt.pm * tstep : cA; const char* nB = has_next ? (const char*)g.Bt + (size_t)nxt.pn * tstep : cB;
        const int tseg = Epi::KHOOK ? 16 : nt;
        for (int tb = 0; tb < nt; tb += tseg) {
        if constexpr (Epi::KHOOK) { if (tb != 0) { PG8_SCHED; E.khook(acc, ui & 1, tb >> 4, wr, fr, lds); PG8_SCHED; } }
        for (int t = tb; t < tb + tseg; t += 2) {
            const bool last = (t == nt - 2);
            const char* a1 = cA + (size_t)(t + 1) * kstep;
            const char* a2 = last ? nA : cA + (size_t)(t + 2) * kstep; const char* b2 = last ? nB : cB + (size_t)(t + 2) * kstep;
            const char* a3 = a2 + kstep; const char* b3 = b2 + kstep;
            if (last && has_next) S.a_ready(nxt);
            if constexpr (SP2) {
            PG8_LDB(B0, 0, 0); PG8_LDB(B1, 0, 1); PG8_SCHED; PG8_LDA(At, 0, 0); PG8_STAGE(PG8_SA(1, 1), a1 + hstep, voffA);
            PG8_WAIT_V(8); PG8_WAIT_L(0); PG8_BAR; PG8_MMA(0, 0, At, B0); PG8_MMA(0, 1, At, B1); PG8_BAR; PG8_SCHED;
            PG8_LDA(At, 0, 1); PG8_STAGE(PG8_SB(0, 0), b2, voffB); PG8_STAGE(PG8_SB(0, 1), b2 + hstep, voffB); PG8_STAGE(PG8_SA(0, 0), a2, voffA);
            PG8_WAIT_V(8); PG8_WAIT_L(0); PG8_BAR; PG8_MMA(1, 0, At, B0); PG8_MMA(1, 1, At, B1); PG8_BAR; PG8_SCHED;
            PG8_LDB(B0, 1, 0); PG8_LDB(B1, 1, 1); PG8_SCHED; PG8_LDA(At, 1, 0); PG8_STAGE(PG8_SA(0, 1), a2 + hstep, voffA);
            PG8_WAIT_V(8); PG8_WAIT_L(0); PG8_BAR; PG8_MMA(0, 0, At, B0); PG8_MMA(0, 1, At, B1); PG8_BAR; PG8_SCHED;
            PG8_LDA(At, 1, 1); PG8_STAGE(PG8_SB(1, 0), b3, voffB); PG8_STAGE(PG8_SB(1, 1), b3 + hstep, voffB); PG8_STAGE(PG8_SA(1, 0), a3, voffA);
            PG8_WAIT_V(8); PG8_WAIT_L(0); PG8_BAR; PG8_MMA(1, 0, At, B0); PG8_MMA(1, 1, At, B1); PG8_BAR; PG8_SCHED;
            } else {
            PG8_LDB(B0, 0, 0); PG8_SCHED; PG8_LDA(At, 0, 0); PG8_STAGE(PG8_SA(1, 1), a1 + hstep, voffA);
            PG8_WAIT_L(8); PG8_BAR; PG8_WAIT_L(0); PG8_MMA(0, 0, At, B0); PG8_BAR; PG8_SCHED;
            PG8_LDB(B1, 0, 1); PG8_STAGE(PG8_SB(0, 0), b2, voffB);
            PG8_BAR; PG8_WAIT_L(0); PG8_MMA(0, 1, At, B1); PG8_BAR;
            PG8_LDA(At, 0, 1); PG8_STAGE(PG8_SA(0, 0), a2, voffA);
            PG8_BAR; PG8_WAIT_L(0); PG8_MMA(1, 0, At, B0); PG8_BAR; PG8_SCHED;
            PG8_STAGE(PG8_SB(0, 1), b2 + hstep, voffB);
            PG8_WAIT_V(6); PG8_BAR; PG8_MMA(1, 1, At, B1); PG8_BAR;
            PG8_LDB(B0, 1, 0); PG8_SCHED; PG8_LDA(At, 1, 0); PG8_STAGE(PG8_SA(0, 1), a2 + hstep, voffA);
            PG8_WAIT_L(8); PG8_BAR; PG8_WAIT_L(0); PG8_MMA(0, 0, At, B0); PG8_BAR; PG8_SCHED;
            PG8_LDB(B1, 1, 1); PG8_STAGE(PG8_SB(1, 0), b3, voffB);
            PG8_BAR; PG8_WAIT_L(0); PG8_MMA(0, 1, At, B1); PG8_BAR;
            PG8_LDA(At, 1, 1); PG8_STAGE(PG8_SA(1, 0), a3, voffA);
            PG8_BAR; PG8_WAIT_L(0); PG8_MMA(1, 0, At, B0); PG8_BAR; PG8_SCHED;
            PG8_STAGE(PG8_SB(1, 1), b3 + hstep, voffB);
            PG8_WAIT_V(6); PG8_BAR; PG8_MMA(1, 1, At, B1); PG8_BAR;
            }
        }
        }
        if constexpr (ALIGN_EPI) { if (wr == 0) PG8_BAR; }
        if constexpr (Epi::KHOOK) { E.epi(acc, cur, wr, wc, fr, fq, ui & 1, lds); S.done(cur); }
        else if constexpr (!Epi::AFTER_DRAIN) { E(acc, cur, wr, wc, fr, fq); S.done(cur); }
        if (!has_next) break;
#pragma unroll
        for (int a = 0; a < 2; ++a)
#pragma unroll
            for (int b = 0; b < 2; ++b)
#pragma unroll
                for (int m = 0; m < 4; ++m)
#pragma unroll
                    for (int n = 0; n < 2; ++n) acc[a][b][m][n] = (f32x4){0.f, 0.f, 0.f, 0.f};
        cur = nxt; cA = nA; cB = nB; ++ui;
        if constexpr (Epi::KHOOK) E.unit_begin(cur, ui & 1, lds);
        if constexpr (ALIGN_EPI) { if (wr == 1) PG8_BAR; }
    }
    PG8_WAIT_V(0);
    if constexpr (!ALIGN_EPI) { if (wr == 0) PG8_BAR; }
    PG8_BAR;
    if constexpr (Epi::AFTER_DRAIN) { E.fused(acc, cur, wr, wc, fr, fq, lds, wid, lane); S.done(cur); }
#undef PG8_SA
#undef PG8_SB
#undef PG8_STAGE
#undef PG8_LDA
#undef PG8_LDB
#undef PG8_MMA
#undef PG8_WAIT_V
#undef PG8_WAIT_L
#undef PG8_BAR
#undef PG8_SCHED
}
}
#ifndef PG8_SP2
#define PG8_SP2 true
#endif
#ifndef PG8_ALIGN
#define PG8_ALIGN true
#endif

constexpr int NWAVES = 8;
constexpr int PER_PHASE = 12;
#ifndef MK_N_LAUNCHES
#define MK_N_LAUNCHES 1
#endif
#ifndef PROBE_MASK
#define PROBE_MASK 0
#endif
#define REP(k) (((PROBE_MASK >> (k)) & 1) + 1)
#ifndef PROBE_VAR
#define PROBE_VAR 0
#endif
#ifndef PROBE_CLK
#define PROBE_CLK 0
#endif
#ifndef STAMP_MASK
#define STAMP_MASK 0
#endif
#ifndef USE_AUX
#define USE_AUX 0
#endif
#ifndef USE_TILE_TRANSPOSE
#define USE_TILE_TRANSPOSE 0
#endif
#ifndef USE_L1_SEQ2
#define USE_L1_SEQ2 0
#endif
#ifndef USE_FUSED_NORM
#define USE_FUSED_NORM 1
#define RES_BF16 (USE_FUSED_NORM && USE_L1_MFMA)
#endif
#ifndef P0_META_FOLD
#define P0_META_FOLD (USE_L0_MFMA == 2 && !USE_TILE_TRANSPOSE)
#endif
#ifndef USE_TICKETS
#define USE_TICKETS 0
#endif
constexpr int N_LAUNCHES = MK_N_LAUNCHES;

constexpr int D = 4096, NB = 4, SEQ = 2048, NMETA = 16, DI = 8192;
constexpr int MX = NB * SEQ;
constexpr int MR = MX + NMETA;
constexpr int MP = 8448;
constexpr int N0 = 4 * DI;
constexpr int N1 = 2 * 4096 + 2 * DI;
constexpr int HG_H = 64, HG_DK = 128;
constexpr int GL_H = 8, GL_DK = 512, GL_DV = 1024, GL_R = 16;
constexpr float LN_EPS = 1e-5f, RMS_EPS = 1e-6f;
constexpr float ALPHA = 1.41421356237309515f;

constexpr size_t MiB = 1u << 20;
constexpr size_t WS_CTL = 0, CTL_ZERO_BYTES = 1 * MiB;
constexpr size_t WS_LB0 = 1 * MiB;
constexpr size_t WS_G1 = 2 * MiB;
constexpr size_t WS_WG1T = 3 * MiB;
constexpr size_t WS_W2F = 3 * MiB + 256 * 1024;
constexpr size_t WS_WT0IN = 4 * MiB;
constexpr size_t WS_WT0OUT = WS_WT0IN + 256 * MiB;
constexpr size_t WS_WT1IN = WS_WT0OUT + 64 * MiB;
constexpr size_t WS_WT1OUT = WS_WT1IN + 192 * MiB;
constexpr size_t WS_XB = WS_WT1OUT + 64 * MiB;
constexpr size_t WS_H1B = WS_XB + 66 * MiB;
constexpr size_t WS_QFIZ = WS_H1B + 66 * MiB;
constexpr size_t WS_Y = WS_QFIZ + 528 * MiB;
constexpr size_t WS_PRE = WS_Y + 132 * MiB;
constexpr size_t WS_REC = WS_PRE + 132 * MiB;
constexpr size_t WS_Q0 = WS_REC + 520 * MiB;
constexpr size_t WS_Y0 = WS_REC + 523 * MiB;
constexpr size_t WS_REC1 = WS_REC, WS_VF1 = WS_REC + 139 * MiB, WS_O1 = WS_REC + 270 * MiB;
constexpr size_t WS_END = WS_REC + 528 * MiB;
static_assert((size_t)MP * D * 2 <= 66 * MiB && (size_t)MP * N0 * 2 <= 528 * MiB && (size_t)MP * DI * 2 <= 132 * MiB && (size_t)MP * D * 4 <= 132 * MiB && (size_t)MR * DI * 4 <= 258 * MiB, "d_ws map");
static_assert((size_t)256 * 65 * 27648 <= 440 * MiB && (size_t)32 * 65 * 69632 <= 139 * MiB && (size_t)32 * 65 * 65536 <= 131 * MiB, "record map");
constexpr int CW_BAR = 4096, CW_POOL = 8192;

constexpr int RING_OFF = 0, RING_BYTES = 155648;
constexpr int LDSCTL_OFF = RING_BYTES, MISC_OFF = LDSCTL_OFF + 320;
constexpr int LDS_BYTES = 163840;
static_assert(MISC_OFF + 128 <= LDS_BYTES, "LDS map");

#define GAS __attribute__((address_space(1)))
#define LAS __attribute__((address_space(3)))
typedef unsigned short bf16;
typedef unsigned v4u __attribute__((ext_vector_type(4)));
typedef unsigned v2u __attribute__((ext_vector_type(2)));
typedef float f32x4 __attribute__((ext_vector_type(4)));
typedef GAS unsigned gu32;
#define RLX_AGENT __ATOMIC_RELAXED, __HIP_MEMORY_SCOPE_AGENT
#define LDS_WAIT() asm volatile("s_waitcnt lgkmcnt(0)" ::: "memory")
#define DI_ __device__ __forceinline__
DI_ unsigned f2bf(float f) { unsigned u = __builtin_bit_cast(unsigned, f); return (u + 0x7fffu + ((u >> 16) & 1u)) >> 16; }
DI_ unsigned pk2(float lo, float hi) { return f2bf(lo) | (f2bf(hi) << 16); }
DI_ unsigned hwpk(float lo, float hi) { unsigned r; asm volatile("v_cvt_pk_bf16_f32 %0, %1, %2" : "=v"(r) : "v"(lo), "v"(hi)); return r; }
DI_ float bflo(unsigned w) { return __builtin_bit_cast(float, w << 16); }
DI_ float bfhi(unsigned w) { return __builtin_bit_cast(float, w & 0xffff0000u); }
DI_ float bf2f(bf16 b) { return __builtin_bit_cast(float, (unsigned)b << 16); }
DI_ float sigm(float x) { return __builtin_amdgcn_rcpf(1.f + __builtin_amdgcn_exp2f(x * -1.4426950408889634f)); }
DI_ float silu(float x) { return x * __builtin_amdgcn_rcpf(1.f + __builtin_amdgcn_exp2f(x * -1.4426950408889634f)); }

#define XB_TMO      128
#define XB_XCNT(j)  (256  + 64 * (j))
#define XB_XSUB(j)  (1280 + 64 * (j))
#define XB_XGEN(j)  (2304 + 64 * (j))
#define XB_TOP      3328
#define XB_TOPGEN   3392
#define XCD_BAR_WORDS 3456
#define XB_SPIN_CAP (1u << 18)

__device__ __forceinline__ unsigned xb_ld(unsigned* p)              { return __hip_atomic_load(p, __ATOMIC_RELAXED, __HIP_MEMORY_SCOPE_AGENT); }
__device__ __forceinline__ unsigned xb_add(unsigned* p, unsigned v) { return __hip_atomic_fetch_add(p, v, __ATOMIC_RELAXED, __HIP_MEMORY_SCOPE_AGENT); }
__device__ __forceinline__ unsigned xb_xcc_id() { return (unsigned)__builtin_amdgcn_s_getreg((3 << 11) | 20) & 0xFu; }
#define XB_SPIN(cond, bar) do { unsigned _sp = 0; while (cond) { __builtin_amdgcn_s_sleep(1); \
    if ((++_sp & 255u) == 0u) { if (xb_ld(&(bar)[XB_TMO])) break; if (_sp > XB_SPIN_CAP) { atomicAdd(&(bar)[XB_TMO], 1u); break; } } } } while (0)

struct XcdBarrier {
    unsigned* bar; unsigned x;
    volatile LAS unsigned* st;
};
__device__ __forceinline__ XcdBarrier xcd_barrier_post(unsigned* bar, volatile LAS unsigned* st) {
    XcdBarrier b; b.bar = bar; b.x = xb_xcc_id(); b.st = st;
    if (threadIdx.x == 0) (void)xb_add(&bar[XB_XCNT(b.x)], 1u);
    return b;
}
__device__ __forceinline__ void xcd_barrier_complete(unsigned* bar, unsigned x, unsigned& nloc, unsigned& nx) {
    const unsigned G = gridDim.x * gridDim.y * gridDim.z;
    unsigned sum, cnt, mine, sp = 0u;
    for (;;) {
        sum = 0u; cnt = 0u; mine = 0u;
#pragma unroll
        for (unsigned j = 0; j < 16; ++j) { const unsigned c = xb_ld(&bar[XB_XCNT(j)]); sum += c; cnt += (c > 0u) ? 1u : 0u; mine = (j == x) ? c : mine; }
        if (sum == G) break;
        __builtin_amdgcn_s_sleep(1);
        if ((++sp & 255u) == 0u) { if (xb_ld(&bar[XB_TMO])) break; if (sp > XB_SPIN_CAP) { atomicAdd(&bar[XB_TMO], 1u); break; } }
    }
    nloc = mine > 0u ? mine : 1u; nx = cnt > 0u ? cnt : 1u;
}
__device__ __forceinline__ void xcd_barrier(const XcdBarrier& b) {
    asm volatile("s_waitcnt vmcnt(0)" ::: "memory");
    __syncthreads();
    if (threadIdx.x == 0) {
        unsigned* bar = b.bar;
        __builtin_amdgcn_s_waitcnt(0);
        unsigned nloc = b.st[0], nx = b.st[1];
        if (nloc == 0u) { xcd_barrier_complete(bar, b.x, nloc, nx); b.st[0] = nloc; b.st[1] = nx; }
        const unsigned old = xb_add(&bar[XB_XSUB(b.x)], 1u);
        const unsigned gen = old / nloc;
        if (old + 1u == (gen + 1u) * nloc) {
            __builtin_amdgcn_fence(__ATOMIC_RELEASE, "agent");
            asm volatile("s_waitcnt vmcnt(0)" ::: "memory");
            const unsigned og = xb_add(&bar[XB_TOP], 1u);
            const unsigned tg = og / nx;
            if (og + 1u == (tg + 1u) * nx) xb_add(&bar[XB_TOPGEN], 1u);
            else XB_SPIN(xb_ld(&bar[XB_TOPGEN]) == tg, bar);
            __builtin_amdgcn_fence(__ATOMIC_ACQUIRE, "agent");
            xb_add(&bar[XB_XGEN(b.x)], 1u);
            asm volatile("s_waitcnt vmcnt(0)" ::: "memory");
        } else {
            XB_SPIN(xb_ld(&bar[XB_XGEN(b.x)]) == gen, bar);
            __builtin_amdgcn_fence(__ATOMIC_ACQUIRE, "agent");
            asm volatile("s_waitcnt vmcnt(0)" ::: "memory");
        }
    }
    __syncthreads();
}

struct Frame {
    LAS unsigned char* lds;
    volatile LAS unsigned* MISC;
    gu32* ctl;
    int tid, lane, wave;
    int vcu, G;
    const float *x, *meta, *lb_logits;
    const float *w0in, *b_f, *ng0, *w0out, *ln0g, *ln0b;
    const float *w1in, *wg1, *wg2, *b_g, *ng1, *w1out, *ln1g, *ln1b;
    float* out;
    float *LB0, *G1, *PRE, *O1;
    unsigned char *REC0, *REC1, *VF1;
    bf16 *WG1T, *W2F, *Q0, *Y0;
    float* SS;
    bf16 *WT0IN, *WT0OUT, *WT1IN, *WT1OUT, *XB, *H1B, *QFIZ, *Y;
};

DI_ float wave_sum(float v) {
#pragma unroll
    for (int o = 1; o < 64; o <<= 1) v += __shfl_xor(v, o);
    return v;
}

typedef short p0_bf16x8 __attribute__((ext_vector_type(8)));
template <bool META>
DI_ void p0_transpose_item_t(const float* W, int K, int N, bf16* WT, LAS float* scr, int item_kb, int item_nb, int lane, const float* meta, f32x4 (&macc)[2]) {
    const int k0 = 64 * item_kb, n0 = 32 * item_nb;
    float wv[32];
#pragma unroll
    for (int i = 0; i < 32; ++i) wv[i] = __builtin_nontemporal_load(W + (size_t)(k0 + 2 * i + (lane >> 5)) * N + n0 + (lane & 31));
    v4u ma[2][2];
    if (META) {
#pragma unroll
        for (int ks = 0; ks < 2; ++ks) { const GAS f32x4* mp = (const GAS f32x4*)(meta + (size_t)(lane & 15) * D + k0 + 32 * ks + 8 * (lane >> 4)); const f32x4 a = mp[0], b = mp[1];
            ma[ks][0] = (v4u){hwpk(a.x, a.y), hwpk(a.z, a.w), hwpk(b.x, b.y), hwpk(b.z, b.w)}; }
    }
#pragma unroll
    for (int i = 0; i < 32; ++i) scr[(2 * i + (lane >> 5)) * 33 + (lane & 31)] = wv[i];
    LDS_WAIT(); asm volatile("" ::: "memory");
    if (META) {
        const int r = lane & 15, g = lane >> 4;
#pragma unroll
        for (int ks = 0; ks < 2; ++ks)
#pragma unroll
            for (int nh = 0; nh < 2; ++nh) { const LAS float* s = scr + (32 * ks + 8 * g) * 33 + 16 * nh + r;
                const v4u bf = (v4u){hwpk(s[0 * 33], s[1 * 33]), hwpk(s[2 * 33], s[3 * 33]), hwpk(s[4 * 33], s[5 * 33]), hwpk(s[6 * 33], s[7 * 33])};
                macc[nh] = __builtin_amdgcn_mfma_f32_16x16x32_bf16(__builtin_bit_cast(p0_bf16x8, ma[ks][0]), __builtin_bit_cast(p0_bf16x8, bf), macc[nh], 0, 0, 0); }
    }
    const int c = lane & 7;
#pragma unroll
    for (int j = 0; j < 4; ++j) { const int n = (lane >> 3) + 8 * j; const LAS float* s = scr + (8 * c) * 33 + n;
        v4u o; o.x = hwpk(s[0 * 33], s[1 * 33]); o.y = hwpk(s[2 * 33], s[3 * 33]); o.z = hwpk(s[4 * 33], s[5 * 33]); o.w = hwpk(s[6 * 33], s[7 * 33]);
        *(GAS v4u*)(WT + (size_t)(n0 + n) * K + k0 + 8 * c) = o; }
    LDS_WAIT(); asm volatile("" ::: "memory");
}
struct P0Item { const float* src; bf16* dst; int N, K; };
template <bool META, bool PREF>
DI_ void p0_item_pipe(const P0Item cur, const P0Item nxt, float (&wv)[32], f32x4 (&mraw)[4], LAS float* scr, int lane, const float* meta_nxt, f32x4 (&macc)[2]) {
#pragma unroll
    for (int i = 0; i < 32; ++i) scr[(2 * i + (lane >> 5)) * 33 + (lane & 31)] = wv[i];
    v4u ma[2];
    if (META) {
#pragma unroll
        for (int ks = 0; ks < 2; ++ks) { const f32x4 a = mraw[2 * ks], b = mraw[2 * ks + 1]; ma[ks] = (v4u){pk2(a.x, a.y), pk2(a.z, a.w), pk2(b.x, b.y), pk2(b.z, b.w)}; }
    }
    if (PREF) {
        if (META) {
#pragma unroll
            for (int ks = 0; ks < 2; ++ks) { const GAS f32x4* mp = (const GAS f32x4*)(meta_nxt + (size_t)(lane & 15) * D + 32 * ks + 8 * (lane >> 4)); mraw[2 * ks] = mp[0]; mraw[2 * ks + 1] = mp[1]; }
        }
#pragma unroll
        for (int i = 0; i < 32; ++i) wv[i] = __builtin_nontemporal_load(nxt.src + (size_t)(2 * i + (lane >> 5)) * nxt.N + (lane & 31));
    }
    LDS_WAIT(); asm volatile("" ::: "memory");
    if (META) {
        const int r = lane & 15, g = lane >> 4;
#pragma unroll
        for (int ks = 0; ks < 2; ++ks)
#pragma unroll
            for (int nh = 0; nh < 2; ++nh) { const LAS float* s = scr + (32 * ks + 8 * g) * 33 + 16 * nh + r;
                const v4u bf = (v4u){hwpk(s[0 * 33], s[1 * 33]), hwpk(s[2 * 33], s[3 * 33]), hwpk(s[4 * 33], s[5 * 33]), hwpk(s[6 * 33], s[7 * 33])};
                macc[nh] = __builtin_amdgcn_mfma_f32_16x16x32_bf16(__builtin_bit_cast(p0_bf16x8, ma[ks]), __builtin_bit_cast(p0_bf16x8, bf), macc[nh], 0, 0, 0); }
    }
    const int c = lane & 7;
#pragma unroll
    for (int j = 0; j < 4; ++j) { const int n = (lane >> 3) + 8 * j; const LAS float* s = scr + (8 * c) * 33 + n;
        v4u o; o.x = hwpk(s[0 * 33], s[1 * 33]); o.y = hwpk(s[2 * 33], s[3 * 33]); o.z = hwpk(s[4 * 33], s[5 * 33]); o.w = hwpk(s[6 * 33], s[7 * 33]);
        *(GAS v4u*)(cur.dst + (size_t)n * cur.K + 8 * c) = o; }
    LDS_WAIT(); asm volatile("" ::: "memory");
}
struct P0Grp { const float* src; bf16* dst; int N, K; };
template <typename T> DI_ T* p0_uni(T* p) { const unsigned long long a = (unsigned long long)p; const unsigned lo = __builtin_amdgcn_readfirstlane((unsigned)a), hi = __builtin_amdgcn_readfirstlane((unsigned)(a >> 32)); return (T*)(((unsigned long long)hi << 32) | lo); }
DI_ P0Grp p0_uni(const P0Grp& x) { return P0Grp{p0_uni(x.src), p0_uni(x.dst), __builtin_amdgcn_readfirstlane(x.N), __builtin_amdgcn_readfirstlane(x.K)}; }
constexpr int P0_PITCH = 528, P0_TILE = 17408;
template <bool META, bool LAST>
DI_ void p0_group(const P0Grp cur, const P0Grp nxt, float (&wv)[2][32], f32x4 (&mraw)[2][4], LAS unsigned char* tile, int lane, const float* meta_cur, const float* meta_nxt, f32x4 (&macc)[2]) {
    const int half = lane >> 5, n = lane & 31, r = lane & 15, g = lane >> 4;
#pragma unroll
    for (int q = 0; q < 4; ++q) {
        unsigned dw[16];
#pragma unroll
        for (int p = 0; p < 16; ++p) dw[p] = hwpk(wv[q & 1][2 * p], wv[q & 1][2 * p + 1]);
#pragma unroll
        for (int t = 0; t < 4; ++t) *(LAS v4u*)(tile + n * P0_PITCH + (64 * q + 32 * half) * 2 + 16 * t) = (v4u){dw[4 * t], dw[4 * t + 1], dw[4 * t + 2], dw[4 * t + 3]};
        asm volatile("" ::: "memory");
        v4u ma[2];
        if (META) {
#pragma unroll
            for (int ks = 0; ks < 2; ++ks) { const f32x4 a = mraw[q & 1][2 * ks], b = mraw[q & 1][2 * ks + 1]; ma[ks] = (v4u){pk2(a.x, a.y), pk2(a.z, a.w), pk2(b.x, b.y), pk2(b.z, b.w)}; }
        }
        if (!(LAST && q >= 2)) {
            const float* ns = (q < 2) ? cur.src + (size_t)(64 * (q + 2)) * cur.N : nxt.src + (size_t)(64 * (q - 2)) * nxt.N; const int nN = (q < 2) ? cur.N : nxt.N;
            if (META) { const float* mn = (q < 2) ? meta_cur + 64 * (q + 2) : meta_nxt + 64 * (q - 2);
#pragma unroll
                for (int ks = 0; ks < 2; ++ks) { const GAS f32x4* mp = (const GAS f32x4*)(mn + (size_t)r * D + 32 * ks + 8 * g); mraw[q & 1][2 * ks] = mp[0]; mraw[q & 1][2 * ks + 1] = mp[1]; } }
            const unsigned lo_ = (unsigned)(32 * half) * (unsigned)nN + n;
#pragma unroll
            for (int i = 0; i < 32; ++i) wv[q & 1][i] = __builtin_nontemporal_load((const GAS float*)(ns + (size_t)i * nN) + lo_);
        }
        asm volatile("" ::: "memory");
        if (META) {
            LDS_WAIT(); asm volatile("" ::: "memory");
#pragma unroll
            for (int ks = 0; ks < 2; ++ks)
#pragma unroll
                for (int nh = 0; nh < 2; ++nh) { const p0_bf16x8 bf = *(const LAS p0_bf16x8*)(tile + (16 * nh + r) * P0_PITCH + (64 * q + 32 * ks + 8 * g) * 2);
                    macc[nh] = __builtin_amdgcn_mfma_f32_16x16x32_bf16(__builtin_bit_cast(p0_bf16x8, ma[ks]), bf, macc[nh], 0, 0, 0); }
        }
    }
    LDS_WAIT(); asm volatile("" ::: "memory");
    const unsigned so_ = (unsigned)half * (unsigned)cur.K + 8 * n;
#pragma unroll
    for (int j = 0; j < 16; ++j) { const v4u o = *(const LAS v4u*)(tile + (2 * j + half) * P0_PITCH + 16 * n); *(GAS v4u*)((GAS bf16*)(cur.dst + (size_t)(2 * j) * cur.K) + so_) = o; }
    LDS_WAIT(); asm volatile("" ::: "memory");
}
DI_ void p0_transpose_item(const float* W, int K, int N, bf16* WT, LAS float* scr, int item, int lane) {
    f32x4 dummy[2]; const int nblk = N / 32;
    p0_transpose_item_t<false>(W, K, N, WT, scr, item / nblk, item % nblk, lane, nullptr, dummy);
}

DI_ void p0_tile_load(const float* W, int N, int k0, int n0, int tid, f32x4 (&wv)[8]) {
    const int row = tid >> 5, c4 = tid & 31;
#pragma unroll
    for (int i = 0; i < 8; ++i) wv[i] = *(const GAS f32x4*)(W + (size_t)(k0 + row + 16 * i) * N + n0 + 4 * c4);
}
DI_ void p0_tile_to_lds(int tid, const f32x4 (&wv)[8], LAS unsigned char* img) {
    const int row = tid >> 5, c4 = tid & 31;
#pragma unroll
    for (int i = 0; i < 8; ++i) { const int k = row + 16 * i; const int col = (2 * c4) ^ (2 * ((k >> 3) & 15));
        *(LAS v2u*)(img + k * 256 + col * 4) = (v2u){hwpk(wv[i].x, wv[i].y), hwpk(wv[i].z, wv[i].w)}; }
}
DI_ void p0_tile_from_lds(bf16* WT, int K, int k0, int n0, int tid, LAS unsigned char* img) {
    __syncthreads();
    const int kc = tid & 15;
#pragma unroll
    for (int j = 0; j < 4; ++j) { const int n = (tid >> 4) + 32 * j; unsigned short hv[8];
#pragma unroll
        for (int e = 0; e < 8; ++e) hv[e] = *(const LAS unsigned short*)(img + (8 * kc + e) * 256 + ((((n >> 1) ^ (2 * kc)) << 2) | ((n & 1) << 1)));
        v4u o; o.x = hv[0] | ((unsigned)hv[1] << 16); o.y = hv[2] | ((unsigned)hv[3] << 16); o.z = hv[4] | ((unsigned)hv[5] << 16); o.w = hv[6] | ((unsigned)hv[7] << 16);
        *(GAS v4u*)(WT + (size_t)(n0 + n) * K + k0 + 8 * kc) = o; }
    __syncthreads();
}
struct P0Tile { const float* W; bf16* WT; int K, N, k0, n0; };
DI_ P0Tile p0_tile_decode(Frame& F, int t) {
    constexpr int T_0 = (D / 128) * (N0 / 128), T_1 = (DI / 128) * (D / 128), T_2 = (D / 128) * (N1 / 128);
    P0Tile p;
    if (t < T_0) { p.W = F.w0in; p.WT = F.WT0IN; p.K = D; p.N = N0; }
    else if (t < T_0 + T_1) { t -= T_0; p.W = F.w0out; p.WT = F.WT0OUT; p.K = DI; p.N = D; }
    else if (t < T_0 + T_1 + T_2) { t -= T_0 + T_1; p.W = F.w1in; p.WT = F.WT1IN; p.K = D; p.N = N1; }
    else { t -= T_0 + T_1 + T_2; p.W = F.w1out; p.WT = F.WT1OUT; p.K = DI; p.N = D; }
    const int nt = p.N / 128, kb = t / nt, nb = t - kb * nt; p.k0 = 128 * kb; p.n0 = 128 * nb; return p;
}
DI_ void p0_transpose_all(Frame& F) {
    constexpr int NT = (D / 128) * (N0 / 128) + 2 * (DI / 128) * (D / 128) + (D / 128) * (N1 / 128);
    f32x4 wv[8];
    int t = F.vcu;
    if (t < NT) { const P0Tile p = p0_tile_decode(F, t); p0_tile_load(p.W, p.N, p.k0, p.n0, F.tid, wv); }
    for (; t < NT; t += F.G) {
        const P0Tile p = p0_tile_decode(F, t);
        p0_tile_to_lds(F.tid, wv, F.lds);
        if (t + F.G < NT) { const P0Tile q = p0_tile_decode(F, t + F.G); p0_tile_load(q.W, q.N, q.k0, q.n0, F.tid, wv); }
        p0_tile_from_lds(p.WT, p.K, p.k0, p.n0, F.tid, F.lds);
    }
}

DI_ void p0_prologue(Frame& F) {
    LAS float* scr = (LAS float*)(F.lds + RING_OFF + F.wave * 16384);
    const int gw = F.vcu * NWAVES + F.wave, NGW = F.G * NWAVES;
    constexpr int I_0 = (D / 64) * (N0 / 32), I_1 = (DI / 64) * (D / 32), I_2 = (D / 64) * (N1 / 32), I_3 = I_1;
    constexpr int NITEMS = I_0 + I_1 + I_2 + I_3;
#if USE_TILE_TRANSPOSE
    p0_transpose_all(F);
#else
    if (P0_META_FOLD && F.G == 256) {
        constexpr int G_1 = (DI / 256) * (D / 32), G_2 = (D / 256) * (N1 / 32), G_3 = G_1;
        static_assert(G_1 + G_2 + G_3 == 1024 * 2 + 1024 * 18, "group split");
        auto other = [&](int q) -> P0Grp {
            const float* W; bf16* WT; int K, N;
            if (q < G_1) { W = F.w0out; WT = F.WT0OUT; K = DI; N = D; }
            else if (q < G_1 + G_2) { q -= G_1; W = F.w1in; WT = F.WT1IN; K = D; N = N1; }
            else { q -= G_1 + G_2; W = F.w1out; WT = F.WT1OUT; K = DI; N = D; }
            const int nblk = N / 32, kg = q / nblk, nb = q - kg * nblk;
            return p0_uni(P0Grp{W + (size_t)(256 * kg) * N + 32 * nb, WT + (size_t)(32 * nb) * K + 256 * kg, N, K});
        };
        LAS unsigned char* tile = F.lds + RING_OFF + F.wave * P0_TILE;
        float wv[2][32]; f32x4 mraw[2][4]; f32x4 macc[2]; macc[0] = (f32x4){0.f, 0.f, 0.f, 0.f}; macc[1] = macc[0];
        const int lane = F.lane;
        int o_lo, o_hi;
        P0Grp cur;
        if (gw < 1024) {
            cur = p0_uni(P0Grp{F.w0in + 32 * gw, F.WT0IN + (size_t)(32 * gw) * D, N0, D});
#pragma unroll
            for (int q = 0; q < 2; ++q)
#pragma unroll
                for (int ks = 0; ks < 2; ++ks) { const GAS f32x4* mp = (const GAS f32x4*)(F.meta + (size_t)(lane & 15) * D + 64 * q + 32 * ks + 8 * (lane >> 4)); mraw[q][2 * ks] = mp[0]; mraw[q][2 * ks + 1] = mp[1]; }
            o_lo = gw * 2; o_hi = o_lo + 2;
        } else { o_lo = 2048 + (gw - 1024) * 18; o_hi = o_lo + 18; cur = other(o_lo); }
#pragma unroll
        for (int q = 0; q < 2; ++q)
#pragma unroll
            for (int i = 0; i < 32; ++i) wv[q][i] = __builtin_nontemporal_load((const GAS float*)(cur.src + (size_t)(64 * q + i) * cur.N) + ((unsigned)(32 * (lane >> 5)) * (unsigned)cur.N + (lane & 31)));
        if (gw < 1024) {
            for (int kg = 0; kg < D / 256 - 1; ++kg) {
                const P0Grp nxt = P0Grp{cur.src + (size_t)256 * N0, cur.dst + 256, N0, D};
                p0_group<true, false>(cur, nxt, wv, mraw, tile, lane, F.meta + 256 * kg, F.meta + 256 * (kg + 1), macc); cur = nxt; }
            { const P0Grp nxt = other(o_lo); p0_group<true, false>(cur, nxt, wv, mraw, tile, lane, F.meta + 256 * (D / 256 - 1), F.meta, macc); cur = nxt; }
            const int r = lane & 15, g = lane >> 4;
#pragma unroll
            for (int nh = 0; nh < 2; ++nh) { const float mv[4] = {macc[nh].x, macc[nh].y, macc[nh].z, macc[nh].w};
#pragma unroll
                for (int jj = 0; jj < 4; ++jj) F.Q0[(size_t)(16 + 4 * g + jj) * N0 + 32 * gw + 16 * nh + r] = (bf16)f2bf(mv[jj]); }
        }
        for (int it = o_lo; it < o_hi - 1; ++it) { const P0Grp nxt = other(it + 1); p0_group<false, false>(cur, nxt, wv, mraw, tile, lane, nullptr, nullptr, macc); cur = nxt; }
        p0_group<false, true>(cur, cur, wv, mraw, tile, lane, nullptr, nullptr, macc);
    } else
    for (int it = gw; it < NITEMS; it += NGW) {
        int r = it;
        if (r < I_0) { p0_transpose_item(F.w0in, D, N0, F.WT0IN, scr, r, F.lane); continue; } r -= I_0;
        if (USE_AUX && USE_L0_MFMA == 2 && F.G == 256) break;
        if (r < I_1) { p0_transpose_item(F.w0out, DI, D, F.WT0OUT, scr, r, F.lane); continue; } r -= I_1;
        if (r < I_2) { p0_transpose_item(F.w1in, D, N1, F.WT1IN, scr, r, F.lane); continue; } r -= I_2;
        p0_transpose_item(F.w1out, DI, D, F.WT1OUT, scr, r, F.lane);
    }
#endif
    for (int m = gw; m < MP; m += NGW) {
        GAS unsigned long long* o8 = (GAS unsigned long long*)(F.XB + (size_t)m * D) + F.lane;
        if (m < MR) {
            const float* src = (m < MX) ? F.x + (size_t)m * D : F.meta + (size_t)(m - MX) * D;
            const GAS f32x4* xr = (const GAS f32x4*)src + F.lane;
            f32x4 xv[16];
#pragma unroll
            for (int j = 0; j < 16; ++j) xv[j] = __builtin_nontemporal_load(xr + 64 * j);
#pragma unroll
            for (int j = 0; j < 16; ++j) { const f32x4 v = xv[j]; o8[64 * j] = (unsigned long long)hwpk(v.x, v.y) | ((unsigned long long)hwpk(v.z, v.w) << 32); }
        } else {
#pragma unroll 4
            for (int j = 0; j < 16; ++j) o8[64 * j] = 0ull;
        }
    }
    for (int m = MR + gw; m < MP; m += NGW) {
        GAS unsigned long long* o8 = (GAS unsigned long long*)(F.H1B + (size_t)m * D) + F.lane;
#pragma unroll 4
        for (int j = 0; j < 16; ++j) o8[64 * j] = 0ull;
    }
    for (int i = gw * 64 + F.lane; i < 16 * N0 / 8; i += NGW * 64) { const int col8 = i % (N0 / 8); const unsigned v = (col8 >= DI / 8 && col8 < 2 * DI / 8) ? 0x47004700u : 0u;
        *((GAS v4u*)F.Q0 + i) = (v4u){v, v, v, v}; }
    for (int i = gw * 64 + F.lane; i < GL_R * D; i += NGW * 64) { const int n = i / D, k = i - n * D; F.WG1T[i] = (bf16)f2bf(F.wg1[(size_t)k * GL_R + n]); }
    for (int i = gw * 64 + F.lane; i < 8 * 16 * 2 * 64 * 8; i += NGW * 64) {
        const int e = i & 7, ln = (i >> 3) & 63, fr = i >> 9, m2 = fr & 1, s2 = (fr >> 1) & 15, hh = fr >> 5, rA = ln & 15, gA = ln >> 4;
        float v = 0.f; if (gA < 2) v = F.wg2[(size_t)(8 * gA + e) * 4096 + hh * 512 + 32 * s2 + 8 * (rA >> 2) + 4 * m2 + (rA & 3)];
        F.W2F[i] = (bf16)f2bf(v);
    }
    for (int c = gw * 64 + F.lane; c < DI; c += NGW * 64) {
        const float l0 = F.lb_logits[c], l1 = F.lb_logits[DI + c], l2 = F.lb_logits[2 * DI + c];
        const float mx = fmaxf(l0, fmaxf(l1, l2));
        const float e0 = __expf(l0 - mx), e1 = __expf(l1 - mx), e2 = __expf(l2 - mx);
        F.LB0[c] = e0 / (e0 + e1 + e2);
    }
}

DI_ void p2_l0_rec_naive(Frame& F) {
    LAS float* qs = (LAS float*)(F.lds);
    LAS float* fs = qs + 2048;
    LAS float* ks = fs + 2048;
    LAS float* vs = ks + 2048;
    LAS float* pb = vs + 2048;
    const int tid = F.tid, dv = tid & 127, kg = tid >> 7;
    const int lj = tid >> 5, lc = (tid & 31) * 4;
    for (int u = blockIdx.x; u < NB * HG_H; u += F.G) {
        const int b = u >> 6, h = u & 63;
        float S[32];
#pragma unroll
        for (int i = 0; i < 32; ++i) S[i] = 0.f;
        float lbv[4], bfv[4], ngv[4];
#pragma unroll
        for (int i = 0; i < 4; ++i) { lbv[i] = F.LB0[h * 128 + lc + i]; bfv[i] = F.b_f[h * 128 + lc + i]; ngv[i] = F.ng0[h * 128 + lc + i]; }
        for (int tb = 0; tb < 129; ++tb) {
            const int rbase = (tb == 0) ? MX : b * SEQ + 16 * (tb - 1);
            const bf16* row = F.QFIZ + (size_t)(rbase + lj) * N0 + h * 128 + lc;
            {
                const v2u q4 = *(const GAS v2u*)(row), f4 = *(const GAS v2u*)(row + DI), i4 = *(const GAS v2u*)(row + 2 * DI);
                const float qv[4] = {bflo(q4.x), bfhi(q4.x), bflo(q4.y), bfhi(q4.y)};
                const float fv[4] = {bflo(f4.x), bfhi(f4.x), bflo(f4.y), bfhi(f4.y)};
                const float iv[4] = {bflo(i4.x), bfhi(i4.x), bflo(i4.y), bfhi(i4.y)};
#pragma unroll
                for (int i = 0; i < 4; ++i) {
                    const float fg = lbv[i] + (1.f - lbv[i]) * sigm(fv[i] + bfv[i]);
                    qs[lj * 128 + lc + i] = silu(qv[i]); fs[lj * 128 + lc + i] = fg; ks[lj * 128 + lc + i] = 1.f - fg; vs[lj * 128 + lc + i] = iv[i];
                }
            }
            __syncthreads();
            for (int j = 0; j < 16; ++j) {
                const float vj = vs[j * 128 + dv]; float po = 0.f;
#pragma unroll
                for (int i = 0; i < 32; i += 4) {
                    const f32x4 f4 = *(const LAS f32x4*)(fs + j * 128 + kg * 32 + i), k4 = *(const LAS f32x4*)(ks + j * 128 + kg * 32 + i), q4 = *(const LAS f32x4*)(qs + j * 128 + kg * 32 + i);
                    S[i + 0] = f4.x * S[i + 0] + k4.x * vj; po += q4.x * S[i + 0];
                    S[i + 1] = f4.y * S[i + 1] + k4.y * vj; po += q4.y * S[i + 1];
                    S[i + 2] = f4.z * S[i + 2] + k4.z * vj; po += q4.z * S[i + 2];
                    S[i + 3] = f4.w * S[i + 3] + k4.w * vj; po += q4.w * S[i + 3];
                }
                pb[(j * 4 + kg) * 128 + dv] = po;
            }
            __syncthreads();
            {
                f32x4 o = *(const LAS f32x4*)(pb + (lj * 4 + 0) * 128 + lc);
                o += *(const LAS f32x4*)(pb + (lj * 4 + 1) * 128 + lc);
                o += *(const LAS f32x4*)(pb + (lj * 4 + 2) * 128 + lc);
                o += *(const LAS f32x4*)(pb + (lj * 4 + 3) * 128 + lc);
                float ss = o.x * o.x + o.y * o.y + o.z * o.z + o.w * o.w;
                ss += __shfl_xor(ss, 16); ss += __shfl_xor(ss, 8); ss += __shfl_xor(ss, 4); ss += __shfl_xor(ss, 2); ss += __shfl_xor(ss, 1);
                const float rs = rsqrtf(ss * (1.f / 128.f) + RMS_EPS);
                const v2u z4 = *(const GAS v2u*)(row + 3 * DI);
                const float y0 = o.x * rs * ngv[0] * silu(bflo(z4.x)), y1 = o.y * rs * ngv[1] * silu(bfhi(z4.x));
                const float y2 = o.z * rs * ngv[2] * silu(bflo(z4.y)), y3 = o.w * rs * ngv[3] * silu(bfhi(z4.y));
                if (tb > 0 || b == 0) { v2u w; w.x = pk2(y0, y1); w.y = pk2(y2, y3); *(GAS v2u*)(F.Y + (size_t)(rbase + lj) * DI + h * 128 + lc) = w; }
            }
        }
        __syncthreads();
    }
}

DI_ void ln_phase(Frame& F, const float* src, int nrows, const float* g, const float* bt, float* dst32, bf16* dstb, float* G1) {
    const int gw = F.vcu * NWAVES + F.wave, NGW = F.G * NWAVES;
    for (int r = gw; r < nrows; r += NGW) {
        const GAS f32x4* s = (const GAS f32x4*)(src + (size_t)r * D) + F.lane;
        f32x4 v[16]; float sm = 0.f;
#pragma unroll
        for (int j = 0; j < 16; ++j) { v[j] = s[64 * j]; sm += (v[j].x + v[j].y) + (v[j].z + v[j].w); }
        const float mean = wave_sum(sm) * (1.f / D); float s2 = 0.f;
#pragma unroll
        for (int j = 0; j < 16; ++j) { v[j] = v[j] - mean; s2 += (v[j].x * v[j].x + v[j].y * v[j].y) + (v[j].z * v[j].z + v[j].w * v[j].w); }
        const float rstd = rsqrtf(wave_sum(s2) * (1.f / D) + LN_EPS);
#pragma unroll
        for (int j = 0; j < 16; ++j) {
            const f32x4 gg = *((const GAS f32x4*)g + F.lane + 64 * j), bb = *((const GAS f32x4*)bt + F.lane + 64 * j);
            v[j] = v[j] * rstd * gg + bb;
            if (dst32) *((GAS f32x4*)(dst32 + (size_t)r * D) + F.lane + 64 * j) = v[j];
            if (dstb) { v2u w; w.x = hwpk(v[j].x, v[j].y); w.y = hwpk(v[j].z, v[j].w); *((GAS v2u*)(dstb + (size_t)r * D) + F.lane + 64 * j) = w; }
            if ((j & 3) == 3) asm volatile("" ::: "memory");
        }
        if (G1) {
            LAS float* rowbuf = (LAS float*)(F.lds + RING_OFF + F.wave * 16384);
#pragma unroll
            for (int j = 0; j < 16; ++j) *(LAS f32x4*)(rowbuf + 256 * j + 4 * F.lane) = v[j];
            LDS_WAIT(); asm volatile("" ::: "memory");
            float a[16];
#pragma unroll
            for (int q = 0; q < 16; ++q) a[q] = 0.f;
#pragma unroll 2
            for (int i = 0; i < 64; ++i) {
                const int k = 64 * i + F.lane;
                const float e = rowbuf[k];
                const GAS f32x4* w = (const GAS f32x4*)(F.wg1 + (size_t)k * GL_R);
                const f32x4 w0 = w[0], w1 = w[1], w2 = w[2], w3 = w[3];
                a[0] += e * w0.x; a[1] += e * w0.y; a[2] += e * w0.z; a[3] += e * w0.w;
                a[4] += e * w1.x; a[5] += e * w1.y; a[6] += e * w1.z; a[7] += e * w1.w;
                a[8] += e * w2.x; a[9] += e * w2.y; a[10] += e * w2.z; a[11] += e * w2.w;
                a[12] += e * w3.x; a[13] += e * w3.y; a[14] += e * w3.z; a[15] += e * w3.w;
            }
#pragma unroll
            for (int q = 0; q < 16; ++q) a[q] = wave_sum(a[q]);
            if (F.lane == 0) {
#pragma unroll
                for (int q = 0; q < 16; q += 4) *(GAS f32x4*)(G1 + (size_t)r * GL_R + q) = (f32x4){a[q], a[q + 1], a[q + 2], a[q + 3]};
            }
            LDS_WAIT(); asm volatile("" ::: "memory");
        }
    }
}

DI_ void ln_phase2(Frame& F, const float* src, int nrows, const float* g, const float* bt, float* dst32, bf16* dstb) {
    const int gw = F.vcu * NWAVES + F.wave, NGW = F.G * NWAVES;
    LAS float* gL = (LAS float*)(F.lds + RING_OFF); LAS float* bL = gL + D;
    for (int i = F.tid; i < D / 4; i += NWAVES * 64) { *(LAS f32x4*)(gL + 4 * i) = *((const GAS f32x4*)g + i); *(LAS f32x4*)(bL + 4 * i) = *((const GAS f32x4*)bt + i); }
    __syncthreads();
    f32x4 va[16], vb[16];
#define LN_LOAD(v_, r_) do { const GAS f32x4* s_ = (const GAS f32x4*)(((r_) < nrows) ? src + (size_t)(r_) * D : g) + F.lane; \
        _Pragma("unroll") for (int j = 0; j < 16; ++j) v_[j] = s_[64 * j]; } while (0)
#define LN_PROC(v_, r_) do { float sm = 0.f; \
        _Pragma("unroll") for (int j = 0; j < 16; ++j) sm += (v_[j].x + v_[j].y) + (v_[j].z + v_[j].w); \
        const float mean = wave_sum(sm) * (1.f / D); float s2 = 0.f; \
        _Pragma("unroll") for (int j = 0; j < 16; ++j) { v_[j] = v_[j] - mean; s2 += (v_[j].x * v_[j].x + v_[j].y * v_[j].y) + (v_[j].z * v_[j].z + v_[j].w * v_[j].w); } \
        const float rstd = rsqrtf(wave_sum(s2) * (1.f / D) + LN_EPS); \
        _Pragma("unroll") for (int j = 0; j < 16; ++j) { \
            const f32x4 gg = *(const LAS f32x4*)(gL + 4 * (F.lane + 64 * j)), bb = *(const LAS f32x4*)(bL + 4 * (F.lane + 64 * j)); \
            const f32x4 o_ = v_[j] * rstd * gg + bb; \
            if (dst32) *((GAS f32x4*)(dst32 + (size_t)(r_) * D) + F.lane + 64 * j) = o_; \
            if (dstb) { v2u w_; w_.x = pk2(o_.x, o_.y); w_.y = pk2(o_.z, o_.w); *((GAS v2u*)(dstb + (size_t)(r_) * D) + F.lane + 64 * j) = w_; } \
            if ((j & 3) == 3) asm volatile("" ::: "memory"); } } while (0)
    int r = gw;
    LN_LOAD(va, r);
    while (r < nrows) {
        LN_LOAD(vb, r + NGW);
        LN_PROC(va, r);
        r += NGW; if (r >= nrows) break;
        LN_LOAD(va, r + NGW);
        LN_PROC(vb, r);
        r += NGW;
    }
#undef LN_LOAD
#undef LN_PROC
}

DI_ void p6_l1_rec_naive(Frame& F) {
    LAS float* qs = (LAS float*)(F.lds);
    LAS float* ks = qs + 4096;
    LAS float* gs = ks + 4096;
    LAS float* vs = gs + 4096;
    LAS float* pb = vs + 512;
    const int tid = F.tid, dv = tid & 63, kg = tid >> 6;
    const float qscale = 0.04419417382415922f;
    for (int u = blockIdx.x; u < NB * GL_H * 16; u += F.G) {
        const int dvs = u & 15, bh = u >> 4, b = bh >> 3, h = bh & 7;
        float S[64];
#pragma unroll
        for (int i = 0; i < 64; ++i) S[i] = 0.f;
        float w2[16];
#pragma unroll
        for (int r = 0; r < 16; ++r) w2[r] = F.wg2[(size_t)r * 4096 + h * 512 + tid];
        const float bg = F.b_g[h * 512 + tid];
        for (int tb = 0; tb < 258; ++tb) {
            const int rbase = (tb < 2) ? MX + 8 * tb : b * SEQ + 8 * (tb - 2);
            for (int j = 0; j < 8; ++j) {
                const size_t r = (size_t)(rbase + j);
                const float q = bf2f(F.QFIZ[r * N1 + h * 512 + tid]) * qscale, k = bf2f(F.QFIZ[r * N1 + 4096 + h * 512 + tid]);
                const float* g1 = F.G1 + r * GL_R;
                float xg = bg;
#pragma unroll
                for (int rr = 0; rr < 16; ++rr) xg += g1[rr] * w2[rr];
                const float ls = fminf(xg, 0.f) - log1pf(__expf(-fabsf(xg)));
                qs[j * 512 + tid] = q; ks[j * 512 + tid] = k; gs[j * 512 + tid] = __expf(ls * (1.f / 16.f));
            }
            vs[tid] = bf2f(F.QFIZ[(size_t)(rbase + (tid >> 6)) * N1 + 8192 + h * 1024 + dvs * 64 + (tid & 63)]);
            __syncthreads();
            for (int j = 0; j < 8; ++j) {
                const float vj = vs[j * 64 + dv]; float po = 0.f;
#pragma unroll
                for (int i = 0; i < 64; i += 4) {
                    const f32x4 g4 = *(const LAS f32x4*)(gs + j * 512 + kg * 64 + i), k4 = *(const LAS f32x4*)(ks + j * 512 + kg * 64 + i), q4 = *(const LAS f32x4*)(qs + j * 512 + kg * 64 + i);
                    S[i + 0] = g4.x * S[i + 0] + k4.x * vj; po += q4.x * S[i + 0];
                    S[i + 1] = g4.y * S[i + 1] + k4.y * vj; po += q4.y * S[i + 1];
                    S[i + 2] = g4.z * S[i + 2] + k4.z * vj; po += q4.z * S[i + 2];
                    S[i + 3] = g4.w * S[i + 3] + k4.w * vj; po += q4.w * S[i + 3];
                    if ((i & 12) == 12) asm volatile("" ::: "memory");
                }
                pb[(j * 8 + kg) * 64 + dv] = po;
            }
            __syncthreads();
            {
                const int j = tid >> 6, d = tid & 63; float o = 0.f;
#pragma unroll
                for (int g = 0; g < 8; ++g) o += pb[(j * 8 + g) * 64 + d];
                if (tb >= 2 || b == 0) F.O1[(size_t)(rbase + j) * DI + h * 1024 + dvs * 64 + d] = o;
            }
        }
        __syncthreads();
    }
}

DI_ void p7_normgate(Frame& F) {
    const int gw = F.vcu * NWAVES + F.wave, NGW = F.G * NWAVES;
    for (int it = gw; it < MX * GL_H; it += NGW) {
        const int r = it >> 3, h = it & 7;
        const GAS v4u* o = (const GAS v4u*)((const bf16*)F.O1 + (size_t)r * DI + h * 1024) + F.lane;
        const GAS v4u* zp = (const GAS v4u*)(F.QFIZ + (size_t)r * N1 + 16384 + h * 1024) + F.lane;
        v4u ov[2], zv[2]; float ss = 0.f;
#pragma unroll
        for (int j = 0; j < 2; ++j) { ov[j] = o[64 * j]; zv[j] = zp[64 * j]; }
        float x[2][8];
#pragma unroll
        for (int j = 0; j < 2; ++j) { x[j][0] = bflo(ov[j].x); x[j][1] = bfhi(ov[j].x); x[j][2] = bflo(ov[j].y); x[j][3] = bfhi(ov[j].y); x[j][4] = bflo(ov[j].z); x[j][5] = bfhi(ov[j].z); x[j][6] = bflo(ov[j].w); x[j][7] = bfhi(ov[j].w);
#pragma unroll
            for (int e = 0; e < 8; ++e) ss += x[j][e] * x[j][e]; }
        const float rs = rsqrtf(wave_sum(ss) * (1.f / 1024.f) + RMS_EPS);
#pragma unroll
        for (int j = 0; j < 2; ++j) {
            const int c = h * 1024 + 512 * j + 8 * F.lane;
            const f32x4 n0 = *(const GAS f32x4*)(F.ng1 + c), n1 = *(const GAS f32x4*)(F.ng1 + c + 4);
            const float z[8] = {bflo(zv[j].x), bfhi(zv[j].x), bflo(zv[j].y), bfhi(zv[j].y), bflo(zv[j].z), bfhi(zv[j].z), bflo(zv[j].w), bfhi(zv[j].w)};
            v4u wv; wv.x = pk2(x[j][0] * rs * n0.x * silu(z[0]), x[j][1] * rs * n0.y * silu(z[1])); wv.y = pk2(x[j][2] * rs * n0.z * silu(z[2]), x[j][3] * rs * n0.w * silu(z[3]));
            wv.z = pk2(x[j][4] * rs * n1.x * silu(z[4]), x[j][5] * rs * n1.y * silu(z[5])); wv.w = pk2(x[j][6] * rs * n1.z * silu(z[6]), x[j][7] * rs * n1.w * silu(z[7]));
            *(GAS v4u*)(F.Y + (size_t)r * DI + c) = wv;
        }
    }
}

typedef short bf16x8 __attribute__((ext_vector_type(8)));
#ifndef USE_FUSED_NORM
#define USE_FUSED_NORM 1
#endif
constexpr int NCH = 65;
constexpr int SSP_OFF = 155648 + 512;
constexpr float LOG2E = 1.4426950408889634f;
constexpr int R1_QD = 0, R1_KD = 32768, R1_P = 65536, R1_GL = 67584, R1_SH = 69632;
constexpr int ST1 = R1_SH + 8192;
constexpr int R0_QD = 0, R0_KD = 8192, R0_P = 16384, R0_V = 18432, R0_GL = 26624, R0_SZ = 27648;
constexpr int ST0 = R0_SZ;

DI_ unsigned cvtpk(float lo, float hi) { unsigned r; asm volatile("v_cvt_pk_bf16_f32 %0, %1, %2" : "=v"(r) : "v"(lo), "v"(hi)); return r; }
template <int N> DI_ float row_shr(float x) { return __builtin_bit_cast(float, __builtin_amdgcn_update_dpp(0, __builtin_bit_cast(int, x), 0x110 + N, 0xF, 0xF, true)); }
template <int K> DI_ float glb(float x) { return __builtin_bit_cast(float, __builtin_amdgcn_update_dpp(0, __builtin_bit_cast(int, x), 0x150 + K, 0xF, 0xF, true)); }
DI_ float bcast15(float x) { return __builtin_bit_cast(float, __builtin_amdgcn_update_dpp(0, __builtin_bit_cast(int, x), 0x15F, 0xF, 0xF, true)); }
DI_ float scan16(float x) { x += row_shr<1>(x); x += row_shr<2>(x); x += row_shr<4>(x); x += row_shr<8>(x); return x; }
DI_ float ex2(float x) { return __builtin_amdgcn_exp2f(x); }
DI_ float lg2(float x) { return __builtin_amdgcn_logf(x); }
DI_ int row_of(int b, int c, int tok) { return c == 0 ? MX + tok - 16 : b * SEQ + 32 * (c - 1) + tok; }
DI_ bf16x8 mk8(unsigned a, unsigned b, unsigned c, unsigned d) { v4u t; t.x = a; t.y = b; t.z = c; t.w = d; return __builtin_bit_cast(bf16x8, t); }
#define MFMA16(a, b, c) __builtin_amdgcn_mfma_f32_16x16x32_bf16((a), (b), (c), 0, 0, 0)

DI_ void l1_prep(Frame& F, unsigned char* REC1, unsigned char* VF1, const bf16* W2F) {
    const int lane = F.lane, w = F.wave, r = lane & 15, g = lane >> 4;
    LAS unsigned char* T = F.lds + w * 16384;
    LAS unsigned char* Tv = F.lds + w * 16384 + 4096;
    LAS f32x4* Pp = (LAS f32x4*)(F.lds + 131072);
    const float qscale = 0.04419417382415922f;
    v4u qn[2][2], kn[2][2]; f32x4 gn[2][2];
#define L1P_LOAD(it_) do { const int bh_ = (it_) / NCH, c_ = (it_) - bh_ * NCH, b_ = bh_ >> 3, h_ = bh_ & 7; \
        _Pragma("unroll") for (int ti = 0; ti < 2; ++ti) { const int tok_ = 16 * ti + r; const int row_ = (c_ == 0 && tok_ < 16) ? 0 : row_of(b_, c_, tok_); \
            const GAS f32x4* gp = (const GAS f32x4*)(F.G1 + (size_t)row_ * GL_R + 8 * (g & 1)); gn[ti][0] = gp[0]; gn[ti][1] = gp[1]; \
            _Pragma("unroll") for (int si = 0; si < 2; ++si) { const bf16* rp = F.QFIZ + (size_t)row_ * N1 + h_ * 512 + 32 * (2 * w + si) + 8 * g; qn[si][ti] = *(const GAS v4u*)rp; kn[si][ti] = *(const GAS v4u*)(rp + 4096); } } } while (0)
    if ((int)blockIdx.x < NB * GL_H * NCH) L1P_LOAD((int)blockIdx.x);
    for (int it = blockIdx.x; it < NB * GL_H * NCH; it += F.G) {
        const int bh = it / NCH, c = it - bh * NCH, b = bh >> 3, h = bh & 7;
        unsigned char* rec = REC1 + (size_t)it * R1_SH;
        bool nul[2];
#pragma unroll
        for (int ti = 0; ti < 2; ++ti) { const int tok = 16 * ti + r; nul[ti] = (c == 0 && tok < 16); }
        bf16x8 g1f[2];
#pragma unroll
        for (int ti = 0; ti < 2; ++ti) {
            const f32x4 t0 = (g < 2) ? gn[ti][0] : (f32x4){0.f, 0.f, 0.f, 0.f}, t1 = (g < 2) ? gn[ti][1] : (f32x4){0.f, 0.f, 0.f, 0.f};
            g1f[ti] = mk8(pk2(t0.x, t0.y), pk2(t0.z, t0.w), pk2(t1.x, t1.y), pk2(t1.z, t1.w));
        }
        f32x4 pacc[3];
#pragma unroll
        for (int t = 0; t < 3; ++t) pacc[t] = (f32x4){0.f, 0.f, 0.f, 0.f};
        v4u qraw[2][2], kraw[2][2];
#pragma unroll
        for (int si = 0; si < 2; ++si)
#pragma unroll
            for (int ti = 0; ti < 2; ++ti) { qraw[si][ti] = qn[si][ti]; kraw[si][ti] = kn[si][ti]; }
        f32x4 bg[2][2]; bf16x8 wfr[2][2];
#pragma unroll
        for (int si = 0; si < 2; ++si) { const int s = 2 * w + si, col = h * 512 + 32 * s + 8 * g;
            bg[si][0] = *(const GAS f32x4*)(F.b_g + col); bg[si][1] = *(const GAS f32x4*)(F.b_g + col + 4);
            wfr[si][0] = *(const GAS bf16x8*)(W2F + ((size_t)((h * 16 + s) * 2 + 0) * 64 + lane) * 8); wfr[si][1] = *(const GAS bf16x8*)(W2F + ((size_t)((h * 16 + s) * 2 + 1) * 64 + lane) * 8); }
        { const int nx = (it + F.G < NB * GL_H * NCH) ? it + F.G : it; L1P_LOAD(nx); }
        v4u vraw[8];
        if (USE_L1_SEQ2) {
#pragma unroll
            for (int i2 = 0; i2 < 8; ++i2) { const int q = lane + 64 * i2, tk = q >> 4, c16 = q & 15; const int vrow = (c == 0) ? MX - 16 + tk : b * SEQ + 32 * (c - 1) + tk;
                vraw[i2] = *(const GAS v4u*)(F.QFIZ + (size_t)vrow * N1 + 8192 + h * 1024 + 128 * w + 8 * c16); }
        }
        asm volatile("" ::: "memory");
#pragma unroll
        for (int si = 0; si < 2; ++si) {
            const int s = 2 * w + si, col = h * 512 + 32 * s + 8 * g;
            float xg[2][8];
            { const f32x4 b0 = bg[si][0], b1 = bg[si][1];
              const bf16x8 wa = wfr[si][0], wb = wfr[si][1];
#pragma unroll
              for (int ti = 0; ti < 2; ++ti) { const f32x4 xa = MFMA16(wa, g1f[ti], b0), xb = MFMA16(wb, g1f[ti], b1);
                  xg[ti][0] = xa.x; xg[ti][1] = xa.y; xg[ti][2] = xa.z; xg[ti][3] = xa.w; xg[ti][4] = xb.x; xg[ti][5] = xb.y; xg[ti][6] = xb.z; xg[ti][7] = xb.w; } }
            float qv[2][8], kv[2][8];
#pragma unroll
            for (int ti = 0; ti < 2; ++ti) {
                const v4u q4 = qraw[si][ti], k4 = kraw[si][ti];
                qv[ti][0] = bflo(q4.x); qv[ti][1] = bfhi(q4.x); qv[ti][2] = bflo(q4.y); qv[ti][3] = bfhi(q4.y); qv[ti][4] = bflo(q4.z); qv[ti][5] = bfhi(q4.z); qv[ti][6] = bflo(q4.w); qv[ti][7] = bfhi(q4.w);
                kv[ti][0] = bflo(k4.x); kv[ti][1] = bfhi(k4.x); kv[ti][2] = bflo(k4.y); kv[ti][3] = bfhi(k4.y); kv[ti][4] = bflo(k4.z); kv[ti][5] = bfhi(k4.z); kv[ti][6] = bflo(k4.w); kv[ti][7] = bfhi(k4.w);
            }
            unsigned qd[2][4], ki[2][4], kd[2][4]; float gl[8];
#pragma unroll
            for (int e = 0; e < 8; e += 2) {
                float bb[2][2], BB[2];
#pragma unroll
                for (int u = 0; u < 2; ++u) {
                    float L0 = nul[0] ? 0.f : (fminf(xg[0][e + u], 0.f) * LOG2E - lg2(1.f + ex2(-fabsf(xg[0][e + u]) * LOG2E))) * (1.f / 16.f);
                    float L1 = nul[1] ? 0.f : (fminf(xg[1][e + u], 0.f) * LOG2E - lg2(1.f + ex2(-fabsf(xg[1][e + u]) * LOG2E))) * (1.f / 16.f);
                    const float b0 = scan16(L0);
                    const float b1 = scan16(L1) + bcast15(b0);
                    bb[0][u] = b0; bb[1][u] = b1; BB[u] = bcast15(b1);
                    gl[e + u] = ex2(BB[u]);
                }
#pragma unroll
                for (int ti = 0; ti < 2; ++ti) {
                    const float q0 = nul[ti] ? 0.f : qv[ti][e] * qscale, q1 = nul[ti] ? 0.f : qv[ti][e + 1] * qscale;
                    const float k0 = nul[ti] ? 0.f : kv[ti][e], k1 = nul[ti] ? 0.f : kv[ti][e + 1];
                    const float ki0 = k0 * ex2(-bb[ti][0]), ki1 = k1 * ex2(-bb[ti][1]);
                    qd[ti][e >> 1] = cvtpk(q0 * ex2(bb[ti][0]), q1 * ex2(bb[ti][1]));
                    ki[ti][e >> 1] = cvtpk(ki0, ki1);
                    kd[ti][e >> 1] = cvtpk(ki0 * gl[e], ki1 * gl[e + 1]);
                }
            }
            const bf16x8 qf0 = mk8(qd[0][0], qd[0][1], qd[0][2], qd[0][3]), qf1 = mk8(qd[1][0], qd[1][1], qd[1][2], qd[1][3]);
            const bf16x8 kf0 = mk8(ki[0][0], ki[0][1], ki[0][2], ki[0][3]), kf1 = mk8(ki[1][0], ki[1][1], ki[1][2], ki[1][3]);
            pacc[0] = MFMA16(kf0, qf0, pacc[0]);
            pacc[1] = MFMA16(kf0, qf1, pacc[1]);
            pacc[2] = MFMA16(kf1, qf1, pacc[2]);
#pragma unroll
            for (int ti = 0; ti < 2; ++ti)
#pragma unroll
                for (int h2 = 0; h2 < 2; ++h2) {
                    const int lp = (2 * (g & 1) + h2) * 16 + r;
                    v2u d; d.x = qd[ti][2 * h2]; d.y = qd[ti][2 * h2 + 1];
                    *(GAS v2u*)(rec + R1_QD + ((ti * 16 + s) * 64 + lp) * 16 + (g >> 1) * 8) = d;
                }
#pragma unroll
            for (int ti = 0; ti < 2; ++ti)
#pragma unroll
                for (int e = 0; e < 8; ++e) {
                    const unsigned wd = kd[ti][e >> 1]; const unsigned short hv = (e & 1) ? (unsigned short)(wd >> 16) : (unsigned short)(wd & 0xffffu);
                    *(LAS unsigned short*)(T + (32 * si + 8 * g + e) * 64 + (16 * ti + r) * 2) = hv;
                }
            if (r == 0) { *(GAS f32x4*)(rec + R1_GL + (32 * s + 8 * g) * 4) = (f32x4){gl[0], gl[1], gl[2], gl[3]}; *(GAS f32x4*)(rec + R1_GL + (32 * s + 8 * g + 4) * 4) = (f32x4){gl[4], gl[5], gl[6], gl[7]}; }
        }
#pragma unroll
        for (int t = 0; t < 3; ++t) Pp[(w * 3 + t) * 64 + lane] = pacc[t];
        if (USE_L1_SEQ2) {
#pragma unroll
            for (int i2 = 0; i2 < 8; ++i2) { const int q = lane + 64 * i2, tk = q >> 4, c16 = q & 15; const v4u d = vraw[i2];
                *(LAS v2u*)(Tv + tk * 264 + c16 * 16) = (v2u){d.x, d.y}; *(LAS v2u*)(Tv + tk * 264 + c16 * 16 + 8) = (v2u){d.z, d.w}; }
        }
        LDS_WAIT(); asm volatile("" ::: "memory");
        if (USE_L1_SEQ2) {
#pragma unroll
            for (int sl = 0; sl < 8; ++sl) { unsigned short hv[8];
#pragma unroll
                for (int e = 0; e < 8; ++e) hv[e] = *(const LAS unsigned short*)(Tv + (8 * g + e) * 264 + (16 * sl + r) * 2);
                v4u d; d.x = hv[0] | ((unsigned)hv[1] << 16); d.y = hv[2] | ((unsigned)hv[3] << 16); d.z = hv[4] | ((unsigned)hv[5] << 16); d.w = hv[6] | ((unsigned)hv[7] << 16);
                *(GAS v4u*)(VF1 + ((size_t)it * 64 + 8 * w + sl) * 1024 + lane * 16) = d; }
        }
#pragma unroll
        for (int ml = 0; ml < 4; ++ml) { const v4u d = *(const LAS v4u*)(T + (16 * ml + r) * 64 + 16 * g); *(GAS v4u*)(rec + R1_KD + ((4 * w + ml) * 64 + lane) * 16) = d; }
        __syncthreads();
        if (w < 4) {
            const int tj = (w == 2 || w == 3) ? 1 : 0, ti = (w == 1 || w == 2) ? 1 : 0;
            f32x4 sum = (f32x4){0.f, 0.f, 0.f, 0.f};
            if (w < 3) {
#pragma unroll
                for (int ww = 0; ww < 8; ++ww) sum += Pp[(ww * 3 + w) * 64 + lane];
            }
            float pv[4] = {sum.x, sum.y, sum.z, sum.w};
#pragma unroll
            for (int jj = 0; jj < 4; ++jj) { const int j = 16 * tj + 4 * g + jj, i = 16 * ti + r; if (j > i) pv[jj] = 0.f; }
            const int lp = (2 * tj + (g >> 1)) * 16 + r;
            v2u d; d.x = cvtpk(pv[0], pv[1]); d.y = cvtpk(pv[2], pv[3]);
            *(GAS v2u*)(rec + R1_P + (ti * 64 + lp) * 16 + 8 * (g & 1)) = d;
        }
        __syncthreads();
    }
}
#undef L1P_LOAD

template <int VAR> DI_ void l1_seq(Frame& F, const unsigned char* REC1, const unsigned char* VF1, float* O1, float* SS) {
    const int lane = F.lane, w = F.wave, r = lane & 15, g = lane >> 4;
    for (int u = F.vcu; u < NB * GL_H * 8; u += F.G) {
        const int bh = u >> 3, ds = u & 7, b = bh >> 3, h = bh & 7;
        f32x4 acc[32];
#pragma unroll
        for (int m = 0; m < 32; ++m) acc[m] = (f32x4){0.f, 0.f, 0.f, 0.f};
#define L1_DMA(c_) do { const unsigned char* rs_ = REC1 + (size_t)(bh * NCH + (c_)) * R1_SH; LAS unsigned char* st_ = F.lds + ((c_) & 1) * ST1; \
        for (int p_ = w; p_ < 76; p_ += 8) { const unsigned char* src_; \
            if (p_ < 68) src_ = rs_ + p_ * 1024 + lane * 16; \
            else { const int tk_ = 4 * (p_ - 68) + (lane >> 4);         \
                   src_ = ((c_) == 0 && tk_ < 16) ? (const unsigned char*)(F.H1B + (size_t)MR * D) + (lane & 15) * 16 \
                        : (const unsigned char*)(F.QFIZ + (size_t)row_of(b, (c_), tk_) * N1 + 8192 + h * 1024 + ds * 128) + (lane & 15) * 16; } \
            __builtin_amdgcn_global_load_lds((const unsigned*)src_, (LAS unsigned*)(st_ + p_ * 1024), 16, 0, 0); } } while (0)
        const int ycol = h * 1024 + ds * 128 + 16 * w + 4 * g;
        const f32x4 ng4 = *(const GAS f32x4*)(F.ng1 + ycol);
        const bf16* xz = F.QFIZ + (size_t)(b * SEQ - 32) * N1 + 16384 + ycol;
        v2u zc0 = (v2u){0u, 0u}, zc1 = zc0, zn0 = zc0, zn1 = zc0;
        if (VAR != 1) L1_DMA(0);
        for (int c = 0; c < NCH; ++c) {
            asm volatile("s_waitcnt vmcnt(0) lgkmcnt(0)" ::: "memory");
            __builtin_amdgcn_s_barrier();
            asm volatile("" ::: "memory");
            const LAS unsigned char* st = F.lds + (c & 1) * ST1;
            v4u qb[2][4], p0, p1;
            const unsigned sa = (unsigned)(size_t)st + lane * 16, sp = (unsigned)(size_t)(st + R1_P) + lane * 16;
#define DSR128(d_, a_, off_) asm volatile("ds_read_b128 %0, %1 offset:%2" : "=v"(d_) : "v"(a_), "n"(off_) : "memory")
#define LDQ(buf_, gi_) do { DSR128(qb[buf_][0], sa, R1_QD + (2 * (gi_)) * 1024); DSR128(qb[buf_][1], sa, R1_QD + (2 * (gi_) + 1) * 1024); \
                    DSR128(qb[buf_][2], sa, R1_QD + (16 + 2 * (gi_)) * 1024); DSR128(qb[buf_][3], sa, R1_QD + (16 + 2 * (gi_) + 1) * 1024); } while (0)
            DSR128(p0, sp, 0); DSR128(p1, sp, 1024);
            LDQ(0, 0);
            if (VAR != 1 && c + 1 < NCH) L1_DMA(c + 1);
            if (USE_FUSED_NORM && VAR == 0 && c >= 2 && w == 0 && lane < 32) {
                const LAS float* pp = (const LAS float*)(F.lds + SSP_OFF) + ((c - 1) & 1) * 256 + lane; float sm = 0.f;
#pragma unroll
                for (int ww = 0; ww < 8; ++ww) sm += pp[ww * 32];
                SS[(size_t)(b * SEQ + 32 * (c - 2) + lane) * 64 + h * 8 + ds] = sm; }
            if (USE_FUSED_NORM && c + 1 < NCH) { const bf16* zp = xz + (size_t)((c + 1) * 32 + r) * N1; zn0 = *(const GAS v2u*)zp; zn1 = *(const GAS v2u*)(zp + (size_t)16 * N1); }
            if (VAR == 2) continue;
            unsigned short vh[8];
#pragma unroll
            for (int e = 0; e < 8; ++e) vh[e] = *(const LAS unsigned short*)(st + R1_SH + (8 * g + e) * 256 + (16 * w + r) * 2);
            const bf16x8 vf = mk8(vh[0] | ((unsigned)vh[1] << 16), vh[2] | ((unsigned)vh[3] << 16), vh[4] | ((unsigned)vh[5] << 16), vh[6] | ((unsigned)vh[7] << 16));
#define SCHED_FENCE() __builtin_amdgcn_sched_barrier(0)
                v4u uk[2][4]; f32x4 ug[2][4];
                const unsigned sk = (unsigned)(size_t)st + lane * 16, sg = (unsigned)(size_t)(st + R1_GL) + g * 16;
#define LDU(buf_, gi_) do { _Pragma("unroll") for (int ml_ = 0; ml_ < 4; ++ml_) { } \
                    DSR128(uk[buf_][0], sk, R1_KD + (4 * (gi_) + 0) * 1024); DSR128(ug[buf_][0], sg, 64 * (4 * (gi_) + 0)); DSR128(uk[buf_][1], sk, R1_KD + (4 * (gi_) + 1) * 1024); DSR128(ug[buf_][1], sg, 64 * (4 * (gi_) + 1)); \
                    DSR128(uk[buf_][2], sk, R1_KD + (4 * (gi_) + 2) * 1024); DSR128(ug[buf_][2], sg, 64 * (4 * (gi_) + 2)); DSR128(uk[buf_][3], sk, R1_KD + (4 * (gi_) + 3) * 1024); DSR128(ug[buf_][3], sg, 64 * (4 * (gi_) + 3)); } while (0)
            if (c > 0) {
                f32x4 o0 = (f32x4){0.f, 0.f, 0.f, 0.f}, o1 = o0;
#define OGRP(GI) { if ((GI) < 7) LDQ(((GI) + 1) & 1, (GI) + 1); \
                    if ((GI) == 0) { asm volatile("s_waitcnt lgkmcnt(4)" : "+v"(p0), "+v"(p1), "+v"(qb[0][0]), "+v"(qb[0][1]), "+v"(qb[0][2]), "+v"(qb[0][3]) :: "memory"); \
                        o0 = MFMA16(vf, __builtin_bit_cast(bf16x8, p0), o0); o1 = MFMA16(vf, __builtin_bit_cast(bf16x8, p1), o1); }        \
                    else if ((GI) < 7) asm volatile("s_waitcnt lgkmcnt(4)" : "+v"(qb[(GI) & 1][0]), "+v"(qb[(GI) & 1][1]), "+v"(qb[(GI) & 1][2]), "+v"(qb[(GI) & 1][3]) :: "memory"); \
                    else asm volatile("s_waitcnt lgkmcnt(0)" : "+v"(qb[(GI) & 1][0]), "+v"(qb[(GI) & 1][1]), "+v"(qb[(GI) & 1][2]), "+v"(qb[(GI) & 1][3]) :: "memory"); \
                    _Pragma("unroll") for (int sl = 0; sl < 2; ++sl) { const int s2 = 2 * (GI) + sl; \
                        const bf16x8 sb = mk8(cvtpk(acc[2 * s2].x, acc[2 * s2].y), cvtpk(acc[2 * s2].z, acc[2 * s2].w), cvtpk(acc[2 * s2 + 1].x, acc[2 * s2 + 1].y), cvtpk(acc[2 * s2 + 1].z, acc[2 * s2 + 1].w)); \
                        o0 = MFMA16(sb, __builtin_bit_cast(bf16x8, qb[(GI) & 1][sl]), o0); o1 = MFMA16(sb, __builtin_bit_cast(bf16x8, qb[(GI) & 1][2 + sl]), o1); } }
                OGRP(0) OGRP(1) OGRP(2) OGRP(3) OGRP(4) OGRP(5) OGRP(6) OGRP(7)
#undef OGRP
#undef LDQ
                LDU(0, 0);
                if (VAR == 1) { asm volatile("" :: "v"(o0), "v"(o1)); } else if (USE_FUSED_NORM) {
                    float t0 = (o0.x * o0.x + o0.y * o0.y) + (o0.z * o0.z + o0.w * o0.w), t1 = (o1.x * o1.x + o1.y * o1.y) + (o1.z * o1.z + o1.w * o1.w);
                    t0 += __shfl_xor(t0, 16); t1 += __shfl_xor(t1, 16); t0 += __shfl_xor(t0, 32); t1 += __shfl_xor(t1, 32);
                    const int row0 = b * SEQ + 32 * (c - 1) + r;
                    if (g == 0) { LAS float* pp = (LAS float*)(F.lds + SSP_OFF) + ((c & 1) * 8 + w) * 32; pp[r] = t0; pp[16 + r] = t1; }
                    const float y0 = o0.x * ng4.x * silu(bflo(zc0.x)), y1 = o0.y * ng4.y * silu(bfhi(zc0.x)), y2 = o0.z * ng4.z * silu(bflo(zc0.y)), y3 = o0.w * ng4.w * silu(bfhi(zc0.y));
                    const float y4 = o1.x * ng4.x * silu(bflo(zc1.x)), y5 = o1.y * ng4.y * silu(bfhi(zc1.x)), y6 = o1.z * ng4.z * silu(bflo(zc1.y)), y7 = o1.w * ng4.w * silu(bfhi(zc1.y));
                    bf16* op = F.Y + (size_t)row0 * DI + ycol;
                    *(GAS v2u*)op = (v2u){cvtpk(y0, y1), cvtpk(y2, y3)}; *(GAS v2u*)(op + (size_t)16 * DI) = (v2u){cvtpk(y4, y5), cvtpk(y6, y7)};
                } else {
                    bf16* op = (bf16*)O1 + (size_t)(b * SEQ + 32 * (c - 1) + r) * DI + h * 1024 + ds * 128 + 16 * w + 4 * g;
                    *(GAS v2u*)op = (v2u){pk2(o0.x, o0.y), pk2(o0.z, o0.w)}; *(GAS v2u*)(op + (size_t)16 * DI) = (v2u){pk2(o1.x, o1.y), pk2(o1.z, o1.w)}; }
            } else { LDU(0, 0); }
            {
#define SGRP(GI) { if ((GI) < 7) { LDU(((GI) + 1) & 1, (GI) + 1); \
                        asm volatile("s_waitcnt lgkmcnt(8)" : "+v"(uk[(GI) & 1][0]), "+v"(uk[(GI) & 1][1]), "+v"(uk[(GI) & 1][2]), "+v"(uk[(GI) & 1][3]), "+v"(ug[(GI) & 1][0]), "+v"(ug[(GI) & 1][1]), "+v"(ug[(GI) & 1][2]), "+v"(ug[(GI) & 1][3]) :: "memory"); } \
                    else asm volatile("s_waitcnt lgkmcnt(0)" : "+v"(uk[(GI) & 1][0]), "+v"(uk[(GI) & 1][1]), "+v"(uk[(GI) & 1][2]), "+v"(uk[(GI) & 1][3]), "+v"(ug[(GI) & 1][0]), "+v"(ug[(GI) & 1][1]), "+v"(ug[(GI) & 1][2]), "+v"(ug[(GI) & 1][3]) :: "memory"); \
                    _Pragma("unroll") for (int ml = 0; ml < 4; ++ml) { const int m = 4 * (GI) + ml; acc[m] = MFMA16(__builtin_bit_cast(bf16x8, uk[(GI) & 1][ml]), vf, acc[m] * ug[(GI) & 1][ml]); } }
                SGRP(0) SGRP(1) SGRP(2) SGRP(3) SGRP(4) SGRP(5) SGRP(6) SGRP(7)
#undef SGRP
#undef LDU
#undef DSR128
            }
            if (USE_FUSED_NORM) { zc0 = zn0; zc1 = zn1; }
        }
#undef L1_DMA
        if (VAR == 1) { _Pragma("unroll") for (int m = 0; m < 32; ++m) asm volatile("" :: "v"(acc[m])); }
        asm volatile("s_waitcnt vmcnt(0) lgkmcnt(0)" ::: "memory");
        __builtin_amdgcn_s_barrier();
        if (USE_FUSED_NORM && VAR == 0 && w == 0 && lane < 32) {
            const LAS float* pp = (const LAS float*)(F.lds + SSP_OFF) + ((NCH - 1) & 1) * 256 + lane; float sm = 0.f;
#pragma unroll
            for (int ww = 0; ww < 8; ++ww) sm += pp[ww * 32];
            SS[(size_t)(b * SEQ + 32 * (NCH - 2) + lane) * 64 + h * 8 + ds] = sm; }
        asm volatile("s_waitcnt vmcnt(0) lgkmcnt(0)" ::: "memory");
    }
}

constexpr int R2_QD = 0, R2_KD = 32768, R2_P = 65536, R2_GL = 67584, ST2 = 69632, X2_OFF = 2 * ST2;
DI_ void l1_seq2(Frame& F, const unsigned char* REC1, const unsigned char* VF1, float* SS) {
    const int lane = F.lane, w = F.wave, r = lane & 15, g = lane >> 4, dkh = w >> 2, dvq = w & 3;
    for (int u = F.vcu; u < NB * GL_H * 8; u += F.G) {
        const int bh = u >> 3, ds = u & 7, b = bh >> 3, h = bh & 7;
        f32x4 acc[16][2];
#pragma unroll
        for (int m = 0; m < 16; ++m) { acc[m][0] = (f32x4){0.f, 0.f, 0.f, 0.f}; acc[m][1] = acc[m][0]; }
        const int ycol = h * 1024 + ds * 128 + 32 * dvq + 16 * dkh + 4 * g;
        const f32x4 ng4 = *(const GAS f32x4*)(F.ng1 + ycol);
        const bf16* xz = F.QFIZ + (size_t)(b * SEQ - 32) * N1 + 16384 + ycol;
        const unsigned char* vfb = VF1 + ((size_t)bh * NCH * 64 + ds * 8 + 2 * dvq) * 1024 + lane * 16;
#define L2_DMA(c_) do { const unsigned char* rs_ = REC1 + (size_t)(bh * NCH + (c_)) * R1_SH; LAS unsigned char* st_ = F.lds + ((c_) & 1) * ST2; \
        _Pragma("unroll") for (int i_ = 0; i_ < 8; ++i_) { const int p_ = w + 8 * i_; __builtin_amdgcn_global_load_lds((const unsigned*)(rs_ + p_ * 1024 + lane * 16), (LAS unsigned*)(st_ + p_ * 1024), 16, 0, 0); } \
        if (w < 4) __builtin_amdgcn_global_load_lds((const unsigned*)(rs_ + (w + 64) * 1024 + lane * 16), (LAS unsigned*)(st_ + (w + 64) * 1024), 16, 0, 0); } while (0)
        v4u vfr[2][2];
        v2u zr[2][2];
        f32x4 keep[2][2];
        vfr[0][0] = *(const GAS v4u*)(vfb); vfr[0][1] = *(const GAS v4u*)(vfb + 1024);
        zr[0][0] = (v2u){0u, 0u}; zr[0][1] = zr[0][0];
        L2_DMA(0);
#define L2_BODY(C_, PAR) do { const int c = (C_); \
            asm volatile("s_waitcnt vmcnt(0) lgkmcnt(0)" ::: "memory"); \
            __builtin_amdgcn_s_barrier(); \
            asm volatile("" ::: "memory"); \
            if (c >= 3 && c <= NCH + 1 && w == 0 && lane < 32) {                  \
                const LAS float* pp = (const LAS float*)(F.lds + SSP_OFF) + PAR * 256 + lane; float sm = 0.f; \
                _Pragma("unroll") for (int ww = 0; ww < 8; ++ww) sm += pp[ww * 32]; \
                SS[(size_t)(b * SEQ + 32 * (c - 3) + lane) * 64 + h * 8 + ds] = sm; } \
            if (c >= 2 && c <= NCH) {                                  \
                const v4u px = *(const LAS v4u*)(F.lds + X2_OFF + (PAR ^ 1) * 8192 + (w ^ 4) * 1024 + lane * 16); \
                const f32x4 a0 = keep[PAR ^ 1][0] + (f32x4){bflo(px.x), bfhi(px.x), bflo(px.y), bfhi(px.y)}, a1 = keep[PAR ^ 1][1] + (f32x4){bflo(px.z), bfhi(px.z), bflo(px.w), bfhi(px.w)}; \
                float t0 = (a0.x * a0.x + a0.y * a0.y) + (a0.z * a0.z + a0.w * a0.w), t1 = (a1.x * a1.x + a1.y * a1.y) + (a1.z * a1.z + a1.w * a1.w); \
                t0 += __shfl_xor(t0, 16); t1 += __shfl_xor(t1, 16); t0 += __shfl_xor(t0, 32); t1 += __shfl_xor(t1, 32); \
                if (g == 0) { LAS float* pp = (LAS float*)(F.lds + SSP_OFF) + ((PAR ^ 1) * 8 + w) * 32; pp[r] = t0; pp[16 + r] = t1; } \
                const v2u z0 = zr[PAR ^ 1][0], z1 = zr[PAR ^ 1][1]; \
                bf16* op = F.Y + (size_t)(b * SEQ + 32 * (c - 2) + r) * DI + ycol; \
                *(GAS v2u*)op = (v2u){cvtpk(a0.x * ng4.x * silu(bflo(z0.x)), a0.y * ng4.y * silu(bfhi(z0.x))), cvtpk(a0.z * ng4.z * silu(bflo(z0.y)), a0.w * ng4.w * silu(bfhi(z0.y)))}; \
                *(GAS v2u*)(op + (size_t)16 * DI) = (v2u){cvtpk(a1.x * ng4.x * silu(bflo(z1.x)), a1.y * ng4.y * silu(bfhi(z1.x))), cvtpk(a1.z * ng4.z * silu(bflo(z1.y)), a1.w * ng4.w * silu(bfhi(z1.y)))}; } \
            if (c + 1 < NCH) {                                         \
                vfr[PAR ^ 1][0] = *(const GAS v4u*)(vfb + (size_t)(c + 1) * 65536); vfr[PAR ^ 1][1] = *(const GAS v4u*)(vfb + (size_t)(c + 1) * 65536 + 1024); \
                { const bf16* zp = xz + (size_t)((c + 1) * 32 + r) * N1; zr[PAR ^ 1][0] = *(const GAS v2u*)zp; zr[PAR ^ 1][1] = *(const GAS v2u*)(zp + (size_t)16 * N1); } \
                L2_DMA(c + 1); } \
            if (c < NCH) { \
                const LAS unsigned char* st = F.lds + (c & 1) * ST2; \
                bf16x8 vf[2]; vf[0] = __builtin_bit_cast(bf16x8, vfr[PAR][0]); vf[1] = __builtin_bit_cast(bf16x8, vfr[PAR][1]); \
                const LAS f32x4* glp = (const LAS f32x4*)(st + R2_GL + (256 * dkh + 4 * g) * 4); \
                f32x4 ug[2][2]; bf16x8 uk[2][2]; \
                if (c > 0) { \
                    f32x4 o[2][2]; \
                    _Pragma("unroll") for (int ti = 0; ti < 2; ++ti) { o[ti][0] = (f32x4){0.f, 0.f, 0.f, 0.f}; o[ti][1] = o[ti][0]; } \
                    if (dkh == 0) { const bf16x8 p0 = *(const LAS bf16x8*)(st + R2_P + lane * 16), p1 = *(const LAS bf16x8*)(st + R2_P + 1024 + lane * 16); \
                        o[0][0] = MFMA16(vf[0], p0, o[0][0]); o[0][1] = MFMA16(vf[1], p0, o[0][1]); o[1][0] = MFMA16(vf[0], p1, o[1][0]); o[1][1] = MFMA16(vf[1], p1, o[1][1]); } \
                    bf16x8 qb[2][2]; \
                    qb[0][0] = *(const LAS bf16x8*)(st + R2_QD + (8 * dkh) * 1024 + lane * 16); qb[0][1] = *(const LAS bf16x8*)(st + R2_QD + (16 + 8 * dkh) * 1024 + lane * 16); \
                    SCHED_FENCE(); \
                    _Pragma("unroll") for (int s2 = 0; s2 < 8; ++s2) { \
                        if (s2 < 7) { qb[(s2 + 1) & 1][0] = *(const LAS bf16x8*)(st + R2_QD + (8 * dkh + s2 + 1) * 1024 + lane * 16); qb[(s2 + 1) & 1][1] = *(const LAS bf16x8*)(st + R2_QD + (16 + 8 * dkh + s2 + 1) * 1024 + lane * 16); } \
                        SCHED_FENCE(); \
                        _Pragma("unroll") for (int t_ = 0; t_ < 2; ++t_) { \
                            const bf16x8 sb = mk8(cvtpk(acc[2 * s2][t_].x, acc[2 * s2][t_].y), cvtpk(acc[2 * s2][t_].z, acc[2 * s2][t_].w), cvtpk(acc[2 * s2 + 1][t_].x, acc[2 * s2 + 1][t_].y), cvtpk(acc[2 * s2 + 1][t_].z, acc[2 * s2 + 1][t_].w)); \
                            o[0][t_] = MFMA16(sb, qb[s2 & 1][0], o[0][t_]); o[1][t_] = MFMA16(sb, qb[s2 & 1][1], o[1][t_]); } \
                        SCHED_FENCE(); \
                    } \
                    { const f32x4 s0 = o[0][dkh ^ 1], s1 = o[1][dkh ^ 1];                    \
                      *(LAS v4u*)(F.lds + X2_OFF + PAR * 8192 + w * 1024 + lane * 16) = (v4u){pk2(s0.x, s0.y), pk2(s0.z, s0.w), pk2(s1.x, s1.y), pk2(s1.z, s1.w)}; \
                      keep[PAR][0] = o[0][dkh]; keep[PAR][1] = o[1][dkh]; } \
                } \
                _Pragma("unroll") for (int ml_ = 0; ml_ < 2; ++ml_) { ug[0][ml_] = glp[4 * ml_]; uk[0][ml_] = *(const LAS bf16x8*)(st + R2_KD + (16 * dkh + ml_) * 1024 + lane * 16); } \
                SCHED_FENCE(); \
                _Pragma("unroll") for (int gi = 0; gi < 8; ++gi) { \
                    if (gi < 7) { _Pragma("unroll") for (int ml_ = 0; ml_ < 2; ++ml_) { const int m_ = 2 * (gi + 1) + ml_; ug[(gi + 1) & 1][ml_] = glp[4 * m_]; uk[(gi + 1) & 1][ml_] = *(const LAS bf16x8*)(st + R2_KD + (16 * dkh + m_) * 1024 + lane * 16); } } \
                    SCHED_FENCE(); \
                    _Pragma("unroll") for (int ml = 0; ml < 2; ++ml) { const int m = 2 * gi + ml; \
                        acc[m][0] = MFMA16(uk[gi & 1][ml], vf[0], acc[m][0] * ug[gi & 1][ml]); acc[m][1] = MFMA16(uk[gi & 1][ml], vf[1], acc[m][1] * ug[gi & 1][ml]); } \
                    SCHED_FENCE(); \
                } \
            } \
            asm volatile("" : "+v"(vfr[PAR ^ 1][0]), "+v"(vfr[PAR ^ 1][1]), "+v"(zr[PAR ^ 1][0]), "+v"(zr[PAR ^ 1][1]));        \
        } while (0)
        for (int c2 = 0; c2 <= NCH + 1; c2 += 2) { L2_BODY(c2, 0); L2_BODY(c2 + 1, 1); }
#undef L2_BODY
#undef L2_DMA
        asm volatile("s_waitcnt vmcnt(0) lgkmcnt(0)" ::: "memory");
        __builtin_amdgcn_s_barrier();
    }
}

DI_ void l0_prep(Frame& F, unsigned char* REC0) {
    const int lane = F.lane, w = F.wave, r = lane & 15, g = lane >> 4;
    LAS unsigned char* T = F.lds + w * 16640;
    LAS unsigned char* Tv = T + 8192;
    const int gw = F.vcu * NWAVES + w, NGW = F.G * NWAVES;
    for (int it = gw; it < NB * HG_H * NCH; it += NGW) {
        const int bh = it / NCH, c = it - bh * NCH, b = bh >> 6, h = bh & 63;
        unsigned char* rec = REC0 + (size_t)it * R0_SZ;
        int row[2]; bool nul[2];
#pragma unroll
        for (int ti = 0; ti < 2; ++ti) { const int tok = 16 * ti + r; nul[ti] = (c == 0 && tok < 16); row[ti] = nul[ti] ? 0 : row_of(b, c, tok); }
        f32x4 pacc[3];
#pragma unroll
        for (int t = 0; t < 3; ++t) pacc[t] = (f32x4){0.f, 0.f, 0.f, 0.f};
        v4u qraw[4][2], fraw[4][2], vraw[8];
#pragma unroll
        for (int s = 0; s < 4; ++s)
#pragma unroll
            for (int ti = 0; ti < 2; ++ti) { const bf16* rp = F.QFIZ + (size_t)row[ti] * N0 + h * 128 + 32 * s + 8 * g; qraw[s][ti] = *(const GAS v4u*)rp; fraw[s][ti] = *(const GAS v4u*)(rp + DI); }
#pragma unroll
        for (int i = 0; i < 8; ++i) { const int q = lane + 64 * i, tk = q >> 4, c16 = q & 15; const bool nl = (c == 0 && tk < 16);
            vraw[i] = (v4u){0u, 0u, 0u, 0u}; if (!nl) vraw[i] = *(const GAS v4u*)(F.QFIZ + (size_t)row_of(b, c, tk) * N0 + 2 * DI + h * 128 + 8 * c16); }
        asm volatile("" ::: "memory");
#pragma unroll
        for (int s = 0; s < 4; ++s) {
            const int col = h * 128 + 32 * s + 8 * g;
            float lbv[8], bfv[8];
            { const f32x4 a0 = *(const GAS f32x4*)(F.LB0 + col), a1 = *(const GAS f32x4*)(F.LB0 + col + 4), c0 = *(const GAS f32x4*)(F.b_f + col), c1 = *(const GAS f32x4*)(F.b_f + col + 4);
              lbv[0] = a0.x; lbv[1] = a0.y; lbv[2] = a0.z; lbv[3] = a0.w; lbv[4] = a1.x; lbv[5] = a1.y; lbv[6] = a1.z; lbv[7] = a1.w;
              bfv[0] = c0.x; bfv[1] = c0.y; bfv[2] = c0.z; bfv[3] = c0.w; bfv[4] = c1.x; bfv[5] = c1.y; bfv[6] = c1.z; bfv[7] = c1.w; }
            float qv[2][8], fv[2][8];
#pragma unroll
            for (int ti = 0; ti < 2; ++ti) {
                const v4u q4 = qraw[s][ti], f4 = fraw[s][ti];
                qv[ti][0] = bflo(q4.x); qv[ti][1] = bfhi(q4.x); qv[ti][2] = bflo(q4.y); qv[ti][3] = bfhi(q4.y); qv[ti][4] = bflo(q4.z); qv[ti][5] = bfhi(q4.z); qv[ti][6] = bflo(q4.w); qv[ti][7] = bfhi(q4.w);
                fv[ti][0] = bflo(f4.x); fv[ti][1] = bfhi(f4.x); fv[ti][2] = bflo(f4.y); fv[ti][3] = bfhi(f4.y); fv[ti][4] = bflo(f4.z); fv[ti][5] = bfhi(f4.z); fv[ti][6] = bflo(f4.w); fv[ti][7] = bfhi(f4.w);
            }
            unsigned qd[2][4], ki[2][4], kd[2][4]; float gl[8];
#pragma unroll
            for (int e = 0; e < 8; e += 2) {
                float bb[2][2], BB[2], kk[2][2];
#pragma unroll
                for (int u = 0; u < 2; ++u) {
                    const float fg0 = lbv[e + u] + (1.f - lbv[e + u]) * sigm(fv[0][e + u] + bfv[e + u]);
                    const float fg1 = lbv[e + u] + (1.f - lbv[e + u]) * sigm(fv[1][e + u] + bfv[e + u]);
                    const float L0 = nul[0] ? 0.f : lg2(fg0), L1 = nul[1] ? 0.f : lg2(fg1);
                    kk[0][u] = nul[0] ? 0.f : 1.f - fg0; kk[1][u] = nul[1] ? 0.f : 1.f - fg1;
                    const float b0 = scan16(L0);
                    const float b1 = scan16(L1) + bcast15(b0);
                    bb[0][u] = b0; bb[1][u] = b1; BB[u] = bcast15(b1);
                    gl[e + u] = ex2(BB[u]);
                }
#pragma unroll
                for (int ti = 0; ti < 2; ++ti) {
                    const float q0 = nul[ti] ? 0.f : silu(qv[ti][e]), q1 = nul[ti] ? 0.f : silu(qv[ti][e + 1]);
                    qd[ti][e >> 1] = cvtpk(q0 * ex2(bb[ti][0]), q1 * ex2(bb[ti][1]));
                    ki[ti][e >> 1] = cvtpk(kk[ti][0] * ex2(-bb[ti][0]), kk[ti][1] * ex2(-bb[ti][1]));
                    kd[ti][e >> 1] = cvtpk(kk[ti][0] * ex2(BB[0] - bb[ti][0]), kk[ti][1] * ex2(BB[1] - bb[ti][1]));
                }
            }
            const bf16x8 qf0 = mk8(qd[0][0], qd[0][1], qd[0][2], qd[0][3]), qf1 = mk8(qd[1][0], qd[1][1], qd[1][2], qd[1][3]);
            const bf16x8 kf0 = mk8(ki[0][0], ki[0][1], ki[0][2], ki[0][3]), kf1 = mk8(ki[1][0], ki[1][1], ki[1][2], ki[1][3]);
            pacc[0] = MFMA16(kf0, qf0, pacc[0]);
            pacc[1] = MFMA16(kf0, qf1, pacc[1]);
            pacc[2] = MFMA16(kf1, qf1, pacc[2]);
#pragma unroll
            for (int ti = 0; ti < 2; ++ti)
#pragma unroll
                for (int h2 = 0; h2 < 2; ++h2) {
                    const int lp = (2 * (g & 1) + h2) * 16 + r;
                    v2u d; d.x = qd[ti][2 * h2]; d.y = qd[ti][2 * h2 + 1];
                    *(GAS v2u*)(rec + R0_QD + ((ti * 4 + s) * 64 + lp) * 16 + (g >> 1) * 8) = d;
                }
#pragma unroll
            for (int ti = 0; ti < 2; ++ti)
#pragma unroll
                for (int e = 0; e < 8; ++e) {
                    const unsigned wd = kd[ti][e >> 1]; const unsigned short hv = (e & 1) ? (unsigned short)(wd >> 16) : (unsigned short)(wd & 0xffffu);
                    *(LAS unsigned short*)(T + (32 * s + 8 * g + e) * 64 + (16 * ti + r) * 2) = hv;
                }
            if (r == 0) { *(GAS f32x4*)(rec + R0_GL + (32 * s + 8 * g) * 4) = (f32x4){gl[0], gl[1], gl[2], gl[3]}; *(GAS f32x4*)(rec + R0_GL + (32 * s + 8 * g + 4) * 4) = (f32x4){gl[4], gl[5], gl[6], gl[7]}; }
        }
#pragma unroll
        for (int t = 0; t < 4; ++t) {
            const int tj = (t >= 2) ? 1 : 0, ti = (t == 1 || t == 2) ? 1 : 0;
            float pv[4] = {0.f, 0.f, 0.f, 0.f};
            if (t < 3) { pv[0] = pacc[t].x; pv[1] = pacc[t].y; pv[2] = pacc[t].z; pv[3] = pacc[t].w; }
#pragma unroll
            for (int jj = 0; jj < 4; ++jj) { const int j = 16 * tj + 4 * g + jj, i = 16 * ti + r; if (j > i) pv[jj] = 0.f; }
            const int lp = (2 * tj + (g >> 1)) * 16 + r;
            v2u d; d.x = cvtpk(pv[0], pv[1]); d.y = cvtpk(pv[2], pv[3]);
            *(GAS v2u*)(rec + R0_P + (ti * 64 + lp) * 16 + 8 * (g & 1)) = d;
        }
#pragma unroll
        for (int i = 0; i < 8; ++i) {
            const int q = lane + 64 * i, tk = q >> 4, c16 = q & 15; const v4u d = vraw[i];
            *(LAS v2u*)(Tv + tk * 264 + c16 * 16) = (v2u){d.x, d.y}; *(LAS v2u*)(Tv + tk * 264 + c16 * 16 + 8) = (v2u){d.z, d.w};
        }
        LDS_WAIT(); asm volatile("" ::: "memory");
#pragma unroll
        for (int mt = 0; mt < 8; ++mt) { const v4u d = *(const LAS v4u*)(T + (16 * mt + r) * 64 + 16 * g); *(GAS v4u*)(rec + R0_KD + (mt * 64 + lane) * 16) = d; }
#pragma unroll
        for (int sl = 0; sl < 8; ++sl) {
            unsigned short hv[8];
#pragma unroll
            for (int e = 0; e < 8; ++e) hv[e] = *(const LAS unsigned short*)(Tv + (8 * g + e) * 264 + (16 * sl + r) * 2);
            v4u d; d.x = hv[0] | ((unsigned)hv[1] << 16); d.y = hv[2] | ((unsigned)hv[3] << 16); d.z = hv[4] | ((unsigned)hv[5] << 16); d.w = hv[6] | ((unsigned)hv[7] << 16);
            *(GAS v4u*)(rec + R0_V + (sl * 64 + lane) * 16) = d;
        }
        LDS_WAIT(); asm volatile("" ::: "memory");
    }
}

DI_ void l0_seq(Frame& F, const unsigned char* REC0) {
    const int lane = F.lane, w = F.wave, r = lane & 15, g = lane >> 4;
    LAS float* obuf = (LAS float*)(F.lds + 2 * ST0);
    constexpr int OB = 32 * 132;
    for (int u = F.vcu; u < NB * HG_H; u += F.G) {
        const int bh = u, b = bh >> 6, h = bh & 63;
        f32x4 acc[8];
#pragma unroll
        for (int m = 0; m < 8; ++m) acc[m] = (f32x4){0.f, 0.f, 0.f, 0.f};
        const int ntok = 4 * w + g, ndv = 8 * r;
        float ngv[8];
        { const f32x4 a0 = *(const GAS f32x4*)(F.ng0 + h * 128 + ndv), a1 = *(const GAS f32x4*)(F.ng0 + h * 128 + ndv + 4);
          ngv[0] = a0.x; ngv[1] = a0.y; ngv[2] = a0.z; ngv[3] = a0.w; ngv[4] = a1.x; ngv[5] = a1.y; ngv[6] = a1.z; ngv[7] = a1.w; }
#define L0_DMA(c_) do { const unsigned char* rs_ = REC0 + (size_t)(bh * NCH + (c_)) * R0_SZ; LAS unsigned char* st_ = F.lds + ((c_) & 1) * ST0; \
        for (int p_ = w; p_ < 27; p_ += 8) __builtin_amdgcn_global_load_lds((const unsigned*)(rs_ + p_ * 1024 + lane * 16), (LAS unsigned*)(st_ + p_ * 1024), 16, 0, 0); } while (0)
        L0_DMA(0);
        v4u zprev = (v4u){0u, 0u, 0u, 0u};
        for (int c = 0; c <= NCH; ++c) {
            asm volatile("s_waitcnt vmcnt(0)" ::: "memory");
            __builtin_amdgcn_s_barrier();
            asm volatile("" ::: "memory");
            if (c + 1 < NCH) L0_DMA(c + 1);
            v4u zcur = (v4u){0u, 0u, 0u, 0u};
            const bool zvalid = (c < NCH) && !(c == 0 && ntok < 16);
            if (zvalid) zcur = *(const GAS v4u*)(F.QFIZ + (size_t)row_of(b, c, ntok) * N0 + 3 * DI + h * 128 + ndv);
            if (c >= 1) {
                const int cp = c - 1;
                const LAS float* ob = obuf + (cp & 1) * OB + ntok * 132 + ndv;
                const f32x4 x0 = *(const LAS f32x4*)(ob), x1 = *(const LAS f32x4*)(ob + 4);
                float ss = (x0.x * x0.x + x0.y * x0.y) + (x0.z * x0.z + x0.w * x0.w) + (x1.x * x1.x + x1.y * x1.y) + (x1.z * x1.z + x1.w * x1.w);
                ss += __shfl_xor(ss, 8); ss += __shfl_xor(ss, 4); ss += __shfl_xor(ss, 2); ss += __shfl_xor(ss, 1);
                const float rs = rsqrtf(ss * (1.f / 128.f) + RMS_EPS);
                const bool wr = !(cp == 0 && (ntok < 16 || b != 0));
                if (wr) {
                    v4u d;
                    d.x = cvtpk(x0.x * rs * ngv[0] * silu(bflo(zprev.x)), x0.y * rs * ngv[1] * silu(bfhi(zprev.x)));
                    d.y = cvtpk(x0.z * rs * ngv[2] * silu(bflo(zprev.y)), x0.w * rs * ngv[3] * silu(bfhi(zprev.y)));
                    d.z = cvtpk(x1.x * rs * ngv[4] * silu(bflo(zprev.z)), x1.y * rs * ngv[5] * silu(bfhi(zprev.z)));
                    d.w = cvtpk(x1.z * rs * ngv[6] * silu(bflo(zprev.w)), x1.w * rs * ngv[7] * silu(bfhi(zprev.w)));
                    *(GAS v4u*)(F.Y + (size_t)row_of(b, cp, ntok) * DI + h * 128 + ndv) = d;
                }
            }
            zprev = zcur;
            if (c < NCH) {
                const LAS unsigned char* st = F.lds + (c & 1) * ST0;
                const bf16x8 vf = *(const LAS bf16x8*)(st + R0_V + w * 1024 + lane * 16);
                const bf16x8 p0 = *(const LAS bf16x8*)(st + R0_P + lane * 16), p1 = *(const LAS bf16x8*)(st + R0_P + 1024 + lane * 16);
                bf16x8 qf[8], kf[8]; f32x4 gf[8];
#pragma unroll
                for (int q = 0; q < 8; ++q) qf[q] = *(const LAS bf16x8*)(st + R0_QD + q * 1024 + lane * 16);
#pragma unroll
                for (int m = 0; m < 8; ++m) { gf[m] = *(const LAS f32x4*)(st + R0_GL + (16 * m + 4 * g) * 4); kf[m] = *(const LAS bf16x8*)(st + R0_KD + m * 1024 + lane * 16); }
                SCHED_FENCE();
                f32x4 o0 = (f32x4){0.f, 0.f, 0.f, 0.f}, o1 = o0;
                o0 = MFMA16(vf, p0, o0); o1 = MFMA16(vf, p1, o1);
#pragma unroll
                for (int s2 = 0; s2 < 4; ++s2) {
                    const bf16x8 sb = mk8(cvtpk(acc[2 * s2].x, acc[2 * s2].y), cvtpk(acc[2 * s2].z, acc[2 * s2].w), cvtpk(acc[2 * s2 + 1].x, acc[2 * s2 + 1].y), cvtpk(acc[2 * s2 + 1].z, acc[2 * s2 + 1].w));
                    o0 = MFMA16(sb, qf[s2], o0); o1 = MFMA16(sb, qf[4 + s2], o1);
                }
#pragma unroll
                for (int m = 0; m < 8; ++m) acc[m] = MFMA16(kf[m], vf, acc[m] * gf[m]);
                LAS float* ow = obuf + (c & 1) * OB + r * 132 + 16 * w + 4 * g;
                *(LAS f32x4*)ow = o0; *(LAS f32x4*)(ow + 16 * 132) = o1;
                asm volatile("s_waitcnt lgkmcnt(0)" ::: "memory");
            }
        }
#undef L0_DMA
        asm volatile("s_waitcnt vmcnt(0)" ::: "memory");
        __builtin_amdgcn_s_barrier();
    }
}

template <int KS, int MODE>
DI_ void skinny(Frame& F, const bf16* A, const bf16* Bt, int K, int n_first, int n_slices, bf16* Ob, int ldo, float* Of, const float* res) {
    const int lane = F.lane, w = F.wave, r = lane & 15, g = lane >> 4;
    constexpr int SPB = 8 / KS;
    const int kw = w % KS, sw = w / KS, klen = K / KS, kbeg = kw * klen;
    LAS f32x4* red = (LAS f32x4*)F.lds;
    for (int p = F.vcu; p * SPB < n_slices; p += F.G) {
        const int sl = p * SPB + sw, n0 = n_first + 16 * sl;
        f32x4 acc = (f32x4){0.f, 0.f, 0.f, 0.f};
        if (sl < n_slices) {
            const GAS v4u* bp = (const GAS v4u*)(Bt + (size_t)(n0 + r) * K + kbeg + 16 * g);
            const GAS v4u* ap = (const GAS v4u*)(A + (size_t)r * K + kbeg + 16 * g);
            for (int kk = 0; kk < klen; kk += 256) {
                v4u bv[8], av[8];
#pragma unroll
                for (int u = 0; u < 4; ++u) { bv[2 * u] = bp[(kk + 64 * u) / 8]; bv[2 * u + 1] = bp[(kk + 64 * u) / 8 + 1]; av[2 * u] = ap[(kk + 64 * u) / 8]; av[2 * u + 1] = ap[(kk + 64 * u) / 8 + 1]; }
                asm volatile("" ::: "memory");
#pragma unroll
                for (int u = 0; u < 8; ++u) acc = MFMA16(__builtin_bit_cast(bf16x8, bv[u]), __builtin_bit_cast(bf16x8, av[u]), acc);
            }
        }
        if (KS > 1) {
            red[w * 64 + lane] = acc;
            __syncthreads();
            if (kw == 0) {
#pragma unroll
                for (int j = 1; j < KS; ++j) acc += red[(w + j) * 64 + lane];
            }
        }
        if (kw == 0 && sl < n_slices) {
            if (MODE == 0) { v2u d; d.x = pk2(acc.x, acc.y); d.y = pk2(acc.z, acc.w); *(GAS v2u*)(Ob + (size_t)r * ldo + n0 + 4 * g) = d; }
            else { const f32x4 rv = *(const GAS f32x4*)(res + (size_t)r * D + n0 + 4 * g); *(GAS f32x4*)(Of + (size_t)r * D + n0 + 4 * g) = rv * ALPHA + acc; }
        }
        if (KS > 1) __syncthreads();
    }
    asm volatile("s_waitcnt vmcnt(0)" ::: "memory");
}

DI_ void gate_proj(Frame& F, const bf16* WG1T  ) {
    const int lane = F.lane, w = F.wave, r = lane & 15, g = lane >> 4, kw = w & 3, sw = w >> 2;
    LAS f32x4* red = (LAS f32x4*)F.lds;
    for (int p = F.vcu; 2 * p < MR / 16; p += F.G) {
        const int t = 2 * p + sw;
        f32x4 acc = (f32x4){0.f, 0.f, 0.f, 0.f};
        if (t < MR / 16) {
            const GAS v4u* wp = (const GAS v4u*)(WG1T + (size_t)r * D + 1024 * kw + 16 * g);
            const GAS v4u* hp = (const GAS v4u*)(F.H1B + (size_t)(16 * t + r) * D + 1024 * kw + 16 * g);
            for (int kk = 0; kk < 1024; kk += 256) {
                v4u wv[8], hv[8];
#pragma unroll
                for (int u = 0; u < 4; ++u) { wv[2 * u] = wp[(kk + 64 * u) / 8]; wv[2 * u + 1] = wp[(kk + 64 * u) / 8 + 1]; hv[2 * u] = hp[(kk + 64 * u) / 8]; hv[2 * u + 1] = hp[(kk + 64 * u) / 8 + 1]; }
                asm volatile("" ::: "memory");
#pragma unroll
                for (int u = 0; u < 8; ++u) acc = MFMA16(__builtin_bit_cast(bf16x8, wv[u]), __builtin_bit_cast(bf16x8, hv[u]), acc);
            }
        }
        red[w * 64 + lane] = acc;
        __syncthreads();
        if (kw == 0 && t < MR / 16) {
            acc += red[(w + 1) * 64 + lane]; acc += red[(w + 2) * 64 + lane]; acc += red[(w + 3) * 64 + lane];
            *(GAS f32x4*)(F.G1 + (size_t)(16 * t + r) * GL_R + 4 * g) = acc;
        }
        __syncthreads();
    }
    asm volatile("s_waitcnt vmcnt(0)" ::: "memory");
}

#ifndef USE_AUX
#define USE_AUX 0
#endif
struct AuxT { const float* src; bf16* dst; int N, K; };
DI_ AuxT aux_decode(Frame& F, int it, unsigned char* dummy) {
    constexpr int I_1 = (DI / 64) * (D / 32), I_2 = (D / 64) * (N1 / 32), I_3 = I_1, AUX_ITERS = (I_1 + I_2 + I_3) / (256 * NWAVES);
    static_assert((I_1 + I_2 + I_3) % (256 * NWAVES) == 0, "aux tiles divide over the waves");
    const int gw = F.vcu * NWAVES + F.wave;
    AuxT t;
    if (it >= AUX_ITERS || F.G != 256) { t.src = (const float*)(dummy + (size_t)gw * 8192); t.dst = (bf16*)(dummy + 32 * MiB + (size_t)gw * 8192); t.N = 32; t.K = 64; return t; }
    int r_ = it * (256 * NWAVES) + gw; const float* W; bf16* WT; int K, N;
    if (r_ < I_1) { W = F.w0out; WT = F.WT0OUT; K = DI; N = D; }
    else if (r_ < I_1 + I_2) { r_ -= I_1; W = F.w1in; WT = F.WT1IN; K = D; N = N1; }
    else { r_ -= I_1 + I_2; W = F.w1out; WT = F.WT1OUT; K = DI; N = D; }
    const int nblk = N / 32, kb = r_ / nblk, nb = r_ - kb * nblk;
    t.src = W + (size_t)(64 * kb) * N + 32 * nb; t.dst = WT + (size_t)(32 * nb) * K + 64 * kb; t.N = N; t.K = K; return t;
}
DI_ void aux_load(Frame& F, const AuxT& t, f32x4 (&wv)[8]) {
    const int rowi = F.lane >> 3, c4 = F.lane & 7;
#pragma unroll
    for (int i = 0; i < 8; ++i) wv[i] = *(const GAS f32x4*)(t.src + (size_t)(8 * i + rowi) * t.N + 4 * c4);
}
DI_ void aux_store(Frame& F, const AuxT& t, const f32x4 (&wv)[8], LAS unsigned char* scr  ) {
    const int lane = F.lane, rowi = lane >> 3, c4 = lane & 7;
#pragma unroll
    for (int i = 0; i < 8; ++i) { LAS unsigned* p = (LAS unsigned*)(scr + (8 * i + rowi) * 68 + c4 * 8); p[0] = cvtpk(wv[i].x, wv[i].y); p[1] = cvtpk(wv[i].z, wv[i].w); }
    LDS_WAIT(); asm volatile("" ::: "memory");
    const int kc = lane & 7;
#pragma unroll
    for (int j = 0; j < 4; ++j) { const int n = (lane >> 3) + 8 * j; unsigned short hv[8];
#pragma unroll
        for (int e = 0; e < 8; ++e) hv[e] = *(const LAS unsigned short*)(scr + (8 * kc + e) * 68 + n * 2);
        v4u o; o.x = hv[0] | ((unsigned)hv[1] << 16); o.y = hv[2] | ((unsigned)hv[3] << 16); o.z = hv[4] | ((unsigned)hv[5] << 16); o.w = hv[6] | ((unsigned)hv[7] << 16);
        *(GAS v4u*)(t.dst + (size_t)n * t.K + 8 * kc) = o; }
    LDS_WAIT(); asm volatile("" ::: "memory");
}

constexpr int F0_QD = 0, F0_KI = 8192, F0_T = 16384, F0_GL = 24576, F0_TV = 25088, F0_STG = 33536;
DI_ void f0_load(const bf16* cb, const int (&oq)[2], int ov, v2u (&q2)[2], v2u (&f2)[2], v4u& vraw) {
#pragma unroll
    for (int ti = 0; ti < 2; ++ti) { q2[ti] = *(const GAS v2u*)(cb + oq[ti]); f2[ti] = *(const GAS v2u*)(cb + oq[ti] + DI); }
    vraw = *(const GAS v4u*)(cb + ov);
}
DI_ void f0_prep(Frame& F, LAS unsigned char* st, const v2u (&q2)[2], const v2u (&f2)[2], const v4u& vraw, const f32x4& lb4, const f32x4& bf4) {
    const int lane = F.lane, w = F.wave, r = lane & 15, g = lane >> 4, ps = w >> 1, hf = w & 1;
    const float lbv[4] = {lb4.x, lb4.y, lb4.z, lb4.w}, bfv[4] = {bf4.x, bf4.y, bf4.z, bf4.w};
    float Lv[2][4], qq[2][4], kk[2][4];
#pragma unroll
    for (int ti = 0; ti < 2; ++ti) {
        const float qv[4] = {bflo(q2[ti].x), bfhi(q2[ti].x), bflo(q2[ti].y), bfhi(q2[ti].y)}, fv[4] = {bflo(f2[ti].x), bfhi(f2[ti].x), bflo(f2[ti].y), bfhi(f2[ti].y)};
#pragma unroll
        for (int x = 0; x < 4; ++x) { const float fg = lbv[x] + (1.f - lbv[x]) * sigm(fv[x] + bfv[x]);
            Lv[ti][x] = lg2(fg); kk[ti][x] = 1.f - fg; qq[ti][x] = silu(qv[x]); }
    }
    float qd[2][4], ki[2][4], kd[2][4], gl[4];
#pragma unroll
    for (int x = 0; x < 4; ++x) {
        const float b0 = scan16(Lv[0][x]);
        const float b1 = scan16(Lv[1][x]) + bcast15(b0);
        const float BB = bcast15(b1);
        gl[x] = ex2(BB);
        qd[0][x] = qq[0][x] * ex2(b0); ki[0][x] = kk[0][x] * ex2(-b0); kd[0][x] = ki[0][x] * gl[x];
        qd[1][x] = qq[1][x] * ex2(b1); ki[1][x] = kk[1][x] * ex2(-b1); kd[1][x] = ki[1][x] * gl[x];
    }
    const int lp = (2 * (g & 1) + hf) * 16 + r;
#pragma unroll
    for (int ti = 0; ti < 2; ++ti) {
        *(LAS v2u*)(st + F0_QD + ((ti * 4 + ps) * 64 + lp) * 16 + (g >> 1) * 8) = (v2u){cvtpk(qd[ti][0], qd[ti][1]), cvtpk(qd[ti][2], qd[ti][3])};
        *(LAS v2u*)(st + F0_KI + ((ti * 4 + ps) * 64 + lp) * 16 + (g >> 1) * 8) = (v2u){cvtpk(ki[ti][0], ki[ti][1]), cvtpk(ki[ti][2], ki[ti][3])};
        const unsigned k01 = cvtpk(kd[ti][0], kd[ti][1]), k23 = cvtpk(kd[ti][2], kd[ti][3]);
        LAS unsigned char* tp = st + F0_T + (32 * ps + 8 * g + 4 * hf) * 64 + (16 * ti + r) * 2;
        *(LAS unsigned short*)(tp) = (unsigned short)(k01 & 0xffffu); *(LAS unsigned short*)(tp + 64) = (unsigned short)(k01 >> 16);
        *(LAS unsigned short*)(tp + 128) = (unsigned short)(k23 & 0xffffu); *(LAS unsigned short*)(tp + 192) = (unsigned short)(k23 >> 16);
    }
    if (r == 0) *(LAS f32x4*)(st + F0_GL + (32 * ps + 8 * g + 4 * hf) * 4) = (f32x4){gl[0], gl[1], gl[2], gl[3]};
    { const int tk = 4 * w + (lane >> 4), c16 = lane & 15;
      *(LAS v2u*)(st + F0_TV + tk * 264 + c16 * 16) = (v2u){vraw.x, vraw.y}; *(LAS v2u*)(st + F0_TV + tk * 264 + c16 * 16 + 8) = (v2u){vraw.z, vraw.w}; }
}
DI_ void l0_fused(Frame& F, unsigned char* dummy) {
    const int lane = F.lane, w = F.wave, r = lane & 15, g = lane >> 4, ps = w >> 1, hf = w & 1;
    LAS float* obuf = (LAS float*)(F.lds + 2 * F0_STG);
    constexpr int OB = 32 * 132;
    for (int u = F.vcu; u < NB * HG_H; u += F.G) {
        const int bh = u, b = bh >> 6, h = bh & 63;
        f32x4 acc[8];
#pragma unroll
        for (int m = 0; m < 8; ++m) acc[m] = (f32x4){0.f, 0.f, 0.f, 0.f};
        const int ntok = 4 * w + g, ndv = 8 * r;
        float ngv[8];
        { const f32x4 a0 = *(const GAS f32x4*)(F.ng0 + h * 128 + ndv), a1 = *(const GAS f32x4*)(F.ng0 + h * 128 + ndv + 4);
          ngv[0] = a0.x; ngv[1] = a0.y; ngv[2] = a0.z; ngv[3] = a0.w; ngv[4] = a1.x; ngv[5] = a1.y; ngv[6] = a1.z; ngv[7] = a1.w; }
        const int colp = h * 128 + 32 * ps + 8 * g + 4 * hf;
        const f32x4 lb4 = *(const GAS f32x4*)(F.LB0 + colp), bf4 = *(const GAS f32x4*)(F.b_f + colp);
        v2u q2s[2][2], f2s[2][2]; v4u vrs[2];
        const int oq[2] = {r * N0 + colp, (16 + r) * N0 + colp};
        const int ov = (4 * w + (lane >> 4)) * N0 + 2 * DI + h * 128 + 8 * (lane & 15), oz = ntok * N0 + 3 * DI + h * 128 + ndv, oy = ntok * DI + h * 128 + ndv;
        const bf16* xq = F.QFIZ + (size_t)(b * SEQ - 32) * N0;
        bf16* xy = F.Y + (size_t)(b * SEQ - 32) * DI;
        bf16* y0 = (b == 0) ? F.Y0 : F.Y0 + (size_t)32 * DI;
#define QCH(c_) (((c_) == 0) ? (const bf16*)F.Q0 : xq + (size_t)(c_) * 32 * N0)
        f0_load(QCH(0), oq, ov, q2s[0], f2s[0], vrs[0]);
        f0_prep(F, F.lds, q2s[0], f2s[0], vrs[0], lb4, bf4);
        f0_load(QCH(1), oq, ov, q2s[1], f2s[1], vrs[1]);
        LAS unsigned char* ascr = F.lds + 2 * F0_STG + 33792 + w * 4352;
        f32x4 awv[8];
        v4u zs[2]; zs[0] = (v4u){0u, 0u, 0u, 0u}; zs[1] = zs[0];
#define F0_BODY(C_, PAR) do { const int c = (C_); \
            asm volatile("s_waitcnt lgkmcnt(0)" ::: "memory"); \
            __builtin_amdgcn_s_barrier(); \
            asm volatile("" ::: "memory"); \
            f0_load(QCH((c + 2 < NCH) ? c + 2 : NCH - 1), oq, ov, q2s[PAR], f2s[PAR], vrs[PAR]); \
            AuxT at_; if (USE_AUX) { at_ = aux_decode(F, c, dummy); aux_load(F, at_, awv); } \
            { const int cz = (c < NCH) ? c : NCH - 1; zs[PAR] = *(const GAS v4u*)(QCH(cz) + oz); } \
            { \
                const int cp = c - 1; \
                const LAS float* ob = obuf + (cp & 1) * OB + ntok * 132 + ndv; \
                const f32x4 x0 = *(const LAS f32x4*)(ob), x1 = *(const LAS f32x4*)(ob + 4); \
                float ss = (x0.x * x0.x + x0.y * x0.y) + (x0.z * x0.z + x0.w * x0.w) + (x1.x * x1.x + x1.y * x1.y) + (x1.z * x1.z + x1.w * x1.w); \
                ss = bcast15(scan16(ss)); \
                const float rs = rsqrtf(ss * (1.f / 128.f) + RMS_EPS); \
                bf16* yb = (cp <= 0) ? ((cp == 0) ? y0 : F.Y0 + (size_t)32 * DI) : xy + (size_t)cp * 32 * DI; \
                { \
                    v4u d; \
                    d.x = cvtpk(x0.x * rs * ngv[0] * silu(bflo(zs[PAR ^ 1].x)), x0.y * rs * ngv[1] * silu(bfhi(zs[PAR ^ 1].x))); \
                    d.y = cvtpk(x0.z * rs * ngv[2] * silu(bflo(zs[PAR ^ 1].y)), x0.w * rs * ngv[3] * silu(bfhi(zs[PAR ^ 1].y))); \
                    d.z = cvtpk(x1.x * rs * ngv[4] * silu(bflo(zs[PAR ^ 1].z)), x1.y * rs * ngv[5] * silu(bfhi(zs[PAR ^ 1].z))); \
                    d.w = cvtpk(x1.z * rs * ngv[6] * silu(bflo(zs[PAR ^ 1].w)), x1.w * rs * ngv[7] * silu(bfhi(zs[PAR ^ 1].w))); \
                    *(GAS v4u*)(yb + oy) = d; \
                } \
            } \
             \
            { \
                const LAS unsigned char* st = F.lds + (c & 1) * F0_STG; \
 \
                unsigned short hv[8]; \
                _Pragma("unroll") \
                for (int e = 0; e < 8; ++e) hv[e] = *(const LAS unsigned short*)(st + F0_TV + (16 * (e >> 2) + 4 * g + (e & 3)) * 264 + (16 * w + r) * 2); \
                const bf16x8 vf = mk8(hv[0] | ((unsigned)hv[1] << 16), hv[2] | ((unsigned)hv[3] << 16), hv[4] | ((unsigned)hv[5] << 16), hv[6] | ((unsigned)hv[7] << 16)); \
                bf16x8 qf[8], kf[8]; \
                _Pragma("unroll") \
                for (int q = 0; q < 8; ++q) { qf[q] = *(const LAS bf16x8*)(st + F0_QD + q * 1024 + lane * 16); kf[q] = *(const LAS bf16x8*)(st + F0_KI + q * 1024 + lane * 16); } \
                SCHED_FENCE(); \
 \
                f32x4 pt00 = (f32x4){0.f, 0.f, 0.f, 0.f}, pt01 = pt00, pt11 = pt00; \
                _Pragma("unroll") \
                for (int s2 = 0; s2 < 4; ++s2) { pt00 = MFMA16(kf[s2], qf[s2], pt00); pt01 = MFMA16(kf[s2], qf[4 + s2], pt01); pt11 = MFMA16(kf[4 + s2], qf[4 + s2], pt11); } \
                const bool m0 = (4 * g + 0 <= r), m1 = (4 * g + 1 <= r), m2 = (4 * g + 2 <= r), m3 = (4 * g + 3 <= r); \
 \
                                const bf16x8 pb0 = mk8(cvtpk(m0 ? pt00.x : 0.f, m1 ? pt00.y : 0.f), cvtpk(m2 ? pt00.z : 0.f, m3 ? pt00.w : 0.f), 0u, 0u); \
                const bf16x8 pb1 = mk8(pk2(pt01.x, pt01.y), pk2(pt01.z, pt01.w), cvtpk(m0 ? pt11.x : 0.f, m1 ? pt11.y : 0.f), cvtpk(m2 ? pt11.z : 0.f, m3 ? pt11.w : 0.f)); \
                f32x4 o0 = (f32x4){0.f, 0.f, 0.f, 0.f}, o1 = o0; \
                o0 = MFMA16(vf, pb0, o0); o1 = MFMA16(vf, pb1, o1); \
                _Pragma("unroll") \
                for (int s2 = 0; s2 < 4; ++s2) { \
                    const bf16x8 sb = mk8(cvtpk(acc[2 * s2].x, acc[2 * s2].y), cvtpk(acc[2 * s2].z, acc[2 * s2].w), cvtpk(acc[2 * s2 + 1].x, acc[2 * s2 + 1].y), cvtpk(acc[2 * s2 + 1].z, acc[2 * s2 + 1].w)); \
                    o0 = MFMA16(sb, qf[s2], o0); o1 = MFMA16(sb, qf[4 + s2], o1); \
                } \
                LAS float* ow = obuf + (c & 1) * OB + r * 132 + 16 * w + 4 * g; \
                *(LAS f32x4*)ow = o0; *(LAS f32x4*)(ow + 16 * 132) = o1; \
                f32x4 gf[8]; v2u klo[8], khi[8]; \
                _Pragma("unroll") \
                for (int m = 0; m < 8; ++m) { gf[m] = *(const LAS f32x4*)(st + F0_GL + (16 * m + 4 * g) * 4); \
                    klo[m] = *(const LAS v2u*)(st + F0_T + (16 * m + r) * 64 + 8 * g); khi[m] = *(const LAS v2u*)(st + F0_T + (16 * m + r) * 64 + 32 + 8 * g); } \
                SCHED_FENCE(); \
                _Pragma("unroll") \
                for (int m = 0; m < 8; ++m) acc[m] = MFMA16(mk8(klo[m].x, klo[m].y, khi[m].x, khi[m].y), vf, acc[m] * gf[m]); \
                SCHED_FENCE(); \
            } \
            f0_prep(F, F.lds + ((c + 1) & 1) * F0_STG, q2s[PAR ^ 1], f2s[PAR ^ 1], vrs[PAR ^ 1], lb4, bf4); \
            if (USE_AUX) aux_store(F, at_, awv, ascr); \
        } while (0)
        for (int c2 = 0; c2 <= NCH; c2 += 2) { F0_BODY(c2, 0); F0_BODY(c2 + 1, 1); }
#undef F0_BODY
#undef QCH
        asm volatile("s_waitcnt vmcnt(0) lgkmcnt(0)" ::: "memory");
        __builtin_amdgcn_s_barrier();
    }
}

struct Args { const float* in[17]; float* out; unsigned char* ws; int ph_lo, ph_hi, li, pad; };
__global__ void __launch_bounds__(NWAVES * 64, 2) mk_fwd(Args args) {
    extern __shared__ __attribute__((aligned(16))) unsigned char lds[];
    Frame F;
    F.lds = (LAS unsigned char*)lds;
    F.MISC = (volatile LAS unsigned*)(F.lds + MISC_OFF);
    F.tid = threadIdx.x; F.lane = F.tid & 63; F.wave = __builtin_amdgcn_readfirstlane(F.tid >> 6);
    F.G = gridDim.x; { const int bx = blockIdx.x; F.vcu = (F.G % 8 == 0) ? (bx % 8) * (F.G / 8) + bx / 8 : bx; }
    unsigned char* ws = args.ws;
    F.ctl = (gu32*)(ws + WS_CTL);
    F.x = args.in[0]; F.meta = args.in[1]; F.lb_logits = args.in[2];
    F.w0in = args.in[3]; F.b_f = args.in[4]; F.ng0 = args.in[5]; F.w0out = args.in[6]; F.ln0g = args.in[7]; F.ln0b = args.in[8];
    F.w1in = args.in[9]; F.wg1 = args.in[10]; F.wg2 = args.in[11]; F.b_g = args.in[12]; F.ng1 = args.in[13]; F.w1out = args.in[14]; F.ln1g = args.in[15]; F.ln1b = args.in[16];
    F.out = args.out;
    F.LB0 = (float*)(ws + WS_LB0); F.G1 = (float*)(ws + WS_G1); F.PRE = (float*)(ws + WS_PRE); F.O1 = (float*)(ws + WS_O1); F.WG1T = (bf16*)(ws + WS_WG1T); F.W2F = (bf16*)(ws + WS_W2F); F.SS = (float*)(ws + WS_REC + 525 * MiB); F.Q0 = (bf16*)(ws + WS_Q0); F.Y0 = (bf16*)(ws + WS_Y0); F.REC0 = ws + WS_REC; F.REC1 = ws + WS_REC1; F.VF1 = ws + WS_VF1;
    F.WT0IN = (bf16*)(ws + WS_WT0IN); F.WT0OUT = (bf16*)(ws + WS_WT0OUT); F.WT1IN = (bf16*)(ws + WS_WT1IN); F.WT1OUT = (bf16*)(ws + WS_WT1OUT);
    F.XB = (bf16*)(ws + WS_XB); F.H1B = (bf16*)(ws + WS_H1B); F.QFIZ = (bf16*)(ws + WS_QFIZ); F.Y = (bf16*)(ws + WS_Y);
    for (int u = F.tid; u < (LDS_BYTES - LDSCTL_OFF) / 4; u += NWAVES * 64) ((LAS unsigned*)(F.lds + LDSCTL_OFF))[u] = 0u;
    __syncthreads();
    int vb = (int)blockIdx.x;
    if (USE_TICKETS && N_LAUNCHES == 1 && (F.G % 8) == 0) {
        if (F.tid == 0) {
            const unsigned per = (unsigned)F.G / 8u; unsigned x = xb_xcc_id() & 7u, got = 0xffffffffu;
            for (unsigned tr = 0; tr < 8u; ++tr) { const unsigned y = (x + tr) & 7u; const unsigned t = xb_add((unsigned*)(F.ctl + CW_POOL) + 64 * y, 1u); if (t < per) { got = y + 8u * t; break; } }
            F.MISC[12] = (got == 0xffffffffu) ? blockIdx.x : got;
        }
        __syncthreads();
        vb = (int)F.MISC[12];
    }
    { F.vcu = (F.G % 8 == 0) ? (vb % 8) * (F.G / 8) + vb / 8 : vb; }
    XcdBarrier bar; bar.bar = (unsigned*)(F.ctl + CW_BAR); bar.x = 0; bar.st = nullptr;
    if (N_LAUNCHES == 1) bar = xcd_barrier_post((unsigned*)(F.ctl + CW_BAR), F.MISC + 8);
#define GRID_BAR() do { if (N_LAUNCHES == 1) xcd_barrier(bar); } while (0)
    const int lo = args.ph_lo, hi = args.ph_hi;
    unsigned long long pclk0 = 0, pclkn = 0; (void)pclk0;
    unsigned long long st_prev = STAMP_MASK ? __builtin_amdgcn_s_memrealtime() : 0ull, st_acc = 0ull;
#define STAMP(k) do { if (STAMP_MASK) { const unsigned long long t_ = __builtin_amdgcn_s_memrealtime(); if ((STAMP_MASK >> (k)) & 1) st_acc += t_ - st_prev; st_prev = t_; } } while (0)
#ifdef ONLY_PHASE
#define IN(k) ((k) == ONLY_PHASE && lo <= (k) && (k) < hi)
#else
#define IN(k) (lo <= (k) && (k) < hi)
#endif
#define BOTH(k) (IN(k) && IN((k) + 1))

    if (IN(0)) { for (int rep = 0; rep < REP(0); ++rep) { p0_prologue(F); if (rep + 1 < REP(0)) GRID_BAR(); } if (BOTH(0)) GRID_BAR(); }
    STAMP(0);
    if (IN(1)) {
        if (!(P0_META_FOLD && F.G == 256)) skinny<1, 0>(F, F.XB + (size_t)MX * D, F.WT0IN, D, 0, N0 / 16, (USE_L0_MFMA == 2) ? F.Q0 + (size_t)16 * N0 : F.QFIZ + (size_t)MX * N0, N0, nullptr, nullptr);
        pg8::Gemm g{F.XB, F.WT0IN, MX, N0, D}; pg8::StaticOrder S; S.init(MX, N0, F.G, vb);
        pg8::EpiBf16<0> E{F.QFIZ, N0, nullptr, 0, 0, 1.f};
        if (PROBE_CLK == 1) pclk0 = __builtin_amdgcn_s_memtime();
        for (int rep = 0; rep < REP(1); ++rep) { pg8::gemm_phase<pg8::EpiBf16<0>, pg8::StaticOrder, PG8_ALIGN, PG8_SP2>(F.lds + RING_OFF, g, S, E); if (rep + 1 < REP(1)) GRID_BAR(); }
        if (PROBE_CLK == 1) pclkn = __builtin_amdgcn_s_memtime() - pclk0;
        if (BOTH(1)) GRID_BAR();
    }
    STAMP(1);
#if USE_L0_MFMA == 2
    STAMP(2);
    if (IN(3)) { for (int rep = 0; rep < REP(3); ++rep) { l0_fused(F, F.REC0); if (rep + 1 < REP(3)) GRID_BAR(); } if (BOTH(3)) GRID_BAR(); }
#elif USE_L0_MFMA
    if (IN(2)) { for (int rep = 0; rep < REP(2); ++rep) { l0_prep(F, F.REC0); if (rep + 1 < REP(2)) GRID_BAR(); } if (BOTH(2)) GRID_BAR(); }
    STAMP(2);
    if (IN(3)) { for (int rep = 0; rep < REP(3); ++rep) { l0_seq(F, F.REC0); if (rep + 1 < REP(3)) GRID_BAR(); } if (BOTH(3)) GRID_BAR(); }
#else
    if (IN(2)) { if (BOTH(2)) GRID_BAR(); }
    if (IN(3)) { for (int rep = 0; rep < REP(3); ++rep) { p2_l0_rec_naive(F); if (rep + 1 < REP(3)) GRID_BAR(); } if (BOTH(3)) GRID_BAR(); }
#endif
    STAMP(3);
    if (IN(4)) {
        skinny<4, 1>(F, (USE_L0_MFMA == 2) ? F.Y0 + (size_t)16 * DI : F.Y + (size_t)MX * DI, F.WT0OUT, DI, 0, D / 16, nullptr, 0, F.PRE + (size_t)MX * D, F.meta);
        pg8::Gemm g{F.Y, F.WT0OUT, MX, D, DI}; pg8::StaticOrder S; S.init(MX, D, F.G, vb);
        pg8::EpiResid E{F.PRE, D, F.x, F.meta, MX, MX, ALPHA};
        for (int rep = 0; rep < REP(4); ++rep) { pg8::gemm_phase<pg8::EpiResid, pg8::StaticOrder, PG8_ALIGN, PG8_SP2>(F.lds + RING_OFF, g, S, E); if (rep + 1 < REP(4)) GRID_BAR(); }
        if (BOTH(4)) GRID_BAR();
    }
    STAMP(4);
    if (IN(5)) { for (int rep = 0; rep < REP(5); ++rep) { ln_phase2(F, F.PRE, MR, F.ln0g, F.ln0b, RES_BF16 ? nullptr : F.PRE, F.H1B); if (rep + 1 < REP(5)) GRID_BAR(); } if (BOTH(5)) GRID_BAR(); }
    STAMP(5);
    if (IN(6)) {
        gate_proj(F, F.WG1T);
        skinny<2, 0>(F, F.H1B + (size_t)MX * D, F.WT1IN, D, 4096, (N1 - 4096 - DI) / 16, F.QFIZ + (size_t)MX * N1, N1, nullptr, nullptr);
        pg8::Gemm g{F.H1B, F.WT1IN, MX, N1, D}; pg8::StaticOrder S; S.init(MX, N1, F.G, vb);
        pg8::EpiBf16<0> E{F.QFIZ, N1, nullptr, 0, 0, 1.f};
        for (int rep = 0; rep < REP(6); ++rep) { pg8::gemm_phase<pg8::EpiBf16<0>, pg8::StaticOrder, PG8_ALIGN, PG8_SP2>(F.lds + RING_OFF, g, S, E); if (rep + 1 < REP(6)) GRID_BAR(); }
        if (BOTH(6)) GRID_BAR();
    }
    STAMP(6);
#if USE_L1_MFMA
    if (IN(7)) { for (int rep = 0; rep < REP(7); ++rep) { l1_prep(F, F.REC1, F.VF1, F.W2F); if (rep + 1 < REP(7)) GRID_BAR(); } if (BOTH(7)) GRID_BAR(); }
    STAMP(7);
#if USE_L1_SEQ2
    if (IN(8)) { l1_seq2(F, F.REC1, F.VF1, F.SS); if (BOTH(8)) GRID_BAR(); }
#else
    if (IN(8)) { l1_seq<0>(F, F.REC1, F.VF1, F.O1, F.SS); if (REP(8) > 1) { GRID_BAR(); l1_seq<PROBE_VAR>(F, F.REC1, F.VF1, F.O1, F.SS); } if (BOTH(8)) GRID_BAR(); }
#endif
#else
    if (IN(7)) { if (BOTH(7)) GRID_BAR(); }
    if (IN(8)) { for (int rep = 0; rep < REP(8); ++rep) { p6_l1_rec_naive(F); if (rep + 1 < REP(8)) GRID_BAR(); } if (BOTH(8)) GRID_BAR(); }
#endif
    STAMP(8);
#if !(USE_FUSED_NORM && USE_L1_MFMA)
    if (IN(9)) { for (int rep = 0; rep < REP(9); ++rep) { p7_normgate(F); if (rep + 1 < REP(9)) GRID_BAR(); } if (BOTH(9)) GRID_BAR(); }
#endif
    STAMP(9);
    if (IN(10)) {
        pg8::Gemm g{F.Y, F.WT1OUT, MX, D, DI}; pg8::StaticOrder S; S.init(MX, D, F.G, vb);
#if USE_FUSED_NORM && USE_L1_MFMA
        pg8::EpiResidScale E{F.PRE, D, F.H1B, ALPHA, F.SS, RMS_EPS};
        for (int rep = 0; rep < REP(10); ++rep) { pg8::gemm_phase<pg8::EpiResidScale, pg8::StaticOrder, PG8_ALIGN, PG8_SP2>(F.lds + RING_OFF, g, S, E); if (rep + 1 < REP(10)) GRID_BAR(); }
#else
        pg8::EpiResid E{F.PRE, D, F.PRE, F.PRE, MX, MX, ALPHA};
        if (PROBE_CLK == 10) pclk0 = __builtin_amdgcn_s_memtime();
        for (int rep = 0; rep < REP(10); ++rep) { pg8::gemm_phase<pg8::EpiResid, pg8::StaticOrder, PG8_ALIGN, PG8_SP2>(F.lds + RING_OFF, g, S, E); if (rep + 1 < REP(10)) GRID_BAR(); }
        if (PROBE_CLK == 10) pclkn = __builtin_amdgcn_s_memtime() - pclk0;
#endif
        if (BOTH(10)) GRID_BAR();
    }
    STAMP(10);
    if (IN(11)) { for (int rep = 0; rep < REP(11); ++rep) { ln_phase2(F, F.PRE, MX, F.ln1g, F.ln1b, F.out, nullptr); if (rep + 1 < REP(11)) GRID_BAR(); } }
    STAMP(11);
    if (STAMP_MASK && blockIdx.x == 0 && F.tid == 0) { const unsigned long long t0 = __builtin_amdgcn_s_memrealtime(); while (__builtin_amdgcn_s_memrealtime() - t0 < st_acc) __builtin_amdgcn_s_sleep(8); }
    if (PROBE_CLK && blockIdx.x == 0 && F.tid == 0) { const unsigned long long t0 = __builtin_amdgcn_s_memrealtime(); while (__builtin_amdgcn_s_memrealtime() - t0 < pclkn / (PROBE_CLK == 10 ? 10ull : 100ull)) __builtin_amdgcn_s_sleep(8); }
#undef IN
#undef BOTH
}

extern "C" void kernel_launch(void* const* d_in, const int* in_sizes, int n_in, void* d_out, int out_size, void* d_ws, size_t ws_size, hipStream_t stream) {
    static int grid = 0;
    if (grid == 0) {
        if (n_in != 17 || in_sizes[0] != MX * D || out_size != MX * D || ws_size < WS_END) { fprintf(stderr, "kernel_launch: unexpected problem (n_in %d, in0 %d, out %d, ws %zu < %zu); nothing launched\n", n_in, n_in > 0 ? in_sizes[0] : -1, out_size, ws_size, (size_t)WS_END); grid = -1; return; }
        int dev = 0, cus = 0, per_cu = 0;
        if (hipGetDevice(&dev) != hipSuccess || hipDeviceGetAttribute(&cus, hipDeviceAttributeMultiprocessorCount, dev) != hipSuccess) { fprintf(stderr, "kernel_launch: device query failed\n"); grid = -1; return; }
        if (hipFuncSetAttribute((const void*)mk_fwd, hipFuncAttributeMaxDynamicSharedMemorySize, LDS_BYTES) != hipSuccess) { fprintf(stderr, "kernel_launch: hipFuncSetAttribute failed\n"); grid = -1; return; }
        if (hipOccupancyMaxActiveBlocksPerMultiprocessor(&per_cu, (const void*)mk_fwd, NWAVES * 64, LDS_BYTES) != hipSuccess || per_cu < 1)
            fprintf(stderr, "kernel_launch: note: occupancy query reports %d workgroups per CU\n", per_cu);
        (void)hipGetLastError();
        grid = cus;
    }
    if (grid < 0) return;
    if (hipMemsetAsync((char*)d_ws + WS_CTL, 0, CTL_ZERO_BYTES, stream) != hipSuccess) { fprintf(stderr, "kernel_launch: memset failed\n"); return; }
    Args a{};
    for (int i = 0; i < 17; ++i) a.in[i] = (const float*)d_in[i];
    a.out = (float*)d_out; a.ws = (unsigned char*)d_ws;
    for (int li = 0; li < N_LAUNCHES; ++li) {
        a.ph_lo = (N_LAUNCHES == 1) ? 0 : li; a.ph_hi = (N_LAUNCHES == 1) ? PER_PHASE : li + 1; a.li = li; a.pad = 0;
        hipLaunchKernelGGL(mk_fwd, dim3(grid), dim3(NWAVES * 64), LDS_BYTES, stream, a);
        const hipError_t le = hipPeekAtLastError();
        if (le != hipSuccess) { fprintf(stderr, "kernel_launch: launch %d failed: %s\n", li, hipGetErrorName(le)); break; }
    }
}
```

```cpp
#include <hip/hip_runtime.h>
#include <cstdio>
#include <cstdint>
#define MK_N_LAUNCHES 1
#define USE_L0_MFMA 2
#define USE_L1_MFMA 1
namespace pg8 {
#define PG8_LAS __attribute__((address_space(3)))
typedef unsigned short bf16_t;
typedef short bf16x8 __attribute__((ext_vector_type(8)));
typedef float f32x4 __attribute__((ext_vector_type(4)));
typedef unsigned u32x4 __attribute__((ext_vector_type(4)));
constexpr int BM = 256, BK = 64, HALF = 128, HTB = HALF * BK * 2  , STAGE_BYTES = 8 * HTB, NXCD = 8, WGM = 8;

__host__ __device__ __forceinline__ int lds_byte(int r, int c) { const int st = (r >> 4) * 2 + (c >> 5), rr = r & 15, cc = c & 31, ob = rr * 64 + cc * 2; return st * 1024 + (ob ^ (((ob >> 9) & 1) << 5)); }
__host__ __device__ __forceinline__ void stage_rc(int b, int& R, int& C) { const int st = b / 1024, sb = b % 1024, swz = sb ^ (((sb >> 9) & 1) << 5); R = (st >> 1) * 16 + swz / 64; C = (st & 1) * 32 + (swz % 64) / 2; }
__host__ __device__ __forceinline__ int perm32(int rho) { const int n = rho >> 4, i = rho & 15; return 8 * (i >> 2) + 4 * n + (i & 3); }

struct Unit { int pm, pn; };
struct Gemm { const bf16_t* A; const bf16_t* Bt; int M, N, K; };

struct StaticOrder {
    int nM, nN, nwg, G, c;
    __host__ __device__ void init(int M, int N, int G_, int c_) { nM = M / BM; nN = N / BM; nwg = nM * nN; G = G_; c = c_; }
    __host__ __device__ bool next(int i, Unit& u) const {
        const long L = (long)i * G + c; if (L >= nwg) return false;
        int wgid = (int)L; { const int q = nwg / NXCD, r = nwg % NXCD, xcd = wgid % NXCD, off = wgid / NXCD; wgid = (xcd < r ? xcd * (q + 1) : r * (q + 1) + (xcd - r) * q) + off; }
        const int nig = WGM * nN, gid = wgid / nig, fm = gid * WGM, gsz = (nM - fm) < WGM ? (nM - fm) : WGM;
        u.pm = fm + ((wgid % nig) % gsz); u.pn = (wgid % nig) / gsz; return true;
    }
    __device__ __forceinline__ void a_ready(const Unit&) const {}
    __device__ __forceinline__ void done(const Unit&) const {}
};

__device__ __forceinline__ unsigned cvt_pk_bf16(float lo, float hi) { unsigned r; asm volatile("v_cvt_pk_bf16_f32 %0, %1, %2" : "=v"(r) : "v"(lo), "v"(hi)); return r; }
typedef float f32x2 __attribute__((ext_vector_type(2)));
__device__ __forceinline__ f32x2 gelu_pk(f32x2 v) {
    const f32x2 av = __builtin_elementwise_abs(v), d = av * 0.2316418882f + 1.0f;
    f32x2 t; t.x = __builtin_amdgcn_rcpf(d.x); t.y = __builtin_amdgcn_rcpf(d.y);
    f32x2 q = t * 0.5307027145f + (-0.7265760135f); q = q * t + 0.7107068705f; q = q * t + (-0.142248368f); q = q * t + 0.127414796f; q = q * t;
    const f32x2 s = (v * v) * (-0.72134752044f);
    f32x2 e; e.x = __builtin_amdgcn_exp2f(s.x); e.y = __builtin_amdgcn_exp2f(s.y);
    const f32x2 m = v * (q * e), r = v - m;
    f32x2 o; o.x = v.x < 0.f ? m.x : r.x; o.y = v.y < 0.f ? m.y : r.y; return o;
}

template <int ACT  > struct EpiBf16 {
    static constexpr bool PERM = true, AFTER_DRAIN = false, KHOOK = false; static_assert(ACT == 0 || ACT == 1, "EpiBf16: ACT is 0 (none) or 1 (gelu_pk)");
    bf16_t* O; int ldc; const float* bias; int split_cols; size_t split_stride; float scale0;
    __device__ __forceinline__ void operator()(const f32x4 (&acc)[2][2][4][2], const Unit& u, int wr, int wc, int fr, int fq) const {
        const int row0 = u.pm * BM + wr * 64 + fr; int colt = u.pn * BM; bf16_t* base = O;
        float sc = 1.f; if (split_cols) { const int t = colt / split_cols; base += (size_t)t * split_stride; colt -= t * split_cols; if (t == 0) sc = scale0; }
        const int col0 = colt + wc * 32 + 8 * fq, bcol0 = u.pn * BM + wc * 32 + 8 * fq;
        f32x4 bv[2][2];
#pragma unroll
        for (int bj = 0; bj < 2; ++bj)
#pragma unroll
            for (int n = 0; n < 2; ++n) bv[bj][n] = bias ? *(const f32x4*)(bias + bcol0 + bj * HALF + 4 * n) : (f32x4){0.f, 0.f, 0.f, 0.f};
#pragma unroll
        for (int ai = 0; ai < 2; ++ai)
#pragma unroll
            for (int m = 0; m < 4; ++m) { bf16_t* rowp = base + (size_t)(row0 + ai * HALF + m * 16) * ldc + col0;
#pragma unroll
                for (int bj = 0; bj < 2; ++bj) { f32x4 v0 = acc[ai][bj][m][0] + bv[bj][0], v1 = acc[ai][bj][m][1] + bv[bj][1];
                    if (ACT == 1) { f32x2 a = gelu_pk((f32x2){v0[0], v0[1]}), b = gelu_pk((f32x2){v0[2], v0[3]}), c = gelu_pk((f32x2){v1[0], v1[1]}), d = gelu_pk((f32x2){v1[2], v1[3]});
                        v0 = (f32x4){a.x, a.y, b.x, b.y}; v1 = (f32x4){c.x, c.y, d.x, d.y}; }
                    v0 = v0 * sc; v1 = v1 * sc; u32x4 w; w.x = cvt_pk_bf16(v0[0], v0[1]); w.y = cvt_pk_bf16(v0[2], v0[3]); w.z = cvt_pk_bf16(v1[0], v1[1]); w.w = cvt_pk_bf16(v1[2], v1[3]);
                    *(u32x4*)(rowp + bj * HALF) = w; } }
    }
};
struct EpiResid {
    static constexpr bool PERM = false, AFTER_DRAIN = false, KHOOK = false;
    float* C; int ldc; const float* resA; const float* resB; int rowsA; int rowsValid; float alpha;
    __device__ __forceinline__ void operator()(const f32x4 (&acc)[2][2][4][2], const Unit& u, int wr, int wc, int fr, int fq) const {
        const int row0 = u.pm * BM + wr * 64 + fr, col0 = u.pn * BM + wc * 32 + 4 * fq;
#pragma unroll
        for (int ai = 0; ai < 2; ++ai)
#pragma unroll
            for (int m = 0; m < 4; ++m) { const int r = row0 + ai * HALF + m * 16;
                if (r < rowsValid) {
                    const float* rp = (r < rowsA) ? resA + (size_t)r * ldc + col0 : resB + (size_t)(r - rowsA) * ldc + col0;
                    float* cp = C + (size_t)r * ldc + col0;
#pragma unroll
                    for (int bj = 0; bj < 2; ++bj)
#pragma unroll
                        for (int n = 0; n < 2; ++n) { const f32x4 rv = *(const f32x4*)(rp + bj * HALF + n * 16); *(f32x4*)(cp + bj * HALF + n * 16) = rv * alpha + acc[ai][bj][m][n]; } }
                asm volatile("" ::: "memory"); }
    }
};

struct EpiResidScale {
    static constexpr bool PERM = false, AFTER_DRAIN = false, KHOOK = true;
    float* C; int ldc; const unsigned short* res; float alpha; const float* SS; float eps;
    __device__ __forceinline__ void unit_begin(const Unit& u, int par, PG8_LAS unsigned char* lds) const {
        const int tid = threadIdx.x, row = tid >> 1, hh = 4 * (tid & 1);
        float sv[4];
        { const f32x4* sp = (const f32x4*)(SS + ((size_t)(u.pm * BM + row) * 8 + hh) * 8);
#pragma unroll
          for (int q = 0; q < 4; ++q) { const f32x4 a = sp[2 * q], b = sp[2 * q + 1]; sv[q] = (a.x + a.y) + (a.z + a.w) + (b.x + b.y) + (b.z + b.w); asm volatile("" ::: "memory"); } }
        const f32x4 s = (f32x4){sv[0], sv[1], sv[2], sv[3]};
        f32x4 rs; rs.x = __builtin_amdgcn_rsqf(s.x * (1.f / 1024.f) + eps); rs.y = __builtin_amdgcn_rsqf(s.y * (1.f / 1024.f) + eps); rs.z = __builtin_amdgcn_rsqf(s.z * (1.f / 1024.f) + eps); rs.w = __builtin_amdgcn_rsqf(s.w * (1.f / 1024.f) + eps);
        *(PG8_LAS f32x4*)(lds + 131072 + par * 8192 + (row * 8 + hh) * 4) = rs;
    }
    __device__ __forceinline__ void khook(f32x4 (&acc)[2][2][4][2], int par, int hb, int wr, int fr, PG8_LAS unsigned char* lds) const {
        const PG8_LAS float* T = (const PG8_LAS float*)(lds + 131072 + par * 8192);
        typedef float f32x2h __attribute__((ext_vector_type(2)));
        f32x2h tv[8]; unsigned ad[8];
#pragma unroll
        for (int i = 0; i < 8; ++i) ad[i] = (unsigned)(size_t)(T + ((i >> 2) * HALF + wr * 64 + (i & 3) * 16 + fr) * 8 + hb - 1);
        asm volatile("ds_read2_b32 %0, %8 offset1:1\n\tds_read2_b32 %1, %9 offset1:1\n\tds_read2_b32 %2, %10 offset1:1\n\tds_read2_b32 %3, %11 offset1:1\n\t"
                     "ds_read2_b32 %4, %12 offset1:1\n\tds_read2_b32 %5, %13 offset1:1\n\tds_read2_b32 %6, %14 offset1:1\n\tds_read2_b32 %7, %15 offset1:1\n\ts_waitcnt lgkmcnt(0)\n\ts_nop 15\n\ts_nop 15"
                     : "=&v"(tv[0]), "=&v"(tv[1]), "=&v"(tv[2]), "=&v"(tv[3]), "=&v"(tv[4]), "=&v"(tv[5]), "=&v"(tv[6]), "=&v"(tv[7])
                     : "v"(ad[0]), "v"(ad[1]), "v"(ad[2]), "v"(ad[3]), "v"(ad[4]), "v"(ad[5]), "v"(ad[6]), "v"(ad[7]) : "memory");
#pragma unroll
        for (int ai = 0; ai < 2; ++ai)
#pragma unroll
            for (int m = 0; m < 4; ++m) { const float ratio = tv[ai * 4 + m].x * __builtin_amdgcn_rcpf(tv[ai * 4 + m].y);
#pragma unroll
                for (int bj = 0; bj < 2; ++bj)
#pragma unroll
                    for (int n = 0; n < 2; ++n) { f32x4& a = acc[ai][bj][m][n];
                        asm volatile("v_mul_f32 %0, %0, %4\n\tv_mul_f32 %1, %1, %4\n\tv_mul_f32 %2, %2, %4\n\tv_mul_f32 %3, %3, %4\n\ts_nop 1" : "+v"(a.x), "+v"(a.y), "+v"(a.z), "+v"(a.w) : "v"(ratio)); } }
    }
    __device__ __forceinline__ void epi(const f32x4 (&acc)[2][2][4][2], const Unit& u, int wr, int wc, int fr, int fq, int par, PG8_LAS unsigned char* lds) const {
        const PG8_LAS float* T = (const PG8_LAS float*)(lds + 131072 + par * 8192);
        const int row0 = u.pm * BM + wr * 64 + fr, col0 = u.pn * BM + wc * 32 + 4 * fq;
#pragma unroll
        for (int ai = 0; ai < 2; ++ai)
#pragma unroll
            for (int m = 0; m < 4; ++m) { const int r = row0 + ai * HALF + m * 16; const float sc = T[(ai * HALF + wr * 64 + m * 16 + fr) * 8 + 7];
                const unsigned short* rp = res + (size_t)r * ldc + col0; float* cp = C + (size_t)r * ldc + col0;
#pragma unroll
                for (int bj = 0; bj < 2; ++bj)
#pragma unroll
                    for (int n = 0; n < 2; ++n) { const uint2 rb = *(const uint2*)(rp + bj * HALF + n * 16);
                        const f32x4 rv = (f32x4){__builtin_bit_cast(float, rb.x << 16), __builtin_bit_cast(float, rb.x & 0xffff0000u), __builtin_bit_cast(float, rb.y << 16), __builtin_bit_cast(float, rb.y & 0xffff0000u)};
                        *(f32x4*)(cp + bj * HALF + n * 16) = rv * alpha + acc[ai][bj][m][n] * sc; }
                asm volatile("" ::: "memory"); }
    }
};


template <class Epi, class Sched, bool ALIGN_EPI = false, bool SP2 = false>
__device__ __forceinline__ void gemm_phase(PG8_LAS unsigned char* lds, const Gemm g, const Sched& S, const Epi& E) {
    const int tid = threadIdx.x, wid = __builtin_amdgcn_readfirstlane(tid >> 6), lane = tid & 63, wr = wid >> 2, wc = wid & 3, fr = lane & 15, fq = lane >> 4;
    const int K = g.K, nt = K / BK;
    unsigned voffA[2], voffB[2];
#pragma unroll
    for (int i = 0; i < 2; ++i) { int R, C; stage_rc(tid * 16 + i * 8192, R, C); const int Rb = Epi::PERM ? ((R & ~31) + perm32(R & 31)) : R;
        voffA[i] = (unsigned)(R * K + C) * 2u; voffB[i] = (unsigned)(Rb * K + C) * 2u; }
    const size_t kstep = (size_t)(BK * 2);
    const size_t hstep = (size_t)HALF * K * 2;
    const size_t tstep = 2 * hstep;
    const unsigned ldsw = (unsigned)wid * 1024u;
    const int aoff = lds_byte(wr * 64 + fr, fq * 8), boff = lds_byte(wc * 32 + fr, fq * 8);
#define PG8_SA(b, h) (((b) * 2 + (h)) * HTB)
#define PG8_SB(b, h) ((4 + (b) * 2 + (h)) * HTB)
#define PG8_STAGE(bufoff, gbase, voff) do { _Pragma("unroll") for (int _i = 0; _i < 2; ++_i) \
        __builtin_amdgcn_global_load_lds((const unsigned*)((const char*)(gbase) + (voff)[_i]), (PG8_LAS unsigned*)(lds + (bufoff) + ldsw + _i * 8192), 16, 0, 0); } while (0)
#define PG8_LDA(dst, b, h) do { _Pragma("unroll") for (int m = 0; m < 4; ++m) _Pragma("unroll") for (int k = 0; k < 2; ++k) dst[m][k] = *(const PG8_LAS bf16x8*)(lds + PG8_SA(b, h) + aoff + m * 2048 + k * 1024); } while (0)
#define PG8_LDB(dst, b, h) do { _Pragma("unroll") for (int n = 0; n < 2; ++n) _Pragma("unroll") for (int k = 0; k < 2; ++k) dst[n][k] = *(const PG8_LAS bf16x8*)(lds + PG8_SB(b, h) + boff + n * 2048 + k * 1024); } while (0)
#define PG8_MMA(ai, bj, At, Bt) do { __builtin_amdgcn_s_setprio(1); _Pragma("unroll") for (int m = 0; m < 4; ++m) _Pragma("unroll") for (int n = 0; n < 2; ++n) _Pragma("unroll") for (int k = 0; k < 2; ++k) \
        acc[ai][bj][m][n] = __builtin_amdgcn_mfma_f32_16x16x32_bf16(Bt[n][k], At[m][k], acc[ai][bj][m][n], 0, 0, 0); __builtin_amdgcn_s_setprio(0); } while (0)
#define PG8_WAIT_V(n) asm volatile("s_waitcnt vmcnt(" #n ")" ::: "memory")
#define PG8_WAIT_L(n) asm volatile("s_waitcnt lgkmcnt(" #n ")" ::: "memory")
#define PG8_BAR __builtin_amdgcn_s_barrier()
#define PG8_SCHED __builtin_amdgcn_sched_barrier(0)
    Unit cur, nxt; int ui = 0;
    if (!S.next(0, cur)) return;
    f32x4 acc[2][2][4][2];
#pragma unroll
    for (int a = 0; a < 2; ++a)
#pragma unroll
        for (int b = 0; b < 2; ++b)
#pragma unroll
            for (int m = 0; m < 4; ++m)
#pragma unroll
                for (int n = 0; n < 2; ++n) acc[a][b][m][n] = (f32x4){0.f, 0.f, 0.f, 0.f};
    bf16x8 At[4][2], B0[2][2], B1[2][2];
    const char* cA = (const char*)g.A + (size_t)cur.pm * tstep; const char* cB = (const char*)g.Bt + (size_t)cur.pn * tstep;
    if constexpr (Epi::KHOOK) E.unit_begin(cur, ui & 1, lds);
    S.a_ready(cur);
    if constexpr (SP2) {
        PG8_STAGE(PG8_SB(0, 0), cB, voffB); PG8_STAGE(PG8_SB(0, 1), cB + hstep, voffB); PG8_STAGE(PG8_SA(0, 0), cA, voffA); PG8_STAGE(PG8_SA(0, 1), cA + hstep, voffA);
        if (wr == 1) PG8_BAR;
        PG8_WAIT_V(2); PG8_BAR;
        PG8_STAGE(PG8_SB(1, 0), cB + kstep, voffB); PG8_STAGE(PG8_SA(1, 0), cA + kstep, voffA); PG8_STAGE(PG8_SB(1, 1), cB + hstep + kstep, voffB);
        PG8_WAIT_V(6); PG8_BAR;
    } else {
        PG8_STAGE(PG8_SB(0, 0), cB, voffB); PG8_STAGE(PG8_SA(0, 0), cA, voffA); PG8_STAGE(PG8_SB(0, 1), cB + hstep, voffB); PG8_STAGE(PG8_SA(0, 1), cA + hstep, voffA);
        if (wr == 1) PG8_BAR;
        PG8_WAIT_V(4); PG8_BAR;
        PG8_STAGE(PG8_SB(1, 0), cB + kstep, voffB); PG8_STAGE(PG8_SA(1, 0), cA + kstep, voffA); PG8_STAGE(PG8_SB(1, 1), cB + hstep + kstep, voffB);
        PG8_WAIT_V(6); PG8_BAR;
    }
    for (;;) {
        const bool has_next = S.next(ui + 1, nxt);
        const char* nA = has_next ? (const char*)g.A + (size_t)nxt.pm * tstep : cA; const char* nB = has_next ? (const char*)g.Bt + (size_t)nxt.pn * tstep : cB;
        const int tseg = Epi::KHOOK ? 16 : nt;
        for (int tb = 0; tb < nt; tb += tseg) {
        if constexpr (Epi::KHOOK) { if (tb != 0) { PG8_SCHED; E.khook(acc, ui & 1, tb >> 4, wr, fr, lds); PG8_SCHED; } }
        for (int t = tb; t < tb + tseg; t += 2) {
            const bool last = (t == nt - 2);
            const char* a1 = cA + (size_t)(t + 1) * kstep;
            const char* a2 = last ? nA : cA + (size_t)(t + 2) * kstep; const char* b2 = last ? nB : cB + (size_t)(t + 2) * kstep;
            const char* a3 = a2 + kstep; const char* b3 = b2 + kstep;
            if (last && has_next) S.a_ready(nxt);
            if constexpr (SP2) {
            PG8_LDB(B0, 0, 0); PG8_LDB(B1, 0, 1); PG8_SCHED; PG8_LDA(At, 0, 0); PG8_STAGE(PG8_SA(1, 1), a1 + hstep, voffA);
            PG8_WAIT_V(8); PG8_WAIT_L(0); PG8_BAR; PG8_MMA(0, 0, At, B0); PG8_MMA(0, 1, At, B1); PG8_BAR; PG8_SCHED;
            PG8_LDA(At, 0, 1); PG8_STAGE(PG8_SB(0, 0), b2, voffB); PG8_STAGE(PG8_SB(0, 1), b2 + hstep, voffB); PG8_STAGE(PG8_SA(0, 0), a2, voffA);
            PG8_WAIT_V(8); PG8_WAIT_L(0); PG8_BAR; PG8_MMA(1, 0, At, B0); PG8_MMA(1, 1, At, B1); PG8_BAR; PG8_SCHED;
            PG8_LDB(B0, 1, 0); PG8_LDB(B1, 1, 1); PG8_SCHED; PG8_LDA(At, 1, 0); PG8_STAGE(PG8_SA(0, 1), a2 + hstep, voffA);
            PG8_WAIT_V(8); PG8_WAIT_L(0); PG8_BAR; PG8_MMA(0, 0, At, B0); PG8_MMA(0, 1, At, B1); PG8_BAR; PG8_SCHED;
            PG8_LDA(At, 1, 1); PG8_STAGE(PG8_SB(1, 0), b3, voffB); PG8_STAGE(PG8_SB(1, 1), b3 + hstep, voffB); PG8_STAGE(PG8_SA(1, 0), a3, voffA);
            PG8_WAIT_V(8); PG8_WAIT_L(0); PG8_BAR; PG8_MMA(1, 0, At, B0); PG8_MMA(1, 1, At, B1); PG8_BAR; PG8_SCHED;
            } else {
            PG8_LDB(B0, 0, 0); PG8_SCHED; PG8_LDA(At, 0, 0); PG8_STAGE(PG8_SA(1, 1), a1 + hstep, voffA);
            PG8_WAIT_L(8); PG8_BAR; PG8_WAIT_L(0); PG8_MMA(0, 0, At, B0); PG8_BAR; PG8_SCHED;
            PG8_LDB(B1, 0, 1); PG8_STAGE(PG8_SB(0, 0), b2, voffB);
            PG8_BAR; PG8_WAIT_L(0); PG8_MMA(0, 1, At, B1); PG8_BAR;
            PG8_LDA(At, 0, 1); PG8_STAGE(PG8_SA(0, 0), a2, voffA);
            PG8_BAR; PG8_WAIT_L(0); PG8_MMA(1, 0, At, B0); PG8_BAR; PG8_SCHED;
            PG8_STAGE(PG8_SB(0, 1), b2 + hstep, voffB);
            PG8_WAIT_V(6); PG8_BAR; PG8_MMA(1, 1, At, B1); PG8_BAR;
            PG8_LDB(B0, 1, 0); PG8_SCHED; PG8_LDA(At, 1, 0); PG8_STAGE(PG8_SA(0, 1), a2 + hstep, voffA);
            PG8_WAIT_L(8); PG8_BAR; PG8_WAIT_L(0); PG8_MMA(0, 0, At, B0); PG8_BAR; PG8_SCHED;
            PG8_LDB(B1, 1, 1); PG8_STAGE(PG8_SB(1, 0), b3, voffB);
            PG8_BAR; PG8_WAIT_L(0); PG8_MMA(0, 1, At, B1); PG8_BAR;
            PG8_LDA(At, 1, 1); PG8_STAGE(PG8_SA(1, 0), a3, voffA);
            PG8_BAR; PG8_WAIT_L(0); PG8_MMA(1, 0, At, B0); PG8_BAR; PG8_SCHED;
            PG8_STAGE(PG8_SB(1, 1), b3 + hstep, voffB);
            PG8_WAIT_V(6); PG8_BAR; PG8_MMA(1, 1, At, B1); PG8_BAR;
            }
        }
        }
        if constexpr (ALIGN_EPI) { if (wr == 0) PG8_BAR; }
        if constexpr (Epi::KHOOK) { E.epi(acc, cur, wr, wc, fr, fq, ui & 1, lds); S.done(cur); }
        else if constexpr (!Epi::AFTER_DRAIN) { E(acc, cur, wr, wc, fr, fq); S.done(cur); }
        if (!has_next) break;
#pragma unroll
        for (int a = 0; a < 2; ++a)
#pragma unroll
            for (int b = 0; b < 2; ++b)
#pragma unroll
                for (int m = 0; m < 4; ++m)
#pragma unroll
                    for (int n = 0; n < 2; ++n) acc[a][b][m][n] = (f32x4){0.f, 0.f, 0.f, 0.f};
        cur = nxt; cA = nA; cB = nB; ++ui;
        if constexpr (Epi::KHOOK) E.unit_begin(cur, ui & 1, lds);
        if constexpr (ALIGN_EPI) { if (wr == 1) PG8_BAR; }
    }
    PG8_WAIT_V(0);
    if constexpr (!ALIGN_EPI) { if (wr == 0) PG8_BAR; }
    PG8_BAR;
    if constexpr (Epi::AFTER_DRAIN) { E.fused(acc, cur, wr, wc, fr, fq, lds, wid, lane); S.done(cur); }
#undef PG8_SA
#undef PG8_SB
#undef PG8_STAGE
#undef PG8_LDA
#undef PG8_LDB
#undef PG8_MMA
#undef PG8_WAIT_V
#undef PG8_WAIT_L
#undef PG8_BAR
#undef PG8_SCHED
}
}
#ifndef PG8_SP2
#define PG8_SP2 true
#endif
#ifndef PG8_ALIGN
#define PG8_ALIGN true
#endif

constexpr int NWAVES = 8;
constexpr int PER_PHASE = 12;
#ifndef MK_N_LAUNCHES
#define MK_N_LAUNCHES 1
#endif
#ifndef PROBE_MASK
#define PROBE_MASK 0
#endif
#define REP(k) (((PROBE_MASK >> (k)) & 1) + 1)
#ifndef PROBE_VAR
#define PROBE_VAR 0
#endif
#ifndef PROBE_CLK
#define PROBE_CLK 0
#endif
#ifndef STAMP_MASK
#define STAMP_MASK 0
#endif
#ifndef USE_AUX
#define USE_AUX 0
#endif
#ifndef USE_TILE_TRANSPOSE
#define USE_TILE_TRANSPOSE 0
#endif
#ifndef USE_L1_SEQ2
#define USE_L1_SEQ2 0
#endif
#ifndef USE_FUSED_NORM
#define USE_FUSED_NORM 1
#define RES_BF16 (USE_FUSED_NORM && USE_L1_MFMA)
#endif
#ifndef P0_META_FOLD
#define P0_META_FOLD (USE_L0_MFMA == 2 && !USE_TILE_TRANSPOSE)
#endif
#ifndef USE_TICKETS
#define USE_TICKETS 0
#endif
constexpr int N_LAUNCHES = MK_N_LAUNCHES;

constexpr int D = 4096, NB = 4, SEQ = 2048, NMETA = 16, DI = 8192;
constexpr int MX = NB * SEQ;
constexpr int MR = MX + NMETA;
constexpr int MP = 8448;
constexpr int N0 = 4 * DI;
constexpr int N1 = 2 * 4096 + 2 * DI;
constexpr int HG_H = 64, HG_DK = 128;
constexpr int GL_H = 8, GL_DK = 512, GL_DV = 1024, GL_R = 16;
constexpr float LN_EPS = 1e-5f, RMS_EPS = 1e-6f;
constexpr float ALPHA = 1.41421356237309515f;

constexpr size_t MiB = 1u << 20;
constexpr size_t WS_CTL = 0, CTL_ZERO_BYTES = 1 * MiB;
constexpr size_t WS_LB0 = 1 * MiB;
constexpr size_t WS_G1 = 2 * MiB;
constexpr size_t WS_WG1T = 3 * MiB;
constexpr size_t WS_W2F = 3 * MiB + 256 * 1024;
constexpr size_t WS_WT0IN = 4 * MiB;
constexpr size_t WS_WT0OUT = WS_WT0IN + 256 * MiB;
constexpr size_t WS_WT1IN = WS_WT0OUT + 64 * MiB;
constexpr size_t WS_WT1OUT = WS_WT1IN + 192 * MiB;
constexpr size_t WS_XB = WS_WT1OUT + 64 * MiB;
constexpr size_t WS_H1B = WS_XB + 66 * MiB;
constexpr size_t WS_QFIZ = WS_H1B + 66 * MiB;
constexpr size_t WS_Y = WS_QFIZ + 528 * MiB;
constexpr size_t WS_PRE = WS_Y + 132 * MiB;
constexpr size_t WS_REC = WS_PRE + 132 * MiB;
constexpr size_t WS_Q0 = WS_REC + 520 * MiB;
constexpr size_t WS_Y0 = WS_REC + 523 * MiB;
constexpr size_t WS_REC1 = WS_REC, WS_VF1 = WS_REC + 139 * MiB, WS_O1 = WS_REC + 270 * MiB;
constexpr size_t WS_END = WS_REC + 528 * MiB;
static_assert((size_t)MP * D * 2 <= 66 * MiB && (size_t)MP * N0 * 2 <= 528 * MiB && (size_t)MP * DI * 2 <= 132 * MiB && (size_t)MP * D * 4 <= 132 * MiB && (size_t)MR * DI * 4 <= 258 * MiB, "d_ws map");
static_assert((size_t)256 * 65 * 27648 <= 440 * MiB && (size_t)32 * 65 * 69632 <= 139 * MiB && (size_t)32 * 65 * 65536 <= 131 * MiB, "record map");
constexpr int CW_BAR = 4096, CW_POOL = 8192;

constexpr int RING_OFF = 0, RING_BYTES = 155648;
constexpr int LDSCTL_OFF = RING_BYTES, MISC_OFF = LDSCTL_OFF + 320;
constexpr int LDS_BYTES = 163840;
static_assert(MISC_OFF + 128 <= LDS_BYTES, "LDS map");

#define GAS __attribute__((address_space(1)))
#define LAS __attribute__((address_space(3)))
typedef unsigned short bf16;
typedef unsigned v4u __attribute__((ext_vector_type(4)));
typedef unsigned v2u __attribute__((ext_vector_type(2)));
typedef float f32x4 __attribute__((ext_vector_type(4)));
typedef GAS unsigned gu32;
#define RLX_AGENT __ATOMIC_RELAXED, __HIP_MEMORY_SCOPE_AGENT
#define LDS_WAIT() asm volatile("s_waitcnt lgkmcnt(0)" ::: "memory")
#define DI_ __device__ __forceinline__
DI_ unsigned f2bf(float f) { unsigned u = __builtin_bit_cast(unsigned, f); return (u + 0x7fffu + ((u >> 16) & 1u)) >> 16; }
DI_ unsigned pk2(float lo, float hi) { return f2bf(lo) | (f2bf(hi) << 16); }
DI_ unsigned hwpk(float lo, float hi) { unsigned r; asm volatile("v_cvt_pk_bf16_f32 %0, %1, %2" : "=v"(r) : "v"(lo), "v"(hi)); return r; }
DI_ float bflo(unsigned w) { return __builtin_bit_cast(float, w << 16); }
DI_ float bfhi(unsigned w) { return __builtin_bit_cast(float, w & 0xffff0000u); }
DI_ float bf2f(bf16 b) { return __builtin_bit_cast(float, (unsigned)b << 16); }
DI_ float sigm(float x) { return __builtin_amdgcn_rcpf(1.f + __builtin_amdgcn_exp2f(x * -1.4426950408889634f)); }
DI_ float silu(float x) { return x * __builtin_amdgcn_rcpf(1.f + __builtin_amdgcn_exp2f(x * -1.4426950408889634f)); }

#define XB_TMO      128
#define XB_XCNT(j)  (256  + 64 * (j))
#define XB_XSUB(j)  (1280 + 64 * (j))
#define XB_XGEN(j)  (2304 + 64 * (j))
#define XB_TOP      3328
#define XB_TOPGEN   3392
#define XCD_BAR_WORDS 3456
#define XB_SPIN_CAP (1u << 18)

__device__ __forceinline__ unsigned xb_ld(unsigned* p)              { return __hip_atomic_load(p, __ATOMIC_RELAXED, __HIP_MEMORY_SCOPE_AGENT); }
__device__ __forceinline__ unsigned xb_add(unsigned* p, unsigned v) { return __hip_atomic_fetch_add(p, v, __ATOMIC_RELAXED, __HIP_MEMORY_SCOPE_AGENT); }
__device__ __forceinline__ unsigned xb_xcc_id() { return (unsigned)__builtin_amdgcn_s_getreg((3 << 11) | 20) & 0xFu; }
#define XB_SPIN(cond, bar) do { unsigned _sp = 0; while (cond) { __builtin_amdgcn_s_sleep(1); \
    if ((++_sp & 255u) == 0u) { if (xb_ld(&(bar)[XB_TMO])) break; if (_sp > XB_SPIN_CAP) { atomicAdd(&(bar)[XB_TMO], 1u); break; } } } } while (0)

struct XcdBarrier {
    unsigned* bar; unsigned x;
    volatile LAS unsigned* st;
};
__device__ __forceinline__ XcdBarrier xcd_barrier_post(unsigned* bar, volatile LAS unsigned* st) {
    XcdBarrier b; b.bar = bar; b.x = xb_xcc_id(); b.st = st;
    if (threadIdx.x == 0) (void)xb_add(&bar[XB_XCNT(b.x)], 1u);
    return b;
}
__device__ __forceinline__ void xcd_barrier_complete(unsigned* bar, unsigned x, unsigned& nloc, unsigned& nx) {
    const unsigned G = gridDim.x * gridDim.y * gridDim.z;
    unsigned sum, cnt, mine, sp = 0u;
    for (;;) {
        sum = 0u; cnt = 0u; mine = 0u;
#pragma unroll
        for (unsigned j = 0; j < 16; ++j) { const unsigned c = xb_ld(&bar[XB_XCNT(j)]); sum += c; cnt += (c > 0u) ? 1u : 0u; mine = (j == x) ? c : mine; }
        if (sum == G) break;
        __builtin_amdgcn_s_sleep(1);
        if ((++sp & 255u) == 0u) { if (xb_ld(&bar[XB_TMO])) break; if (sp > XB_SPIN_CAP) { atomicAdd(&bar[XB_TMO], 1u); break; } }
    }
    nloc = mine > 0u ? mine : 1u; nx = cnt > 0u ? cnt : 1u;
}
__device__ __forceinline__ void xcd_barrier(const XcdBarrier& b) {
    asm volatile("s_waitcnt vmcnt(0)" ::: "memory");
    __syncthreads();
    if (threadIdx.x == 0) {
        unsigned* bar = b.bar;
        __builtin_amdgcn_s_waitcnt(0);
        unsigned nloc = b.st[0], nx = b.st[1];
        if (nloc == 0u) { xcd_barrier_complete(bar, b.x, nloc, nx); b.st[0] = nloc; b.st[1] = nx; }
        const unsigned old = xb_add(&bar[XB_XSUB(b.x)], 1u);
        const unsigned gen = old / nloc;
        if (old + 1u == (gen + 1u) * nloc) {
            __builtin_amdgcn_fence(__ATOMIC_RELEASE, "agent");
            asm volatile("s_waitcnt vmcnt(0)" ::: "memory");
            const unsigned og = xb_add(&bar[XB_TOP], 1u);
            const unsigned tg = og / nx;
            if (og + 1u == (tg + 1u) * nx) xb_add(&bar[XB_TOPGEN], 1u);
            else XB_SPIN(xb_ld(&bar[XB_TOPGEN]) == tg, bar);
            __builtin_amdgcn_fence(__ATOMIC_ACQUIRE, "agent");
            xb_add(&bar[XB_XGEN(b.x)], 1u);
            asm volatile("s_waitcnt vmcnt(0)" ::: "memory");
        } else {
            XB_SPIN(xb_ld(&bar[XB_XGEN(b.x)]) == gen, bar);
            __builtin_amdgcn_fence(__ATOMIC_ACQUIRE, "agent");
            asm volatile("s_waitcnt vmcnt(0)" ::: "memory");
        }
    }
    __syncthreads();
}

struct Frame {
    LAS unsigned char* lds;
    volatile LAS unsigned* MISC;
    gu32* ctl;
    int tid, lane, wave;
    int vcu, G;
    const float *x, *meta, *lb_logits;
    const float *w0in, *b_f, *ng0, *w0out, *ln0g, *ln0b;
    const float *w1in, *wg1, *wg2, *b_g, *ng1, *w1out, *ln1g, *ln1b;
    float* out;
    float *LB0, *G1, *PRE, *O1;
    unsigned char *REC0, *REC1, *VF1;
    bf16 *WG1T, *W2F, *Q0, *Y0;
    float* SS;
    bf16 *WT0IN, *WT0OUT, *WT1IN, *WT1OUT, *XB, *H1B, *QFIZ, *Y;
};

DI_ float wave_sum(float v) {
#pragma unroll
    for (int o = 1; o < 64; o <<= 1) v += __shfl_xor(v, o);
    return v;
}

typedef short p0_bf16x8 __attribute__((ext_vector_type(8)));
template <bool META>
DI_ void p0_transpose_item_t(const float* W, int K, int N, bf16* WT, LAS float* scr, int item_kb, int item_nb, int lane, const float* meta, f32x4 (&macc)[2]) {
    const int k0 = 64 * item_kb, n0 = 32 * item_nb;
    float wv[32];
#pragma unroll
    for (int i = 0; i < 32; ++i) wv[i] = __builtin_nontemporal_load(W + (size_t)(k0 + 2 * i + (lane >> 5)) * N + n0 + (lane & 31));
    v4u ma[2][2];
    if (META) {
#pragma unroll
        for (int ks = 0; ks < 2; ++ks) { const GAS f32x4* mp = (const GAS f32x4*)(meta + (size_t)(lane & 15) * D + k0 + 32 * ks + 8 * (lane >> 4)); const f32x4 a = mp[0], b = mp[1];
            ma[ks][0] = (v4u){hwpk(a.x, a.y), hwpk(a.z, a.w), hwpk(b.x, b.y), hwpk(b.z, b.w)}; }
    }
#pragma unroll
    for (int i = 0; i < 32; ++i) scr[(2 * i + (lane >> 5)) * 33 + (lane & 31)] = wv[i];
    LDS_WAIT(); asm volatile("" ::: "memory");
    if (META) {
        const int r = lane & 15, g = lane >> 4;
#pragma unroll
        for (int ks = 0; ks < 2; ++ks)
#pragma unroll
            for (int nh = 0; nh < 2; ++nh) { const LAS float* s = scr + (32 * ks + 8 * g) * 33 + 16 * nh + r;
                const v4u bf = (v4u){hwpk(s[0 * 33], s[1 * 33]), hwpk(s[2 * 33], s[3 * 33]), hwpk(s[4 * 33], s[5 * 33]), hwpk(s[6 * 33], s[7 * 33])};
                macc[nh] = __builtin_amdgcn_mfma_f32_16x16x32_bf16(__builtin_bit_cast(p0_bf16x8, ma[ks][0]), __builtin_bit_cast(p0_bf16x8, bf), macc[nh], 0, 0, 0); }
    }
    const int c = lane & 7;
#pragma unroll
    for (int j = 0; j < 4; ++j) { const int n = (lane >> 3) + 8 * j; const LAS float* s = scr + (8 * c) * 33 + n;
        v4u o; o.x = hwpk(s[0 * 33], s[1 * 33]); o.y = hwpk(s[2 * 33], s[3 * 33]); o.z = hwpk(s[4 * 33], s[5 * 33]); o.w = hwpk(s[6 * 33], s[7 * 33]);
        *(GAS v4u*)(WT + (size_t)(n0 + n) * K + k0 + 8 * c) = o; }
    LDS_WAIT(); asm volatile("" ::: "memory");
}
struct P0Item { const float* src; bf16* dst; int N, K; };
template <bool META, bool PREF>
DI_ void p0_item_pipe(const P0Item cur, const P0Item nxt, float (&wv)[32], f32x4 (&mraw)[4], LAS float* scr, int lane, const float* meta_nxt, f32x4 (&macc)[2]) {
#pragma unroll
    for (int i = 0; i < 32; ++i) scr[(2 * i + (lane >> 5)) * 33 + (lane & 31)] = wv[i];
    v4u ma[2];
    if (META) {
#pragma unroll
        for (int ks = 0; ks < 2; ++ks) { const f32x4 a = mraw[2 * ks], b = mraw[2 * ks + 1]; ma[ks] = (v4u){pk2(a.x, a.y), pk2(a.z, a.w), pk2(b.x, b.y), pk2(b.z, b.w)}; }
    }
    if (PREF) {
        if (META) {
#pragma unroll
            for (int ks = 0; ks < 2; ++ks) { const GAS f32x4* mp = (const GAS f32x4*)(meta_nxt + (size_t)(lane & 15) * D + 32 * ks + 8 * (lane >> 4)); mraw[2 * ks] = mp[0]; mraw[2 * ks + 1] = mp[1]; }
        }
#pragma unroll
        for (int i = 0; i < 32; ++i) wv[i] = __builtin_nontemporal_load(nxt.src + (size_t)(2 * i + (lane >> 5)) * nxt.N + (lane & 31));
    }
    LDS_WAIT(); asm volatile("" ::: "memory");
    if (META) {
        const int r = lane & 15, g = lane >> 4;
#pragma unroll
        for (int ks = 0; ks < 2; ++ks)
#pragma unroll
            for (int nh = 0; nh < 2; ++nh) { const LAS float* s = scr + (32 * ks + 8 * g) * 33 + 16 * nh + r;
                const v4u bf = (v4u){hwpk(s[0 * 33], s[1 * 33]), hwpk(s[2 * 33], s[3 * 33]), hwpk(s[4 * 33], s[5 * 33]), hwpk(s[6 * 33], s[7 * 33])};
                macc[nh] = __builtin_amdgcn_mfma_f32_16x16x32_bf16(__builtin_bit_cast(p0_bf16x8, ma[ks]), __builtin_bit_cast(p0_bf16x8, bf), macc[nh], 0, 0, 0); }
    }
    const int c = lane & 7;
#pragma unroll
    for (int j = 0; j < 4; ++j) { const int n = (lane >> 3) + 8 * j; const LAS float* s = scr + (8 * c) * 33 + n;
        v4u o; o.x = hwpk(s[0 * 33], s[1 * 33]); o.y = hwpk(s[2 * 33], s[3 * 33]); o.z = hwpk(s[4 * 33], s[5 * 33]); o.w = hwpk(s[6 * 33], s[7 * 33]);
        *(GAS v4u*)(cur.dst + (size_t)n * cur.K + 8 * c) = o; }
    LDS_WAIT(); asm volatile("" ::: "memory");
}
struct P0Grp { const float* src; bf16* dst; int N, K; };
template <typename T> DI_ T* p0_uni(T* p) { const unsigned long long a = (unsigned long long)p; const unsigned lo = __builtin_amdgcn_readfirstlane((unsigned)a), hi = __builtin_amdgcn_readfirstlane((unsigned)(a >> 32)); return (T*)(((unsigned long long)hi << 32) | lo); }
DI_ P0Grp p0_uni(const P0Grp& x) { return P0Grp{p0_uni(x.src), p0_uni(x.dst), __builtin_amdgcn_readfirstlane(x.N), __builtin_amdgcn_readfirstlane(x.K)}; }
constexpr int P0_PITCH = 528, P0_TILE = 17408;
template <bool META, bool LAST>
DI_ void p0_group(const P0Grp cur, const P0Grp nxt, float (&wv)[2][32], f32x4 (&mraw)[2][4], LAS unsigned char* tile, int lane, const float* meta_cur, const float* meta_nxt, f32x4 (&macc)[2]) {
    const int half = lane >> 5, n = lane & 31, r = lane & 15, g = lane >> 4;
#pragma unroll
    for (int q = 0; q < 4; ++q) {
        unsigned dw[16];
#pragma unroll
        for (int p = 0; p < 16; ++p) dw[p] = hwpk(wv[q & 1][2 * p], wv[q & 1][2 * p + 1]);
#pragma unroll
        for (int t = 0; t < 4; ++t) *(LAS v4u*)(tile + n * P0_PITCH + (64 * q + 32 * half) * 2 + 16 * t) = (v4u){dw[4 * t], dw[4 * t + 1], dw[4 * t + 2], dw[4 * t + 3]};
        asm volatile("" ::: "memory");
        v4u ma[2];
        if (META) {
#pragma unroll
            for (int ks = 0; ks < 2; ++ks) { const f32x4 a = mraw[q & 1][2 * ks], b = mraw[q & 1][2 * ks + 1]; ma[ks] = (v4u){pk2(a.x, a.y), pk2(a.z, a.w), pk2(b.x, b.y), pk2(b.z, b.w)}; }
        }
        if (!(LAST && q >= 2)) {
            const float* ns = (q < 2) ? cur.src + (size_t)(64 * (q + 2)) * cur.N : nxt.src + (size_t)(64 * (q - 2)) * nxt.N; const int nN = (q < 2) ? cur.N : nxt.N;
            if (META) { const float* mn = (q < 2) ? meta_cur + 64 * (q + 2) : meta_nxt + 64 * (q - 2);
#pragma unroll
                for (int ks = 0; ks < 2; ++ks) { const GAS f32x4* mp = (const GAS f32x4*)(mn + (size_t)r * D + 32 * ks + 8 * g); mraw[q & 1][2 * ks] = mp[0]; mraw[q & 1][2 * ks + 1] = mp[1]; } }
            const unsigned lo_ = (unsigned)(32 * half) * (unsigned)nN + n;
#pragma unroll
            for (int i = 0; i < 32; ++i) wv[q & 1][i] = __builtin_nontemporal_load((const GAS float*)(ns + (size_t)i * nN) + lo_);
        }
        asm volatile("" ::: "memory");
        if (META) {
            LDS_WAIT(); asm volatile("" ::: "memory");
#pragma unroll
            for (int ks = 0; ks < 2; ++ks)
#pragma unroll
                for (int nh = 0; nh < 2; ++nh) { const p0_bf16x8 bf = *(const LAS p0_bf16x8*)(tile + (16 * nh + r) * P0_PITCH + (64 * q + 32 * ks + 8 * g) * 2);
                    macc[nh] = __builtin_amdgcn_mfma_f32_16x16x32_bf16(__builtin_bit_cast(p0_bf16x8, ma[ks]), bf, macc[nh], 0, 0, 0); }
        }
    }
    LDS_WAIT(); asm volatile("" ::: "memory");
    const unsigned so_ = (unsigned)half * (unsigned)cur.K + 8 * n;
#pragma unroll
    for (int j = 0; j < 16; ++j) { const v4u o = *(const LAS v4u*)(tile + (2 * j + half) * P0_PITCH + 16 * n); *(GAS v4u*)((GAS bf16*)(cur.dst + (size_t)(2 * j) * cur.K) + so_) = o; }
    LDS_WAIT(); asm volatile("" ::: "memory");
}
DI_ void p0_transpose_item(const float* W, int K, int N, bf16* WT, LAS float* scr, int item, int lane) {
    f32x4 dummy[2]; const int nblk = N / 32;
    p0_transpose_item_t<false>(W, K, N, WT, scr, item / nblk, item % nblk, lane, nullptr, dummy);
}

DI_ void p0_tile_load(const float* W, int N, int k0, int n0, int tid, f32x4 (&wv)[8]) {
    const int row = tid >> 5, c4 = tid & 31;
#pragma unroll
    for (int i = 0; i < 8; ++i) wv[i] = *(const GAS f32x4*)(W + (size_t)(k0 + row + 16 * i) * N + n0 + 4 * c4);
}
DI_ void p0_tile_to_lds(int tid, const f32x4 (&wv)[8], LAS unsigned char* img) {
    const int row = tid >> 5, c4 = tid & 31;
#pragma unroll
    for (int i = 0; i < 8; ++i) { const int k = row + 16 * i; const int col = (2 * c4) ^ (2 * ((k >> 3) & 15));
        *(LAS v2u*)(img + k * 256 + col * 4) = (v2u){hwpk(wv[i].x, wv[i].y), hwpk(wv[i].z, wv[i].w)}; }
}
DI_ void p0_tile_from_lds(bf16* WT, int K, int k0, int n0, int tid, LAS unsigned char* img) {
    __syncthreads();
    const int kc = tid & 15;
#pragma unroll
    for (int j = 0; j < 4; ++j) { const int n = (tid >> 4) + 32 * j; unsigned short hv[8];
#pragma unroll
        for (int e = 0; e < 8; ++e) hv[e] = *(const LAS unsigned short*)(img + (8 * kc + e) * 256 + ((((n >> 1) ^ (2 * kc)) << 2) | ((n & 1) << 1)));
        v4u o; o.x = hv[0] | ((unsigned)hv[1] << 16); o.y = hv[2] | ((unsigned)hv[3] << 16); o.z = hv[4] | ((unsigned)hv[5] << 16); o.w = hv[6] | ((unsigned)hv[7] << 16);
        *(GAS v4u*)(WT + (size_t)(n0 + n) * K + k0 + 8 * kc) = o; }
    __syncthreads();
}
struct P0Tile { const float* W; bf16* WT; int K, N, k0, n0; };
DI_ P0Tile p0_tile_decode(Frame& F, int t) {
    constexpr int T_0 = (D / 128) * (N0 / 128), T_1 = (DI / 128) * (D / 128), T_2 = (D / 128) * (N1 / 128);
    P0Tile p;
    if (t < T_0) { p.W = F.w0in; p.WT = F.WT0IN; p.K = D; p.N = N0; }
    else if (t < T_0 + T_1) { t -= T_0; p.W = F.w0out; p.WT = F.WT0OUT; p.K = DI; p.N = D; }
    else if (t < T_0 + T_1 + T_2) { t -= T_0 + T_1; p.W = F.w1in; p.WT = F.WT1IN; p.K = D; p.N = N1; }
    else { t -= T_0 + T_1 + T_2; p.W = F.w1out; p.WT = F.WT1OUT; p.K = DI; p.N = D; }
    const int nt = p.N / 128, kb = t / nt, nb = t - kb * nt; p.k0 = 128 * kb; p.n0 = 128 * nb; return p;
}
DI_ void p0_transpose_all(Frame& F) {
    constexpr int NT = (D / 128) * (N0 / 128) + 2 * (DI / 128) * (D / 128) + (D / 128) * (N1 / 128);
    f32x4 wv[8];
    int t = F.vcu;
    if (t < NT) { const P0Tile p = p0_tile_decode(F, t); p0_tile_load(p.W, p.N, p.k0, p.n0, F.tid, wv); }
    for (; t < NT; t += F.G) {
        const P0Tile p = p0_tile_decode(F, t);
        p0_tile_to_lds(F.tid, wv, F.lds);
        if (t + F.G < NT) { const P0Tile q = p0_tile_decode(F, t + F.G); p0_tile_load(q.W, q.N, q.k0, q.n0, F.tid, wv); }
        p0_tile_from_lds(p.WT, p.K, p.k0, p.n0, F.tid, F.lds);
    }
}

DI_ void p0_prologue(Frame& F) {
    LAS float* scr = (LAS float*)(F.lds + RING_OFF + F.wave * 16384);
    const int gw = F.vcu * NWAVES + F.wave, NGW = F.G * NWAVES;
    constexpr int I_0 = (D / 64) * (N0 / 32), I_1 = (DI / 64) * (D / 32), I_2 = (D / 64) * (N1 / 32), I_3 = I_1;
    constexpr int NITEMS = I_0 + I_1 + I_2 + I_3;
#if USE_TILE_TRANSPOSE
    p0_transpose_all(F);
#else
    if (P0_META_FOLD && F.G == 256) {
        constexpr int G_1 = (DI / 256) * (D / 32), G_2 = (D / 256) * (N1 / 32), G_3 = G_1;
        static_assert(G_1 + G_2 + G_3 == 1024 * 2 + 1024 * 18, "group split");
        auto other = [&](int q) -> P0Grp {
            const float* W; bf16* WT; int K, N;
            if (q < G_1) { W = F.w0out; WT = F.WT0OUT; K = DI; N = D; }
            else if (q < G_1 + G_2) { q -= G_1; W = F.w1in; WT = F.WT1IN; K = D; N = N1; }
            else { q -= G_1 + G_2; W = F.w1out; WT = F.WT1OUT; K = DI; N = D; }
            const int nblk = N / 32, kg = q / nblk, nb = q - kg * nblk;
            return p0_uni(P0Grp{W + (size_t)(256 * kg) * N + 32 * nb, WT + (size_t)(32 * nb) * K + 256 * kg, N, K});
        };
        LAS unsigned char* tile = F.lds + RING_OFF + F.wave * P0_TILE;
        float wv[2][32]; f32x4 mraw[2][4]; f32x4 macc[2]; macc[0] = (f32x4){0.f, 0.f, 0.f, 0.f}; macc[1] = macc[0];
        const int lane = F.lane;
        int o_lo, o_hi;
        P0Grp cur;
        if (gw < 1024) {
            cur = p0_uni(P0Grp{F.w0in + 32 * gw, F.WT0IN + (size_t)(32 * gw) * D, N0, D});
#pragma unroll
            for (int q = 0; q < 2; ++q)
#pragma unroll
                for (int ks = 0; ks < 2; ++ks) { const GAS f32x4* mp = (const GAS f32x4*)(F.meta + (size_t)(lane & 15) * D + 64 * q + 32 * ks + 8 * (lane >> 4)); mraw[q][2 * ks] = mp[0]; mraw[q][2 * ks + 1] = mp[1]; }
            o_lo = gw * 2; o_hi = o_lo + 2;
        } else { o_lo = 2048 + (gw - 1024) * 18; o_hi = o_lo + 18; cur = other(o_lo); }
#pragma unroll
        for (int q = 0; q < 2; ++q)
#pragma unroll
            for (int i = 0; i < 32; ++i) wv[q][i] = __builtin_nontemporal_load((const GAS float*)(cur.src + (size_t)(64 * q + i) * cur.N) + ((unsigned)(32 * (lane >> 5)) * (unsigned)cur.N + (lane & 31)));
        if (gw < 1024) {
            for (int kg = 0; kg < D / 256 - 1; ++kg) {
                const P0Grp nxt = P0Grp{cur.src + (size_t)256 * N0, cur.dst + 256, N0, D};
                p0_group<true, false>(cur, nxt, wv, mraw, tile, lane, F.meta + 256 * kg, F.meta + 256 * (kg + 1), macc); cur = nxt; }
            { const P0Grp nxt = other(o_lo); p0_group<true, false>(cur, nxt, wv, mraw, tile, lane, F.meta + 256 * (D / 256 - 1), F.meta, macc); cur = nxt; }
            const int r = lane & 15, g = lane >> 4;
#pragma unroll
            for (int nh = 0; nh < 2; ++nh) { const float mv[4] = {macc[nh].x, macc[nh].y, macc[nh].z, macc[nh].w};
#pragma unroll
                for (int jj = 0; jj < 4; ++jj) F.Q0[(size_t)(16 + 4 * g + jj) * N0 + 32 * gw + 16 * nh + r] = (bf16)f2bf(mv[jj]); }
        }
        for (int it = o_lo; it < o_hi - 1; ++it) { const P0Grp nxt = other(it + 1); p0_group<false, false>(cur, nxt, wv, mraw, tile, lane, nullptr, nullptr, macc); cur = nxt; }
        p0_group<false, true>(cur, cur, wv, mraw, tile, lane, nullptr, nullptr, macc);
    } else
    for (int it = gw; it < NITEMS; it += NGW) {
        int r = it;
        if (r < I_0) { p0_transpose_item(F.w0in, D, N0, F.WT0IN, scr, r, F.lane); continue; } r -= I_0;
        if (USE_AUX && USE_L0_MFMA == 2 && F.G == 256) break;
        if (r < I_1) { p0_transpose_item(F.w0out, DI, D, F.WT0OUT, scr, r, F.lane); continue; } r -= I_1;
        if (r < I_2) { p0_transpose_item(F.w1in, D, N1, F.WT1IN, scr, r, F.lane); continue; } r -= I_2;
        p0_transpose_item(F.w1out, DI, D, F.WT1OUT, scr, r, F.lane);
    }
#endif
    for (int m = gw; m < MP; m += NGW) {
        GAS unsigned long long* o8 = (GAS unsigned long long*)(F.XB + (size_t)m * D) + F.lane;
        if (m < MR) {
            const float* src = (m < MX) ? F.x + (size_t)m * D : F.meta + (size_t)(m - MX) * D;
            const GAS f32x4* xr = (const GAS f32x4*)src + F.lane;
            f32x4 xv[16];
#pragma unroll
            for (int j = 0; j < 16; ++j) xv[j] = __builtin_nontemporal_load(xr + 64 * j);
#pragma unroll
            for (int j = 0; j < 16; ++j) { const f32x4 v = xv[j]; o8[64 * j] = (unsigned long long)hwpk(v.x, v.y) | ((unsigned long long)hwpk(v.z, v.w) << 32); }
        } else {
#pragma unroll 4
            for (int j = 0; j < 16; ++j) o8[64 * j] = 0ull;
        }
    }
    for (int m = MR + gw; m < MP; m += NGW) {
        GAS unsigned long long* o8 = (GAS unsigned long long*)(F.H1B + (size_t)m * D) + F.lane;
#pragma unroll 4
        for (int j = 0; j < 16; ++j) o8[64 * j] = 0ull;
    }
    for (int i = gw * 64 + F.lane; i < 16 * N0 / 8; i += NGW * 64) { const int col8 = i % (N0 / 8); const unsigned v = (col8 >= DI / 8 && col8 < 2 * DI / 8) ? 0x47004700u : 0u;
        *((GAS v4u*)F.Q0 + i) = (v4u){v, v, v, v}; }
    for (int i = gw * 64 + F.lane; i < GL_R * D; i += NGW * 64) { const int n = i / D, k = i - n * D; F.WG1T[i] = (bf16)f2bf(F.wg1[(size_t)k * GL_R + n]); }
    for (int i = gw * 64 + F.lane; i < 8 * 16 * 2 * 64 * 8; i += NGW * 64) {
        const int e = i & 7, ln = (i >> 3) & 63, fr = i >> 9, m2 = fr & 1, s2 = (fr >> 1) & 15, hh = fr >> 5, rA = ln & 15, gA = ln >> 4;
        float v = 0.f; if (gA < 2) v = F.wg2[(size_t)(8 * gA + e) * 4096 + hh * 512 + 32 * s2 + 8 * (rA >> 2) + 4 * m2 + (rA & 3)];
        F.W2F[i] = (bf16)f2bf(v);
    }
    for (int c = gw * 64 + F.lane; c < DI; c += NGW * 64) {
        const float l0 = F.lb_logits[c], l1 = F.lb_logits[DI + c], l2 = F.lb_logits[2 * DI + c];
        const float mx = fmaxf(l0, fmaxf(l1, l2));
        const float e0 = __expf(l0 - mx), e1 = __expf(l1 - mx), e2 = __expf(l2 - mx);
        F.LB0[c] = e0 / (e0 + e1 + e2);
    }
}

DI_ void p2_l0_rec_naive(Frame& F) {
    LAS float* qs = (LAS float*)(F.lds);
    LAS float* fs = qs + 2048;
    LAS float* ks = fs + 2048;
    LAS float* vs = ks + 2048;
    LAS float* pb = vs + 2048;
    const int tid = F.tid, dv = tid & 127, kg = tid >> 7;
    const int lj = tid >> 5, lc = (tid & 31) * 4;
    for (int u = blockIdx.x; u < NB * HG_H; u += F.G) {
        const int b = u >> 6, h = u & 63;
        float S[32];
#pragma unroll
        for (int i = 0; i < 32; ++i) S[i] = 0.f;
        float lbv[4], bfv[4], ngv[4];
#pragma unroll
        for (int i = 0; i < 4; ++i) { lbv[i] = F.LB0[h * 128 + lc + i]; bfv[i] = F.b_f[h * 128 + lc + i]; ngv[i] = F.ng0[h * 128 + lc + i]; }
        for (int tb = 0; tb < 129; ++tb) {
            const int rbase = (tb == 0) ? MX : b * SEQ + 16 * (tb - 1);
            const bf16* row = F.QFIZ + (size_t)(rbase + lj) * N0 + h * 128 + lc;
            {
                const v2u q4 = *(const GAS v2u*)(row), f4 = *(const GAS v2u*)(row + DI), i4 = *(const GAS v2u*)(row + 2 * DI);
                const float qv[4] = {bflo(q4.x), bfhi(q4.x), bflo(q4.y), bfhi(q4.y)};
                const float fv[4] = {bflo(f4.x), bfhi(f4.x), bflo(f4.y), bfhi(f4.y)};
                const float iv[4] = {bflo(i4.x), bfhi(i4.x), bflo(i4.y), bfhi(i4.y)};
#pragma unroll
                for (int i = 0; i < 4; ++i) {
                    const float fg = lbv[i] + (1.f - lbv[i]) * sigm(fv[i] + bfv[i]);
                    qs[lj * 128 + lc + i] = silu(qv[i]); fs[lj * 128 + lc + i] = fg; ks[lj * 128 + lc + i] = 1.f - fg; vs[lj * 128 + lc + i] = iv[i];
                }
            }
            __syncthreads();
            for (int j = 0; j < 16; ++j) {
                const float vj = vs[j * 128 + dv]; float po = 0.f;
#pragma unroll
                for (int i = 0; i < 32; i += 4) {
                    const f32x4 f4 = *(const LAS f32x4*)(fs + j * 128 + kg * 32 + i), k4 = *(const LAS f32x4*)(ks + j * 128 + kg * 32 + i), q4 = *(const LAS f32x4*)(qs + j * 128 + kg * 32 + i);
                    S[i + 0] = f4.x * S[i + 0] + k4.x * vj; po += q4.x * S[i + 0];
                    S[i + 1] = f4.y * S[i + 1] + k4.y * vj; po += q4.y * S[i + 1];
                    S[i + 2] = f4.z * S[i + 2] + k4.z * vj; po += q4.z * S[i + 2];
                    S[i + 3] = f4.w * S[i + 3] + k4.w * vj; po += q4.w * S[i + 3];
                }
                pb[(j * 4 + kg) * 128 + dv] = po;
            }
            __syncthreads();
            {
                f32x4 o = *(const LAS f32x4*)(pb + (lj * 4 + 0) * 128 + lc);
                o += *(const LAS f32x4*)(pb + (lj * 4 + 1) * 128 + lc);
                o += *(const LAS f32x4*)(pb + (lj * 4 + 2) * 128 + lc);
                o += *(const LAS f32x4*)(pb + (lj * 4 + 3) * 128 + lc);
                float ss = o.x * o.x + o.y * o.y + o.z * o.z + o.w * o.w;
                ss += __shfl_xor(ss, 16); ss += __shfl_xor(ss, 8); ss += __shfl_xor(ss, 4); ss += __shfl_xor(ss, 2); ss += __shfl_xor(ss, 1);
                const float rs = rsqrtf(ss * (1.f / 128.f) + RMS_EPS);
                const v2u z4 = *(const GAS v2u*)(row + 3 * DI);
                const float y0 = o.x * rs * ngv[0] * silu(bflo(z4.x)), y1 = o.y * rs * ngv[1] * silu(bfhi(z4.x));
                const float y2 = o.z * rs * ngv[2] * silu(bflo(z4.y)), y3 = o.w * rs * ngv[3] * silu(bfhi(z4.y));
                if (tb > 0 || b == 0) { v2u w; w.x = pk2(y0, y1); w.y = pk2(y2, y3); *(GAS v2u*)(F.Y + (size_t)(rbase + lj) * DI + h * 128 + lc) = w; }
            }
        }
        __syncthreads();
    }
}

DI_ void ln_phase(Frame& F, const float* src, int nrows, const float* g, const float* bt, float* dst32, bf16* dstb, float* G1) {
    const int gw = F.vcu * NWAVES + F.wave, NGW = F.G * NWAVES;
    for (int r = gw; r < nrows; r += NGW) {
        const GAS f32x4* s = (const GAS f32x4*)(src + (size_t)r * D) + F.lane;
        f32x4 v[16]; float sm = 0.f;
#pragma unroll
        for (int j = 0; j < 16; ++j) { v[j] = s[64 * j]; sm += (v[j].x + v[j].y) + (v[j].z + v[j].w); }
        const float mean = wave_sum(sm) * (1.f / D); float s2 = 0.f;
#pragma unroll
        for (int j = 0; j < 16; ++j) { v[j] = v[j] - mean; s2 += (v[j].x * v[j].x + v[j].y * v[j].y) + (v[j].z * v[j].z + v[j].w * v[j].w); }
        const float rstd = rsqrtf(wave_sum(s2) * (1.f / D) + LN_EPS);
#pragma unroll
        for (int j = 0; j < 16; ++j) {
            const f32x4 gg = *((const GAS f32x4*)g + F.lane + 64 * j), bb = *((const GAS f32x4*)bt + F.lane + 64 * j);
            v[j] = v[j] * rstd * gg + bb;
            if (dst32) *((GAS f32x4*)(dst32 + (size_t)r * D) + F.lane + 64 * j) = v[j];
            if (dstb) { v2u w; w.x = hwpk(v[j].x, v[j].y); w.y = hwpk(v[j].z, v[j].w); *((GAS v2u*)(dstb + (size_t)r * D) + F.lane + 64 * j) = w; }
            if ((j & 3) == 3) asm volatile("" ::: "memory");
        }
        if (G1) {
            LAS float* rowbuf = (LAS float*)(F.lds + RING_OFF + F.wave * 16384);
#pragma unroll
            for (int j = 0; j < 16; ++j) *(LAS f32x4*)(rowbuf + 256 * j + 4 * F.lane) = v[j];
            LDS_WAIT(); asm volatile("" ::: "memory");
            float a[16];
#pragma unroll
            for (int q = 0; q < 16; ++q) a[q] = 0.f;
#pragma unroll 2
            for (int i = 0; i < 64; ++i) {
                const int k = 64 * i + F.lane;
                const float e = rowbuf[k];
                const GAS f32x4* w = (const GAS f32x4*)(F.wg1 + (size_t)k * GL_R);
                const f32x4 w0 = w[0], w1 = w[1], w2 = w[2], w3 = w[3];
                a[0] += e * w0.x; a[1] += e * w0.y; a[2] += e * w0.z; a[3] += e * w0.w;
                a[4] += e * w1.x; a[5] += e * w1.y; a[6] += e * w1.z; a[7] += e * w1.w;
                a[8] += e * w2.x; a[9] += e * w2.y; a[10] += e * w2.z; a[11] += e * w2.w;
                a[12] += e * w3.x; a[13] += e * w3.y; a[14] += e * w3.z; a[15] += e * w3.w;
            }
#pragma unroll
            for (int q = 0; q < 16; ++q) a[q] = wave_sum(a[q]);
            if (F.lane == 0) {
#pragma unroll
                for (int q = 0; q < 16; q += 4) *(GAS f32x4*)(G1 + (size_t)r * GL_R + q) = (f32x4){a[q], a[q + 1], a[q + 2], a[q + 3]};
            }
            LDS_WAIT(); asm volatile("" ::: "memory");
        }
    }
}

DI_ void ln_phase2(Frame& F, const float* src, int nrows, const float* g, const float* bt, float* dst32, bf16* dstb) {
    const int gw = F.vcu * NWAVES + F.wave, NGW = F.G * NWAVES;
    LAS float* gL = (LAS float*)(F.lds + RING_OFF); LAS float* bL = gL + D;
    for (int i = F.tid; i < D / 4; i += NWAVES * 64) { *(LAS f32x4*)(gL + 4 * i) = *((const GAS f32x4*)g + i); *(LAS f32x4*)(bL + 4 * i) = *((const GAS f32x4*)bt + i); }
    __syncthreads();
    f32x4 va[16], vb[16];
#define LN_LOAD(v_, r_) do { const GAS f32x4* s_ = (const GAS f32x4*)(((r_) < nrows) ? src + (size_t)(r_) * D : g) + F.lane; \
        _Pragma("unroll") for (int j = 0; j < 16; ++j) v_[j] = s_[64 * j]; } while (0)
#define LN_PROC(v_, r_) do { float sm = 0.f; \
        _Pragma("unroll") for (int j = 0; j < 16; ++j) sm += (v_[j].x + v_[j].y) + (v_[j].z + v_[j].w); \
        const float mean = wave_sum(sm) * (1.f / D); float s2 = 0.f; \
        _Pragma("unroll") for (int j = 0; j < 16; ++j) { v_[j] = v_[j] - mean; s2 += (v_[j].x * v_[j].x + v_[j].y * v_[j].y) + (v_[j].z * v_[j].z + v_[j].w * v_[j].w); } \
        const float rstd = rsqrtf(wave_sum(s2) * (1.f / D) + LN_EPS); \
        _Pragma("unroll") for (int j = 0; j < 16; ++j) { \
            const f32x4 gg = *(const LAS f32x4*)(gL + 4 * (F.lane + 64 * j)), bb = *(const LAS f32x4*)(bL + 4 * (F.lane + 64 * j)); \
            const f32x4 o_ = v_[j] * rstd * gg + bb; \
            if (dst32) *((GAS f32x4*)(dst32 + (size_t)(r_) * D) + F.lane + 64 * j) = o_; \
            if (dstb) { v2u w_; w_.x = pk2(o_.x, o_.y); w_.y = pk2(o_.z, o_.w); *((GAS v2u*)(dstb + (size_t)(r_) * D) + F.lane + 64 * j) = w_; } \
            if ((j & 3) == 3) asm volatile("" ::: "memory"); } } while (0)
    int r = gw;
    LN_LOAD(va, r);
    while (r < nrows) {
        LN_LOAD(vb, r + NGW);
        LN_PROC(va, r);
        r += NGW; if (r >= nrows) break;
        LN_LOAD(va, r + NGW);
        LN_PROC(vb, r);
        r += NGW;
    }
#undef LN_LOAD
#undef LN_PROC
}

DI_ void p6_l1_rec_naive(Frame& F) {
    LAS float* qs = (LAS float*)(F.lds);
    LAS float* ks = qs + 4096;
    LAS float* gs = ks + 4096;
    LAS float* vs = gs + 4096;
    LAS float* pb = vs + 512;
    const int tid = F.tid, dv = tid & 63, kg = tid >> 6;
    const float qscale = 0.04419417382415922f;
    for (int u = blockIdx.x; u < NB * GL_H * 16; u += F.G) {
        const int dvs = u & 15, bh = u >> 4, b = bh >> 3, h = bh & 7;
        float S[64];
#pragma unroll
        for (int i = 0; i < 64; ++i) S[i] = 0.f;
        float w2[16];
#pragma unroll
        for (int r = 0; r < 16; ++r) w2[r] = F.wg2[(size_t)r * 4096 + h * 512 + tid];
        const float bg = F.b_g[h * 512 + tid];
        for (int tb = 0; tb < 258; ++tb) {
            const int rbase = (tb < 2) ? MX + 8 * tb : b * SEQ + 8 * (tb - 2);
            for (int j = 0; j < 8; ++j) {
                const size_t r = (size_t)(rbase + j);
                const float q = bf2f(F.QFIZ[r * N1 + h * 512 + tid]) * qscale, k = bf2f(F.QFIZ[r * N1 + 4096 + h * 512 + tid]);
                const float* g1 = F.G1 + r * GL_R;
                float xg = bg;
#pragma unroll
                for (int rr = 0; rr < 16; ++rr) xg += g1[rr] * w2[rr];
                const float ls = fminf(xg, 0.f) - log1pf(__expf(-fabsf(xg)));
                qs[j * 512 + tid] = q; ks[j * 512 + tid] = k; gs[j * 512 + tid] = __expf(ls * (1.f / 16.f));
            }
            vs[tid] = bf2f(F.QFIZ[(size_t)(rbase + (tid >> 6)) * N1 + 8192 + h * 1024 + dvs * 64 + (tid & 63)]);
            __syncthreads();
            for (int j = 0; j < 8; ++j) {
                const float vj = vs[j * 64 + dv]; float po = 0.f;
#pragma unroll
                for (int i = 0; i < 64; i += 4) {
                    const f32x4 g4 = *(const LAS f32x4*)(gs + j * 512 + kg * 64 + i), k4 = *(const LAS f32x4*)(ks + j * 512 + kg * 64 + i), q4 = *(const LAS f32x4*)(qs + j * 512 + kg * 64 + i);
                    S[i + 0] = g4.x * S[i + 0] + k4.x * vj; po += q4.x * S[i + 0];
                    S[i + 1] = g4.y * S[i + 1] + k4.y * vj; po += q4.y * S[i + 1];
                    S[i + 2] = g4.z * S[i + 2] + k4.z * vj; po += q4.z * S[i + 2];
                    S[i + 3] = g4.w * S[i + 3] + k4.w * vj; po += q4.w * S[i + 3];
                    if ((i & 12) == 12) asm volatile("" ::: "memory");
                }
                pb[(j * 8 + kg) * 64 + dv] = po;
            }
            __syncthreads();
            {
                const int j = tid >> 6, d = tid & 63; float o = 0.f;
#pragma unroll
                for (int g = 0; g < 8; ++g) o += pb[(j * 8 + g) * 64 + d];
                if (tb >= 2 || b == 0) F.O1[(size_t)(rbase + j) * DI + h * 1024 + dvs * 64 + d] = o;
            }
        }
        __syncthreads();
    }
}

DI_ void p7_normgate(Frame& F) {
    const int gw = F.vcu * NWAVES + F.wave, NGW = F.G * NWAVES;
    for (int it = gw; it < MX * GL_H; it += NGW) {
        const int r = it >> 3, h = it & 7;
        const GAS v4u* o = (const GAS v4u*)((const bf16*)F.O1 + (size_t)r * DI + h * 1024) + F.lane;
        const GAS v4u* zp = (const GAS v4u*)(F.QFIZ + (size_t)r * N1 + 16384 + h * 1024) + F.lane;
        v4u ov[2], zv[2]; float ss = 0.f;
#pragma unroll
        for (int j = 0; j < 2; ++j) { ov[j] = o[64 * j]; zv[j] = zp[64 * j]; }
        float x[2][8];
#pragma unroll
        for (int j = 0; j < 2; ++j) { x[j][0] = bflo(ov[j].x); x[j][1] = bfhi(ov[j].x); x[j][2] = bflo(ov[j].y); x[j][3] = bfhi(ov[j].y); x[j][4] = bflo(ov[j].z); x[j][5] = bfhi(ov[j].z); x[j][6] = bflo(ov[j].w); x[j][7] = bfhi(ov[j].w);
#pragma unroll
            for (int e = 0; e < 8; ++e) ss += x[j][e] * x[j][e]; }
        const float rs = rsqrtf(wave_sum(ss) * (1.f / 1024.f) + RMS_EPS);
#pragma unroll
        for (int j = 0; j < 2; ++j) {
            const int c = h * 1024 + 512 * j + 8 * F.lane;
            const f32x4 n0 = *(const GAS f32x4*)(F.ng1 + c), n1 = *(const GAS f32x4*)(F.ng1 + c + 4);
            const float z[8] = {bflo(zv[j].x), bfhi(zv[j].x), bflo(zv[j].y), bfhi(zv[j].y), bflo(zv[j].z), bfhi(zv[j].z), bflo(zv[j].w), bfhi(zv[j].w)};
            v4u wv; wv.x = pk2(x[j][0] * rs * n0.x * silu(z[0]), x[j][1] * rs * n0.y * silu(z[1])); wv.y = pk2(x[j][2] * rs * n0.z * silu(z[2]), x[j][3] * rs * n0.w * silu(z[3]));
            wv.z = pk2(x[j][4] * rs * n1.x * silu(z[4]), x[j][5] * rs * n1.y * silu(z[5])); wv.w = pk2(x[j][6] * rs * n1.z * silu(z[6]), x[j][7] * rs * n1.w * silu(z[7]));
            *(GAS v4u*)(F.Y + (size_t)r * DI + c) = wv;
        }
    }
}

typedef short bf16x8 __attribute__((ext_vector_type(8)));
#ifndef USE_FUSED_NORM
#define USE_FUSED_NORM 1
#endif
constexpr int NCH = 65;
constexpr int SSP_OFF = 155648 + 512;
constexpr float LOG2E = 1.4426950408889634f;
constexpr int R1_QD = 0, R1_KD = 32768, R1_P = 65536, R1_GL = 67584, R1_SH = 69632;
constexpr int ST1 = R1_SH + 8192;
constexpr int R0_QD = 0, R0_KD = 8192, R0_P = 16384, R0_V = 18432, R0_GL = 26624, R0_SZ = 27648;
constexpr int ST0 = R0_SZ;

DI_ unsigned cvtpk(float lo, float hi) { unsigned r; asm volatile("v_cvt_pk_bf16_f32 %0, %1, %2" : "=v"(r) : "v"(lo), "v"(hi)); return r; }
template <int N> DI_ float row_shr(float x) { return __builtin_bit_cast(float, __builtin_amdgcn_update_dpp(0, __builtin_bit_cast(int, x), 0x110 + N, 0xF, 0xF, true)); }
template <int K> DI_ float glb(float x) { return __builtin_bit_cast(float, __builtin_amdgcn_update_dpp(0, __builtin_bit_cast(int, x), 0x150 + K, 0xF, 0xF, true)); }
DI_ float bcast15(float x) { return __builtin_bit_cast(float, __builtin_amdgcn_update_dpp(0, __builtin_bit_cast(int, x), 0x15F, 0xF, 0xF, true)); }
DI_ float scan16(float x) { x += row_shr<1>(x); x += row_shr<2>(x); x += row_shr<4>(x); x += row_shr<8>(x); return x; }
DI_ float ex2(float x) { return __builtin_amdgcn_exp2f(x); }
DI_ float lg2(float x) { return __builtin_amdgcn_logf(x); }
DI_ int row_of(int b, int c, int tok) { return c == 0 ? MX + tok - 16 : b * SEQ + 32 * (c - 1) + tok; }
DI_ bf16x8 mk8(unsigned a, unsigned b, unsigned c, unsigned d) { v4u t; t.x = a; t.y = b; t.z = c; t.w = d; return __builtin_bit_cast(bf16x8, t); }
#define MFMA16(a, b, c) __builtin_amdgcn_mfma_f32_16x16x32_bf16((a), (b), (c), 0, 0, 0)

DI_ void l1_prep(Frame& F, unsigned char* REC1, unsigned char* VF1, const bf16* W2F) {
    const int lane = F.lane, w = F.wave, r = lane & 15, g = lane >> 4;
    LAS unsigned char* T = F.lds + w * 16384;
    LAS unsigned char* Tv = F.lds + w * 16384 + 4096;
    LAS f32x4* Pp = (LAS f32x4*)(F.lds + 131072);
    const float qscale = 0.04419417382415922f;
    v4u qn[2][2], kn[2][2]; f32x4 gn[2][2];
#define L1P_LOAD(it_) do { const int bh_ = (it_) / NCH, c_ = (it_) - bh_ * NCH, b_ = bh_ >> 3, h_ = bh_ & 7; \
        _Pragma("unroll") for (int ti = 0; ti < 2; ++ti) { const int tok_ = 16 * ti + r; const int row_ = (c_ == 0 && tok_ < 16) ? 0 : row_of(b_, c_, tok_); \
            const GAS f32x4* gp = (const GAS f32x4*)(F.G1 + (size_t)row_ * GL_R + 8 * (g & 1)); gn[ti][0] = gp[0]; gn[ti][1] = gp[1]; \
            _Pragma("unroll") for (int si = 0; si < 2; ++si) { const bf16* rp = F.QFIZ + (size_t)row_ * N1 + h_ * 512 + 32 * (2 * w + si) + 8 * g; qn[si][ti] = *(const GAS v4u*)rp; kn[si][ti] = *(const GAS v4u*)(rp + 4096); } } } while (0)
    if ((int)blockIdx.x < NB * GL_H * NCH) L1P_LOAD((int)blockIdx.x);
    for (int it = blockIdx.x; it < NB * GL_H * NCH; it += F.G) {
        const int bh = it / NCH, c = it - bh * NCH, b = bh >> 3, h = bh & 7;
        unsigned char* rec = REC1 + (size_t)it * R1_SH;
        bool nul[2];
#pragma unroll
        for (int ti = 0; ti < 2; ++ti) { const int tok = 16 * ti + r; nul[ti] = (c == 0 && tok < 16); }
        bf16x8 g1f[2];
#pragma unroll
        for (int ti = 0; ti < 2; ++ti) {
            const f32x4 t0 = (g < 2) ? gn[ti][0] : (f32x4){0.f, 0.f, 0.f, 0.f}, t1 = (g < 2) ? gn[ti][1] : (f32x4){0.f, 0.f, 0.f, 0.f};
            g1f[ti] = mk8(pk2(t0.x, t0.y), pk2(t0.z, t0.w), pk2(t1.x, t1.y), pk2(t1.z, t1.w));
        }
        f32x4 pacc[3];
#pragma unroll
        for (int t = 0; t < 3; ++t) pacc[t] = (f32x4){0.f, 0.f, 0.f, 0.f};
        v4u qraw[2][2], kraw[2][2];
#pragma unroll
        for (int si = 0; si < 2; ++si)
#pragma unroll
            for (int ti = 0; ti < 2; ++ti) { qraw[si][ti] = qn[si][ti]; kraw[si][ti] = kn[si][ti]; }
        f32x4 bg[2][2]; bf16x8 wfr[2][2];
#pragma unroll
        for (int si = 0; si < 2; ++si) { const int s = 2 * w + si, col = h * 512 + 32 * s + 8 * g;
            bg[si][0] = *(const GAS f32x4*)(F.b_g + col); bg[si][1] = *(const GAS f32x4*)(F.b_g + col + 4);
            wfr[si][0] = *(const GAS bf16x8*)(W2F + ((size_t)((h * 16 + s) * 2 + 0) * 64 + lane) * 8); wfr[si][1] = *(const GAS bf16x8*)(W2F + ((size_t)((h * 16 + s) * 2 + 1) * 64 + lane) * 8); }
        { const int nx = (it + F.G < NB * GL_H * NCH) ? it + F.G : it; L1P_LOAD(nx); }
        v4u vraw[8];
        if (USE_L1_SEQ2) {
#pragma unroll
            for (int i2 = 0; i2 < 8; ++i2) { const int q = lane + 64 * i2, tk = q >> 4, c16 = q & 15; const int vrow = (c == 0) ? MX - 16 + tk : b * SEQ + 32 * (c - 1) + tk;
                vraw[i2] = *(const GAS v4u*)(F.QFIZ + (size_t)vrow * N1 + 8192 + h * 1024 + 128 * w + 8 * c16); }
        }
        asm volatile("" ::: "memory");
#pragma unroll
        for (int si = 0; si < 2; ++si) {
            const int s = 2 * w + si, col = h * 512 + 32 * s + 8 * g;
            float xg[2][8];
            { const f32x4 b0 = bg[si][0], b1 = bg[si][1];
              const bf16x8 wa = wfr[si][0], wb = wfr[si][1];
#pragma unroll
              for (int ti = 0; ti < 2; ++ti) { const f32x4 xa = MFMA16(wa, g1f[ti], b0), xb = MFMA16(wb, g1f[ti], b1);
                  xg[ti][0] = xa.x; xg[ti][1] = xa.y; xg[ti][2] = xa.z; xg[ti][3] = xa.w; xg[ti][4] = xb.x; xg[ti][5] = xb.y; xg[ti][6] = xb.z; xg[ti][7] = xb.w; } }
            float qv[2][8], kv[2][8];
#pragma unroll
            for (int ti = 0; ti < 2; ++ti) {
                const v4u q4 = qraw[si][ti], k4 = kraw[si][ti];
                qv[ti][0] = bflo(q4.x); qv[ti][1] = bfhi(q4.x); qv[ti][2] = bflo(q4.y); qv[ti][3] = bfhi(q4.y); qv[ti][4] = bflo(q4.z); qv[ti][5] = bfhi(q4.z); qv[ti][6] = bflo(q4.w); qv[ti][7] = bfhi(q4.w);
                kv[ti][0] = bflo(k4.x); kv[ti][1] = bfhi(k4.x); kv[ti][2] = bflo(k4.y); kv[ti][3] = bfhi(k4.y); kv[ti][4] = bflo(k4.z); kv[ti][5] = bfhi(k4.z); kv[ti][6] = bflo(k4.w); kv[ti][7] = bfhi(k4.w);
            }
            unsigned qd[2][4], ki[2][4], kd[2][4]; float gl[8];
#pragma unroll
            for (int e = 0; e < 8; e += 2) {
                float bb[2][2], BB[2];
#pragma unroll
                for (int u = 0; u < 2; ++u) {
                    float L0 = nul[0] ? 0.f : (fminf(xg[0][e + u], 0.f) * LOG2E - lg2(1.f + ex2(-fabsf(xg[0][e + u]) * LOG2E))) * (1.f / 16.f);
                    float L1 = nul[1] ? 0.f : (fminf(xg[1][e + u], 0.f) * LOG2E - lg2(1.f + ex2(-fabsf(xg[1][e + u]) * LOG2E))) * (1.f / 16.f);
                    const float b0 = scan16(L0);
                    const float b1 = scan16(L1) + bcast15(b0);
                    bb[0][u] = b0; bb[1][u] = b1; BB[u] = bcast15(b1);
                    gl[e + u] = ex2(BB[u]);
                }
#pragma unroll
                for (int ti = 0; ti < 2; ++ti) {
                    const float q0 = nul[ti] ? 0.f : qv[ti][e] * qscale, q1 = nul[ti] ? 0.f : qv[ti][e + 1] * qscale;
                    const float k0 = nul[ti] ? 0.f : kv[ti][e], k1 = nul[ti] ? 0.f : kv[ti][e + 1];
                    const float ki0 = k0 * ex2(-bb[ti][0]), ki1 = k1 * ex2(-bb[ti][1]);
                    qd[ti][e >> 1] = cvtpk(q0 * ex2(bb[ti][0]), q1 * ex2(bb[ti][1]));
                    ki[ti][e >> 1] = cvtpk(ki0, ki1);
                    kd[ti][e >> 1] = cvtpk(ki0 * gl[e], ki1 * gl[e + 1]);
                }
            }
            const bf16x8 qf0 = mk8(qd[0][0], qd[0][1], qd[0][2], qd[0][3]), qf1 = mk8(qd[1][0], qd[1][1], qd[1][2], qd[1][3]);
            const bf16x8 kf0 = mk8(ki[0][0], ki[0][1], ki[0][2], ki[0][3]), kf1 = mk8(ki[1][0], ki[1][1], ki[1][2], ki[1][3]);
            pacc[0] = MFMA16(kf0, qf0, pacc[0]);
            pacc[1] = MFMA16(kf0, qf1, pacc[1]);
            pacc[2] = MFMA16(kf1, qf1, pacc[2]);
#pragma unroll
            for (int ti = 0; ti < 2; ++ti)
#pragma unroll
                for (int h2 = 0; h2 < 2; ++h2) {
                    const int lp = (2 * (g & 1) + h2) * 16 + r;
                    v2u d; d.x = qd[ti][2 * h2]; d.y = qd[ti][2 * h2 + 1];
                    *(GAS v2u*)(rec + R1_QD + ((ti * 16 + s) * 64 + lp) * 16 + (g >> 1) * 8) = d;
                }
#pragma unroll
            for (int ti = 0; ti < 2; ++ti)
#pragma unroll
                for (int e = 0; e < 8; ++e) {
                    const unsigned wd = kd[ti][e >> 1]; const unsigned short hv = (e & 1) ? (unsigned short)(wd >> 16) : (unsigned short)(wd & 0xffffu);
                    *(LAS unsigned short*)(T + (32 * si + 8 * g + e) * 64 + (16 * ti + r) * 2) = hv;
                }
            if (r == 0) { *(GAS f32x4*)(rec + R1_GL + (32 * s + 8 * g) * 4) = (f32x4){gl[0], gl[1], gl[2], gl[3]}; *(GAS f32x4*)(rec + R1_GL + (32 * s + 8 * g + 4) * 4) = (f32x4){gl[4], gl[5], gl[6], gl[7]}; }
        }
#pragma unroll
        for (int t = 0; t < 3; ++t) Pp[(w * 3 + t) * 64 + lane] = pacc[t];
        if (USE_L1_SEQ2) {
#pragma unroll
            for (int i2 = 0; i2 < 8; ++i2) { const int q = lane + 64 * i2, tk = q >> 4, c16 = q & 15; const v4u d = vraw[i2];
                *(LAS v2u*)(Tv + tk * 264 + c16 * 16) = (v2u){d.x, d.y}; *(LAS v2u*)(Tv + tk * 264 + c16 * 16 + 8) = (v2u){d.z, d.w}; }
        }
        LDS_WAIT(); asm volatile("" ::: "memory");
        if (USE_L1_SEQ2) {
#pragma unroll
            for (int sl = 0; sl < 8; ++sl) { unsigned short hv[8];
#pragma unroll
                for (int e = 0; e < 8; ++e) hv[e] = *(const LAS unsigned short*)(Tv + (8 * g + e) * 264 + (16 * sl + r) * 2);
                v4u d; d.x = hv[0] | ((unsigned)hv[1] << 16); d.y = hv[2] | ((unsigned)hv[3] << 16); d.z = hv[4] | ((unsigned)hv[5] << 16); d.w = hv[6] | ((unsigned)hv[7] << 16);
                *(GAS v4u*)(VF1 + ((size_t)it * 64 + 8 * w + sl) * 1024 + lane * 16) = d; }
        }
#pragma unroll
        for (int ml = 0; ml < 4; ++ml) { const v4u d = *(const LAS v4u*)(T + (16 * ml + r) * 64 + 16 * g); *(GAS v4u*)(rec + R1_KD + ((4 * w + ml) * 64 + lane) * 16) = d; }
        __syncthreads();
        if (w < 4) {
            const int tj = (w == 2 || w == 3) ? 1 : 0, ti = (w == 1 || w == 2) ? 1 : 0;
            f32x4 sum = (f32x4){0.f, 0.f, 0.f, 0.f};
            if (w < 3) {
#pragma unroll
                for (int ww = 0; ww < 8; ++ww) sum += Pp[(ww * 3 + w) * 64 + lane];
            }
            float pv[4] = {sum.x, sum.y, sum.z, sum.w};
#pragma unroll
            for (int jj = 0; jj < 4; ++jj) { const int j = 16 * tj + 4 * g + jj, i = 16 * ti + r; if (j > i) pv[jj] = 0.f; }
            const int lp = (2 * tj + (g >> 1)) * 16 + r;
            v2u d; d.x = cvtpk(pv[0], pv[1]); d.y = cvtpk(pv[2], pv[3]);
            *(GAS v2u*)(rec + R1_P + (ti * 64 + lp) * 16 + 8 * (g & 1)) = d;
        }
        __syncthreads();
    }
}
#undef L1P_LOAD

template <int VAR> DI_ void l1_seq(Frame& F, const unsigned char* REC1, const unsigned char* VF1, float* O1, float* SS) {
    const int lane = F.lane, w = F.wave, r = lane & 15, g = lane >> 4;
    for (int u = F.vcu; u < NB * GL_H * 8; u += F.G) {
        const int bh = u >> 3, ds = u & 7, b = bh >> 3, h = bh & 7;
        f32x4 acc[32];
#pragma unroll
        for (int m = 0; m < 32; ++m) acc[m] = (f32x4){0.f, 0.f, 0.f, 0.f};
#define L1_DMA(c_) do { const unsigned char* rs_ = REC1 + (size_t)(bh * NCH + (c_)) * R1_SH; LAS unsigned char* st_ = F.lds + ((c_) & 1) * ST1; \
        for (int p_ = w; p_ < 76; p_ += 8) { const unsigned char* src_; \
            if (p_ < 68) src_ = rs_ + p_ * 1024 + lane * 16; \
            else { const int tk_ = 4 * (p_ - 68) + (lane >> 4);         \
                   src_ = ((c_) == 0 && tk_ < 16) ? (const unsigned char*)(F.H1B + (size_t)MR * D) + (lane & 15) * 16 \
                        : (const unsigned char*)(F.QFIZ + (size_t)row_of(b, (c_), tk_) * N1 + 8192 + h * 1024 + ds * 128) + (lane & 15) * 16; } \
            __builtin_amdgcn_global_load_lds((const unsigned*)src_, (LAS unsigned*)(st_ + p_ * 1024), 16, 0, 0); } } while (0)
        const unsigned char* recb = REC1 + (size_t)bh * NCH * R1_SH + w * 1024 + lane * 16;
        const unsigned char* vsrb = (const unsigned char*)(F.QFIZ + (size_t)(b * SEQ - 32 + 4 * w + (lane >> 4)) * N1 + 8192 + h * 1024 + ds * 128) + (lane & 15) * 16;
#define L1_DMAF(c_) do { const unsigned char* rs_ = recb + (size_t)(c_) * R1_SH; LAS unsigned char* st_ = F.lds + ((c_) & 1) * ST1 + w * 1024; \
        _Pragma("unroll") for (int i_ = 0; i_ < 8; ++i_) __builtin_amdgcn_global_load_lds((const unsigned*)(rs_ + i_ * 8192), (LAS unsigned*)(st_ + i_ * 8192), 16, 0, 0); \
        __builtin_amdgcn_global_load_lds((const unsigned*)(vsrb + (size_t)(c_) * (32 * N1 * 2)), (LAS unsigned*)(st_ + 68 * 1024), 16, 0, 0); \
        if (w < 4) __builtin_amdgcn_global_load_lds((const unsigned*)(rs_ + 64 * 1024), (LAS unsigned*)(st_ + 64 * 1024), 16, 0, 0); } while (0)
        const int ycol = h * 1024 + ds * 128 + 16 * w + 4 * g;
        const f32x4 ng4 = *(const GAS f32x4*)(F.ng1 + ycol);
        const bf16* xz = F.QFIZ + (size_t)(b * SEQ - 32) * N1 + 16384 + ycol;
        v2u zc0 = (v2u){0u, 0u}, zc1 = zc0, zn0 = zc0, zn1 = zc0;
        if (VAR != 1) L1_DMA(0);
        for (int c = 0; c < NCH; ++c) {
            asm volatile("s_waitcnt vmcnt(0) lgkmcnt(0)" ::: "memory");
            __builtin_amdgcn_s_barrier();
            asm volatile("" ::: "memory");
            const LAS unsigned char* st = F.lds + (c & 1) * ST1;
            v4u qb[2][4], p0, p1;
            const unsigned sa = (unsigned)(size_t)st + lane * 16, sp = (unsigned)(size_t)(st + R1_P) + lane * 16;
#define DSR128(d_, a_, off_) asm volatile("ds_read_b128 %0, %1 offset:%2" : "=v"(d_) : "v"(a_), "n"(off_) : "memory")
#define LDQ(buf_, gi_) do { DSR128(qb[buf_][0], sa, R1_QD + (2 * (gi_)) * 1024); DSR128(qb[buf_][1], sa, R1_QD + (2 * (gi_) + 1) * 1024); \
                    DSR128(qb[buf_][2], sa, R1_QD + (16 + 2 * (gi_)) * 1024); DSR128(qb[buf_][3], sa, R1_QD + (16 + 2 * (gi_) + 1) * 1024); } while (0)
            DSR128(p0, sp, 0); DSR128(p1, sp, 1024);
            LDQ(0, 0);
            if (VAR != 1 && c + 1 < NCH) L1_DMAF(c + 1);
            if (USE_FUSED_NORM && VAR == 0 && c >= 2 && w == 0 && lane < 32) {
                const LAS float* pp = (const LAS float*)(F.lds + SSP_OFF) + ((c - 1) & 1) * 256 + lane; float sm = 0.f;
#pragma unroll
                for (int ww = 0; ww < 8; ++ww) sm += pp[ww * 32];
                SS[(size_t)(b * SEQ + 32 * (c - 2) + lane) * 64 + h * 8 + ds] = sm; }
            if (USE_FUSED_NORM && c + 1 < NCH) { const bf16* zp = xz + (size_t)((c + 1) * 32 + r) * N1; zn0 = *(const GAS v2u*)zp; zn1 = *(const GAS v2u*)(zp + (size_t)16 * N1); }
            if (VAR == 2) continue;
            unsigned short vh[8];
#pragma unroll
            for (int e = 0; e < 8; ++e) vh[e] = *(const LAS unsigned short*)(st + R1_SH + (8 * g + e) * 256 + (16 * w + r) * 2);
            const bf16x8 vf = mk8(vh[0] | ((unsigned)vh[1] << 16), vh[2] | ((unsigned)vh[3] << 16), vh[4] | ((unsigned)vh[5] << 16), vh[6] | ((unsigned)vh[7] << 16));
#define SCHED_FENCE() __builtin_amdgcn_sched_barrier(0)
                v4u uk[2][4]; f32x4 ug[2][4];
                const unsigned sk = (unsigned)(size_t)st + lane * 16, sg = (unsigned)(size_t)(st + R1_GL) + g * 16;
#define LDU(buf_, gi_) do { _Pragma("unroll") for (int ml_ = 0; ml_ < 4; ++ml_) { } \
                    DSR128(uk[buf_][0], sk, R1_KD + (4 * (gi_) + 0) * 1024); DSR128(ug[buf_][0], sg, 64 * (4 * (gi_) + 0)); DSR128(uk[buf_][1], sk, R1_KD + (4 * (gi_) + 1) * 1024); DSR128(ug[buf_][1], sg, 64 * (4 * (gi_) + 1)); \
                    DSR128(uk[buf_][2], sk, R1_KD + (4 * (gi_) + 2) * 1024); DSR128(ug[buf_][2], sg, 64 * (4 * (gi_) + 2)); DSR128(uk[buf_][3], sk, R1_KD + (4 * (gi_) + 3) * 1024); DSR128(ug[buf_][3], sg, 64 * (4 * (gi_) + 3)); } while (0)
            if (c > 0) {
                f32x4 o0 = (f32x4){0.f, 0.f, 0.f, 0.f}, o1 = o0;
#define OGRP(GI) { if ((GI) < 7) LDQ(((GI) + 1) & 1, (GI) + 1); \
                    if ((GI) == 0) { asm volatile("s_waitcnt lgkmcnt(4)" : "+v"(p0), "+v"(p1), "+v"(qb[0][0]), "+v"(qb[0][1]), "+v"(qb[0][2]), "+v"(qb[0][3]) :: "memory"); \
                        o0 = MFMA16(vf, __builtin_bit_cast(bf16x8, p0), o0); o1 = MFMA16(vf, __builtin_bit_cast(bf16x8, p1), o1); }        \
                    else if ((GI) < 7) asm volatile("s_waitcnt lgkmcnt(4)" : "+v"(qb[(GI) & 1][0]), "+v"(qb[(GI) & 1][1]), "+v"(qb[(GI) & 1][2]), "+v"(qb[(GI) & 1][3]) :: "memory"); \
                    else asm volatile("s_waitcnt lgkmcnt(0)" : "+v"(qb[(GI) & 1][0]), "+v"(qb[(GI) & 1][1]), "+v"(qb[(GI) & 1][2]), "+v"(qb[(GI) & 1][3]) :: "memory"); \
                    _Pragma("unroll") for (int sl = 0; sl < 2; ++sl) { const int s2 = 2 * (GI) + sl; \
                        const bf16x8 sb = mk8(cvtpk(acc[2 * s2].x, acc[2 * s2].y), cvtpk(acc[2 * s2].z, acc[2 * s2].w), cvtpk(acc[2 * s2 + 1].x, acc[2 * s2 + 1].y), cvtpk(acc[2 * s2 + 1].z, acc[2 * s2 + 1].w)); \
                        o0 = MFMA16(sb, __builtin_bit_cast(bf16x8, qb[(GI) & 1][sl]), o0); o1 = MFMA16(sb, __builtin_bit_cast(bf16x8, qb[(GI) & 1][2 + sl]), o1); } }
                OGRP(0) OGRP(1) OGRP(2) OGRP(3) OGRP(4) OGRP(5) OGRP(6) OGRP(7)
#undef OGRP
#undef LDQ
                LDU(0, 0);
                if (VAR == 1) { asm volatile("" :: "v"(o0), "v"(o1)); } else if (USE_FUSED_NORM) {
                    float t0 = (o0.x * o0.x + o0.y * o0.y) + (o0.z * o0.z + o0.w * o0.w), t1 = (o1.x * o1.x + o1.y * o1.y) + (o1.z * o1.z + o1.w * o1.w);
                    t0 += __shfl_xor(t0, 16); t1 += __shfl_xor(t1, 16); t0 += __shfl_xor(t0, 32); t1 += __shfl_xor(t1, 32);
                    const int row0 = b * SEQ + 32 * (c - 1) + r;
                    if (g == 0) { LAS float* pp = (LAS float*)(F.lds + SSP_OFF) + ((c & 1) * 8 + w) * 32; pp[r] = t0; pp[16 + r] = t1; }
                    const float y0 = o0.x * ng4.x * silu(bflo(zc0.x)), y1 = o0.y * ng4.y * silu(bfhi(zc0.x)), y2 = o0.z * ng4.z * silu(bflo(zc0.y)), y3 = o0.w * ng4.w * silu(bfhi(zc0.y));
                    const float y4 = o1.x * ng4.x * silu(bflo(zc1.x)), y5 = o1.y * ng4.y * silu(bfhi(zc1.x)), y6 = o1.z * ng4.z * silu(bflo(zc1.y)), y7 = o1.w * ng4.w * silu(bfhi(zc1.y));
                    bf16* op = F.Y + (size_t)row0 * DI + ycol;
                    *(GAS v2u*)op = (v2u){cvtpk(y0, y1), cvtpk(y2, y3)}; *(GAS v2u*)(op + (size_t)16 * DI) = (v2u){cvtpk(y4, y5), cvtpk(y6, y7)};
                } else {
                    bf16* op = (bf16*)O1 + (size_t)(b * SEQ + 32 * (c - 1) + r) * DI + h * 1024 + ds * 128 + 16 * w + 4 * g;
                    *(GAS v2u*)op = (v2u){pk2(o0.x, o0.y), pk2(o0.z, o0.w)}; *(GAS v2u*)(op + (size_t)16 * DI) = (v2u){pk2(o1.x, o1.y), pk2(o1.z, o1.w)}; }
            } else { LDU(0, 0); }
            {
#define SGRP(GI) { if ((GI) < 7) { LDU(((GI) + 1) & 1, (GI) + 1); \
                        asm volatile("s_waitcnt lgkmcnt(8)" : "+v"(uk[(GI) & 1][0]), "+v"(uk[(GI) & 1][1]), "+v"(uk[(GI) & 1][2]), "+v"(uk[(GI) & 1][3]), "+v"(ug[(GI) & 1][0]), "+v"(ug[(GI) & 1][1]), "+v"(ug[(GI) & 1][2]), "+v"(ug[(GI) & 1][3]) :: "memory"); } \
                    else asm volatile("s_waitcnt lgkmcnt(0)" : "+v"(uk[(GI) & 1][0]), "+v"(uk[(GI) & 1][1]), "+v"(uk[(GI) & 1][2]), "+v"(uk[(GI) & 1][3]), "+v"(ug[(GI) & 1][0]), "+v"(ug[(GI) & 1][1]), "+v"(ug[(GI) & 1][2]), "+v"(ug[(GI) & 1][3]) :: "memory"); \
                    _Pragma("unroll") for (int ml = 0; ml < 4; ++ml) { const int m = 4 * (GI) + ml; acc[m] = MFMA16(__builtin_bit_cast(bf16x8, uk[(GI) & 1][ml]), vf, acc[m] * ug[(GI) & 1][ml]); } }
                SGRP(0) SGRP(1) SGRP(2) SGRP(3) SGRP(4) SGRP(5) SGRP(6) SGRP(7)
#undef SGRP
#undef LDU
#undef DSR128
            }
            if (USE_FUSED_NORM) { zc0 = zn0; zc1 = zn1; }
        }
#undef L1_DMA
#undef L1_DMAF
        if (VAR == 1) { _Pragma("unroll") for (int m = 0; m < 32; ++m) asm volatile("" :: "v"(acc[m])); }
        asm volatile("s_waitcnt vmcnt(0) lgkmcnt(0)" ::: "memory");
        __builtin_amdgcn_s_barrier();
        if (USE_FUSED_NORM && VAR == 0 && w == 0 && lane < 32) {
            const LAS float* pp = (const LAS float*)(F.lds + SSP_OFF) + ((NCH - 1) & 1) * 256 + lane; float sm = 0.f;
#pragma unroll
            for (int ww = 0; ww < 8; ++ww) sm += pp[ww * 32];
            SS[(size_t)(b * SEQ + 32 * (NCH - 2) + lane) * 64 + h * 8 + ds] = sm; }
        asm volatile("s_waitcnt vmcnt(0) lgkmcnt(0)" ::: "memory");
    }
}

constexpr int R2_QD = 0, R2_KD = 32768, R2_P = 65536, R2_GL = 67584, ST2 = 69632, X2_OFF = 2 * ST2;
DI_ void l1_seq2(Frame& F, const unsigned char* REC1, const unsigned char* VF1, float* SS) {
    const int lane = F.lane, w = F.wave, r = lane & 15, g = lane >> 4, dkh = w >> 2, dvq = w & 3;
    for (int u = F.vcu; u < NB * GL_H * 8; u += F.G) {
        const int bh = u >> 3, ds = u & 7, b = bh >> 3, h = bh & 7;
        f32x4 acc[16][2];
#pragma unroll
        for (int m = 0; m < 16; ++m) { acc[m][0] = (f32x4){0.f, 0.f, 0.f, 0.f}; acc[m][1] = acc[m][0]; }
        const int ycol = h * 1024 + ds * 128 + 32 * dvq + 16 * dkh + 4 * g;
        const f32x4 ng4 = *(const GAS f32x4*)(F.ng1 + ycol);
        const bf16* xz = F.QFIZ + (size_t)(b * SEQ - 32) * N1 + 16384 + ycol;
        const unsigned char* vfb = VF1 + ((size_t)bh * NCH * 64 + ds * 8 + 2 * dvq) * 1024 + lane * 16;
#define L2_DMA(c_) do { const unsigned char* rs_ = REC1 + (size_t)(bh * NCH + (c_)) * R1_SH; LAS unsigned char* st_ = F.lds + ((c_) & 1) * ST2; \
        _Pragma("unroll") for (int i_ = 0; i_ < 8; ++i_) { const int p_ = w + 8 * i_; __builtin_amdgcn_global_load_lds((const unsigned*)(rs_ + p_ * 1024 + lane * 16), (LAS unsigned*)(st_ + p_ * 1024), 16, 0, 0); } \
        if (w < 4) __builtin_amdgcn_global_load_lds((const unsigned*)(rs_ + (w + 64) * 1024 + lane * 16), (LAS unsigned*)(st_ + (w + 64) * 1024), 16, 0, 0); } while (0)
        v4u vfr[2][2];
        v2u zr[2][2];
        f32x4 keep[2][2];
        vfr[0][0] = *(const GAS v4u*)(vfb); vfr[0][1] = *(const GAS v4u*)(vfb + 1024);
        zr[0][0] = (v2u){0u, 0u}; zr[0][1] = zr[0][0];
        L2_DMA(0);
#define L2_BODY(C_, PAR) do { const int c = (C_); \
            asm volatile("s_waitcnt vmcnt(0) lgkmcnt(0)" ::: "memory"); \
            __builtin_amdgcn_s_barrier(); \
            asm volatile("" ::: "memory"); \
            if (c >= 3 && c <= NCH + 1 && w == 0 && lane < 32) {                  \
                const LAS float* pp = (const LAS float*)(F.lds + SSP_OFF) + PAR * 256 + lane; float sm = 0.f; \
                _Pragma("unroll") for (int ww = 0; ww < 8; ++ww) sm += pp[ww * 32]; \
                SS[(size_t)(b * SEQ + 32 * (c - 3) + lane) * 64 + h * 8 + ds] = sm; } \
            if (c >= 2 && c <= NCH) {                                  \
                const v4u px = *(const LAS v4u*)(F.lds + X2_OFF + (PAR ^ 1) * 8192 + (w ^ 4) * 1024 + lane * 16); \
                const f32x4 a0 = keep[PAR ^ 1][0] + (f32x4){bflo(px.x), bfhi(px.x), bflo(px.y), bfhi(px.y)}, a1 = keep[PAR ^ 1][1] + (f32x4){bflo(px.z), bfhi(px.z), bflo(px.w), bfhi(px.w)}; \
                float t0 = (a0.x * a0.x + a0.y * a0.y) + (a0.z * a0.z + a0.w * a0.w), t1 = (a1.x * a1.x + a1.y * a1.y) + (a1.z * a1.z + a1.w * a1.w); \
                t0 += __shfl_xor(t0, 16); t1 += __shfl_xor(t1, 16); t0 += __shfl_xor(t0, 32); t1 += __shfl_xor(t1, 32); \
                if (g == 0) { LAS float* pp = (LAS float*)(F.lds + SSP_OFF) + ((PAR ^ 1) * 8 + w) * 32; pp[r] = t0; pp[16 + r] = t1; } \
                const v2u z0 = zr[PAR ^ 1][0], z1 = zr[PAR ^ 1][1]; \
                bf16* op = F.Y + (size_t)(b * SEQ + 32 * (c - 2) + r) * DI + ycol; \
                *(GAS v2u*)op = (v2u){cvtpk(a0.x * ng4.x * silu(bflo(z0.x)), a0.y * ng4.y * silu(bfhi(z0.x))), cvtpk(a0.z * ng4.z * silu(bflo(z0.y)), a0.w * ng4.w * silu(bfhi(z0.y)))}; \
                *(GAS v2u*)(op + (size_t)16 * DI) = (v2u){cvtpk(a1.x * ng4.x * silu(bflo(z1.x)), a1.y * ng4.y * silu(bfhi(z1.x))), cvtpk(a1.z * ng4.z * silu(bflo(z1.y)), a1.w * ng4.w * silu(bfhi(z1.y)))}; } \
            if (c + 1 < NCH) {                                         \
                vfr[PAR ^ 1][0] = *(const GAS v4u*)(vfb + (size_t)(c + 1) * 65536); vfr[PAR ^ 1][1] = *(const GAS v4u*)(vfb + (size_t)(c + 1) * 65536 + 1024); \
                { const bf16* zp = xz + (size_t)((c + 1) * 32 + r) * N1; zr[PAR ^ 1][0] = *(const GAS v2u*)zp; zr[PAR ^ 1][1] = *(const GAS v2u*)(zp + (size_t)16 * N1); } \
                L2_DMA(c + 1); } \
            if (c < NCH) { \
                const LAS unsigned char* st = F.lds + (c & 1) * ST2; \
                bf16x8 vf[2]; vf[0] = __builtin_bit_cast(bf16x8, vfr[PAR][0]); vf[1] = __builtin_bit_cast(bf16x8, vfr[PAR][1]); \
                const LAS f32x4* glp = (const LAS f32x4*)(st + R2_GL + (256 * dkh + 4 * g) * 4); \
                f32x4 ug[2][2]; bf16x8 uk[2][2]; \
                if (c > 0) { \
                    f32x4 o[2][2]; \
                    _Pragma("unroll") for (int ti = 0; ti < 2; ++ti) { o[ti][0] = (f32x4){0.f, 0.f, 0.f, 0.f}; o[ti][1] = o[ti][0]; } \
                    if (dkh == 0) { const bf16x8 p0 = *(const LAS bf16x8*)(st + R2_P + lane * 16), p1 = *(const LAS bf16x8*)(st + R2_P + 1024 + lane * 16); \
                        o[0][0] = MFMA16(vf[0], p0, o[0][0]); o[0][1] = MFMA16(vf[1], p0, o[0][1]); o[1][0] = MFMA16(vf[0], p1, o[1][0]); o[1][1] = MFMA16(vf[1], p1, o[1][1]); } \
                    bf16x8 qb[2][2]; \
                    qb[0][0] = *(const LAS bf16x8*)(st + R2_QD + (8 * dkh) * 1024 + lane * 16); qb[0][1] = *(const LAS bf16x8*)(st + R2_QD + (16 + 8 * dkh) * 1024 + lane * 16); \
                    SCHED_FENCE(); \
                    _Pragma("unroll") for (int s2 = 0; s2 < 8; ++s2) { \
                        if (s2 < 7) { qb[(s2 + 1) & 1][0] = *(const LAS bf16x8*)(st + R2_QD + (8 * dkh + s2 + 1) * 1024 + lane * 16); qb[(s2 + 1) & 1][1] = *(const LAS bf16x8*)(st + R2_QD + (16 + 8 * dkh + s2 + 1) * 1024 + lane * 16); } \
                        SCHED_FENCE(); \
                        _Pragma("unroll") for (int t_ = 0; t_ < 2; ++t_) { \
                            const bf16x8 sb = mk8(cvtpk(acc[2 * s2][t_].x, acc[2 * s2][t_].y), cvtpk(acc[2 * s2][t_].z, acc[2 * s2][t_].w), cvtpk(acc[2 * s2 + 1][t_].x, acc[2 * s2 + 1][t_].y), cvtpk(acc[2 * s2 + 1][t_].z, acc[2 * s2 + 1][t_].w)); \
                            o[0][t_] = MFMA16(sb, qb[s2 & 1][0], o[0][t_]); o[1][t_] = MFMA16(sb, qb[s2 & 1][1], o[1][t_]); } \
                        SCHED_FENCE(); \
                    } \
                    { const f32x4 s0 = o[0][dkh ^ 1], s1 = o[1][dkh ^ 1];                    \
                      *(LAS v4u*)(F.lds + X2_OFF + PAR * 8192 + w * 1024 + lane * 16) = (v4u){pk2(s0.x, s0.y), pk2(s0.z, s0.w), pk2(s1.x, s1.y), pk2(s1.z, s1.w)}; \
                      keep[PAR][0] = o[0][dkh]; keep[PAR][1] = o[1][dkh]; } \
                } \
                _Pragma("unroll") for (int ml_ = 0; ml_ < 2; ++ml_) { ug[0][ml_] = glp[4 * ml_]; uk[0][ml_] = *(const LAS bf16x8*)(st + R2_KD + (16 * dkh + ml_) * 1024 + lane * 16); } \
                SCHED_FENCE(); \
                _Pragma("unroll") for (int gi = 0; gi < 8; ++gi) { \
                    if (gi < 7) { _Pragma("unroll") for (int ml_ = 0; ml_ < 2; ++ml_) { const int m_ = 2 * (gi + 1) + ml_; ug[(gi + 1) & 1][ml_] = glp[4 * m_]; uk[(gi + 1) & 1][ml_] = *(const LAS bf16x8*)(st + R2_KD + (16 * dkh + m_) * 1024 + lane * 16); } } \
                    SCHED_FENCE(); \
                    _Pragma("unroll") for (int ml = 0; ml < 2; ++ml) { const int m = 2 * gi + ml; \
                        acc[m][0] = MFMA16(uk[gi & 1][ml], vf[0], acc[m][0] * ug[gi & 1][ml]); acc[m][1] = MFMA16(uk[gi & 1][ml], vf[1], acc[m][1] * ug[gi & 1][ml]); } \
                    SCHED_FENCE(); \
                } \
            } \
            asm volatile("" : "+v"(vfr[PAR ^ 1][0]), "+v"(vfr[PAR ^ 1][1]), "+v"(zr[PAR ^ 1][0]), "+v"(zr[PAR ^ 1][1]));        \
        } while (0)
        for (int c2 = 0; c2 <= NCH + 1; c2 += 2) { L2_BODY(c2, 0); L2_BODY(c2 + 1, 1); }
#undef L2_BODY
#undef L2_DMA
        asm volatile("s_waitcnt vmcnt(0) lgkmcnt(0)" ::: "memory");
        __builtin_amdgcn_s_barrier();
    }
}

DI_ void l0_prep(Frame& F, unsigned char* REC0) {
    const int lane = F.lane, w = F.wave, r = lane & 15, g = lane >> 4;
    LAS unsigned char* T = F.lds + w * 16640;
    LAS unsigned char* Tv = T + 8192;
    const int gw = F.vcu * NWAVES + w, NGW = F.G * NWAVES;
    for (int it = gw; it < NB * HG_H * NCH; it += NGW) {
        const int bh = it / NCH, c = it - bh * NCH, b = bh >> 6, h = bh & 63;
        unsigned char* rec = REC0 + (size_t)it * R0_SZ;
        int row[2]; bool nul[2];
#pragma unroll
        for (int ti = 0; ti < 2; ++ti) { const int tok = 16 * ti + r; nul[ti] = (c == 0 && tok < 16); row[ti] = nul[ti] ? 0 : row_of(b, c, tok); }
        f32x4 pacc[3];
#pragma unroll
        for (int t = 0; t < 3; ++t) pacc[t] = (f32x4){0.f, 0.f, 0.f, 0.f};
        v4u qraw[4][2], fraw[4][2], vraw[8];
#pragma unroll
        for (int s = 0; s < 4; ++s)
#pragma unroll
            for (int ti = 0; ti < 2; ++ti) { const bf16* rp = F.QFIZ + (size_t)row[ti] * N0 + h * 128 + 32 * s + 8 * g; qraw[s][ti] = *(const GAS v4u*)rp; fraw[s][ti] = *(const GAS v4u*)(rp + DI); }
#pragma unroll
        for (int i = 0; i < 8; ++i) { const int q = lane + 64 * i, tk = q >> 4, c16 = q & 15; const bool nl = (c == 0 && tk < 16);
            vraw[i] = (v4u){0u, 0u, 0u, 0u}; if (!nl) vraw[i] = *(const GAS v4u*)(F.QFIZ + (size_t)row_of(b, c, tk) * N0 + 2 * DI + h * 128 + 8 * c16); }
        asm volatile("" ::: "memory");
#pragma unroll
        for (int s = 0; s < 4; ++s) {
            const int col = h * 128 + 32 * s + 8 * g;
            float lbv[8], bfv[8];
            { const f32x4 a0 = *(const GAS f32x4*)(F.LB0 + col), a1 = *(const GAS f32x4*)(F.LB0 + col + 4), c0 = *(const GAS f32x4*)(F.b_f + col), c1 = *(const GAS f32x4*)(F.b_f + col + 4);
              lbv[0] = a0.x; lbv[1] = a0.y; lbv[2] = a0.z; lbv[3] = a0.w; lbv[4] = a1.x; lbv[5] = a1.y; lbv[6] = a1.z; lbv[7] = a1.w;
              bfv[0] = c0.x; bfv[1] = c0.y; bfv[2] = c0.z; bfv[3] = c0.w; bfv[4] = c1.x; bfv[5] = c1.y; bfv[6] = c1.z; bfv[7] = c1.w; }
            float qv[2][8], fv[2][8];
#pragma unroll
            for (int ti = 0; ti < 2; ++ti) {
                const v4u q4 = qraw[s][ti], f4 = fraw[s][ti];
                qv[ti][0] = bflo(q4.x); qv[ti][1] = bfhi(q4.x); qv[ti][2] = bflo(q4.y); qv[ti][3] = bfhi(q4.y); qv[ti][4] = bflo(q4.z); qv[ti][5] = bfhi(q4.z); qv[ti][6] = bflo(q4.w); qv[ti][7] = bfhi(q4.w);
                fv[ti][0] = bflo(f4.x); fv[ti][1] = bfhi(f4.x); fv[ti][2] = bflo(f4.y); fv[ti][3] = bfhi(f4.y); fv[ti][4] = bflo(f4.z); fv[ti][5] = bfhi(f4.z); fv[ti][6] = bflo(f4.w); fv[ti][7] = bfhi(f4.w);
            }
            unsigned qd[2][4], ki[2][4], kd[2][4]; float gl[8];
#pragma unroll
            for (int e = 0; e < 8; e += 2) {
                float bb[2][2], BB[2], kk[2][2];
#pragma unroll
                for (int u = 0; u < 2; ++u) {
                    const float fg0 = lbv[e + u] + (1.f - lbv[e + u]) * sigm(fv[0][e + u] + bfv[e + u]);
                    const float fg1 = lbv[e + u] + (1.f - lbv[e + u]) * sigm(fv[1][e + u] + bfv[e + u]);
                    const float L0 = nul[0] ? 0.f : lg2(fg0), L1 = nul[1] ? 0.f : lg2(fg1);
                    kk[0][u] = nul[0] ? 0.f : 1.f - fg0; kk[1][u] = nul[1] ? 0.f : 1.f - fg1;
                    const float b0 = scan16(L0);
                    const float b1 = scan16(L1) + bcast15(b0);
                    bb[0][u] = b0; bb[1][u] = b1; BB[u] = bcast15(b1);
                    gl[e + u] = ex2(BB[u]);
                }
#pragma unroll
                for (int ti = 0; ti < 2; ++ti) {
                    const float q0 = nul[ti] ? 0.f : silu(qv[ti][e]), q1 = nul[ti] ? 0.f : silu(qv[ti][e + 1]);
                    qd[ti][e >> 1] = cvtpk(q0 * ex2(bb[ti][0]), q1 * ex2(bb[ti][1]));
                    ki[ti][e >> 1] = cvtpk(kk[ti][0] * ex2(-bb[ti][0]), kk[ti][1] * ex2(-bb[ti][1]));
                    kd[ti][e >> 1] = cvtpk(kk[ti][0] * ex2(BB[0] - bb[ti][0]), kk[ti][1] * ex2(BB[1] - bb[ti][1]));
                }
            }
            const bf16x8 qf0 = mk8(qd[0][0], qd[0][1], qd[0][2], qd[0][3]), qf1 = mk8(qd[1][0], qd[1][1], qd[1][2], qd[1][3]);
            const bf16x8 kf0 = mk8(ki[0][0], ki[0][1], ki[0][2], ki[0][3]), kf1 = mk8(ki[1][0], ki[1][1], ki[1][2], ki[1][3]);
            pacc[0] = MFMA16(kf0, qf0, pacc[0]);
            pacc[1] = MFMA16(kf0, qf1, pacc[1]);
            pacc[2] = MFMA16(kf1, qf1, pacc[2]);
#pragma unroll
            for (int ti = 0; ti < 2; ++ti)
#pragma unroll
                for (int h2 = 0; h2 < 2; ++h2) {
                    const int lp = (2 * (g & 1) + h2) * 16 + r;
                    v2u d; d.x = qd[ti][2 * h2]; d.y = qd[ti][2 * h2 + 1];
                    *(GAS v2u*)(rec + R0_QD + ((ti * 4 + s) * 64 + lp) * 16 + (g >> 1) * 8) = d;
                }
#pragma unroll
            for (int ti = 0; ti < 2; ++ti)
#pragma unroll
                for (int e = 0; e < 8; ++e) {
                    const unsigned wd = kd[ti][e >> 1]; const unsigned short hv = (e & 1) ? (unsigned short)(wd >> 16) : (unsigned short)(wd & 0xffffu);
                    *(LAS unsigned short*)(T + (32 * s + 8 * g + e) * 64 + (16 * ti + r) * 2) = hv;
                }
            if (r == 0) { *(GAS f32x4*)(rec + R0_GL + (32 * s + 8 * g) * 4) = (f32x4){gl[0], gl[1], gl[2], gl[3]}; *(GAS f32x4*)(rec + R0_GL + (32 * s + 8 * g + 4) * 4) = (f32x4){gl[4], gl[5], gl[6], gl[7]}; }
        }
#pragma unroll
        for (int t = 0; t < 4; ++t) {
            const int tj = (t >= 2) ? 1 : 0, ti = (t == 1 || t == 2) ? 1 : 0;
            float pv[4] = {0.f, 0.f, 0.f, 0.f};
            if (t < 3) { pv[0] = pacc[t].x; pv[1] = pacc[t].y; pv[2] = pacc[t].z; pv[3] = pacc[t].w; }
#pragma unroll
            for (int jj = 0; jj < 4; ++jj) { const int j = 16 * tj + 4 * g + jj, i = 16 * ti + r; if (j > i) pv[jj] = 0.f; }
            const int lp = (2 * tj + (g >> 1)) * 16 + r;
            v2u d; d.x = cvtpk(pv[0], pv[1]); d.y = cvtpk(pv[2], pv[3]);
            *(GAS v2u*)(rec + R0_P + (ti * 64 + lp) * 16 + 8 * (g & 1)) = d;
        }
#pragma unroll
        for (int i = 0; i < 8; ++i) {
            const int q = lane + 64 * i, tk = q >> 4, c16 = q & 15; const v4u d = vraw[i];
            *(LAS v2u*)(Tv + tk * 264 + c16 * 16) = (v2u){d.x, d.y}; *(LAS v2u*)(Tv + tk * 264 + c16 * 16 + 8) = (v2u){d.z, d.w};
        }
        LDS_WAIT(); asm volatile("" ::: "memory");
#pragma unroll
        for (int mt = 0; mt < 8; ++mt) { const v4u d = *(const LAS v4u*)(T + (16 * mt + r) * 64 + 16 * g); *(GAS v4u*)(rec + R0_KD + (mt * 64 + lane) * 16) = d; }
#pragma unroll
        for (int sl = 0; sl < 8; ++sl) {
            unsigned short hv[8];
#pragma unroll
            for (int e = 0; e < 8; ++e) hv[e] = *(const LAS unsigned short*)(Tv + (8 * g + e) * 264 + (16 * sl + r) * 2);
            v4u d; d.x = hv[0] | ((unsigned)hv[1] << 16); d.y = hv[2] | ((unsigned)hv[3] << 16); d.z = hv[4] | ((unsigned)hv[5] << 16); d.w = hv[6] | ((unsigned)hv[7] << 16);
            *(GAS v4u*)(rec + R0_V + (sl * 64 + lane) * 16) = d;
        }
        LDS_WAIT(); asm volatile("" ::: "memory");
    }
}

DI_ void l0_seq(Frame& F, const unsigned char* REC0) {
    const int lane = F.lane, w = F.wave, r = lane & 15, g = lane >> 4;
    LAS float* obuf = (LAS float*)(F.lds + 2 * ST0);
    constexpr int OB = 32 * 132;
    for (int u = F.vcu; u < NB * HG_H; u += F.G) {
        const int bh = u, b = bh >> 6, h = bh & 63;
        f32x4 acc[8];
#pragma unroll
        for (int m = 0; m < 8; ++m) acc[m] = (f32x4){0.f, 0.f, 0.f, 0.f};
        const int ntok = 4 * w + g, ndv = 8 * r;
        float ngv[8];
        { const f32x4 a0 = *(const GAS f32x4*)(F.ng0 + h * 128 + ndv), a1 = *(const GAS f32x4*)(F.ng0 + h * 128 + ndv + 4);
          ngv[0] = a0.x; ngv[1] = a0.y; ngv[2] = a0.z; ngv[3] = a0.w; ngv[4] = a1.x; ngv[5] = a1.y; ngv[6] = a1.z; ngv[7] = a1.w; }
#define L0_DMA(c_) do { const unsigned char* rs_ = REC0 + (size_t)(bh * NCH + (c_)) * R0_SZ; LAS unsigned char* st_ = F.lds + ((c_) & 1) * ST0; \
        for (int p_ = w; p_ < 27; p_ += 8) __builtin_amdgcn_global_load_lds((const unsigned*)(rs_ + p_ * 1024 + lane * 16), (LAS unsigned*)(st_ + p_ * 1024), 16, 0, 0); } while (0)
        L0_DMA(0);
        v4u zprev = (v4u){0u, 0u, 0u, 0u};
        for (int c = 0; c <= NCH; ++c) {
            asm volatile("s_waitcnt vmcnt(0)" ::: "memory");
            __builtin_amdgcn_s_barrier();
            asm volatile("" ::: "memory");
            if (c + 1 < NCH) L0_DMA(c + 1);
            v4u zcur = (v4u){0u, 0u, 0u, 0u};
            const bool zvalid = (c < NCH) && !(c == 0 && ntok < 16);
            if (zvalid) zcur = *(const GAS v4u*)(F.QFIZ + (size_t)row_of(b, c, ntok) * N0 + 3 * DI + h * 128 + ndv);
            if (c >= 1) {
                const int cp = c - 1;
                const LAS float* ob = obuf + (cp & 1) * OB + ntok * 132 + ndv;
                const f32x4 x0 = *(const LAS f32x4*)(ob), x1 = *(const LAS f32x4*)(ob + 4);
                float ss = (x0.x * x0.x + x0.y * x0.y) + (x0.z * x0.z + x0.w * x0.w) + (x1.x * x1.x + x1.y * x1.y) + (x1.z * x1.z + x1.w * x1.w);
                ss += __shfl_xor(ss, 8); ss += __shfl_xor(ss, 4); ss += __shfl_xor(ss, 2); ss += __shfl_xor(ss, 1);
                const float rs = rsqrtf(ss * (1.f / 128.f) + RMS_EPS);
                const bool wr = !(cp == 0 && (ntok < 16 || b != 0));
                if (wr) {
                    v4u d;
                    d.x = cvtpk(x0.x * rs * ngv[0] * silu(bflo(zprev.x)), x0.y * rs * ngv[1] * silu(bfhi(zprev.x)));
                    d.y = cvtpk(x0.z * rs * ngv[2] * silu(bflo(zprev.y)), x0.w * rs * ngv[3] * silu(bfhi(zprev.y)));
                    d.z = cvtpk(x1.x * rs * ngv[4] * silu(bflo(zprev.z)), x1.y * rs * ngv[5] * silu(bfhi(zprev.z)));
                    d.w = cvtpk(x1.z * rs * ngv[6] * silu(bflo(zprev.w)), x1.w * rs * ngv[7] * silu(bfhi(zprev.w)));
                    *(GAS v4u*)(F.Y + (size_t)row_of(b, cp, ntok) * DI + h * 128 + ndv) = d;
                }
            }
            zprev = zcur;
            if (c < NCH) {
                const LAS unsigned char* st = F.lds + (c & 1) * ST0;
                const bf16x8 vf = *(const LAS bf16x8*)(st + R0_V + w * 1024 + lane * 16);
                const bf16x8 p0 = *(const LAS bf16x8*)(st + R0_P + lane * 16), p1 = *(const LAS bf16x8*)(st + R0_P + 1024 + lane * 16);
                bf16x8 qf[8], kf[8]; f32x4 gf[8];
#pragma unroll
                for (int q = 0; q < 8; ++q) qf[q] = *(const LAS bf16x8*)(st + R0_QD + q * 1024 + lane * 16);
#pragma unroll
                for (int m = 0; m < 8; ++m) { gf[m] = *(const LAS f32x4*)(st + R0_GL + (16 * m + 4 * g) * 4); kf[m] = *(const LAS bf16x8*)(st + R0_KD + m * 1024 + lane * 16); }
                SCHED_FENCE();
                f32x4 o0 = (f32x4){0.f, 0.f, 0.f, 0.f}, o1 = o0;
                o0 = MFMA16(vf, p0, o0); o1 = MFMA16(vf, p1, o1);
#pragma unroll
                for (int s2 = 0; s2 < 4; ++s2) {
                    const bf16x8 sb = mk8(cvtpk(acc[2 * s2].x, acc[2 * s2].y), cvtpk(acc[2 * s2].z, acc[2 * s2].w), cvtpk(acc[2 * s2 + 1].x, acc[2 * s2 + 1].y), cvtpk(acc[2 * s2 + 1].z, acc[2 * s2 + 1].w));
                    o0 = MFMA16(sb, qf[s2], o0); o1 = MFMA16(sb, qf[4 + s2], o1);
                }
#pragma unroll
                for (int m = 0; m < 8; ++m) acc[m] = MFMA16(kf[m], vf, acc[m] * gf[m]);
                LAS float* ow = obuf + (c & 1) * OB + r * 132 + 16 * w + 4 * g;
                *(LAS f32x4*)ow = o0; *(LAS f32x4*)(ow + 16 * 132) = o1;
                asm volatile("s_waitcnt lgkmcnt(0)" ::: "memory");
            }
        }
#undef L0_DMA
        asm volatile("s_waitcnt vmcnt(0)" ::: "memory");
        __builtin_amdgcn_s_barrier();
    }
}

template <int KS, int MODE>
DI_ void skinny(Frame& F, const bf16* A, const bf16* Bt, int K, int n_first, int n_slices, bf16* Ob, int ldo, float* Of, const float* res) {
    const int lane = F.lane, w = F.wave, r = lane & 15, g = lane >> 4;
    constexpr int SPB = 8 / KS;
    const int kw = w % KS, sw = w / KS, klen = K / KS, kbeg = kw * klen;
    LAS f32x4* red = (LAS f32x4*)F.lds;
    for (int p = F.vcu; p * SPB < n_slices; p += F.G) {
        const int sl = p * SPB + sw, n0 = n_first + 16 * sl;
        f32x4 acc = (f32x4){0.f, 0.f, 0.f, 0.f};
        if (sl < n_slices) {
            const GAS v4u* bp = (const GAS v4u*)(Bt + (size_t)(n0 + r) * K + kbeg + 16 * g);
            const GAS v4u* ap = (const GAS v4u*)(A + (size_t)r * K + kbeg + 16 * g);
            for (int kk = 0; kk < klen; kk += 256) {
                v4u bv[8], av[8];
#pragma unroll
                for (int u = 0; u < 4; ++u) { bv[2 * u] = bp[(kk + 64 * u) / 8]; bv[2 * u + 1] = bp[(kk + 64 * u) / 8 + 1]; av[2 * u] = ap[(kk + 64 * u) / 8]; av[2 * u + 1] = ap[(kk + 64 * u) / 8 + 1]; }
                asm volatile("" ::: "memory");
#pragma unroll
                for (int u = 0; u < 8; ++u) acc = MFMA16(__builtin_bit_cast(bf16x8, bv[u]), __builtin_bit_cast(bf16x8, av[u]), acc);
            }
        }
        if (KS > 1) {
            red[w * 64 + lane] = acc;
            __syncthreads();
            if (kw == 0) {
#pragma unroll
                for (int j = 1; j < KS; ++j) acc += red[(w + j) * 64 + lane];
            }
        }
        if (kw == 0 && sl < n_slices) {
            if (MODE == 0) { v2u d; d.x = pk2(acc.x, acc.y); d.y = pk2(acc.z, acc.w); *(GAS v2u*)(Ob + (size_t)r * ldo + n0 + 4 * g) = d; }
            else { const f32x4 rv = *(const GAS f32x4*)(res + (size_t)r * D + n0 + 4 * g); *(GAS f32x4*)(Of + (size_t)r * D + n0 + 4 * g) = rv * ALPHA + acc; }
        }
        if (KS > 1) __syncthreads();
    }
    asm volatile("s_waitcnt vmcnt(0)" ::: "memory");
}

DI_ void gate_proj(Frame& F, const bf16* WG1T  ) {
    const int lane = F.lane, w = F.wave, r = lane & 15, g = lane >> 4, kw = w & 3, sw = w >> 2;
    LAS f32x4* red = (LAS f32x4*)F.lds;
    for (int p = F.vcu; 2 * p < MR / 16; p += F.G) {
        const int t = 2 * p + sw;
        f32x4 acc = (f32x4){0.f, 0.f, 0.f, 0.f};
        if (t < MR / 16) {
            const GAS v4u* wp = (const GAS v4u*)(WG1T + (size_t)r * D + 1024 * kw + 16 * g);
            const GAS v4u* hp = (const GAS v4u*)(F.H1B + (size_t)(16 * t + r) * D + 1024 * kw + 16 * g);
            for (int kk = 0; kk < 1024; kk += 256) {
                v4u wv[8], hv[8];
#pragma unroll
                for (int u = 0; u < 4; ++u) { wv[2 * u] = wp[(kk + 64 * u) / 8]; wv[2 * u + 1] = wp[(kk + 64 * u) / 8 + 1]; hv[2 * u] = hp[(kk + 64 * u) / 8]; hv[2 * u + 1] = hp[(kk + 64 * u) / 8 + 1]; }
                asm volatile("" ::: "memory");
#pragma unroll
                for (int u = 0; u < 8; ++u) acc = MFMA16(__builtin_bit_cast(bf16x8, wv[u]), __builtin_bit_cast(bf16x8, hv[u]), acc);
            }
        }
        red[w * 64 + lane] = acc;
        __syncthreads();
        if (kw == 0 && t < MR / 16) {
            acc += red[(w + 1) * 64 + lane]; acc += red[(w + 2) * 64 + lane]; acc += red[(w + 3) * 64 + lane];
            *(GAS f32x4*)(F.G1 + (size_t)(16 * t + r) * GL_R + 4 * g) = acc;
        }
        __syncthreads();
    }
    asm volatile("s_waitcnt vmcnt(0)" ::: "memory");
}

#ifndef USE_AUX
#define USE_AUX 0
#endif
struct AuxT { const float* src; bf16* dst; int N, K; };
DI_ AuxT aux_decode(Frame& F, int it, unsigned char* dummy) {
    constexpr int I_1 = (DI / 64) * (D / 32), I_2 = (D / 64) * (N1 / 32), I_3 = I_1, AUX_ITERS = (I_1 + I_2 + I_3) / (256 * NWAVES);
    static_assert((I_1 + I_2 + I_3) % (256 * NWAVES) == 0, "aux tiles divide over the waves");
    const int gw = F.vcu * NWAVES + F.wave;
    AuxT t;
    if (it >= AUX_ITERS || F.G != 256) { t.src = (const float*)(dummy + (size_t)gw * 8192); t.dst = (bf16*)(dummy + 32 * MiB + (size_t)gw * 8192); t.N = 32; t.K = 64; return t; }
    int r_ = it * (256 * NWAVES) + gw; const float* W; bf16* WT; int K, N;
    if (r_ < I_1) { W = F.w0out; WT = F.WT0OUT; K = DI; N = D; }
    else if (r_ < I_1 + I_2) { r_ -= I_1; W = F.w1in; WT = F.WT1IN; K = D; N = N1; }
    else { r_ -= I_1 + I_2; W = F.w1out; WT = F.WT1OUT; K = DI; N = D; }
    const int nblk = N / 32, kb = r_ / nblk, nb = r_ - kb * nblk;
    t.src = W + (size_t)(64 * kb) * N + 32 * nb; t.dst = WT + (size_t)(32 * nb) * K + 64 * kb; t.N = N; t.K = K; return t;
}
DI_ void aux_load(Frame& F, const AuxT& t, f32x4 (&wv)[8]) {
    const int rowi = F.lane >> 3, c4 = F.lane & 7;
#pragma unroll
    for (int i = 0; i < 8; ++i) wv[i] = *(const GAS f32x4*)(t.src + (size_t)(8 * i + rowi) * t.N + 4 * c4);
}
DI_ void aux_store(Frame& F, const AuxT& t, const f32x4 (&wv)[8], LAS unsigned char* scr  ) {
    const int lane = F.lane, rowi = lane >> 3, c4 = lane & 7;
#pragma unroll
    for (int i = 0; i < 8; ++i) { LAS unsigned* p = (LAS unsigned*)(scr + (8 * i + rowi) * 68 + c4 * 8); p[0] = cvtpk(wv[i].x, wv[i].y); p[1] = cvtpk(wv[i].z, wv[i].w); }
    LDS_WAIT(); asm volatile("" ::: "memory");
    const int kc = lane & 7;
#pragma unroll
    for (int j = 0; j < 4; ++j) { const int n = (lane >> 3) + 8 * j; unsigned short hv[8];
#pragma unroll
        for (int e = 0; e < 8; ++e) hv[e] = *(const LAS unsigned short*)(scr + (8 * kc + e) * 68 + n * 2);
        v4u o; o.x = hv[0] | ((unsigned)hv[1] << 16); o.y = hv[2] | ((unsigned)hv[3] << 16); o.z = hv[4] | ((unsigned)hv[5] << 16); o.w = hv[6] | ((unsigned)hv[7] << 16);
        *(GAS v4u*)(t.dst + (size_t)n * t.K + 8 * kc) = o; }
    LDS_WAIT(); asm volatile("" ::: "memory");
}

constexpr int F0_QD = 0, F0_KI = 8192, F0_T = 16384, F0_GL = 24576, F0_TV = 25088, F0_STG = 33536;
DI_ void f0_load(const bf16* cb, const int (&oq)[2], int ov, v2u (&q2)[2], v2u (&f2)[2], v4u& vraw) {
#pragma unroll
    for (int ti = 0; ti < 2; ++ti) { q2[ti] = *(const GAS v2u*)(cb + oq[ti]); f2[ti] = *(const GAS v2u*)(cb + oq[ti] + DI); }
    vraw = *(const GAS v4u*)(cb + ov);
}
DI_ void f0_prep(Frame& F, LAS unsigned char* st, const v2u (&q2)[2], const v2u (&f2)[2], const v4u& vraw, const f32x4& lb4, const f32x4& bf4) {
    const int lane = F.lane, w = F.wave, r = lane & 15, g = lane >> 4, ps = w >> 1, hf = w & 1;
    const float lbv[4] = {lb4.x, lb4.y, lb4.z, lb4.w}, bfv[4] = {bf4.x, bf4.y, bf4.z, bf4.w};
    float Lv[2][4], qq[2][4], kk[2][4];
#pragma unroll
    for (int ti = 0; ti < 2; ++ti) {
        const float qv[4] = {bflo(q2[ti].x), bfhi(q2[ti].x), bflo(q2[ti].y), bfhi(q2[ti].y)}, fv[4] = {bflo(f2[ti].x), bfhi(f2[ti].x), bflo(f2[ti].y), bfhi(f2[ti].y)};
#pragma unroll
        for (int x = 0; x < 4; ++x) { const float fg = lbv[x] + (1.f - lbv[x]) * sigm(fv[x] + bfv[x]);
            Lv[ti][x] = lg2(fg); kk[ti][x] = 1.f - fg; qq[ti][x] = silu(qv[x]); }
    }
    float qd[2][4], ki[2][4], kd[2][4], gl[4];
#pragma unroll
    for (int x = 0; x < 4; ++x) {
        const float b0 = scan16(Lv[0][x]);
        const float b1 = scan16(Lv[1][x]) + bcast15(b0);
        const float BB = bcast15(b1);
        gl[x] = ex2(BB);
        qd[0][x] = qq[0][x] * ex2(b0); ki[0][x] = kk[0][x] * ex2(-b0); kd[0][x] = ki[0][x] * gl[x];
        qd[1][x] = qq[1][x] * ex2(b1); ki[1][x] = kk[1][x] * ex2(-b1); kd[1][x] = ki[1][x] * gl[x];
    }
    const int lp = (2 * (g & 1) + hf) * 16 + r;
#pragma unroll
    for (int ti = 0; ti < 2; ++ti) {
        *(LAS v2u*)(st + F0_QD + ((ti * 4 + ps) * 64 + lp) * 16 + (g >> 1) * 8) = (v2u){cvtpk(qd[ti][0], qd[ti][1]), cvtpk(qd[ti][2], qd[ti][3])};
        *(LAS v2u*)(st + F0_KI + ((ti * 4 + ps) * 64 + lp) * 16 + (g >> 1) * 8) = (v2u){cvtpk(ki[ti][0], ki[ti][1]), cvtpk(ki[ti][2], ki[ti][3])};
        const unsigned k01 = cvtpk(kd[ti][0], kd[ti][1]), k23 = cvtpk(kd[ti][2], kd[ti][3]);
        LAS unsigned char* tp = st + F0_T + (32 * ps + 8 * g + 4 * hf) * 64 + (16 * ti + r) * 2;
        *(LAS unsigned short*)(tp) = (unsigned short)(k01 & 0xffffu); *(LAS unsigned short*)(tp + 64) = (unsigned short)(k01 >> 16);
        *(LAS unsigned short*)(tp + 128) = (unsigned short)(k23 & 0xffffu); *(LAS unsigned short*)(tp + 192) = (unsigned short)(k23 >> 16);
    }
    if (r == 0) *(LAS f32x4*)(st + F0_GL + (32 * ps + 8 * g + 4 * hf) * 4) = (f32x4){gl[0], gl[1], gl[2], gl[3]};
    { const int tk = 4 * w + (lane >> 4), c16 = lane & 15;
      *(LAS v2u*)(st + F0_TV + tk * 264 + c16 * 16) = (v2u){vraw.x, vraw.y}; *(LAS v2u*)(st + F0_TV + tk * 264 + c16 * 16 + 8) = (v2u){vraw.z, vraw.w}; }
}
DI_ void l0_fused(Frame& F, unsigned char* dummy) {
    const int lane = F.lane, w = F.wave, r = lane & 15, g = lane >> 4, ps = w >> 1, hf = w & 1;
    LAS float* obuf = (LAS float*)(F.lds + 2 * F0_STG);
    constexpr int OB = 32 * 132;
    for (int u = F.vcu; u < NB * HG_H; u += F.G) {
        const int bh = u, b = bh >> 6, h = bh & 63;
        f32x4 acc[8];
#pragma unroll
        for (int m = 0; m < 8; ++m) acc[m] = (f32x4){0.f, 0.f, 0.f, 0.f};
        const int ntok = 4 * w + g, ndv = 8 * r;
        float ngv[8];
        { const f32x4 a0 = *(const GAS f32x4*)(F.ng0 + h * 128 + ndv), a1 = *(const GAS f32x4*)(F.ng0 + h * 128 + ndv + 4);
          ngv[0] = a0.x; ngv[1] = a0.y; ngv[2] = a0.z; ngv[3] = a0.w; ngv[4] = a1.x; ngv[5] = a1.y; ngv[6] = a1.z; ngv[7] = a1.w; }
        const int colp = h * 128 + 32 * ps + 8 * g + 4 * hf;
        const f32x4 lb4 = *(const GAS f32x4*)(F.LB0 + colp), bf4 = *(const GAS f32x4*)(F.b_f + colp);
        v2u q2s[2][2], f2s[2][2]; v4u vrs[2];
        const int oq[2] = {r * N0 + colp, (16 + r) * N0 + colp};
        const int ov = (4 * w + (lane >> 4)) * N0 + 2 * DI + h * 128 + 8 * (lane & 15), oz = ntok * N0 + 3 * DI + h * 128 + ndv, oy = ntok * DI + h * 128 + ndv;
        const bf16* xq = F.QFIZ + (size_t)(b * SEQ - 32) * N0;
        bf16* xy = F.Y + (size_t)(b * SEQ - 32) * DI;
        bf16* y0 = (b == 0) ? F.Y0 : F.Y0 + (size_t)32 * DI;
#define QCH(c_) (((c_) == 0) ? (const bf16*)F.Q0 : xq + (size_t)(c_) * 32 * N0)
        f0_load(QCH(0), oq, ov, q2s[0], f2s[0], vrs[0]);
        f0_prep(F, F.lds, q2s[0], f2s[0], vrs[0], lb4, bf4);
        f0_load(QCH(1), oq, ov, q2s[1], f2s[1], vrs[1]);
        LAS unsigned char* ascr = F.lds + 2 * F0_STG + 33792 + w * 4352;
        f32x4 awv[8];
        v4u zs[2]; zs[0] = (v4u){0u, 0u, 0u, 0u}; zs[1] = zs[0];
#define F0_BODY(C_, PAR) do { const int c = (C_); \
            asm volatile("s_waitcnt lgkmcnt(0)" ::: "memory"); \
            __builtin_amdgcn_s_barrier(); \
            asm volatile("" ::: "memory"); \
            f0_load(QCH((c + 2 < NCH) ? c + 2 : NCH - 1), oq, ov, q2s[PAR], f2s[PAR], vrs[PAR]); \
            AuxT at_; if (USE_AUX) { at_ = aux_decode(F, c, dummy); aux_load(F, at_, awv); } \
            { const int cz = (c < NCH) ? c : NCH - 1; zs[PAR] = *(const GAS v4u*)(QCH(cz) + oz); } \
            { \
                const int cp = c - 1; \
                const LAS float* ob = obuf + (cp & 1) * OB + ntok * 132 + ndv; \
                const f32x4 x0 = *(const LAS f32x4*)(ob), x1 = *(const LAS f32x4*)(ob + 4); \
                float ss = (x0.x * x0.x + x0.y * x0.y) + (x0.z * x0.z + x0.w * x0.w) + (x1.x * x1.x + x1.y * x1.y) + (x1.z * x1.z + x1.w * x1.w); \
                ss = bcast15(scan16(ss)); \
                const float rs = rsqrtf(ss * (1.f / 128.f) + RMS_EPS); \
                bf16* yb = (cp <= 0) ? ((cp == 0) ? y0 : F.Y0 + (size_t)32 * DI) : xy + (size_t)cp * 32 * DI; \
                { \
                    v4u d; \
                    d.x = cvtpk(x0.x * rs * ngv[0] * silu(bflo(zs[PAR ^ 1].x)), x0.y * rs * ngv[1] * silu(bfhi(zs[PAR ^ 1].x))); \
                    d.y = cvtpk(x0.z * rs * ngv[2] * silu(bflo(zs[PAR ^ 1].y)), x0.w * rs * ngv[3] * silu(bfhi(zs[PAR ^ 1].y))); \
                    d.z = cvtpk(x1.x * rs * ngv[4] * silu(bflo(zs[PAR ^ 1].z)), x1.y * rs * ngv[5] * silu(bfhi(zs[PAR ^ 1].z))); \
                    d.w = cvtpk(x1.z * rs * ngv[6] * silu(bflo(zs[PAR ^ 1].w)), x1.w * rs * ngv[7] * silu(bfhi(zs[PAR ^ 1].w))); \
                    *(GAS v4u*)(yb + oy) = d; \
                } \
            } \
             \
            { \
                const LAS unsigned char* st = F.lds + (c & 1) * F0_STG; \
 \
                unsigned short hv[8]; \
                _Pragma("unroll") \
                for (int e = 0; e < 8; ++e) hv[e] = *(const LAS unsigned short*)(st + F0_TV + (16 * (e >> 2) + 4 * g + (e & 3)) * 264 + (16 * w + r) * 2); \
                const bf16x8 vf = mk8(hv[0] | ((unsigned)hv[1] << 16), hv[2] | ((unsigned)hv[3] << 16), hv[4] | ((unsigned)hv[5] << 16), hv[6] | ((unsigned)hv[7] << 16)); \
                bf16x8 qf[8], kf[8]; \
                _Pragma("unroll") \
                for (int q = 0; q < 8; ++q) { qf[q] = *(const LAS bf16x8*)(st + F0_QD + q * 1024 + lane * 16); kf[q] = *(const LAS bf16x8*)(st + F0_KI + q * 1024 + lane * 16); } \
                SCHED_FENCE(); \
 \
                f32x4 pt00 = (f32x4){0.f, 0.f, 0.f, 0.f}, pt01 = pt00, pt11 = pt00; \
                _Pragma("unroll") \
                for (int s2 = 0; s2 < 4; ++s2) { pt00 = MFMA16(kf[s2], qf[s2], pt00); pt01 = MFMA16(kf[s2], qf[4 + s2], pt01); pt11 = MFMA16(kf[4 + s2], qf[4 + s2], pt11); } \
                SCHED_FENCE();                           \
                f32x4 gf[8]; v2u klo[8], khi[8]; \
                _Pragma("unroll") \
                for (int m = 0; m < 8; ++m) { gf[m] = *(const LAS f32x4*)(st + F0_GL + (16 * m + 4 * g) * 4); \
                    klo[m] = *(const LAS v2u*)(st + F0_T + (16 * m + r) * 64 + 8 * g); khi[m] = *(const LAS v2u*)(st + F0_T + (16 * m + r) * 64 + 32 + 8 * g); } \
                SCHED_FENCE(); \
                const bool m0 = (4 * g + 0 <= r), m1 = (4 * g + 1 <= r), m2 = (4 * g + 2 <= r), m3 = (4 * g + 3 <= r); \
 \
                                const bf16x8 pb0 = mk8(cvtpk(m0 ? pt00.x : 0.f, m1 ? pt00.y : 0.f), cvtpk(m2 ? pt00.z : 0.f, m3 ? pt00.w : 0.f), 0u, 0u); \
                const bf16x8 pb1 = mk8(pk2(pt01.x, pt01.y), pk2(pt01.z, pt01.w), cvtpk(m0 ? pt11.x : 0.f, m1 ? pt11.y : 0.f), cvtpk(m2 ? pt11.z : 0.f, m3 ? pt11.w : 0.f)); \
                f32x4 o0 = (f32x4){0.f, 0.f, 0.f, 0.f}, o1 = o0; \
                o0 = MFMA16(vf, pb0, o0); o1 = MFMA16(vf, pb1, o1); \
                _Pragma("unroll") \
                for (int s2 = 0; s2 < 4; ++s2) { \
                    const bf16x8 sb = mk8(cvtpk(acc[2 * s2].x, acc[2 * s2].y), cvtpk(acc[2 * s2].z, acc[2 * s2].w), cvtpk(acc[2 * s2 + 1].x, acc[2 * s2 + 1].y), cvtpk(acc[2 * s2 + 1].z, acc[2 * s2 + 1].w)); \
                    o0 = MFMA16(sb, qf[s2], o0); o1 = MFMA16(sb, qf[4 + s2], o1); \
                } \
                LAS float* ow = obuf + (c & 1) * OB + r * 132 + 16 * w + 4 * g; \
                *(LAS f32x4*)ow = o0; *(LAS f32x4*)(ow + 16 * 132) = o1; \
                SCHED_FENCE(); \
                _Pragma("unroll") \
                for (int m = 0; m < 8; ++m) acc[m] = MFMA16(mk8(klo[m].x, klo[m].y, khi[m].x, khi[m].y), vf, acc[m] * gf[m]); \
                SCHED_FENCE(); \
            } \
            f0_prep(F, F.lds + ((c + 1) & 1) * F0_STG, q2s[PAR ^ 1], f2s[PAR ^ 1], vrs[PAR ^ 1], lb4, bf4); \
            if (USE_AUX) aux_store(F, at_, awv, ascr); \
        } while (0)
        for (int c2 = 0; c2 <= NCH; c2 += 2) { F0_BODY(c2, 0); F0_BODY(c2 + 1, 1); }
#undef F0_BODY
#undef QCH
        asm volatile("s_waitcnt vmcnt(0) lgkmcnt(0)" ::: "memory");
        __builtin_amdgcn_s_barrier();
    }
}

struct Args { const float* in[17]; float* out; unsigned char* ws; int ph_lo, ph_hi, li, pad; };
__global__ void __launch_bounds__(NWAVES * 64, 2) mk_fwd(Args args) {
    extern __shared__ __attribute__((aligned(16))) unsigned char lds[];
    Frame F;
    F.lds = (LAS unsigned char*)lds;
    F.MISC = (volatile LAS unsigned*)(F.lds + MISC_OFF);
    F.tid = threadIdx.x; F.lane = F.tid & 63; F.wave = __builtin_amdgcn_readfirstlane(F.tid >> 6);
    F.G = gridDim.x; { const int bx = blockIdx.x; F.vcu = (F.G % 8 == 0) ? (bx % 8) * (F.G / 8) + bx / 8 : bx; }
    unsigned char* ws = args.ws;
    F.ctl = (gu32*)(ws + WS_CTL);
    F.x = args.in[0]; F.meta = args.in[1]; F.lb_logits = args.in[2];
    F.w0in = args.in[3]; F.b_f = args.in[4]; F.ng0 = args.in[5]; F.w0out = args.in[6]; F.ln0g = args.in[7]; F.ln0b = args.in[8];
    F.w1in = args.in[9]; F.wg1 = args.in[10]; F.wg2 = args.in[11]; F.b_g = args.in[12]; F.ng1 = args.in[13]; F.w1out = args.in[14]; F.ln1g = args.in[15]; F.ln1b = args.in[16];
    F.out = args.out;
    F.LB0 = (float*)(ws + WS_LB0); F.G1 = (float*)(ws + WS_G1); F.PRE = (float*)(ws + WS_PRE); F.O1 = (float*)(ws + WS_O1); F.WG1T = (bf16*)(ws + WS_WG1T); F.W2F = (bf16*)(ws + WS_W2F); F.SS = (float*)(ws + WS_REC + 525 * MiB); F.Q0 = (bf16*)(ws + WS_Q0); F.Y0 = (bf16*)(ws + WS_Y0); F.REC0 = ws + WS_REC; F.REC1 = ws + WS_REC1; F.VF1 = ws + WS_VF1;
    F.WT0IN = (bf16*)(ws + WS_WT0IN); F.WT0OUT = (bf16*)(ws + WS_WT0OUT); F.WT1IN = (bf16*)(ws + WS_WT1IN); F.WT1OUT = (bf16*)(ws + WS_WT1OUT);
    F.XB = (bf16*)(ws + WS_XB); F.H1B = (bf16*)(ws + WS_H1B); F.QFIZ = (bf16*)(ws + WS_QFIZ); F.Y = (bf16*)(ws + WS_Y);
    for (int u = F.tid; u < (LDS_BYTES - LDSCTL_OFF) / 4; u += NWAVES * 64) ((LAS unsigned*)(F.lds + LDSCTL_OFF))[u] = 0u;
    __syncthreads();
    int vb = (int)blockIdx.x;
    if (USE_TICKETS && N_LAUNCHES == 1 && (F.G % 8) == 0) {
        if (F.tid == 0) {
            const unsigned per = (unsigned)F.G / 8u; unsigned x = xb_xcc_id() & 7u, got = 0xffffffffu;
            for (unsigned tr = 0; tr < 8u; ++tr) { const unsigned y = (x + tr) & 7u; const unsigned t = xb_add((unsigned*)(F.ctl + CW_POOL) + 64 * y, 1u); if (t < per) { got = y + 8u * t; break; } }
            F.MISC[12] = (got == 0xffffffffu) ? blockIdx.x : got;
        }
        __syncthreads();
        vb = (int)F.MISC[12];
    }
    { F.vcu = (F.G % 8 == 0) ? (vb % 8) * (F.G / 8) + vb / 8 : vb; }
    XcdBarrier bar; bar.bar = (unsigned*)(F.ctl + CW_BAR); bar.x = 0; bar.st = nullptr;
    if (N_LAUNCHES == 1) bar = xcd_barrier_post((unsigned*)(F.ctl + CW_BAR), F.MISC + 8);
#define GRID_BAR() do { if (N_LAUNCHES == 1) xcd_barrier(bar); } while (0)
    const int lo = args.ph_lo, hi = args.ph_hi;
    unsigned long long pclk0 = 0, pclkn = 0; (void)pclk0;
    unsigned long long st_prev = STAMP_MASK ? __builtin_amdgcn_s_memrealtime() : 0ull, st_acc = 0ull;
#define STAMP(k) do { if (STAMP_MASK) { const unsigned long long t_ = __builtin_amdgcn_s_memrealtime(); if ((STAMP_MASK >> (k)) & 1) st_acc += t_ - st_prev; st_prev = t_; } } while (0)
#ifdef ONLY_PHASE
#define IN(k) ((k) == ONLY_PHASE && lo <= (k) && (k) < hi)
#else
#define IN(k) (lo <= (k) && (k) < hi)
#endif
#define BOTH(k) (IN(k) && IN((k) + 1))

    if (IN(0)) { for (int rep = 0; rep < REP(0); ++rep) { p0_prologue(F); if (rep + 1 < REP(0)) GRID_BAR(); } if (BOTH(0)) GRID_BAR(); }
    STAMP(0);
    if (IN(1)) {
        if (!(P0_META_FOLD && F.G == 256)) skinny<1, 0>(F, F.XB + (size_t)MX * D, F.WT0IN, D, 0, N0 / 16, (USE_L0_MFMA == 2) ? F.Q0 + (size_t)16 * N0 : F.QFIZ + (size_t)MX * N0, N0, nullptr, nullptr);
        pg8::Gemm g{F.XB, F.WT0IN, MX, N0, D}; pg8::StaticOrder S; S.init(MX, N0, F.G, vb);
        pg8::EpiBf16<0> E{F.QFIZ, N0, nullptr, 0, 0, 1.f};
        if (PROBE_CLK == 1) pclk0 = __builtin_amdgcn_s_memtime();
        for (int rep = 0; rep < REP(1); ++rep) { pg8::gemm_phase<pg8::EpiBf16<0>, pg8::StaticOrder, PG8_ALIGN, PG8_SP2>(F.lds + RING_OFF, g, S, E); if (rep + 1 < REP(1)) GRID_BAR(); }
        if (PROBE_CLK == 1) pclkn = __builtin_amdgcn_s_memtime() - pclk0;
        if (BOTH(1)) GRID_BAR();
    }
    STAMP(1);
#if USE_L0_MFMA == 2
    STAMP(2);
    if (IN(3)) { for (int rep = 0; rep < REP(3); ++rep) { l0_fused(F, F.REC0); if (rep + 1 < REP(3)) GRID_BAR(); } if (BOTH(3)) GRID_BAR(); }
#elif USE_L0_MFMA
    if (IN(2)) { for (int rep = 0; rep < REP(2); ++rep) { l0_prep(F, F.REC0); if (rep + 1 < REP(2)) GRID_BAR(); } if (BOTH(2)) GRID_BAR(); }
    STAMP(2);
    if (IN(3)) { for (int rep = 0; rep < REP(3); ++rep) { l0_seq(F, F.REC0); if (rep + 1 < REP(3)) GRID_BAR(); } if (BOTH(3)) GRID_BAR(); }
#else
    if (IN(2)) { if (BOTH(2)) GRID_BAR(); }
    if (IN(3)) { for (int rep = 0; rep < REP(3); ++rep) { p2_l0_rec_naive(F); if (rep + 1 < REP(3)) GRID_BAR(); } if (BOTH(3)) GRID_BAR(); }
#endif
    STAMP(3);
    if (IN(4)) {
        skinny<4, 1>(F, (USE_L0_MFMA == 2) ? F.Y0 + (size_t)16 * DI : F.Y + (size_t)MX * DI, F.WT0OUT, DI, 0, D / 16, nullptr, 0, F.PRE + (size_t)MX * D, F.meta);
        pg8::Gemm g{F.Y, F.WT0OUT, MX, D, DI}; pg8::StaticOrder S; S.init(MX, D, F.G, vb);
        pg8::EpiResid E{F.PRE, D, F.x, F.meta, MX, MX, ALPHA};
        for (int rep = 0; rep < REP(4); ++rep) { pg8::gemm_phase<pg8::EpiResid, pg8::StaticOrder, PG8_ALIGN, PG8_SP2>(F.lds + RING_OFF, g, S, E); if (rep + 1 < REP(4)) GRID_BAR(); }
        if (BOTH(4)) GRID_BAR();
    }
    STAMP(4);
    if (IN(5)) { for (int rep = 0; rep < REP(5); ++rep) { ln_phase2(F, F.PRE, MR, F.ln0g, F.ln0b, RES_BF16 ? nullptr : F.PRE, F.H1B); if (rep + 1 < REP(5)) GRID_BAR(); } if (BOTH(5)) GRID_BAR(); }
    STAMP(5);
    if (IN(6)) {
        gate_proj(F, F.WG1T);
        skinny<2, 0>(F, F.H1B + (size_t)MX * D, F.WT1IN, D, 4096, (N1 - 4096 - DI) / 16, F.QFIZ + (size_t)MX * N1, N1, nullptr, nullptr);
        pg8::Gemm g{F.H1B, F.WT1IN, MX, N1, D}; pg8::StaticOrder S; S.init(MX, N1, F.G, vb);
        pg8::EpiBf16<0> E{F.QFIZ, N1, nullptr, 0, 0, 1.f};
        for (int rep = 0; rep < REP(6); ++rep) { pg8::gemm_phase<pg8::EpiBf16<0>, pg8::StaticOrder, PG8_ALIGN, PG8_SP2>(F.lds + RING_OFF, g, S, E); if (rep + 1 < REP(6)) GRID_BAR(); }
        if (BOTH(6)) GRID_BAR();
    }
    STAMP(6);
#if USE_L1_MFMA
    if (IN(7)) { for (int rep = 0; rep < REP(7); ++rep) { l1_prep(F, F.REC1, F.VF1, F.W2F); if (rep + 1 < REP(7)) GRID_BAR(); } if (BOTH(7)) GRID_BAR(); }
    STAMP(7);
#if USE_L1_SEQ2
    if (IN(8)) { l1_seq2(F, F.REC1, F.VF1, F.SS); if (BOTH(8)) GRID_BAR(); }
#else
    if (IN(8)) { l1_seq<0>(F, F.REC1, F.VF1, F.O1, F.SS); if (REP(8) > 1) { GRID_BAR(); l1_seq<PROBE_VAR>(F, F.REC1, F.VF1, F.O1, F.SS); } if (BOTH(8)) GRID_BAR(); }
#endif
#else
    if (IN(7)) { if (BOTH(7)) GRID_BAR(); }
    if (IN(8)) { for (int rep = 0; rep < REP(8); ++rep) { p6_l1_rec_naive(F); if (rep + 1 < REP(8)) GRID_BAR(); } if (BOTH(8)) GRID_BAR(); }
#endif
    STAMP(8);
#if !(USE_FUSED_NORM && USE_L1_MFMA)
    if (IN(9)) { for (int rep = 0; rep < REP(9); ++rep) { p7_normgate(F); if (rep + 1 < REP(9)) GRID_BAR(); } if (BOTH(9)) GRID_BAR(); }
#endif
    STAMP(9);
    if (IN(10)) {
        pg8::Gemm g{F.Y, F.WT1OUT, MX, D, DI}; pg8::StaticOrder S; S.init(MX, D, F.G, vb);
#if USE_FUSED_NORM && USE_L1_MFMA
        pg8::EpiResidScale E{F.PRE, D, F.H1B, ALPHA, F.SS, RMS_EPS};
        for (int rep = 0; rep < REP(10); ++rep) { pg8::gemm_phase<pg8::EpiResidScale, pg8::StaticOrder, PG8_ALIGN, PG8_SP2>(F.lds + RING_OFF, g, S, E); if (rep + 1 < REP(10)) GRID_BAR(); }
#else
        pg8::EpiResid E{F.PRE, D, F.PRE, F.PRE, MX, MX, ALPHA};
        if (PROBE_CLK == 10) pclk0 = __builtin_amdgcn_s_memtime();
        for (int rep = 0; rep < REP(10); ++rep) { pg8::gemm_phase<pg8::EpiResid, pg8::StaticOrder, PG8_ALIGN, PG8_SP2>(F.lds + RING_OFF, g, S, E); if (rep + 1 < REP(10)) GRID_BAR(); }
        if (PROBE_CLK == 10) pclkn = __builtin_amdgcn_s_memtime() - pclk0;
#endif
        if (BOTH(10)) GRID_BAR();
    }
    STAMP(10);
    if (IN(11)) { for (int rep = 0; rep < REP(11); ++rep) { ln_phase2(F, F.PRE, MX, F.ln1g, F.ln1b, F.out, nullptr); if (rep + 1 < REP(11)) GRID_BAR(); } }
    STAMP(11);
    if (STAMP_MASK && blockIdx.x == 0 && F.tid == 0) { const unsigned long long t0 = __builtin_amdgcn_s_memrealtime(); while (__builtin_amdgcn_s_memrealtime() - t0 < st_acc) __builtin_amdgcn_s_sleep(8); }
    if (PROBE_CLK && blockIdx.x == 0 && F.tid == 0) { const unsigned long long t0 = __builtin_amdgcn_s_memrealtime(); while (__builtin_amdgcn_s_memrealtime() - t0 < pclkn / (PROBE_CLK == 10 ? 10ull : 100ull)) __builtin_amdgcn_s_sleep(8); }
#undef IN
#undef BOTH
}

extern "C" void kernel_launch(void* const* d_in, const int* in_sizes, int n_in, void* d_out, int out_size, void* d_ws, size_t ws_size, hipStream_t stream) {
    static int grid = 0;
    if (grid == 0) {
        if (n_in != 17 || in_sizes[0] != MX * D || out_size != MX * D || ws_size < WS_END) { fprintf(stderr, "kernel_launch: unexpected problem (n_in %d, in0 %d, out %d, ws %zu < %zu); nothing launched\n", n_in, n_in > 0 ? in_sizes[0] : -1, out_size, ws_size, (size_t)WS_END); grid = -1; return; }
        int dev = 0, cus = 0, per_cu = 0;
        if (hipGetDevice(&dev) != hipSuccess || hipDeviceGetAttribute(&cus, hipDeviceAttributeMultiprocessorCount, dev) != hipSuccess) { fprintf(stderr, "kernel_launch: device query failed\n"); grid = -1; return; }
        if (hipFuncSetAttribute((const void*)mk_fwd, hipFuncAttributeMaxDynamicSharedMemorySize, LDS_BYTES) != hipSuccess) { fprintf(stderr, "kernel_launch: hipFuncSetAttribute failed\n"); grid = -1; return; }
        if (hipOccupancyMaxActiveBlocksPerMultiprocessor(&per_cu, (const void*)mk_fwd, NWAVES * 64, LDS_BYTES) != hipSuccess || per_cu < 1)
            fprintf(stderr, "kernel_launch: note: occupancy query reports %d workgroups per CU\n", per_cu);
        (void)hipGetLastError();
        grid = cus;
    }
    if (grid < 0) return;
    if (hipMemsetAsync((char*)d_ws + WS_CTL, 0, CTL_ZERO_BYTES, stream) != hipSuccess) { fprintf(stderr, "kernel_launch: memset failed\n"); return; }
    Args a{};
    for (int i = 0; i < 17; ++i) a.in[i] = (const float*)d_in[i];
    a.out = (float*)d_out; a.ws = (unsigned char*)d_ws;
    for (int li = 0; li < N_LAUNCHES; ++li) {
        a.ph_lo = (N_LAUNCHES == 1) ? 0 : li; a.ph_hi = (N_LAUNCHES == 1) ? PER_PHASE : li + 1; a.li = li; a.pad = 0;
        hipLaunchKernelGGL(mk_fwd, dim3(grid), dim3(NWAVES * 64), LDS_BYTES, stream, a);
        const hipError_t le = hipPeekAtLastError();
        if (le != hipSuccess) { fprintf(stderr, "kernel_launch: launch %d failed: %s\n", li, hipGetErrorName(le)); break; }
    }
}
```
